# Optimizing an MI355X kernel written in HIP

```python
import jax
import jax.numpy as jnp
from jax import lax
import numpy as np

D_MODEL = 1024
BATCH = 16
SEQ = 256
DEPTH = 4
DEC_BATCH = 4
DEC_SEQ = 1024
PAST_LEN = 256

GRID_W = 64
N_MIXERS = 3
N_MLA_LAYERS = (DEPTH + 2) // 3
N_GMLP_LAYERS = (DEPTH + 1) // 3
N_SWA_LAYERS = DEPTH // 3
ALPHA = (2.0 * DEPTH) ** 0.25
BETA = (8.0 * DEPTH) ** -0.25
MLA_HEADS = 8
MLA_Q_LORA = 384
MLA_KV_LORA = 256
MLA_NOPE = 128
MLA_ROPE = 64
MLA_V = 128
GM_FF = 6 * D_MODEL
GM_HALF = GM_FF // 2
GM_GROUPS = 8
CHUNK = 128
SWA_HEADS = 16
SWA_KV_HEADS = 4
SWA_HEAD_DIM = 64
WINDOW = 128
BAND = 128
N_EXPERTS = 16
EXPERT_FF = 2 * D_MODEL
EC_CAPACITY = 2
Q_BLOCK = 128
ROPE_BASE = 10000.0
NEG_INF = -1e30
EPS = 1e-6
F32 = jnp.float32

kernel_name = 'hybrid_mla_gmlp_swa_ecmoe_diffusion_step'


def rms_norm(x, gain):
    x32 = x.astype(F32)
    y = x32 * lax.rsqrt(jnp.mean(x32 * x32, axis=-1, keepdims=True) + EPS)
    return y.astype(x.dtype) * gain


def layer_norm(x, gain, bias=None):
    x32 = x.astype(F32)
    mu = jnp.mean(x32, axis=-1, keepdims=True)
    var = jnp.mean(jnp.square(x32 - mu), axis=-1, keepdims=True)
    y = ((x32 - mu) * lax.rsqrt(var + EPS)).astype(x.dtype) * gain
    return y if bias is None else y + bias


def modulation(cond, w, b):
    m = jax.nn.silu(cond) @ w + b
    return jnp.split(m[:, None, :], 6, axis=-1)


def axial_rope(x):
    L, d = x.shape[1], x.shape[-1]
    rows = L // GRID_W
    t_row = jnp.repeat(jnp.arange(rows), GRID_W).astype(F32)
    t_col = jnp.tile(jnp.arange(GRID_W), rows).astype(F32)
    n_freq = d // 4
    inv_freq = ROPE_BASE ** (-jnp.arange(n_freq, dtype=F32) / n_freq)

    def rot(xa, t):
        ang = t[:, None] * inv_freq[None, :]
        cos = jnp.cos(ang)[None, :, None, :]
        sin = jnp.sin(ang)[None, :, None, :]
        x1, x2 = jnp.split(xa, 2, axis=-1)
        return jnp.concatenate([x1 * cos - x2 * sin, x2 * cos + x1 * sin], axis=-1)

    xr, xc = jnp.split(x.astype(F32), 2, axis=-1)
    return jnp.concatenate([rot(xr, t_row), rot(xc, t_col)], axis=-1).astype(x.dtype)


def dense_attn(q, k, v, scale, sink=None):
    B, Lq, Hk, G, dk = q.shape
    nq = Lq // Q_BLOCK
    qb = jnp.moveaxis(q.reshape(B, nq, Q_BLOCK, Hk, G, dk), 1, 0)

    def one_block(qi):
        s = jnp.einsum('bqhgd,bkhd->bhgqk', qi, k).astype(F32) * scale
        if sink is not None:
            sk = jnp.broadcast_to(sink.astype(F32)[None, :, :, None, None], s.shape[:-1] + (1,))
            p = jax.nn.softmax(jnp.concatenate([s, sk], axis=-1), axis=-1)[..., :-1]
        else:
            p = jax.nn.softmax(s, axis=-1)
        return jnp.einsum('bhgqk,bkhd->bqhgd', p.astype(v.dtype), v)

    o = lax.map(one_block, qb)
    return jnp.moveaxis(o, 0, 1).reshape(B, Lq, Hk * G * v.shape[-1])


def window_attn(q, k, v, k_ctx, v_ctx, sink, scale):
    B, L, Hk, G, d = q.shape
    Lc = k_ctx.shape[1]
    nb = L // BAND
    qb = q.reshape(B, nb, BAND, Hk, G, d)

    def band(t):
        tp = jnp.pad(t, ((0, 0), (BAND, BAND), (0, 0), (0, 0))).reshape(B, nb + 2, BAND, Hk, t.shape[-1])
        return jnp.concatenate([tp[:, :-2], tp[:, 1:-1], tp[:, 2:]], axis=2)

    kb, vb = band(k), band(v)
    qi = jnp.arange(BAND)[:, None]
    kj = jnp.arange(3 * BAND)[None, :]
    rel = kj - BAND - qi
    kpos = jnp.arange(nb)[:, None, None] * BAND + kj[None] - BAND
    valid = (jnp.abs(rel) <= WINDOW)[None] & (kpos >= 0) & (kpos < L)

    s_loc = jnp.einsum('bnqhgd,bnkhd->bnhgqk', qb, kb).astype(F32) * scale
    s_loc = jnp.where(valid[None, :, None, None], s_loc, NEG_INF)
    s_ctx = jnp.einsum('bnqhgd,bchd->bnhgqc', qb, k_ctx).astype(F32) * scale
    s_sink = jnp.broadcast_to(sink.astype(F32)[None, None, :, :, None, None], s_loc.shape[:-1] + (1,))
    p = jax.nn.softmax(jnp.concatenate([s_loc, s_ctx, s_sink], axis=-1), axis=-1)
    p_loc = p[..., :3 * BAND].astype(v.dtype)
    p_ctx = p[..., 3 * BAND:3 * BAND + Lc].astype(v.dtype)
    o = (jnp.einsum('bnhgqk,bnkhd->bnqhgd', p_loc, vb)
         + jnp.einsum('bnhgqc,bchd->bnqhgd', p_ctx, v_ctx))
    return o.reshape(B, L, Hk * G * d)


def mla_project(h, w_in, q_gain, kv_gain, w_q_up):
    z = h @ w_in
    c_q, c_kv, k_pe = jnp.split(z, [MLA_Q_LORA, MLA_Q_LORA + MLA_KV_LORA], axis=-1)
    q = jnp.einsum('blr,rhd->blhd', rms_norm(c_q, q_gain), w_q_up)
    return q, rms_norm(c_kv, kv_gain), k_pe


def mla_keys_values(c_kv, k_pe, w_kv_up):
    kv = jnp.einsum('blr,rhd->blhd', c_kv, w_kv_up)
    k_nope, v = jnp.split(kv, [MLA_NOPE], axis=-1)
    k_rope = jnp.broadcast_to(k_pe[:, :, None, :], k_nope.shape[:3] + (MLA_ROPE,))
    return jnp.concatenate([k_nope, k_rope], axis=-1), v


def mla_context(h, w_in, q_gain, kv_gain, w_q_up, w_kv_up, w_out):
    q, c_kv, k_pe = mla_project(h, w_in, q_gain, kv_gain, w_q_up)
    k, v = mla_keys_values(c_kv, k_pe, w_kv_up)
    o = dense_attn(q[:, :, :, None, :], k, v, (MLA_NOPE + MLA_ROPE) ** -0.5)
    return o @ w_out, c_kv, k_pe


def mla_latent(h, ckv_ctx, kpe_ctx, w_in, q_gain, kv_gain, w_q_up, w_kv_up, w_out):
    q, c_kv, k_pe = mla_project(h, w_in, q_gain, kv_gain, w_q_up)
    q = jnp.concatenate([q[..., :MLA_NOPE], axial_rope(q[..., MLA_NOPE:])], axis=-1)
    k_pe = axial_rope(k_pe[:, :, None, :])[:, :, 0, :]
    k_lat, v_lat = mla_keys_values(c_kv, k_pe, w_kv_up)
    k_ctx, v_ctx = mla_keys_values(ckv_ctx, kpe_ctx, w_kv_up)
    k = jnp.concatenate([k_ctx, k_lat], axis=1)
    v = jnp.concatenate([v_ctx, v_lat], axis=1)
    o = dense_attn(q[:, :, :, None, :], k, v, (MLA_NOPE + MLA_ROPE) ** -0.5)
    return o @ w_out


def gmlp(h, w_in, v_gain, w_s, b_s, w_out):
    B, L, _ = h.shape
    z = jax.nn.gelu(h @ w_in)
    u, v = jnp.split(z, 2, axis=-1)
    v = layer_norm(v, v_gain)
    nc = L // CHUNK
    v = v.reshape(B, nc, CHUNK, GM_GROUPS, GM_HALF // GM_GROUPS)
    mixed = jnp.einsum('gnm,bkmgc->bkngc', w_s, v) + b_s.T[None, None, :, :, None]
    return (u * mixed.reshape(B, L, GM_HALF)) @ w_out


def swa_project(h, w_qkv):
    B, L, _ = h.shape
    qkv = h @ w_qkv
    q, k, v = jnp.split(qkv, [SWA_HEADS * SWA_HEAD_DIM, (SWA_HEADS + SWA_KV_HEADS) * SWA_HEAD_DIM], axis=-1)
    return (q.reshape(B, L, SWA_HEADS, SWA_HEAD_DIM),
            k.reshape(B, L, SWA_KV_HEADS, SWA_HEAD_DIM),
            v.reshape(B, L, SWA_KV_HEADS, SWA_HEAD_DIM))


def swa_context(h, w_qkv, sink, w_out):
    B, L, _ = h.shape
    q, k, v = swa_project(h, w_qkv)
    G = SWA_HEADS // SWA_KV_HEADS
    o = dense_attn(q.reshape(B, L, SWA_KV_HEADS, G, SWA_HEAD_DIM), k, v,
                   SWA_HEAD_DIM ** -0.5, sink.reshape(SWA_KV_HEADS, G))
    return o @ w_out, k, v


def swa_latent(h, k_ctx, v_ctx, w_qkv, sink, w_out):
    B, L, _ = h.shape
    q, k, v = swa_project(h, w_qkv)
    q, k = axial_rope(q), axial_rope(k)
    G = SWA_HEADS // SWA_KV_HEADS
    o = window_attn(q.reshape(B, L, SWA_KV_HEADS, G, SWA_HEAD_DIM), k, v, k_ctx, v_ctx,
                    sink.reshape(SWA_KV_HEADS, G), SWA_HEAD_DIM ** -0.5)
    return o @ w_out


def ec_moe(h, router, w_gate, w_up, w_down):
    x = h.reshape(-1, h.shape[-1])
    n_tok = x.shape[0]
    cap = EC_CAPACITY * n_tok // N_EXPERTS
    aff = jax.nn.softmax((x @ router).astype(F32), axis=-1)
    gate, idx = lax.top_k(aff.T, cap)
    xe = x[idx]
    hid = jax.nn.silu(jnp.einsum('ecd,edf->ecf', xe, w_gate)) * jnp.einsum('ecd,edf->ecf', xe, w_up)
    ye = jnp.einsum('ecf,efd->ecd', hid, w_down) * gate[..., None].astype(x.dtype)
    out = jnp.zeros_like(x).at[idx.reshape(-1)].add(ye.reshape(-1, x.shape[-1]))
    return out.reshape(h.shape)


def setup_inputs(seed: int = 0) -> dict:
    key = jax.random.key(seed)
    keys = jax.random.split(key, 40)
    counter = iter(range(40))

    def nrm(shape, scale=1.0):
        return jax.random.normal(keys[next(counter)], shape, F32) * scale

    d = D_MODEL
    return {
        'x_prompt': nrm((BATCH, SEQ, d)),
        'x_sample': nrm((DEC_BATCH, DEC_SEQ, d)),
        'cache_mla_ckv': nrm((DEC_BATCH, N_MLA_LAYERS, PAST_LEN, MLA_KV_LORA)),
        'cache_mla_kpe': nrm((DEC_BATCH, N_MLA_LAYERS, PAST_LEN, MLA_ROPE)),
        'cache_swa_k': nrm((DEC_BATCH, N_SWA_LAYERS, PAST_LEN, SWA_KV_HEADS, SWA_HEAD_DIM)),
        'cache_swa_v': nrm((DEC_BATCH, N_SWA_LAYERS, PAST_LEN, SWA_KV_HEADS, SWA_HEAD_DIM)),
        'c': nrm((DEC_BATCH, d)),
        'c_ctx': nrm((d,)),
        'mod_w': nrm((DEPTH, d, 6 * d), 0.5 * d ** -0.5),
        'mod_b': nrm((DEPTH, 6 * d), 0.02),
        'ln_gain': 1.0 + nrm((DEPTH, 2, d), 0.02),
        'ln_bias': nrm((DEPTH, 2, d), 0.02),
        'mla_w_in': nrm((N_MLA_LAYERS, d, MLA_Q_LORA + MLA_KV_LORA + MLA_ROPE), d ** -0.5),
        'mla_q_gain': 1.0 + nrm((N_MLA_LAYERS, MLA_Q_LORA), 0.02),
        'mla_kv_gain': 1.0 + nrm((N_MLA_LAYERS, MLA_KV_LORA), 0.02),
        'mla_w_q_up': nrm((N_MLA_LAYERS, MLA_Q_LORA, MLA_HEADS, MLA_NOPE + MLA_ROPE), MLA_Q_LORA ** -0.5),
        'mla_w_kv_up': nrm((N_MLA_LAYERS, MLA_KV_LORA, MLA_HEADS, MLA_NOPE + MLA_V), MLA_KV_LORA ** -0.5),
        'mla_w_out': nrm((N_MLA_LAYERS, MLA_HEADS * MLA_V, d), BETA * (MLA_HEADS * MLA_V) ** -0.5),
        'gm_w_in': nrm((N_GMLP_LAYERS, d, GM_FF), d ** -0.5),
        'gm_v_gain': 1.0 + nrm((N_GMLP_LAYERS, GM_HALF), 0.02),
        'gm_w_s': nrm((N_GMLP_LAYERS, GM_GROUPS, CHUNK, CHUNK), 0.5 * CHUNK ** -0.5),
        'gm_b_s': 1.0 + nrm((N_GMLP_LAYERS, GM_GROUPS, CHUNK), 0.1),
        'gm_w_out': nrm((N_GMLP_LAYERS, GM_HALF, d), BETA * GM_HALF ** -0.5),
        'swa_w_qkv': nrm((N_SWA_LAYERS, d, (SWA_HEADS + 2 * SWA_KV_HEADS) * SWA_HEAD_DIM), d ** -0.5),
        'swa_sink': nrm((N_SWA_LAYERS, SWA_HEADS), 0.5),
        'swa_w_out': nrm((N_SWA_LAYERS, SWA_HEADS * SWA_HEAD_DIM, d), BETA * (SWA_HEADS * SWA_HEAD_DIM) ** -0.5),
        'moe_router': nrm((DEPTH, d, N_EXPERTS), d ** -0.5),
        'moe_w_gate': nrm((DEPTH, N_EXPERTS, d, EXPERT_FF), d ** -0.5),
        'moe_w_up': nrm((DEPTH, N_EXPERTS, d, EXPERT_FF), d ** -0.5),
        'moe_w_down': nrm((DEPTH, N_EXPERTS, EXPERT_FF, d), BETA * EXPERT_FF ** -0.5),
    }


def reference(x_prompt, x_sample, cache_mla_ckv, cache_mla_kpe, cache_swa_k, cache_swa_v, c, c_ctx,
              mod_w, mod_b, ln_gain, ln_bias,
              mla_w_in, mla_q_gain, mla_kv_gain, mla_w_q_up, mla_w_kv_up, mla_w_out,
              gm_w_in, gm_v_gain, gm_w_s, gm_b_s, gm_w_out,
              swa_w_qkv, swa_sink, swa_w_out,
              moe_router, moe_w_gate, moe_w_up, moe_w_down):
    xp, xs = x_prompt, x_sample
    cond_ctx = c_ctx[None, :]
    ckv_list, kpe_list, k_list, v_list = [], [], [], []
    for i in range(DEPTH):
        kind, j = i % N_MIXERS, i // N_MIXERS
        mp = modulation(cond_ctx, mod_w[i], mod_b[i])
        ms = modulation(c, mod_w[i], mod_b[i])
        hp = xp * (1.0 + mp[1]) + mp[0]
        hs = xs * (1.0 + ms[1]) + ms[0]
        if kind == 0:
            yp, ckv, kpe = mla_context(hp, mla_w_in[j], mla_q_gain[j], mla_kv_gain[j],
                                       mla_w_q_up[j], mla_w_kv_up[j], mla_w_out[j])
            ys = mla_latent(hs, cache_mla_ckv[:, j], cache_mla_kpe[:, j], mla_w_in[j], mla_q_gain[j],
                            mla_kv_gain[j], mla_w_q_up[j], mla_w_kv_up[j], mla_w_out[j])
            ckv_list.append(ckv)
            kpe_list.append(kpe)
        elif kind == 1:
            yp = gmlp(hp, gm_w_in[j], gm_v_gain[j], gm_w_s[j], gm_b_s[j], gm_w_out[j])
            ys = gmlp(hs, gm_w_in[j], gm_v_gain[j], gm_w_s[j], gm_b_s[j], gm_w_out[j])
        else:
            yp, k_c, v_c = swa_context(hp, swa_w_qkv[j], swa_sink[j], swa_w_out[j])
            ys = swa_latent(hs, cache_swa_k[:, j], cache_swa_v[:, j], swa_w_qkv[j], swa_sink[j], swa_w_out[j])
            k_list.append(k_c)
            v_list.append(v_c)
        xp = layer_norm(ALPHA * xp + mp[2] * yp, ln_gain[i, 0], ln_bias[i, 0])
        xs = layer_norm(ALPHA * xs + ms[2] * ys, ln_gain[i, 0], ln_bias[i, 0])
        hp = xp * (1.0 + mp[4]) + mp[3]
        hs = xs * (1.0 + ms[4]) + ms[3]
        yp = ec_moe(hp, moe_router[i], moe_w_gate[i], moe_w_up[i], moe_w_down[i])
        ys = ec_moe(hs, moe_router[i], moe_w_gate[i], moe_w_up[i], moe_w_down[i])
        xp = layer_norm(ALPHA * xp + mp[5] * yp, ln_gain[i, 1], ln_bias[i, 1])
        xs = layer_norm(ALPHA * xs + ms[5] * ys, ln_gain[i, 1], ln_bias[i, 1])
    new_mla_ckv = jnp.stack(ckv_list, axis=1)
    new_mla_kpe = jnp.stack(kpe_list, axis=1)
    new_swa_k = jnp.stack(k_list, axis=1)
    new_swa_v = jnp.stack(v_list, axis=1)
    return (xp, xs, new_mla_ckv, new_mla_kpe, new_swa_k, new_swa_v)
```

```cpp
#include <hip/hip_runtime.h>
#include <stdint.h>
#include <stdio.h>

#ifndef N_LAUNCH_PER_PHASE
#define N_LAUNCH_PER_PHASE 0
#endif

#define DEVI __device__ __forceinline__
#define LAS __attribute__((address_space(3)))
typedef unsigned short bf16_t;
typedef short bf16x8 __attribute__((ext_vector_type(8)));
typedef float f32x4 __attribute__((ext_vector_type(4)));
typedef float f32x2 __attribute__((ext_vector_type(2)));
typedef unsigned u32x4 __attribute__((ext_vector_type(4)));
typedef unsigned u32x2 __attribute__((ext_vector_type(2)));
typedef LAS unsigned char lds_t;

constexpr int D = 1024;
constexpr int NTOK = 8192, NPR = 4096;
constexpr int NROWS_KV = 9216;
constexpr int DEPTH = 4;
constexpr float ALPHA_F = 1.681792830507429f;
constexpr float EPS_F = 1e-6f;
constexpr float LOG2E = 1.4426950408889634f;
constexpr int NTHREADS = 512;
constexpr int LDS_MAIN = 147456;
constexpr int LDS_BYTES = LDS_MAIN + 1024;

__device__ const float rope_tab[64 * 16 * 2] = {
1.000000000e+00f,0.000000000e+00f,1.000000000e+00f,0.000000000e+00f,1.000000000e+00f,0.000000000e+00f,1.000000000e+00f,0.000000000e+00f,1.000000000e+00f,0.000000000e+00f,1.000000000e+00f,0.000000000e+00f,1.000000000e+00f,0.000000000e+00f,1.000000000e+00f,0.000000000e+00f,1.000000000e+00f,0.000000000e+00f,1.000000000e+00f,0.000000000e+00f,1.000000000e+00f,0.000000000e+00f,1.000000000e+00f,0.000000000e+00f,1.000000000e+00f,0.000000000e+00f,1.000000000e+00f,0.000000000e+00f,1.000000000e+00f,0.000000000e+00f,1.000000000e+00f,0.000000000e+00f,
5.403023059e-01f,8.414709848e-01f,8.460091064e-01f,5.331684460e-01f,9.504152809e-01f,3.109835909e-01f,9.842302348e-01f,1.768921847e-01f,9.950041651e-01f,9.983341813e-02f,9.984192778e-01f,5.620449919e-02f,9.995000417e-01f,3.161750470e-02f,9.998418903e-01f,1.778185709e-02f,9.999500004e-01f,9.999833111e-03f,9.999841887e-01f,5.623383612e-03f,9.999950000e-01f,3.162272359e-03f,9.999984189e-01f,1.778278494e-03f,9.999995000e-01f,9.999998808e-04f,9.999998419e-01f,5.623412721e-04f,9.999999500e-01f,3.162277519e-04f,9.999999842e-01f,1.778279393e-04f,
-4.161468365e-01f,9.092974268e-01f,4.314628163e-01f,9.021307212e-01f,8.065784124e-01f,5.911271138e-01f,9.374183100e-01f,3.482052729e-01f,9.800665772e-01f,1.986693337e-01f,9.936821085e-01f,1.122313110e-01f,9.980006668e-01f,6.320339453e-02f,9.993676111e-01f,3.555809121e-02f,9.998000067e-01f,1.999866625e-02f,9.999367551e-01f,1.124658940e-02f,9.999800001e-01f,6.324513096e-03f,9.999936755e-01f,3.556551364e-03f,9.999980000e-01f,1.999998762e-03f,9.999993675e-01f,1.124682366e-03f,9.999998000e-01f,6.324554721e-04f,9.999999368e-01f,3.556558729e-04f,
-9.899924966e-01f,1.411200081e-01f,-1.159661631e-01f,9.932531646e-01f,5.827536401e-01f,8.126488756e-01f,8.610406595e-01f,5.085361174e-01f,9.553364856e-01f,2.955202180e-01f,9.858034692e-01f,1.679033061e-01f,9.955033745e-01f,9.472608625e-02f,9.985773124e-01f,5.332308304e-02f,9.995500338e-01f,2.999549953e-02f,9.998577009e-01f,1.686943954e-02f,9.999550003e-01f,9.486690354e-03f,9.999857698e-01f,5.334812988e-03f,9.999955000e-01f,2.999995526e-03f,9.999985770e-01f,1.687023105e-03f,9.999995500e-01f,9.486831000e-04f,9.999998577e-01f,5.334837808e-04f,
-6.536436209e-01f,-7.568024953e-01f,-6.276796763e-01f,7.784717233e-01f,3.011374707e-01f,9.535807379e-01f,7.575061759e-01f,6.528279969e-01f,9.210609917e-01f,3.894183478e-01f,9.748082657e-01f,2.230444915e-01f,9.920106618e-01f,1.261540598e-01f,9.974712443e-01f,7.107120934e-02f,9.992001067e-01f,3.998933329e-02f,9.997470285e-01f,2.249175622e-02f,9.999200011e-01f,1.264877321e-02f,9.999747019e-01f,7.113057742e-03f,9.999920000e-01f,3.999989523e-03f,9.999974702e-01f,2.249363310e-03f,9.999992000e-01f,1.264910691e-03f,9.999997470e-01f,7.113117008e-04f,
2.836621855e-01f,-9.589242747e-01f,-9.460792425e-01f,3.239352821e-01f,-1.034233808e-02f,9.999465166e-01f,6.300802992e-01f,7.765299843e-01f,8.775825619e-01f,4.794255386e-01f,9.607312596e-01f,2.774805341e-01f,9.875260225e-01f,1.574558824e-01f,9.960497565e-01f,8.879686156e-02f,9.987502605e-01f,4.997916629e-02f,9.996047413e-01f,2.811336165e-02f,9.998750026e-01f,1.581072865e-02f,9.999604718e-01f,8.891280002e-03f,9.999875000e-01f,4.999979521e-03f,9.999960472e-01f,2.811702920e-03f,9.999987500e-01f,1.581138156e-03f,9.999996047e-01f,8.891395984e-04f,
9.601702867e-01f,-2.794154982e-01f,-9.731036980e-01f,-2.303675170e-01f,-3.207963899e-01f,9.471481807e-01f,4.827820346e-01f,8.757405478e-01f,8.253356014e-01f,5.646424931e-01f,9.436169596e-01f,3.310393232e-01f,9.820539372e-01f,1.886002770e-01f,9.943132976e-01f,1.064944419e-01f,9.982005400e-01f,5.996400514e-02f,9.994308440e-01f,3.373407806e-02f,9.998200054e-01f,1.897252691e-02f,9.999430795e-01f,1.066947415e-02f,9.999820001e-01f,5.999964052e-03f,9.999943079e-01f,3.374041408e-03f,9.999982000e-01f,1.897365346e-03f,9.999994308e-01f,1.066967410e-03f,
7.539022543e-01f,6.569865987e-01f,-7.004298139e-01f,-7.137212872e-01f,-5.994374526e-01f,8.004216016e-01f,3.202570024e-01f,9.473306986e-01f,7.648421950e-01f,6.442176781e-01f,9.235194568e-01f,3.835515778e-01f,9.755998794e-01f,2.195560870e-01f,9.922624183e-01f,1.241583392e-01f,9.975510002e-01f,6.994284763e-02f,9.992253421e-01f,3.935372584e-02f,9.997550100e-01f,2.213413545e-02f,9.999225252e-01f,1.244763455e-02f,9.999755001e-01f,6.999943050e-03f,9.999922524e-01f,3.936378830e-03f,9.999975500e-01f,2.213592463e-03f,9.999992252e-01f,1.244795304e-03f,
-1.455000338e-01f,9.893582466e-01f,-2.120364479e-01f,-9.772617586e-01f,-8.186324475e-01f,5.743177830e-01f,1.476312130e-01f,9.890424788e-01f,6.967067008e-01f,7.173560992e-01f,9.005023096e-01f,4.348512278e-01f,9.681703064e-01f,2.502923447e-01f,9.898977664e-01f,1.417829752e-01f,9.968017064e-01f,7.991469219e-02f,9.989882418e-01f,4.497213288e-02f,9.996800171e-01f,2.529552265e-02f,9.998988088e-01f,1.422575559e-02f,9.999680002e-01f,7.999915047e-03f,9.999898807e-01f,4.498715239e-03f,9.999968000e-01f,2.529819359e-03f,9.999989881e-01f,1.422623042e-03f,
-9.111302619e-01f,4.121184852e-01f,3.416602554e-01f,-9.398235313e-01f,-9.566441680e-01f,2.912592245e-01f,-2.965079623e-02f,9.995603185e-01f,6.216099403e-01f,7.833269319e-01f,8.746382611e-01f,4.847761465e-01f,9.597726443e-01f,2.807783310e-01f,9.872200896e-01f,1.593627767e-01f,9.959527334e-01f,8.987854534e-02f,9.987195508e-01f,5.058911778e-02f,9.995950273e-01f,2.845665689e-02f,9.998719305e-01f,1.600383071e-02f,9.999595003e-01f,8.999879044e-03f,9.999871928e-01f,5.061050226e-03f,9.999959500e-01f,2.846046001e-03f,9.999987193e-01f,1.600450735e-03f,
-8.390715291e-01f,-5.440211109e-01f,7.901318660e-01f,-6.129368926e-01f,-9.997860721e-01f,-2.068356987e-02f,-2.059976331e-01f,9.785524897e-01f,5.403023059e-01f,8.414709848e-01f,8.460091064e-01f,5.331684460e-01f,9.504152902e-01f,3.109835626e-01f,9.842302348e-01f,1.768921847e-01f,9.950041659e-01f,9.983341072e-02f,9.984192778e-01f,5.620449919e-02f,9.995000417e-01f,3.161750470e-02f,9.998418903e-01f,1.778185709e-02f,9.999500004e-01f,9.999834042e-03f,9.999841887e-01f,5.623383612e-03f,9.999950000e-01f,3.162272359e-03f,9.999984189e-01f,1.778278494e-03f,
4.425697988e-03f,-9.999902066e-01f,9.952573993e-01f,-9.727645772e-02f,-9.437797393e-01f,-3.305749593e-01f,-3.758474003e-01f,9.266815697e-01f,4.535961002e-01f,8.912073709e-01f,8.147053420e-01f,5.798751639e-01f,9.401075903e-01f,3.408778647e-01f,9.809291472e-01f,1.943656558e-01f,9.939560980e-01f,1.097783002e-01f,9.980874321e-01f,6.181810327e-02f,9.993950610e-01f,3.477804006e-02f,9.998086883e-01f,1.955982724e-02f,9.999395006e-01f,1.099977904e-02f,9.999808683e-01f,6.185714754e-03f,9.999939500e-01f,3.478498401e-03f,9.999980868e-01f,1.956106080e-03f,
8.438539587e-01f,-5.365729180e-01f,8.938616142e-01f,4.483429653e-01f,-7.941793525e-01f,-6.076834341e-01f,-5.338430142e-01f,8.455836068e-01f,3.623577100e-01f,9.320391032e-01f,7.808259330e-01f,6.247486393e-01f,9.288598710e-01f,3.704312892e-01f,9.773178677e-01f,2.117776794e-01f,9.928086362e-01f,1.197122046e-01f,9.977240240e-01f,6.742975621e-02f,9.992800864e-01f,3.793822392e-02f,9.997723246e-01f,2.133773367e-02f,9.999280009e-01f,1.199971211e-02f,9.999772317e-01f,6.748044406e-03f,9.999928000e-01f,3.794723862e-03f,9.999977232e-01f,2.133933605e-03f,
9.074467815e-01f,4.201670368e-01f,5.171728454e-01f,8.558809777e-01f,-5.658204930e-01f,-8.245284529e-01f,-6.750016657e-01f,7.378162043e-01f,2.674987597e-01f,9.635582046e-01f,7.444779872e-01f,6.676470075e-01f,9.166833698e-01f,3.996143135e-01f,9.733975442e-01f,2.291227201e-01f,9.915618943e-01f,1.296341379e-01f,9.973290651e-01f,7.303927684e-02f,9.991551190e-01f,4.109803212e-02f,9.997327995e-01f,2.311557262e-02f,9.999155012e-01f,1.299963410e-02f,9.999732789e-01f,7.310371924e-03f,9.999915500e-01f,4.110949176e-03f,9.999973279e-01f,2.311761062e-03f,
1.367372182e-01f,9.906073557e-01f,-1.879615160e-02f,9.998233367e-01f,-2.813494808e-01f,-9.596053718e-01f,-7.948709048e-01f,6.067785796e-01f,1.699671664e-01f,9.854497259e-01f,7.057763743e-01f,7.084346897e-01f,9.035902493e-01f,4.283977840e-01f,9.691694136e-01f,2.463953078e-01f,9.902159961e-01f,1.395431152e-01f,9.969025685e-01f,7.864648034e-02f,9.990201601e-01f,4.425742562e-02f,9.996901128e-01f,2.489334034e-02f,9.999020016e-01f,1.399954310e-02f,9.999690098e-01f,7.872696665e-03f,9.999902000e-01f,4.427174080e-03f,9.999969010e-01f,2.489588678e-03f,
-7.596879129e-01f,6.502878402e-01f,-5.489754720e-01f,8.358384600e-01f,3.102235090e-02f,-9.995186910e-01f,-8.896704271e-01f,4.566032536e-01f,7.073720167e-02f,9.974949866e-01f,6.648435293e-01f,7.469826514e-01f,8.895936264e-01f,4.567528653e-01f,9.646348168e-01f,2.635899662e-01f,9.887710793e-01f,1.494381236e-01f,9.964445467e-01f,8.425120425e-02f,9.988752109e-01f,4.741638026e-02f,9.996442648e-01f,2.667102934e-02f,9.998875021e-01f,1.499943810e-02f,9.999644246e-01f,8.435019847e-03f,9.999887500e-01f,4.743398540e-03f,9.999964424e-01f,2.667415984e-03f,
-9.576594803e-01f,-2.879033167e-01f,-9.100810896e-01f,4.144302238e-01f,3.403181682e-01f,-9.403103447e-01f,-9.564100499e-01f,2.920270818e-01f,-2.919954613e-02f,9.995736023e-01f,6.218088193e-01f,7.831690700e-01f,8.747074844e-01f,4.846512321e-01f,9.597951759e-01f,2.807013010e-01f,9.872272839e-01f,1.593182031e-01f,9.959550145e-01f,8.985326392e-02f,9.987202731e-01f,5.057485702e-02f,9.995952558e-01f,2.844863214e-02f,9.998720027e-01f,1.599931810e-02f,9.999595231e-01f,8.997339431e-03f,9.999872000e-01f,5.059622526e-03f,9.999959523e-01f,2.845243204e-03f,
-2.751633381e-01f,-9.613974919e-01f,-9.908979596e-01f,-1.346151313e-01f,6.158647923e-01f,-7.878518627e-01f,-9.929849841e-01f,1.182405237e-01f,-1.288445416e-01f,9.916648043e-01f,5.768082960e-01f,8.168795441e-01f,8.589467084e-01f,5.120649883e-01f,9.546520286e-01f,2.977238725e-01f,9.855847666e-01f,1.691823508e-01f,9.954339876e-01f,9.545248218e-02f,9.985553481e-01f,5.373282803e-02f,9.995430857e-01f,3.022614497e-02f,9.998555035e-01f,1.699918210e-02f,9.999543054e-01f,9.559656169e-03f,9.999855500e-01f,5.375846007e-03f,9.999954305e-01f,3.023070335e-03f,
6.603167082e-01f,-7.509872468e-01f,-7.665365398e-01f,-6.422006954e-01f,8.303361283e-01f,-5.572628770e-01f,-9.982416606e-01f,-5.927551864e-02f,-2.272021643e-01f,9.738476146e-01f,5.299841756e-01f,8.480075316e-01f,8.423270577e-01f,5.389667224e-01f,9.492070108e-01f,3.146522695e-01f,9.838436942e-01f,1.790295658e-01f,9.948814823e-01f,1.010486820e-01f,9.983804374e-01f,5.689026544e-02f,9.994877548e-01f,3.200356222e-02f,9.998380044e-01f,1.799902910e-02f,9.999487715e-01f,1.012197082e-02f,9.999838000e-01f,5.692068949e-03f,9.999948771e-01f,3.200897370e-03f,
9.887046182e-01f,1.498772097e-01f,-3.060954058e-01f,-9.520008417e-01f,9.624637956e-01f,-2.714100995e-01f,-9.720142724e-01f,-2.349218044e-01f,-3.232895443e-01f,9.463000954e-01f,4.814845890e-01f,8.764545570e-01f,8.248651506e-01f,5.653295351e-01f,9.434618259e-01f,3.314811956e-01f,9.820042356e-01f,1.888588926e-01f,9.942975170e-01f,1.066416789e-01f,9.981955430e-01f,6.004713022e-02f,9.994292631e-01f,3.378088199e-02f,9.998195054e-01f,1.899885811e-02f,9.999429214e-01f,1.068428133e-02f,9.999819501e-01f,6.008291323e-03f,9.999942921e-01f,3.378724537e-03f,
4.080820618e-01f,9.129452507e-01f,2.486167313e-01f,-9.686019414e-01f,9.991443799e-01f,4.135829015e-02f,-9.151299503e-01f,-4.031589936e-01f,-4.161468365e-01f,9.092974268e-01f,4.314628163e-01f,9.021307212e-01f,8.065784476e-01f,5.911270657e-01f,9.374183100e-01f,3.482052729e-01f,9.800665802e-01f,1.986693191e-01f,9.936821085e-01f,1.122313110e-01f,9.980006668e-01f,6.320339453e-02f,9.993676111e-01f,3.555809121e-02f,9.998000066e-01f,1.999866811e-02f,9.999367551e-01f,1.124658940e-02f,9.999800001e-01f,6.324513096e-03f,9.999936755e-01f,3.556551364e-03f,
-5.477292602e-01f,8.366556385e-01f,7.267602563e-01f,-6.868912067e-01f,9.367404516e-01f,3.500247509e-01f,-8.293829489e-01f,-5.586805205e-01f,-5.048462281e-01f,8.632092944e-01f,3.800769984e-01f,9.249548504e-01f,7.874851971e-01f,6.163335658e-01f,9.310783539e-01f,3.648192688e-01f,9.780309161e-01f,2.084598934e-01f,9.930352772e-01f,1.178173940e-01f,9.977958103e-01f,6.635903053e-02f,9.993027988e-01f,3.733518799e-02f,9.997795081e-01f,2.099845811e-02f,9.999302726e-01f,1.180889298e-02f,9.999779501e-01f,6.640734236e-03f,9.999930272e-01f,3.734378079e-03f,
-9.999608264e-01f,-8.851309290e-03f,9.810745815e-01f,-1.936302286e-01f,7.814403926e-01f,6.239798978e-01f,-7.174774633e-01f,-6.965817179e-01f,-5.885011558e-01f,8.084963758e-01f,3.274895886e-01f,9.448547874e-01f,7.676045628e-01f,6.409237359e-01f,9.244439837e-01f,3.813178741e-01f,9.758974496e-01f,2.182296219e-01f,9.923570442e-01f,1.233997439e-01f,9.975809759e-01f,6.951400294e-02f,9.992348263e-01f,3.911217043e-02f,9.997580097e-01f,2.199822712e-02f,9.999234739e-01f,1.237119282e-02f,9.999758001e-01f,6.956954712e-03f,9.999923473e-01f,3.912204676e-03f,
-5.328330203e-01f,-8.462204042e-01f,9.332357723e-01f,3.592645171e-01f,5.486452564e-01f,8.360552510e-01f,-5.829432350e-01f,-8.125128828e-01f,-6.662759857e-01f,7.457052439e-01f,2.738668392e-01f,9.617676197e-01f,7.469563882e-01f,6.648730361e-01f,9.175172750e-01f,3.976959268e-01f,9.736663975e-01f,2.279775131e-01f,9.916474294e-01f,1.289781990e-01f,9.973561656e-01f,7.266828020e-02f,9.991636941e-01f,4.088902546e-02f,9.997355116e-01f,2.299797413e-02f,9.999163589e-01f,1.293348969e-02f,9.999735501e-01f,7.273174492e-03f,9.999916358e-01f,4.090031381e-03f,
4.241790073e-01f,-9.055783620e-01f,5.979771709e-01f,8.015131335e-01f,2.614416878e-01f,9.652192724e-01f,-4.300232723e-01f,-9.028178029e-01f,-7.373937800e-01f,6.754631102e-01f,2.193782753e-01f,9.756398784e-01f,7.255613200e-01f,6.881575190e-01f,9.103004290e-01f,4.139482201e-01f,9.713379761e-01f,2.377026212e-01f,9.909064560e-01f,1.345525754e-01f,9.971213823e-01f,7.582182336e-02f,9.990894022e-01f,4.266575118e-02f,9.997120138e-01f,2.399769627e-02f,9.999089278e-01f,1.349578153e-02f,9.999712001e-01f,7.589393080e-03f,9.999908927e-01f,4.267857492e-03f,
9.912028119e-01f,-1.323517501e-01f,7.855226359e-02f,9.969099969e-01f,-5.168932904e-02f,9.986632131e-01f,-2.635405934e-01f,-9.646483067e-01f,-8.011436155e-01f,5.984721441e-01f,1.641961594e-01f,9.864277070e-01f,7.034407513e-01f,7.107539022e-01f,9.027957408e-01f,4.300695879e-01f,9.689124217e-01f,2.474039593e-01f,9.901341474e-01f,1.401226969e-01f,9.968766273e-01f,7.897461572e-02f,9.990119510e-01f,4.444234199e-02f,9.996875163e-01f,2.499739629e-02f,9.999011805e-01f,1.405806910e-02f,9.999687502e-01f,7.905611374e-03f,9.999901179e-01f,4.445683934e-03f,
6.469193223e-01f,7.625584505e-01f,-4.650644959e-01f,8.852768012e-01f,-3.596943393e-01f,9.330701915e-01f,-8.874550263e-02f,-9.960543337e-01f,-8.568888271e-01f,5.155012492e-01f,1.084949468e-01f,9.940970006e-01f,6.806168009e-01f,7.326395911e-01f,8.950055582e-01f,4.460549862e-01f,9.663899806e-01f,2.570805427e-01f,9.893305281e-01f,1.456883874e-01f,9.966219035e-01f,8.212661834e-02f,9.989313406e-01f,4.621879226e-02f,9.996620190e-01f,2.599707130e-02f,9.998931169e-01f,1.462035317e-02f,9.999662002e-01f,8.221828878e-03f,9.999893115e-01f,4.623509769e-03f,
-2.921388087e-01f,9.563759284e-01f,-8.654506342e-01f,5.009942114e-01f,-6.320286307e-01f,7.749450367e-01f,8.884811635e-02f,-9.960451858e-01f,-9.040721624e-01f,4.273798371e-01f,5.245061444e-02f,9.986235192e-01f,6.571122908e-01f,7.537927018e-01f,8.869323709e-01f,4.618993066e-01f,9.637709015e-01f,2.667314183e-01f,9.884956235e-01f,1.512494708e-01f,9.963572141e-01f,8.527779227e-02f,9.988475711e-01f,4.799510009e-02f,9.996355221e-01f,2.699672032e-02f,9.998847372e-01f,1.518263167e-02f,9.999635502e-01f,8.538045559e-03f,9.999884735e-01f,4.801335923e-03f,
-9.626058663e-01f,2.709057883e-01f,-9.992934094e-01f,-3.758566202e-02f,-8.416849393e-01f,5.399689462e-01f,2.636395107e-01f,-9.646212772e-01f,-9.422223247e-01f,3.349881951e-01f,-3.759419011e-03f,9.999929334e-01f,6.329506774e-01f,7.741921209e-01f,8.785787046e-01f,4.775975920e-01f,9.610554380e-01f,2.763556497e-01f,9.876294623e-01f,1.568057565e-01f,9.960825606e-01f,8.842812085e-02f,9.987606432e-01f,4.977125243e-02f,9.996080256e-01f,2.799634234e-02f,9.998760413e-01f,1.574490538e-02f,9.999608003e-01f,8.854261387e-03f,9.999876039e-01f,4.979161926e-03f,
-7.480575297e-01f,-6.636338842e-01f,-8.253716334e-01f,-5.645898217e-01f,-9.678715076e-01f,2.514453117e-01f,4.301158485e-01f,-9.027737019e-01f,-9.709581880e-01f,2.392492366e-01f,-5.995756728e-02f,9.982009267e-01f,6.081562113e-01f,7.938173736e-01f,8.699472142e-01f,4.931448515e-01f,9.582438779e-01f,2.859522171e-01f,9.867320673e-01f,1.623570984e-01f,9.957979462e-01f,9.157756515e-02f,9.986705569e-01f,5.154724737e-02f,9.995795294e-01f,2.899593637e-02f,9.998670292e-01f,1.630717503e-02f,9.999579503e-01f,9.170476329e-03f,9.999867027e-01f,5.156987306e-03f,
1.542514499e-01f,-9.880316241e-01f,-3.972518623e-01f,-9.177096261e-01f,-9.980752275e-01f,-6.201483913e-02f,5.830269376e-01f,-8.124528233e-01f,-9.899924966e-01f,1.411200081e-01f,-1.159661631e-01f,9.932531646e-01f,5.827536401e-01f,8.126488756e-01f,8.610406595e-01f,5.085361174e-01f,9.553364944e-01f,2.955201896e-01f,9.858034692e-01f,1.679033061e-01f,9.955033738e-01f,9.472609366e-02f,9.985773124e-01f,5.332308304e-02f,9.995500337e-01f,2.999550139e-02f,9.998577009e-01f,1.686943954e-02f,9.999550003e-01f,9.486690354e-03f,9.999857698e-01f,5.334812988e-03f,
9.147423578e-01f,-4.040376453e-01f,1.532154756e-01f,-9.881928041e-01f,-9.293002953e-01f,-3.693250075e-01f,7.175492218e-01f,-6.965077991e-01f,-9.991351562e-01f,4.158051951e-02f,-1.716081385e-01f,9.851652891e-01f,5.567683641e-01f,8.306677968e-01f,8.518617972e-01f,5.237666260e-01f,9.523335692e-01f,3.050586387e-01f,9.848436973e-01f,1.734442042e-01f,9.951988471e-01f,9.787366751e-02f,9.984809103e-01f,5.509874635e-02f,9.995195384e-01f,3.099503643e-02f,9.998480564e-01f,1.743169684e-02f,9.999519504e-01f,9.802903431e-03f,9.999848053e-01f,5.512638036e-03f,
8.342233605e-01f,5.514266812e-01f,6.564951791e-01f,-7.543302193e-01f,-7.683670888e-01f,-6.400093881e-01f,8.294403670e-01f,-5.585952717e-01f,-9.982947730e-01f,-5.837419103e-02f,-2.267075845e-01f,9.739628695e-01f,5.302263665e-01f,8.478561200e-01f,8.424135592e-01f,5.388315091e-01f,9.492354203e-01f,3.145665538e-01f,9.838527819e-01f,1.789796175e-01f,9.948843677e-01f,1.010202700e-01f,9.983813507e-01f,5.687423543e-02f,9.994880436e-01f,3.199454047e-02f,9.998380958e-01f,1.799395049e-02f,9.999488004e-01f,1.011911553e-02f,9.999838092e-01f,5.690463375e-03f,
-1.327674722e-02f,9.999118601e-01f,9.575860738e-01f,-2.881473778e-01f,-5.312352786e-01f,-8.472243379e-01f,9.151713830e-01f,-4.030649323e-01f,-9.874797774e-01f,-1.577456471e-01f,-2.810903074e-01f,9.596813216e-01f,5.031541870e-01f,8.641966582e-01f,8.326989334e-01f,5.537260030e-01f,9.460423489e-01f,3.240430126e-01f,9.828307545e-01f,1.845093711e-01f,9.945599394e-01f,1.041658623e-01f,9.982786339e-01f,5.864954466e-02f,9.994555494e-01f,3.299401065e-02f,9.998278189e-01f,1.855619846e-02f,9.999455505e-01f,1.043532661e-02f,9.999827814e-01f,5.868288535e-03f,
-8.485702748e-01f,5.290826861e-01f,9.637575328e-01f,2.667797179e-01f,-2.414211151e-01f,-9.704204476e-01f,9.720383571e-01f,-2.348221291e-01f,-9.667981682e-01f,-2.555411942e-01f,-3.345843792e-01f,9.423657958e-01f,4.755788956e-01f,8.796730723e-01f,8.227209915e-01f,5.684453977e-01f,9.427546643e-01f,3.334870955e-01f,9.817776473e-01f,1.900332899e-01f,9.942255664e-01f,1.073104056e-01f,9.981727603e-01f,6.042466843e-02f,9.994220556e-01f,3.399345156e-02f,9.998172259e-01f,1.911843869e-02f,9.999422006e-01f,1.075153665e-02f,9.999817221e-01f,6.046113043e-03f,
-9.036922051e-01f,-4.281826695e-01f,6.731102676e-01f,7.395421338e-01f,7.233466718e-02f,-9.973804169e-01f,9.982477619e-01f,-5.917267879e-02f,-9.364566873e-01f,-3.507832277e-01f,-3.870206816e-01f,9.220710342e-01f,4.475280652e-01f,8.942698871e-01f,8.124829236e-01f,5.829849902e-01f,9.393727149e-01f,3.428978019e-01f,9.806934936e-01f,1.955511994e-01f,9.938812503e-01f,1.104538832e-01f,9.980637300e-01f,6.219960483e-02f,9.993875625e-01f,3.499285475e-02f,9.998063168e-01f,1.968067474e-02f,9.999387506e-01f,1.106774562e-02f,9.999806311e-01f,6.223937825e-03f,
-1.279636896e-01f,-9.917788534e-01f,1.751565337e-01f,9.845405978e-01f,3.789161719e-01f,-9.254309994e-01f,9.929728258e-01f,1.183425843e-01f,-8.967583530e-01f,-4.425205716e-01f,-4.382335472e-01f,8.988611451e-01f,4.190297442e-01f,9.079725070e-01f,8.019878986e-01f,5.973402803e-01f,9.358968291e-01f,3.522742188e-01f,9.795783277e-01f,2.010629250e-01f,9.935269954e-01f,1.135962562e-01f,9.979515440e-01f,6.397433710e-02f,9.993520699e-01f,3.599222668e-02f,9.997950914e-01f,2.024290457e-02f,9.999352007e-01f,1.138395348e-02f,9.999795085e-01f,6.401761945e-03f,
7.654140519e-01f,-6.435381334e-01f,-3.767422893e-01f,9.263181135e-01f,6.479216888e-01f,-7.617069550e-01f,9.563800296e-01f,2.921253822e-01f,-8.481000064e-01f,-5.298361813e-01f,-4.880608524e-01f,8.728096037e-01f,3.901124287e-01f,9.207672306e-01f,7.912392691e-01f,6.115066795e-01f,9.323273439e-01f,3.616154364e-01f,9.784321880e-01f,2.065682779e-01f,9.931628052e-01f,1.167374932e-01f,9.978362017e-01f,6.574887451e-02f,9.993155781e-01f,3.699155889e-02f,9.997835499e-01f,2.080512613e-02f,9.999315508e-01f,1.170016020e-02f,9.999783543e-01f,6.579586328e-03f,
9.550736440e-01f,2.963685787e-01f,-8.126112051e-01f,5.828061679e-01f,8.526731157e-01f,-5.224447891e-01f,8.896234916e-01f,4.566946935e-01f,-7.909677411e-01f,-6.118578532e-01f,-5.363451811e-01f,8.439987244e-01f,3.608050334e-01f,9.326412643e-01f,7.802404339e-01f,6.254797082e-01f,9.286646373e-01f,3.709204650e-01f,9.772551046e-01f,2.120671131e-01f,9.927886843e-01f,1.198775555e-01f,9.977177040e-01f,6.752320399e-02f,9.992780868e-01f,3.799085783e-02f,9.997716923e-01f,2.136734297e-02f,9.999278009e-01f,1.201636575e-02f,9.999771684e-01f,6.757410504e-03f,
2.666429324e-01f,9.637953863e-01f,-9.982103598e-01f,5.980031485e-02f,9.728653499e-01f,-2.313720187e-01f,7.948083899e-01f,6.068604645e-01f,-7.259322386e-01f,-6.877662284e-01f,-5.829338849e-01f,8.125195911e-01f,3.311368634e-01f,9.435827349e-01f,7.689949093e-01f,6.392549018e-01f,9.249090653e-01f,3.801884019e-01f,9.760471178e-01f,2.175592422e-01f,9.924046346e-01f,1.230164264e-01f,9.975960518e-01f,6.929731252e-02f,9.992395964e-01f,3.899011506e-02f,9.997595184e-01f,2.192955306e-02f,9.999239510e-01f,1.233257010e-02f,9.999759510e-01f,6.935234000e-03f,
-6.669380617e-01f,7.451131605e-01f,-8.763794418e-01f,-4.816212973e-01f,9.965789837e-01f,8.264580634e-02f,6.749256518e-01f,7.378857395e-01f,-6.536436209e-01f,-7.568024953e-01f,-6.276796763e-01f,7.784717233e-01f,3.011375844e-01f,9.535807020e-01f,7.575061759e-01f,6.528279969e-01f,9.210610033e-01f,3.894183203e-01f,9.748082657e-01f,2.230444915e-01f,9.920106618e-01f,1.261540598e-01f,9.974712443e-01f,7.107120934e-02f,9.992001065e-01f,3.998933702e-02f,9.997470285e-01f,2.249175622e-02f,9.999200011e-01f,1.264877321e-02f,9.999747019e-01f,7.113057742e-03f,
-9.873392775e-01f,-1.586226688e-01f,-4.846393970e-01f,-8.747140418e-01f,9.214623472e-01f,3.884676855e-01f,5.337561004e-01f,8.456384720e-01f,-5.748240246e-01f,-8.182770562e-01f,-6.704410942e-01f,7.419627614e-01f,2.708370782e-01f,9.626252007e-01f,7.457779040e-01f,6.661946547e-01f,9.171208242e-01f,3.986093247e-01f,9.735385875e-01f,2.285226875e-01f,9.916067680e-01f,1.292904390e-01f,9.973432826e-01f,7.284488142e-02f,9.991596177e-01f,4.098851526e-02f,9.997342224e-01f,2.305395040e-02f,9.999159512e-01f,1.296497506e-02f,9.999734212e-01f,7.290880793e-03f,
-3.999853150e-01f,-9.165215479e-01f,5.636094028e-02f,-9.984104589e-01f,7.549653475e-01f,6.557646866e-01f,3.757521519e-01f,9.267201953e-01f,-4.902605720e-01f,-8.715759127e-01f,-7.110829506e-01f,7.031081264e-01f,2.402658714e-01f,9.707071191e-01f,7.338138022e-01f,6.793506485e-01f,9.130889457e-01f,4.077604411e-01f,9.722381233e-01f,2.339936570e-01f,9.911929581e-01f,1.324255253e-01f,9.972121675e-01f,7.461831571e-02f,9.991181295e-01f,4.198765625e-02f,9.997211001e-01f,2.361613915e-02f,9.999118013e-01f,1.328117562e-02f,9.999721088e-01f,7.468704080e-03f,
5.551133015e-01f,-8.317747426e-01f,5.800031129e-01f,-8.146142578e-01f,5.135984179e-01f,8.580306901e-01f,2.058971709e-01f,9.785736329e-01f,-4.007989973e-01f,-9.161660132e-01f,-7.494767587e-01f,6.620306550e-01f,2.094544189e-01f,9.778184118e-01f,7.216176540e-01f,6.922918182e-01f,9.089657591e-01f,4.168707818e-01f,9.709069144e-01f,2.394572270e-01f,9.907692363e-01f,1.355592873e-01f,9.970778984e-01f,7.639152146e-02f,9.990756424e-01f,4.298675152e-02f,9.997076617e-01f,2.417832043e-02f,9.999075514e-01f,1.359737484e-02f,9.999707649e-01f,7.646527131e-03f,
9.998433086e-01f,1.770192511e-02f,9.250146691e-01f,-3.799313911e-01f,2.212981743e-01f,9.752061926e-01f,2.954782069e-02f,9.995633678e-01f,-3.073327792e-01f,-9.516021032e-01f,-7.855011387e-01f,6.188602113e-01f,1.784335295e-01f,9.839519681e-01f,7.091933579e-01f,7.050140291e-01f,9.047516642e-01f,4.259394629e-01f,9.695450064e-01f,2.449132102e-01f,9.903356068e-01f,1.386916938e-01f,9.969404762e-01f,7.816448565e-02f,9.990321560e-01f,4.398580752e-02f,9.996939072e-01f,2.474049220e-02f,9.999032016e-01f,1.391357271e-02f,9.999693893e-01f,7.824349474e-03f,
5.253219888e-01f,8.509035245e-01f,9.851382016e-01f,1.717635693e-01f,-9.294810554e-02f,9.956709545e-01f,-1.477329862e-01f,9.890272821e-01f,-2.107957994e-01f,-9.775301177e-01f,-8.190422014e-01f,5.737332763e-01f,1.472342216e-01f,9.891016550e-01f,6.965447594e-01f,7.175133435e-01f,9.004471075e-01f,4.349655234e-01f,9.681524315e-01f,2.503614776e-01f,9.898920739e-01f,1.418227133e-01f,9.967999021e-01f,7.993719522e-02f,9.989876708e-01f,4.498481582e-02f,9.996798365e-01f,2.530265802e-02f,9.998987517e-01f,1.422976918e-02f,9.999679821e-01f,8.002171569e-03f,
-4.321779449e-01f,9.017883476e-01f,7.418580135e-01f,6.705569982e-01f,-3.979767653e-01f,9.173954950e-01f,-3.203543695e-01f,9.472977768e-01f,-1.121526217e-01f,-9.936909929e-01f,-8.499939088e-01f,5.267925161e-01f,1.158876918e-01f,9.932623233e-01f,6.836758997e-01f,7.297857660e-01f,8.960525071e-01f,4.439480877e-01f,9.667292484e-01f,2.558017989e-01f,9.894386421e-01f,1.449523146e-01f,9.966561752e-01f,8.170965944e-02f,9.989421864e-01f,4.598378286e-02f,9.996654497e-01f,2.586481583e-02f,9.998942019e-01f,1.454596424e-02f,9.999665433e-01f,8.179994343e-03f,
-9.923354692e-01f,1.235731227e-01f,2.700984580e-01f,9.628327077e-01f,-6.635382560e-01f,7.481423547e-01f,-4.828719382e-01f,8.756909793e-01f,-1.238837738e-02f,-9.999232611e-01f,-8.782584087e-01f,4.781863313e-01f,8.442528403e-02f,9.964298126e-01f,6.705908480e-01f,7.418274156e-01f,8.915682887e-01f,4.528862843e-01f,9.652754871e-01f,2.612340599e-01f,9.889753181e-01f,1.480804517e-01f,9.965092972e-01f,8.348185785e-02f,9.988957032e-01f,4.698270019e-02f,9.996507468e-01f,2.642696360e-02f,9.998895520e-01f,1.486215783e-02f,9.999650728e-01f,8.357815927e-03f,
-6.401443395e-01f,-7.682546613e-01f,-2.848466063e-01f,9.585731119e-01f,-8.632964878e-01f,5.046971113e-01f,-6.301599705e-01f,7.764653318e-01f,8.749917344e-02f,-9.961645921e-01f,-9.037463447e-01f,4.280683876e-01f,5.287845807e-02f,9.986009557e-01f,6.572937422e-01f,7.536344847e-01f,8.869949277e-01f,4.617791660e-01f,9.637912089e-01f,2.666580313e-01f,9.885021022e-01f,1.512071226e-01f,9.963592674e-01f,8.525379969e-02f,9.988482211e-01f,4.798157054e-02f,9.996357278e-01f,2.698910488e-02f,9.998848022e-01f,1.517834901e-02f,9.999635708e-01f,8.535637247e-03f,
3.005925437e-01f,-9.537526528e-01f,-7.520639951e-01f,6.590900905e-01f,-9.774427254e-01f,2.112006594e-01f,-7.575730765e-01f,6.527503610e-01f,1.865124631e-01f,-9.824525948e-01f,-9.263771379e-01f,3.765971301e-01f,2.127875808e-02f,9.997735816e-01f,6.437888326e-01f,7.652032012e-01f,8.823328681e-01f,4.706258703e-01f,9.622764532e-01f,2.720735702e-01f,9.880190013e-01f,1.543322815e-01f,9.962060867e-01f,8.702547193e-02f,9.987997401e-01f,4.898039663e-02f,9.996203926e-01f,2.755123762e-02f,9.998799524e-01f,1.549453961e-02f,9.999620371e-01f,8.713459228e-03f,
9.649660285e-01f,-2.623748537e-01f,-9.876590838e-01f,1.566190737e-01f,-9.946564265e-01f,-1.032404628e-01f,-8.610927113e-01f,5.084479743e-01f,2.836621855e-01f,-9.589242747e-01f,-9.460792425e-01f,3.239352821e-01f,-1.034221888e-02f,9.999465178e-01f,6.300802992e-01f,7.765299843e-01f,8.775825619e-01f,4.794255386e-01f,9.607312596e-01f,2.774805341e-01f,9.875260201e-01f,1.574558971e-01f,9.960497565e-01f,8.879686156e-02f,9.987502604e-01f,4.997917001e-02f,9.996047414e-01f,2.811335979e-02f,9.998750026e-01f,1.581072865e-02f,9.999604718e-01f,8.891280002e-03f,
7.421541968e-01f,6.702291758e-01f,-9.190735378e-01f,-3.940860720e-01f,-9.132301279e-01f,-4.074441477e-01f,-9.374542500e-01f,3.481085020e-01f,3.779776544e-01f,-9.258147184e-01f,-9.627903713e-01f,2.702493312e-01f,-4.195285448e-02f,9.991195914e-01f,6.161725219e-01f,7.876112133e-01f,8.727445123e-01f,4.881772386e-01f,9.591556934e-01f,2.828786946e-01f,9.870231637e-01f,1.605779382e-01f,9.958902758e-01f,9.056797780e-02f,9.986997817e-01f,5.097789714e-02f,9.995887740e-01f,2.867547492e-02f,9.998699528e-01f,1.612691704e-02f,9.999588749e-01f,9.069100495e-03f,
-1.629907808e-01f,9.866275920e-01f,-5.674300293e-01f,-8.234216185e-01f,-7.412399645e-01f,-6.712401321e-01f,-9.842484715e-01f,1.767906850e-01f,4.685169241e-01f,-8.834545217e-01f,-9.764576931e-01f,2.157090023e-01f,-7.352154075e-02f,9.972936293e-01f,6.020698986e-01f,7.984433839e-01f,8.678191892e-01f,4.968801213e-01f,9.575497876e-01f,2.882679384e-01f,9.865104371e-01f,1.636983734e-01f,9.957276465e-01f,9.233880022e-02f,9.986483046e-01f,5.197656957e-02f,9.995724905e-01f,2.923758099e-02f,9.998648031e-01f,1.644310196e-02f,9.999572463e-01f,9.246920701e-03f,
-9.182827862e-01f,3.959251502e-01f,-4.102818995e-02f,-9.991579893e-01f,-4.957418213e-01f,-8.684699457e-01f,-9.999999947e-01f,-1.030206758e-04f,5.543744949e-01f,-8.322673365e-01f,-9.870379993e-01f,1.604867217e-01f,-1.050167117e-01f,9.944704572e-01f,5.877769370e-01f,8.090230357e-01f,8.628070850e-01f,5.055333165e-01f,9.559136100e-01f,2.936480378e-01f,9.859878454e-01f,1.668171717e-01f,9.955618677e-01f,9.410933806e-02f,9.985958286e-01f,5.297519375e-02f,9.995558910e-01f,2.979967596e-02f,9.998595533e-01f,1.675928710e-02f,9.999555861e-01f,9.424741546e-03f,
-8.293098329e-01f,-5.587890489e-01f,4.980096003e-01f,-8.671715159e-01f,-2.010796199e-01f,-9.795749009e-01f,-9.842120244e-01f,-1.769934771e-01f,6.346929496e-01f,-7.727644270e-01f,-9.944978661e-01f,1.047568344e-01f,-1.364068747e-01f,9.906528981e-01f,5.732980611e-01f,8.193468943e-01f,8.577087010e-01f,5.141359589e-01f,9.542471952e-01f,2.990188798e-01f,9.854553963e-01f,1.699342871e-01f,9.953929407e-01f,9.587957830e-02f,9.985423542e-01f,5.397376122e-02f,9.995389754e-01f,3.036176336e-02f,9.998542036e-01f,1.707546870e-02f,9.999538943e-01f,9.602561162e-03f,
2.212675626e-02f,-9.997551734e-01f,8.836693140e-01f,-4.681116785e-01f,1.135217773e-01f,-9.935355082e-01f,-9.373825054e-01f,-3.483016489e-01f,7.086697743e-01f,-7.055403256e-01f,-9.988136461e-01f,4.869599955e-02f,-1.676606422e-01f,9.858447692e-01f,5.586378969e-01f,8.294116591e-01f,8.525245158e-01f,5.226872391e-01f,9.525506134e-01f,3.043802375e-01f,9.849130902e-01f,1.730497178e-01f,9.952208667e-01f,9.764950793e-02f,9.984878810e-01f,5.497227845e-02f,9.995217437e-01f,3.092384116e-02f,9.998487538e-01f,1.739165045e-02f,9.999521709e-01f,9.780380474e-03f,
8.532201077e-01f,-5.215510021e-01f,9.971746360e-01f,7.511820869e-02f,4.168670742e-01f,-9.089674595e-01f,-8.609884168e-01f,-5.086245631e-01f,7.755658183e-01f,-6.312667118e-01f,-9.999717335e-01f,-7.518784889e-03f,-1.987468801e-01f,9.800508546e-01f,5.438010803e-01f,8.392141473e-01f,8.472551097e-01f,5.311861999e-01f,9.508239095e-01f,3.097319700e-01f,9.843609349e-01f,1.761634181e-01f,9.950456449e-01f,9.941913618e-02f,9.984324096e-01f,5.597073698e-02f,9.995041959e-01f,3.148590732e-02f,9.998432041e-01f,1.770782860e-02f,9.999504159e-01f,9.958200408e-03f,
8.998668270e-01f,4.361647552e-01f,8.035690866e-01f,5.952114944e-01f,6.788702112e-01f,-7.342582900e-01f,-7.574391895e-01f,-6.529057162e-01f,8.347129424e-01f,-5.506853038e-01f,-9.979684672e-01f,-6.370979912e-02f,-2.296342702e-01f,9.732769914e-01f,5.287923029e-01f,8.487512594e-01f,8.419009790e-01f,5.396320427e-01f,9.490671287e-01f,3.150739362e-01f,9.837989360e-01f,1.792753567e-01f,9.948672764e-01f,1.011884500e-01f,9.983759396e-01f,5.696914326e-02f,9.994863320e-01f,3.204796724e-02f,9.998375544e-01f,1.802400685e-02f,9.999486292e-01f,1.013601910e-02f,
1.191801354e-01f,9.928726481e-01f,3.624766664e-01f,9.319928467e-01f,8.735505105e-01f,-4.867335058e-01f,-6.300007138e-01f,-7.765945536e-01f,8.855196056e-01f,-4.646020105e-01f,-9.928101803e-01f,-1.196993984e-01f,-2.602920453e-01f,9.655299328e-01f,5.136163109e-01f,8.580199795e-01f,8.364626591e-01f,5.480239228e-01f,9.472803452e-01f,3.204059106e-01f,9.832270991e-01f,1.823855026e-01f,9.946857626e-01f,1.029574365e-01f,9.983184713e-01f,5.796748886e-02f,9.994681521e-01f,3.261001331e-02f,9.998318047e-01f,1.834018143e-02f,9.999468110e-01f,1.031383746e-02f,
-7.710802230e-01f,6.367380071e-01f,-1.902490958e-01f,9.817358512e-01f,9.816020978e-01f,-1.909380047e-01f,-4.826923346e-01f,-8.757899920e-01f,9.274784664e-01f,-3.738765764e-01f,-9.845131804e-01f,-1.753105749e-01f,-2.906895502e-01f,9.568174253e-01f,4.982779032e-01f,8.670173765e-01f,8.309406937e-01f,5.563610011e-01f,9.454635966e-01f,3.257277812e-01f,9.826454300e-01f,1.854938246e-01f,9.945011026e-01f,1.047261048e-01f,9.982600046e-01f,5.896578020e-02f,9.994496561e-01f,3.317204907e-02f,9.998259550e-01f,1.865635603e-02f,9.999449611e-01f,1.049165644e-02f,
-9.524129804e-01f,-3.048106211e-01f,-6.843819158e-01f,7.291237161e-01f,9.923083195e-01f,1.237909494e-01f,-3.201591802e-01f,-9.473637630e-01f,9.601702867e-01f,-2.794154982e-01f,-9.731036980e-01f,-2.303675170e-01f,-3.207963899e-01f,9.471481807e-01f,4.827820346e-01f,8.757405478e-01f,8.253356351e-01f,5.646424439e-01f,9.436169596e-01f,3.310393232e-01f,9.820539344e-01f,1.886002917e-01f,9.943132976e-01f,1.064944419e-01f,9.982005398e-01f,5.996400886e-02f,9.994308440e-01f,3.373407806e-02f,9.998200054e-01f,1.897252691e-02f,9.999430795e-01f,1.066947415e-02f,
-2.581016359e-01f,-9.661177700e-01f,-9.677396624e-01f,2.519522691e-01f,9.046075662e-01f,4.262454119e-01f,-1.475292025e-01f,-9.890577002e-01f,9.832684211e-01f,-1.821625980e-01f,-9.586178037e-01f,-2.846961652e-01f,-3.505824602e-01f,9.365318674e-01f,4.671333972e-01f,8.841868520e-01f,8.196480097e-01f,5.728674718e-01f,9.417404730e-01f,3.363404250e-01f,9.814526211e-01f,1.917048581e-01f,9.941223492e-01f,1.082624348e-01f,9.981400766e-01f,6.096218127e-02f,9.994117160e-01f,3.429609266e-02f,9.998139558e-01f,1.928869776e-02f,9.999411664e-01f,1.084729152e-02f,
6.735071623e-01f,-7.391806966e-01f,-9.530500361e-01f,-3.028128610e-01f,7.271980777e-01f,6.864276770e-01f,2.975377145e-02f,-9.995572585e-01f,9.965421208e-01f,-8.308911770e-02f,-9.411012936e-01f,-3.381247627e-01f,-3.800179774e-01f,9.249791008e-01f,4.513370430e-01f,8.923535586e-01f,8.138784539e-01f,5.810351644e-01f,9.398342161e-01f,3.416308626e-01f,9.808414904e-01f,1.948075221e-01f,9.939282563e-01f,1.100300928e-01f,9.980786154e-01f,6.196028901e-02f,9.993922719e-01f,3.485809641e-02f,9.998078062e-01f,1.960486481e-02f,9.999392216e-01f,1.102510855e-02f,
9.858965816e-01f,1.673557003e-01f,-6.448370157e-01f,-7.643201052e-01f,4.776714527e-01f,8.785385497e-01f,2.060983265e-01f,-9.785312871e-01f,9.998586332e-01f,1.681409119e-02f,-9.206095453e-01f,-3.904843980e-01f,-4.090735085e-01f,9.125014327e-01f,4.353979670e-01f,9.002380853e-01f,8.080275111e-01f,5.891447541e-01f,9.378982288e-01f,3.469105251e-01f,9.802205514e-01f,1.979082381e-01f,9.937310211e-01f,1.117973955e-01f,9.980161562e-01f,6.295833478e-02f,9.993725116e-01f,3.542009286e-02f,9.998015566e-01f,1.992103176e-02f,9.999372453e-01f,1.120292616e-02f
};

#define XB_TMO      128
#define XB_XCNT(j)  (256  + 64 * (j))
#define XB_XSUB(j)  (1280 + 64 * (j))
#define XB_XGEN(j)  (2304 + 64 * (j))
#define XB_TOP      3328
#define XB_TOPGEN   3392
#define XCD_BAR_WORDS 3456
#define XB_SPIN_CAP (1u << 18)

__device__ __forceinline__ unsigned xb_ld(unsigned* p)              { return __hip_atomic_load(p, __ATOMIC_RELAXED, __HIP_MEMORY_SCOPE_AGENT); }
__device__ __forceinline__ unsigned xb_add(unsigned* p, unsigned v) { return __hip_atomic_fetch_add(p, v, __ATOMIC_RELAXED, __HIP_MEMORY_SCOPE_AGENT); }
__device__ __forceinline__ unsigned xb_xcc_id() { return (unsigned)__builtin_amdgcn_s_getreg((3 << 11) | 20) & 0xFu; }
#define XB_SPIN(cond, bar) do { unsigned _sp = 0; while (cond) { __builtin_amdgcn_s_sleep(1); \
    if ((++_sp & 255u) == 0u) { if (xb_ld(&(bar)[XB_TMO])) break; if (_sp > XB_SPIN_CAP) { atomicAdd(&(bar)[XB_TMO], 1u); break; } } } } while (0)

struct XcdBarrier {
    unsigned* bar; unsigned x;
    volatile LAS unsigned* st;
};

__device__ __forceinline__ XcdBarrier xcd_barrier_post(unsigned* bar, volatile LAS unsigned* st) {
    XcdBarrier b; b.bar = bar; b.x = xb_xcc_id(); b.st = st;
    if (threadIdx.x == 0) (void)xb_add(&bar[XB_XCNT(b.x)], 1u);
    return b;
}
__device__ __forceinline__ void xcd_barrier_complete(unsigned* bar, unsigned x, unsigned& nloc, unsigned& nx) {
    const unsigned G = gridDim.x * gridDim.y * gridDim.z;
    unsigned sum, cnt, mine, sp = 0u;
    for (;;) {
        sum = 0u; cnt = 0u; mine = 0u;
#pragma unroll
        for (unsigned j = 0; j < 16; ++j) { const unsigned c = xb_ld(&bar[XB_XCNT(j)]); sum += c; cnt += (c > 0u) ? 1u : 0u; mine = (j == x) ? c : mine; }
        if (sum == G) break;
        __builtin_amdgcn_s_sleep(1);
        if ((++sp & 255u) == 0u) { if (xb_ld(&bar[XB_TMO])) break; if (sp > XB_SPIN_CAP) { atomicAdd(&bar[XB_TMO], 1u); break; } }
    }
    nloc = mine > 0u ? mine : 1u; nx = cnt > 0u ? cnt : 1u;
}

__device__ __forceinline__ void xcd_barrier(const XcdBarrier& b) {
    asm volatile("s_waitcnt vmcnt(0)" ::: "memory");
    __syncthreads();
    if (threadIdx.x == 0) {
        unsigned* bar = b.bar;
        __builtin_amdgcn_s_waitcnt(0);
        unsigned nloc = b.st[0], nx = b.st[1];
        if (nloc == 0u) { xcd_barrier_complete(bar, b.x, nloc, nx); b.st[0] = nloc; b.st[1] = nx; }
        const unsigned old = xb_add(&bar[XB_XSUB(b.x)], 1u);
        const unsigned gen = old / nloc;
        if (old + 1u == (gen + 1u) * nloc) {
            __builtin_amdgcn_fence(__ATOMIC_RELEASE, "agent");
            asm volatile("s_waitcnt vmcnt(0)" ::: "memory");
            const unsigned og = xb_add(&bar[XB_TOP], 1u);
            const unsigned tg = og / nx;
            if (og + 1u == (tg + 1u) * nx) xb_add(&bar[XB_TOPGEN], 1u);
            else XB_SPIN(xb_ld(&bar[XB_TOPGEN]) == tg, bar);
            __builtin_amdgcn_fence(__ATOMIC_ACQUIRE, "agent");
            xb_add(&bar[XB_XGEN(b.x)], 1u);
            asm volatile("s_waitcnt vmcnt(0)" ::: "memory");
        } else {
            XB_SPIN(xb_ld(&bar[XB_XGEN(b.x)]) == gen, bar);
            __builtin_amdgcn_fence(__ATOMIC_ACQUIRE, "agent");
            asm volatile("s_waitcnt vmcnt(0)" ::: "memory");
        }
    }
    __syncthreads();
}

typedef __bf16 bf16x2_t __attribute__((ext_vector_type(2)));
DEVI unsigned pk_bf16(float lo, float hi) {
    f32x2 f = {lo, hi}; bf16x2_t v = __builtin_convertvector(f, bf16x2_t); unsigned r; __builtin_memcpy(&r, &v, 4); return r; }
DEVI float bf_lo(unsigned w) { return __uint_as_float(w << 16); }
DEVI float bf_hi(unsigned w) { return __uint_as_float(w & 0xffff0000u); }
DEVI bf16x8 lds_ld128(lds_t* p) { return *(LAS bf16x8*)p; }
DEVI void lds_st128(lds_t* p, u32x4 v) { *(LAS u32x4*)p = v; }
DEVI float wave_sum(float v) {
#pragma unroll
    for (int o = 32; o >= 1; o >>= 1) v += __shfl_xor(v, o);
    return v;
}
DEVI float fexp2(float x) { return __builtin_amdgcn_exp2f(x); }
DEVI float frcp(float x) { return __builtin_amdgcn_rcpf(x); }
DEVI float silu_f(float x) { return x * frcp(1.0f + fexp2(-LOG2E * x)); }
DEVI float gelu_tanh_f(float x) {
    const float y = 0.7978845608028654f * (x + 0.044715f * x * x * x);
    const float e = fexp2((2.0f * LOG2E) * y);
    const float t = 1.0f - 2.0f * frcp(e + 1.0f);
    return 0.5f * x * (1.0f + t);
}
DEVI int cond_of_row(int row) { return row < NPR ? 0 : 1 + ((row - NPR) >> 10); }

struct Params {
    const float *x_prompt, *x_sample, *cache_ckv, *cache_kpe, *cache_k, *cache_v, *c, *c_ctx, *mod_w, *mod_b, *ln_gain, *ln_bias,
        *mla_w_in, *mla_q_gain, *mla_kv_gain, *mla_w_q_up, *mla_w_kv_up, *mla_w_out,
        *gm_w_in, *gm_v_gain, *gm_w_s, *gm_b_s, *gm_w_out, *swa_w_qkv, *swa_sink, *swa_w_out,
        *moe_router, *moe_w_gate, *moe_w_up, *moe_w_down;
    float* out;
    unsigned* bar;
    float *mod, *X0, *X1, *T, *Z, *GST, *AFF, *GATEV;
    bf16_t *H, *H2, *CQ, *CKV, *KPE, *Q, *KN, *VTP, *VTS, *O, *U, *GVT, *TT, *SK, *SVTP, *SVTS, *HID, *YE;
    bf16_t *WTI, *WTQ, *WTKV, *WTO, *WTGI, *WTGO, *WTSQ, *WTSO;
    int *SEL, *IDX;
    long long ph_lo, ph_hi;
};
constexpr size_t OUT_Y = 0;
constexpr size_t OUT_CKV = 8388608;
constexpr size_t OUT_KPE = OUT_CKV + 2097152;
constexpr size_t OUT_SK = OUT_KPE + 524288;
constexpr size_t OUT_SV = OUT_SK + 1048576;

DEVI const float* modp(const Params& p, int layer, int cnd, int which) { return p.mod + ((size_t)(layer * 5 + cnd) * 6 + which) * 1024; }

DEVI int swz(int row) { return ((row >> 1) & 7) ^ ((row >> 4) & 1); }
DEVI int img_off(int row, int chunk) { return row * 128 + ((chunk ^ swz(row)) << 4); }

template <int BM> struct XDma {
    static constexpr int NI = BM / 64;
    const bf16_t* base; unsigned off[NI];
    template <class RowFn> DEVI void init(const RowFn& rowfn, int tid) {
        const int w = tid >> 6, i = tid & 63;
        base = rowfn.base;
#pragma unroll
        for (int j = 0; j < NI; ++j) { const int row = 64 * j + 8 * w + (i >> 3); off[j] = rowfn.offset(row) + (((i & 7) ^ swz(row)) << 3); }
    }
    DEVI void issue(int kt, lds_t* img, int tid) const {
        lds_t* dst = img + (tid >> 6) * 1024 + (tid & 63) * 16;
#pragma unroll
        for (int j = 0; j < NI; ++j) __builtin_amdgcn_global_load_lds((const unsigned*)(base + off[j] + kt * 64), (LAS unsigned*)(dst + j * 8192), 16, 0, 0);
    }
};

struct WRegs {
    f32x4 r[8];
    DEVI void load(const float* p, size_t ldw, int kt) {
        const float* q = p + (size_t)kt * 64 * ldw;
#pragma unroll
        for (int i = 0; i < 8; ++i) r[i] = *(const f32x4*)(q + (size_t)i * ldw);
    }
    DEVI void store(lds_t* img, int wave, int lane) const {
#pragma unroll
        for (int c = 0; c < 4; ++c) {
            u32x4 v;
            v.x = pk_bf16(r[0][c], r[1][c]); v.y = pk_bf16(r[2][c], r[3][c]); v.z = pk_bf16(r[4][c], r[5][c]); v.w = pk_bf16(r[6][c], r[7][c]);
            lds_st128(img + img_off(4 * lane + c, wave), v);
        }
    }
};

template <int BM, bool TRANS>
DEVI void gemm_compute(lds_t* ximg, lds_t* wimg, f32x4 (&acc)[BM / 32][4], int wr, int wc, int lane) {
    constexpr int TM = BM / 32, NH = TM / 4, NSTEP = 2 * NH;
    const int r16 = lane & 15, g = lane >> 4;
    const int c0 = g ^ ((r16 >> 1) & 7);
    lds_t* xb = ximg + (wr * (BM / 2) + r16) * 128;
    lds_t* wb = wimg + (wc * 64 + r16) * 128;
    bf16x8 wf[2][4], xf[2][4];
#define LD_W(buf, s_) do { const int o0_ = ((c0 ^ (4 * (s_))) << 4), o1_ = ((c0 ^ (4 * (s_)) ^ 1) << 4); \
        _Pragma("unroll") for (int nb = 0; nb < 4; ++nb) wf[buf][nb] = lds_ld128(wb + nb * 2048 + ((nb & 1) ? o1_ : o0_)); } while (0)
#define LD_X(buf, s_, h_) do { const int o0_ = ((c0 ^ (4 * (s_))) << 4), o1_ = ((c0 ^ (4 * (s_)) ^ 1) << 4); \
        _Pragma("unroll") for (int m4 = 0; m4 < 4; ++m4) { const int mb_ = 4 * (h_) + m4; xf[buf][m4] = lds_ld128(xb + mb_ * 2048 + ((mb_ & 1) ? o1_ : o0_)); } } while (0)
    LD_W(0, 0); LD_X(0, 0, 0);
#pragma unroll
    for (int st = 0; st < NSTEP; ++st) {
        const int s = st / NH, h = st % NH;
        if (st + 1 < NSTEP) {
            const int s1 = (st + 1) / NH, h1 = (st + 1) % NH;
            if (s1 != s) LD_W(s1 & 1, s1);
            LD_X((st + 1) & 1, s1, h1);
        }
#pragma unroll
        for (int m4 = 0; m4 < 4; ++m4)
#pragma unroll
            for (int nb = 0; nb < 4; ++nb) {
                const int mb = 4 * h + m4;
                acc[mb][nb] = TRANS ? __builtin_amdgcn_mfma_f32_16x16x32_bf16(wf[s & 1][nb], xf[st & 1][m4], acc[mb][nb], 0, 0, 0)
                                    : __builtin_amdgcn_mfma_f32_16x16x32_bf16(xf[st & 1][m4], wf[s & 1][nb], acc[mb][nb], 0, 0, 0);
            }
        __builtin_amdgcn_sched_barrier(0);
    }
#undef LD_W
#undef LD_X
}

struct WLin { const float* base; DEVI const float* operator()(int lane) const { return base + 4 * lane; } };
template <int BM> struct GemmPipe {
    static constexpr int TM = BM / 32, STAGE = (BM + 256) * 128, NI = BM / 64;
    XDma<BM> xd; const float* wp; unsigned ldw; WRegs wr_; int par;
    template <class RowFn, class WFn> DEVI void prime(lds_t* lds, const RowFn& rf, const WFn& wf, unsigned ldw_, int tid_in) {
        const int tid = tid_in;
        const int lane = tid & 63, wave = tid >> 6;
        xd.init(rf, tid); ldw = ldw_; wp = wf(lane) + (size_t)(8 * wave) * ldw_; par = 0;
        wr_.load(wp, ldw, 0);
        __syncthreads();
        xd.issue(0, lds, tid); wr_.store(lds + BM * 128, wave, lane);
        wr_.load(wp, ldw, 1);
    }
    template <bool TRANS, bool XUNIT = true, class Epi, class RowFnN, class WFnN>
    DEVI void run(lds_t* lds, int nk, const Epi& epi, bool has_next_in, const RowFnN& rfn, const WFnN& wfn, unsigned ldw_n, int tid_in) {
        int tid = tid_in; asm volatile("" : "+v"(tid));
        const int lane = tid & 63, wave = tid >> 6, wrow = wave >> 2, wcol = wave & 3;
        const bool has_next = XUNIT && has_next_in;
        f32x4 acc[TM][4];
#pragma unroll
        for (int i = 0; i < TM; ++i)
#pragma unroll
            for (int j = 0; j < 4; ++j) acc[i][j] = (f32x4){0.f, 0.f, 0.f, 0.f};
        unsigned offn[NI];
        if (XUNIT) {
#pragma unroll
            for (int j = 0; j < NI; ++j) offn[j] = 0u;
        }
        for (int t = 0; t < nk; ++t) {
            asm volatile("s_waitcnt vmcnt(0)" ::: "memory");
            __syncthreads();
            lds_t* cur = lds + ((par + t) & 1) * STAGE;
            lds_t* nxt = lds + ((par + t + 1) & 1) * STAGE;
            if (t + 2 < nk) {
                xd.issue(t + 1, nxt, tid); wr_.store(nxt + BM * 128, wave, lane); wr_.load(wp, ldw, t + 2);
            } else if (t + 1 < nk) {
                xd.issue(t + 1, nxt, tid); wr_.store(nxt + BM * 128, wave, lane);
                if (has_next) {
                    ldw = ldw_n; wp = wfn(lane) + (size_t)(8 * wave) * ldw_n; wr_.load(wp, ldw, 0);
#pragma unroll
                    for (int j = 0; j < NI; ++j) { const int row = 64 * j + 8 * wave + (lane >> 3); offn[j] = rfn.offset(row) + (((lane & 7) ^ swz(row)) << 3); }
                }
            } else if (has_next) {
                xd.base = rfn.base;
#pragma unroll
                for (int j = 0; j < NI; ++j) xd.off[j] = offn[j];
                xd.issue(0, nxt, tid); wr_.store(nxt + BM * 128, wave, lane); wr_.load(wp, ldw, 1);
            }
            gemm_compute<BM, TRANS>(cur, cur + BM * 128, acc, wrow, wcol, lane);
        }
        par = (par + nk) & 1;
        { int t2 = tid; asm volatile("" : "+v"(t2));
          const int w2 = t2 >> 6; epi(acc, w2 >> 2, w2 & 3, t2 & 63); }
    }
};

template <int BM, bool TRANS, class RowFn, class WFn, class Epi>
DEVI void gemm_unit(lds_t* lds, const RowFn& rowfn, const WFn& wfn, unsigned ldw, int nk, const Epi& epi, int tid_in) {
    int tid = tid_in; asm volatile("" : "+v"(tid));
    constexpr int TM = BM / 32;
    constexpr int STAGE = (BM + 256) * 128;
    const int lane = tid & 63, wave = tid >> 6, wr = wave >> 2, wc = wave & 3;
    XDma<BM> xd; WRegs wl;
    const float* wp = wfn(lane) + (size_t)(8 * wave) * ldw;
    wl.load(wp, ldw, 0);
    xd.init(rowfn, tid);
    f32x4 acc[TM][4];
#pragma unroll
    for (int i = 0; i < TM; ++i)
#pragma unroll
        for (int j = 0; j < 4; ++j) acc[i][j] = (f32x4){0.f, 0.f, 0.f, 0.f};
    __syncthreads();
    xd.issue(0, lds, tid); wl.store(lds + BM * 128, wave, lane);
    if (nk > 1) wl.load(wp, ldw, 1);
    for (int t = 0; t < nk; ++t) {
        asm volatile("s_waitcnt vmcnt(0)" ::: "memory");
        __syncthreads();
        lds_t* cur = lds + (t & 1) * STAGE;
        lds_t* nxt = lds + ((t + 1) & 1) * STAGE;
        if (t + 1 < nk) {
            xd.issue(t + 1, nxt, tid); wl.store(nxt + BM * 128, wave, lane);
            if (t + 2 < nk) wl.load(wp, ldw, t + 2);
        }
        gemm_compute<BM, TRANS>(cur, cur + BM * 128, acc, wr, wc, lane);
    }
    { int t2 = tid; asm volatile("" : "+v"(t2));
      const int w2 = t2 >> 6; epi(acc, w2 >> 2, w2 & 3, t2 & 63); }
}

template <int BM, bool TRANS, class RowFn, class WRowFn, class Epi>
DEVI void gemm_unit_bb(lds_t* lds, const RowFn& rowfn, const WRowFn& wrowfn, int nk, const Epi& epi, int tid_in) {
    int tid = tid_in; asm volatile("" : "+v"(tid));
    constexpr int TM = BM / 32;
    constexpr int STAGE = (BM + 256) * 128;
    const int lane = tid & 63, wave = tid >> 6, wr = wave >> 2, wc = wave & 3;
    XDma<BM> xd; XDma<256> wd;
    xd.init(rowfn, tid); wd.init(wrowfn, tid);
    f32x4 acc[TM][4];
#pragma unroll
    for (int i = 0; i < TM; ++i)
#pragma unroll
        for (int j = 0; j < 4; ++j) acc[i][j] = (f32x4){0.f, 0.f, 0.f, 0.f};
    __syncthreads();
    xd.issue(0, lds, tid); wd.issue(0, lds + BM * 128, tid);
    for (int t = 0; t < nk; ++t) {
        asm volatile("s_waitcnt vmcnt(0)" ::: "memory");
        __syncthreads();
        lds_t* cur = lds + (t & 1) * STAGE;
        lds_t* nxt = lds + ((t + 1) & 1) * STAGE;
        if (t + 1 < nk) { xd.issue(t + 1, nxt, tid); wd.issue(t + 1, nxt + BM * 128, tid); }
        gemm_compute<BM, TRANS>(cur, cur + BM * 128, acc, wr, wc, lane);
    }
    { int t2 = tid; asm volatile("" : "+v"(t2));
      const int w2 = t2 >> 6; epi(acc, w2 >> 2, w2 & 3, t2 & 63); }
}

template <int BM, bool TRANS, class RowFn, class WRowFn, class Epi>
DEVI void gemm_unit_bb3(lds_t* lds, const RowFn& rowfn, const WRowFn& wrowfn, int nk, const Epi& epi, int tid_in) {
    int tid = tid_in; asm volatile("" : "+v"(tid));
    constexpr int TM = BM / 32;
    constexpr int STAGE = (BM + 256) * 128;
    static_assert(BM == 128, "3 stages fit for BM = 128 only; the counted wait below assumes 2 + 4 DMA instructions per tile");
    const int lane = tid & 63, wave = tid >> 6, wr = wave >> 2, wc = wave & 3;
    XDma<BM> xd; XDma<256> wd;
    xd.init(rowfn, tid); wd.init(wrowfn, tid);
    f32x4 acc[TM][4];
#pragma unroll
    for (int i = 0; i < TM; ++i)
#pragma unroll
        for (int j = 0; j < 4; ++j) acc[i][j] = (f32x4){0.f, 0.f, 0.f, 0.f};
    __syncthreads();
    lds_t* s0 = lds; lds_t* s1 = lds + STAGE; lds_t* s2 = lds + 2 * STAGE;
    xd.issue(0, s0, tid); wd.issue(0, s0 + BM * 128, tid);
    if (nk > 1) { xd.issue(1, s1, tid); wd.issue(1, s1 + BM * 128, tid); }
    for (int t = 0; t < nk; ++t) {
        if (t + 1 < nk) asm volatile("s_waitcnt vmcnt(6)" ::: "memory");
        else asm volatile("s_waitcnt vmcnt(0)" ::: "memory");
        asm volatile("s_waitcnt lgkmcnt(0)" ::: "memory");
        __builtin_amdgcn_s_barrier();
        asm volatile("" ::: "memory");
        if (t + 2 < nk) { xd.issue(t + 2, s2, tid); wd.issue(t + 2, s2 + BM * 128, tid); }
        gemm_compute<BM, TRANS>(s0, s0 + BM * 128, acc, wr, wc, lane);
        lds_t* tmp = s0; s0 = s1; s1 = s2; s2 = tmp;
    }
    __syncthreads();
    { int t2 = tid; asm volatile("" : "+v"(t2));
      const int w2 = t2 >> 6; epi(acc, w2 >> 2, w2 & 3, t2 & 63); }
}

DEVI int swz32(int row) { return ((((row >> 2) ^ (row >> 3)) & 1) << 1) | ((row >> 2) & 1); }
template <int BM> struct XDma32 {
    static constexpr int NI = BM / 128;
    const bf16_t* base; unsigned off[NI];
    template <class RowFn> DEVI void init(const RowFn& rowfn, int tid) {
        const int w = tid >> 6, i = tid & 63;
        base = rowfn.base;
#pragma unroll
        for (int j = 0; j < NI; ++j) { const int row = 128 * j + 16 * w + (i >> 2); off[j] = rowfn.offset(row) + (((i & 3) ^ swz32(row)) << 3); }
    }
    DEVI void issue(int kt32, lds_t* img, int tid) const {
        lds_t* dst = img + (tid >> 6) * 1024 + (tid & 63) * 16;
#pragma unroll
        for (int j = 0; j < NI; ++j) __builtin_amdgcn_global_load_lds((const unsigned*)(base + off[j] + kt32 * 32), (LAS unsigned*)(dst + j * 8192), 16, 0, 0);
    }
};
template <int BM, bool TRANS>
DEVI void gemm_compute32(lds_t* ximg, lds_t* wimg, f32x4 (&acc)[BM / 32][4], int wr, int wc, int lane) {
    constexpr int TM = BM / 32;
    const int r16 = lane & 15, g = lane >> 4;
    const int c0 = (g ^ swz32(r16)) << 4;
    lds_t* xb = ximg + (wr * (BM / 2) + r16) * 64 + c0;
    lds_t* wb = wimg + (wc * 64 + r16) * 64 + c0;
    bf16x8 wf[4], xf[TM];
#pragma unroll
    for (int nb = 0; nb < 4; ++nb) wf[nb] = lds_ld128(wb + nb * 1024);
#pragma unroll
    for (int mb = 0; mb < TM; ++mb) xf[mb] = lds_ld128(xb + mb * 1024);
#pragma unroll
    for (int mb = 0; mb < TM; ++mb)
#pragma unroll
        for (int nb = 0; nb < 4; ++nb)
            acc[mb][nb] = TRANS ? __builtin_amdgcn_mfma_f32_16x16x32_bf16(wf[nb], xf[mb], acc[mb][nb], 0, 0, 0)
                                : __builtin_amdgcn_mfma_f32_16x16x32_bf16(xf[mb], wf[nb], acc[mb][nb], 0, 0, 0);
}
template <int BM, bool TRANS, class RowFn, class WRowFn, class Epi>
DEVI void gemm_unit_bb4(lds_t* lds, const RowFn& rowfn, const WRowFn& wrowfn, int nk2  , const Epi& epi, int tid_in) {
    int tid = tid_in; asm volatile("" : "+v"(tid));
    constexpr int TM = BM / 32;
    constexpr int XB = BM * 64, STAGE = XB + 256 * 64;
    static_assert(BM == 256, "the counted waits below assume 2 + 2 DMA instructions per sub-tile");
    const int lane = tid & 63, wave = tid >> 6, wr = wave >> 2, wc = wave & 3;
    XDma32<BM> xd; XDma32<256> wd;
    xd.init(rowfn, tid); wd.init(wrowfn, tid);
    f32x4 acc[TM][4];
#pragma unroll
    for (int i = 0; i < TM; ++i)
#pragma unroll
        for (int j = 0; j < 4; ++j) acc[i][j] = (f32x4){0.f, 0.f, 0.f, 0.f};
    __syncthreads();
#pragma unroll
    for (int t = 0; t < 3; ++t) if (t < nk2) { xd.issue(t, lds + t * STAGE, tid); wd.issue(t, lds + t * STAGE + XB, tid); }
    for (int t = 0; t < nk2; ++t) {
        const int rem = nk2 - 1 - t;
        if (rem >= 2) asm volatile("s_waitcnt vmcnt(8)" ::: "memory");
        else if (rem == 1) asm volatile("s_waitcnt vmcnt(4)" ::: "memory");
        else asm volatile("s_waitcnt vmcnt(0)" ::: "memory");
        asm volatile("s_waitcnt lgkmcnt(0)" ::: "memory");
        __builtin_amdgcn_s_barrier();
        asm volatile("" ::: "memory");
        if (t + 3 < nk2) { lds_t* st = lds + ((t + 3) & 3) * STAGE; xd.issue(t + 3, st, tid); wd.issue(t + 3, st + XB, tid); }
        lds_t* cur = lds + (t & 3) * STAGE;
        gemm_compute32<BM, TRANS>(cur, cur + XB, acc, wr, wc, lane);
    }
    __syncthreads();
    { int t2 = tid; asm volatile("" : "+v"(t2));
      const int w2 = t2 >> 6; epi(acc, w2 >> 2, w2 & 3, t2 & 63); }
}

DEVI void phase_modulation(const Params& p, lds_t* lds, int bid, int nblk, int tid) {
    LAS float* sc = (LAS float*)lds;
    LAS float* red = (LAS float*)(lds + 20480);
    __syncthreads();
    for (int i = tid; i < 5 * 1024; i += NTHREADS) {
        const int cnd = i >> 10, k = i & 1023;
        const float v = cnd == 0 ? p.c_ctx[k] : p.c[(cnd - 1) * 1024 + k];
        sc[i] = silu_f(v);
    }
    __syncthreads();
    const int cg = tid & 31, kg = tid >> 5;
    for (int u = bid; u < DEPTH * 48; u += nblk) {
        const int l = u / 48, n0 = (u % 48) * 128;
        const float* w = p.mod_w + (size_t)l * 1024 * 6144 + n0 + 4 * cg;
        f32x4 a[5];
#pragma unroll
        for (int c = 0; c < 5; ++c) a[c] = (f32x4){0.f, 0.f, 0.f, 0.f};
#pragma unroll 8
        for (int kk = 0; kk < 64; ++kk) {
            const int k = kg * 64 + kk;
            const f32x4 wv = *(const f32x4*)(w + (size_t)k * 6144);
#pragma unroll
            for (int c = 0; c < 5; ++c) a[c] += wv * sc[c * 1024 + k];
        }
#pragma unroll
        for (int c = 0; c < 5; ++c) *(LAS f32x4*)(red + (kg * 5 + c) * 128 + 4 * cg) = a[c];
        __syncthreads();
        for (int i = tid; i < 5 * 128; i += NTHREADS) {
            const int c = i >> 7, n = i & 127;
            float s = 0.f;
#pragma unroll
            for (int q = 0; q < 16; ++q) s += red[(q * 5 + c) * 128 + n];
            p.mod[(size_t)(l * 5 + c) * 6144 + n0 + n] = s + p.mod_b[l * 6144 + n0 + n];
        }
        __syncthreads();
    }
}


DEVI void wconv_tile(const float* W, bf16_t* Wt, int K, int N, int tk, int tn, lds_t* lds, int tid) {
    LAS bf16_t* s = (LAS bf16_t*)lds;
    __syncthreads();
#pragma unroll
    for (int i = 0; i < 2; ++i) {
        const int c = tid + NTHREADS * i, k = c >> 4, n4 = (c & 15) * 4;
        const f32x4 v = *(const f32x4*)(W + (size_t)(tk * 64 + k) * N + tn * 64 + n4);
#pragma unroll
        for (int q = 0; q < 4; ++q) s[(n4 + q) * 72 + k] = (bf16_t)(pk_bf16(v[q], 0.f) & 0xffffu);
    }
    __syncthreads();
    { const int n = tid >> 3, kc = tid & 7;
      const u32x4 v = *(LAS u32x4*)(s + n * 72 + kc * 8);
      *(u32x4*)(Wt + (size_t)(tn * 64 + n) * K + tk * 64 + kc * 8) = v; }
}
DEVI void phase_wconv(const Params& p, lds_t* lds, int bid, int nblk, int tid) {
    for (int it = bid; it < 4352; it += nblk) {
        int r = it; const float* W; bf16_t* Wt; int K, N;
        if (r < 352) { const int j = r / 176; r %= 176; W = p.mla_w_in + (size_t)j * 1024 * 704; Wt = p.WTI + (size_t)j * 704 * 1024; K = 1024; N = 704; }
        else if ((r -= 352) < 288) { const int j = r / 144; r %= 144; W = p.mla_w_q_up + (size_t)j * 384 * 1536; Wt = p.WTQ + (size_t)j * 1536 * 384; K = 384; N = 1536; }
        else if ((r -= 288) < 256) { const int j = r / 128; r %= 128; W = p.mla_w_kv_up + (size_t)j * 256 * 2048; Wt = p.WTKV + (size_t)j * 2048 * 256; K = 256; N = 2048; }
        else if ((r -= 256) < 512) { const int j = r / 256; r %= 256; W = p.mla_w_out + (size_t)j * 1024 * 1024; Wt = p.WTO + (size_t)j * 1024 * 1024; K = 1024; N = 1024; }
        else if ((r -= 512) < 1536) { W = p.gm_w_in; Wt = p.WTGI; K = 1024; N = 6144; }
        else if ((r -= 1536) < 768) { W = p.gm_w_out; Wt = p.WTGO; K = 3072; N = 1024; }
        else if ((r -= 768) < 384) { W = p.swa_w_qkv; Wt = p.WTSQ; K = 1024; N = 1536; }
        else { r -= 384; W = p.swa_w_out; Wt = p.WTSO; K = 1024; N = 1024; }
        const int ntn = N / 64;
        wconv_tile(W, Wt, K, N, r / ntn, r % ntn, lds, tid);
    }
}

DEVI void phase_prep(const Params& p, int bid, int nblk, int tid) {
    const int lane = tid & 63, wave = tid >> 6;
    for (int row = bid * 8 + wave; row < NTOK; row += nblk * 8) {
        const float* src = row < NPR ? p.x_prompt + (size_t)row * D : p.x_sample + (size_t)(row - NPR) * D;
        const int cnd = cond_of_row(row);
        const float* sh = modp(p, 0, cnd, 0); const float* scl = modp(p, 0, cnd, 1);
#pragma unroll
        for (int i = 0; i < 4; ++i) {
            const int col = lane * 4 + 256 * i;
            const f32x4 v = *(const f32x4*)(src + col);
            const f32x4 s = *(const f32x4*)(scl + col), b = *(const f32x4*)(sh + col);
            const f32x4 h = v * (s + 1.0f) + b;
            u32x2 o; o.x = pk_bf16(h[0], h[1]); o.y = pk_bf16(h[2], h[3]);
            *(u32x2*)(p.H + (size_t)row * D + col) = o;
        }
    }
    for (int i = bid * NTHREADS + tid; i < 1024 * 64; i += nblk * NTHREADS) {
        const f32x4 v = *(const f32x4*)(p.cache_k + (size_t)i * 4);
        u32x2 o; o.x = pk_bf16(v[0], v[1]); o.y = pk_bf16(v[2], v[3]);
        *(u32x2*)(p.SK + (size_t)NTOK * 256 + (size_t)i * 4) = o;
    }
    for (int i = bid * NTHREADS + tid; i < 4 * 4 * 64 * 64; i += nblk * NTHREADS) {
        const int kg4 = i & 63, dv = (i >> 6) & 63, kvh = (i >> 12) & 3, b = i >> 14;
        float v[4];
#pragma unroll
        for (int q = 0; q < 4; ++q) v[q] = p.cache_v[((size_t)(b * 256 + kg4 * 4 + q) * 4 + kvh) * 64 + dv];
        u32x2 o; o.x = pk_bf16(v[0], v[1]); o.y = pk_bf16(v[2], v[3]);
        *(u32x2*)(p.SVTS + ((size_t)(b * 4 + kvh) * 64 + dv) * 1280 + kg4 * 4) = o;
    }
}

DEVI void phase_mla_norm(const Params& p, int j, int bid, int nblk, int tid) {
    const int lane = tid & 63, wave = tid >> 6;
    const float* qg = p.mla_q_gain + j * 384; const float* kg = p.mla_kv_gain + j * 256;
    for (int row = bid * 8 + wave; row < NROWS_KV; row += nblk * 8) {
        if (row >= NTOK) {
            const int b = (row - NTOK) >> 8, t = (row - NTOK) & 255;
            const float* ck = p.cache_ckv + ((size_t)(b * 2 + j) * 256 + t) * 256;
            const f32x4 v = *(const f32x4*)(ck + lane * 4);
            u32x2 o; o.x = pk_bf16(v[0], v[1]); o.y = pk_bf16(v[2], v[3]);
            *(u32x2*)(p.CKV + (size_t)row * 256 + lane * 4) = o;
            const float kp = p.cache_kpe[((size_t)(b * 2 + j) * 256 + t) * 64 + lane];
            p.KPE[(size_t)row * 64 + lane] = (bf16_t)(pk_bf16(kp, 0.f) & 0xffffu);
            continue;
        }
        const float* z = p.Z + (size_t)row * 704;
        float q[6]; float ss = 0.f;
#pragma unroll
        for (int i = 0; i < 6; ++i) { q[i] = z[lane + 64 * i]; ss += q[i] * q[i]; }
        ss = wave_sum(ss);
        const float rq = rsqrtf(ss * (1.0f / 384.0f) + EPS_F);
#pragma unroll
        for (int i = 0; i < 6; ++i) p.CQ[(size_t)row * 384 + lane + 64 * i] = (bf16_t)(pk_bf16(q[i] * rq * qg[lane + 64 * i], 0.f) & 0xffffu);
        const f32x4 kv = *(const f32x4*)(z + 384 + lane * 4);
        float s2 = kv[0] * kv[0] + kv[1] * kv[1] + kv[2] * kv[2] + kv[3] * kv[3];
        s2 = wave_sum(s2);
        const float rk = rsqrtf(s2 * (1.0f / 256.0f) + EPS_F);
        const f32x4 gv = *(const f32x4*)(kg + lane * 4);
        const f32x4 kn = kv * rk * gv;
        { u32x2 o; o.x = pk_bf16(kn[0], kn[1]); o.y = pk_bf16(kn[2], kn[3]); *(u32x2*)(p.CKV + (size_t)row * 256 + lane * 4) = o; }
        float kp = z[640 + lane];
        if (row < NPR) {
            const int b = row >> 8, t = row & 255;
            *(f32x4*)(p.out + OUT_CKV + ((size_t)(b * 2 + j) * 256 + t) * 256 + lane * 4) = kn;
            p.out[OUT_KPE + ((size_t)(b * 2 + j) * 256 + t) * 64 + lane] = kp;
        } else {
            const int t = (row - NPR) & 1023;
            const int pos = lane < 32 ? (t >> 6) : (t & 63);
            const float cs = rope_tab[(pos * 16 + (lane & 15)) * 2], sn = rope_tab[(pos * 16 + (lane & 15)) * 2 + 1];
            const float other = __shfl_xor(kp, 16);
            kp = (lane & 16) ? (kp * cs + other * sn) : (kp * cs - other * sn);
        }
        p.KPE[(size_t)row * 64 + lane] = (bf16_t)(pk_bf16(kp, 0.f) & 0xffffu);
    }
}

DEVI void phase_ln_a(const Params& p, int layer, lds_t* lds, int bid, int nblk, int tid) {
    const int lane = tid & 63, wave = tid >> 6;
    LAS float* rt = (LAS float*)lds;
    const float* router = p.moe_router + (size_t)layer * 1024 * 16;
    __syncthreads();
    for (int i = tid; i < 4096; i += NTHREADS) {
        const f32x4 w = *(const f32x4*)(router + i * 4);
        const int k = i >> 2, e0 = (i & 3) * 4;
        rt[(e0 + 0) * 1024 + k] = w[0]; rt[(e0 + 1) * 1024 + k] = w[1]; rt[(e0 + 2) * 1024 + k] = w[2]; rt[(e0 + 3) * 1024 + k] = w[3];
    }
    __syncthreads();
    const float* lg = p.ln_gain + (layer * 2 + 0) * 1024; const float* lb = p.ln_bias + (layer * 2 + 0) * 1024;
    for (int r0 = (bid * 8 + wave) * 4; r0 < NTOK; r0 += nblk * 32) {
        const int cnd = cond_of_row(r0);
        const float* sh = modp(p, layer, cnd, 3); const float* scl = modp(p, layer, cnd, 4);
        f32x4 v[4][4];
        float mu[4], rs[4];
#pragma unroll
        for (int j = 0; j < 4; ++j)
#pragma unroll
            for (int i = 0; i < 4; ++i) v[j][i] = *(const f32x4*)(p.T + (size_t)(r0 + j) * D + lane * 4 + 256 * i);
#pragma unroll
        for (int j = 0; j < 4; ++j) { float s = 0.f;
#pragma unroll
            for (int i = 0; i < 4; ++i) s += (v[j][i][0] + v[j][i][1]) + (v[j][i][2] + v[j][i][3]);
            mu[j] = s; }
#pragma unroll
        for (int j = 0; j < 4; ++j) mu[j] = wave_sum(mu[j]) * (1.0f / 1024.0f);
#pragma unroll
        for (int j = 0; j < 4; ++j) { float q = 0.f;
#pragma unroll
            for (int i = 0; i < 4; ++i) { v[j][i] = v[j][i] - mu[j]; q += (v[j][i][0] * v[j][i][0] + v[j][i][1] * v[j][i][1]) + (v[j][i][2] * v[j][i][2] + v[j][i][3] * v[j][i][3]); }
            rs[j] = q; }
#pragma unroll
        for (int j = 0; j < 4; ++j) rs[j] = rsqrtf(wave_sum(rs[j]) * (1.0f / 1024.0f) + EPS_F);
        float lgt[4][16];
#pragma unroll
        for (int j = 0; j < 4; ++j)
#pragma unroll
            for (int e = 0; e < 16; ++e) lgt[j][e] = 0.f;
#pragma unroll
        for (int i = 0; i < 4; ++i) {
            const int col = lane * 4 + 256 * i;
            const f32x4 g4 = *(const f32x4*)(lg + col), b4 = *(const f32x4*)(lb + col), sc4 = *(const f32x4*)(scl + col) + 1.0f, sh4 = *(const f32x4*)(sh + col);
            f32x4 h[4];
#pragma unroll
            for (int j = 0; j < 4; ++j) {
                const f32x4 x = v[j][i] * rs[j] * g4 + b4;
                *(f32x4*)(p.X1 + (size_t)(r0 + j) * D + col) = x;
                h[j] = x * sc4 + sh4;
                u32x2 o; o.x = pk_bf16(h[j][0], h[j][1]); o.y = pk_bf16(h[j][2], h[j][3]);
                *(u32x2*)(p.H2 + (size_t)(r0 + j) * D + col) = o;
            }
#pragma unroll
            for (int e = 0; e < 16; ++e) {
                const f32x4 rw = *(LAS f32x4*)(rt + e * 1024 + col);
#pragma unroll
                for (int j = 0; j < 4; ++j) lgt[j][e] += (h[j][0] * rw[0] + h[j][1] * rw[1]) + (h[j][2] * rw[2] + h[j][3] * rw[3]);
                if ((e & 3) == 3) __builtin_amdgcn_sched_barrier(0);
            }
        }
        float r1[4];
#pragma unroll
        for (int j = 0; j < 4; ++j) {
            float r8[8], r4[4], r2[2];
            { const bool hi = (lane & 32) != 0;
#pragma unroll
              for (int i = 0; i < 8; ++i) { const float keep = hi ? lgt[j][8 + i] : lgt[j][i], send = hi ? lgt[j][i] : lgt[j][8 + i]; r8[i] = keep + __shfl_xor(send, 32); } }
            { const bool hi = (lane & 16) != 0;
#pragma unroll
              for (int i = 0; i < 4; ++i) { const float keep = hi ? r8[4 + i] : r8[i], send = hi ? r8[i] : r8[4 + i]; r4[i] = keep + __shfl_xor(send, 16); } }
            { const bool hi = (lane & 8) != 0;
#pragma unroll
              for (int i = 0; i < 2; ++i) { const float keep = hi ? r4[2 + i] : r4[i], send = hi ? r4[i] : r4[2 + i]; r2[i] = keep + __shfl_xor(send, 8); } }
            { const bool hi = (lane & 4) != 0; const float keep = hi ? r2[1] : r2[0], send = hi ? r2[0] : r2[1]; r1[j] = keep + __shfl_xor(send, 4); }
        }
        const int e = ((lane >> 5) & 1) * 8 + ((lane >> 4) & 1) * 4 + ((lane >> 3) & 1) * 2 + ((lane >> 2) & 1);
#pragma unroll
        for (int j = 0; j < 4; ++j) {
            float r = r1[j];
            r += __shfl_xor(r, 2); r += __shfl_xor(r, 1);
            float mx = r;
            mx = fmaxf(mx, __shfl_xor(mx, 4)); mx = fmaxf(mx, __shfl_xor(mx, 8)); mx = fmaxf(mx, __shfl_xor(mx, 16)); mx = fmaxf(mx, __shfl_xor(mx, 32));
            const float ex = __expf(r - mx);
            float den = ex;
            den += __shfl_xor(den, 4); den += __shfl_xor(den, 8); den += __shfl_xor(den, 16); den += __shfl_xor(den, 32);
            if ((lane & 3) == 0) p.AFF[(size_t)e * NTOK + r0 + j] = ex / den;
        }
    }
}

DEVI int block_sum_i(int v, LAS int* red, int tid) {
    const int lane = tid & 63, wave = tid >> 6;
    v = __builtin_popcountll(__ballot(v & 1)) + 2 * __builtin_popcountll(__ballot(v & 2)) + 4 * __builtin_popcountll(__ballot(v & 4)) + 8 * __builtin_popcountll(__ballot(v & 8));
    __syncthreads();
    if (lane == 0) red[wave] = v;
    __syncthreads();
    return (red[0] + red[1]) + (red[2] + red[3]) + (red[4] + red[5]) + (red[6] + red[7]);
}
DEVI int block_excl_scan_i(int v, LAS int* red, int tid, int& total) {
    const int lane = tid & 63, wave = tid >> 6;
    int inc = v;
#pragma unroll
    for (int o = 1; o < 64; o <<= 1) { const int t = __shfl_up(inc, o); if (lane >= o) inc += t; }
    __syncthreads();
    if (lane == 63) red[wave] = inc;
    __syncthreads();
    int base = 0, tot = 0;
#pragma unroll
    for (int w = 0; w < 8; ++w) { const int c = red[w]; if (w < wave) base += c; tot += c; }
    total = tot;
    return base + inc - v;
}
DEVI void phase_topk(const Params& p, lds_t* lds, int bid, int nblk, int tid) {
    LAS int* red = (LAS int*)lds;
    for (int it = bid; it < 32; it += nblk) {
        const int grp = it >> 4, e = it & 15;
        const float* a = p.AFF + (size_t)e * NTOK + grp * 4096 + tid * 8;
        const f32x4 a0 = *(const f32x4*)a, a1 = *(const f32x4*)(a + 4);
        unsigned key[8];
#pragma unroll
        for (int i = 0; i < 4; ++i) { key[i] = __float_as_uint(a0[i]); key[4 + i] = __float_as_uint(a1[i]); }
        unsigned thr = 0u;
        for (int bit = 30; bit >= 0; --bit) {
            const unsigned cand = thr | (1u << bit);
            int c = 0;
#pragma unroll
            for (int i = 0; i < 8; ++i) c += key[i] >= cand ? 1 : 0;
            if (block_sum_i(c, red, tid) >= 512) thr = cand;
        }
        int cgt = 0, ceq = 0;
#pragma unroll
        for (int i = 0; i < 8; ++i) { cgt += key[i] > thr ? 1 : 0; ceq += key[i] == thr ? 1 : 0; }
        int ngt, neq;
        (void)block_excl_scan_i(cgt, red, tid, ngt);
        int tie_rank = block_excl_scan_i(ceq, red, tid, neq);
        const int need = 512 - ngt;
        int sel[8], cs = 0;
#pragma unroll
        for (int i = 0; i < 8; ++i) {
            const bool eq = key[i] == thr;
            sel[i] = (key[i] > thr || (eq && tie_rank < need)) ? 1 : 0;
            tie_rank += eq ? 1 : 0; cs += sel[i];
        }
        int tot;
        int slot = block_excl_scan_i(cs, red, tid, tot);
#pragma unroll
        for (int i = 0; i < 8; ++i) {
            const int t = grp * 4096 + tid * 8 + i;
            int sl = -1;
            if (sel[i]) { sl = grp * 512 + slot; ++slot; p.IDX[e * 1024 + sl] = t; p.GATEV[e * 1024 + sl] = __uint_as_float(key[i]); }
            p.SEL[(size_t)t * 16 + e] = sl;
        }
    }
}

DEVI void phase_ln_b(const Params& p, int layer, int bid, int nblk, int tid) {
    const int lane = tid & 63, wave = tid >> 6;
    const float* lg = p.ln_gain + (layer * 2 + 1) * 1024; const float* lb = p.ln_bias + (layer * 2 + 1) * 1024;
    const bool last = (layer == DEPTH - 1);
    float* xo = last ? p.out + OUT_Y : p.X0;
    const int stride = nblk * 8;
    int row = bid * 8 + wave;
    int seln = -1; f32x4 xn[4];
    if (row < NTOK) {
        if (lane < 16) seln = p.SEL[(size_t)row * 16 + lane];
#pragma unroll
        for (int i = 0; i < 4; ++i) xn[i] = *(const f32x4*)(p.X1 + (size_t)row * D + lane * 4 + 256 * i);
    }
    for (; row < NTOK; row += stride) {
        const int selv = seln;
        f32x4 v[4];
#pragma unroll
        for (int i = 0; i < 4; ++i) v[i] = xn[i];
        unsigned long long mask = __ballot(selv >= 0);
        f32x4 y[4];
#pragma unroll
        for (int i = 0; i < 4; ++i) y[i] = (f32x4){0.f, 0.f, 0.f, 0.f};
        while (mask) {
            const int e0 = __builtin_ctzll(mask); mask &= mask - 1;
            const int s0 = __builtin_amdgcn_readlane(selv, e0);
            const bf16_t* y0 = p.YE + ((size_t)e0 * 1024 + s0) * 1024 + lane * 4;
            const bool two = mask != 0;
            int e1 = e0, s1 = s0;
            if (two) { e1 = __builtin_ctzll(mask); mask &= mask - 1; s1 = __builtin_amdgcn_readlane(selv, e1); }
            const bf16_t* y1 = p.YE + ((size_t)e1 * 1024 + s1) * 1024 + lane * 4;
            u32x2 w0[4], w1[4];
#pragma unroll
            for (int i = 0; i < 4; ++i) { w0[i] = *(const u32x2*)(y0 + 256 * i); w1[i] = *(const u32x2*)(y1 + 256 * i); }
            const float f1 = two ? 1.0f : 0.0f;
#pragma unroll
            for (int i = 0; i < 4; ++i) {
                y[i][0] += bf_lo(w0[i].x) + f1 * bf_lo(w1[i].x); y[i][1] += bf_hi(w0[i].x) + f1 * bf_hi(w1[i].x);
                y[i][2] += bf_lo(w0[i].y) + f1 * bf_lo(w1[i].y); y[i][3] += bf_hi(w0[i].y) + f1 * bf_hi(w1[i].y);
            }
        }
        if (row + stride < NTOK) {
            seln = -1;
            if (lane < 16) seln = p.SEL[(size_t)(row + stride) * 16 + lane];
#pragma unroll
            for (int i = 0; i < 4; ++i) xn[i] = *(const f32x4*)(p.X1 + (size_t)(row + stride) * D + lane * 4 + 256 * i);
        }
        const int cnd = cond_of_row(row);
        const float* gt = modp(p, layer, cnd, 5);
        float s = 0.f;
#pragma unroll
        for (int i = 0; i < 4; ++i) {
            const int col = lane * 4 + 256 * i;
            v[i] = v[i] * ALPHA_F + *(const f32x4*)(gt + col) * y[i];
            s += (v[i][0] + v[i][1]) + (v[i][2] + v[i][3]);
        }
        s = wave_sum(s);
        const float mu = s * (1.0f / 1024.0f);
        float q = 0.f;
#pragma unroll
        for (int i = 0; i < 4; ++i) { v[i] = v[i] - mu; q += (v[i][0] * v[i][0] + v[i][1] * v[i][1]) + (v[i][2] * v[i][2] + v[i][3] * v[i][3]); }
        q = wave_sum(q);
        const float rs = rsqrtf(q * (1.0f / 1024.0f) + EPS_F);
        const float* sh = modp(p, last ? layer : layer + 1, cnd, 0); const float* scl = modp(p, last ? layer : layer + 1, cnd, 1);
#pragma unroll
        for (int i = 0; i < 4; ++i) {
            const int col = lane * 4 + 256 * i;
            const f32x4 x = v[i] * rs * *(const f32x4*)(lg + col) + *(const f32x4*)(lb + col);
            *(f32x4*)(xo + (size_t)row * D + col) = x;
            if (!last) {
                const f32x4 h = x * (*(const f32x4*)(scl + col) + 1.0f) + *(const f32x4*)(sh + col);
                u32x2 o; o.x = pk_bf16(h[0], h[1]); o.y = pk_bf16(h[2], h[3]);
                *(u32x2*)(p.H + (size_t)row * D + col) = o;
            }
        }
    }
}

constexpr int GBM = 128;
constexpr int GBM2 = 256;
DEVI int xcd_first_unit(int bid, int nblk) { return (nblk & 7) ? bid : (bid & 7) * (nblk >> 3) + (bid >> 3); }
struct RowLin { const bf16_t* base; unsigned ld; DEVI unsigned offset(int r) const { return (unsigned)r * ld; } };
struct RowGather { const bf16_t* base; const int* idx; DEVI unsigned offset(int r) const { return (unsigned)(idx[r] & 8191) * 1024u; } };
struct RowClamp { const bf16_t* base; unsigned ld; int r0, rmax; DEVI unsigned offset(int r) const { int q = r0 + r; if (q > rmax) q = rmax; return (unsigned)q * ld; } };
struct RowKv { const bf16_t* base; int n0, isv; DEVI unsigned offset(int r) const { const int n = n0 + r; return (unsigned)((n >> 7) * 256 + isv * 128 + (n & 127)) * 256u; } };
struct GDesc { RowLin rf; WLin wl; unsigned ldw; int nk; };
struct WUp { const float* base; int kv; DEVI const float* operator()(int lane) const { return kv ? base + (lane >> 5) * 256 + ((4 * lane) & 127) : base + 4 * lane; } };
struct GDescUp { RowLin rf; WUp wl; unsigned ldw; };
struct WClamp { const float* base; int col0; DEVI const float* operator()(int lane) const { int c = col0 + 4 * lane; if (c > 700) c = 700; return base + c; } };
struct WMoe { const float* gate; const float* up; size_t off; DEVI const float* operator()(int lane) const { const int r = 4 * lane, sub = r >> 5;
    const unsigned long long ga = (unsigned long long)gate, ua = (unsigned long long)up, mk = 0ull - (unsigned long long)(sub & 1);
    return (const float*)(ga ^ ((ga ^ ua) & mk)) + off + 32 * (sub >> 1) + (r & 31); } };

DEVI void st_bf16x4(bf16_t* dst, f32x4 v) { u32x2 o; o.x = pk_bf16(v[0], v[1]); o.y = pk_bf16(v[2], v[3]); *(u32x2*)dst = o; }

template <int TM> DEVI void rope_tile(f32x4 (&acc)[TM][4], int row0  , int lane) {
    const int r16 = lane & 15, g = lane >> 4;
#pragma unroll
    for (int mb = 0; mb < TM; ++mb) {
        const int t = (row0 + mb * 16 + r16 - NPR) & 1023;
        const int prow = t >> 6, pcol = t & 63;
#pragma unroll
        for (int r = 0; r < 4; ++r) {
            const int f = 4 * g + r;
            const float c1 = rope_tab[(prow * 16 + f) * 2], s1 = rope_tab[(prow * 16 + f) * 2 + 1];
            const float c2 = rope_tab[(pcol * 16 + f) * 2], s2 = rope_tab[(pcol * 16 + f) * 2 + 1];
            const float a1 = acc[mb][0][r], a2 = acc[mb][1][r], b1 = acc[mb][2][r], b2 = acc[mb][3][r];
            acc[mb][0][r] = a1 * c1 - a2 * s1; acc[mb][1][r] = a2 * c1 + a1 * s1;
            acc[mb][2][r] = b1 * c2 - b2 * s2; acc[mb][3][r] = b2 * c2 + b1 * s2;
        }
        __builtin_amdgcn_sched_barrier(0);
    }
}

template <int BM> struct EpiZ { float* Z; int m0, n0;
    DEVI void operator()(const f32x4 (&acc)[BM / 32][4], int wr, int wc, int lane) const {
        const int r16 = lane & 15, g = lane >> 4;
#pragma unroll
        for (int mb = 0; mb < BM / 32; ++mb) { const int row = m0 + wr * (BM / 2) + mb * 16 + r16;
#pragma unroll
            for (int nb = 0; nb < 4; ++nb) { const int col = n0 + wc * 64 + nb * 16 + 4 * g; if (col < 704) *(f32x4*)(Z + (size_t)row * 704 + col) = acc[mb][nb]; } }
    } };
DEVI void phase_mla_win(const Params& p, int j, lds_t* lds, int bid, int nblk, int tid) {
    constexpr int MT = NTOK / GBM, NU = MT * 3;
    for (int u = xcd_first_unit(bid, nblk); u < NU; u += nblk) {
        const int mt = u % MT, nt = u / MT;
        RowLin rf{p.H + (size_t)mt * GBM * 1024, 1024u};
        RowClamp wf{p.WTI + (size_t)j * 704 * 1024, 1024u, nt * 256, 703};
        EpiZ<GBM> epi{p.Z, mt * GBM, nt * 256};
        gemm_unit_bb3<GBM, true>(lds, rf, wf, 16, epi, tid);
    }
}

template <int BM> struct EpiQ { bf16_t* Q; int m0, n0; float scale;
    DEVI void operator()(f32x4 (&acc)[BM / 32][4], int wr, int wc, int lane) const {
        const int r16 = lane & 15, g = lane >> 4;
        const int ncol0 = n0 + wc * 64;
        if (m0 >= NPR && (ncol0 % 192) == 128) rope_tile<BM / 32>(acc, m0 + wr * (BM / 2), lane);
#pragma unroll
        for (int mb = 0; mb < BM / 32; ++mb) { const int row = m0 + wr * (BM / 2) + mb * 16 + r16;
#pragma unroll
            for (int nb = 0; nb < 4; ++nb) st_bf16x4(Q + (size_t)row * 1536 + ncol0 + nb * 16 + 4 * g, acc[mb][nb] * scale); }
    } };
template <int BM> struct EpiKN { bf16_t* KN; int m0, n0;
    DEVI void operator()(const f32x4 (&acc)[BM / 32][4], int wr, int wc, int lane) const {
        const int r16 = lane & 15, g = lane >> 4;
#pragma unroll
        for (int mb = 0; mb < BM / 32; ++mb) { const int row = m0 + wr * (BM / 2) + mb * 16 + r16;
#pragma unroll
            for (int nb = 0; nb < 4; ++nb) st_bf16x4(KN + (size_t)row * 1024 + n0 + wc * 64 + nb * 16 + 4 * g, acc[mb][nb]); }
    } };
template <int BM> struct EpiVT { bf16_t* VTP; bf16_t* VTS; int m0, n0;
    DEVI void operator()(const f32x4 (&acc)[BM / 32][4], int wr, int wc, int lane) const {
        const int r16 = lane & 15, g = lane >> 4;
#pragma unroll
        for (int mb = 0; mb < BM / 32; ++mb) { const int row = m0 + wr * (BM / 2) + mb * 16 + 4 * g;
            bf16_t* dst;
            if (row < NPR) dst = VTP + (size_t)(row >> 8) * (8 * 128 * 256) + (row & 255);
            else if (row < NTOK) dst = VTS + (size_t)((row - NPR) >> 10) * (8 * 128 * 1280) + 256 + ((row - NPR) & 1023);
            else dst = VTS + (size_t)((row - NTOK) >> 8) * (8 * 128 * 1280) + ((row - NTOK) & 255);
            const size_t ldk = row < NPR ? 256 : 1280;
#pragma unroll
            for (int nb = 0; nb < 4; ++nb) { const int col = n0 + wc * 64 + nb * 16 + r16;
                st_bf16x4(dst + (size_t)col * ldk, acc[mb][nb]); } }
    } };
DEVI void phase_mla_up(const Params& p, int j, lds_t* lds, int bid, int nblk, int tid) {
    const float qscale = 0.07216878364870322f * LOG2E;
    constexpr int MTQ = NTOK / GBM2, MTK = NROWS_KV / GBM2, NQ = MTQ * 6, NK = MTK * 4, NU = NQ + 2 * NK;
    for (int u = xcd_first_unit(bid, nblk); u < NU; u += nblk) {
        if (u < NQ) {
            const int mt = u % MTQ, nt = u / MTQ;
            RowLin rf{p.CQ + (size_t)mt * GBM2 * 384, 384u};
            RowLin wf{p.WTQ + (size_t)j * 1536 * 384 + (size_t)nt * 256 * 384, 384u};
            EpiQ<GBM2> epi{p.Q, mt * GBM2, nt * 256, qscale};
            gemm_unit_bb<GBM2, true>(lds, rf, wf, 6, epi, tid);
        } else if (u < NQ + NK) {
            const int v = u - NQ, mt = v % MTK, nt = v / MTK;
            RowLin rf{p.CKV + (size_t)mt * GBM2 * 256, 256u};
            RowKv wf{p.WTKV + (size_t)j * 2048 * 256, nt * 256, 0};
            EpiKN<GBM2> epi{p.KN, mt * GBM2, nt * 256};
            gemm_unit_bb<GBM2, true>(lds, rf, wf, 4, epi, tid);
        } else {
            const int v = u - NQ - NK, mt = v % MTK, nt = v / MTK;
            RowLin rf{p.CKV + (size_t)mt * GBM2 * 256, 256u};
            RowKv wf{p.WTKV + (size_t)j * 2048 * 256, nt * 256, 1};
            EpiVT<GBM2> epi{p.VTP, p.VTS, mt * GBM2, nt * 256};
            gemm_unit_bb<GBM2, false>(lds, rf, wf, 4, epi, tid);
        }
    }
}

struct EpiRes { float* T; const float* X0; const float* mod; int layer, m0, n0;
    DEVI void operator()(const f32x4 (&acc)[4][4], int wr, int wc, int lane) const {
        const int r16 = lane & 15, g = lane >> 4;
        const int cnd = cond_of_row(m0);
        const float* gt = mod + ((size_t)(layer * 5 + cnd) * 6 + 2) * 1024;
#pragma unroll
        for (int nb = 0; nb < 4; ++nb) { const int col = n0 + wc * 64 + nb * 16 + 4 * g; const f32x4 gv = *(const f32x4*)(gt + col);
#pragma unroll
            for (int mb = 0; mb < 4; ++mb) { const size_t o = (size_t)(m0 + wr * 64 + mb * 16 + r16) * 1024 + col;
                *(f32x4*)(T + o) = *(const f32x4*)(X0 + o) * ALPHA_F + gv * acc[mb][nb]; } }
    } };
DEVI void phase_out_proj(const Params& p, int layer, const bf16_t* A, int K, const bf16_t* Wt, lds_t* lds, int bid, int nblk, int tid) {
    constexpr int NU = 64 * 4;
    for (int u = xcd_first_unit(bid, nblk); u < NU; u += nblk) {
        const int mt = u & 63, nt = u >> 6;
        RowLin rf{A + (size_t)mt * 128 * K, (unsigned)K};
        RowLin wf{Wt + (size_t)nt * 256 * K, (unsigned)K};
        const float* xres = layer ? p.X0 : (mt * 128 < NPR ? p.x_prompt : p.x_sample - (size_t)NPR * D);
        EpiRes epi{p.T, xres, p.mod, layer, mt * 128, nt * 256};
        gemm_unit_bb3<128, true>(lds, rf, wf, K / 64, epi, tid);
    }
}

template <int BM> struct EpiGU { bf16_t* U; int m0, n0;
    DEVI void operator()(const f32x4 (&acc)[BM / 32][4], int wr, int wc, int lane) const {
        const int r16 = lane & 15, g = lane >> 4;
#pragma unroll
        for (int mb = 0; mb < BM / 32; ++mb) { const int row = m0 + wr * (BM / 2) + mb * 16 + r16;
#pragma unroll
            for (int nb = 0; nb < 4; ++nb) { f32x4 v = acc[mb][nb];
                v[0] = gelu_tanh_f(v[0]); v[1] = gelu_tanh_f(v[1]); v[2] = gelu_tanh_f(v[2]); v[3] = gelu_tanh_f(v[3]);
                st_bf16x4(U + (size_t)row * 3072 + n0 + wc * 64 + nb * 16 + 4 * g, v); } }
    } };
template <int BM> struct EpiGV { bf16_t* GVT; float* GST; int m0, n0;
    DEVI void operator()(const f32x4 (&acc)[BM / 32][4], int wr, int wc, int lane) const {
        const int r16 = lane & 15, g = lane >> 4;
        const int part = (n0 >> 6) + wc;
#pragma unroll
        for (int mb = 0; mb < BM / 32; ++mb) { const int row = m0 + wr * (BM / 2) + mb * 16 + 4 * g;
            f32x4 s = (f32x4){0.f, 0.f, 0.f, 0.f}, q = s;
#pragma unroll
            for (int nb = 0; nb < 4; ++nb) { f32x4 v = acc[mb][nb];
                v[0] = gelu_tanh_f(v[0]); v[1] = gelu_tanh_f(v[1]); v[2] = gelu_tanh_f(v[2]); v[3] = gelu_tanh_f(v[3]);
                s += v; q += v * v;
                const int col = n0 + wc * 64 + nb * 16 + r16;
                st_bf16x4(GVT + ((size_t)(row >> 7) * 3072 + col) * 128 + (row & 127), v); }
#pragma unroll
            for (int o = 1; o < 16; o <<= 1) {
#pragma unroll
                for (int r = 0; r < 4; ++r) { s[r] += __shfl_xor(s[r], o); q[r] += __shfl_xor(q[r], o); } }
            if (r16 == 0) {
#pragma unroll
                for (int r = 0; r < 4; ++r) { f32x2 w; w.x = s[r]; w.y = q[r]; *(f32x2*)(GST + ((size_t)(row + r) * 48 + part) * 2) = w; } }
        }
    } };
DEVI void phase_gm_win(const Params& p, lds_t* lds, int bid, int nblk, int tid) {
    constexpr int MT = NTOK / GBM2, NU = MT * 24;
    for (int u = xcd_first_unit(bid, nblk); u < NU; u += nblk) {
        const int mt = u % MT, nt = u / MT;
        RowLin rf{p.H + (size_t)mt * GBM2 * 1024, 1024u};
        RowLin wf{p.WTGI + (size_t)nt * 256 * 1024, 1024u};
        if (nt < 12) { EpiGU<GBM2> epi{p.U, mt * GBM2, nt * 256}; gemm_unit_bb<GBM2, true>(lds, rf, wf, 16, epi, tid); }
        else { EpiGV<GBM2> epi{p.GVT, p.GST, mt * GBM2, (nt - 12) * 256}; gemm_unit_bb<GBM2, false>(lds, rf, wf, 16, epi, tid); }
    }
}

template <int BM> struct EpiSQ { bf16_t* Q; int m0, n0; float scale;
    DEVI void operator()(f32x4 (&acc)[BM / 32][4], int wr, int wc, int lane) const {
        const int r16 = lane & 15, g = lane >> 4;
        if (m0 >= NPR) rope_tile<BM / 32>(acc, m0 + wr * (BM / 2), lane);
#pragma unroll
        for (int mb = 0; mb < BM / 32; ++mb) { const int row = m0 + wr * (BM / 2) + mb * 16 + r16;
#pragma unroll
            for (int nb = 0; nb < 4; ++nb) st_bf16x4(Q + (size_t)row * 1024 + n0 + wc * 64 + nb * 16 + 4 * g, acc[mb][nb] * scale); }
    } };
template <int BM> struct EpiSK { bf16_t* SK; float* out; int m0;
    DEVI void operator()(f32x4 (&acc)[BM / 32][4], int wr, int wc, int lane) const {
        const int r16 = lane & 15, g = lane >> 4;
        if (m0 >= NPR) rope_tile<BM / 32>(acc, m0 + wr * (BM / 2), lane);
#pragma unroll
        for (int mb = 0; mb < BM / 32; ++mb) { const int row = m0 + wr * (BM / 2) + mb * 16 + r16;
#pragma unroll
            for (int nb = 0; nb < 4; ++nb) { const int col = wc * 64 + nb * 16 + 4 * g;
                if (m0 < NPR) *(f32x4*)(out + OUT_SK + (size_t)row * 256 + col) = acc[mb][nb];
                st_bf16x4(SK + (size_t)row * 256 + col, acc[mb][nb]); } }
    } };
template <int BM> struct EpiSV { bf16_t* SVTP; bf16_t* SVTS; float* out; int m0;
    DEVI void operator()(const f32x4 (&acc)[BM / 32][4], int wr, int wc, int lane) const {
        const int r16 = lane & 15, g = lane >> 4;
#pragma unroll
        for (int mb = 0; mb < BM / 32; ++mb) { const int row = m0 + wr * (BM / 2) + mb * 16 + 4 * g;
            bf16_t* dst; size_t ldk;
            if (row < NPR) { dst = SVTP + (size_t)(row >> 8) * (4 * 64 * 256) + (row & 255); ldk = 256; }
            else { dst = SVTS + (size_t)((row - NPR) >> 10) * (4 * 64 * 1280) + 256 + ((row - NPR) & 1023); ldk = 1280; }
#pragma unroll
            for (int nb = 0; nb < 4; ++nb) { const int col = wc * 64 + nb * 16 + r16;
                st_bf16x4(dst + (size_t)col * ldk, acc[mb][nb]);
                if (row < NPR) {
#pragma unroll
                    for (int r = 0; r < 4; ++r) out[OUT_SV + (size_t)(row + r) * 256 + col] = acc[mb][nb][r]; } } }
    } };
DEVI void phase_swa_qkv(const Params& p, lds_t* lds, int bid, int nblk, int tid) {
    constexpr int MT = NTOK / GBM2, NU = MT * 6;
    for (int u = xcd_first_unit(bid, nblk); u < NU; u += nblk) {
        const int mt = u % MT, nt = u / MT;
        RowLin rf{p.H + (size_t)mt * GBM2 * 1024, 1024u};
        RowLin wf{p.WTSQ + (size_t)nt * 256 * 1024, 1024u};
        if (nt < 4) { EpiSQ<GBM2> epi{p.Q, mt * GBM2, nt * 256, 0.125f * LOG2E}; gemm_unit_bb<GBM2, true>(lds, rf, wf, 16, epi, tid); }
        else if (nt == 4) { EpiSK<GBM2> epi{p.SK, p.out, mt * GBM2}; gemm_unit_bb<GBM2, true>(lds, rf, wf, 16, epi, tid); }
        else { EpiSV<GBM2> epi{p.SVTP, p.SVTS, p.out, mt * GBM2}; gemm_unit_bb<GBM2, false>(lds, rf, wf, 16, epi, tid); }
    }
}

template <int BM> struct EpiHid { bf16_t* HID; int e, mt, nt;
    DEVI void operator()(const f32x4 (&acc)[BM / 32][4], int wr, int wc, int lane) const {
        const int r16 = lane & 15, g = lane >> 4;
#pragma unroll
        for (int mb = 0; mb < BM / 32; ++mb) { const size_t row = (size_t)e * 1024 + mt * BM + wr * (BM / 2) + mb * 16 + r16;
#pragma unroll
            for (int nb = 0; nb < 2; ++nb) { const f32x4 gv = acc[mb][nb], uv = acc[mb][nb + 2]; f32x4 h;
                h[0] = silu_f(gv[0]) * uv[0]; h[1] = silu_f(gv[1]) * uv[1]; h[2] = silu_f(gv[2]) * uv[2]; h[3] = silu_f(gv[3]) * uv[3];
                st_bf16x4(HID + row * 2048 + nt * 128 + wc * 32 + nb * 16 + 4 * g, h); } }
    } };
template <int DBG = 0> DEVI void phase_moe_up(const Params& p, int layer, lds_t* lds, int bid, int nblk, int tid) {
    constexpr int MT = 1024 / GBM2, NU = 16 * MT * 16;
#define DEC_MU(u_, rf_, wf_) do { const int e_ = (u_) / (MT * 16), w_ = (u_) % (MT * 16), mt_ = w_ % MT, nt_ = w_ / MT; \
        rf_ = RowGather{p.H2, p.IDX + e_ * 1024 + mt_ * GBM2}; wf_ = WMoe{p.moe_w_gate, p.moe_w_up, ((size_t)layer * 16 + e_) * 1024 * 2048 + nt_ * 128}; } while (0)
    int u = xcd_first_unit(bid, nblk);
    RowGather rf, rfn; WMoe wf, wfn;
    for (; u < NU; u += nblk) {
        const int e = u / (MT * 16), w = u % (MT * 16), mt = w % MT, nt = w / MT;
        DEC_MU(u, rf, wf);
        EpiHid<GBM2> epi{p.HID, e, mt, nt};
        gemm_unit<GBM2, true>(lds, rf, wf, 2048u, 16, epi, tid);
    }
#undef DEC_MU
}
template <int BM> struct EpiYe { bf16_t* YE; const float* GATEV; int e, mt, nt;
    DEVI void operator()(const f32x4 (&acc)[BM / 32][4], int wr, int wc, int lane) const {
        const int r16 = lane & 15, g = lane >> 4;
#pragma unroll
        for (int mb = 0; mb < BM / 32; ++mb) { const size_t row = (size_t)e * 1024 + mt * BM + wr * (BM / 2) + mb * 16 + r16;
            const float gt = GATEV[row];
#pragma unroll
            for (int nb = 0; nb < 4; ++nb) st_bf16x4(YE + row * 1024 + nt * 256 + wc * 64 + nb * 16 + 4 * g, acc[mb][nb] * gt); }
    } };
DEVI void phase_moe_down(const Params& p, int layer, lds_t* lds, int bid, int nblk, int tid) {
    constexpr int MT = 1024 / GBM2, NU = 16 * MT * 4;
#define DEC_MD(u_, d_) do { const int e_ = (u_) / (MT * 4), w_ = (u_) % (MT * 4), mt_ = w_ % MT, nt_ = w_ / MT; \
        d_.rf = RowLin{p.HID + ((size_t)e_ * 1024 + mt_ * GBM2) * 2048, 2048u}; d_.wl = WLin{p.moe_w_down + ((size_t)layer * 16 + e_) * 2048 * 1024 + nt_ * 256}; d_.ldw = 1024u; d_.nk = 32; } while (0)
    int u = xcd_first_unit(bid, nblk);
    GDesc d, dn;
    for (; u < NU; u += nblk) {
        const int e = u / (MT * 4), w = u % (MT * 4), mt = w % MT, nt = w / MT;
        DEC_MD(u, d);
        EpiYe<GBM2> epi{p.YE, p.GATEV, e, mt, nt};
        gemm_unit<GBM2, true>(lds, d.rf, d.wl, d.ldw, 32, epi, tid);
    }
#undef DEC_MD
}

template <int DK, int DV> struct AttnCfg {
    static constexpr int CPK = DK / 8;
    static constexpr int KT_BYTES = 64 * DK * 2;
    static constexpr int VT_BYTES = DV * 128;
    static constexpr int STAGE = KT_BYTES + VT_BYTES;
    static constexpr int NKC = 64 * CPK / NTHREADS;
    static constexpr int NVC = DV * 8 / NTHREADS;
};
DEVI int kswz(int key) { return ((key >> 1) & 1) | (((key >> 3) & 3) << 1); }

struct AttnSeg { int n_ctx, ctx_krow0, ctx_vcol0, n_loc, loc_krow0, loc_vcol0, loc_kpos0; };

template <int DK, int DV, bool WINDOW, class KSrc>
DEVI void attn_unit(lds_t* lds, const bf16_t* Qp, int ldq, const KSrc& ks, const bf16_t* vt, int ldv, const AttnSeg sg, int qpos0,
                    float sink, bool has_sink, bf16_t* Op, int ldo, int tid) {
    typedef AttnCfg<DK, DV> C;
    const int lane = tid & 63, wave = tid >> 6, r16 = lane & 15, g = lane >> 4;
    const int ntile = sg.n_ctx + sg.n_loc;
    bf16x8 qf[DK / 32];
    {
        const bf16_t* qr = Qp + (size_t)(wave * 16 + r16) * ldq + 8 * g;
#pragma unroll
        for (int s = 0; s < DK / 32; ++s) qf[s] = *(const bf16x8*)(qr + 32 * s);
    }
    u32x4 kreg[C::NKC], vreg[C::NVC];
#define TILE_LOAD(jj) do { const int j_ = (jj); int krow, vcol; \
        if (j_ < sg.n_ctx) { krow = sg.ctx_krow0 + 64 * j_; vcol = sg.ctx_vcol0 + 64 * j_; } \
        else { krow = sg.loc_krow0 + 64 * (j_ - sg.n_ctx); vcol = sg.loc_vcol0 + 64 * (j_ - sg.n_ctx); } \
        _Pragma("unroll") for (int i = 0; i < C::NKC; ++i) { const int c = tid + NTHREADS * i, key = c / C::CPK, ch = c % C::CPK; kreg[i] = *(const u32x4*)ks(krow + key, ch); } \
        _Pragma("unroll") for (int i = 0; i < C::NVC; ++i) { const int c = tid + NTHREADS * i, dv = c >> 3, ch = c & 7; vreg[i] = *(const u32x4*)(vt + (size_t)dv * ldv + vcol + ch * 8); } } while (0)
#define TILE_STORE(stp) do { lds_t* st_ = (stp); \
        _Pragma("unroll") for (int i = 0; i < C::NKC; ++i) { const int c = tid + NTHREADS * i, key = c / C::CPK, ch = c % C::CPK; lds_st128(st_ + key * (DK * 2) + ((ch ^ kswz(key)) << 4), kreg[i]); } \
        _Pragma("unroll") for (int i = 0; i < C::NVC; ++i) { const int c = tid + NTHREADS * i, dv = c >> 3, ch = c & 7; lds_st128(st_ + C::KT_BYTES + img_off(dv, ch), vreg[i]); } } while (0)
    f32x4 o[DV / 16];
#pragma unroll
    for (int i = 0; i < DV / 16; ++i) o[i] = (f32x4){0.f, 0.f, 0.f, 0.f};
    float m = has_sink ? sink : -1.0e30f;
    float l = (has_sink && g == 0) ? 1.0f : 0.0f;
    const int qpos = qpos0 + wave * 16 + r16;
    const int kbyte = (8 * (r16 >> 2) + (r16 & 3)) * (DK * 2);
    const int ksw0 = ((r16 >> 1) & 1) | ((r16 >> 2) << 1);
    const int ke0 = (g ^ ksw0) << 4, ke1 = ((4 + g) ^ ksw0) << 4;
    const int vc0 = g ^ ((r16 >> 1) & 7);

    TILE_LOAD(0);
    __syncthreads();
    TILE_STORE(lds);
    if (ntile > 1) TILE_LOAD(1);
    for (int j = 0; j < ntile; ++j) {
        __syncthreads();
        lds_t* cur = lds + (j & 1) * C::STAGE;
        if (j + 1 < ntile) { TILE_STORE(lds + ((j + 1) & 1) * C::STAGE); if (j + 2 < ntile) TILE_LOAD(j + 2); }
        const bool masked = WINDOW && (j >= sg.n_ctx);
        const int kpos0 = sg.loc_kpos0 + 64 * (j - sg.n_ctx);
        if (masked) {
            const int qlo = qpos0 + wave * 16;
            if (kpos0 > qlo + 15 + 128 || kpos0 + 63 < qlo - 128) continue;
        }
        f32x4 s[4];
        {
            lds_t* kb0 = cur + kbyte + ke0;
            lds_t* kb1 = cur + kbyte + ke1;
#pragma unroll
            for (int grp = 0; grp < 2; ++grp)
#pragma unroll
                for (int b = 0; b < 2; ++b) {
                    f32x4 a = (f32x4){0.f, 0.f, 0.f, 0.f};
#pragma unroll
                    for (int st = 0; st < DK / 32; ++st) {
                        const bf16x8 kf = lds_ld128(((st & 1) ? kb1 : kb0) + (32 * grp + 4 * b) * (DK * 2) + (st >> 1) * 128);
                        a = __builtin_amdgcn_mfma_f32_16x16x32_bf16(kf, qf[st], a, 0, 0, 0);
                    }
                    s[grp * 2 + b] = a;
                }
        }
        if (masked) {
#pragma unroll
            for (int grp = 0; grp < 2; ++grp)
#pragma unroll
                for (int b = 0; b < 2; ++b)
#pragma unroll
                    for (int r = 0; r < 4; ++r) {
                        const int kp = kpos0 + 32 * grp + 8 * g + 4 * b + r;
                        const int d = qpos - kp;
                        if (d > 128 || d < -128) s[grp * 2 + b][r] = -1.0e30f;
                    }
        }
        float mx = fmaxf(fmaxf(fmaxf(s[0][0], s[0][1]), fmaxf(s[0][2], s[0][3])), fmaxf(fmaxf(s[1][0], s[1][1]), fmaxf(s[1][2], s[1][3])));
        mx = fmaxf(mx, fmaxf(fmaxf(fmaxf(s[2][0], s[2][1]), fmaxf(s[2][2], s[2][3])), fmaxf(fmaxf(s[3][0], s[3][1]), fmaxf(s[3][2], s[3][3]))));
        mx = fmaxf(mx, __shfl_xor(mx, 16)); mx = fmaxf(mx, __shfl_xor(mx, 32));
        const float mn = fmaxf(m, mx);
        const float alpha = fexp2(m - mn);
        m = mn;
        float ps = 0.f;
#pragma unroll
        for (int i = 0; i < 4; ++i)
#pragma unroll
            for (int r = 0; r < 4; ++r) { const float pv = fexp2(s[i][r] - mn); s[i][r] = pv; ps += pv; }
        l = l * alpha + ps;
#pragma unroll
        for (int i = 0; i < DV / 16; ++i) o[i] = o[i] * alpha;
#pragma unroll
        for (int grp = 0; grp < 2; ++grp) {
            u32x4 pw;
            pw.x = pk_bf16(s[grp * 2][0], s[grp * 2][1]); pw.y = pk_bf16(s[grp * 2][2], s[grp * 2][3]);
            pw.z = pk_bf16(s[grp * 2 + 1][0], s[grp * 2 + 1][1]); pw.w = pk_bf16(s[grp * 2 + 1][2], s[grp * 2 + 1][3]);
            bf16x8 pf; __builtin_memcpy(&pf, &pw, 16);
#pragma unroll
            for (int dvb = 0; dvb < DV / 16; ++dvb) {
                const bf16x8 vf = lds_ld128(cur + C::KT_BYTES + r16 * 128 + dvb * 2048 + (((vc0 ^ (4 * grp)) ^ (dvb & 1)) << 4));
                o[dvb] = __builtin_amdgcn_mfma_f32_16x16x32_bf16(vf, pf, o[dvb], 0, 0, 0);
            }
        }
    }
    l += __shfl_xor(l, 16); l += __shfl_xor(l, 32);
    const float inv = frcp(l);
    bf16_t* orow = Op + (size_t)(wave * 16 + r16) * ldo + 4 * g;
#pragma unroll
    for (int dvb = 0; dvb < DV / 16; ++dvb) st_bf16x4(orow + dvb * 16, o[dvb] * inv);
}

struct KSrcMla { const bf16_t* KN; const bf16_t* KPE; int h;
    DEVI const bf16_t* operator()(int krow, int ch) const { return ch < 16 ? KN + (size_t)krow * 1024 + h * 128 + ch * 8 : KPE + (size_t)krow * 64 + (ch - 16) * 8; } };
struct KSrcSwa { const bf16_t* SK; int kvh;
    DEVI const bf16_t* operator()(int krow, int ch) const { return SK + (size_t)krow * 256 + kvh * 64 + ch * 8; } };

DEVI void phase_mla_attn(const Params& p, lds_t* lds, int bid, int nblk, int tid) {
    for (int u = xcd_first_unit(bid, nblk); u < 512; u += nblk) {
        if (u < 256) {
            const int b = u >> 6, h = (u >> 3) & 7, qt = u & 7;
            const int qrow0 = NPR + b * 1024 + qt * 128;
            KSrcMla ks{p.KN, p.KPE, h};
            AttnSeg sg{4, NTOK + b * 256, 0, 16, NPR + b * 1024, 256, 0};
            attn_unit<192, 128, false>(lds, p.Q + (size_t)qrow0 * 1536 + h * 192, 1536, ks, p.VTS + (size_t)(b * 8 + h) * 128 * 1280, 1280, sg, 0, 0.f, false,
                                       p.O + (size_t)qrow0 * 1024 + h * 128, 1024, tid);
        } else {
            const int v = u - 256, b = v >> 4, h = (v >> 1) & 7, qt = v & 1;
            const int qrow0 = b * 256 + qt * 128;
            KSrcMla ks{p.KN, p.KPE, h};
            AttnSeg sg{0, 0, 0, 4, b * 256, 0, 0};
            attn_unit<192, 128, false>(lds, p.Q + (size_t)qrow0 * 1536 + h * 192, 1536, ks, p.VTP + (size_t)(b * 8 + h) * 128 * 256, 256, sg, 0, 0.f, false,
                                       p.O + (size_t)qrow0 * 1024 + h * 128, 1024, tid);
        }
    }
}
DEVI void phase_swa_attn(const Params& p, lds_t* lds, int bid, int nblk, int tid) {
    for (int u = xcd_first_unit(bid, nblk); u < 1024; u += nblk) {
        const int w = u >> 8, idx = ((u >> 9) << 8) | (u & 255);
        if ((w & 1) == 0) {
            const int b = idx >> 7, hq = (idx >> 3) & 15, qt = idx & 7, kvh = hq >> 2;
            const int qs = qt * 128, qrow0 = NPR + b * 1024 + qs;
            const int lo = qs >= 128 ? qs - 128 : 0, hi = qs + 256 <= 1024 ? qs + 256 : 1024;
            KSrcSwa ks{p.SK, kvh};
            AttnSeg sg{4, NTOK + b * 256, 0, (hi - lo) >> 6, NPR + b * 1024 + lo, 256 + lo, lo};
            attn_unit<64, 64, true>(lds, p.Q + (size_t)qrow0 * 1024 + hq * 64, 1024, ks, p.SVTS + (size_t)(b * 4 + kvh) * 64 * 1280, 1280, sg, qs,
                                    p.swa_sink[hq] * LOG2E, true, p.O + (size_t)qrow0 * 1024 + hq * 64, 1024, tid);
        } else {
            const int b = idx >> 5, hq = (idx >> 1) & 15, qt = idx & 1, kvh = hq >> 2;
            const int qrow0 = b * 256 + qt * 128;
            KSrcSwa ks{p.SK, kvh};
            AttnSeg sg{0, 0, 0, 4, b * 256, 0, 0};
            attn_unit<64, 64, false>(lds, p.Q + (size_t)qrow0 * 1024 + hq * 64, 1024, ks, p.SVTP + (size_t)(b * 4 + kvh) * 64 * 256, 256, sg, 0,
                                     p.swa_sink[hq] * LOG2E, true, p.O + (size_t)qrow0 * 1024 + hq * 64, 1024, tid);
        }
    }
}

DEVI void phase_gm_spatial(const Params& p, lds_t* lds, int bid, int nblk, int tid) {
    const int lane = tid & 63, wave = tid >> 6, r16 = lane & 15, g = lane >> 4, wr = wave >> 2, wc = wave & 3;
    lds_t* aimg = lds;
    lds_t* vimg = lds + 32768;
    LAS float* mean = (LAS float*)(lds + 65536);
    LAS float* rstd = mean + 128;
    LAS float* biasp = rstd + 128;
    LAS float* bpart = biasp + 128;
    for (int u = xcd_first_unit(bid, nblk); u < 512; u += nblk) {
        const int chunk = u >> 3, grp = u & 7;
        __syncthreads();
        if (tid < 128) {
            const float* gs = p.GST + (size_t)(chunk * 128 + tid) * 96;
            float s = 0.f, q = 0.f;
            for (int i = 0; i < 48; ++i) { s += gs[2 * i]; q += gs[2 * i + 1]; }
            const float mu = s * (1.0f / 3072.0f);
            const float var = q * (1.0f / 3072.0f) - mu * mu;
            mean[tid] = mu; rstd[tid] = rsqrtf(fmaxf(var, 0.f) + EPS_F);
        }
        __syncthreads();
        {
            const int n = tid >> 2, mq = tid & 3;
            const float* ws = p.gm_w_s + ((size_t)grp * 128 + n) * 128 + mq * 32;
            float bp = 0.f;
#pragma unroll
            for (int c4 = 0; c4 < 4; ++c4) {
                const f32x4 w0 = *(const f32x4*)(ws + c4 * 8), w1 = *(const f32x4*)(ws + c4 * 8 + 4);
                const int m0 = mq * 32 + c4 * 8;
                float a[8];
#pragma unroll
                for (int i = 0; i < 4; ++i) { a[i] = w0[i] * rstd[m0 + i]; a[4 + i] = w1[i] * rstd[m0 + 4 + i]; }
                u32x4 v; v.x = pk_bf16(a[0], a[1]); v.y = pk_bf16(a[2], a[3]); v.z = pk_bf16(a[4], a[5]); v.w = pk_bf16(a[6], a[7]);
#pragma unroll
                for (int i = 0; i < 4; ++i) { const unsigned wd = i == 0 ? v.x : i == 1 ? v.y : i == 2 ? v.z : v.w; bp += bf_lo(wd) * mean[m0 + 2 * i] + bf_hi(wd) * mean[m0 + 2 * i + 1]; }
                const int kc = m0 >> 3;
                lds_st128(aimg + (kc >> 3) * 16384 + img_off(n, kc & 7), v);
            }
            bpart[mq * 128 + n] = bp;
        }
        __syncthreads();
        if (tid < 128) biasp[tid] = bpart[tid] + bpart[128 + tid] + bpart[256 + tid] + bpart[384 + tid];
        for (int cs = 0; cs < 3; ++cs) {
            __syncthreads();
            {
                const bf16_t* src = p.GVT + ((size_t)chunk * 3072 + grp * 384 + cs * 128) * 128;
#pragma unroll
                for (int i = 0; i < 4; ++i) { const int c = tid + NTHREADS * i, row = c >> 4, kc = c & 15;
                    const u32x4 v = *(const u32x4*)(src + (size_t)row * 128 + kc * 8);
                    lds_st128(vimg + (kc >> 3) * 16384 + img_off(row, kc & 7), v); }
            }
            __syncthreads();
            f32x4 acc[4][2];
#pragma unroll
            for (int i = 0; i < 4; ++i) { acc[i][0] = (f32x4){0.f, 0.f, 0.f, 0.f}; acc[i][1] = acc[i][0]; }
#pragma unroll
            for (int kh = 0; kh < 2; ++kh)
#pragma unroll
                for (int s = 0; s < 2; ++s) {
                    bf16x8 af[4], vf[2];
#pragma unroll
                    for (int mb = 0; mb < 4; ++mb) af[mb] = lds_ld128(aimg + kh * 16384 + img_off(wr * 64 + mb * 16 + r16, 4 * s + g));
#pragma unroll
                    for (int nb = 0; nb < 2; ++nb) vf[nb] = lds_ld128(vimg + kh * 16384 + img_off(wc * 32 + nb * 16 + r16, 4 * s + g));
#pragma unroll
                    for (int mb = 0; mb < 4; ++mb)
#pragma unroll
                        for (int nb = 0; nb < 2; ++nb) acc[mb][nb] = __builtin_amdgcn_mfma_f32_16x16x32_bf16(vf[nb], af[mb], acc[mb][nb], 0, 0, 0);
                }
#pragma unroll
            for (int mb = 0; mb < 4; ++mb) {
                const int n = wr * 64 + mb * 16 + r16;
                const float bp = biasp[n], bs = p.gm_b_s[grp * 128 + n];
                const size_t row = (size_t)chunk * 128 + n;
#pragma unroll
                for (int nb = 0; nb < 2; ++nb) {
                    const int col = grp * 384 + cs * 128 + wc * 32 + nb * 16 + 4 * g;
                    const f32x4 gn = *(const f32x4*)(p.gm_v_gain + col);
                    const u32x2 uw = *(const u32x2*)(p.U + row * 3072 + col);
                    f32x4 t;
                    t[0] = bf_lo(uw.x) * (gn[0] * (acc[mb][nb][0] - bp) + bs);
                    t[1] = bf_hi(uw.x) * (gn[1] * (acc[mb][nb][1] - bp) + bs);
                    t[2] = bf_lo(uw.y) * (gn[2] * (acc[mb][nb][2] - bp) + bs);
                    t[3] = bf_hi(uw.y) * (gn[3] * (acc[mb][nb][3] - bp) + bs);
                    st_bf16x4(p.TT + row * 3072 + col, t);
                }
            }
        }
    }
}

constexpr int N_PHASES = 2 + 10 * DEPTH;
__global__ void __launch_bounds__(NTHREADS, 2) fwd_kernel(Params p_kernarg) {
    extern __shared__ __attribute__((aligned(16))) unsigned char smem[];
    lds_t* lds = (lds_t*)smem;
    const int tid0 = threadIdx.x, bid0 = blockIdx.x, nblk0 = gridDim.x;
    const int wave0 = __builtin_amdgcn_readfirstlane(tid0 >> 6);
    volatile LAS unsigned* misc = (volatile LAS unsigned*)(lds + LDS_MAIN);
    if (tid0 == 0) { misc[0] = 0u; misc[1] = 0u; misc[2] = 0u; misc[3] = 0u; }
    __syncthreads();
    typedef const __attribute__((address_space(4))) Params* kparams_t;
    kparams_t pp = (kparams_t)__builtin_amdgcn_kernarg_segment_ptr();
    const int lo = (int)pp->ph_lo, hi = (int)pp->ph_hi;
    XcdBarrier bar; bar.bar = pp->bar; bar.x = 0; bar.st = misc;
    if (hi - lo > 1) bar = xcd_barrier_post(bar.bar, misc);
#define IN(k) (lo <= (k) && (k) < hi)
#ifndef REP_MASK
#define REP_MASK 0
#endif
#define RUN(k, knext, cls, body) do { if (IN(k)) { { asm volatile("" : "+s"(pp)); Params p; __builtin_memcpy(&p, pp, sizeof(Params)); \
        int tid = wave0 * 64 + (int)__builtin_amdgcn_mbcnt_hi(~0u, __builtin_amdgcn_mbcnt_lo(~0u, 0u)), bid = bid0, nblk = nblk0; asm volatile("" : "+v"(tid)); asm volatile("" : "+s"(bid), "+s"(nblk)); body; \
        if ((REP_MASK) & (cls)) { asm volatile("" : "+v"(tid)); body; } } if (IN(knext)) { xcd_barrier(bar); if ((REP_MASK) & 8192) xcd_barrier(bar); } } } while (0)
    RUN(0, 1, 64, { phase_modulation(p, lds, bid, nblk, tid); phase_wconv(p, lds, bid, nblk, tid); });
    RUN(1, 2, 512, phase_prep(p, bid, nblk, tid));
#pragma unroll 1
    for (int li = 0; li < DEPTH; ++li) {
        const int kind = li % 3, j = li / 3, base = 2 + 10 * li;
        if (kind == 0) {
            RUN(base + 0, base + 1, 32, phase_mla_win(p, j, lds, bid, nblk, tid));
            RUN(base + 1, base + 2, 1024, phase_mla_norm(p, j, bid, nblk, tid));
            RUN(base + 2, base + 3, 32, phase_mla_up(p, j, lds, bid, nblk, tid));
            RUN(base + 3, base + 4, 16, phase_mla_attn(p, lds, bid, nblk, tid));
            RUN(base + 4, base + 5, 8, phase_out_proj(p, li, p.O, 1024, p.WTO + (size_t)j * 1024 * 1024, lds, bid, nblk, tid));
        } else if (kind == 1) {
            RUN(base + 0, base + 1, 4, phase_gm_win(p, lds, bid, nblk, tid));
            RUN(base + 1, base + 2, 128, phase_gm_spatial(p, lds, bid, nblk, tid));
            RUN(base + 2, base + 5, 8, phase_out_proj(p, li, p.TT, 3072, p.WTGO, lds, bid, nblk, tid));
        } else {
            RUN(base + 0, base + 1, 32, phase_swa_qkv(p, lds, bid, nblk, tid));
            RUN(base + 1, base + 2, 16, phase_swa_attn(p, lds, bid, nblk, tid));
            RUN(base + 2, base + 5, 8, phase_out_proj(p, li, p.O, 1024, p.WTSO, lds, bid, nblk, tid));
        }
        RUN(base + 5, base + 6, 2048, phase_ln_a(p, li, lds, bid, nblk, tid));
        RUN(base + 6, base + 7, 256, phase_topk(p, lds, bid, nblk, tid));
        RUN(base + 7, base + 8, 1, phase_moe_up(p, li, lds, bid, nblk, tid));
        RUN(base + 8, base + 9, 2, phase_moe_down(p, li, lds, bid, nblk, tid));
        RUN(base + 9, base + 10, 4096, phase_ln_b(p, li, bid, nblk, tid));
    }
#undef IN
#undef RUN
}

#ifdef PROBE_V
__global__ void __launch_bounds__(NTHREADS, 2) probe_kernel(Params p) {
    extern __shared__ __attribute__((aligned(16))) unsigned char smem[];
    lds_t* lds = (lds_t*)smem;
    const int tid = threadIdx.x, bid = blockIdx.x, nblk = gridDim.x;
#if PROBE_V < 1000
    if (PROBE_V == 1) phase_mla_attn(p, lds, bid, nblk, tid);
    else if (PROBE_V == 2) phase_swa_attn(p, lds, bid, nblk, tid);
    else if (PROBE_V == 3) phase_gm_spatial(p, lds, bid, nblk, tid);
    else if (PROBE_V == 4) phase_ln_a(p, 3, lds, bid, nblk, tid);
    else if (PROBE_V == 5) phase_mla_up(p, 1, lds, bid, nblk, tid);
    else phase_moe_up<0>(p, 0, lds, bid, nblk, tid);
#else
    const int lane = tid & 63, wave = tid >> 6;
    const int u0 = xcd_first_unit(bid, nblk);
    f32x4 acc = (f32x4){0.f, 0.f, 0.f, 0.f};
    for (int u = u0; u < 1024; u += nblk) {
        const int e = u >> 6, w = u & 63, nt = w >> 2;
        const float* wp = p.moe_w_gate + (size_t)e * 1024 * 2048 + nt * 128 + 4 * lane + (size_t)(8 * wave) * 2048;
        const bf16_t* xp = p.H2 + (size_t)((u * 37 + wave * 8 + (lane >> 3)) & 8191) * 1024 + (lane & 7) * 8;
#pragma unroll 2
        for (int kt = 0; kt < 16; ++kt) {
            const float* q = wp + (size_t)((PROBE_V & 1) ? 0 : ((PROBE_V & 4) ? ((kt + (w & 3) * ((PROBE_V >> 4) & 7)) & 15) : ((PROBE_V & 8) ? (kt & 3) : kt))) * 64 * 2048;
#pragma unroll
            for (int i = 0; i < 8; ++i) acc += *(const f32x4*)(q + (size_t)i * 2048);
            if (PROBE_V & 2) {
#pragma unroll
                for (int j = 0; j < 4; ++j) { const u32x4 x = *(const u32x4*)(xp + (size_t)j * 64 * 1024 + kt * 64); acc[0] += __uint_as_float(x.x & 0x3f800000u); }
            }
        }
    }
    if (acc[0] + acc[1] + acc[2] + acc[3] == 12345.678f) p.GST[tid] = acc[0];
#endif
}
#endif
extern "C" void kernel_launch(void* const* d_in, const int* in_sizes, int n_in, void* d_out, int out_size, void* d_ws, size_t ws_size, hipStream_t stream) {
    static int grid = 0;
    if (grid == 0) {
        int dev = 0, cus = 0, per_cu = 0;
        if (hipGetDevice(&dev) != hipSuccess || hipDeviceGetAttribute(&cus, hipDeviceAttributeMultiprocessorCount, dev) != hipSuccess) { fprintf(stderr, "kernel_launch: device query failed\n"); grid = -1; return; }
        if (hipFuncSetAttribute((const void*)fwd_kernel, hipFuncAttributeMaxDynamicSharedMemorySize, LDS_BYTES) != hipSuccess) { fprintf(stderr, "kernel_launch: hipFuncSetAttribute failed\n"); grid = -1; return; }
        if (hipOccupancyMaxActiveBlocksPerMultiprocessor(&per_cu, (const void*)fwd_kernel, NTHREADS, LDS_BYTES) != hipSuccess || per_cu < 1) {
            fprintf(stderr, "kernel_launch: occupancy query reports %d blocks per CU\n", per_cu); (void)hipGetLastError(); per_cu = 1; }
        grid = cus;
    }
    if (grid < 0) return;
    unsigned char* ws = (unsigned char*)d_ws;
    size_t off = 0;
    auto take = [&](size_t bytes) { unsigned char* r = ws + off; off += (bytes + 255) & ~(size_t)255; return r; };
    Params p{};
    const float* const* in = (const float* const*)d_in;
    p.x_prompt = in[0]; p.x_sample = in[1]; p.cache_ckv = in[2]; p.cache_kpe = in[3]; p.cache_k = in[4]; p.cache_v = in[5]; p.c = in[6]; p.c_ctx = in[7];
    p.mod_w = in[8]; p.mod_b = in[9]; p.ln_gain = in[10]; p.ln_bias = in[11];
    p.mla_w_in = in[12]; p.mla_q_gain = in[13]; p.mla_kv_gain = in[14]; p.mla_w_q_up = in[15]; p.mla_w_kv_up = in[16]; p.mla_w_out = in[17];
    p.gm_w_in = in[18]; p.gm_v_gain = in[19]; p.gm_w_s = in[20]; p.gm_b_s = in[21]; p.gm_w_out = in[22];
    p.swa_w_qkv = in[23]; p.swa_sink = in[24]; p.swa_w_out = in[25];
    p.moe_router = in[26]; p.moe_w_gate = in[27]; p.moe_w_up = in[28]; p.moe_w_down = in[29];
    p.out = (float*)d_out;
    p.bar = (unsigned*)take(16384);
    p.mod = (float*)take((size_t)DEPTH * 5 * 6144 * 4);
    p.X0 = (float*)take((size_t)NTOK * D * 4); p.X1 = (float*)take((size_t)NTOK * D * 4); p.T = (float*)take((size_t)NTOK * D * 4);
    p.Z = (float*)take((size_t)NTOK * 704 * 4); p.GST = (float*)take((size_t)NTOK * 96 * 4); p.AFF = (float*)take((size_t)NTOK * 16 * 4); p.GATEV = (float*)take(16 * 1024 * 4);
    p.H = (bf16_t*)take((size_t)NTOK * D * 2); p.H2 = (bf16_t*)take((size_t)NTOK * D * 2);
    p.CQ = (bf16_t*)take((size_t)NTOK * 384 * 2); p.CKV = (bf16_t*)take((size_t)NROWS_KV * 256 * 2); p.KPE = (bf16_t*)take((size_t)NROWS_KV * 64 * 2);
    p.Q = (bf16_t*)take((size_t)NTOK * 1536 * 2); p.KN = (bf16_t*)take((size_t)NROWS_KV * 1024 * 2);
    p.VTP = (bf16_t*)take((size_t)16 * 8 * 128 * 256 * 2); p.VTS = (bf16_t*)take((size_t)4 * 8 * 128 * 1280 * 2);
    p.O = (bf16_t*)take((size_t)NTOK * D * 2);
    p.U = (bf16_t*)take((size_t)NTOK * 3072 * 2); p.GVT = (bf16_t*)take((size_t)NTOK * 3072 * 2); p.TT = (bf16_t*)take((size_t)NTOK * 3072 * 2);
    p.SK = (bf16_t*)take((size_t)NROWS_KV * 256 * 2); p.SVTP = (bf16_t*)take((size_t)16 * 4 * 64 * 256 * 2); p.SVTS = (bf16_t*)take((size_t)4 * 4 * 64 * 1280 * 2);
    p.HID = (bf16_t*)take((size_t)16 * 1024 * 2048 * 2); p.YE = (bf16_t*)take((size_t)16 * 1024 * 1024 * 2);
    p.SEL = (int*)take((size_t)NTOK * 16 * 4); p.IDX = (int*)take(16 * 1024 * 4);
    p.WTI = (bf16_t*)take((size_t)2 * 704 * 1024 * 2); p.WTQ = (bf16_t*)take((size_t)2 * 1536 * 384 * 2); p.WTKV = (bf16_t*)take((size_t)2 * 2048 * 256 * 2); p.WTO = (bf16_t*)take((size_t)2 * 1024 * 1024 * 2);
    p.WTGI = (bf16_t*)take((size_t)6144 * 1024 * 2); p.WTGO = (bf16_t*)take((size_t)1024 * 3072 * 2); p.WTSQ = (bf16_t*)take((size_t)1536 * 1024 * 2); p.WTSO = (bf16_t*)take((size_t)1024 * 1024 * 2);
    if (off > ws_size) { fprintf(stderr, "kernel_launch: workspace too small: need %zu, have %zu\n", off, ws_size); return; }
    (void)in_sizes; (void)n_in; (void)out_size;
    if (hipMemsetAsync(p.bar, 0, 16384, stream) != hipSuccess) { fprintf(stderr, "kernel_launch: memset failed\n"); return; }
#if N_LAUNCH_PER_PHASE
#ifndef MAX_PHASE
#define MAX_PHASE N_PHASES
#endif
    for (int k = 0; k < MAX_PHASE; ++k) {
        if (k >= 2) { const int li = (k - 2) / 10, s = (k - 2) % 10, kind = li % 3; if (kind != 0 && (s == 3 || s == 4)) continue; }
        p.ph_lo = k; p.ph_hi = k + 1;
        hipLaunchKernelGGL(fwd_kernel, dim3(grid), dim3(NTHREADS), LDS_BYTES, stream, p);
    }
#else
    p.ph_lo = 0; p.ph_hi = N_PHASES;
    hipLaunchKernelGGL(fwd_kernel, dim3(grid), dim3(NTHREADS), LDS_BYTES, stream, p);
#endif
#ifdef PROBE_V
    { static int once = 0; if (!once) { once = 1; (void)hipFuncSetAttribute((const void*)probe_kernel, hipFuncAttributeMaxDynamicSharedMemorySize, LDS_BYTES); }
      hipLaunchKernelGGL(probe_kernel, dim3(grid), dim3(NTHREADS), LDS_BYTES, stream, p); }
#endif
    const hipError_t le = hipPeekAtLastError();
    if (le != hipSuccess) fprintf(stderr, "kernel_launch: launch failed: %s\n", hipGetErrorName(le));
}
```

```cpp
#include <hip/hip_runtime.h>
#include <stdint.h>
#include <stdio.h>

#ifndef N_LAUNCH_PER_PHASE
#define N_LAUNCH_PER_PHASE 0
#endif

#define DEVI __device__ __forceinline__
#define LAS __attribute__((address_space(3)))
typedef unsigned short bf16_t;
typedef short bf16x8 __attribute__((ext_vector_type(8)));
typedef float f32x4 __attribute__((ext_vector_type(4)));
typedef float f32x2 __attribute__((ext_vector_type(2)));
typedef unsigned u32x4 __attribute__((ext_vector_type(4)));
typedef unsigned u32x2 __attribute__((ext_vector_type(2)));
typedef LAS unsigned char lds_t;

constexpr int D = 1024;
constexpr int NTOK = 8192, NPR = 4096;
constexpr int NROWS_KV = 9216;
constexpr int DEPTH = 4;
constexpr float ALPHA_F = 1.681792830507429f;
constexpr float EPS_F = 1e-6f;
constexpr float LOG2E = 1.4426950408889634f;
constexpr int NTHREADS = 512;
constexpr int LDS_MAIN = 147456;
constexpr int LDS_BYTES = LDS_MAIN + 1024;

__device__ const float rope_tab[64 * 16 * 2] = {
1.000000000e+00f,0.000000000e+00f,1.000000000e+00f,0.000000000e+00f,1.000000000e+00f,0.000000000e+00f,1.000000000e+00f,0.000000000e+00f,1.000000000e+00f,0.000000000e+00f,1.000000000e+00f,0.000000000e+00f,1.000000000e+00f,0.000000000e+00f,1.000000000e+00f,0.000000000e+00f,1.000000000e+00f,0.000000000e+00f,1.000000000e+00f,0.000000000e+00f,1.000000000e+00f,0.000000000e+00f,1.000000000e+00f,0.000000000e+00f,1.000000000e+00f,0.000000000e+00f,1.000000000e+00f,0.000000000e+00f,1.000000000e+00f,0.000000000e+00f,1.000000000e+00f,0.000000000e+00f,
5.403023059e-01f,8.414709848e-01f,8.460091064e-01f,5.331684460e-01f,9.504152809e-01f,3.109835909e-01f,9.842302348e-01f,1.768921847e-01f,9.950041651e-01f,9.983341813e-02f,9.984192778e-01f,5.620449919e-02f,9.995000417e-01f,3.161750470e-02f,9.998418903e-01f,1.778185709e-02f,9.999500004e-01f,9.999833111e-03f,9.999841887e-01f,5.623383612e-03f,9.999950000e-01f,3.162272359e-03f,9.999984189e-01f,1.778278494e-03f,9.999995000e-01f,9.999998808e-04f,9.999998419e-01f,5.623412721e-04f,9.999999500e-01f,3.162277519e-04f,9.999999842e-01f,1.778279393e-04f,
-4.161468365e-01f,9.092974268e-01f,4.314628163e-01f,9.021307212e-01f,8.065784124e-01f,5.911271138e-01f,9.374183100e-01f,3.482052729e-01f,9.800665772e-01f,1.986693337e-01f,9.936821085e-01f,1.122313110e-01f,9.980006668e-01f,6.320339453e-02f,9.993676111e-01f,3.555809121e-02f,9.998000067e-01f,1.999866625e-02f,9.999367551e-01f,1.124658940e-02f,9.999800001e-01f,6.324513096e-03f,9.999936755e-01f,3.556551364e-03f,9.999980000e-01f,1.999998762e-03f,9.999993675e-01f,1.124682366e-03f,9.999998000e-01f,6.324554721e-04f,9.999999368e-01f,3.556558729e-04f,
-9.899924966e-01f,1.411200081e-01f,-1.159661631e-01f,9.932531646e-01f,5.827536401e-01f,8.126488756e-01f,8.610406595e-01f,5.085361174e-01f,9.553364856e-01f,2.955202180e-01f,9.858034692e-01f,1.679033061e-01f,9.955033745e-01f,9.472608625e-02f,9.985773124e-01f,5.332308304e-02f,9.995500338e-01f,2.999549953e-02f,9.998577009e-01f,1.686943954e-02f,9.999550003e-01f,9.486690354e-03f,9.999857698e-01f,5.334812988e-03f,9.999955000e-01f,2.999995526e-03f,9.999985770e-01f,1.687023105e-03f,9.999995500e-01f,9.486831000e-04f,9.999998577e-01f,5.334837808e-04f,
-6.536436209e-01f,-7.568024953e-01f,-6.276796763e-01f,7.784717233e-01f,3.011374707e-01f,9.535807379e-01f,7.575061759e-01f,6.528279969e-01f,9.210609917e-01f,3.894183478e-01f,9.748082657e-01f,2.230444915e-01f,9.920106618e-01f,1.261540598e-01f,9.974712443e-01f,7.107120934e-02f,9.992001067e-01f,3.998933329e-02f,9.997470285e-01f,2.249175622e-02f,9.999200011e-01f,1.264877321e-02f,9.999747019e-01f,7.113057742e-03f,9.999920000e-01f,3.999989523e-03f,9.999974702e-01f,2.249363310e-03f,9.999992000e-01f,1.264910691e-03f,9.999997470e-01f,7.113117008e-04f,
2.836621855e-01f,-9.589242747e-01f,-9.460792425e-01f,3.239352821e-01f,-1.034233808e-02f,9.999465166e-01f,6.300802992e-01f,7.765299843e-01f,8.775825619e-01f,4.794255386e-01f,9.607312596e-01f,2.774805341e-01f,9.875260225e-01f,1.574558824e-01f,9.960497565e-01f,8.879686156e-02f,9.987502605e-01f,4.997916629e-02f,9.996047413e-01f,2.811336165e-02f,9.998750026e-01f,1.581072865e-02f,9.999604718e-01f,8.891280002e-03f,9.999875000e-01f,4.999979521e-03f,9.999960472e-01f,2.811702920e-03f,9.999987500e-01f,1.581138156e-03f,9.999996047e-01f,8.891395984e-04f,
9.601702867e-01f,-2.794154982e-01f,-9.731036980e-01f,-2.303675170e-01f,-3.207963899e-01f,9.471481807e-01f,4.827820346e-01f,8.757405478e-01f,8.253356014e-01f,5.646424931e-01f,9.436169596e-01f,3.310393232e-01f,9.820539372e-01f,1.886002770e-01f,9.943132976e-01f,1.064944419e-01f,9.982005400e-01f,5.996400514e-02f,9.994308440e-01f,3.373407806e-02f,9.998200054e-01f,1.897252691e-02f,9.999430795e-01f,1.066947415e-02f,9.999820001e-01f,5.999964052e-03f,9.999943079e-01f,3.374041408e-03f,9.999982000e-01f,1.897365346e-03f,9.999994308e-01f,1.066967410e-03f,
7.539022543e-01f,6.569865987e-01f,-7.004298139e-01f,-7.137212872e-01f,-5.994374526e-01f,8.004216016e-01f,3.202570024e-01f,9.473306986e-01f,7.648421950e-01f,6.442176781e-01f,9.235194568e-01f,3.835515778e-01f,9.755998794e-01f,2.195560870e-01f,9.922624183e-01f,1.241583392e-01f,9.975510002e-01f,6.994284763e-02f,9.992253421e-01f,3.935372584e-02f,9.997550100e-01f,2.213413545e-02f,9.999225252e-01f,1.244763455e-02f,9.999755001e-01f,6.999943050e-03f,9.999922524e-01f,3.936378830e-03f,9.999975500e-01f,2.213592463e-03f,9.999992252e-01f,1.244795304e-03f,
-1.455000338e-01f,9.893582466e-01f,-2.120364479e-01f,-9.772617586e-01f,-8.186324475e-01f,5.743177830e-01f,1.476312130e-01f,9.890424788e-01f,6.967067008e-01f,7.173560992e-01f,9.005023096e-01f,4.348512278e-01f,9.681703064e-01f,2.502923447e-01f,9.898977664e-01f,1.417829752e-01f,9.968017064e-01f,7.991469219e-02f,9.989882418e-01f,4.497213288e-02f,9.996800171e-01f,2.529552265e-02f,9.998988088e-01f,1.422575559e-02f,9.999680002e-01f,7.999915047e-03f,9.999898807e-01f,4.498715239e-03f,9.999968000e-01f,2.529819359e-03f,9.999989881e-01f,1.422623042e-03f,
-9.111302619e-01f,4.121184852e-01f,3.416602554e-01f,-9.398235313e-01f,-9.566441680e-01f,2.912592245e-01f,-2.965079623e-02f,9.995603185e-01f,6.216099403e-01f,7.833269319e-01f,8.746382611e-01f,4.847761465e-01f,9.597726443e-01f,2.807783310e-01f,9.872200896e-01f,1.593627767e-01f,9.959527334e-01f,8.987854534e-02f,9.987195508e-01f,5.058911778e-02f,9.995950273e-01f,2.845665689e-02f,9.998719305e-01f,1.600383071e-02f,9.999595003e-01f,8.999879044e-03f,9.999871928e-01f,5.061050226e-03f,9.999959500e-01f,2.846046001e-03f,9.999987193e-01f,1.600450735e-03f,
-8.390715291e-01f,-5.440211109e-01f,7.901318660e-01f,-6.129368926e-01f,-9.997860721e-01f,-2.068356987e-02f,-2.059976331e-01f,9.785524897e-01f,5.403023059e-01f,8.414709848e-01f,8.460091064e-01f,5.331684460e-01f,9.504152902e-01f,3.109835626e-01f,9.842302348e-01f,1.768921847e-01f,9.950041659e-01f,9.983341072e-02f,9.984192778e-01f,5.620449919e-02f,9.995000417e-01f,3.161750470e-02f,9.998418903e-01f,1.778185709e-02f,9.999500004e-01f,9.999834042e-03f,9.999841887e-01f,5.623383612e-03f,9.999950000e-01f,3.162272359e-03f,9.999984189e-01f,1.778278494e-03f,
4.425697988e-03f,-9.999902066e-01f,9.952573993e-01f,-9.727645772e-02f,-9.437797393e-01f,-3.305749593e-01f,-3.758474003e-01f,9.266815697e-01f,4.535961002e-01f,8.912073709e-01f,8.147053420e-01f,5.798751639e-01f,9.401075903e-01f,3.408778647e-01f,9.809291472e-01f,1.943656558e-01f,9.939560980e-01f,1.097783002e-01f,9.980874321e-01f,6.181810327e-02f,9.993950610e-01f,3.477804006e-02f,9.998086883e-01f,1.955982724e-02f,9.999395006e-01f,1.099977904e-02f,9.999808683e-01f,6.185714754e-03f,9.999939500e-01f,3.478498401e-03f,9.999980868e-01f,1.956106080e-03f,
8.438539587e-01f,-5.365729180e-01f,8.938616142e-01f,4.483429653e-01f,-7.941793525e-01f,-6.076834341e-01f,-5.338430142e-01f,8.455836068e-01f,3.623577100e-01f,9.320391032e-01f,7.808259330e-01f,6.247486393e-01f,9.288598710e-01f,3.704312892e-01f,9.773178677e-01f,2.117776794e-01f,9.928086362e-01f,1.197122046e-01f,9.977240240e-01f,6.742975621e-02f,9.992800864e-01f,3.793822392e-02f,9.997723246e-01f,2.133773367e-02f,9.999280009e-01f,1.199971211e-02f,9.999772317e-01f,6.748044406e-03f,9.999928000e-01f,3.794723862e-03f,9.999977232e-01f,2.133933605e-03f,
9.074467815e-01f,4.201670368e-01f,5.171728454e-01f,8.558809777e-01f,-5.658204930e-01f,-8.245284529e-01f,-6.750016657e-01f,7.378162043e-01f,2.674987597e-01f,9.635582046e-01f,7.444779872e-01f,6.676470075e-01f,9.166833698e-01f,3.996143135e-01f,9.733975442e-01f,2.291227201e-01f,9.915618943e-01f,1.296341379e-01f,9.973290651e-01f,7.303927684e-02f,9.991551190e-01f,4.109803212e-02f,9.997327995e-01f,2.311557262e-02f,9.999155012e-01f,1.299963410e-02f,9.999732789e-01f,7.310371924e-03f,9.999915500e-01f,4.110949176e-03f,9.999973279e-01f,2.311761062e-03f,
1.367372182e-01f,9.906073557e-01f,-1.879615160e-02f,9.998233367e-01f,-2.813494808e-01f,-9.596053718e-01f,-7.948709048e-01f,6.067785796e-01f,1.699671664e-01f,9.854497259e-01f,7.057763743e-01f,7.084346897e-01f,9.035902493e-01f,4.283977840e-01f,9.691694136e-01f,2.463953078e-01f,9.902159961e-01f,1.395431152e-01f,9.969025685e-01f,7.864648034e-02f,9.990201601e-01f,4.425742562e-02f,9.996901128e-01f,2.489334034e-02f,9.999020016e-01f,1.399954310e-02f,9.999690098e-01f,7.872696665e-03f,9.999902000e-01f,4.427174080e-03f,9.999969010e-01f,2.489588678e-03f,
-7.596879129e-01f,6.502878402e-01f,-5.489754720e-01f,8.358384600e-01f,3.102235090e-02f,-9.995186910e-01f,-8.896704271e-01f,4.566032536e-01f,7.073720167e-02f,9.974949866e-01f,6.648435293e-01f,7.469826514e-01f,8.895936264e-01f,4.567528653e-01f,9.646348168e-01f,2.635899662e-01f,9.887710793e-01f,1.494381236e-01f,9.964445467e-01f,8.425120425e-02f,9.988752109e-01f,4.741638026e-02f,9.996442648e-01f,2.667102934e-02f,9.998875021e-01f,1.499943810e-02f,9.999644246e-01f,8.435019847e-03f,9.999887500e-01f,4.743398540e-03f,9.999964424e-01f,2.667415984e-03f,
-9.576594803e-01f,-2.879033167e-01f,-9.100810896e-01f,4.144302238e-01f,3.403181682e-01f,-9.403103447e-01f,-9.564100499e-01f,2.920270818e-01f,-2.919954613e-02f,9.995736023e-01f,6.218088193e-01f,7.831690700e-01f,8.747074844e-01f,4.846512321e-01f,9.597951759e-01f,2.807013010e-01f,9.872272839e-01f,1.593182031e-01f,9.959550145e-01f,8.985326392e-02f,9.987202731e-01f,5.057485702e-02f,9.995952558e-01f,2.844863214e-02f,9.998720027e-01f,1.599931810e-02f,9.999595231e-01f,8.997339431e-03f,9.999872000e-01f,5.059622526e-03f,9.999959523e-01f,2.845243204e-03f,
-2.751633381e-01f,-9.613974919e-01f,-9.908979596e-01f,-1.346151313e-01f,6.158647923e-01f,-7.878518627e-01f,-9.929849841e-01f,1.182405237e-01f,-1.288445416e-01f,9.916648043e-01f,5.768082960e-01f,8.168795441e-01f,8.589467084e-01f,5.120649883e-01f,9.546520286e-01f,2.977238725e-01f,9.855847666e-01f,1.691823508e-01f,9.954339876e-01f,9.545248218e-02f,9.985553481e-01f,5.373282803e-02f,9.995430857e-01f,3.022614497e-02f,9.998555035e-01f,1.699918210e-02f,9.999543054e-01f,9.559656169e-03f,9.999855500e-01f,5.375846007e-03f,9.999954305e-01f,3.023070335e-03f,
6.603167082e-01f,-7.509872468e-01f,-7.665365398e-01f,-6.422006954e-01f,8.303361283e-01f,-5.572628770e-01f,-9.982416606e-01f,-5.927551864e-02f,-2.272021643e-01f,9.738476146e-01f,5.299841756e-01f,8.480075316e-01f,8.423270577e-01f,5.389667224e-01f,9.492070108e-01f,3.146522695e-01f,9.838436942e-01f,1.790295658e-01f,9.948814823e-01f,1.010486820e-01f,9.983804374e-01f,5.689026544e-02f,9.994877548e-01f,3.200356222e-02f,9.998380044e-01f,1.799902910e-02f,9.999487715e-01f,1.012197082e-02f,9.999838000e-01f,5.692068949e-03f,9.999948771e-01f,3.200897370e-03f,
9.887046182e-01f,1.498772097e-01f,-3.060954058e-01f,-9.520008417e-01f,9.624637956e-01f,-2.714100995e-01f,-9.720142724e-01f,-2.349218044e-01f,-3.232895443e-01f,9.463000954e-01f,4.814845890e-01f,8.764545570e-01f,8.248651506e-01f,5.653295351e-01f,9.434618259e-01f,3.314811956e-01f,9.820042356e-01f,1.888588926e-01f,9.942975170e-01f,1.066416789e-01f,9.981955430e-01f,6.004713022e-02f,9.994292631e-01f,3.378088199e-02f,9.998195054e-01f,1.899885811e-02f,9.999429214e-01f,1.068428133e-02f,9.999819501e-01f,6.008291323e-03f,9.999942921e-01f,3.378724537e-03f,
4.080820618e-01f,9.129452507e-01f,2.486167313e-01f,-9.686019414e-01f,9.991443799e-01f,4.135829015e-02f,-9.151299503e-01f,-4.031589936e-01f,-4.161468365e-01f,9.092974268e-01f,4.314628163e-01f,9.021307212e-01f,8.065784476e-01f,5.911270657e-01f,9.374183100e-01f,3.482052729e-01f,9.800665802e-01f,1.986693191e-01f,9.936821085e-01f,1.122313110e-01f,9.980006668e-01f,6.320339453e-02f,9.993676111e-01f,3.555809121e-02f,9.998000066e-01f,1.999866811e-02f,9.999367551e-01f,1.124658940e-02f,9.999800001e-01f,6.324513096e-03f,9.999936755e-01f,3.556551364e-03f,
-5.477292602e-01f,8.366556385e-01f,7.267602563e-01f,-6.868912067e-01f,9.367404516e-01f,3.500247509e-01f,-8.293829489e-01f,-5.586805205e-01f,-5.048462281e-01f,8.632092944e-01f,3.800769984e-01f,9.249548504e-01f,7.874851971e-01f,6.163335658e-01f,9.310783539e-01f,3.648192688e-01f,9.780309161e-01f,2.084598934e-01f,9.930352772e-01f,1.178173940e-01f,9.977958103e-01f,6.635903053e-02f,9.993027988e-01f,3.733518799e-02f,9.997795081e-01f,2.099845811e-02f,9.999302726e-01f,1.180889298e-02f,9.999779501e-01f,6.640734236e-03f,9.999930272e-01f,3.734378079e-03f,
-9.999608264e-01f,-8.851309290e-03f,9.810745815e-01f,-1.936302286e-01f,7.814403926e-01f,6.239798978e-01f,-7.174774633e-01f,-6.965817179e-01f,-5.885011558e-01f,8.084963758e-01f,3.274895886e-01f,9.448547874e-01f,7.676045628e-01f,6.409237359e-01f,9.244439837e-01f,3.813178741e-01f,9.758974496e-01f,2.182296219e-01f,9.923570442e-01f,1.233997439e-01f,9.975809759e-01f,6.951400294e-02f,9.992348263e-01f,3.911217043e-02f,9.997580097e-01f,2.199822712e-02f,9.999234739e-01f,1.237119282e-02f,9.999758001e-01f,6.956954712e-03f,9.999923473e-01f,3.912204676e-03f,
-5.328330203e-01f,-8.462204042e-01f,9.332357723e-01f,3.592645171e-01f,5.486452564e-01f,8.360552510e-01f,-5.829432350e-01f,-8.125128828e-01f,-6.662759857e-01f,7.457052439e-01f,2.738668392e-01f,9.617676197e-01f,7.469563882e-01f,6.648730361e-01f,9.175172750e-01f,3.976959268e-01f,9.736663975e-01f,2.279775131e-01f,9.916474294e-01f,1.289781990e-01f,9.973561656e-01f,7.266828020e-02f,9.991636941e-01f,4.088902546e-02f,9.997355116e-01f,2.299797413e-02f,9.999163589e-01f,1.293348969e-02f,9.999735501e-01f,7.273174492e-03f,9.999916358e-01f,4.090031381e-03f,
4.241790073e-01f,-9.055783620e-01f,5.979771709e-01f,8.015131335e-01f,2.614416878e-01f,9.652192724e-01f,-4.300232723e-01f,-9.028178029e-01f,-7.373937800e-01f,6.754631102e-01f,2.193782753e-01f,9.756398784e-01f,7.255613200e-01f,6.881575190e-01f,9.103004290e-01f,4.139482201e-01f,9.713379761e-01f,2.377026212e-01f,9.909064560e-01f,1.345525754e-01f,9.971213823e-01f,7.582182336e-02f,9.990894022e-01f,4.266575118e-02f,9.997120138e-01f,2.399769627e-02f,9.999089278e-01f,1.349578153e-02f,9.999712001e-01f,7.589393080e-03f,9.999908927e-01f,4.267857492e-03f,
9.912028119e-01f,-1.323517501e-01f,7.855226359e-02f,9.969099969e-01f,-5.168932904e-02f,9.986632131e-01f,-2.635405934e-01f,-9.646483067e-01f,-8.011436155e-01f,5.984721441e-01f,1.641961594e-01f,9.864277070e-01f,7.034407513e-01f,7.107539022e-01f,9.027957408e-01f,4.300695879e-01f,9.689124217e-01f,2.474039593e-01f,9.901341474e-01f,1.401226969e-01f,9.968766273e-01f,7.897461572e-02f,9.990119510e-01f,4.444234199e-02f,9.996875163e-01f,2.499739629e-02f,9.999011805e-01f,1.405806910e-02f,9.999687502e-01f,7.905611374e-03f,9.999901179e-01f,4.445683934e-03f,
6.469193223e-01f,7.625584505e-01f,-4.650644959e-01f,8.852768012e-01f,-3.596943393e-01f,9.330701915e-01f,-8.874550263e-02f,-9.960543337e-01f,-8.568888271e-01f,5.155012492e-01f,1.084949468e-01f,9.940970006e-01f,6.806168009e-01f,7.326395911e-01f,8.950055582e-01f,4.460549862e-01f,9.663899806e-01f,2.570805427e-01f,9.893305281e-01f,1.456883874e-01f,9.966219035e-01f,8.212661834e-02f,9.989313406e-01f,4.621879226e-02f,9.996620190e-01f,2.599707130e-02f,9.998931169e-01f,1.462035317e-02f,9.999662002e-01f,8.221828878e-03f,9.999893115e-01f,4.623509769e-03f,
-2.921388087e-01f,9.563759284e-01f,-8.654506342e-01f,5.009942114e-01f,-6.320286307e-01f,7.749450367e-01f,8.884811635e-02f,-9.960451858e-01f,-9.040721624e-01f,4.273798371e-01f,5.245061444e-02f,9.986235192e-01f,6.571122908e-01f,7.537927018e-01f,8.869323709e-01f,4.618993066e-01f,9.637709015e-01f,2.667314183e-01f,9.884956235e-01f,1.512494708e-01f,9.963572141e-01f,8.527779227e-02f,9.988475711e-01f,4.799510009e-02f,9.996355221e-01f,2.699672032e-02f,9.998847372e-01f,1.518263167e-02f,9.999635502e-01f,8.538045559e-03f,9.999884735e-01f,4.801335923e-03f,
-9.626058663e-01f,2.709057883e-01f,-9.992934094e-01f,-3.758566202e-02f,-8.416849393e-01f,5.399689462e-01f,2.636395107e-01f,-9.646212772e-01f,-9.422223247e-01f,3.349881951e-01f,-3.759419011e-03f,9.999929334e-01f,6.329506774e-01f,7.741921209e-01f,8.785787046e-01f,4.775975920e-01f,9.610554380e-01f,2.763556497e-01f,9.876294623e-01f,1.568057565e-01f,9.960825606e-01f,8.842812085e-02f,9.987606432e-01f,4.977125243e-02f,9.996080256e-01f,2.799634234e-02f,9.998760413e-01f,1.574490538e-02f,9.999608003e-01f,8.854261387e-03f,9.999876039e-01f,4.979161926e-03f,
-7.480575297e-01f,-6.636338842e-01f,-8.253716334e-01f,-5.645898217e-01f,-9.678715076e-01f,2.514453117e-01f,4.301158485e-01f,-9.027737019e-01f,-9.709581880e-01f,2.392492366e-01f,-5.995756728e-02f,9.982009267e-01f,6.081562113e-01f,7.938173736e-01f,8.699472142e-01f,4.931448515e-01f,9.582438779e-01f,2.859522171e-01f,9.867320673e-01f,1.623570984e-01f,9.957979462e-01f,9.157756515e-02f,9.986705569e-01f,5.154724737e-02f,9.995795294e-01f,2.899593637e-02f,9.998670292e-01f,1.630717503e-02f,9.999579503e-01f,9.170476329e-03f,9.999867027e-01f,5.156987306e-03f,
1.542514499e-01f,-9.880316241e-01f,-3.972518623e-01f,-9.177096261e-01f,-9.980752275e-01f,-6.201483913e-02f,5.830269376e-01f,-8.124528233e-01f,-9.899924966e-01f,1.411200081e-01f,-1.159661631e-01f,9.932531646e-01f,5.827536401e-01f,8.126488756e-01f,8.610406595e-01f,5.085361174e-01f,9.553364944e-01f,2.955201896e-01f,9.858034692e-01f,1.679033061e-01f,9.955033738e-01f,9.472609366e-02f,9.985773124e-01f,5.332308304e-02f,9.995500337e-01f,2.999550139e-02f,9.998577009e-01f,1.686943954e-02f,9.999550003e-01f,9.486690354e-03f,9.999857698e-01f,5.334812988e-03f,
9.147423578e-01f,-4.040376453e-01f,1.532154756e-01f,-9.881928041e-01f,-9.293002953e-01f,-3.693250075e-01f,7.175492218e-01f,-6.965077991e-01f,-9.991351562e-01f,4.158051951e-02f,-1.716081385e-01f,9.851652891e-01f,5.567683641e-01f,8.306677968e-01f,8.518617972e-01f,5.237666260e-01f,9.523335692e-01f,3.050586387e-01f,9.848436973e-01f,1.734442042e-01f,9.951988471e-01f,9.787366751e-02f,9.984809103e-01f,5.509874635e-02f,9.995195384e-01f,3.099503643e-02f,9.998480564e-01f,1.743169684e-02f,9.999519504e-01f,9.802903431e-03f,9.999848053e-01f,5.512638036e-03f,
8.342233605e-01f,5.514266812e-01f,6.564951791e-01f,-7.543302193e-01f,-7.683670888e-01f,-6.400093881e-01f,8.294403670e-01f,-5.585952717e-01f,-9.982947730e-01f,-5.837419103e-02f,-2.267075845e-01f,9.739628695e-01f,5.302263665e-01f,8.478561200e-01f,8.424135592e-01f,5.388315091e-01f,9.492354203e-01f,3.145665538e-01f,9.838527819e-01f,1.789796175e-01f,9.948843677e-01f,1.010202700e-01f,9.983813507e-01f,5.687423543e-02f,9.994880436e-01f,3.199454047e-02f,9.998380958e-01f,1.799395049e-02f,9.999488004e-01f,1.011911553e-02f,9.999838092e-01f,5.690463375e-03f,
-1.327674722e-02f,9.999118601e-01f,9.575860738e-01f,-2.881473778e-01f,-5.312352786e-01f,-8.472243379e-01f,9.151713830e-01f,-4.030649323e-01f,-9.874797774e-01f,-1.577456471e-01f,-2.810903074e-01f,9.596813216e-01f,5.031541870e-01f,8.641966582e-01f,8.326989334e-01f,5.537260030e-01f,9.460423489e-01f,3.240430126e-01f,9.828307545e-01f,1.845093711e-01f,9.945599394e-01f,1.041658623e-01f,9.982786339e-01f,5.864954466e-02f,9.994555494e-01f,3.299401065e-02f,9.998278189e-01f,1.855619846e-02f,9.999455505e-01f,1.043532661e-02f,9.999827814e-01f,5.868288535e-03f,
-8.485702748e-01f,5.290826861e-01f,9.637575328e-01f,2.667797179e-01f,-2.414211151e-01f,-9.704204476e-01f,9.720383571e-01f,-2.348221291e-01f,-9.667981682e-01f,-2.555411942e-01f,-3.345843792e-01f,9.423657958e-01f,4.755788956e-01f,8.796730723e-01f,8.227209915e-01f,5.684453977e-01f,9.427546643e-01f,3.334870955e-01f,9.817776473e-01f,1.900332899e-01f,9.942255664e-01f,1.073104056e-01f,9.981727603e-01f,6.042466843e-02f,9.994220556e-01f,3.399345156e-02f,9.998172259e-01f,1.911843869e-02f,9.999422006e-01f,1.075153665e-02f,9.999817221e-01f,6.046113043e-03f,
-9.036922051e-01f,-4.281826695e-01f,6.731102676e-01f,7.395421338e-01f,7.233466718e-02f,-9.973804169e-01f,9.982477619e-01f,-5.917267879e-02f,-9.364566873e-01f,-3.507832277e-01f,-3.870206816e-01f,9.220710342e-01f,4.475280652e-01f,8.942698871e-01f,8.124829236e-01f,5.829849902e-01f,9.393727149e-01f,3.428978019e-01f,9.806934936e-01f,1.955511994e-01f,9.938812503e-01f,1.104538832e-01f,9.980637300e-01f,6.219960483e-02f,9.993875625e-01f,3.499285475e-02f,9.998063168e-01f,1.968067474e-02f,9.999387506e-01f,1.106774562e-02f,9.999806311e-01f,6.223937825e-03f,
-1.279636896e-01f,-9.917788534e-01f,1.751565337e-01f,9.845405978e-01f,3.789161719e-01f,-9.254309994e-01f,9.929728258e-01f,1.183425843e-01f,-8.967583530e-01f,-4.425205716e-01f,-4.382335472e-01f,8.988611451e-01f,4.190297442e-01f,9.079725070e-01f,8.019878986e-01f,5.973402803e-01f,9.358968291e-01f,3.522742188e-01f,9.795783277e-01f,2.010629250e-01f,9.935269954e-01f,1.135962562e-01f,9.979515440e-01f,6.397433710e-02f,9.993520699e-01f,3.599222668e-02f,9.997950914e-01f,2.024290457e-02f,9.999352007e-01f,1.138395348e-02f,9.999795085e-01f,6.401761945e-03f,
7.654140519e-01f,-6.435381334e-01f,-3.767422893e-01f,9.263181135e-01f,6.479216888e-01f,-7.617069550e-01f,9.563800296e-01f,2.921253822e-01f,-8.481000064e-01f,-5.298361813e-01f,-4.880608524e-01f,8.728096037e-01f,3.901124287e-01f,9.207672306e-01f,7.912392691e-01f,6.115066795e-01f,9.323273439e-01f,3.616154364e-01f,9.784321880e-01f,2.065682779e-01f,9.931628052e-01f,1.167374932e-01f,9.978362017e-01f,6.574887451e-02f,9.993155781e-01f,3.699155889e-02f,9.997835499e-01f,2.080512613e-02f,9.999315508e-01f,1.170016020e-02f,9.999783543e-01f,6.579586328e-03f,
9.550736440e-01f,2.963685787e-01f,-8.126112051e-01f,5.828061679e-01f,8.526731157e-01f,-5.224447891e-01f,8.896234916e-01f,4.566946935e-01f,-7.909677411e-01f,-6.118578532e-01f,-5.363451811e-01f,8.439987244e-01f,3.608050334e-01f,9.326412643e-01f,7.802404339e-01f,6.254797082e-01f,9.286646373e-01f,3.709204650e-01f,9.772551046e-01f,2.120671131e-01f,9.927886843e-01f,1.198775555e-01f,9.977177040e-01f,6.752320399e-02f,9.992780868e-01f,3.799085783e-02f,9.997716923e-01f,2.136734297e-02f,9.999278009e-01f,1.201636575e-02f,9.999771684e-01f,6.757410504e-03f,
2.666429324e-01f,9.637953863e-01f,-9.982103598e-01f,5.980031485e-02f,9.728653499e-01f,-2.313720187e-01f,7.948083899e-01f,6.068604645e-01f,-7.259322386e-01f,-6.877662284e-01f,-5.829338849e-01f,8.125195911e-01f,3.311368634e-01f,9.435827349e-01f,7.689949093e-01f,6.392549018e-01f,9.249090653e-01f,3.801884019e-01f,9.760471178e-01f,2.175592422e-01f,9.924046346e-01f,1.230164264e-01f,9.975960518e-01f,6.929731252e-02f,9.992395964e-01f,3.899011506e-02f,9.997595184e-01f,2.192955306e-02f,9.999239510e-01f,1.233257010e-02f,9.999759510e-01f,6.935234000e-03f,
-6.669380617e-01f,7.451131605e-01f,-8.763794418e-01f,-4.816212973e-01f,9.965789837e-01f,8.264580634e-02f,6.749256518e-01f,7.378857395e-01f,-6.536436209e-01f,-7.568024953e-01f,-6.276796763e-01f,7.784717233e-01f,3.011375844e-01f,9.535807020e-01f,7.575061759e-01f,6.528279969e-01f,9.210610033e-01f,3.894183203e-01f,9.748082657e-01f,2.230444915e-01f,9.920106618e-01f,1.261540598e-01f,9.974712443e-01f,7.107120934e-02f,9.992001065e-01f,3.998933702e-02f,9.997470285e-01f,2.249175622e-02f,9.999200011e-01f,1.264877321e-02f,9.999747019e-01f,7.113057742e-03f,
-9.873392775e-01f,-1.586226688e-01f,-4.846393970e-01f,-8.747140418e-01f,9.214623472e-01f,3.884676855e-01f,5.337561004e-01f,8.456384720e-01f,-5.748240246e-01f,-8.182770562e-01f,-6.704410942e-01f,7.419627614e-01f,2.708370782e-01f,9.626252007e-01f,7.457779040e-01f,6.661946547e-01f,9.171208242e-01f,3.986093247e-01f,9.735385875e-01f,2.285226875e-01f,9.916067680e-01f,1.292904390e-01f,9.973432826e-01f,7.284488142e-02f,9.991596177e-01f,4.098851526e-02f,9.997342224e-01f,2.305395040e-02f,9.999159512e-01f,1.296497506e-02f,9.999734212e-01f,7.290880793e-03f,
-3.999853150e-01f,-9.165215479e-01f,5.636094028e-02f,-9.984104589e-01f,7.549653475e-01f,6.557646866e-01f,3.757521519e-01f,9.267201953e-01f,-4.902605720e-01f,-8.715759127e-01f,-7.110829506e-01f,7.031081264e-01f,2.402658714e-01f,9.707071191e-01f,7.338138022e-01f,6.793506485e-01f,9.130889457e-01f,4.077604411e-01f,9.722381233e-01f,2.339936570e-01f,9.911929581e-01f,1.324255253e-01f,9.972121675e-01f,7.461831571e-02f,9.991181295e-01f,4.198765625e-02f,9.997211001e-01f,2.361613915e-02f,9.999118013e-01f,1.328117562e-02f,9.999721088e-01f,7.468704080e-03f,
5.551133015e-01f,-8.317747426e-01f,5.800031129e-01f,-8.146142578e-01f,5.135984179e-01f,8.580306901e-01f,2.058971709e-01f,9.785736329e-01f,-4.007989973e-01f,-9.161660132e-01f,-7.494767587e-01f,6.620306550e-01f,2.094544189e-01f,9.778184118e-01f,7.216176540e-01f,6.922918182e-01f,9.089657591e-01f,4.168707818e-01f,9.709069144e-01f,2.394572270e-01f,9.907692363e-01f,1.355592873e-01f,9.970778984e-01f,7.639152146e-02f,9.990756424e-01f,4.298675152e-02f,9.997076617e-01f,2.417832043e-02f,9.999075514e-01f,1.359737484e-02f,9.999707649e-01f,7.646527131e-03f,
9.998433086e-01f,1.770192511e-02f,9.250146691e-01f,-3.799313911e-01f,2.212981743e-01f,9.752061926e-01f,2.954782069e-02f,9.995633678e-01f,-3.073327792e-01f,-9.516021032e-01f,-7.855011387e-01f,6.188602113e-01f,1.784335295e-01f,9.839519681e-01f,7.091933579e-01f,7.050140291e-01f,9.047516642e-01f,4.259394629e-01f,9.695450064e-01f,2.449132102e-01f,9.903356068e-01f,1.386916938e-01f,9.969404762e-01f,7.816448565e-02f,9.990321560e-01f,4.398580752e-02f,9.996939072e-01f,2.474049220e-02f,9.999032016e-01f,1.391357271e-02f,9.999693893e-01f,7.824349474e-03f,
5.253219888e-01f,8.509035245e-01f,9.851382016e-01f,1.717635693e-01f,-9.294810554e-02f,9.956709545e-01f,-1.477329862e-01f,9.890272821e-01f,-2.107957994e-01f,-9.775301177e-01f,-8.190422014e-01f,5.737332763e-01f,1.472342216e-01f,9.891016550e-01f,6.965447594e-01f,7.175133435e-01f,9.004471075e-01f,4.349655234e-01f,9.681524315e-01f,2.503614776e-01f,9.898920739e-01f,1.418227133e-01f,9.967999021e-01f,7.993719522e-02f,9.989876708e-01f,4.498481582e-02f,9.996798365e-01f,2.530265802e-02f,9.998987517e-01f,1.422976918e-02f,9.999679821e-01f,8.002171569e-03f,
-4.321779449e-01f,9.017883476e-01f,7.418580135e-01f,6.705569982e-01f,-3.979767653e-01f,9.173954950e-01f,-3.203543695e-01f,9.472977768e-01f,-1.121526217e-01f,-9.936909929e-01f,-8.499939088e-01f,5.267925161e-01f,1.158876918e-01f,9.932623233e-01f,6.836758997e-01f,7.297857660e-01f,8.960525071e-01f,4.439480877e-01f,9.667292484e-01f,2.558017989e-01f,9.894386421e-01f,1.449523146e-01f,9.966561752e-01f,8.170965944e-02f,9.989421864e-01f,4.598378286e-02f,9.996654497e-01f,2.586481583e-02f,9.998942019e-01f,1.454596424e-02f,9.999665433e-01f,8.179994343e-03f,
-9.923354692e-01f,1.235731227e-01f,2.700984580e-01f,9.628327077e-01f,-6.635382560e-01f,7.481423547e-01f,-4.828719382e-01f,8.756909793e-01f,-1.238837738e-02f,-9.999232611e-01f,-8.782584087e-01f,4.781863313e-01f,8.442528403e-02f,9.964298126e-01f,6.705908480e-01f,7.418274156e-01f,8.915682887e-01f,4.528862843e-01f,9.652754871e-01f,2.612340599e-01f,9.889753181e-01f,1.480804517e-01f,9.965092972e-01f,8.348185785e-02f,9.988957032e-01f,4.698270019e-02f,9.996507468e-01f,2.642696360e-02f,9.998895520e-01f,1.486215783e-02f,9.999650728e-01f,8.357815927e-03f,
-6.401443395e-01f,-7.682546613e-01f,-2.848466063e-01f,9.585731119e-01f,-8.632964878e-01f,5.046971113e-01f,-6.301599705e-01f,7.764653318e-01f,8.749917344e-02f,-9.961645921e-01f,-9.037463447e-01f,4.280683876e-01f,5.287845807e-02f,9.986009557e-01f,6.572937422e-01f,7.536344847e-01f,8.869949277e-01f,4.617791660e-01f,9.637912089e-01f,2.666580313e-01f,9.885021022e-01f,1.512071226e-01f,9.963592674e-01f,8.525379969e-02f,9.988482211e-01f,4.798157054e-02f,9.996357278e-01f,2.698910488e-02f,9.998848022e-01f,1.517834901e-02f,9.999635708e-01f,8.535637247e-03f,
3.005925437e-01f,-9.537526528e-01f,-7.520639951e-01f,6.590900905e-01f,-9.774427254e-01f,2.112006594e-01f,-7.575730765e-01f,6.527503610e-01f,1.865124631e-01f,-9.824525948e-01f,-9.263771379e-01f,3.765971301e-01f,2.127875808e-02f,9.997735816e-01f,6.437888326e-01f,7.652032012e-01f,8.823328681e-01f,4.706258703e-01f,9.622764532e-01f,2.720735702e-01f,9.880190013e-01f,1.543322815e-01f,9.962060867e-01f,8.702547193e-02f,9.987997401e-01f,4.898039663e-02f,9.996203926e-01f,2.755123762e-02f,9.998799524e-01f,1.549453961e-02f,9.999620371e-01f,8.713459228e-03f,
9.649660285e-01f,-2.623748537e-01f,-9.876590838e-01f,1.566190737e-01f,-9.946564265e-01f,-1.032404628e-01f,-8.610927113e-01f,5.084479743e-01f,2.836621855e-01f,-9.589242747e-01f,-9.460792425e-01f,3.239352821e-01f,-1.034221888e-02f,9.999465178e-01f,6.300802992e-01f,7.765299843e-01f,8.775825619e-01f,4.794255386e-01f,9.607312596e-01f,2.774805341e-01f,9.875260201e-01f,1.574558971e-01f,9.960497565e-01f,8.879686156e-02f,9.987502604e-01f,4.997917001e-02f,9.996047414e-01f,2.811335979e-02f,9.998750026e-01f,1.581072865e-02f,9.999604718e-01f,8.891280002e-03f,
7.421541968e-01f,6.702291758e-01f,-9.190735378e-01f,-3.940860720e-01f,-9.132301279e-01f,-4.074441477e-01f,-9.374542500e-01f,3.481085020e-01f,3.779776544e-01f,-9.258147184e-01f,-9.627903713e-01f,2.702493312e-01f,-4.195285448e-02f,9.991195914e-01f,6.161725219e-01f,7.876112133e-01f,8.727445123e-01f,4.881772386e-01f,9.591556934e-01f,2.828786946e-01f,9.870231637e-01f,1.605779382e-01f,9.958902758e-01f,9.056797780e-02f,9.986997817e-01f,5.097789714e-02f,9.995887740e-01f,2.867547492e-02f,9.998699528e-01f,1.612691704e-02f,9.999588749e-01f,9.069100495e-03f,
-1.629907808e-01f,9.866275920e-01f,-5.674300293e-01f,-8.234216185e-01f,-7.412399645e-01f,-6.712401321e-01f,-9.842484715e-01f,1.767906850e-01f,4.685169241e-01f,-8.834545217e-01f,-9.764576931e-01f,2.157090023e-01f,-7.352154075e-02f,9.972936293e-01f,6.020698986e-01f,7.984433839e-01f,8.678191892e-01f,4.968801213e-01f,9.575497876e-01f,2.882679384e-01f,9.865104371e-01f,1.636983734e-01f,9.957276465e-01f,9.233880022e-02f,9.986483046e-01f,5.197656957e-02f,9.995724905e-01f,2.923758099e-02f,9.998648031e-01f,1.644310196e-02f,9.999572463e-01f,9.246920701e-03f,
-9.182827862e-01f,3.959251502e-01f,-4.102818995e-02f,-9.991579893e-01f,-4.957418213e-01f,-8.684699457e-01f,-9.999999947e-01f,-1.030206758e-04f,5.543744949e-01f,-8.322673365e-01f,-9.870379993e-01f,1.604867217e-01f,-1.050167117e-01f,9.944704572e-01f,5.877769370e-01f,8.090230357e-01f,8.628070850e-01f,5.055333165e-01f,9.559136100e-01f,2.936480378e-01f,9.859878454e-01f,1.668171717e-01f,9.955618677e-01f,9.410933806e-02f,9.985958286e-01f,5.297519375e-02f,9.995558910e-01f,2.979967596e-02f,9.998595533e-01f,1.675928710e-02f,9.999555861e-01f,9.424741546e-03f,
-8.293098329e-01f,-5.587890489e-01f,4.980096003e-01f,-8.671715159e-01f,-2.010796199e-01f,-9.795749009e-01f,-9.842120244e-01f,-1.769934771e-01f,6.346929496e-01f,-7.727644270e-01f,-9.944978661e-01f,1.047568344e-01f,-1.364068747e-01f,9.906528981e-01f,5.732980611e-01f,8.193468943e-01f,8.577087010e-01f,5.141359589e-01f,9.542471952e-01f,2.990188798e-01f,9.854553963e-01f,1.699342871e-01f,9.953929407e-01f,9.587957830e-02f,9.985423542e-01f,5.397376122e-02f,9.995389754e-01f,3.036176336e-02f,9.998542036e-01f,1.707546870e-02f,9.999538943e-01f,9.602561162e-03f,
2.212675626e-02f,-9.997551734e-01f,8.836693140e-01f,-4.681116785e-01f,1.135217773e-01f,-9.935355082e-01f,-9.373825054e-01f,-3.483016489e-01f,7.086697743e-01f,-7.055403256e-01f,-9.988136461e-01f,4.869599955e-02f,-1.676606422e-01f,9.858447692e-01f,5.586378969e-01f,8.294116591e-01f,8.525245158e-01f,5.226872391e-01f,9.525506134e-01f,3.043802375e-01f,9.849130902e-01f,1.730497178e-01f,9.952208667e-01f,9.764950793e-02f,9.984878810e-01f,5.497227845e-02f,9.995217437e-01f,3.092384116e-02f,9.998487538e-01f,1.739165045e-02f,9.999521709e-01f,9.780380474e-03f,
8.532201077e-01f,-5.215510021e-01f,9.971746360e-01f,7.511820869e-02f,4.168670742e-01f,-9.089674595e-01f,-8.609884168e-01f,-5.086245631e-01f,7.755658183e-01f,-6.312667118e-01f,-9.999717335e-01f,-7.518784889e-03f,-1.987468801e-01f,9.800508546e-01f,5.438010803e-01f,8.392141473e-01f,8.472551097e-01f,5.311861999e-01f,9.508239095e-01f,3.097319700e-01f,9.843609349e-01f,1.761634181e-01f,9.950456449e-01f,9.941913618e-02f,9.984324096e-01f,5.597073698e-02f,9.995041959e-01f,3.148590732e-02f,9.998432041e-01f,1.770782860e-02f,9.999504159e-01f,9.958200408e-03f,
8.998668270e-01f,4.361647552e-01f,8.035690866e-01f,5.952114944e-01f,6.788702112e-01f,-7.342582900e-01f,-7.574391895e-01f,-6.529057162e-01f,8.347129424e-01f,-5.506853038e-01f,-9.979684672e-01f,-6.370979912e-02f,-2.296342702e-01f,9.732769914e-01f,5.287923029e-01f,8.487512594e-01f,8.419009790e-01f,5.396320427e-01f,9.490671287e-01f,3.150739362e-01f,9.837989360e-01f,1.792753567e-01f,9.948672764e-01f,1.011884500e-01f,9.983759396e-01f,5.696914326e-02f,9.994863320e-01f,3.204796724e-02f,9.998375544e-01f,1.802400685e-02f,9.999486292e-01f,1.013601910e-02f,
1.191801354e-01f,9.928726481e-01f,3.624766664e-01f,9.319928467e-01f,8.735505105e-01f,-4.867335058e-01f,-6.300007138e-01f,-7.765945536e-01f,8.855196056e-01f,-4.646020105e-01f,-9.928101803e-01f,-1.196993984e-01f,-2.602920453e-01f,9.655299328e-01f,5.136163109e-01f,8.580199795e-01f,8.364626591e-01f,5.480239228e-01f,9.472803452e-01f,3.204059106e-01f,9.832270991e-01f,1.823855026e-01f,9.946857626e-01f,1.029574365e-01f,9.983184713e-01f,5.796748886e-02f,9.994681521e-01f,3.261001331e-02f,9.998318047e-01f,1.834018143e-02f,9.999468110e-01f,1.031383746e-02f,
-7.710802230e-01f,6.367380071e-01f,-1.902490958e-01f,9.817358512e-01f,9.816020978e-01f,-1.909380047e-01f,-4.826923346e-01f,-8.757899920e-01f,9.274784664e-01f,-3.738765764e-01f,-9.845131804e-01f,-1.753105749e-01f,-2.906895502e-01f,9.568174253e-01f,4.982779032e-01f,8.670173765e-01f,8.309406937e-01f,5.563610011e-01f,9.454635966e-01f,3.257277812e-01f,9.826454300e-01f,1.854938246e-01f,9.945011026e-01f,1.047261048e-01f,9.982600046e-01f,5.896578020e-02f,9.994496561e-01f,3.317204907e-02f,9.998259550e-01f,1.865635603e-02f,9.999449611e-01f,1.049165644e-02f,
-9.524129804e-01f,-3.048106211e-01f,-6.843819158e-01f,7.291237161e-01f,9.923083195e-01f,1.237909494e-01f,-3.201591802e-01f,-9.473637630e-01f,9.601702867e-01f,-2.794154982e-01f,-9.731036980e-01f,-2.303675170e-01f,-3.207963899e-01f,9.471481807e-01f,4.827820346e-01f,8.757405478e-01f,8.253356351e-01f,5.646424439e-01f,9.436169596e-01f,3.310393232e-01f,9.820539344e-01f,1.886002917e-01f,9.943132976e-01f,1.064944419e-01f,9.982005398e-01f,5.996400886e-02f,9.994308440e-01f,3.373407806e-02f,9.998200054e-01f,1.897252691e-02f,9.999430795e-01f,1.066947415e-02f,
-2.581016359e-01f,-9.661177700e-01f,-9.677396624e-01f,2.519522691e-01f,9.046075662e-01f,4.262454119e-01f,-1.475292025e-01f,-9.890577002e-01f,9.832684211e-01f,-1.821625980e-01f,-9.586178037e-01f,-2.846961652e-01f,-3.505824602e-01f,9.365318674e-01f,4.671333972e-01f,8.841868520e-01f,8.196480097e-01f,5.728674718e-01f,9.417404730e-01f,3.363404250e-01f,9.814526211e-01f,1.917048581e-01f,9.941223492e-01f,1.082624348e-01f,9.981400766e-01f,6.096218127e-02f,9.994117160e-01f,3.429609266e-02f,9.998139558e-01f,1.928869776e-02f,9.999411664e-01f,1.084729152e-02f,
6.735071623e-01f,-7.391806966e-01f,-9.530500361e-01f,-3.028128610e-01f,7.271980777e-01f,6.864276770e-01f,2.975377145e-02f,-9.995572585e-01f,9.965421208e-01f,-8.308911770e-02f,-9.411012936e-01f,-3.381247627e-01f,-3.800179774e-01f,9.249791008e-01f,4.513370430e-01f,8.923535586e-01f,8.138784539e-01f,5.810351644e-01f,9.398342161e-01f,3.416308626e-01f,9.808414904e-01f,1.948075221e-01f,9.939282563e-01f,1.100300928e-01f,9.980786154e-01f,6.196028901e-02f,9.993922719e-01f,3.485809641e-02f,9.998078062e-01f,1.960486481e-02f,9.999392216e-01f,1.102510855e-02f,
9.858965816e-01f,1.673557003e-01f,-6.448370157e-01f,-7.643201052e-01f,4.776714527e-01f,8.785385497e-01f,2.060983265e-01f,-9.785312871e-01f,9.998586332e-01f,1.681409119e-02f,-9.206095453e-01f,-3.904843980e-01f,-4.090735085e-01f,9.125014327e-01f,4.353979670e-01f,9.002380853e-01f,8.080275111e-01f,5.891447541e-01f,9.378982288e-01f,3.469105251e-01f,9.802205514e-01f,1.979082381e-01f,9.937310211e-01f,1.117973955e-01f,9.980161562e-01f,6.295833478e-02f,9.993725116e-01f,3.542009286e-02f,9.998015566e-01f,1.992103176e-02f,9.999372453e-01f,1.120292616e-02f
};

#define XB_TMO      128
#define XB_XCNT(j)  (256  + 64 * (j))
#define XB_XSUB(j)  (1280 + 64 * (j))
#define XB_XGEN(j)  (2304 + 64 * (j))
#define XB_TOP      3328
#define XB_TOPGEN   3392
#define XCD_BAR_WORDS 3456
#define XB_SPIN_CAP (1u << 18)

__device__ __forceinline__ unsigned xb_ld(unsigned* p)              { return __hip_atomic_load(p, __ATOMIC_RELAXED, __HIP_MEMORY_SCOPE_AGENT); }
__device__ __forceinline__ unsigned xb_add(unsigned* p, unsigned v) { return __hip_atomic_fetch_add(p, v, __ATOMIC_RELAXED, __HIP_MEMORY_SCOPE_AGENT); }
__device__ __forceinline__ unsigned xb_xcc_id() { return (unsigned)__builtin_amdgcn_s_getreg((3 << 11) | 20) & 0xFu; }
#define XB_SPIN(cond, bar) do { unsigned _sp = 0; while (cond) { __builtin_amdgcn_s_sleep(1); \
    if ((++_sp & 255u) == 0u) { if (xb_ld(&(bar)[XB_TMO])) break; if (_sp > XB_SPIN_CAP) { atomicAdd(&(bar)[XB_TMO], 1u); break; } } } } while (0)

struct XcdBarrier {
    unsigned* bar; unsigned x;
    volatile LAS unsigned* st;
};

__device__ __forceinline__ XcdBarrier xcd_barrier_post(unsigned* bar, volatile LAS unsigned* st) {
    XcdBarrier b; b.bar = bar; b.x = xb_xcc_id(); b.st = st;
    if (threadIdx.x == 0) (void)xb_add(&bar[XB_XCNT(b.x)], 1u);
    return b;
}
__device__ __forceinline__ void xcd_barrier_complete(unsigned* bar, unsigned x, unsigned& nloc, unsigned& nx) {
    const unsigned G = gridDim.x * gridDim.y * gridDim.z;
    unsigned sum, cnt, mine, sp = 0u;
    for (;;) {
        sum = 0u; cnt = 0u; mine = 0u;
#pragma unroll
        for (unsigned j = 0; j < 16; ++j) { const unsigned c = xb_ld(&bar[XB_XCNT(j)]); sum += c; cnt += (c > 0u) ? 1u : 0u; mine = (j == x) ? c : mine; }
        if (sum == G) break;
        __builtin_amdgcn_s_sleep(1);
        if ((++sp & 255u) == 0u) { if (xb_ld(&bar[XB_TMO])) break; if (sp > XB_SPIN_CAP) { atomicAdd(&bar[XB_TMO], 1u); break; } }
    }
    nloc = mine > 0u ? mine : 1u; nx = cnt > 0u ? cnt : 1u;
}

__device__ __forceinline__ void xcd_barrier(const XcdBarrier& b) {
    asm volatile("s_waitcnt vmcnt(0)" ::: "memory");
    __syncthreads();
    if (threadIdx.x == 0) {
        unsigned* bar = b.bar;
        __builtin_amdgcn_s_waitcnt(0);
        unsigned nloc = b.st[0], nx = b.st[1];
        if (nloc == 0u) { xcd_barrier_complete(bar, b.x, nloc, nx); b.st[0] = nloc; b.st[1] = nx; }
        const unsigned old = xb_add(&bar[XB_XSUB(b.x)], 1u);
        const unsigned gen = old / nloc;
        if (old + 1u == (gen + 1u) * nloc) {
            __builtin_amdgcn_fence(__ATOMIC_RELEASE, "agent");
            asm volatile("s_waitcnt vmcnt(0)" ::: "memory");
            const unsigned og = xb_add(&bar[XB_TOP], 1u);
            const unsigned tg = og / nx;
            if (og + 1u == (tg + 1u) * nx) xb_add(&bar[XB_TOPGEN], 1u);
            else XB_SPIN(xb_ld(&bar[XB_TOPGEN]) == tg, bar);
            __builtin_amdgcn_fence(__ATOMIC_ACQUIRE, "agent");
            xb_add(&bar[XB_XGEN(b.x)], 1u);
            asm volatile("s_waitcnt vmcnt(0)" ::: "memory");
        } else {
            XB_SPIN(xb_ld(&bar[XB_XGEN(b.x)]) == gen, bar);
            __builtin_amdgcn_fence(__ATOMIC_ACQUIRE, "agent");
            asm volatile("s_waitcnt vmcnt(0)" ::: "memory");
        }
    }
    __syncthreads();
}

typedef __bf16 bf16x2_t __attribute__((ext_vector_type(2)));
DEVI unsigned pk_bf16(float lo, float hi) {
    f32x2 f = {lo, hi}; bf16x2_t v = __builtin_convertvector(f, bf16x2_t); unsigned r; __builtin_memcpy(&r, &v, 4); return r; }
DEVI float bf_lo(unsigned w) { return __uint_as_float(w << 16); }
DEVI float bf_hi(unsigned w) { return __uint_as_float(w & 0xffff0000u); }
DEVI bf16x8 lds_ld128(lds_t* p) { return *(LAS bf16x8*)p; }
DEVI void lds_st128(lds_t* p, u32x4 v) { *(LAS u32x4*)p = v; }
DEVI float wave_sum(float v) {
#pragma unroll
    for (int o = 32; o >= 1; o >>= 1) v += __shfl_xor(v, o);
    return v;
}
DEVI float fexp2(float x) { return __builtin_amdgcn_exp2f(x); }
DEVI float frcp(float x) { return __builtin_amdgcn_rcpf(x); }
DEVI float silu_f(float x) { return x * frcp(1.0f + fexp2(-LOG2E * x)); }
DEVI float gelu_tanh_f(float x) {
    const float y = 0.7978845608028654f * (x + 0.044715f * x * x * x);
    const float e = fexp2((2.0f * LOG2E) * y);
    const float t = 1.0f - 2.0f * frcp(e + 1.0f);
    return 0.5f * x * (1.0f + t);
}
DEVI int cond_of_row(int row) { return row < NPR ? 0 : 1 + ((row - NPR) >> 10); }

struct Params {
    const float *x_prompt, *x_sample, *cache_ckv, *cache_kpe, *cache_k, *cache_v, *c, *c_ctx, *mod_w, *mod_b, *ln_gain, *ln_bias,
        *mla_w_in, *mla_q_gain, *mla_kv_gain, *mla_w_q_up, *mla_w_kv_up, *mla_w_out,
        *gm_w_in, *gm_v_gain, *gm_w_s, *gm_b_s, *gm_w_out, *swa_w_qkv, *swa_sink, *swa_w_out,
        *moe_router, *moe_w_gate, *moe_w_up, *moe_w_down;
    float* out;
    unsigned* bar;
    float *mod, *X0, *X1, *T, *Z, *GST, *AFF, *GATEV;
    bf16_t *H, *H2, *CQ, *CKV, *KPE, *Q, *KN, *VTP, *VTS, *O, *U, *GVT, *TT, *SK, *SVTP, *SVTS, *HID, *YE;
    bf16_t *WTI, *WTQ, *WTKV, *WTO, *WTGI, *WTGO, *WTSQ, *WTSO;
    int *SEL, *IDX;
    long long ph_lo, ph_hi;
};
constexpr size_t OUT_Y = 0;
constexpr size_t OUT_CKV = 8388608;
constexpr size_t OUT_KPE = OUT_CKV + 2097152;
constexpr size_t OUT_SK = OUT_KPE + 524288;
constexpr size_t OUT_SV = OUT_SK + 1048576;

DEVI const float* modp(const Params& p, int layer, int cnd, int which) { return p.mod + ((size_t)(layer * 5 + cnd) * 6 + which) * 1024; }

DEVI int swz(int row) { return ((row >> 1) & 7) ^ ((row >> 4) & 1); }
DEVI int img_off(int row, int chunk) { return row * 128 + ((chunk ^ swz(row)) << 4); }

template <int BM> struct XDma {
    static constexpr int NI = BM / 64;
    const bf16_t* base; unsigned off[NI];
    template <class RowFn> DEVI void init(const RowFn& rowfn, int tid) {
        const int w = tid >> 6, i = tid & 63;
        base = rowfn.base;
#pragma unroll
        for (int j = 0; j < NI; ++j) { const int row = 64 * j + 8 * w + (i >> 3); off[j] = rowfn.offset(row) + (((i & 7) ^ swz(row)) << 3); }
    }
    DEVI void issue(int kt, lds_t* img, int tid) const {
        lds_t* dst = img + (tid >> 6) * 1024 + (tid & 63) * 16;
#pragma unroll
        for (int j = 0; j < NI; ++j) __builtin_amdgcn_global_load_lds((const unsigned*)(base + off[j] + kt * 64), (LAS unsigned*)(dst + j * 8192), 16, 0, 0);
    }
};

struct WRegs {
    f32x4 r[8];
    DEVI void load(const float* p, size_t ldw, int kt) {
        const float* q = p + (size_t)kt * 64 * ldw;
#pragma unroll
        for (int i = 0; i < 8; ++i) r[i] = *(const f32x4*)(q + (size_t)i * ldw);
    }
    DEVI void store(lds_t* img, int wave, int lane) const {
#pragma unroll
        for (int c = 0; c < 4; ++c) {
            u32x4 v;
            v.x = pk_bf16(r[0][c], r[1][c]); v.y = pk_bf16(r[2][c], r[3][c]); v.z = pk_bf16(r[4][c], r[5][c]); v.w = pk_bf16(r[6][c], r[7][c]);
            lds_st128(img + img_off(4 * lane + c, wave), v);
        }
    }
};

template <int BM, bool TRANS>
DEVI void gemm_compute(lds_t* ximg, lds_t* wimg, f32x4 (&acc)[BM / 32][4], int wr, int wc, int lane) {
    constexpr int TM = BM / 32, NH = TM / 4, NSTEP = 2 * NH;
    const int r16 = lane & 15, g = lane >> 4;
    const int c0 = g ^ ((r16 >> 1) & 7);
    lds_t* xb = ximg + (wr * (BM / 2) + r16) * 128;
    lds_t* wb = wimg + (wc * 64 + r16) * 128;
    bf16x8 wf[2][4], xf[2][4];
#define LD_W(buf, s_) do { const int o0_ = ((c0 ^ (4 * (s_))) << 4), o1_ = ((c0 ^ (4 * (s_)) ^ 1) << 4); \
        _Pragma("unroll") for (int nb = 0; nb < 4; ++nb) wf[buf][nb] = lds_ld128(wb + nb * 2048 + ((nb & 1) ? o1_ : o0_)); } while (0)
#define LD_X(buf, s_, h_) do { const int o0_ = ((c0 ^ (4 * (s_))) << 4), o1_ = ((c0 ^ (4 * (s_)) ^ 1) << 4); \
        _Pragma("unroll") for (int m4 = 0; m4 < 4; ++m4) { const int mb_ = 4 * (h_) + m4; xf[buf][m4] = lds_ld128(xb + mb_ * 2048 + ((mb_ & 1) ? o1_ : o0_)); } } while (0)
    LD_W(0, 0); LD_X(0, 0, 0);
#pragma unroll
    for (int st = 0; st < NSTEP; ++st) {
        const int s = st / NH, h = st % NH;
        if (st + 1 < NSTEP) {
            const int s1 = (st + 1) / NH, h1 = (st + 1) % NH;
            if (s1 != s) LD_W(s1 & 1, s1);
            LD_X((st + 1) & 1, s1, h1);
        }
#pragma unroll
        for (int m4 = 0; m4 < 4; ++m4)
#pragma unroll
            for (int nb = 0; nb < 4; ++nb) {
                const int mb = 4 * h + m4;
                acc[mb][nb] = TRANS ? __builtin_amdgcn_mfma_f32_16x16x32_bf16(wf[s & 1][nb], xf[st & 1][m4], acc[mb][nb], 0, 0, 0)
                                    : __builtin_amdgcn_mfma_f32_16x16x32_bf16(xf[st & 1][m4], wf[s & 1][nb], acc[mb][nb], 0, 0, 0);
            }
        __builtin_amdgcn_sched_barrier(0);
    }
#undef LD_W
#undef LD_X
}

struct WLin { const float* base; DEVI const float* operator()(int lane) const { return base + 4 * lane; } };
template <int BM> struct GemmPipe {
    static constexpr int TM = BM / 32, STAGE = (BM + 256) * 128, NI = BM / 64;
    XDma<BM> xd; const float* wp; unsigned ldw; WRegs wr_; int par;
    template <class RowFn, class WFn> DEVI void prime(lds_t* lds, const RowFn& rf, const WFn& wf, unsigned ldw_, int tid_in) {
        const int tid = tid_in;
        const int lane = tid & 63, wave = tid >> 6;
        xd.init(rf, tid); ldw = ldw_; wp = wf(lane) + (size_t)(8 * wave) * ldw_; par = 0;
        wr_.load(wp, ldw, 0);
        __syncthreads();
        xd.issue(0, lds, tid); wr_.store(lds + BM * 128, wave, lane);
        wr_.load(wp, ldw, 1);
    }
    template <bool TRANS, bool XUNIT = true, class Epi, class RowFnN, class WFnN>
    DEVI void run(lds_t* lds, int nk, const Epi& epi, bool has_next_in, const RowFnN& rfn, const WFnN& wfn, unsigned ldw_n, int tid_in) {
        int tid = tid_in; asm volatile("" : "+v"(tid));
        const int lane = tid & 63, wave = tid >> 6, wrow = wave >> 2, wcol = wave & 3;
        const bool has_next = XUNIT && has_next_in;
        f32x4 acc[TM][4];
#pragma unroll
        for (int i = 0; i < TM; ++i)
#pragma unroll
            for (int j = 0; j < 4; ++j) acc[i][j] = (f32x4){0.f, 0.f, 0.f, 0.f};
        unsigned offn[NI];
        if (XUNIT) {
#pragma unroll
            for (int j = 0; j < NI; ++j) offn[j] = 0u;
        }
        for (int t = 0; t < nk; ++t) {
            asm volatile("s_waitcnt vmcnt(0)" ::: "memory");
            __syncthreads();
            lds_t* cur = lds + ((par + t) & 1) * STAGE;
            lds_t* nxt = lds + ((par + t + 1) & 1) * STAGE;
            if (t + 2 < nk) {
                xd.issue(t + 1, nxt, tid); wr_.store(nxt + BM * 128, wave, lane); wr_.load(wp, ldw, t + 2);
            } else if (t + 1 < nk) {
                xd.issue(t + 1, nxt, tid); wr_.store(nxt + BM * 128, wave, lane);
                if (has_next) {
                    ldw = ldw_n; wp = wfn(lane) + (size_t)(8 * wave) * ldw_n; wr_.load(wp, ldw, 0);
#pragma unroll
                    for (int j = 0; j < NI; ++j) { const int row = 64 * j + 8 * wave + (lane >> 3); offn[j] = rfn.offset(row) + (((lane & 7) ^ swz(row)) << 3); }
                }
            } else if (has_next) {
                xd.base = rfn.base;
#pragma unroll
                for (int j = 0; j < NI; ++j) xd.off[j] = offn[j];
                xd.issue(0, nxt, tid); wr_.store(nxt + BM * 128, wave, lane); wr_.load(wp, ldw, 1);
            }
            gemm_compute<BM, TRANS>(cur, cur + BM * 128, acc, wrow, wcol, lane);
        }
        par = (par + nk) & 1;
        { int t2 = tid; asm volatile("" : "+v"(t2));
          const int w2 = t2 >> 6; epi(acc, w2 >> 2, w2 & 3, t2 & 63); }
    }
};

template <int BM, bool TRANS, class RowFn, class WFn, class Epi>
DEVI void gemm_unit(lds_t* lds, const RowFn& rowfn, const WFn& wfn, unsigned ldw, int nk, const Epi& epi, int tid_in) {
    int tid = tid_in; asm volatile("" : "+v"(tid));
    constexpr int TM = BM / 32;
    constexpr int STAGE = (BM + 256) * 128;
    const int lane = tid & 63, wave = tid >> 6, wr = wave >> 2, wc = wave & 3;
    XDma<BM> xd; WRegs wl;
    const float* wp = wfn(lane) + (size_t)(8 * wave) * ldw;
    wl.load(wp, ldw, 0);
    xd.init(rowfn, tid);
    f32x4 acc[TM][4];
#pragma unroll
    for (int i = 0; i < TM; ++i)
#pragma unroll
        for (int j = 0; j < 4; ++j) acc[i][j] = (f32x4){0.f, 0.f, 0.f, 0.f};
    __syncthreads();
    xd.issue(0, lds, tid); wl.store(lds + BM * 128, wave, lane);
    if (nk > 1) wl.load(wp, ldw, 1);
    for (int t = 0; t < nk; ++t) {
        asm volatile("s_waitcnt vmcnt(0)" ::: "memory");
        __syncthreads();
        lds_t* cur = lds + (t & 1) * STAGE;
        lds_t* nxt = lds + ((t + 1) & 1) * STAGE;
        if (t + 1 < nk) {
            xd.issue(t + 1, nxt, tid); wl.store(nxt + BM * 128, wave, lane);
            if (t + 2 < nk) wl.load(wp, ldw, t + 2);
        }
        gemm_compute<BM, TRANS>(cur, cur + BM * 128, acc, wr, wc, lane);
    }
    { int t2 = tid; asm volatile("" : "+v"(t2));
      const int w2 = t2 >> 6; epi(acc, w2 >> 2, w2 & 3, t2 & 63); }
}

template <int BM, bool TRANS, class RowFn, class WRowFn, class Epi>
DEVI void gemm_unit_bb(lds_t* lds, const RowFn& rowfn, const WRowFn& wrowfn, int nk, const Epi& epi, int tid_in) {
    int tid = tid_in; asm volatile("" : "+v"(tid));
    constexpr int TM = BM / 32;
    constexpr int STAGE = (BM + 256) * 128;
    const int lane = tid & 63, wave = tid >> 6, wr = wave >> 2, wc = wave & 3;
    XDma<BM> xd; XDma<256> wd;
    xd.init(rowfn, tid); wd.init(wrowfn, tid);
    f32x4 acc[TM][4];
#pragma unroll
    for (int i = 0; i < TM; ++i)
#pragma unroll
        for (int j = 0; j < 4; ++j) acc[i][j] = (f32x4){0.f, 0.f, 0.f, 0.f};
    __syncthreads();
    xd.issue(0, lds, tid); wd.issue(0, lds + BM * 128, tid);
    for (int t = 0; t < nk; ++t) {
        asm volatile("s_waitcnt vmcnt(0)" ::: "memory");
        __syncthreads();
        lds_t* cur = lds + (t & 1) * STAGE;
        lds_t* nxt = lds + ((t + 1) & 1) * STAGE;
        if (t + 1 < nk) { xd.issue(t + 1, nxt, tid); wd.issue(t + 1, nxt + BM * 128, tid); }
        gemm_compute<BM, TRANS>(cur, cur + BM * 128, acc, wr, wc, lane);
    }
    { int t2 = tid; asm volatile("" : "+v"(t2));
      const int w2 = t2 >> 6; epi(acc, w2 >> 2, w2 & 3, t2 & 63); }
}

template <int BM, bool TRANS, class RowFn, class WRowFn, class Epi>
DEVI void gemm_unit_bb3(lds_t* lds, const RowFn& rowfn, const WRowFn& wrowfn, int nk, const Epi& epi, int tid_in) {
    int tid = tid_in; asm volatile("" : "+v"(tid));
    constexpr int TM = BM / 32;
    constexpr int STAGE = (BM + 256) * 128;
    static_assert(BM == 128, "3 stages fit for BM = 128 only; the counted wait below assumes 2 + 4 DMA instructions per tile");
    const int lane = tid & 63, wave = tid >> 6, wr = wave >> 2, wc = wave & 3;
    XDma<BM> xd; XDma<256> wd;
    xd.init(rowfn, tid); wd.init(wrowfn, tid);
    f32x4 acc[TM][4];
#pragma unroll
    for (int i = 0; i < TM; ++i)
#pragma unroll
        for (int j = 0; j < 4; ++j) acc[i][j] = (f32x4){0.f, 0.f, 0.f, 0.f};
    __syncthreads();
    lds_t* s0 = lds; lds_t* s1 = lds + STAGE; lds_t* s2 = lds + 2 * STAGE;
    xd.issue(0, s0, tid); wd.issue(0, s0 + BM * 128, tid);
    if (nk > 1) { xd.issue(1, s1, tid); wd.issue(1, s1 + BM * 128, tid); }
    for (int t = 0; t < nk; ++t) {
        if (t + 1 < nk) asm volatile("s_waitcnt vmcnt(6)" ::: "memory");
        else asm volatile("s_waitcnt vmcnt(0)" ::: "memory");
        asm volatile("s_waitcnt lgkmcnt(0)" ::: "memory");
        __builtin_amdgcn_s_barrier();
        asm volatile("" ::: "memory");
        if (t + 2 < nk) { xd.issue(t + 2, s2, tid); wd.issue(t + 2, s2 + BM * 128, tid); }
        gemm_compute<BM, TRANS>(s0, s0 + BM * 128, acc, wr, wc, lane);
        lds_t* tmp = s0; s0 = s1; s1 = s2; s2 = tmp;
    }
    __syncthreads();
    { int t2 = tid; asm volatile("" : "+v"(t2));
      const int w2 = t2 >> 6; epi(acc, w2 >> 2, w2 & 3, t2 & 63); }
}

DEVI int swz32(int row) { return ((((row >> 2) ^ (row >> 3)) & 1) << 1) | ((row >> 2) & 1); }
template <int BM> struct XDma32 {
    static constexpr int NI = BM / 128;
    const bf16_t* base; unsigned off[NI];
    template <class RowFn> DEVI void init(const RowFn& rowfn, int tid) {
        const int w = tid >> 6, i = tid & 63;
        base = rowfn.base;
#pragma unroll
        for (int j = 0; j < NI; ++j) { const int row = 128 * j + 16 * w + (i >> 2); off[j] = rowfn.offset(row) + (((i & 3) ^ swz32(row)) << 3); }
    }
    DEVI void issue(int kt32, lds_t* img, int tid) const {
        lds_t* dst = img + (tid >> 6) * 1024 + (tid & 63) * 16;
#pragma unroll
        for (int j = 0; j < NI; ++j) __builtin_amdgcn_global_load_lds((const unsigned*)(base + off[j] + kt32 * 32), (LAS unsigned*)(dst + j * 8192), 16, 0, 0);
    }
};
template <int BM, bool TRANS>
DEVI void gemm_compute32(lds_t* ximg, lds_t* wimg, f32x4 (&acc)[BM / 32][4], int wr, int wc, int lane) {
    constexpr int TM = BM / 32;
    const int r16 = lane & 15, g = lane >> 4;
    const int c0 = (g ^ swz32(r16)) << 4;
    lds_t* xb = ximg + (wr * (BM / 2) + r16) * 64 + c0;
    lds_t* wb = wimg + (wc * 64 + r16) * 64 + c0;
    bf16x8 wf[4], xf[TM];
#pragma unroll
    for (int nb = 0; nb < 4; ++nb) wf[nb] = lds_ld128(wb + nb * 1024);
#pragma unroll
    for (int mb = 0; mb < TM; ++mb) xf[mb] = lds_ld128(xb + mb * 1024);
#pragma unroll
    for (int mb = 0; mb < TM; ++mb)
#pragma unroll
        for (int nb = 0; nb < 4; ++nb)
            acc[mb][nb] = TRANS ? __builtin_amdgcn_mfma_f32_16x16x32_bf16(wf[nb], xf[mb], acc[mb][nb], 0, 0, 0)
                                : __builtin_amdgcn_mfma_f32_16x16x32_bf16(xf[mb], wf[nb], acc[mb][nb], 0, 0, 0);
}
template <int BM, bool TRANS, class RowFn, class WRowFn, class Epi>
DEVI void gemm_unit_bb4(lds_t* lds, const RowFn& rowfn, const WRowFn& wrowfn, int nk2  , const Epi& epi, int tid_in) {
    int tid = tid_in; asm volatile("" : "+v"(tid));
    constexpr int TM = BM / 32;
    constexpr int XB = BM * 64, STAGE = XB + 256 * 64;
    static_assert(BM == 256, "the counted waits below assume 2 + 2 DMA instructions per sub-tile");
    const int lane = tid & 63, wave = tid >> 6, wr = wave >> 2, wc = wave & 3;
    XDma32<BM> xd; XDma32<256> wd;
    xd.init(rowfn, tid); wd.init(wrowfn, tid);
    f32x4 acc[TM][4];
#pragma unroll
    for (int i = 0; i < TM; ++i)
#pragma unroll
        for (int j = 0; j < 4; ++j) acc[i][j] = (f32x4){0.f, 0.f, 0.f, 0.f};
    __syncthreads();
#pragma unroll
    for (int t = 0; t < 3; ++t) if (t < nk2) { xd.issue(t, lds + t * STAGE, tid); wd.issue(t, lds + t * STAGE + XB, tid); }
    for (int t = 0; t < nk2; ++t) {
        const int rem = nk2 - 1 - t;
        if (rem >= 2) asm volatile("s_waitcnt vmcnt(8)" ::: "memory");
        else if (rem == 1) asm volatile("s_waitcnt vmcnt(4)" ::: "memory");
        else asm volatile("s_waitcnt vmcnt(0)" ::: "memory");
        asm volatile("s_waitcnt lgkmcnt(0)" ::: "memory");
        __builtin_amdgcn_s_barrier();
        asm volatile("" ::: "memory");
        if (t + 3 < nk2) { lds_t* st = lds + ((t + 3) & 3) * STAGE; xd.issue(t + 3, st, tid); wd.issue(t + 3, st + XB, tid); }
        lds_t* cur = lds + (t & 3) * STAGE;
        gemm_compute32<BM, TRANS>(cur, cur + XB, acc, wr, wc, lane);
    }
    __syncthreads();
    { int t2 = tid; asm volatile("" : "+v"(t2));
      const int w2 = t2 >> 6; epi(acc, w2 >> 2, w2 & 3, t2 & 63); }
}

DEVI void phase_modulation(const Params& p, lds_t* lds, int bid, int nblk, int tid) {
    LAS float* sc = (LAS float*)lds;
    LAS float* red = (LAS float*)(lds + 20480);
    __syncthreads();
    for (int i = tid; i < 5 * 1024; i += NTHREADS) {
        const int cnd = i >> 10, k = i & 1023;
        const float v = cnd == 0 ? p.c_ctx[k] : p.c[(cnd - 1) * 1024 + k];
        sc[i] = silu_f(v);
    }
    __syncthreads();
    const int cg = tid & 31, kg = tid >> 5;
    for (int u = bid; u < DEPTH * 48; u += nblk) {
        const int l = u / 48, n0 = (u % 48) * 128;
        const float* w = p.mod_w + (size_t)l * 1024 * 6144 + n0 + 4 * cg;
        f32x4 a[5];
#pragma unroll
        for (int c = 0; c < 5; ++c) a[c] = (f32x4){0.f, 0.f, 0.f, 0.f};
#pragma unroll 8
        for (int kk = 0; kk < 64; ++kk) {
            const int k = kg * 64 + kk;
            const f32x4 wv = *(const f32x4*)(w + (size_t)k * 6144);
#pragma unroll
            for (int c = 0; c < 5; ++c) a[c] += wv * sc[c * 1024 + k];
        }
#pragma unroll
        for (int c = 0; c < 5; ++c) *(LAS f32x4*)(red + (kg * 5 + c) * 128 + 4 * cg) = a[c];
        __syncthreads();
        for (int i = tid; i < 5 * 128; i += NTHREADS) {
            const int c = i >> 7, n = i & 127;
            float s = 0.f;
#pragma unroll
            for (int q = 0; q < 16; ++q) s += red[(q * 5 + c) * 128 + n];
            p.mod[(size_t)(l * 5 + c) * 6144 + n0 + n] = s + p.mod_b[l * 6144 + n0 + n];
        }
        __syncthreads();
    }
}


DEVI void wconv_tile(const float* W, bf16_t* Wt, int K, int N, int tk, int tn, lds_t* lds, int tid) {
    LAS bf16_t* s = (LAS bf16_t*)lds;
    __syncthreads();
#pragma unroll
    for (int i = 0; i < 2; ++i) {
        const int c = tid + NTHREADS * i, k = c >> 4, n4 = (c & 15) * 4;
        const f32x4 v = *(const f32x4*)(W + (size_t)(tk * 64 + k) * N + tn * 64 + n4);
#pragma unroll
        for (int q = 0; q < 4; ++q) s[(n4 + q) * 72 + k] = (bf16_t)(pk_bf16(v[q], 0.f) & 0xffffu);
    }
    __syncthreads();
    { const int n = tid >> 3, kc = tid & 7;
      const u32x4 v = *(LAS u32x4*)(s + n * 72 + kc * 8);
      *(u32x4*)(Wt + (size_t)(tn * 64 + n) * K + tk * 64 + kc * 8) = v; }
}
DEVI void phase_wconv(const Params& p, lds_t* lds, int bid, int nblk, int tid) {
    for (int it = bid; it < 4352; it += nblk) {
        int r = it; const float* W; bf16_t* Wt; int K, N;
        if (r < 352) { const int j = r / 176; r %= 176; W = p.mla_w_in + (size_t)j * 1024 * 704; Wt = p.WTI + (size_t)j * 704 * 1024; K = 1024; N = 704; }
        else if ((r -= 352) < 288) { const int j = r / 144; r %= 144; W = p.mla_w_q_up + (size_t)j * 384 * 1536; Wt = p.WTQ + (size_t)j * 1536 * 384; K = 384; N = 1536; }
        else if ((r -= 288) < 256) { const int j = r / 128; r %= 128; W = p.mla_w_kv_up + (size_t)j * 256 * 2048; Wt = p.WTKV + (size_t)j * 2048 * 256; K = 256; N = 2048; }
        else if ((r -= 256) < 512) { const int j = r / 256; r %= 256; W = p.mla_w_out + (size_t)j * 1024 * 1024; Wt = p.WTO + (size_t)j * 1024 * 1024; K = 1024; N = 1024; }
        else if ((r -= 512) < 1536) { W = p.gm_w_in; Wt = p.WTGI; K = 1024; N = 6144; }
        else if ((r -= 1536) < 768) { W = p.gm_w_out; Wt = p.WTGO; K = 3072; N = 1024; }
        else if ((r -= 768) < 384) { W = p.swa_w_qkv; Wt = p.WTSQ; K = 1024; N = 1536; }
        else { r -= 384; W = p.swa_w_out; Wt = p.WTSO; K = 1024; N = 1024; }
        const int ntn = N / 64;
        wconv_tile(W, Wt, K, N, r / ntn, r % ntn, lds, tid);
    }
}

DEVI void phase_prep(const Params& p, int bid, int nblk, int tid) {
    const int lane = tid & 63, wave = tid >> 6;
    for (int row = bid * 8 + wave; row < NTOK; row += nblk * 8) {
        const float* src = row < NPR ? p.x_prompt + (size_t)row * D : p.x_sample + (size_t)(row - NPR) * D;
        const int cnd = cond_of_row(row);
        const float* sh = modp(p, 0, cnd, 0); const float* scl = modp(p, 0, cnd, 1);
#pragma unroll
        for (int i = 0; i < 4; ++i) {
            const int col = lane * 4 + 256 * i;
            const f32x4 v = *(const f32x4*)(src + col);
            const f32x4 s = *(const f32x4*)(scl + col), b = *(const f32x4*)(sh + col);
            const f32x4 h = v * (s + 1.0f) + b;
            u32x2 o; o.x = pk_bf16(h[0], h[1]); o.y = pk_bf16(h[2], h[3]);
            *(u32x2*)(p.H + (size_t)row * D + col) = o;
        }
    }
    for (int i = bid * NTHREADS + tid; i < 1024 * 64; i += nblk * NTHREADS) {
        const f32x4 v = *(const f32x4*)(p.cache_k + (size_t)i * 4);
        u32x2 o; o.x = pk_bf16(v[0], v[1]); o.y = pk_bf16(v[2], v[3]);
        *(u32x2*)(p.SK + (size_t)NTOK * 256 + (size_t)i * 4) = o;
    }
    for (int i = bid * NTHREADS + tid; i < 4 * 4 * 64 * 64; i += nblk * NTHREADS) {
        const int kg4 = i & 63, dv = (i >> 6) & 63, kvh = (i >> 12) & 3, b = i >> 14;
        float v[4];
#pragma unroll
        for (int q = 0; q < 4; ++q) v[q] = p.cache_v[((size_t)(b * 256 + kg4 * 4 + q) * 4 + kvh) * 64 + dv];
        u32x2 o; o.x = pk_bf16(v[0], v[1]); o.y = pk_bf16(v[2], v[3]);
        *(u32x2*)(p.SVTS + ((size_t)(b * 4 + kvh) * 64 + dv) * 1280 + kg4 * 4) = o;
    }
}

DEVI void phase_mla_norm(const Params& p, int j, int bid, int nblk, int tid) {
    const int lane = tid & 63, wave = tid >> 6;
    const float* qg = p.mla_q_gain + j * 384; const float* kg = p.mla_kv_gain + j * 256;
    for (int row = bid * 8 + wave; row < NROWS_KV; row += nblk * 8) {
        if (row >= NTOK) {
            const int b = (row - NTOK) >> 8, t = (row - NTOK) & 255;
            const float* ck = p.cache_ckv + ((size_t)(b * 2 + j) * 256 + t) * 256;
            const f32x4 v = *(const f32x4*)(ck + lane * 4);
            u32x2 o; o.x = pk_bf16(v[0], v[1]); o.y = pk_bf16(v[2], v[3]);
            *(u32x2*)(p.CKV + (size_t)row * 256 + lane * 4) = o;
            const float kp = p.cache_kpe[((size_t)(b * 2 + j) * 256 + t) * 64 + lane];
            p.KPE[(size_t)row * 64 + lane] = (bf16_t)(pk_bf16(kp, 0.f) & 0xffffu);
            continue;
        }
        const float* z = p.Z + (size_t)row * 704;
        float q[6]; float ss = 0.f;
#pragma unroll
        for (int i = 0; i < 6; ++i) { q[i] = z[lane + 64 * i]; ss += q[i] * q[i]; }
        ss = wave_sum(ss);
        const float rq = rsqrtf(ss * (1.0f / 384.0f) + EPS_F);
#pragma unroll
        for (int i = 0; i < 6; ++i) p.CQ[(size_t)row * 384 + lane + 64 * i] = (bf16_t)(pk_bf16(q[i] * rq * qg[lane + 64 * i], 0.f) & 0xffffu);
        const f32x4 kv = *(const f32x4*)(z + 384 + lane * 4);
        float s2 = kv[0] * kv[0] + kv[1] * kv[1] + kv[2] * kv[2] + kv[3] * kv[3];
        s2 = wave_sum(s2);
        const float rk = rsqrtf(s2 * (1.0f / 256.0f) + EPS_F);
        const f32x4 gv = *(const f32x4*)(kg + lane * 4);
        const f32x4 kn = kv * rk * gv;
        { u32x2 o; o.x = pk_bf16(kn[0], kn[1]); o.y = pk_bf16(kn[2], kn[3]); *(u32x2*)(p.CKV + (size_t)row * 256 + lane * 4) = o; }
        float kp = z[640 + lane];
        if (row < NPR) {
            const int b = row >> 8, t = row & 255;
            *(f32x4*)(p.out + OUT_CKV + ((size_t)(b * 2 + j) * 256 + t) * 256 + lane * 4) = kn;
            p.out[OUT_KPE + ((size_t)(b * 2 + j) * 256 + t) * 64 + lane] = kp;
        } else {
            const int t = (row - NPR) & 1023;
            const int pos = lane < 32 ? (t >> 6) : (t & 63);
            const float cs = rope_tab[(pos * 16 + (lane & 15)) * 2], sn = rope_tab[(pos * 16 + (lane & 15)) * 2 + 1];
            const float other = __shfl_xor(kp, 16);
            kp = (lane & 16) ? (kp * cs + other * sn) : (kp * cs - other * sn);
        }
        p.KPE[(size_t)row * 64 + lane] = (bf16_t)(pk_bf16(kp, 0.f) & 0xffffu);
    }
}

DEVI void phase_ln_a(const Params& p, int layer, lds_t* lds, int bid, int nblk, int tid) {
    const int lane = tid & 63, wave = tid >> 6;
    LAS float* rt = (LAS float*)lds;
    const float* router = p.moe_router + (size_t)layer * 1024 * 16;
    __syncthreads();
    for (int i = tid; i < 4096; i += NTHREADS) {
        const f32x4 w = *(const f32x4*)(router + i * 4);
        const int k = i >> 2, e0 = (i & 3) * 4;
        rt[(e0 + 0) * 1024 + k] = w[0]; rt[(e0 + 1) * 1024 + k] = w[1]; rt[(e0 + 2) * 1024 + k] = w[2]; rt[(e0 + 3) * 1024 + k] = w[3];
    }
    __syncthreads();
    const float* lg = p.ln_gain + (layer * 2 + 0) * 1024; const float* lb = p.ln_bias + (layer * 2 + 0) * 1024;
    for (int r0 = (bid * 8 + wave) * 4; r0 < NTOK; r0 += nblk * 32) {
        const int cnd = cond_of_row(r0);
        const float* sh = modp(p, layer, cnd, 3); const float* scl = modp(p, layer, cnd, 4);
        f32x4 v[4][4];
        float mu[4], rs[4];
#pragma unroll
        for (int j = 0; j < 4; ++j)
#pragma unroll
            for (int i = 0; i < 4; ++i) v[j][i] = *(const f32x4*)(p.T + (size_t)(r0 + j) * D + lane * 4 + 256 * i);
#pragma unroll
        for (int j = 0; j < 4; ++j) { float s = 0.f;
#pragma unroll
            for (int i = 0; i < 4; ++i) s += (v[j][i][0] + v[j][i][1]) + (v[j][i][2] + v[j][i][3]);
            mu[j] = s; }
#pragma unroll
        for (int j = 0; j < 4; ++j) mu[j] = wave_sum(mu[j]) * (1.0f / 1024.0f);
#pragma unroll
        for (int j = 0; j < 4; ++j) { float q = 0.f;
#pragma unroll
            for (int i = 0; i < 4; ++i) { v[j][i] = v[j][i] - mu[j]; q += (v[j][i][0] * v[j][i][0] + v[j][i][1] * v[j][i][1]) + (v[j][i][2] * v[j][i][2] + v[j][i][3] * v[j][i][3]); }
            rs[j] = q; }
#pragma unroll
        for (int j = 0; j < 4; ++j) rs[j] = rsqrtf(wave_sum(rs[j]) * (1.0f / 1024.0f) + EPS_F);
        float lgt[4][16];
#pragma unroll
        for (int j = 0; j < 4; ++j)
#pragma unroll
            for (int e = 0; e < 16; ++e) lgt[j][e] = 0.f;
#pragma unroll
        for (int i = 0; i < 4; ++i) {
            const int col = lane * 4 + 256 * i;
            const f32x4 g4 = *(const f32x4*)(lg + col), b4 = *(const f32x4*)(lb + col), sc4 = *(const f32x4*)(scl + col) + 1.0f, sh4 = *(const f32x4*)(sh + col);
            f32x4 h[4];
#pragma unroll
            for (int j = 0; j < 4; ++j) {
                const f32x4 x = v[j][i] * rs[j] * g4 + b4;
                *(f32x4*)(p.X1 + (size_t)(r0 + j) * D + col) = x;
                h[j] = x * sc4 + sh4;
                u32x2 o; o.x = pk_bf16(h[j][0], h[j][1]); o.y = pk_bf16(h[j][2], h[j][3]);
                *(u32x2*)(p.H2 + (size_t)(r0 + j) * D + col) = o;
            }
#pragma unroll
            for (int e = 0; e < 16; ++e) {
                const f32x4 rw = *(LAS f32x4*)(rt + e * 1024 + col);
#pragma unroll
                for (int j = 0; j < 4; ++j) lgt[j][e] += (h[j][0] * rw[0] + h[j][1] * rw[1]) + (h[j][2] * rw[2] + h[j][3] * rw[3]);
                if ((e & 3) == 3) __builtin_amdgcn_sched_barrier(0);
            }
        }
        float r1[4];
#pragma unroll
        for (int j = 0; j < 4; ++j) {
            float r8[8], r4[4], r2[2];
            { const bool hi = (lane & 32) != 0;
#pragma unroll
              for (int i = 0; i < 8; ++i) { const float keep = hi ? lgt[j][8 + i] : lgt[j][i], send = hi ? lgt[j][i] : lgt[j][8 + i]; r8[i] = keep + __shfl_xor(send, 32); } }
            { const bool hi = (lane & 16) != 0;
#pragma unroll
              for (int i = 0; i < 4; ++i) { const float keep = hi ? r8[4 + i] : r8[i], send = hi ? r8[i] : r8[4 + i]; r4[i] = keep + __shfl_xor(send, 16); } }
            { const bool hi = (lane & 8) != 0;
#pragma unroll
              for (int i = 0; i < 2; ++i) { const float keep = hi ? r4[2 + i] : r4[i], send = hi ? r4[i] : r4[2 + i]; r2[i] = keep + __shfl_xor(send, 8); } }
            { const bool hi = (lane & 4) != 0; const float keep = hi ? r2[1] : r2[0], send = hi ? r2[0] : r2[1]; r1[j] = keep + __shfl_xor(send, 4); }
        }
        const int e = ((lane >> 5) & 1) * 8 + ((lane >> 4) & 1) * 4 + ((lane >> 3) & 1) * 2 + ((lane >> 2) & 1);
#pragma unroll
        for (int j = 0; j < 4; ++j) {
            float r = r1[j];
            r += __shfl_xor(r, 2); r += __shfl_xor(r, 1);
            float mx = r;
            mx = fmaxf(mx, __shfl_xor(mx, 4)); mx = fmaxf(mx, __shfl_xor(mx, 8)); mx = fmaxf(mx, __shfl_xor(mx, 16)); mx = fmaxf(mx, __shfl_xor(mx, 32));
            const float ex = __expf(r - mx);
            float den = ex;
            den += __shfl_xor(den, 4); den += __shfl_xor(den, 8); den += __shfl_xor(den, 16); den += __shfl_xor(den, 32);
            if ((lane & 3) == 0) p.AFF[(size_t)e * NTOK + r0 + j] = ex / den;
        }
    }
}

DEVI int block_sum_i(int v, LAS int* red, int tid) {
    const int lane = tid & 63, wave = tid >> 6;
    v = __builtin_popcountll(__ballot(v & 1)) + 2 * __builtin_popcountll(__ballot(v & 2)) + 4 * __builtin_popcountll(__ballot(v & 4)) + 8 * __builtin_popcountll(__ballot(v & 8));
    __syncthreads();
    if (lane == 0) red[wave] = v;
    __syncthreads();
    return (red[0] + red[1]) + (red[2] + red[3]) + (red[4] + red[5]) + (red[6] + red[7]);
}
DEVI int block_excl_scan_i(int v, LAS int* red, int tid, int& total) {
    const int lane = tid & 63, wave = tid >> 6;
    int inc = v;
#pragma unroll
    for (int o = 1; o < 64; o <<= 1) { const int t = __shfl_up(inc, o); if (lane >= o) inc += t; }
    __syncthreads();
    if (lane == 63) red[wave] = inc;
    __syncthreads();
    int base = 0, tot = 0;
#pragma unroll
    for (int w = 0; w < 8; ++w) { const int c = red[w]; if (w < wave) base += c; tot += c; }
    total = tot;
    return base + inc - v;
}
DEVI void phase_topk(const Params& p, lds_t* lds, int bid, int nblk, int tid) {
    LAS int* red = (LAS int*)lds;
    for (int it = bid; it < 32; it += nblk) {
        const int grp = it >> 4, e = it & 15;
        const float* a = p.AFF + (size_t)e * NTOK + grp * 4096 + tid * 8;
        const f32x4 a0 = *(const f32x4*)a, a1 = *(const f32x4*)(a + 4);
        unsigned key[8];
#pragma unroll
        for (int i = 0; i < 4; ++i) { key[i] = __float_as_uint(a0[i]); key[4 + i] = __float_as_uint(a1[i]); }
        unsigned thr = 0u;
        for (int bit = 30; bit >= 0; --bit) {
            const unsigned cand = thr | (1u << bit);
            int c = 0;
#pragma unroll
            for (int i = 0; i < 8; ++i) c += key[i] >= cand ? 1 : 0;
            if (block_sum_i(c, red, tid) >= 512) thr = cand;
        }
        int cgt = 0, ceq = 0;
#pragma unroll
        for (int i = 0; i < 8; ++i) { cgt += key[i] > thr ? 1 : 0; ceq += key[i] == thr ? 1 : 0; }
        int ngt, neq;
        (void)block_excl_scan_i(cgt, red, tid, ngt);
        int tie_rank = block_excl_scan_i(ceq, red, tid, neq);
        const int need = 512 - ngt;
        int sel[8], cs = 0;
#pragma unroll
        for (int i = 0; i < 8; ++i) {
            const bool eq = key[i] == thr;
            sel[i] = (key[i] > thr || (eq && tie_rank < need)) ? 1 : 0;
            tie_rank += eq ? 1 : 0; cs += sel[i];
        }
        int tot;
        int slot = block_excl_scan_i(cs, red, tid, tot);
#pragma unroll
        for (int i = 0; i < 8; ++i) {
            const int t = grp * 4096 + tid * 8 + i;
            int sl = -1;
            if (sel[i]) { sl = grp * 512 + slot; ++slot; p.IDX[e * 1024 + sl] = t; p.GATEV[e * 1024 + sl] = __uint_as_float(key[i]); }
            p.SEL[(size_t)t * 16 + e] = sl;
        }
    }
}

DEVI void phase_ln_b(const Params& p, int layer, int bid, int nblk, int tid) {
    const int lane = tid & 63, wave = tid >> 6;
    const float* lg = p.ln_gain + (layer * 2 + 1) * 1024; const float* lb = p.ln_bias + (layer * 2 + 1) * 1024;
    const bool last = (layer == DEPTH - 1);
    float* xo = last ? p.out + OUT_Y : p.X0;
    const int stride = nblk * 8;
    int row = bid * 8 + wave;
    int seln = -1; f32x4 xn[4];
    if (row < NTOK) {
        if (lane < 16) seln = p.SEL[(size_t)row * 16 + lane];
#pragma unroll
        for (int i = 0; i < 4; ++i) xn[i] = *(const f32x4*)(p.X1 + (size_t)row * D + lane * 4 + 256 * i);
    }
    for (; row < NTOK; row += stride) {
        const int selv = seln;
        f32x4 v[4];
#pragma unroll
        for (int i = 0; i < 4; ++i) v[i] = xn[i];
        unsigned long long mask = __ballot(selv >= 0);
        f32x4 y[4];
#pragma unroll
        for (int i = 0; i < 4; ++i) y[i] = (f32x4){0.f, 0.f, 0.f, 0.f};
        while (mask) {
            const int e0 = __builtin_ctzll(mask); mask &= mask - 1;
            const int s0 = __builtin_amdgcn_readlane(selv, e0);
            const bf16_t* y0 = p.YE + ((size_t)e0 * 1024 + s0) * 1024 + lane * 4;
            const bool two = mask != 0;
            int e1 = e0, s1 = s0;
            if (two) { e1 = __builtin_ctzll(mask); mask &= mask - 1; s1 = __builtin_amdgcn_readlane(selv, e1); }
            const bf16_t* y1 = p.YE + ((size_t)e1 * 1024 + s1) * 1024 + lane * 4;
            u32x2 w0[4], w1[4];
#pragma unroll
            for (int i = 0; i < 4; ++i) { w0[i] = *(const u32x2*)(y0 + 256 * i); w1[i] = *(const u32x2*)(y1 + 256 * i); }
            const float f1 = two ? 1.0f : 0.0f;
#pragma unroll
            for (int i = 0; i < 4; ++i) {
                y[i][0] += bf_lo(w0[i].x) + f1 * bf_lo(w1[i].x); y[i][1] += bf_hi(w0[i].x) + f1 * bf_hi(w1[i].x);
                y[i][2] += bf_lo(w0[i].y) + f1 * bf_lo(w1[i].y); y[i][3] += bf_hi(w0[i].y) + f1 * bf_hi(w1[i].y);
            }
        }
        if (row + stride < NTOK) {
            seln = -1;
            if (lane < 16) seln = p.SEL[(size_t)(row + stride) * 16 + lane];
#pragma unroll
            for (int i = 0; i < 4; ++i) xn[i] = *(const f32x4*)(p.X1 + (size_t)(row + stride) * D + lane * 4 + 256 * i);
        }
        const int cnd = cond_of_row(row);
        const float* gt = modp(p, layer, cnd, 5);
        float s = 0.f;
#pragma unroll
        for (int i = 0; i < 4; ++i) {
            const int col = lane * 4 + 256 * i;
            v[i] = v[i] * ALPHA_F + *(const f32x4*)(gt + col) * y[i];
            s += (v[i][0] + v[i][1]) + (v[i][2] + v[i][3]);
        }
        s = wave_sum(s);
        const float mu = s * (1.0f / 1024.0f);
        float q = 0.f;
#pragma unroll
        for (int i = 0; i < 4; ++i) { v[i] = v[i] - mu; q += (v[i][0] * v[i][0] + v[i][1] * v[i][1]) + (v[i][2] * v[i][2] + v[i][3] * v[i][3]); }
        q = wave_sum(q);
        const float rs = rsqrtf(q * (1.0f / 1024.0f) + EPS_F);
        const float* sh = modp(p, last ? layer : layer + 1, cnd, 0); const float* scl = modp(p, last ? layer : layer + 1, cnd, 1);
#pragma unroll
        for (int i = 0; i < 4; ++i) {
            const int col = lane * 4 + 256 * i;
            const f32x4 x = v[i] * rs * *(const f32x4*)(lg + col) + *(const f32x4*)(lb + col);
            *(f32x4*)(xo + (size_t)row * D + col) = x;
            if (!last) {
                const f32x4 h = x * (*(const f32x4*)(scl + col) + 1.0f) + *(const f32x4*)(sh + col);
                u32x2 o; o.x = pk_bf16(h[0], h[1]); o.y = pk_bf16(h[2], h[3]);
                *(u32x2*)(p.H + (size_t)row * D + col) = o;
            }
        }
    }
}

constexpr int GBM = 128;
constexpr int GBM2 = 256;
DEVI int xcd_first_unit(int bid, int nblk) { return (nblk & 7) ? bid : (bid & 7) * (nblk >> 3) + (bid >> 3); }
struct RowLin { const bf16_t* base; unsigned ld; DEVI unsigned offset(int r) const { return (unsigned)r * ld; } };
struct RowGather { const bf16_t* base; const int* idx; DEVI unsigned offset(int r) const { return (unsigned)(idx[r] & 8191) * 1024u; } };
struct RowClamp { const bf16_t* base; unsigned ld; int r0, rmax; DEVI unsigned offset(int r) const { int q = r0 + r; if (q > rmax) q = rmax; return (unsigned)q * ld; } };
struct RowKv { const bf16_t* base; int n0, isv; DEVI unsigned offset(int r) const { const int n = n0 + r; return (unsigned)((n >> 7) * 256 + isv * 128 + (n & 127)) * 256u; } };
struct GDesc { RowLin rf; WLin wl; unsigned ldw; int nk; };
struct WUp { const float* base; int kv; DEVI const float* operator()(int lane) const { return kv ? base + (lane >> 5) * 256 + ((4 * lane) & 127) : base + 4 * lane; } };
struct GDescUp { RowLin rf; WUp wl; unsigned ldw; };
struct WClamp { const float* base; int col0; DEVI const float* operator()(int lane) const { int c = col0 + 4 * lane; if (c > 700) c = 700; return base + c; } };
struct WMoe { const float* gate; const float* up; size_t off; DEVI const float* operator()(int lane) const { const int r = 4 * lane, sub = r >> 5;
    const unsigned long long ga = (unsigned long long)gate, ua = (unsigned long long)up, mk = 0ull - (unsigned long long)(sub & 1);
    return (const float*)(ga ^ ((ga ^ ua) & mk)) + off + 32 * (sub >> 1) + 8 * ((r & 15) >> 2) + 4 * ((r >> 4) & 1); } };

DEVI void st_bf16x4(bf16_t* dst, f32x4 v) { u32x2 o; o.x = pk_bf16(v[0], v[1]); o.y = pk_bf16(v[2], v[3]); *(u32x2*)dst = o; }

template <int TM> DEVI void rope_tile(f32x4 (&acc)[TM][4], int row0  , int lane) {
    const int r16 = lane & 15, g = lane >> 4;
#pragma unroll
    for (int mb = 0; mb < TM; ++mb) {
        const int t = (row0 + mb * 16 + r16 - NPR) & 1023;
        const int prow = t >> 6, pcol = t & 63;
#pragma unroll
        for (int r = 0; r < 4; ++r) {
            const int f = 4 * g + r;
            const float c1 = rope_tab[(prow * 16 + f) * 2], s1 = rope_tab[(prow * 16 + f) * 2 + 1];
            const float c2 = rope_tab[(pcol * 16 + f) * 2], s2 = rope_tab[(pcol * 16 + f) * 2 + 1];
            const float a1 = acc[mb][0][r], a2 = acc[mb][1][r], b1 = acc[mb][2][r], b2 = acc[mb][3][r];
            acc[mb][0][r] = a1 * c1 - a2 * s1; acc[mb][1][r] = a2 * c1 + a1 * s1;
            acc[mb][2][r] = b1 * c2 - b2 * s2; acc[mb][3][r] = b2 * c2 + b1 * s2;
        }
        __builtin_amdgcn_sched_barrier(0);
    }
}

template <int BM> struct EpiZ { float* Z; int m0, n0;
    DEVI void operator()(const f32x4 (&acc)[BM / 32][4], int wr, int wc, int lane) const {
        const int r16 = lane & 15, g = lane >> 4;
#pragma unroll
        for (int mb = 0; mb < BM / 32; ++mb) { const int row = m0 + wr * (BM / 2) + mb * 16 + r16;
#pragma unroll
            for (int nb = 0; nb < 4; ++nb) { const int col = n0 + wc * 64 + nb * 16 + 4 * g; if (col < 704) *(f32x4*)(Z + (size_t)row * 704 + col) = acc[mb][nb]; } }
    } };
DEVI void phase_mla_win(const Params& p, int j, lds_t* lds, int bid, int nblk, int tid) {
    constexpr int MT = NTOK / GBM, NU = MT * 3;
    for (int u = xcd_first_unit(bid, nblk); u < NU; u += nblk) {
        const int mt = u % MT, nt = u / MT;
        RowLin rf{p.H + (size_t)mt * GBM * 1024, 1024u};
        RowClamp wf{p.WTI + (size_t)j * 704 * 1024, 1024u, nt * 256, 703};
        EpiZ<GBM> epi{p.Z, mt * GBM, nt * 256};
        gemm_unit_bb3<GBM, true>(lds, rf, wf, 16, epi, tid);
    }
}

template <int BM> struct EpiQ { bf16_t* Q; int m0, n0; float scale;
    DEVI void operator()(f32x4 (&acc)[BM / 32][4], int wr, int wc, int lane) const {
        const int r16 = lane & 15, g = lane >> 4;
        const int ncol0 = n0 + wc * 64;
        if (m0 >= NPR && (ncol0 % 192) == 128) rope_tile<BM / 32>(acc, m0 + wr * (BM / 2), lane);
#pragma unroll
        for (int mb = 0; mb < BM / 32; ++mb) { const int row = m0 + wr * (BM / 2) + mb * 16 + r16;
#pragma unroll
            for (int nb = 0; nb < 4; ++nb) st_bf16x4(Q + (size_t)row * 1536 + ncol0 + nb * 16 + 4 * g, acc[mb][nb] * scale); }
    } };
template <int BM> struct EpiKN { bf16_t* KN; int m0, n0;
    DEVI void operator()(const f32x4 (&acc)[BM / 32][4], int wr, int wc, int lane) const {
        const int r16 = lane & 15, g = lane >> 4;
#pragma unroll
        for (int mb = 0; mb < BM / 32; ++mb) { const int row = m0 + wr * (BM / 2) + mb * 16 + r16;
#pragma unroll
            for (int nb = 0; nb < 4; ++nb) st_bf16x4(KN + (size_t)row * 1024 + n0 + wc * 64 + nb * 16 + 4 * g, acc[mb][nb]); }
    } };
template <int BM> struct EpiVT { bf16_t* VTP; bf16_t* VTS; int m0, n0;
    DEVI void operator()(const f32x4 (&acc)[BM / 32][4], int wr, int wc, int lane) const {
        const int r16 = lane & 15, g = lane >> 4;
#pragma unroll
        for (int mb = 0; mb < BM / 32; ++mb) { const int row = m0 + wr * (BM / 2) + mb * 16 + 4 * g;
            bf16_t* dst;
            if (row < NPR) dst = VTP + (size_t)(row >> 8) * (8 * 128 * 256) + (row & 255);
            else if (row < NTOK) dst = VTS + (size_t)((row - NPR) >> 10) * (8 * 128 * 1280) + 256 + ((row - NPR) & 1023);
            else dst = VTS + (size_t)((row - NTOK) >> 8) * (8 * 128 * 1280) + ((row - NTOK) & 255);
            const size_t ldk = row < NPR ? 256 : 1280;
#pragma unroll
            for (int nb = 0; nb < 4; ++nb) { const int col = n0 + wc * 64 + nb * 16 + r16;
                st_bf16x4(dst + (size_t)col * ldk, acc[mb][nb]); } }
    } };
DEVI void phase_mla_up(const Params& p, int j, lds_t* lds, int bid, int nblk, int tid) {
    const float qscale = 0.07216878364870322f * LOG2E;
    constexpr int MTQ = NTOK / GBM2, MTK = NROWS_KV / GBM2, NQ = MTQ * 6, NK = MTK * 4, NU = NQ + 2 * NK;
    for (int u = xcd_first_unit(bid, nblk); u < NU; u += nblk) {
        if (u < NQ) {
            const int mt = u % MTQ, nt = u / MTQ;
            RowLin rf{p.CQ + (size_t)mt * GBM2 * 384, 384u};
            RowLin wf{p.WTQ + (size_t)j * 1536 * 384 + (size_t)nt * 256 * 384, 384u};
            EpiQ<GBM2> epi{p.Q, mt * GBM2, nt * 256, qscale};
            gemm_unit_bb<GBM2, true>(lds, rf, wf, 6, epi, tid);
        } else if (u < NQ + NK) {
            const int v = u - NQ, mt = v % MTK, nt = v / MTK;
            RowLin rf{p.CKV + (size_t)mt * GBM2 * 256, 256u};
            RowKv wf{p.WTKV + (size_t)j * 2048 * 256, nt * 256, 0};
            EpiKN<GBM2> epi{p.KN, mt * GBM2, nt * 256};
            gemm_unit_bb<GBM2, true>(lds, rf, wf, 4, epi, tid);
        } else {
            const int v = u - NQ - NK, mt = v % MTK, nt = v / MTK;
            RowLin rf{p.CKV + (size_t)mt * GBM2 * 256, 256u};
            RowKv wf{p.WTKV + (size_t)j * 2048 * 256, nt * 256, 1};
            EpiVT<GBM2> epi{p.VTP, p.VTS, mt * GBM2, nt * 256};
            gemm_unit_bb<GBM2, false>(lds, rf, wf, 4, epi, tid);
        }
    }
}

struct EpiRes { float* T; const float* X0; const float* mod; int layer, m0, n0;
    DEVI void operator()(const f32x4 (&acc)[4][4], int wr, int wc, int lane) const {
        const int r16 = lane & 15, g = lane >> 4;
        const int cnd = cond_of_row(m0);
        const float* gt = mod + ((size_t)(layer * 5 + cnd) * 6 + 2) * 1024;
#pragma unroll
        for (int nb = 0; nb < 4; ++nb) { const int col = n0 + wc * 64 + nb * 16 + 4 * g; const f32x4 gv = *(const f32x4*)(gt + col);
#pragma unroll
            for (int mb = 0; mb < 4; ++mb) { const size_t o = (size_t)(m0 + wr * 64 + mb * 16 + r16) * 1024 + col;
                *(f32x4*)(T + o) = *(const f32x4*)(X0 + o) * ALPHA_F + gv * acc[mb][nb]; } }
    } };
DEVI void phase_out_proj(const Params& p, int layer, const bf16_t* A, int K, const bf16_t* Wt, lds_t* lds, int bid, int nblk, int tid) {
    constexpr int NU = 64 * 4;
    for (int u = xcd_first_unit(bid, nblk); u < NU; u += nblk) {
        const int mt = u & 63, nt = u >> 6;
        RowLin rf{A + (size_t)mt * 128 * K, (unsigned)K};
        RowLin wf{Wt + (size_t)nt * 256 * K, (unsigned)K};
        const float* xres = layer ? p.X0 : (mt * 128 < NPR ? p.x_prompt : p.x_sample - (size_t)NPR * D);
        EpiRes epi{p.T, xres, p.mod, layer, mt * 128, nt * 256};
        gemm_unit_bb3<128, true>(lds, rf, wf, K / 64, epi, tid);
    }
}

template <int BM> struct EpiGU { bf16_t* U; int m0, n0;
    DEVI void operator()(const f32x4 (&acc)[BM / 32][4], int wr, int wc, int lane) const {
        const int r16 = lane & 15, g = lane >> 4;
#pragma unroll
        for (int mb = 0; mb < BM / 32; ++mb) { const int row = m0 + wr * (BM / 2) + mb * 16 + r16;
#pragma unroll
            for (int nb = 0; nb < 4; ++nb) { f32x4 v = acc[mb][nb];
                v[0] = gelu_tanh_f(v[0]); v[1] = gelu_tanh_f(v[1]); v[2] = gelu_tanh_f(v[2]); v[3] = gelu_tanh_f(v[3]);
                st_bf16x4(U + (size_t)row * 3072 + n0 + wc * 64 + nb * 16 + 4 * g, v); } }
    } };
template <int BM> struct EpiGV { bf16_t* GVT; float* GST; int m0, n0;
    DEVI void operator()(const f32x4 (&acc)[BM / 32][4], int wr, int wc, int lane) const {
        const int r16 = lane & 15, g = lane >> 4;
        const int part = (n0 >> 6) + wc;
#pragma unroll
        for (int mb = 0; mb < BM / 32; ++mb) { const int row = m0 + wr * (BM / 2) + mb * 16 + 4 * g;
            f32x4 s = (f32x4){0.f, 0.f, 0.f, 0.f}, q = s;
#pragma unroll
            for (int nb = 0; nb < 4; ++nb) { f32x4 v = acc[mb][nb];
                v[0] = gelu_tanh_f(v[0]); v[1] = gelu_tanh_f(v[1]); v[2] = gelu_tanh_f(v[2]); v[3] = gelu_tanh_f(v[3]);
                s += v; q += v * v;
                const int col = n0 + wc * 64 + nb * 16 + r16;
                st_bf16x4(GVT + ((size_t)(row >> 7) * 3072 + col) * 128 + (row & 127), v); }
#pragma unroll
            for (int o = 1; o < 16; o <<= 1) {
#pragma unroll
                for (int r = 0; r < 4; ++r) { s[r] += __shfl_xor(s[r], o); q[r] += __shfl_xor(q[r], o); } }
            if (r16 == 0) {
#pragma unroll
                for (int r = 0; r < 4; ++r) { f32x2 w; w.x = s[r]; w.y = q[r]; *(f32x2*)(GST + ((size_t)(row + r) * 48 + part) * 2) = w; } }
        }
    } };
DEVI void phase_gm_win(const Params& p, lds_t* lds, int bid, int nblk, int tid) {
    constexpr int MT = NTOK / GBM2, NU = MT * 24;
    for (int u = xcd_first_unit(bid, nblk); u < NU; u += nblk) {
        const int mt = u % MT, nt = u / MT;
        RowLin rf{p.H + (size_t)mt * GBM2 * 1024, 1024u};
        RowLin wf{p.WTGI + (size_t)nt * 256 * 1024, 1024u};
        if (nt < 12) { EpiGU<GBM2> epi{p.U, mt * GBM2, nt * 256}; gemm_unit_bb<GBM2, true>(lds, rf, wf, 16, epi, tid); }
        else { EpiGV<GBM2> epi{p.GVT, p.GST, mt * GBM2, (nt - 12) * 256}; gemm_unit_bb<GBM2, false>(lds, rf, wf, 16, epi, tid); }
    }
}

template <int BM> struct EpiSQ { bf16_t* Q; int m0, n0; float scale;
    DEVI void operator()(f32x4 (&acc)[BM / 32][4], int wr, int wc, int lane) const {
        const int r16 = lane & 15, g = lane >> 4;
        if (m0 >= NPR) rope_tile<BM / 32>(acc, m0 + wr * (BM / 2), lane);
#pragma unroll
        for (int mb = 0; mb < BM / 32; ++mb) { const int row = m0 + wr * (BM / 2) + mb * 16 + r16;
#pragma unroll
            for (int nb = 0; nb < 4; ++nb) st_bf16x4(Q + (size_t)row * 1024 + n0 + wc * 64 + nb * 16 + 4 * g, acc[mb][nb] * scale); }
    } };
template <int BM> struct EpiSK { bf16_t* SK; float* out; int m0;
    DEVI void operator()(f32x4 (&acc)[BM / 32][4], int wr, int wc, int lane) const {
        const int r16 = lane & 15, g = lane >> 4;
        if (m0 >= NPR) rope_tile<BM / 32>(acc, m0 + wr * (BM / 2), lane);
#pragma unroll
        for (int mb = 0; mb < BM / 32; ++mb) { const int row = m0 + wr * (BM / 2) + mb * 16 + r16;
#pragma unroll
            for (int nb = 0; nb < 4; ++nb) { const int col = wc * 64 + nb * 16 + 4 * g;
                if (m0 < NPR) *(f32x4*)(out + OUT_SK + (size_t)row * 256 + col) = acc[mb][nb];
                st_bf16x4(SK + (size_t)row * 256 + col, acc[mb][nb]); } }
    } };
template <int BM> struct EpiSV { bf16_t* SVTP; bf16_t* SVTS; float* out; int m0;
    DEVI void operator()(const f32x4 (&acc)[BM / 32][4], int wr, int wc, int lane) const {
        const int r16 = lane & 15, g = lane >> 4;
#pragma unroll
        for (int mb = 0; mb < BM / 32; ++mb) { const int row = m0 + wr * (BM / 2) + mb * 16 + 4 * g;
            bf16_t* dst; size_t ldk;
            if (row < NPR) { dst = SVTP + (size_t)(row >> 8) * (4 * 64 * 256) + (row & 255); ldk = 256; }
            else { dst = SVTS + (size_t)((row - NPR) >> 10) * (4 * 64 * 1280) + 256 + ((row - NPR) & 1023); ldk = 1280; }
#pragma unroll
            for (int nb = 0; nb < 4; ++nb) { const int col = wc * 64 + nb * 16 + r16;
                st_bf16x4(dst + (size_t)col * ldk, acc[mb][nb]);
                if (row < NPR) {
#pragma unroll
                    for (int r = 0; r < 4; ++r) out[OUT_SV + (size_t)(row + r) * 256 + col] = acc[mb][nb][r]; } } }
    } };
DEVI void phase_swa_qkv(const Params& p, lds_t* lds, int bid, int nblk, int tid) {
    constexpr int MT = NTOK / GBM2, NU = MT * 6;
    for (int u = xcd_first_unit(bid, nblk); u < NU; u += nblk) {
        const int mt = u % MT, nt = u / MT;
        RowLin rf{p.H + (size_t)mt * GBM2 * 1024, 1024u};
        RowLin wf{p.WTSQ + (size_t)nt * 256 * 1024, 1024u};
        if (nt < 4) { EpiSQ<GBM2> epi{p.Q, mt * GBM2, nt * 256, 0.125f * LOG2E}; gemm_unit_bb<GBM2, true>(lds, rf, wf, 16, epi, tid); }
        else if (nt == 4) { EpiSK<GBM2> epi{p.SK, p.out, mt * GBM2}; gemm_unit_bb<GBM2, true>(lds, rf, wf, 16, epi, tid); }
        else { EpiSV<GBM2> epi{p.SVTP, p.SVTS, p.out, mt * GBM2}; gemm_unit_bb<GBM2, false>(lds, rf, wf, 16, epi, tid); }
    }
}

template <int BM> struct EpiHid { bf16_t* HID; int e, mt, nt;
    DEVI void operator()(const f32x4 (&acc)[BM / 32][4], int wr, int wc, int lane) const {
        const int r16 = lane & 15, g = lane >> 4;
#pragma unroll
        for (int mb = 0; mb < BM / 32; ++mb) { const size_t row = (size_t)e * 1024 + mt * BM + wr * (BM / 2) + mb * 16 + r16;
            u32x4 w;
            { const f32x4 gv = acc[mb][0], uv = acc[mb][2]; w.x = pk_bf16(silu_f(gv[0]) * uv[0], silu_f(gv[1]) * uv[1]); w.y = pk_bf16(silu_f(gv[2]) * uv[2], silu_f(gv[3]) * uv[3]); }
            { const f32x4 gv = acc[mb][1], uv = acc[mb][3]; w.z = pk_bf16(silu_f(gv[0]) * uv[0], silu_f(gv[1]) * uv[1]); w.w = pk_bf16(silu_f(gv[2]) * uv[2], silu_f(gv[3]) * uv[3]); }
            *(u32x4*)(HID + row * 2048 + nt * 128 + wc * 32 + 8 * g) = w; }
    } };
template <int DBG = 0> DEVI void phase_moe_up(const Params& p, int layer, lds_t* lds, int bid, int nblk, int tid) {
    constexpr int MT = 1024 / GBM2, NU = 16 * MT * 16;
#define DEC_MU(u_, rf_, wf_) do { const int e_ = (u_) / (MT * 16), w_ = (u_) % (MT * 16), mt_ = w_ % MT, nt_ = w_ / MT; \
        rf_ = RowGather{p.H2, p.IDX + e_ * 1024 + mt_ * GBM2}; wf_ = WMoe{p.moe_w_gate, p.moe_w_up, ((size_t)layer * 16 + e_) * 1024 * 2048 + nt_ * 128}; } while (0)
    int u = xcd_first_unit(bid, nblk);
    RowGather rf, rfn; WMoe wf, wfn;
    for (; u < NU; u += nblk) {
        const int e = u / (MT * 16), w = u % (MT * 16), mt = w % MT, nt = w / MT;
        DEC_MU(u, rf, wf);
        EpiHid<GBM2> epi{p.HID, e, mt, nt};
        gemm_unit<GBM2, true>(lds, rf, wf, 2048u, 16, epi, tid);
    }
#undef DEC_MU
}
template <int BM> struct EpiYe { bf16_t* YE; const float* GATEV; int e, mt, nt;
    DEVI void operator()(const f32x4 (&acc)[BM / 32][4], int wr, int wc, int lane) const {
        const int r16 = lane & 15, g = lane >> 4;
#pragma unroll
        for (int mb = 0; mb < BM / 32; ++mb) { const size_t row = (size_t)e * 1024 + mt * BM + wr * (BM / 2) + mb * 16 + r16;
            const float gt = GATEV[row];
#pragma unroll
            for (int nb = 0; nb < 4; ++nb) st_bf16x4(YE + row * 1024 + nt * 256 + wc * 64 + nb * 16 + 4 * g, acc[mb][nb] * gt); }
    } };
DEVI void phase_moe_down(const Params& p, int layer, lds_t* lds, int bid, int nblk, int tid) {
    constexpr int MT = 1024 / GBM2, NU = 16 * MT * 4;
#define DEC_MD(u_, d_) do { const int e_ = (u_) / (MT * 4), w_ = (u_) % (MT * 4), mt_ = w_ % MT, nt_ = w_ / MT; \
        d_.rf = RowLin{p.HID + ((size_t)e_ * 1024 + mt_ * GBM2) * 2048, 2048u}; d_.wl = WLin{p.moe_w_down + ((size_t)layer * 16 + e_) * 2048 * 1024 + nt_ * 256}; d_.ldw = 1024u; d_.nk = 32; } while (0)
    int u = xcd_first_unit(bid, nblk);
    GDesc d, dn;
    for (; u < NU; u += nblk) {
        const int e = u / (MT * 4), w = u % (MT * 4), mt = w % MT, nt = w / MT;
        DEC_MD(u, d);
        EpiYe<GBM2> epi{p.YE, p.GATEV, e, mt, nt};
        gemm_unit<GBM2, true>(lds, d.rf, d.wl, d.ldw, 32, epi, tid);
    }
#undef DEC_MD
}

template <int DK, int DV> struct AttnCfg {
    static constexpr int CPK = DK / 8;
    static constexpr int KT_BYTES = 64 * DK * 2;
    static constexpr int VT_BYTES = DV * 128;
    static constexpr int STAGE = KT_BYTES + VT_BYTES;
    static constexpr int NKC = 64 * CPK / NTHREADS;
    static constexpr int NVC = DV * 8 / NTHREADS;
};
DEVI int kswz(int key) { return ((key >> 1) & 1) | (((key >> 3) & 3) << 1); }

struct AttnSeg { int n_ctx, ctx_krow0, ctx_vcol0, n_loc, loc_krow0, loc_vcol0, loc_kpos0; };

template <int DK, int DV, bool WINDOW, class KSrc>
DEVI void attn_unit(lds_t* lds, const bf16_t* Qp, int ldq, const KSrc& ks, const bf16_t* vt, int ldv, const AttnSeg sg, int qpos0,
                    float sink, bool has_sink, bf16_t* Op, int ldo, int tid) {
    typedef AttnCfg<DK, DV> C;
    const int lane = tid & 63, wave = tid >> 6, r16 = lane & 15, g = lane >> 4;
    const int ntile = sg.n_ctx + sg.n_loc;
    bf16x8 qf[DK / 32];
    {
        const bf16_t* qr = Qp + (size_t)(wave * 16 + r16) * ldq + 8 * g;
#pragma unroll
        for (int s = 0; s < DK / 32; ++s) qf[s] = *(const bf16x8*)(qr + 32 * s);
    }
    u32x4 kreg[C::NKC], vreg[C::NVC];
#define TILE_LOAD(jj) do { const int j_ = (jj); int krow, vcol; \
        if (j_ < sg.n_ctx) { krow = sg.ctx_krow0 + 64 * j_; vcol = sg.ctx_vcol0 + 64 * j_; } \
        else { krow = sg.loc_krow0 + 64 * (j_ - sg.n_ctx); vcol = sg.loc_vcol0 + 64 * (j_ - sg.n_ctx); } \
        _Pragma("unroll") for (int i = 0; i < C::NKC; ++i) { const int c = tid + NTHREADS * i, key = c / C::CPK, ch = c % C::CPK; kreg[i] = *(const u32x4*)ks(krow + key, ch); } \
        _Pragma("unroll") for (int i = 0; i < C::NVC; ++i) { const int c = tid + NTHREADS * i, dv = c >> 3, ch = c & 7; vreg[i] = *(const u32x4*)(vt + (size_t)dv * ldv + vcol + ch * 8); } } while (0)
#define TILE_STORE(stp) do { lds_t* st_ = (stp); \
        _Pragma("unroll") for (int i = 0; i < C::NKC; ++i) { const int c = tid + NTHREADS * i, key = c / C::CPK, ch = c % C::CPK; lds_st128(st_ + key * (DK * 2) + ((ch ^ kswz(key)) << 4), kreg[i]); } \
        _Pragma("unroll") for (int i = 0; i < C::NVC; ++i) { const int c = tid + NTHREADS * i, dv = c >> 3, ch = c & 7; lds_st128(st_ + C::KT_BYTES + img_off(dv, ch), vreg[i]); } } while (0)
    f32x4 o[DV / 16];
#pragma unroll
    for (int i = 0; i < DV / 16; ++i) o[i] = (f32x4){0.f, 0.f, 0.f, 0.f};
    float m = has_sink ? sink : -1.0e30f;
    float l = (has_sink && g == 0) ? 1.0f : 0.0f;
    const int qpos = qpos0 + wave * 16 + r16;
    const int kbyte = (8 * (r16 >> 2) + (r16 & 3)) * (DK * 2);
    const int ksw0 = ((r16 >> 1) & 1) | ((r16 >> 2) << 1);
    const int ke0 = (g ^ ksw0) << 4, ke1 = ((4 + g) ^ ksw0) << 4;
    const int vc0 = g ^ ((r16 >> 1) & 7);

    TILE_LOAD(0);
    __syncthreads();
    TILE_STORE(lds);
    if (ntile > 1) TILE_LOAD(1);
    for (int j = 0; j < ntile; ++j) {
        __syncthreads();
        lds_t* cur = lds + (j & 1) * C::STAGE;
        if (j + 1 < ntile) { TILE_STORE(lds + ((j + 1) & 1) * C::STAGE); if (j + 2 < ntile) TILE_LOAD(j + 2); }
        const bool masked = WINDOW && (j >= sg.n_ctx);
        const int kpos0 = sg.loc_kpos0 + 64 * (j - sg.n_ctx);
        if (masked) {
            const int qlo = qpos0 + wave * 16;
            if (kpos0 > qlo + 15 + 128 || kpos0 + 63 < qlo - 128) continue;
        }
        f32x4 s[4];
        {
            lds_t* kb0 = cur + kbyte + ke0;
            lds_t* kb1 = cur + kbyte + ke1;
#pragma unroll
            for (int grp = 0; grp < 2; ++grp)
#pragma unroll
                for (int b = 0; b < 2; ++b) {
                    f32x4 a = (f32x4){0.f, 0.f, 0.f, 0.f};
#pragma unroll
                    for (int st = 0; st < DK / 32; ++st) {
                        const bf16x8 kf = lds_ld128(((st & 1) ? kb1 : kb0) + (32 * grp + 4 * b) * (DK * 2) + (st >> 1) * 128);
                        a = __builtin_amdgcn_mfma_f32_16x16x32_bf16(kf, qf[st], a, 0, 0, 0);
                    }
                    s[grp * 2 + b] = a;
                }
        }
        if (masked) {
#pragma unroll
            for (int grp = 0; grp < 2; ++grp)
#pragma unroll
                for (int b = 0; b < 2; ++b)
#pragma unroll
                    for (int r = 0; r < 4; ++r) {
                        const int kp = kpos0 + 32 * grp + 8 * g + 4 * b + r;
                        const int d = qpos - kp;
                        if (d > 128 || d < -128) s[grp * 2 + b][r] = -1.0e30f;
                    }
        }
        float mx = fmaxf(fmaxf(fmaxf(s[0][0], s[0][1]), fmaxf(s[0][2], s[0][3])), fmaxf(fmaxf(s[1][0], s[1][1]), fmaxf(s[1][2], s[1][3])));
        mx = fmaxf(mx, fmaxf(fmaxf(fmaxf(s[2][0], s[2][1]), fmaxf(s[2][2], s[2][3])), fmaxf(fmaxf(s[3][0], s[3][1]), fmaxf(s[3][2], s[3][3]))));
        mx = fmaxf(mx, __shfl_xor(mx, 16)); mx = fmaxf(mx, __shfl_xor(mx, 32));
        const float mn = fmaxf(m, mx);
        const float alpha = fexp2(m - mn);
        m = mn;
        float ps = 0.f;
#pragma unroll
        for (int i = 0; i < 4; ++i)
#pragma unroll
            for (int r = 0; r < 4; ++r) { const float pv = fexp2(s[i][r] - mn); s[i][r] = pv; ps += pv; }
        l = l * alpha + ps;
#pragma unroll
        for (int i = 0; i < DV / 16; ++i) o[i] = o[i] * alpha;
#pragma unroll
        for (int grp = 0; grp < 2; ++grp) {
            u32x4 pw;
            pw.x = pk_bf16(s[grp * 2][0], s[grp * 2][1]); pw.y = pk_bf16(s[grp * 2][2], s[grp * 2][3]);
            pw.z = pk_bf16(s[grp * 2 + 1][0], s[grp * 2 + 1][1]); pw.w = pk_bf16(s[grp * 2 + 1][2], s[grp * 2 + 1][3]);
            bf16x8 pf; __builtin_memcpy(&pf, &pw, 16);
#pragma unroll
            for (int dvb = 0; dvb < DV / 16; ++dvb) {
                const bf16x8 vf = lds_ld128(cur + C::KT_BYTES + r16 * 128 + dvb * 2048 + (((vc0 ^ (4 * grp)) ^ (dvb & 1)) << 4));
                o[dvb] = __builtin_amdgcn_mfma_f32_16x16x32_bf16(vf, pf, o[dvb], 0, 0, 0);
            }
        }
    }
    l += __shfl_xor(l, 16); l += __shfl_xor(l, 32);
    const float inv = frcp(l);
    bf16_t* orow = Op + (size_t)(wave * 16 + r16) * ldo + 4 * g;
#pragma unroll
    for (int dvb = 0; dvb < DV / 16; ++dvb) st_bf16x4(orow + dvb * 16, o[dvb] * inv);
}

struct KSrcMla { const bf16_t* KN; const bf16_t* KPE; int h;
    DEVI const bf16_t* operator()(int krow, int ch) const { return ch < 16 ? KN + (size_t)krow * 1024 + h * 128 + ch * 8 : KPE + (size_t)krow * 64 + (ch - 16) * 8; } };
struct KSrcSwa { const bf16_t* SK; int kvh;
    DEVI const bf16_t* operator()(int krow, int ch) const { return SK + (size_t)krow * 256 + kvh * 64 + ch * 8; } };

DEVI void phase_mla_attn(const Params& p, lds_t* lds, int bid, int nblk, int tid) {
    for (int u = xcd_first_unit(bid, nblk); u < 512; u += nblk) {
        if (u < 256) {
            const int b = u >> 6, h = (u >> 3) & 7, qt = u & 7;
            const int qrow0 = NPR + b * 1024 + qt * 128;
            KSrcMla ks{p.KN, p.KPE, h};
            AttnSeg sg{4, NTOK + b * 256, 0, 16, NPR + b * 1024, 256, 0};
            attn_unit<192, 128, false>(lds, p.Q + (size_t)qrow0 * 1536 + h * 192, 1536, ks, p.VTS + (size_t)(b * 8 + h) * 128 * 1280, 1280, sg, 0, 0.f, false,
                                       p.O + (size_t)qrow0 * 1024 + h * 128, 1024, tid);
        } else {
            const int v = u - 256, b = v >> 4, h = (v >> 1) & 7, qt = v & 1;
            const int qrow0 = b * 256 + qt * 128;
            KSrcMla ks{p.KN, p.KPE, h};
            AttnSeg sg{0, 0, 0, 4, b * 256, 0, 0};
            attn_unit<192, 128, false>(lds, p.Q + (size_t)qrow0 * 1536 + h * 192, 1536, ks, p.VTP + (size_t)(b * 8 + h) * 128 * 256, 256, sg, 0, 0.f, false,
                                       p.O + (size_t)qrow0 * 1024 + h * 128, 1024, tid);
        }
    }
}
DEVI void phase_swa_attn(const Params& p, lds_t* lds, int bid, int nblk, int tid) {
    for (int u = xcd_first_unit(bid, nblk); u < 1024; u += nblk) {
        const int w = u >> 8, idx = ((u >> 9) << 8) | (u & 255);
        if ((w & 1) == 0) {
            const int b = idx >> 7, hq = (idx >> 3) & 15, qt = idx & 7, kvh = hq >> 2;
            const int qs = qt * 128, qrow0 = NPR + b * 1024 + qs;
            const int lo = qs >= 128 ? qs - 128 : 0, hi = qs + 256 <= 1024 ? qs + 256 : 1024;
            KSrcSwa ks{p.SK, kvh};
            AttnSeg sg{4, NTOK + b * 256, 0, (hi - lo) >> 6, NPR + b * 1024 + lo, 256 + lo, lo};
            attn_unit<64, 64, true>(lds, p.Q + (size_t)qrow0 * 1024 + hq * 64, 1024, ks, p.SVTS + (size_t)(b * 4 + kvh) * 64 * 1280, 1280, sg, qs,
                                    p.swa_sink[hq] * LOG2E, true, p.O + (size_t)qrow0 * 1024 + hq * 64, 1024, tid);
        } else {
            const int b = idx >> 5, hq = (idx >> 1) & 15, qt = idx & 1, kvh = hq >> 2;
            const int qrow0 = b * 256 + qt * 128;
            KSrcSwa ks{p.SK, kvh};
            AttnSeg sg{0, 0, 0, 4, b * 256, 0, 0};
            attn_unit<64, 64, false>(lds, p.Q + (size_t)qrow0 * 1024 + hq * 64, 1024, ks, p.SVTP + (size_t)(b * 4 + kvh) * 64 * 256, 256, sg, 0,
                                     p.swa_sink[hq] * LOG2E, true, p.O + (size_t)qrow0 * 1024 + hq * 64, 1024, tid);
        }
    }
}

DEVI void phase_gm_spatial(const Params& p, lds_t* lds, int bid, int nblk, int tid) {
    const int lane = tid & 63, wave = tid >> 6, r16 = lane & 15, g = lane >> 4, wr = wave >> 2, wc = wave & 3;
    lds_t* aimg = lds;
    lds_t* vimg = lds + 32768;
    LAS float* mean = (LAS float*)(lds + 65536);
    LAS float* rstd = mean + 128;
    LAS float* biasp = rstd + 128;
    LAS float* bpart = biasp + 128;
    for (int u = xcd_first_unit(bid, nblk); u < 512; u += nblk) {
        const int chunk = u >> 3, grp = u & 7;
        __syncthreads();
        if (tid < 128) {
            const float* gs = p.GST + (size_t)(chunk * 128 + tid) * 96;
            float s = 0.f, q = 0.f;
            for (int i = 0; i < 48; ++i) { s += gs[2 * i]; q += gs[2 * i + 1]; }
            const float mu = s * (1.0f / 3072.0f);
            const float var = q * (1.0f / 3072.0f) - mu * mu;
            mean[tid] = mu; rstd[tid] = rsqrtf(fmaxf(var, 0.f) + EPS_F);
        }
        __syncthreads();
        {
            const int n = tid >> 2, mq = tid & 3;
            const float* ws = p.gm_w_s + ((size_t)grp * 128 + n) * 128 + mq * 32;
            float bp = 0.f;
#pragma unroll
            for (int c4 = 0; c4 < 4; ++c4) {
                const f32x4 w0 = *(const f32x4*)(ws + c4 * 8), w1 = *(const f32x4*)(ws + c4 * 8 + 4);
                const int m0 = mq * 32 + c4 * 8;
                float a[8];
#pragma unroll
                for (int i = 0; i < 4; ++i) { a[i] = w0[i] * rstd[m0 + i]; a[4 + i] = w1[i] * rstd[m0 + 4 + i]; }
                u32x4 v; v.x = pk_bf16(a[0], a[1]); v.y = pk_bf16(a[2], a[3]); v.z = pk_bf16(a[4], a[5]); v.w = pk_bf16(a[6], a[7]);
#pragma unroll
                for (int i = 0; i < 4; ++i) { const unsigned wd = i == 0 ? v.x : i == 1 ? v.y : i == 2 ? v.z : v.w; bp += bf_lo(wd) * mean[m0 + 2 * i] + bf_hi(wd) * mean[m0 + 2 * i + 1]; }
                const int kc = m0 >> 3;
                lds_st128(aimg + (kc >> 3) * 16384 + img_off(n, kc & 7), v);
            }
            bpart[mq * 128 + n] = bp;
        }
        __syncthreads();
        if (tid < 128) biasp[tid] = bpart[tid] + bpart[128 + tid] + bpart[256 + tid] + bpart[384 + tid];
        for (int cs = 0; cs < 3; ++cs) {
            __syncthreads();
            {
                const bf16_t* src = p.GVT + ((size_t)chunk * 3072 + grp * 384 + cs * 128) * 128;
#pragma unroll
                for (int i = 0; i < 4; ++i) { const int c = tid + NTHREADS * i, row = c >> 4, kc = c & 15;
                    const u32x4 v = *(const u32x4*)(src + (size_t)row * 128 + kc * 8);
                    lds_st128(vimg + (kc >> 3) * 16384 + img_off(row, kc & 7), v); }
            }
            __syncthreads();
            f32x4 acc[4][2];
#pragma unroll
            for (int i = 0; i < 4; ++i) { acc[i][0] = (f32x4){0.f, 0.f, 0.f, 0.f}; acc[i][1] = acc[i][0]; }
#pragma unroll
            for (int kh = 0; kh < 2; ++kh)
#pragma unroll
                for (int s = 0; s < 2; ++s) {
                    bf16x8 af[4], vf[2];
#pragma unroll
                    for (int mb = 0; mb < 4; ++mb) af[mb] = lds_ld128(aimg + kh * 16384 + img_off(wr * 64 + mb * 16 + r16, 4 * s + g));
#pragma unroll
                    for (int nb = 0; nb < 2; ++nb) vf[nb] = lds_ld128(vimg + kh * 16384 + img_off(wc * 32 + nb * 16 + r16, 4 * s + g));
#pragma unroll
                    for (int mb = 0; mb < 4; ++mb)
#pragma unroll
                        for (int nb = 0; nb < 2; ++nb) acc[mb][nb] = __builtin_amdgcn_mfma_f32_16x16x32_bf16(vf[nb], af[mb], acc[mb][nb], 0, 0, 0);
                }
#pragma unroll
            for (int mb = 0; mb < 4; ++mb) {
                const int n = wr * 64 + mb * 16 + r16;
                const float bp = biasp[n], bs = p.gm_b_s[grp * 128 + n];
                const size_t row = (size_t)chunk * 128 + n;
#pragma unroll
                for (int nb = 0; nb < 2; ++nb) {
                    const int col = grp * 384 + cs * 128 + wc * 32 + nb * 16 + 4 * g;
                    const f32x4 gn = *(const f32x4*)(p.gm_v_gain + col);
                    const u32x2 uw = *(const u32x2*)(p.U + row * 3072 + col);
                    f32x4 t;
                    t[0] = bf_lo(uw.x) * (gn[0] * (acc[mb][nb][0] - bp) + bs);
                    t[1] = bf_hi(uw.x) * (gn[1] * (acc[mb][nb][1] - bp) + bs);
                    t[2] = bf_lo(uw.y) * (gn[2] * (acc[mb][nb][2] - bp) + bs);
                    t[3] = bf_hi(uw.y) * (gn[3] * (acc[mb][nb][3] - bp) + bs);
                    st_bf16x4(p.TT + row * 3072 + col, t);
                }
            }
        }
    }
}

constexpr int N_PHASES = 2 + 10 * DEPTH;
__global__ void __launch_bounds__(NTHREADS, 2) fwd_kernel(Params p_kernarg) {
    extern __shared__ __attribute__((aligned(16))) unsigned char smem[];
    lds_t* lds = (lds_t*)smem;
    const int tid0 = threadIdx.x, bid0 = blockIdx.x, nblk0 = gridDim.x;
    const int wave0 = __builtin_amdgcn_readfirstlane(tid0 >> 6);
    volatile LAS unsigned* misc = (volatile LAS unsigned*)(lds + LDS_MAIN);
    if (tid0 == 0) { misc[0] = 0u; misc[1] = 0u; misc[2] = 0u; misc[3] = 0u; }
    __syncthreads();
    typedef const __attribute__((address_space(4))) Params* kparams_t;
    kparams_t pp = (kparams_t)__builtin_amdgcn_kernarg_segment_ptr();
    const int lo = (int)pp->ph_lo, hi = (int)pp->ph_hi;
    XcdBarrier bar; bar.bar = pp->bar; bar.x = 0; bar.st = misc;
    if (hi - lo > 1) bar = xcd_barrier_post(bar.bar, misc);
#define IN(k) (lo <= (k) && (k) < hi)
#ifndef REP_MASK
#define REP_MASK 0
#endif
#define RUN(k, knext, cls, body) do { if (IN(k)) { { asm volatile("" : "+s"(pp)); Params p; __builtin_memcpy(&p, pp, sizeof(Params)); \
        int tid = wave0 * 64 + (int)__builtin_amdgcn_mbcnt_hi(~0u, __builtin_amdgcn_mbcnt_lo(~0u, 0u)), bid = bid0, nblk = nblk0; asm volatile("" : "+v"(tid)); asm volatile("" : "+s"(bid), "+s"(nblk)); body; \
        if ((REP_MASK) & (cls)) { asm volatile("" : "+v"(tid)); body; } } if (IN(knext)) { xcd_barrier(bar); if ((REP_MASK) & 8192) xcd_barrier(bar); } } } while (0)
    RUN(0, 1, 64, { phase_modulation(p, lds, bid, nblk, tid); phase_wconv(p, lds, bid, nblk, tid); });
    RUN(1, 2, 512, phase_prep(p, bid, nblk, tid));
#pragma unroll 1
    for (int li = 0; li < DEPTH; ++li) {
        const int kind = li % 3, j = li / 3, base = 2 + 10 * li;
        if (kind == 0) {
            RUN(base + 0, base + 1, 32, phase_mla_win(p, j, lds, bid, nblk, tid));
            RUN(base + 1, base + 2, 1024, phase_mla_norm(p, j, bid, nblk, tid));
            RUN(base + 2, base + 3, 32, phase_mla_up(p, j, lds, bid, nblk, tid));
            RUN(base + 3, base + 4, 16, phase_mla_attn(p, lds, bid, nblk, tid));
            RUN(base + 4, base + 5, 8, phase_out_proj(p, li, p.O, 1024, p.WTO + (size_t)j * 1024 * 1024, lds, bid, nblk, tid));
        } else if (kind == 1) {
            RUN(base + 0, base + 1, 4, phase_gm_win(p, lds, bid, nblk, tid));
            RUN(base + 1, base + 2, 128, phase_gm_spatial(p, lds, bid, nblk, tid));
            RUN(base + 2, base + 5, 8, phase_out_proj(p, li, p.TT, 3072, p.WTGO, lds, bid, nblk, tid));
        } else {
            RUN(base + 0, base + 1, 32, phase_swa_qkv(p, lds, bid, nblk, tid));
            RUN(base + 1, base + 2, 16, phase_swa_attn(p, lds, bid, nblk, tid));
            RUN(base + 2, base + 5, 8, phase_out_proj(p, li, p.O, 1024, p.WTSO, lds, bid, nblk, tid));
        }
        RUN(base + 5, base + 6, 2048, phase_ln_a(p, li, lds, bid, nblk, tid));
        RUN(base + 6, base + 7, 256, phase_topk(p, lds, bid, nblk, tid));
        RUN(base + 7, base + 8, 1, phase_moe_up(p, li, lds, bid, nblk, tid));
        RUN(base + 8, base + 9, 2, phase_moe_down(p, li, lds, bid, nblk, tid));
        RUN(base + 9, base + 10, 4096, phase_ln_b(p, li, bid, nblk, tid));
    }
#undef IN
#undef RUN
}

#ifdef PROBE_V
__global__ void __launch_bounds__(NTHREADS, 2) probe_kernel(Params p) {
    extern __shared__ __attribute__((aligned(16))) unsigned char smem[];
    lds_t* lds = (lds_t*)smem;
    const int tid = threadIdx.x, bid = blockIdx.x, nblk = gridDim.x;
#if PROBE_V < 1000
    if (PROBE_V == 1) phase_mla_attn(p, lds, bid, nblk, tid);
    else if (PROBE_V == 2) phase_swa_attn(p, lds, bid, nblk, tid);
    else if (PROBE_V == 3) phase_gm_spatial(p, lds, bid, nblk, tid);
    else if (PROBE_V == 4) phase_ln_a(p, 3, lds, bid, nblk, tid);
    else if (PROBE_V == 5) phase_mla_up(p, 1, lds, bid, nblk, tid);
    else phase_moe_up<0>(p, 0, lds, bid, nblk, tid);
#else
    const int lane = tid & 63, wave = tid >> 6;
    const int u0 = xcd_first_unit(bid, nblk);
    f32x4 acc = (f32x4){0.f, 0.f, 0.f, 0.f};
    for (int u = u0; u < 1024; u += nblk) {
        const int e = u >> 6, w = u & 63, nt = w >> 2;
        const float* wp = p.moe_w_gate + (size_t)e * 1024 * 2048 + nt * 128 + 4 * lane + (size_t)(8 * wave) * 2048;
        const bf16_t* xp = p.H2 + (size_t)((u * 37 + wave * 8 + (lane >> 3)) & 8191) * 1024 + (lane & 7) * 8;
#pragma unroll 2
        for (int kt = 0; kt < 16; ++kt) {
            const float* q = wp + (size_t)((PROBE_V & 1) ? 0 : ((PROBE_V & 4) ? ((kt + (w & 3) * ((PROBE_V >> 4) & 7)) & 15) : ((PROBE_V & 8) ? (kt & 3) : kt))) * 64 * 2048;
#pragma unroll
            for (int i = 0; i < 8; ++i) acc += *(const f32x4*)(q + (size_t)i * 2048);
            if (PROBE_V & 2) {
#pragma unroll
                for (int j = 0; j < 4; ++j) { const u32x4 x = *(const u32x4*)(xp + (size_t)j * 64 * 1024 + kt * 64); acc[0] += __uint_as_float(x.x & 0x3f800000u); }
            }
        }
    }
    if (acc[0] + acc[1] + acc[2] + acc[3] == 12345.678f) p.GST[tid] = acc[0];
#endif
}
#endif
extern "C" void kernel_launch(void* const* d_in, const int* in_sizes, int n_in, void* d_out, int out_size, void* d_ws, size_t ws_size, hipStream_t stream) {
    static int grid = 0;
    if (grid == 0) {
        int dev = 0, cus = 0, per_cu = 0;
        if (hipGetDevice(&dev) != hipSuccess || hipDeviceGetAttribute(&cus, hipDeviceAttributeMultiprocessorCount, dev) != hipSuccess) { fprintf(stderr, "kernel_launch: device query failed\n"); grid = -1; return; }
        if (hipFuncSetAttribute((const void*)fwd_kernel, hipFuncAttributeMaxDynamicSharedMemorySize, LDS_BYTES) != hipSuccess) { fprintf(stderr, "kernel_launch: hipFuncSetAttribute failed\n"); grid = -1; return; }
        if (hipOccupancyMaxActiveBlocksPerMultiprocessor(&per_cu, (const void*)fwd_kernel, NTHREADS, LDS_BYTES) != hipSuccess || per_cu < 1) {
            fprintf(stderr, "kernel_launch: occupancy query reports %d blocks per CU\n", per_cu); (void)hipGetLastError(); per_cu = 1; }
        grid = cus;
    }
    if (grid < 0) return;
    unsigned char* ws = (unsigned char*)d_ws;
    size_t off = 0;
    auto take = [&](size_t bytes) { unsigned char* r = ws + off; off += (bytes + 255) & ~(size_t)255; return r; };
    Params p{};
    const float* const* in = (const float* const*)d_in;
    p.x_prompt = in[0]; p.x_sample = in[1]; p.cache_ckv = in[2]; p.cache_kpe = in[3]; p.cache_k = in[4]; p.cache_v = in[5]; p.c = in[6]; p.c_ctx = in[7];
    p.mod_w = in[8]; p.mod_b = in[9]; p.ln_gain = in[10]; p.ln_bias = in[11];
    p.mla_w_in = in[12]; p.mla_q_gain = in[13]; p.mla_kv_gain = in[14]; p.mla_w_q_up = in[15]; p.mla_w_kv_up = in[16]; p.mla_w_out = in[17];
    p.gm_w_in = in[18]; p.gm_v_gain = in[19]; p.gm_w_s = in[20]; p.gm_b_s = in[21]; p.gm_w_out = in[22];
    p.swa_w_qkv = in[23]; p.swa_sink = in[24]; p.swa_w_out = in[25];
    p.moe_router = in[26]; p.moe_w_gate = in[27]; p.moe_w_up = in[28]; p.moe_w_down = in[29];
    p.out = (float*)d_out;
    p.bar = (unsigned*)take(16384);
    p.mod = (float*)take((size_t)DEPTH * 5 * 6144 * 4);
    p.X0 = (float*)take((size_t)NTOK * D * 4); p.X1 = (float*)take((size_t)NTOK * D * 4); p.T = (float*)take((size_t)NTOK * D * 4);
    p.Z = (float*)take((size_t)NTOK * 704 * 4); p.GST = (float*)take((size_t)NTOK * 96 * 4); p.AFF = (float*)take((size_t)NTOK * 16 * 4); p.GATEV = (float*)take(16 * 1024 * 4);
    p.H = (bf16_t*)take((size_t)NTOK * D * 2); p.H2 = (bf16_t*)take((size_t)NTOK * D * 2);
    p.CQ = (bf16_t*)take((size_t)NTOK * 384 * 2); p.CKV = (bf16_t*)take((size_t)NROWS_KV * 256 * 2); p.KPE = (bf16_t*)take((size_t)NROWS_KV * 64 * 2);
    p.Q = (bf16_t*)take((size_t)NTOK * 1536 * 2); p.KN = (bf16_t*)take((size_t)NROWS_KV * 1024 * 2);
    p.VTP = (bf16_t*)take((size_t)16 * 8 * 128 * 256 * 2); p.VTS = (bf16_t*)take((size_t)4 * 8 * 128 * 1280 * 2);
    p.O = (bf16_t*)take((size_t)NTOK * D * 2);
    p.U = (bf16_t*)take((size_t)NTOK * 3072 * 2); p.GVT = (bf16_t*)take((size_t)NTOK * 3072 * 2); p.TT = (bf16_t*)take((size_t)NTOK * 3072 * 2);
    p.SK = (bf16_t*)take((size_t)NROWS_KV * 256 * 2); p.SVTP = (bf16_t*)take((size_t)16 * 4 * 64 * 256 * 2); p.SVTS = (bf16_t*)take((size_t)4 * 4 * 64 * 1280 * 2);
    p.HID = (bf16_t*)take((size_t)16 * 1024 * 2048 * 2); p.YE = (bf16_t*)take((size_t)16 * 1024 * 1024 * 2);
    p.SEL = (int*)take((size_t)NTOK * 16 * 4); p.IDX = (int*)take(16 * 1024 * 4);
    p.WTI = (bf16_t*)take((size_t)2 * 704 * 1024 * 2); p.WTQ = (bf16_t*)take((size_t)2 * 1536 * 384 * 2); p.WTKV = (bf16_t*)take((size_t)2 * 2048 * 256 * 2); p.WTO = (bf16_t*)take((size_t)2 * 1024 * 1024 * 2);
    p.WTGI = (bf16_t*)take((size_t)6144 * 1024 * 2); p.WTGO = (bf16_t*)take((size_t)1024 * 3072 * 2); p.WTSQ = (bf16_t*)take((size_t)1536 * 1024 * 2); p.WTSO = (bf16_t*)take((size_t)1024 * 1024 * 2);
    if (off > ws_size) { fprintf(stderr, "kernel_launch: workspace too small: need %zu, have %zu\n", off, ws_size); return; }
    (void)in_sizes; (void)n_in; (void)out_size;
    if (hipMemsetAsync(p.bar, 0, 16384, stream) != hipSuccess) { fprintf(stderr, "kernel_launch: memset failed\n"); return; }
#if N_LAUNCH_PER_PHASE
#ifndef MAX_PHASE
#define MAX_PHASE N_PHASES
#endif
    for (int k = 0; k < MAX_PHASE; ++k) {
        if (k >= 2) { const int li = (k - 2) / 10, s = (k - 2) % 10, kind = li % 3; if (kind != 0 && (s == 3 || s == 4)) continue; }
        p.ph_lo = k; p.ph_hi = k + 1;
        hipLaunchKernelGGL(fwd_kernel, dim3(grid), dim3(NTHREADS), LDS_BYTES, stream, p);
    }
#else
    p.ph_lo = 0; p.ph_hi = N_PHASES;
    hipLaunchKernelGGL(fwd_kernel, dim3(grid), dim3(NTHREADS), LDS_BYTES, stream, p);
#endif
#ifdef PROBE_V
    { static int once = 0; if (!once) { once = 1; (void)hipFuncSetAttribute((const void*)probe_kernel, hipFuncAttributeMaxDynamicSharedMemorySize, LDS_BYTES); }
      hipLaunchKernelGGL(probe_kernel, dim3(grid), dim3(NTHREADS), LDS_BYTES, stream, p); }
#endif
    const hipError_t le = hipPeekAtLastError();
    if (le != hipSuccess) fprintf(stderr, "kernel_launch: launch failed: %s\n", hipGetErrorName(le));
}
```

```cpp
#include <hip/hip_runtime.h>
#include <stdint.h>
#include <stdio.h>

#ifndef N_LAUNCH_PER_PHASE
#define N_LAUNCH_PER_PHASE 0
#endif

#define DEVI __device__ __forceinline__
#define LAS __attribute__((address_space(3)))
typedef unsigned short bf16_t;
typedef short bf16x8 __attribute__((ext_vector_type(8)));
typedef float f32x4 __attribute__((ext_vector_type(4)));
typedef float f32x2 __attribute__((ext_vector_type(2)));
typedef unsigned u32x4 __attribute__((ext_vector_type(4)));
typedef unsigned u32x2 __attribute__((ext_vector_type(2)));
typedef LAS unsigned char lds_t;

constexpr int D = 1024;
constexpr int NTOK = 8192, NPR = 4096;
constexpr int NROWS_KV = 9216;
constexpr int DEPTH = 4;
constexpr float ALPHA_F = 1.681792830507429f;
constexpr float EPS_F = 1e-6f;
constexpr float LOG2E = 1.4426950408889634f;
constexpr int NTHREADS = 512;
constexpr int LDS_MAIN = 147456;
constexpr int LDS_BYTES = LDS_MAIN + 1024;

__device__ const float rope_tab[64 * 16 * 2] = {
1.000000000e+00f,0.000000000e+00f,1.000000000e+00f,0.000000000e+00f,1.000000000e+00f,0.000000000e+00f,1.000000000e+00f,0.000000000e+00f,1.000000000e+00f,0.000000000e+00f,1.000000000e+00f,0.000000000e+00f,1.000000000e+00f,0.000000000e+00f,1.000000000e+00f,0.000000000e+00f,1.000000000e+00f,0.000000000e+00f,1.000000000e+00f,0.000000000e+00f,1.000000000e+00f,0.000000000e+00f,1.000000000e+00f,0.000000000e+00f,1.000000000e+00f,0.000000000e+00f,1.000000000e+00f,0.000000000e+00f,1.000000000e+00f,0.000000000e+00f,1.000000000e+00f,0.000000000e+00f,
5.403023059e-01f,8.414709848e-01f,8.460091064e-01f,5.331684460e-01f,9.504152809e-01f,3.109835909e-01f,9.842302348e-01f,1.768921847e-01f,9.950041651e-01f,9.983341813e-02f,9.984192778e-01f,5.620449919e-02f,9.995000417e-01f,3.161750470e-02f,9.998418903e-01f,1.778185709e-02f,9.999500004e-01f,9.999833111e-03f,9.999841887e-01f,5.623383612e-03f,9.999950000e-01f,3.162272359e-03f,9.999984189e-01f,1.778278494e-03f,9.999995000e-01f,9.999998808e-04f,9.999998419e-01f,5.623412721e-04f,9.999999500e-01f,3.162277519e-04f,9.999999842e-01f,1.778279393e-04f,
-4.161468365e-01f,9.092974268e-01f,4.314628163e-01f,9.021307212e-01f,8.065784124e-01f,5.911271138e-01f,9.374183100e-01f,3.482052729e-01f,9.800665772e-01f,1.986693337e-01f,9.936821085e-01f,1.122313110e-01f,9.980006668e-01f,6.320339453e-02f,9.993676111e-01f,3.555809121e-02f,9.998000067e-01f,1.999866625e-02f,9.999367551e-01f,1.124658940e-02f,9.999800001e-01f,6.324513096e-03f,9.999936755e-01f,3.556551364e-03f,9.999980000e-01f,1.999998762e-03f,9.999993675e-01f,1.124682366e-03f,9.999998000e-01f,6.324554721e-04f,9.999999368e-01f,3.556558729e-04f,
-9.899924966e-01f,1.411200081e-01f,-1.159661631e-01f,9.932531646e-01f,5.827536401e-01f,8.126488756e-01f,8.610406595e-01f,5.085361174e-01f,9.553364856e-01f,2.955202180e-01f,9.858034692e-01f,1.679033061e-01f,9.955033745e-01f,9.472608625e-02f,9.985773124e-01f,5.332308304e-02f,9.995500338e-01f,2.999549953e-02f,9.998577009e-01f,1.686943954e-02f,9.999550003e-01f,9.486690354e-03f,9.999857698e-01f,5.334812988e-03f,9.999955000e-01f,2.999995526e-03f,9.999985770e-01f,1.687023105e-03f,9.999995500e-01f,9.486831000e-04f,9.999998577e-01f,5.334837808e-04f,
-6.536436209e-01f,-7.568024953e-01f,-6.276796763e-01f,7.784717233e-01f,3.011374707e-01f,9.535807379e-01f,7.575061759e-01f,6.528279969e-01f,9.210609917e-01f,3.894183478e-01f,9.748082657e-01f,2.230444915e-01f,9.920106618e-01f,1.261540598e-01f,9.974712443e-01f,7.107120934e-02f,9.992001067e-01f,3.998933329e-02f,9.997470285e-01f,2.249175622e-02f,9.999200011e-01f,1.264877321e-02f,9.999747019e-01f,7.113057742e-03f,9.999920000e-01f,3.999989523e-03f,9.999974702e-01f,2.249363310e-03f,9.999992000e-01f,1.264910691e-03f,9.999997470e-01f,7.113117008e-04f,
2.836621855e-01f,-9.589242747e-01f,-9.460792425e-01f,3.239352821e-01f,-1.034233808e-02f,9.999465166e-01f,6.300802992e-01f,7.765299843e-01f,8.775825619e-01f,4.794255386e-01f,9.607312596e-01f,2.774805341e-01f,9.875260225e-01f,1.574558824e-01f,9.960497565e-01f,8.879686156e-02f,9.987502605e-01f,4.997916629e-02f,9.996047413e-01f,2.811336165e-02f,9.998750026e-01f,1.581072865e-02f,9.999604718e-01f,8.891280002e-03f,9.999875000e-01f,4.999979521e-03f,9.999960472e-01f,2.811702920e-03f,9.999987500e-01f,1.581138156e-03f,9.999996047e-01f,8.891395984e-04f,
9.601702867e-01f,-2.794154982e-01f,-9.731036980e-01f,-2.303675170e-01f,-3.207963899e-01f,9.471481807e-01f,4.827820346e-01f,8.757405478e-01f,8.253356014e-01f,5.646424931e-01f,9.436169596e-01f,3.310393232e-01f,9.820539372e-01f,1.886002770e-01f,9.943132976e-01f,1.064944419e-01f,9.982005400e-01f,5.996400514e-02f,9.994308440e-01f,3.373407806e-02f,9.998200054e-01f,1.897252691e-02f,9.999430795e-01f,1.066947415e-02f,9.999820001e-01f,5.999964052e-03f,9.999943079e-01f,3.374041408e-03f,9.999982000e-01f,1.897365346e-03f,9.999994308e-01f,1.066967410e-03f,
7.539022543e-01f,6.569865987e-01f,-7.004298139e-01f,-7.137212872e-01f,-5.994374526e-01f,8.004216016e-01f,3.202570024e-01f,9.473306986e-01f,7.648421950e-01f,6.442176781e-01f,9.235194568e-01f,3.835515778e-01f,9.755998794e-01f,2.195560870e-01f,9.922624183e-01f,1.241583392e-01f,9.975510002e-01f,6.994284763e-02f,9.992253421e-01f,3.935372584e-02f,9.997550100e-01f,2.213413545e-02f,9.999225252e-01f,1.244763455e-02f,9.999755001e-01f,6.999943050e-03f,9.999922524e-01f,3.936378830e-03f,9.999975500e-01f,2.213592463e-03f,9.999992252e-01f,1.244795304e-03f,
-1.455000338e-01f,9.893582466e-01f,-2.120364479e-01f,-9.772617586e-01f,-8.186324475e-01f,5.743177830e-01f,1.476312130e-01f,9.890424788e-01f,6.967067008e-01f,7.173560992e-01f,9.005023096e-01f,4.348512278e-01f,9.681703064e-01f,2.502923447e-01f,9.898977664e-01f,1.417829752e-01f,9.968017064e-01f,7.991469219e-02f,9.989882418e-01f,4.497213288e-02f,9.996800171e-01f,2.529552265e-02f,9.998988088e-01f,1.422575559e-02f,9.999680002e-01f,7.999915047e-03f,9.999898807e-01f,4.498715239e-03f,9.999968000e-01f,2.529819359e-03f,9.999989881e-01f,1.422623042e-03f,
-9.111302619e-01f,4.121184852e-01f,3.416602554e-01f,-9.398235313e-01f,-9.566441680e-01f,2.912592245e-01f,-2.965079623e-02f,9.995603185e-01f,6.216099403e-01f,7.833269319e-01f,8.746382611e-01f,4.847761465e-01f,9.597726443e-01f,2.807783310e-01f,9.872200896e-01f,1.593627767e-01f,9.959527334e-01f,8.987854534e-02f,9.987195508e-01f,5.058911778e-02f,9.995950273e-01f,2.845665689e-02f,9.998719305e-01f,1.600383071e-02f,9.999595003e-01f,8.999879044e-03f,9.999871928e-01f,5.061050226e-03f,9.999959500e-01f,2.846046001e-03f,9.999987193e-01f,1.600450735e-03f,
-8.390715291e-01f,-5.440211109e-01f,7.901318660e-01f,-6.129368926e-01f,-9.997860721e-01f,-2.068356987e-02f,-2.059976331e-01f,9.785524897e-01f,5.403023059e-01f,8.414709848e-01f,8.460091064e-01f,5.331684460e-01f,9.504152902e-01f,3.109835626e-01f,9.842302348e-01f,1.768921847e-01f,9.950041659e-01f,9.983341072e-02f,9.984192778e-01f,5.620449919e-02f,9.995000417e-01f,3.161750470e-02f,9.998418903e-01f,1.778185709e-02f,9.999500004e-01f,9.999834042e-03f,9.999841887e-01f,5.623383612e-03f,9.999950000e-01f,3.162272359e-03f,9.999984189e-01f,1.778278494e-03f,
4.425697988e-03f,-9.999902066e-01f,9.952573993e-01f,-9.727645772e-02f,-9.437797393e-01f,-3.305749593e-01f,-3.758474003e-01f,9.266815697e-01f,4.535961002e-01f,8.912073709e-01f,8.147053420e-01f,5.798751639e-01f,9.401075903e-01f,3.408778647e-01f,9.809291472e-01f,1.943656558e-01f,9.939560980e-01f,1.097783002e-01f,9.980874321e-01f,6.181810327e-02f,9.993950610e-01f,3.477804006e-02f,9.998086883e-01f,1.955982724e-02f,9.999395006e-01f,1.099977904e-02f,9.999808683e-01f,6.185714754e-03f,9.999939500e-01f,3.478498401e-03f,9.999980868e-01f,1.956106080e-03f,
8.438539587e-01f,-5.365729180e-01f,8.938616142e-01f,4.483429653e-01f,-7.941793525e-01f,-6.076834341e-01f,-5.338430142e-01f,8.455836068e-01f,3.623577100e-01f,9.320391032e-01f,7.808259330e-01f,6.247486393e-01f,9.288598710e-01f,3.704312892e-01f,9.773178677e-01f,2.117776794e-01f,9.928086362e-01f,1.197122046e-01f,9.977240240e-01f,6.742975621e-02f,9.992800864e-01f,3.793822392e-02f,9.997723246e-01f,2.133773367e-02f,9.999280009e-01f,1.199971211e-02f,9.999772317e-01f,6.748044406e-03f,9.999928000e-01f,3.794723862e-03f,9.999977232e-01f,2.133933605e-03f,
9.074467815e-01f,4.201670368e-01f,5.171728454e-01f,8.558809777e-01f,-5.658204930e-01f,-8.245284529e-01f,-6.750016657e-01f,7.378162043e-01f,2.674987597e-01f,9.635582046e-01f,7.444779872e-01f,6.676470075e-01f,9.166833698e-01f,3.996143135e-01f,9.733975442e-01f,2.291227201e-01f,9.915618943e-01f,1.296341379e-01f,9.973290651e-01f,7.303927684e-02f,9.991551190e-01f,4.109803212e-02f,9.997327995e-01f,2.311557262e-02f,9.999155012e-01f,1.299963410e-02f,9.999732789e-01f,7.310371924e-03f,9.999915500e-01f,4.110949176e-03f,9.999973279e-01f,2.311761062e-03f,
1.367372182e-01f,9.906073557e-01f,-1.879615160e-02f,9.998233367e-01f,-2.813494808e-01f,-9.596053718e-01f,-7.948709048e-01f,6.067785796e-01f,1.699671664e-01f,9.854497259e-01f,7.057763743e-01f,7.084346897e-01f,9.035902493e-01f,4.283977840e-01f,9.691694136e-01f,2.463953078e-01f,9.902159961e-01f,1.395431152e-01f,9.969025685e-01f,7.864648034e-02f,9.990201601e-01f,4.425742562e-02f,9.996901128e-01f,2.489334034e-02f,9.999020016e-01f,1.399954310e-02f,9.999690098e-01f,7.872696665e-03f,9.999902000e-01f,4.427174080e-03f,9.999969010e-01f,2.489588678e-03f,
-7.596879129e-01f,6.502878402e-01f,-5.489754720e-01f,8.358384600e-01f,3.102235090e-02f,-9.995186910e-01f,-8.896704271e-01f,4.566032536e-01f,7.073720167e-02f,9.974949866e-01f,6.648435293e-01f,7.469826514e-01f,8.895936264e-01f,4.567528653e-01f,9.646348168e-01f,2.635899662e-01f,9.887710793e-01f,1.494381236e-01f,9.964445467e-01f,8.425120425e-02f,9.988752109e-01f,4.741638026e-02f,9.996442648e-01f,2.667102934e-02f,9.998875021e-01f,1.499943810e-02f,9.999644246e-01f,8.435019847e-03f,9.999887500e-01f,4.743398540e-03f,9.999964424e-01f,2.667415984e-03f,
-9.576594803e-01f,-2.879033167e-01f,-9.100810896e-01f,4.144302238e-01f,3.403181682e-01f,-9.403103447e-01f,-9.564100499e-01f,2.920270818e-01f,-2.919954613e-02f,9.995736023e-01f,6.218088193e-01f,7.831690700e-01f,8.747074844e-01f,4.846512321e-01f,9.597951759e-01f,2.807013010e-01f,9.872272839e-01f,1.593182031e-01f,9.959550145e-01f,8.985326392e-02f,9.987202731e-01f,5.057485702e-02f,9.995952558e-01f,2.844863214e-02f,9.998720027e-01f,1.599931810e-02f,9.999595231e-01f,8.997339431e-03f,9.999872000e-01f,5.059622526e-03f,9.999959523e-01f,2.845243204e-03f,
-2.751633381e-01f,-9.613974919e-01f,-9.908979596e-01f,-1.346151313e-01f,6.158647923e-01f,-7.878518627e-01f,-9.929849841e-01f,1.182405237e-01f,-1.288445416e-01f,9.916648043e-01f,5.768082960e-01f,8.168795441e-01f,8.589467084e-01f,5.120649883e-01f,9.546520286e-01f,2.977238725e-01f,9.855847666e-01f,1.691823508e-01f,9.954339876e-01f,9.545248218e-02f,9.985553481e-01f,5.373282803e-02f,9.995430857e-01f,3.022614497e-02f,9.998555035e-01f,1.699918210e-02f,9.999543054e-01f,9.559656169e-03f,9.999855500e-01f,5.375846007e-03f,9.999954305e-01f,3.023070335e-03f,
6.603167082e-01f,-7.509872468e-01f,-7.665365398e-01f,-6.422006954e-01f,8.303361283e-01f,-5.572628770e-01f,-9.982416606e-01f,-5.927551864e-02f,-2.272021643e-01f,9.738476146e-01f,5.299841756e-01f,8.480075316e-01f,8.423270577e-01f,5.389667224e-01f,9.492070108e-01f,3.146522695e-01f,9.838436942e-01f,1.790295658e-01f,9.948814823e-01f,1.010486820e-01f,9.983804374e-01f,5.689026544e-02f,9.994877548e-01f,3.200356222e-02f,9.998380044e-01f,1.799902910e-02f,9.999487715e-01f,1.012197082e-02f,9.999838000e-01f,5.692068949e-03f,9.999948771e-01f,3.200897370e-03f,
9.887046182e-01f,1.498772097e-01f,-3.060954058e-01f,-9.520008417e-01f,9.624637956e-01f,-2.714100995e-01f,-9.720142724e-01f,-2.349218044e-01f,-3.232895443e-01f,9.463000954e-01f,4.814845890e-01f,8.764545570e-01f,8.248651506e-01f,5.653295351e-01f,9.434618259e-01f,3.314811956e-01f,9.820042356e-01f,1.888588926e-01f,9.942975170e-01f,1.066416789e-01f,9.981955430e-01f,6.004713022e-02f,9.994292631e-01f,3.378088199e-02f,9.998195054e-01f,1.899885811e-02f,9.999429214e-01f,1.068428133e-02f,9.999819501e-01f,6.008291323e-03f,9.999942921e-01f,3.378724537e-03f,
4.080820618e-01f,9.129452507e-01f,2.486167313e-01f,-9.686019414e-01f,9.991443799e-01f,4.135829015e-02f,-9.151299503e-01f,-4.031589936e-01f,-4.161468365e-01f,9.092974268e-01f,4.314628163e-01f,9.021307212e-01f,8.065784476e-01f,5.911270657e-01f,9.374183100e-01f,3.482052729e-01f,9.800665802e-01f,1.986693191e-01f,9.936821085e-01f,1.122313110e-01f,9.980006668e-01f,6.320339453e-02f,9.993676111e-01f,3.555809121e-02f,9.998000066e-01f,1.999866811e-02f,9.999367551e-01f,1.124658940e-02f,9.999800001e-01f,6.324513096e-03f,9.999936755e-01f,3.556551364e-03f,
-5.477292602e-01f,8.366556385e-01f,7.267602563e-01f,-6.868912067e-01f,9.367404516e-01f,3.500247509e-01f,-8.293829489e-01f,-5.586805205e-01f,-5.048462281e-01f,8.632092944e-01f,3.800769984e-01f,9.249548504e-01f,7.874851971e-01f,6.163335658e-01f,9.310783539e-01f,3.648192688e-01f,9.780309161e-01f,2.084598934e-01f,9.930352772e-01f,1.178173940e-01f,9.977958103e-01f,6.635903053e-02f,9.993027988e-01f,3.733518799e-02f,9.997795081e-01f,2.099845811e-02f,9.999302726e-01f,1.180889298e-02f,9.999779501e-01f,6.640734236e-03f,9.999930272e-01f,3.734378079e-03f,
-9.999608264e-01f,-8.851309290e-03f,9.810745815e-01f,-1.936302286e-01f,7.814403926e-01f,6.239798978e-01f,-7.174774633e-01f,-6.965817179e-01f,-5.885011558e-01f,8.084963758e-01f,3.274895886e-01f,9.448547874e-01f,7.676045628e-01f,6.409237359e-01f,9.244439837e-01f,3.813178741e-01f,9.758974496e-01f,2.182296219e-01f,9.923570442e-01f,1.233997439e-01f,9.975809759e-01f,6.951400294e-02f,9.992348263e-01f,3.911217043e-02f,9.997580097e-01f,2.199822712e-02f,9.999234739e-01f,1.237119282e-02f,9.999758001e-01f,6.956954712e-03f,9.999923473e-01f,3.912204676e-03f,
-5.328330203e-01f,-8.462204042e-01f,9.332357723e-01f,3.592645171e-01f,5.486452564e-01f,8.360552510e-01f,-5.829432350e-01f,-8.125128828e-01f,-6.662759857e-01f,7.457052439e-01f,2.738668392e-01f,9.617676197e-01f,7.469563882e-01f,6.648730361e-01f,9.175172750e-01f,3.976959268e-01f,9.736663975e-01f,2.279775131e-01f,9.916474294e-01f,1.289781990e-01f,9.973561656e-01f,7.266828020e-02f,9.991636941e-01f,4.088902546e-02f,9.997355116e-01f,2.299797413e-02f,9.999163589e-01f,1.293348969e-02f,9.999735501e-01f,7.273174492e-03f,9.999916358e-01f,4.090031381e-03f,
4.241790073e-01f,-9.055783620e-01f,5.979771709e-01f,8.015131335e-01f,2.614416878e-01f,9.652192724e-01f,-4.300232723e-01f,-9.028178029e-01f,-7.373937800e-01f,6.754631102e-01f,2.193782753e-01f,9.756398784e-01f,7.255613200e-01f,6.881575190e-01f,9.103004290e-01f,4.139482201e-01f,9.713379761e-01f,2.377026212e-01f,9.909064560e-01f,1.345525754e-01f,9.971213823e-01f,7.582182336e-02f,9.990894022e-01f,4.266575118e-02f,9.997120138e-01f,2.399769627e-02f,9.999089278e-01f,1.349578153e-02f,9.999712001e-01f,7.589393080e-03f,9.999908927e-01f,4.267857492e-03f,
9.912028119e-01f,-1.323517501e-01f,7.855226359e-02f,9.969099969e-01f,-5.168932904e-02f,9.986632131e-01f,-2.635405934e-01f,-9.646483067e-01f,-8.011436155e-01f,5.984721441e-01f,1.641961594e-01f,9.864277070e-01f,7.034407513e-01f,7.107539022e-01f,9.027957408e-01f,4.300695879e-01f,9.689124217e-01f,2.474039593e-01f,9.901341474e-01f,1.401226969e-01f,9.968766273e-01f,7.897461572e-02f,9.990119510e-01f,4.444234199e-02f,9.996875163e-01f,2.499739629e-02f,9.999011805e-01f,1.405806910e-02f,9.999687502e-01f,7.905611374e-03f,9.999901179e-01f,4.445683934e-03f,
6.469193223e-01f,7.625584505e-01f,-4.650644959e-01f,8.852768012e-01f,-3.596943393e-01f,9.330701915e-01f,-8.874550263e-02f,-9.960543337e-01f,-8.568888271e-01f,5.155012492e-01f,1.084949468e-01f,9.940970006e-01f,6.806168009e-01f,7.326395911e-01f,8.950055582e-01f,4.460549862e-01f,9.663899806e-01f,2.570805427e-01f,9.893305281e-01f,1.456883874e-01f,9.966219035e-01f,8.212661834e-02f,9.989313406e-01f,4.621879226e-02f,9.996620190e-01f,2.599707130e-02f,9.998931169e-01f,1.462035317e-02f,9.999662002e-01f,8.221828878e-03f,9.999893115e-01f,4.623509769e-03f,
-2.921388087e-01f,9.563759284e-01f,-8.654506342e-01f,5.009942114e-01f,-6.320286307e-01f,7.749450367e-01f,8.884811635e-02f,-9.960451858e-01f,-9.040721624e-01f,4.273798371e-01f,5.245061444e-02f,9.986235192e-01f,6.571122908e-01f,7.537927018e-01f,8.869323709e-01f,4.618993066e-01f,9.637709015e-01f,2.667314183e-01f,9.884956235e-01f,1.512494708e-01f,9.963572141e-01f,8.527779227e-02f,9.988475711e-01f,4.799510009e-02f,9.996355221e-01f,2.699672032e-02f,9.998847372e-01f,1.518263167e-02f,9.999635502e-01f,8.538045559e-03f,9.999884735e-01f,4.801335923e-03f,
-9.626058663e-01f,2.709057883e-01f,-9.992934094e-01f,-3.758566202e-02f,-8.416849393e-01f,5.399689462e-01f,2.636395107e-01f,-9.646212772e-01f,-9.422223247e-01f,3.349881951e-01f,-3.759419011e-03f,9.999929334e-01f,6.329506774e-01f,7.741921209e-01f,8.785787046e-01f,4.775975920e-01f,9.610554380e-01f,2.763556497e-01f,9.876294623e-01f,1.568057565e-01f,9.960825606e-01f,8.842812085e-02f,9.987606432e-01f,4.977125243e-02f,9.996080256e-01f,2.799634234e-02f,9.998760413e-01f,1.574490538e-02f,9.999608003e-01f,8.854261387e-03f,9.999876039e-01f,4.979161926e-03f,
-7.480575297e-01f,-6.636338842e-01f,-8.253716334e-01f,-5.645898217e-01f,-9.678715076e-01f,2.514453117e-01f,4.301158485e-01f,-9.027737019e-01f,-9.709581880e-01f,2.392492366e-01f,-5.995756728e-02f,9.982009267e-01f,6.081562113e-01f,7.938173736e-01f,8.699472142e-01f,4.931448515e-01f,9.582438779e-01f,2.859522171e-01f,9.867320673e-01f,1.623570984e-01f,9.957979462e-01f,9.157756515e-02f,9.986705569e-01f,5.154724737e-02f,9.995795294e-01f,2.899593637e-02f,9.998670292e-01f,1.630717503e-02f,9.999579503e-01f,9.170476329e-03f,9.999867027e-01f,5.156987306e-03f,
1.542514499e-01f,-9.880316241e-01f,-3.972518623e-01f,-9.177096261e-01f,-9.980752275e-01f,-6.201483913e-02f,5.830269376e-01f,-8.124528233e-01f,-9.899924966e-01f,1.411200081e-01f,-1.159661631e-01f,9.932531646e-01f,5.827536401e-01f,8.126488756e-01f,8.610406595e-01f,5.085361174e-01f,9.553364944e-01f,2.955201896e-01f,9.858034692e-01f,1.679033061e-01f,9.955033738e-01f,9.472609366e-02f,9.985773124e-01f,5.332308304e-02f,9.995500337e-01f,2.999550139e-02f,9.998577009e-01f,1.686943954e-02f,9.999550003e-01f,9.486690354e-03f,9.999857698e-01f,5.334812988e-03f,
9.147423578e-01f,-4.040376453e-01f,1.532154756e-01f,-9.881928041e-01f,-9.293002953e-01f,-3.693250075e-01f,7.175492218e-01f,-6.965077991e-01f,-9.991351562e-01f,4.158051951e-02f,-1.716081385e-01f,9.851652891e-01f,5.567683641e-01f,8.306677968e-01f,8.518617972e-01f,5.237666260e-01f,9.523335692e-01f,3.050586387e-01f,9.848436973e-01f,1.734442042e-01f,9.951988471e-01f,9.787366751e-02f,9.984809103e-01f,5.509874635e-02f,9.995195384e-01f,3.099503643e-02f,9.998480564e-01f,1.743169684e-02f,9.999519504e-01f,9.802903431e-03f,9.999848053e-01f,5.512638036e-03f,
8.342233605e-01f,5.514266812e-01f,6.564951791e-01f,-7.543302193e-01f,-7.683670888e-01f,-6.400093881e-01f,8.294403670e-01f,-5.585952717e-01f,-9.982947730e-01f,-5.837419103e-02f,-2.267075845e-01f,9.739628695e-01f,5.302263665e-01f,8.478561200e-01f,8.424135592e-01f,5.388315091e-01f,9.492354203e-01f,3.145665538e-01f,9.838527819e-01f,1.789796175e-01f,9.948843677e-01f,1.010202700e-01f,9.983813507e-01f,5.687423543e-02f,9.994880436e-01f,3.199454047e-02f,9.998380958e-01f,1.799395049e-02f,9.999488004e-01f,1.011911553e-02f,9.999838092e-01f,5.690463375e-03f,
-1.327674722e-02f,9.999118601e-01f,9.575860738e-01f,-2.881473778e-01f,-5.312352786e-01f,-8.472243379e-01f,9.151713830e-01f,-4.030649323e-01f,-9.874797774e-01f,-1.577456471e-01f,-2.810903074e-01f,9.596813216e-01f,5.031541870e-01f,8.641966582e-01f,8.326989334e-01f,5.537260030e-01f,9.460423489e-01f,3.240430126e-01f,9.828307545e-01f,1.845093711e-01f,9.945599394e-01f,1.041658623e-01f,9.982786339e-01f,5.864954466e-02f,9.994555494e-01f,3.299401065e-02f,9.998278189e-01f,1.855619846e-02f,9.999455505e-01f,1.043532661e-02f,9.999827814e-01f,5.868288535e-03f,
-8.485702748e-01f,5.290826861e-01f,9.637575328e-01f,2.667797179e-01f,-2.414211151e-01f,-9.704204476e-01f,9.720383571e-01f,-2.348221291e-01f,-9.667981682e-01f,-2.555411942e-01f,-3.345843792e-01f,9.423657958e-01f,4.755788956e-01f,8.796730723e-01f,8.227209915e-01f,5.684453977e-01f,9.427546643e-01f,3.334870955e-01f,9.817776473e-01f,1.900332899e-01f,9.942255664e-01f,1.073104056e-01f,9.981727603e-01f,6.042466843e-02f,9.994220556e-01f,3.399345156e-02f,9.998172259e-01f,1.911843869e-02f,9.999422006e-01f,1.075153665e-02f,9.999817221e-01f,6.046113043e-03f,
-9.036922051e-01f,-4.281826695e-01f,6.731102676e-01f,7.395421338e-01f,7.233466718e-02f,-9.973804169e-01f,9.982477619e-01f,-5.917267879e-02f,-9.364566873e-01f,-3.507832277e-01f,-3.870206816e-01f,9.220710342e-01f,4.475280652e-01f,8.942698871e-01f,8.124829236e-01f,5.829849902e-01f,9.393727149e-01f,3.428978019e-01f,9.806934936e-01f,1.955511994e-01f,9.938812503e-01f,1.104538832e-01f,9.980637300e-01f,6.219960483e-02f,9.993875625e-01f,3.499285475e-02f,9.998063168e-01f,1.968067474e-02f,9.999387506e-01f,1.106774562e-02f,9.999806311e-01f,6.223937825e-03f,
-1.279636896e-01f,-9.917788534e-01f,1.751565337e-01f,9.845405978e-01f,3.789161719e-01f,-9.254309994e-01f,9.929728258e-01f,1.183425843e-01f,-8.967583530e-01f,-4.425205716e-01f,-4.382335472e-01f,8.988611451e-01f,4.190297442e-01f,9.079725070e-01f,8.019878986e-01f,5.973402803e-01f,9.358968291e-01f,3.522742188e-01f,9.795783277e-01f,2.010629250e-01f,9.935269954e-01f,1.135962562e-01f,9.979515440e-01f,6.397433710e-02f,9.993520699e-01f,3.599222668e-02f,9.997950914e-01f,2.024290457e-02f,9.999352007e-01f,1.138395348e-02f,9.999795085e-01f,6.401761945e-03f,
7.654140519e-01f,-6.435381334e-01f,-3.767422893e-01f,9.263181135e-01f,6.479216888e-01f,-7.617069550e-01f,9.563800296e-01f,2.921253822e-01f,-8.481000064e-01f,-5.298361813e-01f,-4.880608524e-01f,8.728096037e-01f,3.901124287e-01f,9.207672306e-01f,7.912392691e-01f,6.115066795e-01f,9.323273439e-01f,3.616154364e-01f,9.784321880e-01f,2.065682779e-01f,9.931628052e-01f,1.167374932e-01f,9.978362017e-01f,6.574887451e-02f,9.993155781e-01f,3.699155889e-02f,9.997835499e-01f,2.080512613e-02f,9.999315508e-01f,1.170016020e-02f,9.999783543e-01f,6.579586328e-03f,
9.550736440e-01f,2.963685787e-01f,-8.126112051e-01f,5.828061679e-01f,8.526731157e-01f,-5.224447891e-01f,8.896234916e-01f,4.566946935e-01f,-7.909677411e-01f,-6.118578532e-01f,-5.363451811e-01f,8.439987244e-01f,3.608050334e-01f,9.326412643e-01f,7.802404339e-01f,6.254797082e-01f,9.286646373e-01f,3.709204650e-01f,9.772551046e-01f,2.120671131e-01f,9.927886843e-01f,1.198775555e-01f,9.977177040e-01f,6.752320399e-02f,9.992780868e-01f,3.799085783e-02f,9.997716923e-01f,2.136734297e-02f,9.999278009e-01f,1.201636575e-02f,9.999771684e-01f,6.757410504e-03f,
2.666429324e-01f,9.637953863e-01f,-9.982103598e-01f,5.980031485e-02f,9.728653499e-01f,-2.313720187e-01f,7.948083899e-01f,6.068604645e-01f,-7.259322386e-01f,-6.877662284e-01f,-5.829338849e-01f,8.125195911e-01f,3.311368634e-01f,9.435827349e-01f,7.689949093e-01f,6.392549018e-01f,9.249090653e-01f,3.801884019e-01f,9.760471178e-01f,2.175592422e-01f,9.924046346e-01f,1.230164264e-01f,9.975960518e-01f,6.929731252e-02f,9.992395964e-01f,3.899011506e-02f,9.997595184e-01f,2.192955306e-02f,9.999239510e-01f,1.233257010e-02f,9.999759510e-01f,6.935234000e-03f,
-6.669380617e-01f,7.451131605e-01f,-8.763794418e-01f,-4.816212973e-01f,9.965789837e-01f,8.264580634e-02f,6.749256518e-01f,7.378857395e-01f,-6.536436209e-01f,-7.568024953e-01f,-6.276796763e-01f,7.784717233e-01f,3.011375844e-01f,9.535807020e-01f,7.575061759e-01f,6.528279969e-01f,9.210610033e-01f,3.894183203e-01f,9.748082657e-01f,2.230444915e-01f,9.920106618e-01f,1.261540598e-01f,9.974712443e-01f,7.107120934e-02f,9.992001065e-01f,3.998933702e-02f,9.997470285e-01f,2.249175622e-02f,9.999200011e-01f,1.264877321e-02f,9.999747019e-01f,7.113057742e-03f,
-9.873392775e-01f,-1.586226688e-01f,-4.846393970e-01f,-8.747140418e-01f,9.214623472e-01f,3.884676855e-01f,5.337561004e-01f,8.456384720e-01f,-5.748240246e-01f,-8.182770562e-01f,-6.704410942e-01f,7.419627614e-01f,2.708370782e-01f,9.626252007e-01f,7.457779040e-01f,6.661946547e-01f,9.171208242e-01f,3.986093247e-01f,9.735385875e-01f,2.285226875e-01f,9.916067680e-01f,1.292904390e-01f,9.973432826e-01f,7.284488142e-02f,9.991596177e-01f,4.098851526e-02f,9.997342224e-01f,2.305395040e-02f,9.999159512e-01f,1.296497506e-02f,9.999734212e-01f,7.290880793e-03f,
-3.999853150e-01f,-9.165215479e-01f,5.636094028e-02f,-9.984104589e-01f,7.549653475e-01f,6.557646866e-01f,3.757521519e-01f,9.267201953e-01f,-4.902605720e-01f,-8.715759127e-01f,-7.110829506e-01f,7.031081264e-01f,2.402658714e-01f,9.707071191e-01f,7.338138022e-01f,6.793506485e-01f,9.130889457e-01f,4.077604411e-01f,9.722381233e-01f,2.339936570e-01f,9.911929581e-01f,1.324255253e-01f,9.972121675e-01f,7.461831571e-02f,9.991181295e-01f,4.198765625e-02f,9.997211001e-01f,2.361613915e-02f,9.999118013e-01f,1.328117562e-02f,9.999721088e-01f,7.468704080e-03f,
5.551133015e-01f,-8.317747426e-01f,5.800031129e-01f,-8.146142578e-01f,5.135984179e-01f,8.580306901e-01f,2.058971709e-01f,9.785736329e-01f,-4.007989973e-01f,-9.161660132e-01f,-7.494767587e-01f,6.620306550e-01f,2.094544189e-01f,9.778184118e-01f,7.216176540e-01f,6.922918182e-01f,9.089657591e-01f,4.168707818e-01f,9.709069144e-01f,2.394572270e-01f,9.907692363e-01f,1.355592873e-01f,9.970778984e-01f,7.639152146e-02f,9.990756424e-01f,4.298675152e-02f,9.997076617e-01f,2.417832043e-02f,9.999075514e-01f,1.359737484e-02f,9.999707649e-01f,7.646527131e-03f,
9.998433086e-01f,1.770192511e-02f,9.250146691e-01f,-3.799313911e-01f,2.212981743e-01f,9.752061926e-01f,2.954782069e-02f,9.995633678e-01f,-3.073327792e-01f,-9.516021032e-01f,-7.855011387e-01f,6.188602113e-01f,1.784335295e-01f,9.839519681e-01f,7.091933579e-01f,7.050140291e-01f,9.047516642e-01f,4.259394629e-01f,9.695450064e-01f,2.449132102e-01f,9.903356068e-01f,1.386916938e-01f,9.969404762e-01f,7.816448565e-02f,9.990321560e-01f,4.398580752e-02f,9.996939072e-01f,2.474049220e-02f,9.999032016e-01f,1.391357271e-02f,9.999693893e-01f,7.824349474e-03f,
5.253219888e-01f,8.509035245e-01f,9.851382016e-01f,1.717635693e-01f,-9.294810554e-02f,9.956709545e-01f,-1.477329862e-01f,9.890272821e-01f,-2.107957994e-01f,-9.775301177e-01f,-8.190422014e-01f,5.737332763e-01f,1.472342216e-01f,9.891016550e-01f,6.965447594e-01f,7.175133435e-01f,9.004471075e-01f,4.349655234e-01f,9.681524315e-01f,2.503614776e-01f,9.898920739e-01f,1.418227133e-01f,9.967999021e-01f,7.993719522e-02f,9.989876708e-01f,4.498481582e-02f,9.996798365e-01f,2.530265802e-02f,9.998987517e-01f,1.422976918e-02f,9.999679821e-01f,8.002171569e-03f,
-4.321779449e-01f,9.017883476e-01f,7.418580135e-01f,6.705569982e-01f,-3.979767653e-01f,9.173954950e-01f,-3.203543695e-01f,9.472977768e-01f,-1.121526217e-01f,-9.936909929e-01f,-8.499939088e-01f,5.267925161e-01f,1.158876918e-01f,9.932623233e-01f,6.836758997e-01f,7.297857660e-01f,8.960525071e-01f,4.439480877e-01f,9.667292484e-01f,2.558017989e-01f,9.894386421e-01f,1.449523146e-01f,9.966561752e-01f,8.170965944e-02f,9.989421864e-01f,4.598378286e-02f,9.996654497e-01f,2.586481583e-02f,9.998942019e-01f,1.454596424e-02f,9.999665433e-01f,8.179994343e-03f,
-9.923354692e-01f,1.235731227e-01f,2.700984580e-01f,9.628327077e-01f,-6.635382560e-01f,7.481423547e-01f,-4.828719382e-01f,8.756909793e-01f,-1.238837738e-02f,-9.999232611e-01f,-8.782584087e-01f,4.781863313e-01f,8.442528403e-02f,9.964298126e-01f,6.705908480e-01f,7.418274156e-01f,8.915682887e-01f,4.528862843e-01f,9.652754871e-01f,2.612340599e-01f,9.889753181e-01f,1.480804517e-01f,9.965092972e-01f,8.348185785e-02f,9.988957032e-01f,4.698270019e-02f,9.996507468e-01f,2.642696360e-02f,9.998895520e-01f,1.486215783e-02f,9.999650728e-01f,8.357815927e-03f,
-6.401443395e-01f,-7.682546613e-01f,-2.848466063e-01f,9.585731119e-01f,-8.632964878e-01f,5.046971113e-01f,-6.301599705e-01f,7.764653318e-01f,8.749917344e-02f,-9.961645921e-01f,-9.037463447e-01f,4.280683876e-01f,5.287845807e-02f,9.986009557e-01f,6.572937422e-01f,7.536344847e-01f,8.869949277e-01f,4.617791660e-01f,9.637912089e-01f,2.666580313e-01f,9.885021022e-01f,1.512071226e-01f,9.963592674e-01f,8.525379969e-02f,9.988482211e-01f,4.798157054e-02f,9.996357278e-01f,2.698910488e-02f,9.998848022e-01f,1.517834901e-02f,9.999635708e-01f,8.535637247e-03f,
3.005925437e-01f,-9.537526528e-01f,-7.520639951e-01f,6.590900905e-01f,-9.774427254e-01f,2.112006594e-01f,-7.575730765e-01f,6.527503610e-01f,1.865124631e-01f,-9.824525948e-01f,-9.263771379e-01f,3.765971301e-01f,2.127875808e-02f,9.997735816e-01f,6.437888326e-01f,7.652032012e-01f,8.823328681e-01f,4.706258703e-01f,9.622764532e-01f,2.720735702e-01f,9.880190013e-01f,1.543322815e-01f,9.962060867e-01f,8.702547193e-02f,9.987997401e-01f,4.898039663e-02f,9.996203926e-01f,2.755123762e-02f,9.998799524e-01f,1.549453961e-02f,9.999620371e-01f,8.713459228e-03f,
9.649660285e-01f,-2.623748537e-01f,-9.876590838e-01f,1.566190737e-01f,-9.946564265e-01f,-1.032404628e-01f,-8.610927113e-01f,5.084479743e-01f,2.836621855e-01f,-9.589242747e-01f,-9.460792425e-01f,3.239352821e-01f,-1.034221888e-02f,9.999465178e-01f,6.300802992e-01f,7.765299843e-01f,8.775825619e-01f,4.794255386e-01f,9.607312596e-01f,2.774805341e-01f,9.875260201e-01f,1.574558971e-01f,9.960497565e-01f,8.879686156e-02f,9.987502604e-01f,4.997917001e-02f,9.996047414e-01f,2.811335979e-02f,9.998750026e-01f,1.581072865e-02f,9.999604718e-01f,8.891280002e-03f,
7.421541968e-01f,6.702291758e-01f,-9.190735378e-01f,-3.940860720e-01f,-9.132301279e-01f,-4.074441477e-01f,-9.374542500e-01f,3.481085020e-01f,3.779776544e-01f,-9.258147184e-01f,-9.627903713e-01f,2.702493312e-01f,-4.195285448e-02f,9.991195914e-01f,6.161725219e-01f,7.876112133e-01f,8.727445123e-01f,4.881772386e-01f,9.591556934e-01f,2.828786946e-01f,9.870231637e-01f,1.605779382e-01f,9.958902758e-01f,9.056797780e-02f,9.986997817e-01f,5.097789714e-02f,9.995887740e-01f,2.867547492e-02f,9.998699528e-01f,1.612691704e-02f,9.999588749e-01f,9.069100495e-03f,
-1.629907808e-01f,9.866275920e-01f,-5.674300293e-01f,-8.234216185e-01f,-7.412399645e-01f,-6.712401321e-01f,-9.842484715e-01f,1.767906850e-01f,4.685169241e-01f,-8.834545217e-01f,-9.764576931e-01f,2.157090023e-01f,-7.352154075e-02f,9.972936293e-01f,6.020698986e-01f,7.984433839e-01f,8.678191892e-01f,4.968801213e-01f,9.575497876e-01f,2.882679384e-01f,9.865104371e-01f,1.636983734e-01f,9.957276465e-01f,9.233880022e-02f,9.986483046e-01f,5.197656957e-02f,9.995724905e-01f,2.923758099e-02f,9.998648031e-01f,1.644310196e-02f,9.999572463e-01f,9.246920701e-03f,
-9.182827862e-01f,3.959251502e-01f,-4.102818995e-02f,-9.991579893e-01f,-4.957418213e-01f,-8.684699457e-01f,-9.999999947e-01f,-1.030206758e-04f,5.543744949e-01f,-8.322673365e-01f,-9.870379993e-01f,1.604867217e-01f,-1.050167117e-01f,9.944704572e-01f,5.877769370e-01f,8.090230357e-01f,8.628070850e-01f,5.055333165e-01f,9.559136100e-01f,2.936480378e-01f,9.859878454e-01f,1.668171717e-01f,9.955618677e-01f,9.410933806e-02f,9.985958286e-01f,5.297519375e-02f,9.995558910e-01f,2.979967596e-02f,9.998595533e-01f,1.675928710e-02f,9.999555861e-01f,9.424741546e-03f,
-8.293098329e-01f,-5.587890489e-01f,4.980096003e-01f,-8.671715159e-01f,-2.010796199e-01f,-9.795749009e-01f,-9.842120244e-01f,-1.769934771e-01f,6.346929496e-01f,-7.727644270e-01f,-9.944978661e-01f,1.047568344e-01f,-1.364068747e-01f,9.906528981e-01f,5.732980611e-01f,8.193468943e-01f,8.577087010e-01f,5.141359589e-01f,9.542471952e-01f,2.990188798e-01f,9.854553963e-01f,1.699342871e-01f,9.953929407e-01f,9.587957830e-02f,9.985423542e-01f,5.397376122e-02f,9.995389754e-01f,3.036176336e-02f,9.998542036e-01f,1.707546870e-02f,9.999538943e-01f,9.602561162e-03f,
2.212675626e-02f,-9.997551734e-01f,8.836693140e-01f,-4.681116785e-01f,1.135217773e-01f,-9.935355082e-01f,-9.373825054e-01f,-3.483016489e-01f,7.086697743e-01f,-7.055403256e-01f,-9.988136461e-01f,4.869599955e-02f,-1.676606422e-01f,9.858447692e-01f,5.586378969e-01f,8.294116591e-01f,8.525245158e-01f,5.226872391e-01f,9.525506134e-01f,3.043802375e-01f,9.849130902e-01f,1.730497178e-01f,9.952208667e-01f,9.764950793e-02f,9.984878810e-01f,5.497227845e-02f,9.995217437e-01f,3.092384116e-02f,9.998487538e-01f,1.739165045e-02f,9.999521709e-01f,9.780380474e-03f,
8.532201077e-01f,-5.215510021e-01f,9.971746360e-01f,7.511820869e-02f,4.168670742e-01f,-9.089674595e-01f,-8.609884168e-01f,-5.086245631e-01f,7.755658183e-01f,-6.312667118e-01f,-9.999717335e-01f,-7.518784889e-03f,-1.987468801e-01f,9.800508546e-01f,5.438010803e-01f,8.392141473e-01f,8.472551097e-01f,5.311861999e-01f,9.508239095e-01f,3.097319700e-01f,9.843609349e-01f,1.761634181e-01f,9.950456449e-01f,9.941913618e-02f,9.984324096e-01f,5.597073698e-02f,9.995041959e-01f,3.148590732e-02f,9.998432041e-01f,1.770782860e-02f,9.999504159e-01f,9.958200408e-03f,
8.998668270e-01f,4.361647552e-01f,8.035690866e-01f,5.952114944e-01f,6.788702112e-01f,-7.342582900e-01f,-7.574391895e-01f,-6.529057162e-01f,8.347129424e-01f,-5.506853038e-01f,-9.979684672e-01f,-6.370979912e-02f,-2.296342702e-01f,9.732769914e-01f,5.287923029e-01f,8.487512594e-01f,8.419009790e-01f,5.396320427e-01f,9.490671287e-01f,3.150739362e-01f,9.837989360e-01f,1.792753567e-01f,9.948672764e-01f,1.011884500e-01f,9.983759396e-01f,5.696914326e-02f,9.994863320e-01f,3.204796724e-02f,9.998375544e-01f,1.802400685e-02f,9.999486292e-01f,1.013601910e-02f,
1.191801354e-01f,9.928726481e-01f,3.624766664e-01f,9.319928467e-01f,8.735505105e-01f,-4.867335058e-01f,-6.300007138e-01f,-7.765945536e-01f,8.855196056e-01f,-4.646020105e-01f,-9.928101803e-01f,-1.196993984e-01f,-2.602920453e-01f,9.655299328e-01f,5.136163109e-01f,8.580199795e-01f,8.364626591e-01f,5.480239228e-01f,9.472803452e-01f,3.204059106e-01f,9.832270991e-01f,1.823855026e-01f,9.946857626e-01f,1.029574365e-01f,9.983184713e-01f,5.796748886e-02f,9.994681521e-01f,3.261001331e-02f,9.998318047e-01f,1.834018143e-02f,9.999468110e-01f,1.031383746e-02f,
-7.710802230e-01f,6.367380071e-01f,-1.902490958e-01f,9.817358512e-01f,9.816020978e-01f,-1.909380047e-01f,-4.826923346e-01f,-8.757899920e-01f,9.274784664e-01f,-3.738765764e-01f,-9.845131804e-01f,-1.753105749e-01f,-2.906895502e-01f,9.568174253e-01f,4.982779032e-01f,8.670173765e-01f,8.309406937e-01f,5.563610011e-01f,9.454635966e-01f,3.257277812e-01f,9.826454300e-01f,1.854938246e-01f,9.945011026e-01f,1.047261048e-01f,9.982600046e-01f,5.896578020e-02f,9.994496561e-01f,3.317204907e-02f,9.998259550e-01f,1.865635603e-02f,9.999449611e-01f,1.049165644e-02f,
-9.524129804e-01f,-3.048106211e-01f,-6.843819158e-01f,7.291237161e-01f,9.923083195e-01f,1.237909494e-01f,-3.201591802e-01f,-9.473637630e-01f,9.601702867e-01f,-2.794154982e-01f,-9.731036980e-01f,-2.303675170e-01f,-3.207963899e-01f,9.471481807e-01f,4.827820346e-01f,8.757405478e-01f,8.253356351e-01f,5.646424439e-01f,9.436169596e-01f,3.310393232e-01f,9.820539344e-01f,1.886002917e-01f,9.943132976e-01f,1.064944419e-01f,9.982005398e-01f,5.996400886e-02f,9.994308440e-01f,3.373407806e-02f,9.998200054e-01f,1.897252691e-02f,9.999430795e-01f,1.066947415e-02f,
-2.581016359e-01f,-9.661177700e-01f,-9.677396624e-01f,2.519522691e-01f,9.046075662e-01f,4.262454119e-01f,-1.475292025e-01f,-9.890577002e-01f,9.832684211e-01f,-1.821625980e-01f,-9.586178037e-01f,-2.846961652e-01f,-3.505824602e-01f,9.365318674e-01f,4.671333972e-01f,8.841868520e-01f,8.196480097e-01f,5.728674718e-01f,9.417404730e-01f,3.363404250e-01f,9.814526211e-01f,1.917048581e-01f,9.941223492e-01f,1.082624348e-01f,9.981400766e-01f,6.096218127e-02f,9.994117160e-01f,3.429609266e-02f,9.998139558e-01f,1.928869776e-02f,9.999411664e-01f,1.084729152e-02f,
6.735071623e-01f,-7.391806966e-01f,-9.530500361e-01f,-3.028128610e-01f,7.271980777e-01f,6.864276770e-01f,2.975377145e-02f,-9.995572585e-01f,9.965421208e-01f,-8.308911770e-02f,-9.411012936e-01f,-3.381247627e-01f,-3.800179774e-01f,9.249791008e-01f,4.513370430e-01f,8.923535586e-01f,8.138784539e-01f,5.810351644e-01f,9.398342161e-01f,3.416308626e-01f,9.808414904e-01f,1.948075221e-01f,9.939282563e-01f,1.100300928e-01f,9.980786154e-01f,6.196028901e-02f,9.993922719e-01f,3.485809641e-02f,9.998078062e-01f,1.960486481e-02f,9.999392216e-01f,1.102510855e-02f,
9.858965816e-01f,1.673557003e-01f,-6.448370157e-01f,-7.643201052e-01f,4.776714527e-01f,8.785385497e-01f,2.060983265e-01f,-9.785312871e-01f,9.998586332e-01f,1.681409119e-02f,-9.206095453e-01f,-3.904843980e-01f,-4.090735085e-01f,9.125014327e-01f,4.353979670e-01f,9.002380853e-01f,8.080275111e-01f,5.891447541e-01f,9.378982288e-01f,3.469105251e-01f,9.802205514e-01f,1.979082381e-01f,9.937310211e-01f,1.117973955e-01f,9.980161562e-01f,6.295833478e-02f,9.993725116e-01f,3.542009286e-02f,9.998015566e-01f,1.992103176e-02f,9.999372453e-01f,1.120292616e-02f
};

#define XB_TMO      128
#define XB_XCNT(j)  (256  + 64 * (j))
#define XB_XSUB(j)  (1280 + 64 * (j))
#define XB_XGEN(j)  (2304 + 64 * (j))
#define XB_TOP      3328
#define XB_TOPGEN   3392
#define XCD_BAR_WORDS 3456
#define XB_SPIN_CAP (1u << 18)

__device__ __forceinline__ unsigned xb_ld(unsigned* p)              { return __hip_atomic_load(p, __ATOMIC_RELAXED, __HIP_MEMORY_SCOPE_AGENT); }
__device__ __forceinline__ unsigned xb_add(unsigned* p, unsigned v) { return __hip_atomic_fetch_add(p, v, __ATOMIC_RELAXED, __HIP_MEMORY_SCOPE_AGENT); }
__device__ __forceinline__ unsigned xb_xcc_id() { return (unsigned)__builtin_amdgcn_s_getreg((3 << 11) | 20) & 0xFu; }
#define XB_SPIN(cond, bar) do { unsigned _sp = 0; while (cond) { __builtin_amdgcn_s_sleep(1); \
    if ((++_sp & 255u) == 0u) { if (xb_ld(&(bar)[XB_TMO])) break; if (_sp > XB_SPIN_CAP) { atomicAdd(&(bar)[XB_TMO], 1u); break; } } } } while (0)

struct XcdBarrier {
    unsigned* bar; unsigned x;
    volatile LAS unsigned* st;
};

__device__ __forceinline__ XcdBarrier xcd_barrier_post(unsigned* bar, volatile LAS unsigned* st) {
    XcdBarrier b; b.bar = bar; b.x = xb_xcc_id(); b.st = st;
    if (threadIdx.x == 0) (void)xb_add(&bar[XB_XCNT(b.x)], 1u);
    return b;
}
__device__ __forceinline__ void xcd_barrier_complete(unsigned* bar, unsigned x, unsigned& nloc, unsigned& nx) {
    const unsigned G = gridDim.x * gridDim.y * gridDim.z;
    unsigned sum, cnt, mine, sp = 0u;
    for (;;) {
        sum = 0u; cnt = 0u; mine = 0u;
#pragma unroll
        for (unsigned j = 0; j < 16; ++j) { const unsigned c = xb_ld(&bar[XB_XCNT(j)]); sum += c; cnt += (c > 0u) ? 1u : 0u; mine = (j == x) ? c : mine; }
        if (sum == G) break;
        __builtin_amdgcn_s_sleep(1);
        if ((++sp & 255u) == 0u) { if (xb_ld(&bar[XB_TMO])) break; if (sp > XB_SPIN_CAP) { atomicAdd(&bar[XB_TMO], 1u); break; } }
    }
    nloc = mine > 0u ? mine : 1u; nx = cnt > 0u ? cnt : 1u;
}

__device__ __forceinline__ void xcd_barrier(const XcdBarrier& b) {
    asm volatile("s_waitcnt vmcnt(0)" ::: "memory");
    __syncthreads();
    if (threadIdx.x == 0) {
        unsigned* bar = b.bar;
        __builtin_amdgcn_s_waitcnt(0);
        unsigned nloc = b.st[0], nx = b.st[1];
        if (nloc == 0u) { xcd_barrier_complete(bar, b.x, nloc, nx); b.st[0] = nloc; b.st[1] = nx; }
        const unsigned old = xb_add(&bar[XB_XSUB(b.x)], 1u);
        const unsigned gen = old / nloc;
        if (old + 1u == (gen + 1u) * nloc) {
            __builtin_amdgcn_fence(__ATOMIC_RELEASE, "agent");
            asm volatile("s_waitcnt vmcnt(0)" ::: "memory");
            const unsigned og = xb_add(&bar[XB_TOP], 1u);
            const unsigned tg = og / nx;
            if (og + 1u == (tg + 1u) * nx) xb_add(&bar[XB_TOPGEN], 1u);
            else XB_SPIN(xb_ld(&bar[XB_TOPGEN]) == tg, bar);
            __builtin_amdgcn_fence(__ATOMIC_ACQUIRE, "agent");
            xb_add(&bar[XB_XGEN(b.x)], 1u);
            asm volatile("s_waitcnt vmcnt(0)" ::: "memory");
        } else {
            XB_SPIN(xb_ld(&bar[XB_XGEN(b.x)]) == gen, bar);
            __builtin_amdgcn_fence(__ATOMIC_ACQUIRE, "agent");
            asm volatile("s_waitcnt vmcnt(0)" ::: "memory");
        }
    }
    __syncthreads();
}

typedef __bf16 bf16x2_t __attribute__((ext_vector_type(2)));
DEVI unsigned pk_bf16(float lo, float hi) {
    f32x2 f = {lo, hi}; bf16x2_t v = __builtin_convertvector(f, bf16x2_t); unsigned r; __builtin_memcpy(&r, &v, 4); return r; }
DEVI float bf_lo(unsigned w) { return __uint_as_float(w << 16); }
DEVI float bf_hi(unsigned w) { return __uint_as_float(w & 0xffff0000u); }
DEVI bf16x8 lds_ld128(lds_t* p) { return *(LAS bf16x8*)p; }
DEVI void lds_st128(lds_t* p, u32x4 v) { *(LAS u32x4*)p = v; }
DEVI float wave_sum(float v) {
#pragma unroll
    for (int o = 32; o >= 1; o >>= 1) v += __shfl_xor(v, o);
    return v;
}
DEVI float fexp2(float x) { return __builtin_amdgcn_exp2f(x); }
DEVI float frcp(float x) { return __builtin_amdgcn_rcpf(x); }
DEVI float silu_f(float x) { return x * frcp(1.0f + fexp2(-LOG2E * x)); }
DEVI float gelu_tanh_f(float x) {
    const float y = 0.7978845608028654f * (x + 0.044715f * x * x * x);
    const float e = fexp2((2.0f * LOG2E) * y);
    const float t = 1.0f - 2.0f * frcp(e + 1.0f);
    return 0.5f * x * (1.0f + t);
}
DEVI int cond_of_row(int row) { return row < NPR ? 0 : 1 + ((row - NPR) >> 10); }

struct Params {
    const float *x_prompt, *x_sample, *cache_ckv, *cache_kpe, *cache_k, *cache_v, *c, *c_ctx, *mod_w, *mod_b, *ln_gain, *ln_bias,
        *mla_w_in, *mla_q_gain, *mla_kv_gain, *mla_w_q_up, *mla_w_kv_up, *mla_w_out,
        *gm_w_in, *gm_v_gain, *gm_w_s, *gm_b_s, *gm_w_out, *swa_w_qkv, *swa_sink, *swa_w_out,
        *moe_router, *moe_w_gate, *moe_w_up, *moe_w_down;
    float* out;
    unsigned* bar;
    float *mod, *X0, *X1, *T, *Z, *GST, *AFF, *GATEV;
    bf16_t *H, *H2, *CQ, *CKV, *KPE, *Q, *KN, *VTP, *VTS, *O, *U, *GVT, *TT, *SK, *SVTP, *SVTS, *HID, *YE;
    bf16_t *WTI, *WTQ, *WTKV, *WTO, *WTGI, *WTGO, *WTSQ, *WTSO;
    int *SEL, *IDX;
    long long ph_lo, ph_hi;
};
constexpr size_t OUT_Y = 0;
constexpr size_t OUT_CKV = 8388608;
constexpr size_t OUT_KPE = OUT_CKV + 2097152;
constexpr size_t OUT_SK = OUT_KPE + 524288;
constexpr size_t OUT_SV = OUT_SK + 1048576;

DEVI const float* modp(const Params& p, int layer, int cnd, int which) { return p.mod + ((size_t)(layer * 5 + cnd) * 6 + which) * 1024; }

DEVI int swz(int row) { return ((row >> 1) & 7) ^ ((row >> 4) & 1); }
DEVI int img_off(int row, int chunk) { return row * 128 + ((chunk ^ swz(row)) << 4); }

template <int BM> struct XDma {
    static constexpr int NI = BM / 64;
    const bf16_t* base; unsigned off[NI];
    template <class RowFn> DEVI void init(const RowFn& rowfn, int tid) {
        const int w = tid >> 6, i = tid & 63;
        base = rowfn.base;
#pragma unroll
        for (int j = 0; j < NI; ++j) { const int row = 64 * j + 8 * w + (i >> 3); off[j] = rowfn.offset(row) + (((i & 7) ^ swz(row)) << 3); }
    }
    DEVI void issue(int kt, lds_t* img, int tid) const {
        lds_t* dst = img + (tid >> 6) * 1024 + (tid & 63) * 16;
#pragma unroll
        for (int j = 0; j < NI; ++j) __builtin_amdgcn_global_load_lds((const unsigned*)(base + off[j] + kt * 64), (LAS unsigned*)(dst + j * 8192), 16, 0, 0);
    }
};

struct WRegs {
    f32x4 r[8];
    DEVI void load(const float* p, size_t ldw, int kt) {
        const float* q = p + (size_t)kt * 64 * ldw;
#pragma unroll
        for (int i = 0; i < 8; ++i) r[i] = *(const f32x4*)(q + (size_t)i * ldw);
    }
    DEVI void store(lds_t* img, int wave, int lane) const {
#pragma unroll
        for (int c = 0; c < 4; ++c) {
            u32x4 v;
            v.x = pk_bf16(r[0][c], r[1][c]); v.y = pk_bf16(r[2][c], r[3][c]); v.z = pk_bf16(r[4][c], r[5][c]); v.w = pk_bf16(r[6][c], r[7][c]);
            lds_st128(img + img_off(4 * lane + c, wave), v);
        }
    }
};

template <int BM, bool TRANS>
DEVI void gemm_compute(lds_t* ximg, lds_t* wimg, f32x4 (&acc)[BM / 32][4], int wr, int wc, int lane) {
    constexpr int TM = BM / 32, NH = TM / 4, NSTEP = 2 * NH;
    const int r16 = lane & 15, g = lane >> 4;
    const int c0 = g ^ ((r16 >> 1) & 7);
    lds_t* xb = ximg + (wr * (BM / 2) + r16) * 128;
    lds_t* wb = wimg + (wc * 64 + r16) * 128;
    bf16x8 wf[2][4], xf[2][4];
#define LD_W(buf, s_) do { const int o0_ = ((c0 ^ (4 * (s_))) << 4), o1_ = ((c0 ^ (4 * (s_)) ^ 1) << 4); \
        _Pragma("unroll") for (int nb = 0; nb < 4; ++nb) wf[buf][nb] = lds_ld128(wb + nb * 2048 + ((nb & 1) ? o1_ : o0_)); } while (0)
#define LD_X(buf, s_, h_) do { const int o0_ = ((c0 ^ (4 * (s_))) << 4), o1_ = ((c0 ^ (4 * (s_)) ^ 1) << 4); \
        _Pragma("unroll") for (int m4 = 0; m4 < 4; ++m4) { const int mb_ = 4 * (h_) + m4; xf[buf][m4] = lds_ld128(xb + mb_ * 2048 + ((mb_ & 1) ? o1_ : o0_)); } } while (0)
    LD_W(0, 0); LD_X(0, 0, 0);
#pragma unroll
    for (int st = 0; st < NSTEP; ++st) {
        const int s = st / NH, h = st % NH;
        if (st + 1 < NSTEP) {
            const int s1 = (st + 1) / NH, h1 = (st + 1) % NH;
            if (s1 != s) LD_W(s1 & 1, s1);
            LD_X((st + 1) & 1, s1, h1);
        }
#pragma unroll
        for (int m4 = 0; m4 < 4; ++m4)
#pragma unroll
            for (int nb = 0; nb < 4; ++nb) {
                const int mb = 4 * h + m4;
                acc[mb][nb] = TRANS ? __builtin_amdgcn_mfma_f32_16x16x32_bf16(wf[s & 1][nb], xf[st & 1][m4], acc[mb][nb], 0, 0, 0)
                                    : __builtin_amdgcn_mfma_f32_16x16x32_bf16(xf[st & 1][m4], wf[s & 1][nb], acc[mb][nb], 0, 0, 0);
            }
        __builtin_amdgcn_sched_barrier(0);
    }
#undef LD_W
#undef LD_X
}

struct WLin { const float* base; DEVI const float* operator()(int lane) const { return base + 4 * lane; } };
template <int BM> struct GemmPipe {
    static constexpr int TM = BM / 32, STAGE = (BM + 256) * 128, NI = BM / 64;
    XDma<BM> xd; const float* wp; unsigned ldw; WRegs wr_; int par;
    template <class RowFn, class WFn> DEVI void prime(lds_t* lds, const RowFn& rf, const WFn& wf, unsigned ldw_, int tid_in) {
        const int tid = tid_in;
        const int lane = tid & 63, wave = tid >> 6;
        xd.init(rf, tid); ldw = ldw_; wp = wf(lane) + (size_t)(8 * wave) * ldw_; par = 0;
        wr_.load(wp, ldw, 0);
        __syncthreads();
        xd.issue(0, lds, tid); wr_.store(lds + BM * 128, wave, lane);
        wr_.load(wp, ldw, 1);
    }
    template <bool TRANS, bool XUNIT = true, class Epi, class RowFnN, class WFnN>
    DEVI void run(lds_t* lds, int nk, const Epi& epi, bool has_next_in, const RowFnN& rfn, const WFnN& wfn, unsigned ldw_n, int tid_in) {
        int tid = tid_in; asm volatile("" : "+v"(tid));
        const int lane = tid & 63, wave = tid >> 6, wrow = wave >> 2, wcol = wave & 3;
        const bool has_next = XUNIT && has_next_in;
        f32x4 acc[TM][4];
#pragma unroll
        for (int i = 0; i < TM; ++i)
#pragma unroll
            for (int j = 0; j < 4; ++j) acc[i][j] = (f32x4){0.f, 0.f, 0.f, 0.f};
        unsigned offn[NI];
        if (XUNIT) {
#pragma unroll
            for (int j = 0; j < NI; ++j) offn[j] = 0u;
        }
        for (int t = 0; t < nk; ++t) {
            asm volatile("s_waitcnt vmcnt(0)" ::: "memory");
            __syncthreads();
            lds_t* cur = lds + ((par + t) & 1) * STAGE;
            lds_t* nxt = lds + ((par + t + 1) & 1) * STAGE;
            if (t + 2 < nk) {
                xd.issue(t + 1, nxt, tid); wr_.store(nxt + BM * 128, wave, lane); wr_.load(wp, ldw, t + 2);
            } else if (t + 1 < nk) {
                xd.issue(t + 1, nxt, tid); wr_.store(nxt + BM * 128, wave, lane);
                if (has_next) {
                    ldw = ldw_n; wp = wfn(lane) + (size_t)(8 * wave) * ldw_n; wr_.load(wp, ldw, 0);
#pragma unroll
                    for (int j = 0; j < NI; ++j) { const int row = 64 * j + 8 * wave + (lane >> 3); offn[j] = rfn.offset(row) + (((lane & 7) ^ swz(row)) << 3); }
                }
            } else if (has_next) {
                xd.base = rfn.base;
#pragma unroll
                for (int j = 0; j < NI; ++j) xd.off[j] = offn[j];
                xd.issue(0, nxt, tid); wr_.store(nxt + BM * 128, wave, lane); wr_.load(wp, ldw, 1);
            }
            gemm_compute<BM, TRANS>(cur, cur + BM * 128, acc, wrow, wcol, lane);
        }
        par = (par + nk) & 1;
        { int t2 = tid; asm volatile("" : "+v"(t2));
          const int w2 = t2 >> 6; epi(acc, w2 >> 2, w2 & 3, t2 & 63); }
    }
};

template <int BM, bool TRANS, class RowFn, class WFn, class Epi>
DEVI void gemm_unit(lds_t* lds, const RowFn& rowfn, const WFn& wfn, unsigned ldw, int nk, const Epi& epi, int tid_in) {
    int tid = tid_in; asm volatile("" : "+v"(tid));
    constexpr int TM = BM / 32;
    constexpr int STAGE = (BM + 256) * 128;
    const int lane = tid & 63, wave = tid >> 6, wr = wave >> 2, wc = wave & 3;
    XDma<BM> xd; WRegs wl;
    const float* wp = wfn(lane) + (size_t)(8 * wave) * ldw;
    wl.load(wp, ldw, 0);
    xd.init(rowfn, tid);
    f32x4 acc[TM][4];
#pragma unroll
    for (int i = 0; i < TM; ++i)
#pragma unroll
        for (int j = 0; j < 4; ++j) acc[i][j] = (f32x4){0.f, 0.f, 0.f, 0.f};
    __syncthreads();
    xd.issue(0, lds, tid); wl.store(lds + BM * 128, wave, lane);
    if (nk > 1) wl.load(wp, ldw, 1);
    for (int t = 0; t < nk; ++t) {
        asm volatile("s_waitcnt vmcnt(0)" ::: "memory");
        __syncthreads();
        lds_t* cur = lds + (t & 1) * STAGE;
        lds_t* nxt = lds + ((t + 1) & 1) * STAGE;
        if (t + 1 < nk) {
            xd.issue(t + 1, nxt, tid); wl.store(nxt + BM * 128, wave, lane);
            if (t + 2 < nk) wl.load(wp, ldw, t + 2);
        }
        gemm_compute<BM, TRANS>(cur, cur + BM * 128, acc, wr, wc, lane);
    }
    { int t2 = tid; asm volatile("" : "+v"(t2));
      const int w2 = t2 >> 6; epi(acc, w2 >> 2, w2 & 3, t2 & 63); }
}

template <int BM, bool TRANS, class RowFn, class WRowFn, class Epi>
DEVI void gemm_unit_bb(lds_t* lds, const RowFn& rowfn, const WRowFn& wrowfn, int nk, const Epi& epi, int tid_in) {
    int tid = tid_in; asm volatile("" : "+v"(tid));
    constexpr int TM = BM / 32;
    constexpr int STAGE = (BM + 256) * 128;
    const int lane = tid & 63, wave = tid >> 6, wr = wave >> 2, wc = wave & 3;
    XDma<BM> xd; XDma<256> wd;
    xd.init(rowfn, tid); wd.init(wrowfn, tid);
    f32x4 acc[TM][4];
#pragma unroll
    for (int i = 0; i < TM; ++i)
#pragma unroll
        for (int j = 0; j < 4; ++j) acc[i][j] = (f32x4){0.f, 0.f, 0.f, 0.f};
    __syncthreads();
    xd.issue(0, lds, tid); wd.issue(0, lds + BM * 128, tid);
    for (int t = 0; t < nk; ++t) {
        asm volatile("s_waitcnt vmcnt(0)" ::: "memory");
        __syncthreads();
        lds_t* cur = lds + (t & 1) * STAGE;
        lds_t* nxt = lds + ((t + 1) & 1) * STAGE;
        if (t + 1 < nk) { xd.issue(t + 1, nxt, tid); wd.issue(t + 1, nxt + BM * 128, tid); }
        gemm_compute<BM, TRANS>(cur, cur + BM * 128, acc, wr, wc, lane);
    }
    { int t2 = tid; asm volatile("" : "+v"(t2));
      const int w2 = t2 >> 6; epi(acc, w2 >> 2, w2 & 3, t2 & 63); }
}

template <int BM, bool TRANS, class RowFn, class WRowFn, class Epi>
DEVI void gemm_unit_bb3(lds_t* lds, const RowFn& rowfn, const WRowFn& wrowfn, int nk, const Epi& epi, int tid_in) {
    int tid = tid_in; asm volatile("" : "+v"(tid));
    constexpr int TM = BM / 32;
    constexpr int STAGE = (BM + 256) * 128;
    static_assert(BM == 128, "3 stages fit for BM = 128 only; the counted wait below assumes 2 + 4 DMA instructions per tile");
    const int lane = tid & 63, wave = tid >> 6, wr = wave >> 2, wc = wave & 3;
    XDma<BM> xd; XDma<256> wd;
    xd.init(rowfn, tid); wd.init(wrowfn, tid);
    f32x4 acc[TM][4];
#pragma unroll
    for (int i = 0; i < TM; ++i)
#pragma unroll
        for (int j = 0; j < 4; ++j) acc[i][j] = (f32x4){0.f, 0.f, 0.f, 0.f};
    __syncthreads();
    lds_t* s0 = lds; lds_t* s1 = lds + STAGE; lds_t* s2 = lds + 2 * STAGE;
    xd.issue(0, s0, tid); wd.issue(0, s0 + BM * 128, tid);
    if (nk > 1) { xd.issue(1, s1, tid); wd.issue(1, s1 + BM * 128, tid); }
    for (int t = 0; t < nk; ++t) {
        if (t + 1 < nk) asm volatile("s_waitcnt vmcnt(6)" ::: "memory");
        else asm volatile("s_waitcnt vmcnt(0)" ::: "memory");
        asm volatile("s_waitcnt lgkmcnt(0)" ::: "memory");
        __builtin_amdgcn_s_barrier();
        asm volatile("" ::: "memory");
        if (t + 2 < nk) { xd.issue(t + 2, s2, tid); wd.issue(t + 2, s2 + BM * 128, tid); }
        gemm_compute<BM, TRANS>(s0, s0 + BM * 128, acc, wr, wc, lane);
        lds_t* tmp = s0; s0 = s1; s1 = s2; s2 = tmp;
    }
    __syncthreads();
    { int t2 = tid; asm volatile("" : "+v"(t2));
      const int w2 = t2 >> 6; epi(acc, w2 >> 2, w2 & 3, t2 & 63); }
}

DEVI int swz32(int row) { return ((((row >> 2) ^ (row >> 3)) & 1) << 1) | ((row >> 2) & 1); }
template <int BM> struct XDma32 {
    static constexpr int NI = BM / 128;
    const bf16_t* base; unsigned off[NI];
    template <class RowFn> DEVI void init(const RowFn& rowfn, int tid) {
        const int w = tid >> 6, i = tid & 63;
        base = rowfn.base;
#pragma unroll
        for (int j = 0; j < NI; ++j) { const int row = 128 * j + 16 * w + (i >> 2); off[j] = rowfn.offset(row) + (((i & 3) ^ swz32(row)) << 3); }
    }
    DEVI void issue(int kt32, lds_t* img, int tid) const {
        lds_t* dst = img + (tid >> 6) * 1024 + (tid & 63) * 16;
#pragma unroll
        for (int j = 0; j < NI; ++j) __builtin_amdgcn_global_load_lds((const unsigned*)(base + off[j] + kt32 * 32), (LAS unsigned*)(dst + j * 8192), 16, 0, 0);
    }
};
template <int BM, bool TRANS>
DEVI void gemm_compute32(lds_t* ximg, lds_t* wimg, f32x4 (&acc)[BM / 32][4], int wr, int wc, int lane) {
    constexpr int TM = BM / 32;
    const int r16 = lane & 15, g = lane >> 4;
    const int c0 = (g ^ swz32(r16)) << 4;
    lds_t* xb = ximg + (wr * (BM / 2) + r16) * 64 + c0;
    lds_t* wb = wimg + (wc * 64 + r16) * 64 + c0;
    bf16x8 wf[4], xf[TM];
#pragma unroll
    for (int nb = 0; nb < 4; ++nb) wf[nb] = lds_ld128(wb + nb * 1024);
#pragma unroll
    for (int mb = 0; mb < TM; ++mb) xf[mb] = lds_ld128(xb + mb * 1024);
#pragma unroll
    for (int mb = 0; mb < TM; ++mb)
#pragma unroll
        for (int nb = 0; nb < 4; ++nb)
            acc[mb][nb] = TRANS ? __builtin_amdgcn_mfma_f32_16x16x32_bf16(wf[nb], xf[mb], acc[mb][nb], 0, 0, 0)
                                : __builtin_amdgcn_mfma_f32_16x16x32_bf16(xf[mb], wf[nb], acc[mb][nb], 0, 0, 0);
}
template <int BM, bool TRANS, class RowFn, class WRowFn, class Epi>
DEVI void gemm_unit_bb4(lds_t* lds, const RowFn& rowfn, const WRowFn& wrowfn, int nk2  , const Epi& epi, int tid_in) {
    int tid = tid_in; asm volatile("" : "+v"(tid));
    constexpr int TM = BM / 32;
    constexpr int XB = BM * 64, STAGE = XB + 256 * 64;
    static_assert(BM == 256, "the counted waits below assume 2 + 2 DMA instructions per sub-tile");
    const int lane = tid & 63, wave = tid >> 6, wr = wave >> 2, wc = wave & 3;
    XDma32<BM> xd; XDma32<256> wd;
    xd.init(rowfn, tid); wd.init(wrowfn, tid);
    f32x4 acc[TM][4];
#pragma unroll
    for (int i = 0; i < TM; ++i)
#pragma unroll
        for (int j = 0; j < 4; ++j) acc[i][j] = (f32x4){0.f, 0.f, 0.f, 0.f};
    __syncthreads();
#pragma unroll
    for (int t = 0; t < 3; ++t) if (t < nk2) { xd.issue(t, lds + t * STAGE, tid); wd.issue(t, lds + t * STAGE + XB, tid); }
    for (int t = 0; t < nk2; ++t) {
        const int rem = nk2 - 1 - t;
        if (rem >= 2) asm volatile("s_waitcnt vmcnt(8)" ::: "memory");
        else if (rem == 1) asm volatile("s_waitcnt vmcnt(4)" ::: "memory");
        else asm volatile("s_waitcnt vmcnt(0)" ::: "memory");
        asm volatile("s_waitcnt lgkmcnt(0)" ::: "memory");
        __builtin_amdgcn_s_barrier();
        asm volatile("" ::: "memory");
        if (t + 3 < nk2) { lds_t* st = lds + ((t + 3) & 3) * STAGE; xd.issue(t + 3, st, tid); wd.issue(t + 3, st + XB, tid); }
        lds_t* cur = lds + (t & 3) * STAGE;
        gemm_compute32<BM, TRANS>(cur, cur + XB, acc, wr, wc, lane);
    }
    __syncthreads();
    { int t2 = tid; asm volatile("" : "+v"(t2));
      const int w2 = t2 >> 6; epi(acc, w2 >> 2, w2 & 3, t2 & 63); }
}

DEVI void phase_modulation(const Params& p, lds_t* lds, int bid, int nblk, int tid) {
    LAS float* sc = (LAS float*)lds;
    LAS float* red = (LAS float*)(lds + 20480);
    __syncthreads();
    for (int i = tid; i < 5 * 1024; i += NTHREADS) {
        const int cnd = i >> 10, k = i & 1023;
        const float v = cnd == 0 ? p.c_ctx[k] : p.c[(cnd - 1) * 1024 + k];
        sc[i] = silu_f(v);
    }
    __syncthreads();
    const int cg = tid & 31, kg = tid >> 5;
    for (int u = bid; u < DEPTH * 48; u += nblk) {
        const int l = u / 48, n0 = (u % 48) * 128;
        const float* w = p.mod_w + (size_t)l * 1024 * 6144 + n0 + 4 * cg;
        f32x4 a[5];
#pragma unroll
        for (int c = 0; c < 5; ++c) a[c] = (f32x4){0.f, 0.f, 0.f, 0.f};
#pragma unroll 8
        for (int kk = 0; kk < 64; ++kk) {
            const int k = kg * 64 + kk;
            const f32x4 wv = *(const f32x4*)(w + (size_t)k * 6144);
#pragma unroll
            for (int c = 0; c < 5; ++c) a[c] += wv * sc[c * 1024 + k];
        }
#pragma unroll
        for (int c = 0; c < 5; ++c) *(LAS f32x4*)(red + (kg * 5 + c) * 128 + 4 * cg) = a[c];
        __syncthreads();
        for (int i = tid; i < 5 * 128; i += NTHREADS) {
            const int c = i >> 7, n = i & 127;
            float s = 0.f;
#pragma unroll
            for (int q = 0; q < 16; ++q) s += red[(q * 5 + c) * 128 + n];
            p.mod[(size_t)(l * 5 + c) * 6144 + n0 + n] = s + p.mod_b[l * 6144 + n0 + n];
        }
        __syncthreads();
    }
}


DEVI void wconv_tile(const float* W, bf16_t* Wt, int K, int N, int tk, int tn, lds_t* lds, int tid) {
    LAS bf16_t* s = (LAS bf16_t*)lds;
    __syncthreads();
#pragma unroll
    for (int i = 0; i < 2; ++i) {
        const int c = tid + NTHREADS * i, k = c >> 4, n4 = (c & 15) * 4;
        const f32x4 v = *(const f32x4*)(W + (size_t)(tk * 64 + k) * N + tn * 64 + n4);
#pragma unroll
        for (int q = 0; q < 4; ++q) s[(n4 + q) * 72 + k] = (bf16_t)(pk_bf16(v[q], 0.f) & 0xffffu);
    }
    __syncthreads();
    { const int n = tid >> 3, kc = tid & 7;
      const u32x4 v = *(LAS u32x4*)(s + n * 72 + kc * 8);
      *(u32x4*)(Wt + (size_t)(tn * 64 + n) * K + tk * 64 + kc * 8) = v; }
}
DEVI void phase_wconv(const Params& p, lds_t* lds, int bid, int nblk, int tid) {
    for (int it = bid; it < 4352; it += nblk) {
        int r = it; const float* W; bf16_t* Wt; int K, N;
        if (r < 352) { const int j = r / 176; r %= 176; W = p.mla_w_in + (size_t)j * 1024 * 704; Wt = p.WTI + (size_t)j * 704 * 1024; K = 1024; N = 704; }
        else if ((r -= 352) < 288) { const int j = r / 144; r %= 144; W = p.mla_w_q_up + (size_t)j * 384 * 1536; Wt = p.WTQ + (size_t)j * 1536 * 384; K = 384; N = 1536; }
        else if ((r -= 288) < 256) { const int j = r / 128; r %= 128; W = p.mla_w_kv_up + (size_t)j * 256 * 2048; Wt = p.WTKV + (size_t)j * 2048 * 256; K = 256; N = 2048; }
        else if ((r -= 256) < 512) { const int j = r / 256; r %= 256; W = p.mla_w_out + (size_t)j * 1024 * 1024; Wt = p.WTO + (size_t)j * 1024 * 1024; K = 1024; N = 1024; }
        else if ((r -= 512) < 1536) { W = p.gm_w_in; Wt = p.WTGI; K = 1024; N = 6144; }
        else if ((r -= 1536) < 768) { W = p.gm_w_out; Wt = p.WTGO; K = 3072; N = 1024; }
        else if ((r -= 768) < 384) { W = p.swa_w_qkv; Wt = p.WTSQ; K = 1024; N = 1536; }
        else { r -= 384; W = p.swa_w_out; Wt = p.WTSO; K = 1024; N = 1024; }
        const int ntn = N / 64;
        wconv_tile(W, Wt, K, N, r / ntn, r % ntn, lds, tid);
    }
}

DEVI void phase_prep(const Params& p, int bid, int nblk, int tid) {
    const int lane = tid & 63, wave = tid >> 6;
    for (int row = bid * 8 + wave; row < NTOK; row += nblk * 8) {
        const float* src = row < NPR ? p.x_prompt + (size_t)row * D : p.x_sample + (size_t)(row - NPR) * D;
        const int cnd = cond_of_row(row);
        const float* sh = modp(p, 0, cnd, 0); const float* scl = modp(p, 0, cnd, 1);
#pragma unroll
        for (int i = 0; i < 4; ++i) {
            const int col = lane * 4 + 256 * i;
            const f32x4 v = *(const f32x4*)(src + col);
            const f32x4 s = *(const f32x4*)(scl + col), b = *(const f32x4*)(sh + col);
            const f32x4 h = v * (s + 1.0f) + b;
            u32x2 o; o.x = pk_bf16(h[0], h[1]); o.y = pk_bf16(h[2], h[3]);
            *(u32x2*)(p.H + (size_t)row * D + col) = o;
        }
    }
    for (int i = bid * NTHREADS + tid; i < 1024 * 64; i += nblk * NTHREADS) {
        const f32x4 v = *(const f32x4*)(p.cache_k + (size_t)i * 4);
        u32x2 o; o.x = pk_bf16(v[0], v[1]); o.y = pk_bf16(v[2], v[3]);
        *(u32x2*)(p.SK + (size_t)NTOK * 256 + (size_t)i * 4) = o;
    }
    for (int i = bid * NTHREADS + tid; i < 4 * 4 * 64 * 64; i += nblk * NTHREADS) {
        const int kg4 = i & 63, dv = (i >> 6) & 63, kvh = (i >> 12) & 3, b = i >> 14;
        float v[4];
#pragma unroll
        for (int q = 0; q < 4; ++q) v[q] = p.cache_v[((size_t)(b * 256 + kg4 * 4 + q) * 4 + kvh) * 64 + dv];
        u32x2 o; o.x = pk_bf16(v[0], v[1]); o.y = pk_bf16(v[2], v[3]);
        *(u32x2*)(p.SVTS + ((size_t)(b * 4 + kvh) * 64 + dv) * 1280 + kg4 * 4) = o;
    }
}

DEVI void phase_mla_norm(const Params& p, int j, int bid, int nblk, int tid) {
    const int lane = tid & 63, wave = tid >> 6;
    const float* qg = p.mla_q_gain + j * 384; const float* kg = p.mla_kv_gain + j * 256;
    for (int row = bid * 8 + wave; row < NROWS_KV; row += nblk * 8) {
        if (row >= NTOK) {
            const int b = (row - NTOK) >> 8, t = (row - NTOK) & 255;
            const float* ck = p.cache_ckv + ((size_t)(b * 2 + j) * 256 + t) * 256;
            const f32x4 v = *(const f32x4*)(ck + lane * 4);
            u32x2 o; o.x = pk_bf16(v[0], v[1]); o.y = pk_bf16(v[2], v[3]);
            *(u32x2*)(p.CKV + (size_t)row * 256 + lane * 4) = o;
            const float kp = p.cache_kpe[((size_t)(b * 2 + j) * 256 + t) * 64 + lane];
            p.KPE[(size_t)row * 64 + lane] = (bf16_t)(pk_bf16(kp, 0.f) & 0xffffu);
            continue;
        }
        const float* z = p.Z + (size_t)row * 704;
        float q[6]; float ss = 0.f;
#pragma unroll
        for (int i = 0; i < 6; ++i) { q[i] = z[lane + 64 * i]; ss += q[i] * q[i]; }
        ss = wave_sum(ss);
        const float rq = rsqrtf(ss * (1.0f / 384.0f) + EPS_F);
#pragma unroll
        for (int i = 0; i < 6; ++i) p.CQ[(size_t)row * 384 + lane + 64 * i] = (bf16_t)(pk_bf16(q[i] * rq * qg[lane + 64 * i], 0.f) & 0xffffu);
        const f32x4 kv = *(const f32x4*)(z + 384 + lane * 4);
        float s2 = kv[0] * kv[0] + kv[1] * kv[1] + kv[2] * kv[2] + kv[3] * kv[3];
        s2 = wave_sum(s2);
        const float rk = rsqrtf(s2 * (1.0f / 256.0f) + EPS_F);
        const f32x4 gv = *(const f32x4*)(kg + lane * 4);
        const f32x4 kn = kv * rk * gv;
        { u32x2 o; o.x = pk_bf16(kn[0], kn[1]); o.y = pk_bf16(kn[2], kn[3]); *(u32x2*)(p.CKV + (size_t)row * 256 + lane * 4) = o; }
        float kp = z[640 + lane];
        if (row < NPR) {
            const int b = row >> 8, t = row & 255;
            *(f32x4*)(p.out + OUT_CKV + ((size_t)(b * 2 + j) * 256 + t) * 256 + lane * 4) = kn;
            p.out[OUT_KPE + ((size_t)(b * 2 + j) * 256 + t) * 64 + lane] = kp;
        } else {
            const int t = (row - NPR) & 1023;
            const int pos = lane < 32 ? (t >> 6) : (t & 63);
            const float cs = rope_tab[(pos * 16 + (lane & 15)) * 2], sn = rope_tab[(pos * 16 + (lane & 15)) * 2 + 1];
            const float other = __shfl_xor(kp, 16);
            kp = (lane & 16) ? (kp * cs + other * sn) : (kp * cs - other * sn);
        }
        p.KPE[(size_t)row * 64 + lane] = (bf16_t)(pk_bf16(kp, 0.f) & 0xffffu);
    }
}

DEVI void phase_ln_a(const Params& p, int layer, lds_t* lds, int bid, int nblk, int tid) {
    const int lane = tid & 63, wave = tid >> 6;
    LAS float* rt = (LAS float*)lds;
    const float* router = p.moe_router + (size_t)layer * 1024 * 16;
    __syncthreads();
    for (int i = tid; i < 4096; i += NTHREADS) {
        const f32x4 w = *(const f32x4*)(router + i * 4);
        const int k = i >> 2, e0 = (i & 3) * 4;
        rt[(e0 + 0) * 1024 + k] = w[0]; rt[(e0 + 1) * 1024 + k] = w[1]; rt[(e0 + 2) * 1024 + k] = w[2]; rt[(e0 + 3) * 1024 + k] = w[3];
    }
    __syncthreads();
    const float* lg = p.ln_gain + (layer * 2 + 0) * 1024; const float* lb = p.ln_bias + (layer * 2 + 0) * 1024;
    for (int r0 = (bid * 8 + wave) * 4; r0 < NTOK; r0 += nblk * 32) {
        const int cnd = cond_of_row(r0);
        const float* sh = modp(p, layer, cnd, 3); const float* scl = modp(p, layer, cnd, 4);
        f32x4 v[4][4];
        float mu[4], rs[4];
#pragma unroll
        for (int j = 0; j < 4; ++j)
#pragma unroll
            for (int i = 0; i < 4; ++i) v[j][i] = *(const f32x4*)(p.T + (size_t)(r0 + j) * D + lane * 4 + 256 * i);
#pragma unroll
        for (int j = 0; j < 4; ++j) { float s = 0.f;
#pragma unroll
            for (int i = 0; i < 4; ++i) s += (v[j][i][0] + v[j][i][1]) + (v[j][i][2] + v[j][i][3]);
            mu[j] = s; }
#pragma unroll
        for (int j = 0; j < 4; ++j) mu[j] = wave_sum(mu[j]) * (1.0f / 1024.0f);
#pragma unroll
        for (int j = 0; j < 4; ++j) { float q = 0.f;
#pragma unroll
            for (int i = 0; i < 4; ++i) { v[j][i] = v[j][i] - mu[j]; q += (v[j][i][0] * v[j][i][0] + v[j][i][1] * v[j][i][1]) + (v[j][i][2] * v[j][i][2] + v[j][i][3] * v[j][i][3]); }
            rs[j] = q; }
#pragma unroll
        for (int j = 0; j < 4; ++j) rs[j] = rsqrtf(wave_sum(rs[j]) * (1.0f / 1024.0f) + EPS_F);
        float lgt[4][16];
#pragma unroll
        for (int j = 0; j < 4; ++j)
#pragma unroll
            for (int e = 0; e < 16; ++e) lgt[j][e] = 0.f;
#pragma unroll
        for (int i = 0; i < 4; ++i) {
            const int col = lane * 4 + 256 * i;
            const f32x4 g4 = *(const f32x4*)(lg + col), b4 = *(const f32x4*)(lb + col), sc4 = *(const f32x4*)(scl + col) + 1.0f, sh4 = *(const f32x4*)(sh + col);
            f32x4 h[4];
#pragma unroll
            for (int j = 0; j < 4; ++j) {
                const f32x4 x = v[j][i] * rs[j] * g4 + b4;
                *(f32x4*)(p.X1 + (size_t)(r0 + j) * D + col) = x;
                h[j] = x * sc4 + sh4;
                u32x2 o; o.x = pk_bf16(h[j][0], h[j][1]); o.y = pk_bf16(h[j][2], h[j][3]);
                *(u32x2*)(p.H2 + (size_t)(r0 + j) * D + col) = o;
            }
#pragma unroll
            for (int e = 0; e < 16; ++e) {
                const f32x4 rw = *(LAS f32x4*)(rt + e * 1024 + col);
#pragma unroll
                for (int j = 0; j < 4; ++j) lgt[j][e] += (h[j][0] * rw[0] + h[j][1] * rw[1]) + (h[j][2] * rw[2] + h[j][3] * rw[3]);
                if ((e & 3) == 3) __builtin_amdgcn_sched_barrier(0);
            }
        }
        float r1[4];
#pragma unroll
        for (int j = 0; j < 4; ++j) {
            float r8[8], r4[4], r2[2];
            { const bool hi = (lane & 32) != 0;
#pragma unroll
              for (int i = 0; i < 8; ++i) { const float keep = hi ? lgt[j][8 + i] : lgt[j][i], send = hi ? lgt[j][i] : lgt[j][8 + i]; r8[i] = keep + __shfl_xor(send, 32); } }
            { const bool hi = (lane & 16) != 0;
#pragma unroll
              for (int i = 0; i < 4; ++i) { const float keep = hi ? r8[4 + i] : r8[i], send = hi ? r8[i] : r8[4 + i]; r4[i] = keep + __shfl_xor(send, 16); } }
            { const bool hi = (lane & 8) != 0;
#pragma unroll
              for (int i = 0; i < 2; ++i) { const float keep = hi ? r4[2 + i] : r4[i], send = hi ? r4[i] : r4[2 + i]; r2[i] = keep + __shfl_xor(send, 8); } }
            { const bool hi = (lane & 4) != 0; const float keep = hi ? r2[1] : r2[0], send = hi ? r2[0] : r2[1]; r1[j] = keep + __shfl_xor(send, 4); }
        }
        const int e = ((lane >> 5) & 1) * 8 + ((lane >> 4) & 1) * 4 + ((lane >> 3) & 1) * 2 + ((lane >> 2) & 1);
#pragma unroll
        for (int j = 0; j < 4; ++j) {
            float r = r1[j];
            r += __shfl_xor(r, 2); r += __shfl_xor(r, 1);
            float mx = r;
            mx = fmaxf(mx, __shfl_xor(mx, 4)); mx = fmaxf(mx, __shfl_xor(mx, 8)); mx = fmaxf(mx, __shfl_xor(mx, 16)); mx = fmaxf(mx, __shfl_xor(mx, 32));
            const float ex = __expf(r - mx);
            float den = ex;
            den += __shfl_xor(den, 4); den += __shfl_xor(den, 8); den += __shfl_xor(den, 16); den += __shfl_xor(den, 32);
            if ((lane & 3) == 0) p.AFF[(size_t)e * NTOK + r0 + j] = ex / den;
        }
    }
}

DEVI int block_sum_i(int v, LAS int* red, int tid) {
    const int lane = tid & 63, wave = tid >> 6;
    v = __builtin_popcountll(__ballot(v & 1)) + 2 * __builtin_popcountll(__ballot(v & 2)) + 4 * __builtin_popcountll(__ballot(v & 4)) + 8 * __builtin_popcountll(__ballot(v & 8));
    __syncthreads();
    if (lane == 0) red[wave] = v;
    __syncthreads();
    return (red[0] + red[1]) + (red[2] + red[3]) + (red[4] + red[5]) + (red[6] + red[7]);
}
DEVI int block_excl_scan_i(int v, LAS int* red, int tid, int& total) {
    const int lane = tid & 63, wave = tid >> 6;
    int inc = v;
#pragma unroll
    for (int o = 1; o < 64; o <<= 1) { const int t = __shfl_up(inc, o); if (lane >= o) inc += t; }
    __syncthreads();
    if (lane == 63) red[wave] = inc;
    __syncthreads();
    int base = 0, tot = 0;
#pragma unroll
    for (int w = 0; w < 8; ++w) { const int c = red[w]; if (w < wave) base += c; tot += c; }
    total = tot;
    return base + inc - v;
}
DEVI void phase_topk(const Params& p, lds_t* lds, int bid, int nblk, int tid) {
    LAS int* red = (LAS int*)lds;
    for (int it = bid; it < 32; it += nblk) {
        const int grp = it >> 4, e = it & 15;
        const float* a = p.AFF + (size_t)e * NTOK + grp * 4096 + tid * 8;
        const f32x4 a0 = *(const f32x4*)a, a1 = *(const f32x4*)(a + 4);
        unsigned key[8];
#pragma unroll
        for (int i = 0; i < 4; ++i) { key[i] = __float_as_uint(a0[i]); key[4 + i] = __float_as_uint(a1[i]); }
        unsigned thr = 0u;
        for (int bit = 30; bit >= 0; --bit) {
            const unsigned cand = thr | (1u << bit);
            int c = 0;
#pragma unroll
            for (int i = 0; i < 8; ++i) c += key[i] >= cand ? 1 : 0;
            if (block_sum_i(c, red, tid) >= 512) thr = cand;
        }
        int cgt = 0, ceq = 0;
#pragma unroll
        for (int i = 0; i < 8; ++i) { cgt += key[i] > thr ? 1 : 0; ceq += key[i] == thr ? 1 : 0; }
        int ngt, neq;
        (void)block_excl_scan_i(cgt, red, tid, ngt);
        int tie_rank = block_excl_scan_i(ceq, red, tid, neq);
        const int need = 512 - ngt;
        int sel[8], cs = 0;
#pragma unroll
        for (int i = 0; i < 8; ++i) {
            const bool eq = key[i] == thr;
            sel[i] = (key[i] > thr || (eq && tie_rank < need)) ? 1 : 0;
            tie_rank += eq ? 1 : 0; cs += sel[i];
        }
        int tot;
        int slot = block_excl_scan_i(cs, red, tid, tot);
#pragma unroll
        for (int i = 0; i < 8; ++i) {
            const int t = grp * 4096 + tid * 8 + i;
            int sl = -1;
            if (sel[i]) { sl = grp * 512 + slot; ++slot; p.IDX[e * 1024 + sl] = t; p.GATEV[e * 1024 + sl] = __uint_as_float(key[i]); }
            p.SEL[(size_t)t * 16 + e] = sl;
        }
    }
}

DEVI void phase_ln_b(const Params& p, int layer, int bid, int nblk, int tid) {
    const int lane = tid & 63, wave = tid >> 6;
    const float* lg = p.ln_gain + (layer * 2 + 1) * 1024; const float* lb = p.ln_bias + (layer * 2 + 1) * 1024;
    const bool last = (layer == DEPTH - 1);
    float* xo = last ? p.out + OUT_Y : p.X0;
    const int stride = nblk * 8;
    int row = bid * 8 + wave;
    int seln = -1; f32x4 xn[4];
    if (row < NTOK) {
        if (lane < 16) seln = p.SEL[(size_t)row * 16 + lane];
#pragma unroll
        for (int i = 0; i < 4; ++i) xn[i] = *(const f32x4*)(p.X1 + (size_t)row * D + lane * 4 + 256 * i);
    }
    for (; row < NTOK; row += stride) {
        const int selv = seln;
        f32x4 v[4];
#pragma unroll
        for (int i = 0; i < 4; ++i) v[i] = xn[i];
        unsigned long long mask = __ballot(selv >= 0);
        f32x4 y[4];
#pragma unroll
        for (int i = 0; i < 4; ++i) y[i] = (f32x4){0.f, 0.f, 0.f, 0.f};
        while (mask) {
            const int e0 = __builtin_ctzll(mask); mask &= mask - 1;
            const int s0 = __builtin_amdgcn_readlane(selv, e0);
            const bf16_t* y0 = p.YE + ((size_t)e0 * 1024 + s0) * 1024 + lane * 4;
            const bool two = mask != 0;
            int e1 = e0, s1 = s0;
            if (two) { e1 = __builtin_ctzll(mask); mask &= mask - 1; s1 = __builtin_amdgcn_readlane(selv, e1); }
            const bf16_t* y1 = p.YE + ((size_t)e1 * 1024 + s1) * 1024 + lane * 4;
            u32x2 w0[4], w1[4];
#pragma unroll
            for (int i = 0; i < 4; ++i) { w0[i] = *(const u32x2*)(y0 + 256 * i); w1[i] = *(const u32x2*)(y1 + 256 * i); }
            const float f1 = two ? 1.0f : 0.0f;
#pragma unroll
            for (int i = 0; i < 4; ++i) {
                y[i][0] += bf_lo(w0[i].x) + f1 * bf_lo(w1[i].x); y[i][1] += bf_hi(w0[i].x) + f1 * bf_hi(w1[i].x);
                y[i][2] += bf_lo(w0[i].y) + f1 * bf_lo(w1[i].y); y[i][3] += bf_hi(w0[i].y) + f1 * bf_hi(w1[i].y);
            }
        }
        if (row + stride < NTOK) {
            seln = -1;
            if (lane < 16) seln = p.SEL[(size_t)(row + stride) * 16 + lane];
#pragma unroll
            for (int i = 0; i < 4; ++i) xn[i] = *(const f32x4*)(p.X1 + (size_t)(row + stride) * D + lane * 4 + 256 * i);
        }
        const int cnd = cond_of_row(row);
        const float* gt = modp(p, layer, cnd, 5);
        float s = 0.f;
#pragma unroll
        for (int i = 0; i < 4; ++i) {
            const int col = lane * 4 + 256 * i;
            v[i] = v[i] * ALPHA_F + *(const f32x4*)(gt + col) * y[i];
            s += (v[i][0] + v[i][1]) + (v[i][2] + v[i][3]);
        }
        s = wave_sum(s);
        const float mu = s * (1.0f / 1024.0f);
        float q = 0.f;
#pragma unroll
        for (int i = 0; i < 4; ++i) { v[i] = v[i] - mu; q += (v[i][0] * v[i][0] + v[i][1] * v[i][1]) + (v[i][2] * v[i][2] + v[i][3] * v[i][3]); }
        q = wave_sum(q);
        const float rs = rsqrtf(q * (1.0f / 1024.0f) + EPS_F);
        const float* sh = modp(p, last ? layer : layer + 1, cnd, 0); const float* scl = modp(p, last ? layer : layer + 1, cnd, 1);
#pragma unroll
        for (int i = 0; i < 4; ++i) {
            const int col = lane * 4 + 256 * i;
            const f32x4 x = v[i] * rs * *(const f32x4*)(lg + col) + *(const f32x4*)(lb + col);
            *(f32x4*)(xo + (size_t)row * D + col) = x;
            if (!last) {
                const f32x4 h = x * (*(const f32x4*)(scl + col) + 1.0f) + *(const f32x4*)(sh + col);
                u32x2 o; o.x = pk_bf16(h[0], h[1]); o.y = pk_bf16(h[2], h[3]);
                *(u32x2*)(p.H + (size_t)row * D + col) = o;
            }
        }
    }
}

constexpr int GBM = 128;
constexpr int GBM2 = 256;
DEVI int xcd_first_unit(int bid, int nblk) { return (nblk & 7) ? bid : (bid & 7) * (nblk >> 3) + (bid >> 3); }
struct RowLin { const bf16_t* base; unsigned ld; DEVI unsigned offset(int r) const { return (unsigned)r * ld; } };
struct RowGather { const bf16_t* base; const int* idx; DEVI unsigned offset(int r) const { return (unsigned)(idx[r] & 8191) * 1024u; } };
struct RowClamp { const bf16_t* base; unsigned ld; int r0, rmax; DEVI unsigned offset(int r) const { int q = r0 + r; if (q > rmax) q = rmax; return (unsigned)q * ld; } };
struct RowKv { const bf16_t* base; int n0, isv; DEVI unsigned offset(int r) const { const int n = n0 + r; return (unsigned)((n >> 7) * 256 + isv * 128 + (n & 127)) * 256u; } };
struct GDesc { RowLin rf; WLin wl; unsigned ldw; int nk; };
struct WUp { const float* base; int kv; DEVI const float* operator()(int lane) const { return kv ? base + (lane >> 5) * 256 + ((4 * lane) & 127) : base + 4 * lane; } };
struct GDescUp { RowLin rf; WUp wl; unsigned ldw; };
struct WClamp { const float* base; int col0; DEVI const float* operator()(int lane) const { int c = col0 + 4 * lane; if (c > 700) c = 700; return base + c; } };
struct WLinP { const float* base; DEVI const float* operator()(int lane) const { const int r = 4 * lane; return base + 32 * (r >> 5) + 8 * ((r & 15) >> 2) + 4 * ((r >> 4) & 1); } };
struct WMoe { const float* gate; const float* up; size_t off; DEVI const float* operator()(int lane) const { const int r = 4 * lane, sub = r >> 5;
    const unsigned long long ga = (unsigned long long)gate, ua = (unsigned long long)up, mk = 0ull - (unsigned long long)(sub & 1);
    return (const float*)(ga ^ ((ga ^ ua) & mk)) + off + 32 * (sub >> 1) + 8 * ((r & 15) >> 2) + 4 * ((r >> 4) & 1); } };

DEVI void st_bf16x4(bf16_t* dst, f32x4 v) { u32x2 o; o.x = pk_bf16(v[0], v[1]); o.y = pk_bf16(v[2], v[3]); *(u32x2*)dst = o; }

template <int TM> DEVI void rope_tile(f32x4 (&acc)[TM][4], int row0  , int lane) {
    const int r16 = lane & 15, g = lane >> 4;
#pragma unroll
    for (int mb = 0; mb < TM; ++mb) {
        const int t = (row0 + mb * 16 + r16 - NPR) & 1023;
        const int prow = t >> 6, pcol = t & 63;
#pragma unroll
        for (int r = 0; r < 4; ++r) {
            const int f = 4 * g + r;
            const float c1 = rope_tab[(prow * 16 + f) * 2], s1 = rope_tab[(prow * 16 + f) * 2 + 1];
            const float c2 = rope_tab[(pcol * 16 + f) * 2], s2 = rope_tab[(pcol * 16 + f) * 2 + 1];
            const float a1 = acc[mb][0][r], a2 = acc[mb][1][r], b1 = acc[mb][2][r], b2 = acc[mb][3][r];
            acc[mb][0][r] = a1 * c1 - a2 * s1; acc[mb][1][r] = a2 * c1 + a1 * s1;
            acc[mb][2][r] = b1 * c2 - b2 * s2; acc[mb][3][r] = b2 * c2 + b1 * s2;
        }
        __builtin_amdgcn_sched_barrier(0);
    }
}

template <int BM> struct EpiZ { float* Z; int m0, n0;
    DEVI void operator()(const f32x4 (&acc)[BM / 32][4], int wr, int wc, int lane) const {
        const int r16 = lane & 15, g = lane >> 4;
#pragma unroll
        for (int mb = 0; mb < BM / 32; ++mb) { const int row = m0 + wr * (BM / 2) + mb * 16 + r16;
#pragma unroll
            for (int nb = 0; nb < 4; ++nb) { const int col = n0 + wc * 64 + nb * 16 + 4 * g; if (col < 704) *(f32x4*)(Z + (size_t)row * 704 + col) = acc[mb][nb]; } }
    } };
DEVI void phase_mla_win(const Params& p, int j, lds_t* lds, int bid, int nblk, int tid) {
    constexpr int MT = NTOK / GBM, NU = MT * 3;
    for (int u = xcd_first_unit(bid, nblk); u < NU; u += nblk) {
        const int mt = u % MT, nt = u / MT;
        RowLin rf{p.H + (size_t)mt * GBM * 1024, 1024u};
        RowClamp wf{p.WTI + (size_t)j * 704 * 1024, 1024u, nt * 256, 703};
        EpiZ<GBM> epi{p.Z, mt * GBM, nt * 256};
        gemm_unit_bb3<GBM, true>(lds, rf, wf, 16, epi, tid);
    }
}

template <int BM> struct EpiQ { bf16_t* Q; int m0, n0; float scale;
    DEVI void operator()(f32x4 (&acc)[BM / 32][4], int wr, int wc, int lane) const {
        const int r16 = lane & 15, g = lane >> 4;
        const int ncol0 = n0 + wc * 64;
        if (m0 >= NPR && (ncol0 % 192) == 128) rope_tile<BM / 32>(acc, m0 + wr * (BM / 2), lane);
#pragma unroll
        for (int mb = 0; mb < BM / 32; ++mb) { const int row = m0 + wr * (BM / 2) + mb * 16 + r16;
#pragma unroll
            for (int nb = 0; nb < 4; ++nb) st_bf16x4(Q + (size_t)row * 1536 + ncol0 + nb * 16 + 4 * g, acc[mb][nb] * scale); }
    } };
template <int BM> struct EpiKN { bf16_t* KN; int m0, n0;
    DEVI void operator()(const f32x4 (&acc)[BM / 32][4], int wr, int wc, int lane) const {
        const int r16 = lane & 15, g = lane >> 4;
#pragma unroll
        for (int mb = 0; mb < BM / 32; ++mb) { const int row = m0 + wr * (BM / 2) + mb * 16 + r16;
#pragma unroll
            for (int nb = 0; nb < 4; ++nb) st_bf16x4(KN + (size_t)row * 1024 + n0 + wc * 64 + nb * 16 + 4 * g, acc[mb][nb]); }
    } };
template <int BM> struct EpiVT { bf16_t* VTP; bf16_t* VTS; int m0, n0;
    DEVI void operator()(const f32x4 (&acc)[BM / 32][4], int wr, int wc, int lane) const {
        const int r16 = lane & 15, g = lane >> 4;
#pragma unroll
        for (int mb = 0; mb < BM / 32; ++mb) { const int row = m0 + wr * (BM / 2) + mb * 16 + 4 * g;
            bf16_t* dst;
            if (row < NPR) dst = VTP + (size_t)(row >> 8) * (8 * 128 * 256) + (row & 255);
            else if (row < NTOK) dst = VTS + (size_t)((row - NPR) >> 10) * (8 * 128 * 1280) + 256 + ((row - NPR) & 1023);
            else dst = VTS + (size_t)((row - NTOK) >> 8) * (8 * 128 * 1280) + ((row - NTOK) & 255);
            const size_t ldk = row < NPR ? 256 : 1280;
#pragma unroll
            for (int nb = 0; nb < 4; ++nb) { const int col = n0 + wc * 64 + nb * 16 + r16;
                st_bf16x4(dst + (size_t)col * ldk, acc[mb][nb]); } }
    } };
DEVI void phase_mla_up(const Params& p, int j, lds_t* lds, int bid, int nblk, int tid) {
    const float qscale = 0.07216878364870322f * LOG2E;
    constexpr int MTQ = NTOK / GBM2, MTK = NROWS_KV / GBM2, NQ = MTQ * 6, NK = MTK * 4, NU = NQ + 2 * NK;
    for (int u = xcd_first_unit(bid, nblk); u < NU; u += nblk) {
        if (u < NQ) {
            const int mt = u % MTQ, nt = u / MTQ;
            RowLin rf{p.CQ + (size_t)mt * GBM2 * 384, 384u};
            RowLin wf{p.WTQ + (size_t)j * 1536 * 384 + (size_t)nt * 256 * 384, 384u};
            EpiQ<GBM2> epi{p.Q, mt * GBM2, nt * 256, qscale};
            gemm_unit_bb<GBM2, true>(lds, rf, wf, 6, epi, tid);
        } else if (u < NQ + NK) {
            const int v = u - NQ, mt = v % MTK, nt = v / MTK;
            RowLin rf{p.CKV + (size_t)mt * GBM2 * 256, 256u};
            RowKv wf{p.WTKV + (size_t)j * 2048 * 256, nt * 256, 0};
            EpiKN<GBM2> epi{p.KN, mt * GBM2, nt * 256};
            gemm_unit_bb<GBM2, true>(lds, rf, wf, 4, epi, tid);
        } else {
            const int v = u - NQ - NK, mt = v % MTK, nt = v / MTK;
            RowLin rf{p.CKV + (size_t)mt * GBM2 * 256, 256u};
            RowKv wf{p.WTKV + (size_t)j * 2048 * 256, nt * 256, 1};
            EpiVT<GBM2> epi{p.VTP, p.VTS, mt * GBM2, nt * 256};
            gemm_unit_bb<GBM2, false>(lds, rf, wf, 4, epi, tid);
        }
    }
}

struct EpiRes { float* T; const float* X0; const float* mod; int layer, m0, n0;
    DEVI void operator()(const f32x4 (&acc)[4][4], int wr, int wc, int lane) const {
        const int r16 = lane & 15, g = lane >> 4;
        const int cnd = cond_of_row(m0);
        const float* gt = mod + ((size_t)(layer * 5 + cnd) * 6 + 2) * 1024;
#pragma unroll
        for (int nb = 0; nb < 4; ++nb) { const int col = n0 + wc * 64 + nb * 16 + 4 * g; const f32x4 gv = *(const f32x4*)(gt + col);
#pragma unroll
            for (int mb = 0; mb < 4; ++mb) { const size_t o = (size_t)(m0 + wr * 64 + mb * 16 + r16) * 1024 + col;
                *(f32x4*)(T + o) = *(const f32x4*)(X0 + o) * ALPHA_F + gv * acc[mb][nb]; } }
    } };
DEVI void phase_out_proj(const Params& p, int layer, const bf16_t* A, int K, const bf16_t* Wt, lds_t* lds, int bid, int nblk, int tid) {
    constexpr int NU = 64 * 4;
    for (int u = xcd_first_unit(bid, nblk); u < NU; u += nblk) {
        const int mt = u & 63, nt = u >> 6;
        RowLin rf{A + (size_t)mt * 128 * K, (unsigned)K};
        RowLin wf{Wt + (size_t)nt * 256 * K, (unsigned)K};
        const float* xres = layer ? p.X0 : (mt * 128 < NPR ? p.x_prompt : p.x_sample - (size_t)NPR * D);
        EpiRes epi{p.T, xres, p.mod, layer, mt * 128, nt * 256};
        gemm_unit_bb3<128, true>(lds, rf, wf, K / 64, epi, tid);
    }
}

template <int BM> struct EpiGU { bf16_t* U; int m0, n0;
    DEVI void operator()(const f32x4 (&acc)[BM / 32][4], int wr, int wc, int lane) const {
        const int r16 = lane & 15, g = lane >> 4;
#pragma unroll
        for (int mb = 0; mb < BM / 32; ++mb) { const int row = m0 + wr * (BM / 2) + mb * 16 + r16;
#pragma unroll
            for (int nb = 0; nb < 4; ++nb) { f32x4 v = acc[mb][nb];
                v[0] = gelu_tanh_f(v[0]); v[1] = gelu_tanh_f(v[1]); v[2] = gelu_tanh_f(v[2]); v[3] = gelu_tanh_f(v[3]);
                st_bf16x4(U + (size_t)row * 3072 + n0 + wc * 64 + nb * 16 + 4 * g, v); } }
    } };
template <int BM> struct EpiGV { bf16_t* GVT; float* GST; int m0, n0;
    DEVI void operator()(const f32x4 (&acc)[BM / 32][4], int wr, int wc, int lane) const {
        const int r16 = lane & 15, g = lane >> 4;
        const int part = (n0 >> 6) + wc;
#pragma unroll
        for (int mb = 0; mb < BM / 32; ++mb) { const int row = m0 + wr * (BM / 2) + mb * 16 + 4 * g;
            f32x4 s = (f32x4){0.f, 0.f, 0.f, 0.f}, q = s;
#pragma unroll
            for (int nb = 0; nb < 4; ++nb) { f32x4 v = acc[mb][nb];
                v[0] = gelu_tanh_f(v[0]); v[1] = gelu_tanh_f(v[1]); v[2] = gelu_tanh_f(v[2]); v[3] = gelu_tanh_f(v[3]);
                s += v; q += v * v;
                const int col = n0 + wc * 64 + nb * 16 + r16;
                st_bf16x4(GVT + ((size_t)(row >> 7) * 3072 + col) * 128 + (row & 127), v); }
#pragma unroll
            for (int o = 1; o < 16; o <<= 1) {
#pragma unroll
                for (int r = 0; r < 4; ++r) { s[r] += __shfl_xor(s[r], o); q[r] += __shfl_xor(q[r], o); } }
            if (r16 == 0) {
#pragma unroll
                for (int r = 0; r < 4; ++r) { f32x2 w; w.x = s[r]; w.y = q[r]; *(f32x2*)(GST + ((size_t)(row + r) * 48 + part) * 2) = w; } }
        }
    } };
DEVI void phase_gm_win(const Params& p, lds_t* lds, int bid, int nblk, int tid) {
    constexpr int MT = NTOK / GBM2, NU = MT * 24;
    for (int u = xcd_first_unit(bid, nblk); u < NU; u += nblk) {
        const int mt = u % MT, nt = u / MT;
        RowLin rf{p.H + (size_t)mt * GBM2 * 1024, 1024u};
        RowLin wf{p.WTGI + (size_t)nt * 256 * 1024, 1024u};
        if (nt < 12) { EpiGU<GBM2> epi{p.U, mt * GBM2, nt * 256}; gemm_unit_bb<GBM2, true>(lds, rf, wf, 16, epi, tid); }
        else { EpiGV<GBM2> epi{p.GVT, p.GST, mt * GBM2, (nt - 12) * 256}; gemm_unit_bb<GBM2, false>(lds, rf, wf, 16, epi, tid); }
    }
}

template <int BM> struct EpiSQ { bf16_t* Q; int m0, n0; float scale;
    DEVI void operator()(f32x4 (&acc)[BM / 32][4], int wr, int wc, int lane) const {
        const int r16 = lane & 15, g = lane >> 4;
        if (m0 >= NPR) rope_tile<BM / 32>(acc, m0 + wr * (BM / 2), lane);
#pragma unroll
        for (int mb = 0; mb < BM / 32; ++mb) { const int row = m0 + wr * (BM / 2) + mb * 16 + r16;
#pragma unroll
            for (int nb = 0; nb < 4; ++nb) st_bf16x4(Q + (size_t)row * 1024 + n0 + wc * 64 + nb * 16 + 4 * g, acc[mb][nb] * scale); }
    } };
template <int BM> struct EpiSK { bf16_t* SK; float* out; int m0;
    DEVI void operator()(f32x4 (&acc)[BM / 32][4], int wr, int wc, int lane) const {
        const int r16 = lane & 15, g = lane >> 4;
        if (m0 >= NPR) rope_tile<BM / 32>(acc, m0 + wr * (BM / 2), lane);
#pragma unroll
        for (int mb = 0; mb < BM / 32; ++mb) { const int row = m0 + wr * (BM / 2) + mb * 16 + r16;
#pragma unroll
            for (int nb = 0; nb < 4; ++nb) { const int col = wc * 64 + nb * 16 + 4 * g;
                if (m0 < NPR) *(f32x4*)(out + OUT_SK + (size_t)row * 256 + col) = acc[mb][nb];
                st_bf16x4(SK + (size_t)row * 256 + col, acc[mb][nb]); } }
    } };
template <int BM> struct EpiSV { bf16_t* SVTP; bf16_t* SVTS; float* out; int m0;
    DEVI void operator()(const f32x4 (&acc)[BM / 32][4], int wr, int wc, int lane) const {
        const int r16 = lane & 15, g = lane >> 4;
#pragma unroll
        for (int mb = 0; mb < BM / 32; ++mb) { const int row = m0 + wr * (BM / 2) + mb * 16 + 4 * g;
            bf16_t* dst; size_t ldk;
            if (row < NPR) { dst = SVTP + (size_t)(row >> 8) * (4 * 64 * 256) + (row & 255); ldk = 256; }
            else { dst = SVTS + (size_t)((row - NPR) >> 10) * (4 * 64 * 1280) + 256 + ((row - NPR) & 1023); ldk = 1280; }
#pragma unroll
            for (int nb = 0; nb < 4; ++nb) { const int col = wc * 64 + nb * 16 + r16;
                st_bf16x4(dst + (size_t)col * ldk, acc[mb][nb]);
                if (row < NPR) {
#pragma unroll
                    for (int r = 0; r < 4; ++r) out[OUT_SV + (size_t)(row + r) * 256 + col] = acc[mb][nb][r]; } } }
    } };
DEVI void phase_swa_qkv(const Params& p, lds_t* lds, int bid, int nblk, int tid) {
    constexpr int MT = NTOK / GBM2, NU = MT * 6;
    for (int u = xcd_first_unit(bid, nblk); u < NU; u += nblk) {
        const int mt = u % MT, nt = u / MT;
        RowLin rf{p.H + (size_t)mt * GBM2 * 1024, 1024u};
        RowLin wf{p.WTSQ + (size_t)nt * 256 * 1024, 1024u};
        if (nt < 4) { EpiSQ<GBM2> epi{p.Q, mt * GBM2, nt * 256, 0.125f * LOG2E}; gemm_unit_bb<GBM2, true>(lds, rf, wf, 16, epi, tid); }
        else if (nt == 4) { EpiSK<GBM2> epi{p.SK, p.out, mt * GBM2}; gemm_unit_bb<GBM2, true>(lds, rf, wf, 16, epi, tid); }
        else { EpiSV<GBM2> epi{p.SVTP, p.SVTS, p.out, mt * GBM2}; gemm_unit_bb<GBM2, false>(lds, rf, wf, 16, epi, tid); }
    }
}

template <int BM> struct EpiHid { bf16_t* HID; int e, mt, nt;
    DEVI void operator()(const f32x4 (&acc)[BM / 32][4], int wr, int wc, int lane) const {
        const int r16 = lane & 15, g = lane >> 4;
#pragma unroll
        for (int mb = 0; mb < BM / 32; ++mb) { const size_t row = (size_t)e * 1024 + mt * BM + wr * (BM / 2) + mb * 16 + r16;
            u32x4 w;
            { const f32x4 gv = acc[mb][0], uv = acc[mb][2]; w.x = pk_bf16(silu_f(gv[0]) * uv[0], silu_f(gv[1]) * uv[1]); w.y = pk_bf16(silu_f(gv[2]) * uv[2], silu_f(gv[3]) * uv[3]); }
            { const f32x4 gv = acc[mb][1], uv = acc[mb][3]; w.z = pk_bf16(silu_f(gv[0]) * uv[0], silu_f(gv[1]) * uv[1]); w.w = pk_bf16(silu_f(gv[2]) * uv[2], silu_f(gv[3]) * uv[3]); }
            *(u32x4*)(HID + row * 2048 + nt * 128 + wc * 32 + 8 * g) = w; }
    } };
template <int DBG = 0> DEVI void phase_moe_up(const Params& p, int layer, lds_t* lds, int bid, int nblk, int tid) {
    constexpr int MT = 1024 / GBM2, NU = 16 * MT * 16;
#define DEC_MU(u_, rf_, wf_) do { const int e_ = (u_) / (MT * 16), w_ = (u_) % (MT * 16), mt_ = w_ % MT, nt_ = w_ / MT; \
        rf_ = RowGather{p.H2, p.IDX + e_ * 1024 + mt_ * GBM2}; wf_ = WMoe{p.moe_w_gate, p.moe_w_up, ((size_t)layer * 16 + e_) * 1024 * 2048 + nt_ * 128}; } while (0)
    int u = xcd_first_unit(bid, nblk);
    RowGather rf, rfn; WMoe wf, wfn;
    for (; u < NU; u += nblk) {
        const int e = u / (MT * 16), w = u % (MT * 16), mt = w % MT, nt = w / MT;
        DEC_MU(u, rf, wf);
        EpiHid<GBM2> epi{p.HID, e, mt, nt};
        gemm_unit<GBM2, true>(lds, rf, wf, 2048u, 16, epi, tid);
    }
#undef DEC_MU
}
template <int BM> struct EpiYe { bf16_t* YE; const float* GATEV; int e, mt, nt;
    DEVI void operator()(const f32x4 (&acc)[BM / 32][4], int wr, int wc, int lane) const {
        const int r16 = lane & 15, g = lane >> 4;
#pragma unroll
        for (int mb = 0; mb < BM / 32; ++mb) { const size_t row = (size_t)e * 1024 + mt * BM + wr * (BM / 2) + mb * 16 + r16;
            const float gt = GATEV[row];
#pragma unroll
            for (int np = 0; np < 2; ++np) {
                const f32x4 a = acc[mb][2 * np] * gt, b = acc[mb][2 * np + 1] * gt;
                u32x4 w; w.x = pk_bf16(a[0], a[1]); w.y = pk_bf16(a[2], a[3]); w.z = pk_bf16(b[0], b[1]); w.w = pk_bf16(b[2], b[3]);
                *(u32x4*)(YE + row * 1024 + nt * 256 + wc * 64 + 32 * np + 8 * g) = w; } }
    } };
DEVI void phase_moe_down(const Params& p, int layer, lds_t* lds, int bid, int nblk, int tid) {
    constexpr int MT = 1024 / GBM2, NU = 16 * MT * 4;
#define DEC_MD(u_, d_) do { const int e_ = (u_) / (MT * 4), w_ = (u_) % (MT * 4), mt_ = w_ % MT, nt_ = w_ / MT; \
        d_.rf = RowLin{p.HID + ((size_t)e_ * 1024 + mt_ * GBM2) * 2048, 2048u}; d_.wl = WLin{p.moe_w_down + ((size_t)layer * 16 + e_) * 2048 * 1024 + nt_ * 256}; d_.ldw = 1024u; d_.nk = 32; } while (0)
    int u = xcd_first_unit(bid, nblk);
    GDesc d, dn;
    for (; u < NU; u += nblk) {
        const int e = u / (MT * 4), w = u % (MT * 4), mt = w % MT, nt = w / MT;
        DEC_MD(u, d);
        EpiYe<GBM2> epi{p.YE, p.GATEV, e, mt, nt};
        gemm_unit<GBM2, true>(lds, d.rf, WLinP{d.wl.base}, d.ldw, 32, epi, tid);
    }
#undef DEC_MD
}

template <int DK, int DV> struct AttnCfg {
    static constexpr int CPK = DK / 8;
    static constexpr int KT_BYTES = 64 * DK * 2;
    static constexpr int VT_BYTES = DV * 128;
    static constexpr int STAGE = KT_BYTES + VT_BYTES;
    static constexpr int NKC = 64 * CPK / NTHREADS;
    static constexpr int NVC = DV * 8 / NTHREADS;
};
DEVI int kswz(int key) { return ((key >> 1) & 1) | (((key >> 3) & 3) << 1); }

struct AttnSeg { int n_ctx, ctx_krow0, ctx_vcol0, n_loc, loc_krow0, loc_vcol0, loc_kpos0; };

template <int DK, int DV, bool WINDOW, class KSrc>
DEVI void attn_unit(lds_t* lds, const bf16_t* Qp, int ldq, const KSrc& ks, const bf16_t* vt, int ldv, const AttnSeg sg, int qpos0,
                    float sink, bool has_sink, bf16_t* Op, int ldo, int tid) {
    typedef AttnCfg<DK, DV> C;
    const int lane = tid & 63, wave = tid >> 6, r16 = lane & 15, g = lane >> 4;
    const int ntile = sg.n_ctx + sg.n_loc;
    bf16x8 qf[DK / 32];
    {
        const bf16_t* qr = Qp + (size_t)(wave * 16 + r16) * ldq + 8 * g;
#pragma unroll
        for (int s = 0; s < DK / 32; ++s) qf[s] = *(const bf16x8*)(qr + 32 * s);
    }
    u32x4 kreg[C::NKC], vreg[C::NVC];
#define TILE_LOAD(jj) do { const int j_ = (jj); int krow, vcol; \
        if (j_ < sg.n_ctx) { krow = sg.ctx_krow0 + 64 * j_; vcol = sg.ctx_vcol0 + 64 * j_; } \
        else { krow = sg.loc_krow0 + 64 * (j_ - sg.n_ctx); vcol = sg.loc_vcol0 + 64 * (j_ - sg.n_ctx); } \
        _Pragma("unroll") for (int i = 0; i < C::NKC; ++i) { const int c = tid + NTHREADS * i, key = c / C::CPK, ch = c % C::CPK; kreg[i] = *(const u32x4*)ks(krow + key, ch); } \
        _Pragma("unroll") for (int i = 0; i < C::NVC; ++i) { const int c = tid + NTHREADS * i, dv = c >> 3, ch = c & 7; vreg[i] = *(const u32x4*)(vt + (size_t)dv * ldv + vcol + ch * 8); } } while (0)
#define TILE_STORE(stp) do { lds_t* st_ = (stp); \
        _Pragma("unroll") for (int i = 0; i < C::NKC; ++i) { const int c = tid + NTHREADS * i, key = c / C::CPK, ch = c % C::CPK; lds_st128(st_ + key * (DK * 2) + ((ch ^ kswz(key)) << 4), kreg[i]); } \
        _Pragma("unroll") for (int i = 0; i < C::NVC; ++i) { const int c = tid + NTHREADS * i, dv = c >> 3, ch = c & 7; lds_st128(st_ + C::KT_BYTES + img_off(dv, ch), vreg[i]); } } while (0)
    f32x4 o[DV / 16];
#pragma unroll
    for (int i = 0; i < DV / 16; ++i) o[i] = (f32x4){0.f, 0.f, 0.f, 0.f};
    float m = has_sink ? sink : -1.0e30f;
    float l = (has_sink && g == 0) ? 1.0f : 0.0f;
    const int qpos = qpos0 + wave * 16 + r16;
    const int kbyte = (8 * (r16 >> 2) + (r16 & 3)) * (DK * 2);
    const int ksw0 = ((r16 >> 1) & 1) | ((r16 >> 2) << 1);
    const int ke0 = (g ^ ksw0) << 4, ke1 = ((4 + g) ^ ksw0) << 4;
    const int vc0 = g ^ ((r16 >> 1) & 7);

    TILE_LOAD(0);
    __syncthreads();
    TILE_STORE(lds);
    if (ntile > 1) TILE_LOAD(1);
    for (int j = 0; j < ntile; ++j) {
        __syncthreads();
        lds_t* cur = lds + (j & 1) * C::STAGE;
        if (j + 1 < ntile) { TILE_STORE(lds + ((j + 1) & 1) * C::STAGE); if (j + 2 < ntile) TILE_LOAD(j + 2); }
        const bool masked = WINDOW && (j >= sg.n_ctx);
        const int kpos0 = sg.loc_kpos0 + 64 * (j - sg.n_ctx);
        if (masked) {
            const int qlo = qpos0 + wave * 16;
            if (kpos0 > qlo + 15 + 128 || kpos0 + 63 < qlo - 128) continue;
        }
        f32x4 s[4];
        {
            lds_t* kb0 = cur + kbyte + ke0;
            lds_t* kb1 = cur + kbyte + ke1;
#pragma unroll
            for (int grp = 0; grp < 2; ++grp)
#pragma unroll
                for (int b = 0; b < 2; ++b) {
                    f32x4 a = (f32x4){0.f, 0.f, 0.f, 0.f};
#pragma unroll
                    for (int st = 0; st < DK / 32; ++st) {
                        const bf16x8 kf = lds_ld128(((st & 1) ? kb1 : kb0) + (32 * grp + 4 * b) * (DK * 2) + (st >> 1) * 128);
                        a = __builtin_amdgcn_mfma_f32_16x16x32_bf16(kf, qf[st], a, 0, 0, 0);
                    }
                    s[grp * 2 + b] = a;
                }
        }
        if (masked) {
#pragma unroll
            for (int grp = 0; grp < 2; ++grp)
#pragma unroll
                for (int b = 0; b < 2; ++b)
#pragma unroll
                    for (int r = 0; r < 4; ++r) {
                        const int kp = kpos0 + 32 * grp + 8 * g + 4 * b + r;
                        const int d = qpos - kp;
                        if (d > 128 || d < -128) s[grp * 2 + b][r] = -1.0e30f;
                    }
        }
        float mx = fmaxf(fmaxf(fmaxf(s[0][0], s[0][1]), fmaxf(s[0][2], s[0][3])), fmaxf(fmaxf(s[1][0], s[1][1]), fmaxf(s[1][2], s[1][3])));
        mx = fmaxf(mx, fmaxf(fmaxf(fmaxf(s[2][0], s[2][1]), fmaxf(s[2][2], s[2][3])), fmaxf(fmaxf(s[3][0], s[3][1]), fmaxf(s[3][2], s[3][3]))));
        mx = fmaxf(mx, __shfl_xor(mx, 16)); mx = fmaxf(mx, __shfl_xor(mx, 32));
        const float mn = fmaxf(m, mx);
        const float alpha = fexp2(m - mn);
        m = mn;
        float ps = 0.f;
#pragma unroll
        for (int i = 0; i < 4; ++i)
#pragma unroll
            for (int r = 0; r < 4; ++r) { const float pv = fexp2(s[i][r] - mn); s[i][r] = pv; ps += pv; }
        l = l * alpha + ps;
#pragma unroll
        for (int i = 0; i < DV / 16; ++i) o[i] = o[i] * alpha;
#pragma unroll
        for (int grp = 0; grp < 2; ++grp) {
            u32x4 pw;
            pw.x = pk_bf16(s[grp * 2][0], s[grp * 2][1]); pw.y = pk_bf16(s[grp * 2][2], s[grp * 2][3]);
            pw.z = pk_bf16(s[grp * 2 + 1][0], s[grp * 2 + 1][1]); pw.w = pk_bf16(s[grp * 2 + 1][2], s[grp * 2 + 1][3]);
            bf16x8 pf; __builtin_memcpy(&pf, &pw, 16);
#pragma unroll
            for (int dvb = 0; dvb < DV / 16; ++dvb) {
                const bf16x8 vf = lds_ld128(cur + C::KT_BYTES + r16 * 128 + dvb * 2048 + (((vc0 ^ (4 * grp)) ^ (dvb & 1)) << 4));
                o[dvb] = __builtin_amdgcn_mfma_f32_16x16x32_bf16(vf, pf, o[dvb], 0, 0, 0);
            }
        }
    }
    l += __shfl_xor(l, 16); l += __shfl_xor(l, 32);
    const float inv = frcp(l);
    bf16_t* orow = Op + (size_t)(wave * 16 + r16) * ldo + 4 * g;
#pragma unroll
    for (int dvb = 0; dvb < DV / 16; ++dvb) st_bf16x4(orow + dvb * 16, o[dvb] * inv);
}

struct KSrcMla { const bf16_t* KN; const bf16_t* KPE; int h;
    DEVI const bf16_t* operator()(int krow, int ch) const { return ch < 16 ? KN + (size_t)krow * 1024 + h * 128 + ch * 8 : KPE + (size_t)krow * 64 + (ch - 16) * 8; } };
struct KSrcSwa { const bf16_t* SK; int kvh;
    DEVI const bf16_t* operator()(int krow, int ch) const { return SK + (size_t)krow * 256 + kvh * 64 + ch * 8; } };

DEVI void phase_mla_attn(const Params& p, lds_t* lds, int bid, int nblk, int tid) {
    for (int u = xcd_first_unit(bid, nblk); u < 512; u += nblk) {
        if (u < 256) {
            const int b = u >> 6, h = (u >> 3) & 7, qt = u & 7;
            const int qrow0 = NPR + b * 1024 + qt * 128;
            KSrcMla ks{p.KN, p.KPE, h};
            AttnSeg sg{4, NTOK + b * 256, 0, 16, NPR + b * 1024, 256, 0};
            attn_unit<192, 128, false>(lds, p.Q + (size_t)qrow0 * 1536 + h * 192, 1536, ks, p.VTS + (size_t)(b * 8 + h) * 128 * 1280, 1280, sg, 0, 0.f, false,
                                       p.O + (size_t)qrow0 * 1024 + h * 128, 1024, tid);
        } else {
            const int v = u - 256, b = v >> 4, h = (v >> 1) & 7, qt = v & 1;
            const int qrow0 = b * 256 + qt * 128;
            KSrcMla ks{p.KN, p.KPE, h};
            AttnSeg sg{0, 0, 0, 4, b * 256, 0, 0};
            attn_unit<192, 128, false>(lds, p.Q + (size_t)qrow0 * 1536 + h * 192, 1536, ks, p.VTP + (size_t)(b * 8 + h) * 128 * 256, 256, sg, 0, 0.f, false,
                                       p.O + (size_t)qrow0 * 1024 + h * 128, 1024, tid);
        }
    }
}
DEVI void phase_swa_attn(const Params& p, lds_t* lds, int bid, int nblk, int tid) {
    for (int u = xcd_first_unit(bid, nblk); u < 1024; u += nblk) {
        const int w = u >> 8, idx = ((u >> 9) << 8) | (u & 255);
        if ((w & 1) == 0) {
            const int b = idx >> 7, hq = (idx >> 3) & 15, qt = idx & 7, kvh = hq >> 2;
            const int qs = qt * 128, qrow0 = NPR + b * 1024 + qs;
            const int lo = qs >= 128 ? qs - 128 : 0, hi = qs + 256 <= 1024 ? qs + 256 : 1024;
            KSrcSwa ks{p.SK, kvh};
            AttnSeg sg{4, NTOK + b * 256, 0, (hi - lo) >> 6, NPR + b * 1024 + lo, 256 + lo, lo};
            attn_unit<64, 64, true>(lds, p.Q + (size_t)qrow0 * 1024 + hq * 64, 1024, ks, p.SVTS + (size_t)(b * 4 + kvh) * 64 * 1280, 1280, sg, qs,
                                    p.swa_sink[hq] * LOG2E, true, p.O + (size_t)qrow0 * 1024 + hq * 64, 1024, tid);
        } else {
            const int b = idx >> 5, hq = (idx >> 1) & 15, qt = idx & 1, kvh = hq >> 2;
            const int qrow0 = b * 256 + qt * 128;
            KSrcSwa ks{p.SK, kvh};
            AttnSeg sg{0, 0, 0, 4, b * 256, 0, 0};
            attn_unit<64, 64, false>(lds, p.Q + (size_t)qrow0 * 1024 + hq * 64, 1024, ks, p.SVTP + (size_t)(b * 4 + kvh) * 64 * 256, 256, sg, 0,
                                     p.swa_sink[hq] * LOG2E, true, p.O + (size_t)qrow0 * 1024 + hq * 64, 1024, tid);
        }
    }
}

DEVI void phase_gm_spatial(const Params& p, lds_t* lds, int bid, int nblk, int tid) {
    const int lane = tid & 63, wave = tid >> 6, r16 = lane & 15, g = lane >> 4, wr = wave >> 2, wc = wave & 3;
    lds_t* aimg = lds;
    lds_t* vimg = lds + 32768;
    LAS float* mean = (LAS float*)(lds + 65536);
    LAS float* rstd = mean + 128;
    LAS float* biasp = rstd + 128;
    LAS float* bpart = biasp + 128;
    for (int u = xcd_first_unit(bid, nblk); u < 512; u += nblk) {
        const int chunk = u >> 3, grp = u & 7;
        __syncthreads();
        if (tid < 128) {
            const float* gs = p.GST + (size_t)(chunk * 128 + tid) * 96;
            float s = 0.f, q = 0.f;
            for (int i = 0; i < 48; ++i) { s += gs[2 * i]; q += gs[2 * i + 1]; }
            const float mu = s * (1.0f / 3072.0f);
            const float var = q * (1.0f / 3072.0f) - mu * mu;
            mean[tid] = mu; rstd[tid] = rsqrtf(fmaxf(var, 0.f) + EPS_F);
        }
        __syncthreads();
        {
            const int n = tid >> 2, mq = tid & 3;
            const float* ws = p.gm_w_s + ((size_t)grp * 128 + n) * 128 + mq * 32;
            float bp = 0.f;
#pragma unroll
            for (int c4 = 0; c4 < 4; ++c4) {
                const f32x4 w0 = *(const f32x4*)(ws + c4 * 8), w1 = *(const f32x4*)(ws + c4 * 8 + 4);
                const int m0 = mq * 32 + c4 * 8;
                float a[8];
#pragma unroll
                for (int i = 0; i < 4; ++i) { a[i] = w0[i] * rstd[m0 + i]; a[4 + i] = w1[i] * rstd[m0 + 4 + i]; }
                u32x4 v; v.x = pk_bf16(a[0], a[1]); v.y = pk_bf16(a[2], a[3]); v.z = pk_bf16(a[4], a[5]); v.w = pk_bf16(a[6], a[7]);
#pragma unroll
                for (int i = 0; i < 4; ++i) { const unsigned wd = i == 0 ? v.x : i == 1 ? v.y : i == 2 ? v.z : v.w; bp += bf_lo(wd) * mean[m0 + 2 * i] + bf_hi(wd) * mean[m0 + 2 * i + 1]; }
                const int kc = m0 >> 3;
                lds_st128(aimg + (kc >> 3) * 16384 + img_off(n, kc & 7), v);
            }
            bpart[mq * 128 + n] = bp;
        }
        __syncthreads();
        if (tid < 128) biasp[tid] = bpart[tid] + bpart[128 + tid] + bpart[256 + tid] + bpart[384 + tid];
        for (int cs = 0; cs < 3; ++cs) {
            __syncthreads();
            {
                const bf16_t* src = p.GVT + ((size_t)chunk * 3072 + grp * 384 + cs * 128) * 128;
#pragma unroll
                for (int i = 0; i < 4; ++i) { const int c = tid + NTHREADS * i, row = c >> 4, kc = c & 15;
                    const u32x4 v = *(const u32x4*)(src + (size_t)row * 128 + kc * 8);
                    lds_st128(vimg + (kc >> 3) * 16384 + img_off(row, kc & 7), v); }
            }
            __syncthreads();
            f32x4 acc[4][2];
#pragma unroll
            for (int i = 0; i < 4; ++i) { acc[i][0] = (f32x4){0.f, 0.f, 0.f, 0.f}; acc[i][1] = acc[i][0]; }
#pragma unroll
            for (int kh = 0; kh < 2; ++kh)
#pragma unroll
                for (int s = 0; s < 2; ++s) {
                    bf16x8 af[4], vf[2];
#pragma unroll
                    for (int mb = 0; mb < 4; ++mb) af[mb] = lds_ld128(aimg + kh * 16384 + img_off(wr * 64 + mb * 16 + r16, 4 * s + g));
#pragma unroll
                    for (int nb = 0; nb < 2; ++nb) vf[nb] = lds_ld128(vimg + kh * 16384 + img_off(wc * 32 + nb * 16 + r16, 4 * s + g));
#pragma unroll
                    for (int mb = 0; mb < 4; ++mb)
#pragma unroll
                        for (int nb = 0; nb < 2; ++nb) acc[mb][nb] = __builtin_amdgcn_mfma_f32_16x16x32_bf16(vf[nb], af[mb], acc[mb][nb], 0, 0, 0);
                }
#pragma unroll
            for (int mb = 0; mb < 4; ++mb) {
                const int n = wr * 64 + mb * 16 + r16;
                const float bp = biasp[n], bs = p.gm_b_s[grp * 128 + n];
                const size_t row = (size_t)chunk * 128 + n;
#pragma unroll
                for (int nb = 0; nb < 2; ++nb) {
                    const int col = grp * 384 + cs * 128 + wc * 32 + nb * 16 + 4 * g;
                    const f32x4 gn = *(const f32x4*)(p.gm_v_gain + col);
                    const u32x2 uw = *(const u32x2*)(p.U + row * 3072 + col);
                    f32x4 t;
                    t[0] = bf_lo(uw.x) * (gn[0] * (acc[mb][nb][0] - bp) + bs);
                    t[1] = bf_hi(uw.x) * (gn[1] * (acc[mb][nb][1] - bp) + bs);
                    t[2] = bf_lo(uw.y) * (gn[2] * (acc[mb][nb][2] - bp) + bs);
                    t[3] = bf_hi(uw.y) * (gn[3] * (acc[mb][nb][3] - bp) + bs);
                    st_bf16x4(p.TT + row * 3072 + col, t);
                }
            }
        }
    }
}

constexpr int N_PHASES = 2 + 10 * DEPTH;
__global__ void __launch_bounds__(NTHREADS, 2) fwd_kernel(Params p_kernarg) {
    extern __shared__ __attribute__((aligned(16))) unsigned char smem[];
    lds_t* lds = (lds_t*)smem;
    const int tid0 = threadIdx.x, bid0 = blockIdx.x, nblk0 = gridDim.x;
    const int wave0 = __builtin_amdgcn_readfirstlane(tid0 >> 6);
    volatile LAS unsigned* misc = (volatile LAS unsigned*)(lds + LDS_MAIN);
    if (tid0 == 0) { misc[0] = 0u; misc[1] = 0u; misc[2] = 0u; misc[3] = 0u; }
    __syncthreads();
    typedef const __attribute__((address_space(4))) Params* kparams_t;
    kparams_t pp = (kparams_t)__builtin_amdgcn_kernarg_segment_ptr();
    const int lo = (int)pp->ph_lo, hi = (int)pp->ph_hi;
    XcdBarrier bar; bar.bar = pp->bar; bar.x = 0; bar.st = misc;
    if (hi - lo > 1) bar = xcd_barrier_post(bar.bar, misc);
#define IN(k) (lo <= (k) && (k) < hi)
#ifndef REP_MASK
#define REP_MASK 0
#endif
#define RUN(k, knext, cls, body) do { if (IN(k)) { { asm volatile("" : "+s"(pp)); Params p; __builtin_memcpy(&p, pp, sizeof(Params)); \
        int tid = wave0 * 64 + (int)__builtin_amdgcn_mbcnt_hi(~0u, __builtin_amdgcn_mbcnt_lo(~0u, 0u)), bid = bid0, nblk = nblk0; asm volatile("" : "+v"(tid)); asm volatile("" : "+s"(bid), "+s"(nblk)); body; \
        if ((REP_MASK) & (cls)) { asm volatile("" : "+v"(tid)); body; } } if (IN(knext)) { xcd_barrier(bar); if ((REP_MASK) & 8192) xcd_barrier(bar); } } } while (0)
    RUN(0, 1, 64, { phase_modulation(p, lds, bid, nblk, tid); phase_wconv(p, lds, bid, nblk, tid); });
    RUN(1, 2, 512, phase_prep(p, bid, nblk, tid));
#pragma unroll 1
    for (int li = 0; li < DEPTH; ++li) {
        const int kind = li % 3, j = li / 3, base = 2 + 10 * li;
        if (kind == 0) {
            RUN(base + 0, base + 1, 32, phase_mla_win(p, j, lds, bid, nblk, tid));
            RUN(base + 1, base + 2, 1024, phase_mla_norm(p, j, bid, nblk, tid));
            RUN(base + 2, base + 3, 32, phase_mla_up(p, j, lds, bid, nblk, tid));
            RUN(base + 3, base + 4, 16, phase_mla_attn(p, lds, bid, nblk, tid));
            RUN(base + 4, base + 5, 8, phase_out_proj(p, li, p.O, 1024, p.WTO + (size_t)j * 1024 * 1024, lds, bid, nblk, tid));
        } else if (kind == 1) {
            RUN(base + 0, base + 1, 4, phase_gm_win(p, lds, bid, nblk, tid));
            RUN(base + 1, base + 2, 128, phase_gm_spatial(p, lds, bid, nblk, tid));
            RUN(base + 2, base + 5, 8, phase_out_proj(p, li, p.TT, 3072, p.WTGO, lds, bid, nblk, tid));
        } else {
            RUN(base + 0, base + 1, 32, phase_swa_qkv(p, lds, bid, nblk, tid));
            RUN(base + 1, base + 2, 16, phase_swa_attn(p, lds, bid, nblk, tid));
            RUN(base + 2, base + 5, 8, phase_out_proj(p, li, p.O, 1024, p.WTSO, lds, bid, nblk, tid));
        }
        RUN(base + 5, base + 6, 2048, phase_ln_a(p, li, lds, bid, nblk, tid));
        RUN(base + 6, base + 7, 256, phase_topk(p, lds, bid, nblk, tid));
        RUN(base + 7, base + 8, 1, phase_moe_up(p, li, lds, bid, nblk, tid));
        RUN(base + 8, base + 9, 2, phase_moe_down(p, li, lds, bid, nblk, tid));
        RUN(base + 9, base + 10, 4096, phase_ln_b(p, li, bid, nblk, tid));
    }
#undef IN
#undef RUN
}

#ifdef PROBE_V
__global__ void __launch_bounds__(NTHREADS, 2) probe_kernel(Params p) {
    extern __shared__ __attribute__((aligned(16))) unsigned char smem[];
    lds_t* lds = (lds_t*)smem;
    const int tid = threadIdx.x, bid = blockIdx.x, nblk = gridDim.x;
#if PROBE_V < 1000
    if (PROBE_V == 1) phase_mla_attn(p, lds, bid, nblk, tid);
    else if (PROBE_V == 2) phase_swa_attn(p, lds, bid, nblk, tid);
    else if (PROBE_V == 3) phase_gm_spatial(p, lds, bid, nblk, tid);
    else if (PROBE_V == 4) phase_ln_a(p, 3, lds, bid, nblk, tid);
    else if (PROBE_V == 5) phase_mla_up(p, 1, lds, bid, nblk, tid);
    else phase_moe_up<0>(p, 0, lds, bid, nblk, tid);
#else
    const int lane = tid & 63, wave = tid >> 6;
    const int u0 = xcd_first_unit(bid, nblk);
    f32x4 acc = (f32x4){0.f, 0.f, 0.f, 0.f};
    for (int u = u0; u < 1024; u += nblk) {
        const int e = u >> 6, w = u & 63, nt = w >> 2;
        const float* wp = p.moe_w_gate + (size_t)e * 1024 * 2048 + nt * 128 + 4 * lane + (size_t)(8 * wave) * 2048;
        const bf16_t* xp = p.H2 + (size_t)((u * 37 + wave * 8 + (lane >> 3)) & 8191) * 1024 + (lane & 7) * 8;
#pragma unroll 2
        for (int kt = 0; kt < 16; ++kt) {
            const float* q = wp + (size_t)((PROBE_V & 1) ? 0 : ((PROBE_V & 4) ? ((kt + (w & 3) * ((PROBE_V >> 4) & 7)) & 15) : ((PROBE_V & 8) ? (kt & 3) : kt))) * 64 * 2048;
#pragma unroll
            for (int i = 0; i < 8; ++i) acc += *(const f32x4*)(q + (size_t)i * 2048);
            if (PROBE_V & 2) {
#pragma unroll
                for (int j = 0; j < 4; ++j) { const u32x4 x = *(const u32x4*)(xp + (size_t)j * 64 * 1024 + kt * 64); acc[0] += __uint_as_float(x.x & 0x3f800000u); }
            }
        }
    }
    if (acc[0] + acc[1] + acc[2] + acc[3] == 12345.678f) p.GST[tid] = acc[0];
#endif
}
#endif
extern "C" void kernel_launch(void* const* d_in, const int* in_sizes, int n_in, void* d_out, int out_size, void* d_ws, size_t ws_size, hipStream_t stream) {
    static int grid = 0;
    if (grid == 0) {
        int dev = 0, cus = 0, per_cu = 0;
        if (hipGetDevice(&dev) != hipSuccess || hipDeviceGetAttribute(&cus, hipDeviceAttributeMultiprocessorCount, dev) != hipSuccess) { fprintf(stderr, "kernel_launch: device query failed\n"); grid = -1; return; }
        if (hipFuncSetAttribute((const void*)fwd_kernel, hipFuncAttributeMaxDynamicSharedMemorySize, LDS_BYTES) != hipSuccess) { fprintf(stderr, "kernel_launch: hipFuncSetAttribute failed\n"); grid = -1; return; }
        if (hipOccupancyMaxActiveBlocksPerMultiprocessor(&per_cu, (const void*)fwd_kernel, NTHREADS, LDS_BYTES) != hipSuccess || per_cu < 1) {
            fprintf(stderr, "kernel_launch: occupancy query reports %d blocks per CU\n", per_cu); (void)hipGetLastError(); per_cu = 1; }
        grid = cus;
    }
    if (grid < 0) return;
    unsigned char* ws = (unsigned char*)d_ws;
    size_t off = 0;
    auto take = [&](size_t bytes) { unsigned char* r = ws + off; off += (bytes + 255) & ~(size_t)255; return r; };
    Params p{};
    const float* const* in = (const float* const*)d_in;
    p.x_prompt = in[0]; p.x_sample = in[1]; p.cache_ckv = in[2]; p.cache_kpe = in[3]; p.cache_k = in[4]; p.cache_v = in[5]; p.c = in[6]; p.c_ctx = in[7];
    p.mod_w = in[8]; p.mod_b = in[9]; p.ln_gain = in[10]; p.ln_bias = in[11];
    p.mla_w_in = in[12]; p.mla_q_gain = in[13]; p.mla_kv_gain = in[14]; p.mla_w_q_up = in[15]; p.mla_w_kv_up = in[16]; p.mla_w_out = in[17];
    p.gm_w_in = in[18]; p.gm_v_gain = in[19]; p.gm_w_s = in[20]; p.gm_b_s = in[21]; p.gm_w_out = in[22];
    p.swa_w_qkv = in[23]; p.swa_sink = in[24]; p.swa_w_out = in[25];
    p.moe_router = in[26]; p.moe_w_gate = in[27]; p.moe_w_up = in[28]; p.moe_w_down = in[29];
    p.out = (float*)d_out;
    p.bar = (unsigned*)take(16384);
    p.mod = (float*)take((size_t)DEPTH * 5 * 6144 * 4);
    p.X0 = (float*)take((size_t)NTOK * D * 4); p.X1 = (float*)take((size_t)NTOK * D * 4); p.T = (float*)take((size_t)NTOK * D * 4);
    p.Z = (float*)take((size_t)NTOK * 704 * 4); p.GST = (float*)take((size_t)NTOK * 96 * 4); p.AFF = (float*)take((size_t)NTOK * 16 * 4); p.GATEV = (float*)take(16 * 1024 * 4);
    p.H = (bf16_t*)take((size_t)NTOK * D * 2); p.H2 = (bf16_t*)take((size_t)NTOK * D * 2);
    p.CQ = (bf16_t*)take((size_t)NTOK * 384 * 2); p.CKV = (bf16_t*)take((size_t)NROWS_KV * 256 * 2); p.KPE = (bf16_t*)take((size_t)NROWS_KV * 64 * 2);
    p.Q = (bf16_t*)take((size_t)NTOK * 1536 * 2); p.KN = (bf16_t*)take((size_t)NROWS_KV * 1024 * 2);
    p.VTP = (bf16_t*)take((size_t)16 * 8 * 128 * 256 * 2); p.VTS = (bf16_t*)take((size_t)4 * 8 * 128 * 1280 * 2);
    p.O = (bf16_t*)take((size_t)NTOK * D * 2);
    p.U = (bf16_t*)take((size_t)NTOK * 3072 * 2); p.GVT = (bf16_t*)take((size_t)NTOK * 3072 * 2); p.TT = (bf16_t*)take((size_t)NTOK * 3072 * 2);
    p.SK = (bf16_t*)take((size_t)NROWS_KV * 256 * 2); p.SVTP = (bf16_t*)take((size_t)16 * 4 * 64 * 256 * 2); p.SVTS = (bf16_t*)take((size_t)4 * 4 * 64 * 1280 * 2);
    p.HID = (bf16_t*)take((size_t)16 * 1024 * 2048 * 2); p.YE = (bf16_t*)take((size_t)16 * 1024 * 1024 * 2);
    p.SEL = (int*)take((size_t)NTOK * 16 * 4); p.IDX = (int*)take(16 * 1024 * 4);
    p.WTI = (bf16_t*)take((size_t)2 * 704 * 1024 * 2); p.WTQ = (bf16_t*)take((size_t)2 * 1536 * 384 * 2); p.WTKV = (bf16_t*)take((size_t)2 * 2048 * 256 * 2); p.WTO = (bf16_t*)take((size_t)2 * 1024 * 1024 * 2);
    p.WTGI = (bf16_t*)take((size_t)6144 * 1024 * 2); p.WTGO = (bf16_t*)take((size_t)1024 * 3072 * 2); p.WTSQ = (bf16_t*)take((size_t)1536 * 1024 * 2); p.WTSO = (bf16_t*)take((size_t)1024 * 1024 * 2);
    if (off > ws_size) { fprintf(stderr, "kernel_launch: workspace too small: need %zu, have %zu\n", off, ws_size); return; }
    (void)in_sizes; (void)n_in; (void)out_size;
    if (hipMemsetAsync(p.bar, 0, 16384, stream) != hipSuccess) { fprintf(stderr, "kernel_launch: memset failed\n"); return; }
#if N_LAUNCH_PER_PHASE
#ifndef MAX_PHASE
#define MAX_PHASE N_PHASES
#endif
    for (int k = 0; k < MAX_PHASE; ++k) {
        if (k >= 2) { const int li = (k - 2) / 10, s = (k - 2) % 10, kind = li % 3; if (kind != 0 && (s == 3 || s == 4)) continue; }
        p.ph_lo = k; p.ph_hi = k + 1;
        hipLaunchKernelGGL(fwd_kernel, dim3(grid), dim3(NTHREADS), LDS_BYTES, stream, p);
    }
#else
    p.ph_lo = 0; p.ph_hi = N_PHASES;
    hipLaunchKernelGGL(fwd_kernel, dim3(grid), dim3(NTHREADS), LDS_BYTES, stream, p);
#endif
#ifdef PROBE_V
    { static int once = 0; if (!once) { once = 1; (void)hipFuncSetAttribute((const void*)probe_kernel, hipFuncAttributeMaxDynamicSharedMemorySize, LDS_BYTES); }
      hipLaunchKernelGGL(probe_kernel, dim3(grid), dim3(NTHREADS), LDS_BYTES, stream, p); }
#endif
    const hipError_t le = hipPeekAtLastError();
    if (le != hipSuccess) fprintf(stderr, "kernel_launch: launch failed: %s\n", hipGetErrorName(le));
}
```

```cpp
#include <hip/hip_runtime.h>
#include <stdint.h>
#include <stdio.h>

#ifndef N_LAUNCH_PER_PHASE
#define N_LAUNCH_PER_PHASE 0
#endif

#define DEVI __device__ __forceinline__
#define LAS __attribute__((address_space(3)))
typedef unsigned short bf16_t;
typedef short bf16x8 __attribute__((ext_vector_type(8)));
typedef float f32x4 __attribute__((ext_vector_type(4)));
typedef float f32x2 __attribute__((ext_vector_type(2)));
typedef unsigned u32x4 __attribute__((ext_vector_type(4)));
typedef unsigned u32x2 __attribute__((ext_vector_type(2)));
typedef LAS unsigned char lds_t;

constexpr int D = 1024;
constexpr int NTOK = 8192, NPR = 4096;
constexpr int NROWS_KV = 9216;
constexpr int DEPTH = 4;
constexpr float ALPHA_F = 1.681792830507429f;
constexpr float EPS_F = 1e-6f;
constexpr float LOG2E = 1.4426950408889634f;
constexpr int NTHREADS = 512;
constexpr int LDS_MAIN = 147456;
constexpr int LDS_BYTES = LDS_MAIN + 1024;

__device__ const float rope_tab[64 * 16 * 2] = {
1.000000000e+00f,0.000000000e+00f,1.000000000e+00f,0.000000000e+00f,1.000000000e+00f,0.000000000e+00f,1.000000000e+00f,0.000000000e+00f,1.000000000e+00f,0.000000000e+00f,1.000000000e+00f,0.000000000e+00f,1.000000000e+00f,0.000000000e+00f,1.000000000e+00f,0.000000000e+00f,1.000000000e+00f,0.000000000e+00f,1.000000000e+00f,0.000000000e+00f,1.000000000e+00f,0.000000000e+00f,1.000000000e+00f,0.000000000e+00f,1.000000000e+00f,0.000000000e+00f,1.000000000e+00f,0.000000000e+00f,1.000000000e+00f,0.000000000e+00f,1.000000000e+00f,0.000000000e+00f,
5.403023059e-01f,8.414709848e-01f,8.460091064e-01f,5.331684460e-01f,9.504152809e-01f,3.109835909e-01f,9.842302348e-01f,1.768921847e-01f,9.950041651e-01f,9.983341813e-02f,9.984192778e-01f,5.620449919e-02f,9.995000417e-01f,3.161750470e-02f,9.998418903e-01f,1.778185709e-02f,9.999500004e-01f,9.999833111e-03f,9.999841887e-01f,5.623383612e-03f,9.999950000e-01f,3.162272359e-03f,9.999984189e-01f,1.778278494e-03f,9.999995000e-01f,9.999998808e-04f,9.999998419e-01f,5.623412721e-04f,9.999999500e-01f,3.162277519e-04f,9.999999842e-01f,1.778279393e-04f,
-4.161468365e-01f,9.092974268e-01f,4.314628163e-01f,9.021307212e-01f,8.065784124e-01f,5.911271138e-01f,9.374183100e-01f,3.482052729e-01f,9.800665772e-01f,1.986693337e-01f,9.936821085e-01f,1.122313110e-01f,9.980006668e-01f,6.320339453e-02f,9.993676111e-01f,3.555809121e-02f,9.998000067e-01f,1.999866625e-02f,9.999367551e-01f,1.124658940e-02f,9.999800001e-01f,6.324513096e-03f,9.999936755e-01f,3.556551364e-03f,9.999980000e-01f,1.999998762e-03f,9.999993675e-01f,1.124682366e-03f,9.999998000e-01f,6.324554721e-04f,9.999999368e-01f,3.556558729e-04f,
-9.899924966e-01f,1.411200081e-01f,-1.159661631e-01f,9.932531646e-01f,5.827536401e-01f,8.126488756e-01f,8.610406595e-01f,5.085361174e-01f,9.553364856e-01f,2.955202180e-01f,9.858034692e-01f,1.679033061e-01f,9.955033745e-01f,9.472608625e-02f,9.985773124e-01f,5.332308304e-02f,9.995500338e-01f,2.999549953e-02f,9.998577009e-01f,1.686943954e-02f,9.999550003e-01f,9.486690354e-03f,9.999857698e-01f,5.334812988e-03f,9.999955000e-01f,2.999995526e-03f,9.999985770e-01f,1.687023105e-03f,9.999995500e-01f,9.486831000e-04f,9.999998577e-01f,5.334837808e-04f,
-6.536436209e-01f,-7.568024953e-01f,-6.276796763e-01f,7.784717233e-01f,3.011374707e-01f,9.535807379e-01f,7.575061759e-01f,6.528279969e-01f,9.210609917e-01f,3.894183478e-01f,9.748082657e-01f,2.230444915e-01f,9.920106618e-01f,1.261540598e-01f,9.974712443e-01f,7.107120934e-02f,9.992001067e-01f,3.998933329e-02f,9.997470285e-01f,2.249175622e-02f,9.999200011e-01f,1.264877321e-02f,9.999747019e-01f,7.113057742e-03f,9.999920000e-01f,3.999989523e-03f,9.999974702e-01f,2.249363310e-03f,9.999992000e-01f,1.264910691e-03f,9.999997470e-01f,7.113117008e-04f,
2.836621855e-01f,-9.589242747e-01f,-9.460792425e-01f,3.239352821e-01f,-1.034233808e-02f,9.999465166e-01f,6.300802992e-01f,7.765299843e-01f,8.775825619e-01f,4.794255386e-01f,9.607312596e-01f,2.774805341e-01f,9.875260225e-01f,1.574558824e-01f,9.960497565e-01f,8.879686156e-02f,9.987502605e-01f,4.997916629e-02f,9.996047413e-01f,2.811336165e-02f,9.998750026e-01f,1.581072865e-02f,9.999604718e-01f,8.891280002e-03f,9.999875000e-01f,4.999979521e-03f,9.999960472e-01f,2.811702920e-03f,9.999987500e-01f,1.581138156e-03f,9.999996047e-01f,8.891395984e-04f,
9.601702867e-01f,-2.794154982e-01f,-9.731036980e-01f,-2.303675170e-01f,-3.207963899e-01f,9.471481807e-01f,4.827820346e-01f,8.757405478e-01f,8.253356014e-01f,5.646424931e-01f,9.436169596e-01f,3.310393232e-01f,9.820539372e-01f,1.886002770e-01f,9.943132976e-01f,1.064944419e-01f,9.982005400e-01f,5.996400514e-02f,9.994308440e-01f,3.373407806e-02f,9.998200054e-01f,1.897252691e-02f,9.999430795e-01f,1.066947415e-02f,9.999820001e-01f,5.999964052e-03f,9.999943079e-01f,3.374041408e-03f,9.999982000e-01f,1.897365346e-03f,9.999994308e-01f,1.066967410e-03f,
7.539022543e-01f,6.569865987e-01f,-7.004298139e-01f,-7.137212872e-01f,-5.994374526e-01f,8.004216016e-01f,3.202570024e-01f,9.473306986e-01f,7.648421950e-01f,6.442176781e-01f,9.235194568e-01f,3.835515778e-01f,9.755998794e-01f,2.195560870e-01f,9.922624183e-01f,1.241583392e-01f,9.975510002e-01f,6.994284763e-02f,9.992253421e-01f,3.935372584e-02f,9.997550100e-01f,2.213413545e-02f,9.999225252e-01f,1.244763455e-02f,9.999755001e-01f,6.999943050e-03f,9.999922524e-01f,3.936378830e-03f,9.999975500e-01f,2.213592463e-03f,9.999992252e-01f,1.244795304e-03f,
-1.455000338e-01f,9.893582466e-01f,-2.120364479e-01f,-9.772617586e-01f,-8.186324475e-01f,5.743177830e-01f,1.476312130e-01f,9.890424788e-01f,6.967067008e-01f,7.173560992e-01f,9.005023096e-01f,4.348512278e-01f,9.681703064e-01f,2.502923447e-01f,9.898977664e-01f,1.417829752e-01f,9.968017064e-01f,7.991469219e-02f,9.989882418e-01f,4.497213288e-02f,9.996800171e-01f,2.529552265e-02f,9.998988088e-01f,1.422575559e-02f,9.999680002e-01f,7.999915047e-03f,9.999898807e-01f,4.498715239e-03f,9.999968000e-01f,2.529819359e-03f,9.999989881e-01f,1.422623042e-03f,
-9.111302619e-01f,4.121184852e-01f,3.416602554e-01f,-9.398235313e-01f,-9.566441680e-01f,2.912592245e-01f,-2.965079623e-02f,9.995603185e-01f,6.216099403e-01f,7.833269319e-01f,8.746382611e-01f,4.847761465e-01f,9.597726443e-01f,2.807783310e-01f,9.872200896e-01f,1.593627767e-01f,9.959527334e-01f,8.987854534e-02f,9.987195508e-01f,5.058911778e-02f,9.995950273e-01f,2.845665689e-02f,9.998719305e-01f,1.600383071e-02f,9.999595003e-01f,8.999879044e-03f,9.999871928e-01f,5.061050226e-03f,9.999959500e-01f,2.846046001e-03f,9.999987193e-01f,1.600450735e-03f,
-8.390715291e-01f,-5.440211109e-01f,7.901318660e-01f,-6.129368926e-01f,-9.997860721e-01f,-2.068356987e-02f,-2.059976331e-01f,9.785524897e-01f,5.403023059e-01f,8.414709848e-01f,8.460091064e-01f,5.331684460e-01f,9.504152902e-01f,3.109835626e-01f,9.842302348e-01f,1.768921847e-01f,9.950041659e-01f,9.983341072e-02f,9.984192778e-01f,5.620449919e-02f,9.995000417e-01f,3.161750470e-02f,9.998418903e-01f,1.778185709e-02f,9.999500004e-01f,9.999834042e-03f,9.999841887e-01f,5.623383612e-03f,9.999950000e-01f,3.162272359e-03f,9.999984189e-01f,1.778278494e-03f,
4.425697988e-03f,-9.999902066e-01f,9.952573993e-01f,-9.727645772e-02f,-9.437797393e-01f,-3.305749593e-01f,-3.758474003e-01f,9.266815697e-01f,4.535961002e-01f,8.912073709e-01f,8.147053420e-01f,5.798751639e-01f,9.401075903e-01f,3.408778647e-01f,9.809291472e-01f,1.943656558e-01f,9.939560980e-01f,1.097783002e-01f,9.980874321e-01f,6.181810327e-02f,9.993950610e-01f,3.477804006e-02f,9.998086883e-01f,1.955982724e-02f,9.999395006e-01f,1.099977904e-02f,9.999808683e-01f,6.185714754e-03f,9.999939500e-01f,3.478498401e-03f,9.999980868e-01f,1.956106080e-03f,
8.438539587e-01f,-5.365729180e-01f,8.938616142e-01f,4.483429653e-01f,-7.941793525e-01f,-6.076834341e-01f,-5.338430142e-01f,8.455836068e-01f,3.623577100e-01f,9.320391032e-01f,7.808259330e-01f,6.247486393e-01f,9.288598710e-01f,3.704312892e-01f,9.773178677e-01f,2.117776794e-01f,9.928086362e-01f,1.197122046e-01f,9.977240240e-01f,6.742975621e-02f,9.992800864e-01f,3.793822392e-02f,9.997723246e-01f,2.133773367e-02f,9.999280009e-01f,1.199971211e-02f,9.999772317e-01f,6.748044406e-03f,9.999928000e-01f,3.794723862e-03f,9.999977232e-01f,2.133933605e-03f,
9.074467815e-01f,4.201670368e-01f,5.171728454e-01f,8.558809777e-01f,-5.658204930e-01f,-8.245284529e-01f,-6.750016657e-01f,7.378162043e-01f,2.674987597e-01f,9.635582046e-01f,7.444779872e-01f,6.676470075e-01f,9.166833698e-01f,3.996143135e-01f,9.733975442e-01f,2.291227201e-01f,9.915618943e-01f,1.296341379e-01f,9.973290651e-01f,7.303927684e-02f,9.991551190e-01f,4.109803212e-02f,9.997327995e-01f,2.311557262e-02f,9.999155012e-01f,1.299963410e-02f,9.999732789e-01f,7.310371924e-03f,9.999915500e-01f,4.110949176e-03f,9.999973279e-01f,2.311761062e-03f,
1.367372182e-01f,9.906073557e-01f,-1.879615160e-02f,9.998233367e-01f,-2.813494808e-01f,-9.596053718e-01f,-7.948709048e-01f,6.067785796e-01f,1.699671664e-01f,9.854497259e-01f,7.057763743e-01f,7.084346897e-01f,9.035902493e-01f,4.283977840e-01f,9.691694136e-01f,2.463953078e-01f,9.902159961e-01f,1.395431152e-01f,9.969025685e-01f,7.864648034e-02f,9.990201601e-01f,4.425742562e-02f,9.996901128e-01f,2.489334034e-02f,9.999020016e-01f,1.399954310e-02f,9.999690098e-01f,7.872696665e-03f,9.999902000e-01f,4.427174080e-03f,9.999969010e-01f,2.489588678e-03f,
-7.596879129e-01f,6.502878402e-01f,-5.489754720e-01f,8.358384600e-01f,3.102235090e-02f,-9.995186910e-01f,-8.896704271e-01f,4.566032536e-01f,7.073720167e-02f,9.974949866e-01f,6.648435293e-01f,7.469826514e-01f,8.895936264e-01f,4.567528653e-01f,9.646348168e-01f,2.635899662e-01f,9.887710793e-01f,1.494381236e-01f,9.964445467e-01f,8.425120425e-02f,9.988752109e-01f,4.741638026e-02f,9.996442648e-01f,2.667102934e-02f,9.998875021e-01f,1.499943810e-02f,9.999644246e-01f,8.435019847e-03f,9.999887500e-01f,4.743398540e-03f,9.999964424e-01f,2.667415984e-03f,
-9.576594803e-01f,-2.879033167e-01f,-9.100810896e-01f,4.144302238e-01f,3.403181682e-01f,-9.403103447e-01f,-9.564100499e-01f,2.920270818e-01f,-2.919954613e-02f,9.995736023e-01f,6.218088193e-01f,7.831690700e-01f,8.747074844e-01f,4.846512321e-01f,9.597951759e-01f,2.807013010e-01f,9.872272839e-01f,1.593182031e-01f,9.959550145e-01f,8.985326392e-02f,9.987202731e-01f,5.057485702e-02f,9.995952558e-01f,2.844863214e-02f,9.998720027e-01f,1.599931810e-02f,9.999595231e-01f,8.997339431e-03f,9.999872000e-01f,5.059622526e-03f,9.999959523e-01f,2.845243204e-03f,
-2.751633381e-01f,-9.613974919e-01f,-9.908979596e-01f,-1.346151313e-01f,6.158647923e-01f,-7.878518627e-01f,-9.929849841e-01f,1.182405237e-01f,-1.288445416e-01f,9.916648043e-01f,5.768082960e-01f,8.168795441e-01f,8.589467084e-01f,5.120649883e-01f,9.546520286e-01f,2.977238725e-01f,9.855847666e-01f,1.691823508e-01f,9.954339876e-01f,9.545248218e-02f,9.985553481e-01f,5.373282803e-02f,9.995430857e-01f,3.022614497e-02f,9.998555035e-01f,1.699918210e-02f,9.999543054e-01f,9.559656169e-03f,9.999855500e-01f,5.375846007e-03f,9.999954305e-01f,3.023070335e-03f,
6.603167082e-01f,-7.509872468e-01f,-7.665365398e-01f,-6.422006954e-01f,8.303361283e-01f,-5.572628770e-01f,-9.982416606e-01f,-5.927551864e-02f,-2.272021643e-01f,9.738476146e-01f,5.299841756e-01f,8.480075316e-01f,8.423270577e-01f,5.389667224e-01f,9.492070108e-01f,3.146522695e-01f,9.838436942e-01f,1.790295658e-01f,9.948814823e-01f,1.010486820e-01f,9.983804374e-01f,5.689026544e-02f,9.994877548e-01f,3.200356222e-02f,9.998380044e-01f,1.799902910e-02f,9.999487715e-01f,1.012197082e-02f,9.999838000e-01f,5.692068949e-03f,9.999948771e-01f,3.200897370e-03f,
9.887046182e-01f,1.498772097e-01f,-3.060954058e-01f,-9.520008417e-01f,9.624637956e-01f,-2.714100995e-01f,-9.720142724e-01f,-2.349218044e-01f,-3.232895443e-01f,9.463000954e-01f,4.814845890e-01f,8.764545570e-01f,8.248651506e-01f,5.653295351e-01f,9.434618259e-01f,3.314811956e-01f,9.820042356e-01f,1.888588926e-01f,9.942975170e-01f,1.066416789e-01f,9.981955430e-01f,6.004713022e-02f,9.994292631e-01f,3.378088199e-02f,9.998195054e-01f,1.899885811e-02f,9.999429214e-01f,1.068428133e-02f,9.999819501e-01f,6.008291323e-03f,9.999942921e-01f,3.378724537e-03f,
4.080820618e-01f,9.129452507e-01f,2.486167313e-01f,-9.686019414e-01f,9.991443799e-01f,4.135829015e-02f,-9.151299503e-01f,-4.031589936e-01f,-4.161468365e-01f,9.092974268e-01f,4.314628163e-01f,9.021307212e-01f,8.065784476e-01f,5.911270657e-01f,9.374183100e-01f,3.482052729e-01f,9.800665802e-01f,1.986693191e-01f,9.936821085e-01f,1.122313110e-01f,9.980006668e-01f,6.320339453e-02f,9.993676111e-01f,3.555809121e-02f,9.998000066e-01f,1.999866811e-02f,9.999367551e-01f,1.124658940e-02f,9.999800001e-01f,6.324513096e-03f,9.999936755e-01f,3.556551364e-03f,
-5.477292602e-01f,8.366556385e-01f,7.267602563e-01f,-6.868912067e-01f,9.367404516e-01f,3.500247509e-01f,-8.293829489e-01f,-5.586805205e-01f,-5.048462281e-01f,8.632092944e-01f,3.800769984e-01f,9.249548504e-01f,7.874851971e-01f,6.163335658e-01f,9.310783539e-01f,3.648192688e-01f,9.780309161e-01f,2.084598934e-01f,9.930352772e-01f,1.178173940e-01f,9.977958103e-01f,6.635903053e-02f,9.993027988e-01f,3.733518799e-02f,9.997795081e-01f,2.099845811e-02f,9.999302726e-01f,1.180889298e-02f,9.999779501e-01f,6.640734236e-03f,9.999930272e-01f,3.734378079e-03f,
-9.999608264e-01f,-8.851309290e-03f,9.810745815e-01f,-1.936302286e-01f,7.814403926e-01f,6.239798978e-01f,-7.174774633e-01f,-6.965817179e-01f,-5.885011558e-01f,8.084963758e-01f,3.274895886e-01f,9.448547874e-01f,7.676045628e-01f,6.409237359e-01f,9.244439837e-01f,3.813178741e-01f,9.758974496e-01f,2.182296219e-01f,9.923570442e-01f,1.233997439e-01f,9.975809759e-01f,6.951400294e-02f,9.992348263e-01f,3.911217043e-02f,9.997580097e-01f,2.199822712e-02f,9.999234739e-01f,1.237119282e-02f,9.999758001e-01f,6.956954712e-03f,9.999923473e-01f,3.912204676e-03f,
-5.328330203e-01f,-8.462204042e-01f,9.332357723e-01f,3.592645171e-01f,5.486452564e-01f,8.360552510e-01f,-5.829432350e-01f,-8.125128828e-01f,-6.662759857e-01f,7.457052439e-01f,2.738668392e-01f,9.617676197e-01f,7.469563882e-01f,6.648730361e-01f,9.175172750e-01f,3.976959268e-01f,9.736663975e-01f,2.279775131e-01f,9.916474294e-01f,1.289781990e-01f,9.973561656e-01f,7.266828020e-02f,9.991636941e-01f,4.088902546e-02f,9.997355116e-01f,2.299797413e-02f,9.999163589e-01f,1.293348969e-02f,9.999735501e-01f,7.273174492e-03f,9.999916358e-01f,4.090031381e-03f,
4.241790073e-01f,-9.055783620e-01f,5.979771709e-01f,8.015131335e-01f,2.614416878e-01f,9.652192724e-01f,-4.300232723e-01f,-9.028178029e-01f,-7.373937800e-01f,6.754631102e-01f,2.193782753e-01f,9.756398784e-01f,7.255613200e-01f,6.881575190e-01f,9.103004290e-01f,4.139482201e-01f,9.713379761e-01f,2.377026212e-01f,9.909064560e-01f,1.345525754e-01f,9.971213823e-01f,7.582182336e-02f,9.990894022e-01f,4.266575118e-02f,9.997120138e-01f,2.399769627e-02f,9.999089278e-01f,1.349578153e-02f,9.999712001e-01f,7.589393080e-03f,9.999908927e-01f,4.267857492e-03f,
9.912028119e-01f,-1.323517501e-01f,7.855226359e-02f,9.969099969e-01f,-5.168932904e-02f,9.986632131e-01f,-2.635405934e-01f,-9.646483067e-01f,-8.011436155e-01f,5.984721441e-01f,1.641961594e-01f,9.864277070e-01f,7.034407513e-01f,7.107539022e-01f,9.027957408e-01f,4.300695879e-01f,9.689124217e-01f,2.474039593e-01f,9.901341474e-01f,1.401226969e-01f,9.968766273e-01f,7.897461572e-02f,9.990119510e-01f,4.444234199e-02f,9.996875163e-01f,2.499739629e-02f,9.999011805e-01f,1.405806910e-02f,9.999687502e-01f,7.905611374e-03f,9.999901179e-01f,4.445683934e-03f,
6.469193223e-01f,7.625584505e-01f,-4.650644959e-01f,8.852768012e-01f,-3.596943393e-01f,9.330701915e-01f,-8.874550263e-02f,-9.960543337e-01f,-8.568888271e-01f,5.155012492e-01f,1.084949468e-01f,9.940970006e-01f,6.806168009e-01f,7.326395911e-01f,8.950055582e-01f,4.460549862e-01f,9.663899806e-01f,2.570805427e-01f,9.893305281e-01f,1.456883874e-01f,9.966219035e-01f,8.212661834e-02f,9.989313406e-01f,4.621879226e-02f,9.996620190e-01f,2.599707130e-02f,9.998931169e-01f,1.462035317e-02f,9.999662002e-01f,8.221828878e-03f,9.999893115e-01f,4.623509769e-03f,
-2.921388087e-01f,9.563759284e-01f,-8.654506342e-01f,5.009942114e-01f,-6.320286307e-01f,7.749450367e-01f,8.884811635e-02f,-9.960451858e-01f,-9.040721624e-01f,4.273798371e-01f,5.245061444e-02f,9.986235192e-01f,6.571122908e-01f,7.537927018e-01f,8.869323709e-01f,4.618993066e-01f,9.637709015e-01f,2.667314183e-01f,9.884956235e-01f,1.512494708e-01f,9.963572141e-01f,8.527779227e-02f,9.988475711e-01f,4.799510009e-02f,9.996355221e-01f,2.699672032e-02f,9.998847372e-01f,1.518263167e-02f,9.999635502e-01f,8.538045559e-03f,9.999884735e-01f,4.801335923e-03f,
-9.626058663e-01f,2.709057883e-01f,-9.992934094e-01f,-3.758566202e-02f,-8.416849393e-01f,5.399689462e-01f,2.636395107e-01f,-9.646212772e-01f,-9.422223247e-01f,3.349881951e-01f,-3.759419011e-03f,9.999929334e-01f,6.329506774e-01f,7.741921209e-01f,8.785787046e-01f,4.775975920e-01f,9.610554380e-01f,2.763556497e-01f,9.876294623e-01f,1.568057565e-01f,9.960825606e-01f,8.842812085e-02f,9.987606432e-01f,4.977125243e-02f,9.996080256e-01f,2.799634234e-02f,9.998760413e-01f,1.574490538e-02f,9.999608003e-01f,8.854261387e-03f,9.999876039e-01f,4.979161926e-03f,
-7.480575297e-01f,-6.636338842e-01f,-8.253716334e-01f,-5.645898217e-01f,-9.678715076e-01f,2.514453117e-01f,4.301158485e-01f,-9.027737019e-01f,-9.709581880e-01f,2.392492366e-01f,-5.995756728e-02f,9.982009267e-01f,6.081562113e-01f,7.938173736e-01f,8.699472142e-01f,4.931448515e-01f,9.582438779e-01f,2.859522171e-01f,9.867320673e-01f,1.623570984e-01f,9.957979462e-01f,9.157756515e-02f,9.986705569e-01f,5.154724737e-02f,9.995795294e-01f,2.899593637e-02f,9.998670292e-01f,1.630717503e-02f,9.999579503e-01f,9.170476329e-03f,9.999867027e-01f,5.156987306e-03f,
1.542514499e-01f,-9.880316241e-01f,-3.972518623e-01f,-9.177096261e-01f,-9.980752275e-01f,-6.201483913e-02f,5.830269376e-01f,-8.124528233e-01f,-9.899924966e-01f,1.411200081e-01f,-1.159661631e-01f,9.932531646e-01f,5.827536401e-01f,8.126488756e-01f,8.610406595e-01f,5.085361174e-01f,9.553364944e-01f,2.955201896e-01f,9.858034692e-01f,1.679033061e-01f,9.955033738e-01f,9.472609366e-02f,9.985773124e-01f,5.332308304e-02f,9.995500337e-01f,2.999550139e-02f,9.998577009e-01f,1.686943954e-02f,9.999550003e-01f,9.486690354e-03f,9.999857698e-01f,5.334812988e-03f,
9.147423578e-01f,-4.040376453e-01f,1.532154756e-01f,-9.881928041e-01f,-9.293002953e-01f,-3.693250075e-01f,7.175492218e-01f,-6.965077991e-01f,-9.991351562e-01f,4.158051951e-02f,-1.716081385e-01f,9.851652891e-01f,5.567683641e-01f,8.306677968e-01f,8.518617972e-01f,5.237666260e-01f,9.523335692e-01f,3.050586387e-01f,9.848436973e-01f,1.734442042e-01f,9.951988471e-01f,9.787366751e-02f,9.984809103e-01f,5.509874635e-02f,9.995195384e-01f,3.099503643e-02f,9.998480564e-01f,1.743169684e-02f,9.999519504e-01f,9.802903431e-03f,9.999848053e-01f,5.512638036e-03f,
8.342233605e-01f,5.514266812e-01f,6.564951791e-01f,-7.543302193e-01f,-7.683670888e-01f,-6.400093881e-01f,8.294403670e-01f,-5.585952717e-01f,-9.982947730e-01f,-5.837419103e-02f,-2.267075845e-01f,9.739628695e-01f,5.302263665e-01f,8.478561200e-01f,8.424135592e-01f,5.388315091e-01f,9.492354203e-01f,3.145665538e-01f,9.838527819e-01f,1.789796175e-01f,9.948843677e-01f,1.010202700e-01f,9.983813507e-01f,5.687423543e-02f,9.994880436e-01f,3.199454047e-02f,9.998380958e-01f,1.799395049e-02f,9.999488004e-01f,1.011911553e-02f,9.999838092e-01f,5.690463375e-03f,
-1.327674722e-02f,9.999118601e-01f,9.575860738e-01f,-2.881473778e-01f,-5.312352786e-01f,-8.472243379e-01f,9.151713830e-01f,-4.030649323e-01f,-9.874797774e-01f,-1.577456471e-01f,-2.810903074e-01f,9.596813216e-01f,5.031541870e-01f,8.641966582e-01f,8.326989334e-01f,5.537260030e-01f,9.460423489e-01f,3.240430126e-01f,9.828307545e-01f,1.845093711e-01f,9.945599394e-01f,1.041658623e-01f,9.982786339e-01f,5.864954466e-02f,9.994555494e-01f,3.299401065e-02f,9.998278189e-01f,1.855619846e-02f,9.999455505e-01f,1.043532661e-02f,9.999827814e-01f,5.868288535e-03f,
-8.485702748e-01f,5.290826861e-01f,9.637575328e-01f,2.667797179e-01f,-2.414211151e-01f,-9.704204476e-01f,9.720383571e-01f,-2.348221291e-01f,-9.667981682e-01f,-2.555411942e-01f,-3.345843792e-01f,9.423657958e-01f,4.755788956e-01f,8.796730723e-01f,8.227209915e-01f,5.684453977e-01f,9.427546643e-01f,3.334870955e-01f,9.817776473e-01f,1.900332899e-01f,9.942255664e-01f,1.073104056e-01f,9.981727603e-01f,6.042466843e-02f,9.994220556e-01f,3.399345156e-02f,9.998172259e-01f,1.911843869e-02f,9.999422006e-01f,1.075153665e-02f,9.999817221e-01f,6.046113043e-03f,
-9.036922051e-01f,-4.281826695e-01f,6.731102676e-01f,7.395421338e-01f,7.233466718e-02f,-9.973804169e-01f,9.982477619e-01f,-5.917267879e-02f,-9.364566873e-01f,-3.507832277e-01f,-3.870206816e-01f,9.220710342e-01f,4.475280652e-01f,8.942698871e-01f,8.124829236e-01f,5.829849902e-01f,9.393727149e-01f,3.428978019e-01f,9.806934936e-01f,1.955511994e-01f,9.938812503e-01f,1.104538832e-01f,9.980637300e-01f,6.219960483e-02f,9.993875625e-01f,3.499285475e-02f,9.998063168e-01f,1.968067474e-02f,9.999387506e-01f,1.106774562e-02f,9.999806311e-01f,6.223937825e-03f,
-1.279636896e-01f,-9.917788534e-01f,1.751565337e-01f,9.845405978e-01f,3.789161719e-01f,-9.254309994e-01f,9.929728258e-01f,1.183425843e-01f,-8.967583530e-01f,-4.425205716e-01f,-4.382335472e-01f,8.988611451e-01f,4.190297442e-01f,9.079725070e-01f,8.019878986e-01f,5.973402803e-01f,9.358968291e-01f,3.522742188e-01f,9.795783277e-01f,2.010629250e-01f,9.935269954e-01f,1.135962562e-01f,9.979515440e-01f,6.397433710e-02f,9.993520699e-01f,3.599222668e-02f,9.997950914e-01f,2.024290457e-02f,9.999352007e-01f,1.138395348e-02f,9.999795085e-01f,6.401761945e-03f,
7.654140519e-01f,-6.435381334e-01f,-3.767422893e-01f,9.263181135e-01f,6.479216888e-01f,-7.617069550e-01f,9.563800296e-01f,2.921253822e-01f,-8.481000064e-01f,-5.298361813e-01f,-4.880608524e-01f,8.728096037e-01f,3.901124287e-01f,9.207672306e-01f,7.912392691e-01f,6.115066795e-01f,9.323273439e-01f,3.616154364e-01f,9.784321880e-01f,2.065682779e-01f,9.931628052e-01f,1.167374932e-01f,9.978362017e-01f,6.574887451e-02f,9.993155781e-01f,3.699155889e-02f,9.997835499e-01f,2.080512613e-02f,9.999315508e-01f,1.170016020e-02f,9.999783543e-01f,6.579586328e-03f,
9.550736440e-01f,2.963685787e-01f,-8.126112051e-01f,5.828061679e-01f,8.526731157e-01f,-5.224447891e-01f,8.896234916e-01f,4.566946935e-01f,-7.909677411e-01f,-6.118578532e-01f,-5.363451811e-01f,8.439987244e-01f,3.608050334e-01f,9.326412643e-01f,7.802404339e-01f,6.254797082e-01f,9.286646373e-01f,3.709204650e-01f,9.772551046e-01f,2.120671131e-01f,9.927886843e-01f,1.198775555e-01f,9.977177040e-01f,6.752320399e-02f,9.992780868e-01f,3.799085783e-02f,9.997716923e-01f,2.136734297e-02f,9.999278009e-01f,1.201636575e-02f,9.999771684e-01f,6.757410504e-03f,
2.666429324e-01f,9.637953863e-01f,-9.982103598e-01f,5.980031485e-02f,9.728653499e-01f,-2.313720187e-01f,7.948083899e-01f,6.068604645e-01f,-7.259322386e-01f,-6.877662284e-01f,-5.829338849e-01f,8.125195911e-01f,3.311368634e-01f,9.435827349e-01f,7.689949093e-01f,6.392549018e-01f,9.249090653e-01f,3.801884019e-01f,9.760471178e-01f,2.175592422e-01f,9.924046346e-01f,1.230164264e-01f,9.975960518e-01f,6.929731252e-02f,9.992395964e-01f,3.899011506e-02f,9.997595184e-01f,2.192955306e-02f,9.999239510e-01f,1.233257010e-02f,9.999759510e-01f,6.935234000e-03f,
-6.669380617e-01f,7.451131605e-01f,-8.763794418e-01f,-4.816212973e-01f,9.965789837e-01f,8.264580634e-02f,6.749256518e-01f,7.378857395e-01f,-6.536436209e-01f,-7.568024953e-01f,-6.276796763e-01f,7.784717233e-01f,3.011375844e-01f,9.535807020e-01f,7.575061759e-01f,6.528279969e-01f,9.210610033e-01f,3.894183203e-01f,9.748082657e-01f,2.230444915e-01f,9.920106618e-01f,1.261540598e-01f,9.974712443e-01f,7.107120934e-02f,9.992001065e-01f,3.998933702e-02f,9.997470285e-01f,2.249175622e-02f,9.999200011e-01f,1.264877321e-02f,9.999747019e-01f,7.113057742e-03f,
-9.873392775e-01f,-1.586226688e-01f,-4.846393970e-01f,-8.747140418e-01f,9.214623472e-01f,3.884676855e-01f,5.337561004e-01f,8.456384720e-01f,-5.748240246e-01f,-8.182770562e-01f,-6.704410942e-01f,7.419627614e-01f,2.708370782e-01f,9.626252007e-01f,7.457779040e-01f,6.661946547e-01f,9.171208242e-01f,3.986093247e-01f,9.735385875e-01f,2.285226875e-01f,9.916067680e-01f,1.292904390e-01f,9.973432826e-01f,7.284488142e-02f,9.991596177e-01f,4.098851526e-02f,9.997342224e-01f,2.305395040e-02f,9.999159512e-01f,1.296497506e-02f,9.999734212e-01f,7.290880793e-03f,
-3.999853150e-01f,-9.165215479e-01f,5.636094028e-02f,-9.984104589e-01f,7.549653475e-01f,6.557646866e-01f,3.757521519e-01f,9.267201953e-01f,-4.902605720e-01f,-8.715759127e-01f,-7.110829506e-01f,7.031081264e-01f,2.402658714e-01f,9.707071191e-01f,7.338138022e-01f,6.793506485e-01f,9.130889457e-01f,4.077604411e-01f,9.722381233e-01f,2.339936570e-01f,9.911929581e-01f,1.324255253e-01f,9.972121675e-01f,7.461831571e-02f,9.991181295e-01f,4.198765625e-02f,9.997211001e-01f,2.361613915e-02f,9.999118013e-01f,1.328117562e-02f,9.999721088e-01f,7.468704080e-03f,
5.551133015e-01f,-8.317747426e-01f,5.800031129e-01f,-8.146142578e-01f,5.135984179e-01f,8.580306901e-01f,2.058971709e-01f,9.785736329e-01f,-4.007989973e-01f,-9.161660132e-01f,-7.494767587e-01f,6.620306550e-01f,2.094544189e-01f,9.778184118e-01f,7.216176540e-01f,6.922918182e-01f,9.089657591e-01f,4.168707818e-01f,9.709069144e-01f,2.394572270e-01f,9.907692363e-01f,1.355592873e-01f,9.970778984e-01f,7.639152146e-02f,9.990756424e-01f,4.298675152e-02f,9.997076617e-01f,2.417832043e-02f,9.999075514e-01f,1.359737484e-02f,9.999707649e-01f,7.646527131e-03f,
9.998433086e-01f,1.770192511e-02f,9.250146691e-01f,-3.799313911e-01f,2.212981743e-01f,9.752061926e-01f,2.954782069e-02f,9.995633678e-01f,-3.073327792e-01f,-9.516021032e-01f,-7.855011387e-01f,6.188602113e-01f,1.784335295e-01f,9.839519681e-01f,7.091933579e-01f,7.050140291e-01f,9.047516642e-01f,4.259394629e-01f,9.695450064e-01f,2.449132102e-01f,9.903356068e-01f,1.386916938e-01f,9.969404762e-01f,7.816448565e-02f,9.990321560e-01f,4.398580752e-02f,9.996939072e-01f,2.474049220e-02f,9.999032016e-01f,1.391357271e-02f,9.999693893e-01f,7.824349474e-03f,
5.253219888e-01f,8.509035245e-01f,9.851382016e-01f,1.717635693e-01f,-9.294810554e-02f,9.956709545e-01f,-1.477329862e-01f,9.890272821e-01f,-2.107957994e-01f,-9.775301177e-01f,-8.190422014e-01f,5.737332763e-01f,1.472342216e-01f,9.891016550e-01f,6.965447594e-01f,7.175133435e-01f,9.004471075e-01f,4.349655234e-01f,9.681524315e-01f,2.503614776e-01f,9.898920739e-01f,1.418227133e-01f,9.967999021e-01f,7.993719522e-02f,9.989876708e-01f,4.498481582e-02f,9.996798365e-01f,2.530265802e-02f,9.998987517e-01f,1.422976918e-02f,9.999679821e-01f,8.002171569e-03f,
-4.321779449e-01f,9.017883476e-01f,7.418580135e-01f,6.705569982e-01f,-3.979767653e-01f,9.173954950e-01f,-3.203543695e-01f,9.472977768e-01f,-1.121526217e-01f,-9.936909929e-01f,-8.499939088e-01f,5.267925161e-01f,1.158876918e-01f,9.932623233e-01f,6.836758997e-01f,7.297857660e-01f,8.960525071e-01f,4.439480877e-01f,9.667292484e-01f,2.558017989e-01f,9.894386421e-01f,1.449523146e-01f,9.966561752e-01f,8.170965944e-02f,9.989421864e-01f,4.598378286e-02f,9.996654497e-01f,2.586481583e-02f,9.998942019e-01f,1.454596424e-02f,9.999665433e-01f,8.179994343e-03f,
-9.923354692e-01f,1.235731227e-01f,2.700984580e-01f,9.628327077e-01f,-6.635382560e-01f,7.481423547e-01f,-4.828719382e-01f,8.756909793e-01f,-1.238837738e-02f,-9.999232611e-01f,-8.782584087e-01f,4.781863313e-01f,8.442528403e-02f,9.964298126e-01f,6.705908480e-01f,7.418274156e-01f,8.915682887e-01f,4.528862843e-01f,9.652754871e-01f,2.612340599e-01f,9.889753181e-01f,1.480804517e-01f,9.965092972e-01f,8.348185785e-02f,9.988957032e-01f,4.698270019e-02f,9.996507468e-01f,2.642696360e-02f,9.998895520e-01f,1.486215783e-02f,9.999650728e-01f,8.357815927e-03f,
-6.401443395e-01f,-7.682546613e-01f,-2.848466063e-01f,9.585731119e-01f,-8.632964878e-01f,5.046971113e-01f,-6.301599705e-01f,7.764653318e-01f,8.749917344e-02f,-9.961645921e-01f,-9.037463447e-01f,4.280683876e-01f,5.287845807e-02f,9.986009557e-01f,6.572937422e-01f,7.536344847e-01f,8.869949277e-01f,4.617791660e-01f,9.637912089e-01f,2.666580313e-01f,9.885021022e-01f,1.512071226e-01f,9.963592674e-01f,8.525379969e-02f,9.988482211e-01f,4.798157054e-02f,9.996357278e-01f,2.698910488e-02f,9.998848022e-01f,1.517834901e-02f,9.999635708e-01f,8.535637247e-03f,
3.005925437e-01f,-9.537526528e-01f,-7.520639951e-01f,6.590900905e-01f,-9.774427254e-01f,2.112006594e-01f,-7.575730765e-01f,6.527503610e-01f,1.865124631e-01f,-9.824525948e-01f,-9.263771379e-01f,3.765971301e-01f,2.127875808e-02f,9.997735816e-01f,6.437888326e-01f,7.652032012e-01f,8.823328681e-01f,4.706258703e-01f,9.622764532e-01f,2.720735702e-01f,9.880190013e-01f,1.543322815e-01f,9.962060867e-01f,8.702547193e-02f,9.987997401e-01f,4.898039663e-02f,9.996203926e-01f,2.755123762e-02f,9.998799524e-01f,1.549453961e-02f,9.999620371e-01f,8.713459228e-03f,
9.649660285e-01f,-2.623748537e-01f,-9.876590838e-01f,1.566190737e-01f,-9.946564265e-01f,-1.032404628e-01f,-8.610927113e-01f,5.084479743e-01f,2.836621855e-01f,-9.589242747e-01f,-9.460792425e-01f,3.239352821e-01f,-1.034221888e-02f,9.999465178e-01f,6.300802992e-01f,7.765299843e-01f,8.775825619e-01f,4.794255386e-01f,9.607312596e-01f,2.774805341e-01f,9.875260201e-01f,1.574558971e-01f,9.960497565e-01f,8.879686156e-02f,9.987502604e-01f,4.997917001e-02f,9.996047414e-01f,2.811335979e-02f,9.998750026e-01f,1.581072865e-02f,9.999604718e-01f,8.891280002e-03f,
7.421541968e-01f,6.702291758e-01f,-9.190735378e-01f,-3.940860720e-01f,-9.132301279e-01f,-4.074441477e-01f,-9.374542500e-01f,3.481085020e-01f,3.779776544e-01f,-9.258147184e-01f,-9.627903713e-01f,2.702493312e-01f,-4.195285448e-02f,9.991195914e-01f,6.161725219e-01f,7.876112133e-01f,8.727445123e-01f,4.881772386e-01f,9.591556934e-01f,2.828786946e-01f,9.870231637e-01f,1.605779382e-01f,9.958902758e-01f,9.056797780e-02f,9.986997817e-01f,5.097789714e-02f,9.995887740e-01f,2.867547492e-02f,9.998699528e-01f,1.612691704e-02f,9.999588749e-01f,9.069100495e-03f,
-1.629907808e-01f,9.866275920e-01f,-5.674300293e-01f,-8.234216185e-01f,-7.412399645e-01f,-6.712401321e-01f,-9.842484715e-01f,1.767906850e-01f,4.685169241e-01f,-8.834545217e-01f,-9.764576931e-01f,2.157090023e-01f,-7.352154075e-02f,9.972936293e-01f,6.020698986e-01f,7.984433839e-01f,8.678191892e-01f,4.968801213e-01f,9.575497876e-01f,2.882679384e-01f,9.865104371e-01f,1.636983734e-01f,9.957276465e-01f,9.233880022e-02f,9.986483046e-01f,5.197656957e-02f,9.995724905e-01f,2.923758099e-02f,9.998648031e-01f,1.644310196e-02f,9.999572463e-01f,9.246920701e-03f,
-9.182827862e-01f,3.959251502e-01f,-4.102818995e-02f,-9.991579893e-01f,-4.957418213e-01f,-8.684699457e-01f,-9.999999947e-01f,-1.030206758e-04f,5.543744949e-01f,-8.322673365e-01f,-9.870379993e-01f,1.604867217e-01f,-1.050167117e-01f,9.944704572e-01f,5.877769370e-01f,8.090230357e-01f,8.628070850e-01f,5.055333165e-01f,9.559136100e-01f,2.936480378e-01f,9.859878454e-01f,1.668171717e-01f,9.955618677e-01f,9.410933806e-02f,9.985958286e-01f,5.297519375e-02f,9.995558910e-01f,2.979967596e-02f,9.998595533e-01f,1.675928710e-02f,9.999555861e-01f,9.424741546e-03f,
-8.293098329e-01f,-5.587890489e-01f,4.980096003e-01f,-8.671715159e-01f,-2.010796199e-01f,-9.795749009e-01f,-9.842120244e-01f,-1.769934771e-01f,6.346929496e-01f,-7.727644270e-01f,-9.944978661e-01f,1.047568344e-01f,-1.364068747e-01f,9.906528981e-01f,5.732980611e-01f,8.193468943e-01f,8.577087010e-01f,5.141359589e-01f,9.542471952e-01f,2.990188798e-01f,9.854553963e-01f,1.699342871e-01f,9.953929407e-01f,9.587957830e-02f,9.985423542e-01f,5.397376122e-02f,9.995389754e-01f,3.036176336e-02f,9.998542036e-01f,1.707546870e-02f,9.999538943e-01f,9.602561162e-03f,
2.212675626e-02f,-9.997551734e-01f,8.836693140e-01f,-4.681116785e-01f,1.135217773e-01f,-9.935355082e-01f,-9.373825054e-01f,-3.483016489e-01f,7.086697743e-01f,-7.055403256e-01f,-9.988136461e-01f,4.869599955e-02f,-1.676606422e-01f,9.858447692e-01f,5.586378969e-01f,8.294116591e-01f,8.525245158e-01f,5.226872391e-01f,9.525506134e-01f,3.043802375e-01f,9.849130902e-01f,1.730497178e-01f,9.952208667e-01f,9.764950793e-02f,9.984878810e-01f,5.497227845e-02f,9.995217437e-01f,3.092384116e-02f,9.998487538e-01f,1.739165045e-02f,9.999521709e-01f,9.780380474e-03f,
8.532201077e-01f,-5.215510021e-01f,9.971746360e-01f,7.511820869e-02f,4.168670742e-01f,-9.089674595e-01f,-8.609884168e-01f,-5.086245631e-01f,7.755658183e-01f,-6.312667118e-01f,-9.999717335e-01f,-7.518784889e-03f,-1.987468801e-01f,9.800508546e-01f,5.438010803e-01f,8.392141473e-01f,8.472551097e-01f,5.311861999e-01f,9.508239095e-01f,3.097319700e-01f,9.843609349e-01f,1.761634181e-01f,9.950456449e-01f,9.941913618e-02f,9.984324096e-01f,5.597073698e-02f,9.995041959e-01f,3.148590732e-02f,9.998432041e-01f,1.770782860e-02f,9.999504159e-01f,9.958200408e-03f,
8.998668270e-01f,4.361647552e-01f,8.035690866e-01f,5.952114944e-01f,6.788702112e-01f,-7.342582900e-01f,-7.574391895e-01f,-6.529057162e-01f,8.347129424e-01f,-5.506853038e-01f,-9.979684672e-01f,-6.370979912e-02f,-2.296342702e-01f,9.732769914e-01f,5.287923029e-01f,8.487512594e-01f,8.419009790e-01f,5.396320427e-01f,9.490671287e-01f,3.150739362e-01f,9.837989360e-01f,1.792753567e-01f,9.948672764e-01f,1.011884500e-01f,9.983759396e-01f,5.696914326e-02f,9.994863320e-01f,3.204796724e-02f,9.998375544e-01f,1.802400685e-02f,9.999486292e-01f,1.013601910e-02f,
1.191801354e-01f,9.928726481e-01f,3.624766664e-01f,9.319928467e-01f,8.735505105e-01f,-4.867335058e-01f,-6.300007138e-01f,-7.765945536e-01f,8.855196056e-01f,-4.646020105e-01f,-9.928101803e-01f,-1.196993984e-01f,-2.602920453e-01f,9.655299328e-01f,5.136163109e-01f,8.580199795e-01f,8.364626591e-01f,5.480239228e-01f,9.472803452e-01f,3.204059106e-01f,9.832270991e-01f,1.823855026e-01f,9.946857626e-01f,1.029574365e-01f,9.983184713e-01f,5.796748886e-02f,9.994681521e-01f,3.261001331e-02f,9.998318047e-01f,1.834018143e-02f,9.999468110e-01f,1.031383746e-02f,
-7.710802230e-01f,6.367380071e-01f,-1.902490958e-01f,9.817358512e-01f,9.816020978e-01f,-1.909380047e-01f,-4.826923346e-01f,-8.757899920e-01f,9.274784664e-01f,-3.738765764e-01f,-9.845131804e-01f,-1.753105749e-01f,-2.906895502e-01f,9.568174253e-01f,4.982779032e-01f,8.670173765e-01f,8.309406937e-01f,5.563610011e-01f,9.454635966e-01f,3.257277812e-01f,9.826454300e-01f,1.854938246e-01f,9.945011026e-01f,1.047261048e-01f,9.982600046e-01f,5.896578020e-02f,9.994496561e-01f,3.317204907e-02f,9.998259550e-01f,1.865635603e-02f,9.999449611e-01f,1.049165644e-02f,
-9.524129804e-01f,-3.048106211e-01f,-6.843819158e-01f,7.291237161e-01f,9.923083195e-01f,1.237909494e-01f,-3.201591802e-01f,-9.473637630e-01f,9.601702867e-01f,-2.794154982e-01f,-9.731036980e-01f,-2.303675170e-01f,-3.207963899e-01f,9.471481807e-01f,4.827820346e-01f,8.757405478e-01f,8.253356351e-01f,5.646424439e-01f,9.436169596e-01f,3.310393232e-01f,9.820539344e-01f,1.886002917e-01f,9.943132976e-01f,1.064944419e-01f,9.982005398e-01f,5.996400886e-02f,9.994308440e-01f,3.373407806e-02f,9.998200054e-01f,1.897252691e-02f,9.999430795e-01f,1.066947415e-02f,
-2.581016359e-01f,-9.661177700e-01f,-9.677396624e-01f,2.519522691e-01f,9.046075662e-01f,4.262454119e-01f,-1.475292025e-01f,-9.890577002e-01f,9.832684211e-01f,-1.821625980e-01f,-9.586178037e-01f,-2.846961652e-01f,-3.505824602e-01f,9.365318674e-01f,4.671333972e-01f,8.841868520e-01f,8.196480097e-01f,5.728674718e-01f,9.417404730e-01f,3.363404250e-01f,9.814526211e-01f,1.917048581e-01f,9.941223492e-01f,1.082624348e-01f,9.981400766e-01f,6.096218127e-02f,9.994117160e-01f,3.429609266e-02f,9.998139558e-01f,1.928869776e-02f,9.999411664e-01f,1.084729152e-02f,
6.735071623e-01f,-7.391806966e-01f,-9.530500361e-01f,-3.028128610e-01f,7.271980777e-01f,6.864276770e-01f,2.975377145e-02f,-9.995572585e-01f,9.965421208e-01f,-8.308911770e-02f,-9.411012936e-01f,-3.381247627e-01f,-3.800179774e-01f,9.249791008e-01f,4.513370430e-01f,8.923535586e-01f,8.138784539e-01f,5.810351644e-01f,9.398342161e-01f,3.416308626e-01f,9.808414904e-01f,1.948075221e-01f,9.939282563e-01f,1.100300928e-01f,9.980786154e-01f,6.196028901e-02f,9.993922719e-01f,3.485809641e-02f,9.998078062e-01f,1.960486481e-02f,9.999392216e-01f,1.102510855e-02f,
9.858965816e-01f,1.673557003e-01f,-6.448370157e-01f,-7.643201052e-01f,4.776714527e-01f,8.785385497e-01f,2.060983265e-01f,-9.785312871e-01f,9.998586332e-01f,1.681409119e-02f,-9.206095453e-01f,-3.904843980e-01f,-4.090735085e-01f,9.125014327e-01f,4.353979670e-01f,9.002380853e-01f,8.080275111e-01f,5.891447541e-01f,9.378982288e-01f,3.469105251e-01f,9.802205514e-01f,1.979082381e-01f,9.937310211e-01f,1.117973955e-01f,9.980161562e-01f,6.295833478e-02f,9.993725116e-01f,3.542009286e-02f,9.998015566e-01f,1.992103176e-02f,9.999372453e-01f,1.120292616e-02f
};

#define XB_TMO      128
#define XB_XCNT(j)  (256  + 64 * (j))
#define XB_XSUB(j)  (1280 + 64 * (j))
#define XB_XGEN(j)  (2304 + 64 * (j))
#define XB_TOP      3328
#define XB_TOPGEN   3392
#define XCD_BAR_WORDS 3456
#define XB_SPIN_CAP (1u << 18)

__device__ __forceinline__ unsigned xb_ld(unsigned* p)              { return __hip_atomic_load(p, __ATOMIC_RELAXED, __HIP_MEMORY_SCOPE_AGENT); }
__device__ __forceinline__ unsigned xb_add(unsigned* p, unsigned v) { return __hip_atomic_fetch_add(p, v, __ATOMIC_RELAXED, __HIP_MEMORY_SCOPE_AGENT); }
__device__ __forceinline__ unsigned xb_xcc_id() { return (unsigned)__builtin_amdgcn_s_getreg((3 << 11) | 20) & 0xFu; }
#define XB_SPIN(cond, bar) do { unsigned _sp = 0; while (cond) { __builtin_amdgcn_s_sleep(1); \
    if ((++_sp & 255u) == 0u) { if (xb_ld(&(bar)[XB_TMO])) break; if (_sp > XB_SPIN_CAP) { atomicAdd(&(bar)[XB_TMO], 1u); break; } } } } while (0)

struct XcdBarrier {
    unsigned* bar; unsigned x;
    volatile LAS unsigned* st;
};

__device__ __forceinline__ XcdBarrier xcd_barrier_post(unsigned* bar, volatile LAS unsigned* st) {
    XcdBarrier b; b.bar = bar; b.x = xb_xcc_id(); b.st = st;
    if (threadIdx.x == 0) (void)xb_add(&bar[XB_XCNT(b.x)], 1u);
    return b;
}
__device__ __forceinline__ void xcd_barrier_complete(unsigned* bar, unsigned x, unsigned& nloc, unsigned& nx) {
    const unsigned G = gridDim.x * gridDim.y * gridDim.z;
    unsigned sum, cnt, mine, sp = 0u;
    for (;;) {
        sum = 0u; cnt = 0u; mine = 0u;
#pragma unroll
        for (unsigned j = 0; j < 16; ++j) { const unsigned c = xb_ld(&bar[XB_XCNT(j)]); sum += c; cnt += (c > 0u) ? 1u : 0u; mine = (j == x) ? c : mine; }
        if (sum == G) break;
        __builtin_amdgcn_s_sleep(1);
        if ((++sp & 255u) == 0u) { if (xb_ld(&bar[XB_TMO])) break; if (sp > XB_SPIN_CAP) { atomicAdd(&bar[XB_TMO], 1u); break; } }
    }
    nloc = mine > 0u ? mine : 1u; nx = cnt > 0u ? cnt : 1u;
}

__device__ __forceinline__ void xcd_barrier(const XcdBarrier& b) {
    asm volatile("s_waitcnt vmcnt(0)" ::: "memory");
    __syncthreads();
    if (threadIdx.x == 0) {
        unsigned* bar = b.bar;
        __builtin_amdgcn_s_waitcnt(0);
        unsigned nloc = b.st[0], nx = b.st[1];
        if (nloc == 0u) { xcd_barrier_complete(bar, b.x, nloc, nx); b.st[0] = nloc; b.st[1] = nx; }
        const unsigned old = xb_add(&bar[XB_XSUB(b.x)], 1u);
        const unsigned gen = old / nloc;
        if (old + 1u == (gen + 1u) * nloc) {
            __builtin_amdgcn_fence(__ATOMIC_RELEASE, "agent");
            asm volatile("s_waitcnt vmcnt(0)" ::: "memory");
            const unsigned og = xb_add(&bar[XB_TOP], 1u);
            const unsigned tg = og / nx;
            if (og + 1u == (tg + 1u) * nx) xb_add(&bar[XB_TOPGEN], 1u);
            else XB_SPIN(xb_ld(&bar[XB_TOPGEN]) == tg, bar);
            __builtin_amdgcn_fence(__ATOMIC_ACQUIRE, "agent");
            xb_add(&bar[XB_XGEN(b.x)], 1u);
            asm volatile("s_waitcnt vmcnt(0)" ::: "memory");
        } else {
            XB_SPIN(xb_ld(&bar[XB_XGEN(b.x)]) == gen, bar);
            __builtin_amdgcn_fence(__ATOMIC_ACQUIRE, "agent");
            asm volatile("s_waitcnt vmcnt(0)" ::: "memory");
        }
    }
    __syncthreads();
}

typedef __bf16 bf16x2_t __attribute__((ext_vector_type(2)));
DEVI unsigned pk_bf16(float lo, float hi) {
    f32x2 f = {lo, hi}; bf16x2_t v = __builtin_convertvector(f, bf16x2_t); unsigned r; __builtin_memcpy(&r, &v, 4); return r; }
DEVI float bf_lo(unsigned w) { return __uint_as_float(w << 16); }
DEVI float bf_hi(unsigned w) { return __uint_as_float(w & 0xffff0000u); }
DEVI bf16x8 lds_ld128(lds_t* p) { return *(LAS bf16x8*)p; }
DEVI void lds_st128(lds_t* p, u32x4 v) { *(LAS u32x4*)p = v; }
DEVI float wave_sum(float v) {
#pragma unroll
    for (int o = 32; o >= 1; o >>= 1) v += __shfl_xor(v, o);
    return v;
}
DEVI float fexp2(float x) { return __builtin_amdgcn_exp2f(x); }
DEVI float frcp(float x) { return __builtin_amdgcn_rcpf(x); }
DEVI float silu_f(float x) { return x * frcp(1.0f + fexp2(-LOG2E * x)); }
DEVI float gelu_tanh_f(float x) {
    const float y = 0.7978845608028654f * (x + 0.044715f * x * x * x);
    const float e = fexp2((2.0f * LOG2E) * y);
    const float t = 1.0f - 2.0f * frcp(e + 1.0f);
    return 0.5f * x * (1.0f + t);
}
DEVI int cond_of_row(int row) { return row < NPR ? 0 : 1 + ((row - NPR) >> 10); }

struct Params {
    const float *x_prompt, *x_sample, *cache_ckv, *cache_kpe, *cache_k, *cache_v, *c, *c_ctx, *mod_w, *mod_b, *ln_gain, *ln_bias,
        *mla_w_in, *mla_q_gain, *mla_kv_gain, *mla_w_q_up, *mla_w_kv_up, *mla_w_out,
        *gm_w_in, *gm_v_gain, *gm_w_s, *gm_b_s, *gm_w_out, *swa_w_qkv, *swa_sink, *swa_w_out,
        *moe_router, *moe_w_gate, *moe_w_up, *moe_w_down;
    float* out;
    unsigned* bar;
    float *mod, *X0, *X1, *T, *Z, *GST, *AFF, *GATEV;
    bf16_t *H, *H2, *CQ, *CKV, *KPE, *Q, *KN, *VTP, *VTS, *O, *U, *GVT, *TT, *SK, *SVTP, *SVTS, *HID, *YE;
    bf16_t *WTI, *WTQ, *WTKV, *WTO, *WTGI, *WTGO, *WTSQ, *WTSO;
    int *SEL, *IDX;
    long long ph_lo, ph_hi;
};
constexpr size_t OUT_Y = 0;
constexpr size_t OUT_CKV = 8388608;
constexpr size_t OUT_KPE = OUT_CKV + 2097152;
constexpr size_t OUT_SK = OUT_KPE + 524288;
constexpr size_t OUT_SV = OUT_SK + 1048576;

DEVI const float* modp(const Params& p, int layer, int cnd, int which) { return p.mod + ((size_t)(layer * 5 + cnd) * 6 + which) * 1024; }

DEVI int swz(int row) { return ((row >> 1) & 7) ^ ((row >> 4) & 1); }
DEVI int img_off(int row, int chunk) { return row * 128 + ((chunk ^ swz(row)) << 4); }

template <int BM> struct XDma {
    static constexpr int NI = BM / 64;
    const bf16_t* base; unsigned off[NI];
    template <class RowFn> DEVI void init(const RowFn& rowfn, int tid) {
        const int w = tid >> 6, i = tid & 63;
        base = rowfn.base;
#pragma unroll
        for (int j = 0; j < NI; ++j) { const int row = 64 * j + 8 * w + (i >> 3); off[j] = rowfn.offset(row) + (((i & 7) ^ swz(row)) << 3); }
    }
    DEVI void issue(int kt, lds_t* img, int tid) const {
        lds_t* dst = img + (tid >> 6) * 1024 + (tid & 63) * 16;
#pragma unroll
        for (int j = 0; j < NI; ++j) __builtin_amdgcn_global_load_lds((const unsigned*)(base + off[j] + kt * 64), (LAS unsigned*)(dst + j * 8192), 16, 0, 0);
    }
};

struct WRegs {
    f32x4 r[8];
    DEVI void load(const float* p, size_t ldw, int kt) {
        const float* q = p + (size_t)kt * 64 * ldw;
#pragma unroll
        for (int i = 0; i < 8; ++i) r[i] = *(const f32x4*)(q + (size_t)i * ldw);
    }
    DEVI void store(lds_t* img, int wave, int lane) const {
#pragma unroll
        for (int c = 0; c < 4; ++c) {
            u32x4 v;
            v.x = pk_bf16(r[0][c], r[1][c]); v.y = pk_bf16(r[2][c], r[3][c]); v.z = pk_bf16(r[4][c], r[5][c]); v.w = pk_bf16(r[6][c], r[7][c]);
            lds_st128(img + img_off(4 * lane + c, wave), v);
        }
    }
};

template <int BM, bool TRANS>
DEVI void gemm_compute(lds_t* ximg, lds_t* wimg, f32x4 (&acc)[BM / 32][4], int wr, int wc, int lane) {
    constexpr int TM = BM / 32, NH = TM / 4, NSTEP = 2 * NH;
    const int r16 = lane & 15, g = lane >> 4;
    const int c0 = g ^ ((r16 >> 1) & 7);
    lds_t* xb = ximg + (wr * (BM / 2) + r16) * 128;
    lds_t* wb = wimg + (wc * 64 + r16) * 128;
    bf16x8 wf[2][4], xf[2][4];
#define LD_W(buf, s_) do { const int o0_ = ((c0 ^ (4 * (s_))) << 4), o1_ = ((c0 ^ (4 * (s_)) ^ 1) << 4); \
        _Pragma("unroll") for (int nb = 0; nb < 4; ++nb) wf[buf][nb] = lds_ld128(wb + nb * 2048 + ((nb & 1) ? o1_ : o0_)); } while (0)
#define LD_X(buf, s_, h_) do { const int o0_ = ((c0 ^ (4 * (s_))) << 4), o1_ = ((c0 ^ (4 * (s_)) ^ 1) << 4); \
        _Pragma("unroll") for (int m4 = 0; m4 < 4; ++m4) { const int mb_ = 4 * (h_) + m4; xf[buf][m4] = lds_ld128(xb + mb_ * 2048 + ((mb_ & 1) ? o1_ : o0_)); } } while (0)
    LD_W(0, 0); LD_X(0, 0, 0);
#pragma unroll
    for (int st = 0; st < NSTEP; ++st) {
        const int s = st / NH, h = st % NH;
        if (st + 1 < NSTEP) {
            const int s1 = (st + 1) / NH, h1 = (st + 1) % NH;
            if (s1 != s) LD_W(s1 & 1, s1);
            LD_X((st + 1) & 1, s1, h1);
        }
#pragma unroll
        for (int m4 = 0; m4 < 4; ++m4)
#pragma unroll
            for (int nb = 0; nb < 4; ++nb) {
                const int mb = 4 * h + m4;
                acc[mb][nb] = TRANS ? __builtin_amdgcn_mfma_f32_16x16x32_bf16(wf[s & 1][nb], xf[st & 1][m4], acc[mb][nb], 0, 0, 0)
                                    : __builtin_amdgcn_mfma_f32_16x16x32_bf16(xf[st & 1][m4], wf[s & 1][nb], acc[mb][nb], 0, 0, 0);
            }
        __builtin_amdgcn_sched_barrier(0);
    }
#undef LD_W
#undef LD_X
}

struct WLin { const float* base; DEVI const float* operator()(int lane) const { return base + 4 * lane; } };
template <int BM> struct GemmPipe {
    static constexpr int TM = BM / 32, STAGE = (BM + 256) * 128, NI = BM / 64;
    XDma<BM> xd; const float* wp; unsigned ldw; WRegs wr_; int par;
    template <class RowFn, class WFn> DEVI void prime(lds_t* lds, const RowFn& rf, const WFn& wf, unsigned ldw_, int tid_in) {
        const int tid = tid_in;
        const int lane = tid & 63, wave = tid >> 6;
        xd.init(rf, tid); ldw = ldw_; wp = wf(lane) + (size_t)(8 * wave) * ldw_; par = 0;
        wr_.load(wp, ldw, 0);
        __syncthreads();
        xd.issue(0, lds, tid); wr_.store(lds + BM * 128, wave, lane);
        wr_.load(wp, ldw, 1);
    }
    template <bool TRANS, bool XUNIT = true, class Epi, class RowFnN, class WFnN>
    DEVI void run(lds_t* lds, int nk, const Epi& epi, bool has_next_in, const RowFnN& rfn, const WFnN& wfn, unsigned ldw_n, int tid_in) {
        int tid = tid_in; asm volatile("" : "+v"(tid));
        const int lane = tid & 63, wave = tid >> 6, wrow = wave >> 2, wcol = wave & 3;
        const bool has_next = XUNIT && has_next_in;
        f32x4 acc[TM][4];
#pragma unroll
        for (int i = 0; i < TM; ++i)
#pragma unroll
            for (int j = 0; j < 4; ++j) acc[i][j] = (f32x4){0.f, 0.f, 0.f, 0.f};
        unsigned offn[NI];
        if (XUNIT) {
#pragma unroll
            for (int j = 0; j < NI; ++j) offn[j] = 0u;
        }
        for (int t = 0; t < nk; ++t) {
            asm volatile("s_waitcnt vmcnt(0)" ::: "memory");
            __syncthreads();
            lds_t* cur = lds + ((par + t) & 1) * STAGE;
            lds_t* nxt = lds + ((par + t + 1) & 1) * STAGE;
            if (t + 2 < nk) {
                xd.issue(t + 1, nxt, tid); wr_.store(nxt + BM * 128, wave, lane); wr_.load(wp, ldw, t + 2);
            } else if (t + 1 < nk) {
                xd.issue(t + 1, nxt, tid); wr_.store(nxt + BM * 128, wave, lane);
                if (has_next) {
                    ldw = ldw_n; wp = wfn(lane) + (size_t)(8 * wave) * ldw_n; wr_.load(wp, ldw, 0);
#pragma unroll
                    for (int j = 0; j < NI; ++j) { const int row = 64 * j + 8 * wave + (lane >> 3); offn[j] = rfn.offset(row) + (((lane & 7) ^ swz(row)) << 3); }
                }
            } else if (has_next) {
                xd.base = rfn.base;
#pragma unroll
                for (int j = 0; j < NI; ++j) xd.off[j] = offn[j];
                xd.issue(0, nxt, tid); wr_.store(nxt + BM * 128, wave, lane); wr_.load(wp, ldw, 1);
            }
            gemm_compute<BM, TRANS>(cur, cur + BM * 128, acc, wrow, wcol, lane);
        }
        par = (par + nk) & 1;
        { int t2 = tid; asm volatile("" : "+v"(t2));
          const int w2 = t2 >> 6; epi(acc, w2 >> 2, w2 & 3, t2 & 63); }
    }
};

template <int BM, bool TRANS, class RowFn, class WFn, class Epi>
DEVI void gemm_unit(lds_t* lds, const RowFn& rowfn, const WFn& wfn, unsigned ldw, int nk, const Epi& epi, int tid_in) {
    int tid = tid_in; asm volatile("" : "+v"(tid));
    constexpr int TM = BM / 32;
    constexpr int STAGE = (BM + 256) * 128;
    const int lane = tid & 63, wave = tid >> 6, wr = wave >> 2, wc = wave & 3;
    XDma<BM> xd; WRegs wl;
    const float* wp = wfn(lane) + (size_t)(8 * wave) * ldw;
    wl.load(wp, ldw, 0);
    xd.init(rowfn, tid);
    f32x4 acc[TM][4];
#pragma unroll
    for (int i = 0; i < TM; ++i)
#pragma unroll
        for (int j = 0; j < 4; ++j) acc[i][j] = (f32x4){0.f, 0.f, 0.f, 0.f};
    __syncthreads();
    xd.issue(0, lds, tid); wl.store(lds + BM * 128, wave, lane);
    if (nk > 1) wl.load(wp, ldw, 1);
    for (int t = 0; t < nk; ++t) {
        asm volatile("s_waitcnt vmcnt(0)" ::: "memory");
        __syncthreads();
        lds_t* cur = lds + (t & 1) * STAGE;
        lds_t* nxt = lds + ((t + 1) & 1) * STAGE;
        if (t + 1 < nk) {
            xd.issue(t + 1, nxt, tid); wl.store(nxt + BM * 128, wave, lane);
            if (t + 2 < nk) wl.load(wp, ldw, t + 2);
        }
        gemm_compute<BM, TRANS>(cur, cur + BM * 128, acc, wr, wc, lane);
    }
    { int t2 = tid; asm volatile("" : "+v"(t2));
      const int w2 = t2 >> 6; epi(acc, w2 >> 2, w2 & 3, t2 & 63); }
}

template <int BM, bool TRANS, class RowFn, class WRowFn, class Epi>
DEVI void gemm_unit_bb(lds_t* lds, const RowFn& rowfn, const WRowFn& wrowfn, int nk, const Epi& epi, int tid_in) {
    int tid = tid_in; asm volatile("" : "+v"(tid));
    constexpr int TM = BM / 32;
    constexpr int STAGE = (BM + 256) * 128;
    const int lane = tid & 63, wave = tid >> 6, wr = wave >> 2, wc = wave & 3;
    XDma<BM> xd; XDma<256> wd;
    xd.init(rowfn, tid); wd.init(wrowfn, tid);
    f32x4 acc[TM][4];
#pragma unroll
    for (int i = 0; i < TM; ++i)
#pragma unroll
        for (int j = 0; j < 4; ++j) acc[i][j] = (f32x4){0.f, 0.f, 0.f, 0.f};
    __syncthreads();
    xd.issue(0, lds, tid); wd.issue(0, lds + BM * 128, tid);
    for (int t = 0; t < nk; ++t) {
        asm volatile("s_waitcnt vmcnt(0)" ::: "memory");
        __syncthreads();
        lds_t* cur = lds + (t & 1) * STAGE;
        lds_t* nxt = lds + ((t + 1) & 1) * STAGE;
        if (t + 1 < nk) { xd.issue(t + 1, nxt, tid); wd.issue(t + 1, nxt + BM * 128, tid); }
        gemm_compute<BM, TRANS>(cur, cur + BM * 128, acc, wr, wc, lane);
    }
    { int t2 = tid; asm volatile("" : "+v"(t2));
      const int w2 = t2 >> 6; epi(acc, w2 >> 2, w2 & 3, t2 & 63); }
}

template <int BM, bool TRANS, class RowFn, class WRowFn, class Epi>
DEVI void gemm_unit_bb3(lds_t* lds, const RowFn& rowfn, const WRowFn& wrowfn, int nk, const Epi& epi, int tid_in) {
    int tid = tid_in; asm volatile("" : "+v"(tid));
    constexpr int TM = BM / 32;
    constexpr int STAGE = (BM + 256) * 128;
    static_assert(BM == 128, "3 stages fit for BM = 128 only; the counted wait below assumes 2 + 4 DMA instructions per tile");
    const int lane = tid & 63, wave = tid >> 6, wr = wave >> 2, wc = wave & 3;
    XDma<BM> xd; XDma<256> wd;
    xd.init(rowfn, tid); wd.init(wrowfn, tid);
    f32x4 acc[TM][4];
#pragma unroll
    for (int i = 0; i < TM; ++i)
#pragma unroll
        for (int j = 0; j < 4; ++j) acc[i][j] = (f32x4){0.f, 0.f, 0.f, 0.f};
    __syncthreads();
    lds_t* s0 = lds; lds_t* s1 = lds + STAGE; lds_t* s2 = lds + 2 * STAGE;
    xd.issue(0, s0, tid); wd.issue(0, s0 + BM * 128, tid);
    if (nk > 1) { xd.issue(1, s1, tid); wd.issue(1, s1 + BM * 128, tid); }
    for (int t = 0; t < nk; ++t) {
        if (t + 1 < nk) asm volatile("s_waitcnt vmcnt(6)" ::: "memory");
        else asm volatile("s_waitcnt vmcnt(0)" ::: "memory");
        asm volatile("s_waitcnt lgkmcnt(0)" ::: "memory");
        __builtin_amdgcn_s_barrier();
        asm volatile("" ::: "memory");
        if (t + 2 < nk) { xd.issue(t + 2, s2, tid); wd.issue(t + 2, s2 + BM * 128, tid); }
        gemm_compute<BM, TRANS>(s0, s0 + BM * 128, acc, wr, wc, lane);
        lds_t* tmp = s0; s0 = s1; s1 = s2; s2 = tmp;
    }
    __syncthreads();
    { int t2 = tid; asm volatile("" : "+v"(t2));
      const int w2 = t2 >> 6; epi(acc, w2 >> 2, w2 & 3, t2 & 63); }
}

DEVI int swz32(int row) { return ((((row >> 2) ^ (row >> 3)) & 1) << 1) | ((row >> 2) & 1); }
template <int BM> struct XDma32 {
    static constexpr int NI = BM / 128;
    const bf16_t* base; unsigned off[NI];
    template <class RowFn> DEVI void init(const RowFn& rowfn, int tid) {
        const int w = tid >> 6, i = tid & 63;
        base = rowfn.base;
#pragma unroll
        for (int j = 0; j < NI; ++j) { const int row = 128 * j + 16 * w + (i >> 2); off[j] = rowfn.offset(row) + (((i & 3) ^ swz32(row)) << 3); }
    }
    DEVI void issue(int kt32, lds_t* img, int tid) const {
        lds_t* dst = img + (tid >> 6) * 1024 + (tid & 63) * 16;
#pragma unroll
        for (int j = 0; j < NI; ++j) __builtin_amdgcn_global_load_lds((const unsigned*)(base + off[j] + kt32 * 32), (LAS unsigned*)(dst + j * 8192), 16, 0, 0);
    }
};
template <int BM, bool TRANS>
DEVI void gemm_compute32(lds_t* ximg, lds_t* wimg, f32x4 (&acc)[BM / 32][4], int wr, int wc, int lane) {
    constexpr int TM = BM / 32;
    const int r16 = lane & 15, g = lane >> 4;
    const int c0 = (g ^ swz32(r16)) << 4;
    lds_t* xb = ximg + (wr * (BM / 2) + r16) * 64 + c0;
    lds_t* wb = wimg + (wc * 64 + r16) * 64 + c0;
    bf16x8 wf[4], xf[TM];
#pragma unroll
    for (int nb = 0; nb < 4; ++nb) wf[nb] = lds_ld128(wb + nb * 1024);
#pragma unroll
    for (int mb = 0; mb < TM; ++mb) xf[mb] = lds_ld128(xb + mb * 1024);
#pragma unroll
    for (int mb = 0; mb < TM; ++mb)
#pragma unroll
        for (int nb = 0; nb < 4; ++nb)
            acc[mb][nb] = TRANS ? __builtin_amdgcn_mfma_f32_16x16x32_bf16(wf[nb], xf[mb], acc[mb][nb], 0, 0, 0)
                                : __builtin_amdgcn_mfma_f32_16x16x32_bf16(xf[mb], wf[nb], acc[mb][nb], 0, 0, 0);
}
template <int BM, bool TRANS, class RowFn, class WRowFn, class Epi>
DEVI void gemm_unit_bb4(lds_t* lds, const RowFn& rowfn, const WRowFn& wrowfn, int nk2  , const Epi& epi, int tid_in) {
    int tid = tid_in; asm volatile("" : "+v"(tid));
    constexpr int TM = BM / 32;
    constexpr int XB = BM * 64, STAGE = XB + 256 * 64;
    static_assert(BM == 256, "the counted waits below assume 2 + 2 DMA instructions per sub-tile");
    const int lane = tid & 63, wave = tid >> 6, wr = wave >> 2, wc = wave & 3;
    XDma32<BM> xd; XDma32<256> wd;
    xd.init(rowfn, tid); wd.init(wrowfn, tid);
    f32x4 acc[TM][4];
#pragma unroll
    for (int i = 0; i < TM; ++i)
#pragma unroll
        for (int j = 0; j < 4; ++j) acc[i][j] = (f32x4){0.f, 0.f, 0.f, 0.f};
    __syncthreads();
#pragma unroll
    for (int t = 0; t < 3; ++t) if (t < nk2) { xd.issue(t, lds + t * STAGE, tid); wd.issue(t, lds + t * STAGE + XB, tid); }
    for (int t = 0; t < nk2; ++t) {
        const int rem = nk2 - 1 - t;
        if (rem >= 2) asm volatile("s_waitcnt vmcnt(8)" ::: "memory");
        else if (rem == 1) asm volatile("s_waitcnt vmcnt(4)" ::: "memory");
        else asm volatile("s_waitcnt vmcnt(0)" ::: "memory");
        asm volatile("s_waitcnt lgkmcnt(0)" ::: "memory");
        __builtin_amdgcn_s_barrier();
        asm volatile("" ::: "memory");
        if (t + 3 < nk2) { lds_t* st = lds + ((t + 3) & 3) * STAGE; xd.issue(t + 3, st, tid); wd.issue(t + 3, st + XB, tid); }
        lds_t* cur = lds + (t & 3) * STAGE;
        gemm_compute32<BM, TRANS>(cur, cur + XB, acc, wr, wc, lane);
    }
    __syncthreads();
    { int t2 = tid; asm volatile("" : "+v"(t2));
      const int w2 = t2 >> 6; epi(acc, w2 >> 2, w2 & 3, t2 & 63); }
}

namespace pg8 {
constexpr int BM = 256, BK = 64, HALF = 128, HTB = HALF * BK * 2  , STAGE_BYTES = 8 * HTB;
DEVI int lds_byte(int r, int c) { const int st = (r >> 4) * 2 + (c >> 5), rr = r & 15, cc = c & 31, ob = rr * 64 + cc * 2; return st * 1024 + (ob ^ (((ob >> 9) & 1) << 5)); }
DEVI void stage_rc(int b, int& R, int& C) { const int st = b / 1024, sb = b % 1024, swz = sb ^ (((sb >> 9) & 1) << 5); R = (st >> 1) * 16 + swz / 64; C = (st & 1) * 32 + (swz % 64) / 2; }
DEVI int perm32(int rho) { const int n = rho >> 4, i = rho & 15; return 8 * (i >> 2) + 4 * n + (i & 3); }
struct Unit { int pm, pn, aux; };

template <class Epi, class Sched>
DEVI void gemm_phase(lds_t* lds, const int ldk  , const int nt  , const Sched& S, const Epi& E, const int tid) {
    const int wid = __builtin_amdgcn_readfirstlane(tid >> 6), lane = tid & 63, wr = wid >> 2, wc = wid & 3, fr = lane & 15, fq = lane >> 4;
    unsigned voffA[2], voffB[2];
#pragma unroll
    for (int i = 0; i < 2; ++i) { int R, C; stage_rc(tid * 16 + i * 8192, R, C); const int Rb = Epi::PERM ? ((R & ~31) + perm32(R & 31)) : R;
        voffA[i] = (unsigned)(R * ldk + C) * 2u; voffB[i] = (unsigned)(Rb * ldk + C) * 2u; }
    const size_t kstep = (size_t)(BK * 2);
    const size_t hstep = (size_t)HALF * ldk * 2;
    const unsigned ldsw = (unsigned)wid * 1024u;
    const int aoff = lds_byte(wr * 64 + fr, fq * 8), boff = lds_byte(wc * 32 + fr, fq * 8);
#define PG8_SA(b, h) (((b) * 2 + (h)) * HTB)
#define PG8_SB(b, h) ((4 + (b) * 2 + (h)) * HTB)
#define PG8_STAGE(bufoff, gbase, voff) do { _Pragma("unroll") for (int _i = 0; _i < 2; ++_i) \
        __builtin_amdgcn_global_load_lds((const unsigned*)((const char*)(gbase) + (voff)[_i]), (LAS unsigned*)(lds + (bufoff) + ldsw + _i * 8192), 16, 0, 0); } while (0)
#define PG8_LDA(dst, b, h) do { _Pragma("unroll") for (int m = 0; m < 4; ++m) _Pragma("unroll") for (int k = 0; k < 2; ++k) dst[m][k] = *(const LAS bf16x8*)(lds + PG8_SA(b, h) + aoff + m * 2048 + k * 1024); } while (0)
#define PG8_LDB(dst, b, h) do { _Pragma("unroll") for (int n = 0; n < 2; ++n) _Pragma("unroll") for (int k = 0; k < 2; ++k) dst[n][k] = *(const LAS bf16x8*)(lds + PG8_SB(b, h) + boff + n * 2048 + k * 1024); } while (0)
#define PG8_MMA(ai, bj, At, Bt) do { __builtin_amdgcn_s_setprio(1); _Pragma("unroll") for (int m = 0; m < 4; ++m) _Pragma("unroll") for (int n = 0; n < 2; ++n) _Pragma("unroll") for (int k = 0; k < 2; ++k) \
        acc[ai][bj][m][n] = __builtin_amdgcn_mfma_f32_16x16x32_bf16(Bt[n][k], At[m][k], acc[ai][bj][m][n], 0, 0, 0); __builtin_amdgcn_s_setprio(0); } while (0)
#define PG8_WAIT_V(n) asm volatile("s_waitcnt vmcnt(" #n ")" ::: "memory")
#define PG8_WAIT_L(n) asm volatile("s_waitcnt lgkmcnt(" #n ")" ::: "memory")
#define PG8_BAR __builtin_amdgcn_s_barrier()
#define PG8_SCHED __builtin_amdgcn_sched_barrier(0)
    Unit cur, nxt; int ui = 0;
    __syncthreads();
    if (!S.next(0, cur)) return;
    f32x4 acc[2][2][4][2];
#pragma unroll
    for (int a = 0; a < 2; ++a)
#pragma unroll
        for (int b = 0; b < 2; ++b)
#pragma unroll
            for (int m = 0; m < 4; ++m)
#pragma unroll
                for (int n = 0; n < 2; ++n) acc[a][b][m][n] = (f32x4){0.f, 0.f, 0.f, 0.f};
    bf16x8 At[4][2], B0[2][2], B1[2][2];
    const char* cA; const char* cB;
    S.ptrs(cur, cA, cB);
    PG8_STAGE(PG8_SB(0, 0), cB, voffB); PG8_STAGE(PG8_SA(0, 0), cA, voffA); PG8_STAGE(PG8_SB(0, 1), cB + hstep, voffB); PG8_STAGE(PG8_SA(0, 1), cA + hstep, voffA);
    if (wr == 1) PG8_BAR;
    PG8_WAIT_V(4); PG8_BAR;
    PG8_STAGE(PG8_SB(1, 0), cB + kstep, voffB); PG8_STAGE(PG8_SA(1, 0), cA + kstep, voffA); PG8_STAGE(PG8_SB(1, 1), cB + hstep + kstep, voffB);
    PG8_WAIT_V(6); PG8_BAR;
    for (;;) {
        const bool has_next = S.next(ui + 1, nxt);
        const char* nA = cA; const char* nB = cB;
        if (has_next) S.ptrs(nxt, nA, nB);
        for (int t = 0; t < nt; t += 2) {
            const bool last = (t == nt - 2);
            const char* a1 = cA + (size_t)(t + 1) * kstep;
            const char* a2 = last ? nA : cA + (size_t)(t + 2) * kstep; const char* b2 = last ? nB : cB + (size_t)(t + 2) * kstep;
            const char* a3 = a2 + kstep; const char* b3 = b2 + kstep;
            PG8_LDB(B0, 0, 0); PG8_SCHED; PG8_LDA(At, 0, 0); PG8_STAGE(PG8_SA(1, 1), a1 + hstep, voffA);
            PG8_WAIT_L(8); PG8_BAR; PG8_WAIT_L(0); PG8_MMA(0, 0, At, B0); PG8_BAR; PG8_SCHED;
            PG8_LDB(B1, 0, 1); PG8_STAGE(PG8_SB(0, 0), b2, voffB);
            PG8_BAR; PG8_WAIT_L(0); PG8_MMA(0, 1, At, B1); PG8_BAR;
            PG8_LDA(At, 0, 1); PG8_STAGE(PG8_SA(0, 0), a2, voffA);
            PG8_BAR; PG8_WAIT_L(0); PG8_MMA(1, 0, At, B0); PG8_BAR; PG8_SCHED;
            PG8_STAGE(PG8_SB(0, 1), b2 + hstep, voffB);
            PG8_WAIT_V(6); PG8_BAR; PG8_MMA(1, 1, At, B1); PG8_BAR;
            PG8_LDB(B0, 1, 0); PG8_SCHED; PG8_LDA(At, 1, 0); PG8_STAGE(PG8_SA(0, 1), a2 + hstep, voffA);
            PG8_WAIT_L(8); PG8_BAR; PG8_WAIT_L(0); PG8_MMA(0, 0, At, B0); PG8_BAR; PG8_SCHED;
            PG8_LDB(B1, 1, 1); PG8_STAGE(PG8_SB(1, 0), b3, voffB);
            PG8_BAR; PG8_WAIT_L(0); PG8_MMA(0, 1, At, B1); PG8_BAR;
            PG8_LDA(At, 1, 1); PG8_STAGE(PG8_SA(1, 0), a3, voffA);
            PG8_BAR; PG8_WAIT_L(0); PG8_MMA(1, 0, At, B0); PG8_BAR; PG8_SCHED;
            PG8_STAGE(PG8_SB(1, 1), b3 + hstep, voffB);
            PG8_WAIT_V(6); PG8_BAR; PG8_MMA(1, 1, At, B1); PG8_BAR;
        }
        E(acc, cur, wr, wc, fr, fq);
        if (!has_next) break;
#pragma unroll
        for (int a = 0; a < 2; ++a)
#pragma unroll
            for (int b = 0; b < 2; ++b)
#pragma unroll
                for (int m = 0; m < 4; ++m)
#pragma unroll
                    for (int n = 0; n < 2; ++n) acc[a][b][m][n] = (f32x4){0.f, 0.f, 0.f, 0.f};
        cur = nxt; cA = nA; cB = nB; ++ui;
    }
    PG8_WAIT_V(0);
    if (wr == 0) PG8_BAR;
    PG8_BAR;
#undef PG8_SA
#undef PG8_SB
#undef PG8_STAGE
#undef PG8_LDA
#undef PG8_LDB
#undef PG8_MMA
#undef PG8_WAIT_V
#undef PG8_WAIT_L
#undef PG8_BAR
#undef PG8_SCHED
}
}

DEVI void phase_modulation(const Params& p, lds_t* lds, int bid, int nblk, int tid) {
    LAS float* sc = (LAS float*)lds;
    LAS float* red = (LAS float*)(lds + 20480);
    __syncthreads();
    for (int i = tid; i < 5 * 1024; i += NTHREADS) {
        const int cnd = i >> 10, k = i & 1023;
        const float v = cnd == 0 ? p.c_ctx[k] : p.c[(cnd - 1) * 1024 + k];
        sc[i] = silu_f(v);
    }
    __syncthreads();
    const int cg = tid & 31, kg = tid >> 5;
    for (int u = bid; u < DEPTH * 48; u += nblk) {
        const int l = u / 48, n0 = (u % 48) * 128;
        const float* w = p.mod_w + (size_t)l * 1024 * 6144 + n0 + 4 * cg;
        f32x4 a[5];
#pragma unroll
        for (int c = 0; c < 5; ++c) a[c] = (f32x4){0.f, 0.f, 0.f, 0.f};
#pragma unroll 8
        for (int kk = 0; kk < 64; ++kk) {
            const int k = kg * 64 + kk;
            const f32x4 wv = *(const f32x4*)(w + (size_t)k * 6144);
#pragma unroll
            for (int c = 0; c < 5; ++c) a[c] += wv * sc[c * 1024 + k];
        }
#pragma unroll
        for (int c = 0; c < 5; ++c) *(LAS f32x4*)(red + (kg * 5 + c) * 128 + 4 * cg) = a[c];
        __syncthreads();
        for (int i = tid; i < 5 * 128; i += NTHREADS) {
            const int c = i >> 7, n = i & 127;
            float s = 0.f;
#pragma unroll
            for (int q = 0; q < 16; ++q) s += red[(q * 5 + c) * 128 + n];
            p.mod[(size_t)(l * 5 + c) * 6144 + n0 + n] = s + p.mod_b[l * 6144 + n0 + n];
        }
        __syncthreads();
    }
}


DEVI void wconv_tile(const float* W, bf16_t* Wt, int K, int N, int tk, int tn, lds_t* lds, int tid) {
    LAS bf16_t* s = (LAS bf16_t*)lds;
    __syncthreads();
#pragma unroll
    for (int i = 0; i < 2; ++i) {
        const int c = tid + NTHREADS * i, k = c >> 4, n4 = (c & 15) * 4;
        const f32x4 v = *(const f32x4*)(W + (size_t)(tk * 64 + k) * N + tn * 64 + n4);
#pragma unroll
        for (int q = 0; q < 4; ++q) s[(n4 + q) * 72 + k] = (bf16_t)(pk_bf16(v[q], 0.f) & 0xffffu);
    }
    __syncthreads();
    { const int n = tid >> 3, kc = tid & 7;
      const u32x4 v = *(LAS u32x4*)(s + n * 72 + kc * 8);
      *(u32x4*)(Wt + (size_t)(tn * 64 + n) * K + tk * 64 + kc * 8) = v; }
}
DEVI void phase_wconv(const Params& p, lds_t* lds, int bid, int nblk, int tid) {
    for (int it = bid; it < 4352; it += nblk) {
        int r = it; const float* W; bf16_t* Wt; int K, N;
        if (r < 352) { const int j = r / 176; r %= 176; W = p.mla_w_in + (size_t)j * 1024 * 704; Wt = p.WTI + (size_t)j * 704 * 1024; K = 1024; N = 704; }
        else if ((r -= 352) < 288) { const int j = r / 144; r %= 144; W = p.mla_w_q_up + (size_t)j * 384 * 1536; Wt = p.WTQ + (size_t)j * 1536 * 384; K = 384; N = 1536; }
        else if ((r -= 288) < 256) { const int j = r / 128; r %= 128; W = p.mla_w_kv_up + (size_t)j * 256 * 2048; Wt = p.WTKV + (size_t)j * 2048 * 256; K = 256; N = 2048; }
        else if ((r -= 256) < 512) { const int j = r / 256; r %= 256; W = p.mla_w_out + (size_t)j * 1024 * 1024; Wt = p.WTO + (size_t)j * 1024 * 1024; K = 1024; N = 1024; }
        else if ((r -= 512) < 1536) { W = p.gm_w_in; Wt = p.WTGI; K = 1024; N = 6144; }
        else if ((r -= 1536) < 768) { W = p.gm_w_out; Wt = p.WTGO; K = 3072; N = 1024; }
        else if ((r -= 768) < 384) { W = p.swa_w_qkv; Wt = p.WTSQ; K = 1024; N = 1536; }
        else { r -= 384; W = p.swa_w_out; Wt = p.WTSO; K = 1024; N = 1024; }
        const int ntn = N / 64;
        wconv_tile(W, Wt, K, N, r / ntn, r % ntn, lds, tid);
    }
}

DEVI void phase_prep(const Params& p, int bid, int nblk, int tid) {
    const int lane = tid & 63, wave = tid >> 6;
    for (int row = bid * 8 + wave; row < NTOK; row += nblk * 8) {
        const float* src = row < NPR ? p.x_prompt + (size_t)row * D : p.x_sample + (size_t)(row - NPR) * D;
        const int cnd = cond_of_row(row);
        const float* sh = modp(p, 0, cnd, 0); const float* scl = modp(p, 0, cnd, 1);
#pragma unroll
        for (int i = 0; i < 4; ++i) {
            const int col = lane * 4 + 256 * i;
            const f32x4 v = *(const f32x4*)(src + col);
            const f32x4 s = *(const f32x4*)(scl + col), b = *(const f32x4*)(sh + col);
            const f32x4 h = v * (s + 1.0f) + b;
            u32x2 o; o.x = pk_bf16(h[0], h[1]); o.y = pk_bf16(h[2], h[3]);
            *(u32x2*)(p.H + (size_t)row * D + col) = o;
        }
    }
    for (int i = bid * NTHREADS + tid; i < 1024 * 64; i += nblk * NTHREADS) {
        const f32x4 v = *(const f32x4*)(p.cache_k + (size_t)i * 4);
        u32x2 o; o.x = pk_bf16(v[0], v[1]); o.y = pk_bf16(v[2], v[3]);
        *(u32x2*)(p.SK + (size_t)NTOK * 256 + (size_t)i * 4) = o;
    }
    for (int i = bid * NTHREADS + tid; i < 4 * 4 * 64 * 64; i += nblk * NTHREADS) {
        const int kg4 = i & 63, dv = (i >> 6) & 63, kvh = (i >> 12) & 3, b = i >> 14;
        float v[4];
#pragma unroll
        for (int q = 0; q < 4; ++q) v[q] = p.cache_v[((size_t)(b * 256 + kg4 * 4 + q) * 4 + kvh) * 64 + dv];
        u32x2 o; o.x = pk_bf16(v[0], v[1]); o.y = pk_bf16(v[2], v[3]);
        *(u32x2*)(p.SVTS + ((size_t)(b * 4 + kvh) * 64 + dv) * 1280 + kg4 * 4) = o;
    }
}

DEVI void phase_mla_norm(const Params& p, int j, int bid, int nblk, int tid) {
    const int lane = tid & 63, wave = tid >> 6;
    const float* qg = p.mla_q_gain + j * 384; const float* kg = p.mla_kv_gain + j * 256;
    for (int row = bid * 8 + wave; row < NROWS_KV; row += nblk * 8) {
        if (row >= NTOK) {
            const int b = (row - NTOK) >> 8, t = (row - NTOK) & 255;
            const float* ck = p.cache_ckv + ((size_t)(b * 2 + j) * 256 + t) * 256;
            const f32x4 v = *(const f32x4*)(ck + lane * 4);
            u32x2 o; o.x = pk_bf16(v[0], v[1]); o.y = pk_bf16(v[2], v[3]);
            *(u32x2*)(p.CKV + (size_t)row * 256 + lane * 4) = o;
            const float kp = p.cache_kpe[((size_t)(b * 2 + j) * 256 + t) * 64 + lane];
            p.KPE[(size_t)row * 64 + lane] = (bf16_t)(pk_bf16(kp, 0.f) & 0xffffu);
            continue;
        }
        const float* z = p.Z + (size_t)row * 704;
        float q[6]; float ss = 0.f;
#pragma unroll
        for (int i = 0; i < 6; ++i) { q[i] = z[lane + 64 * i]; ss += q[i] * q[i]; }
        ss = wave_sum(ss);
        const float rq = rsqrtf(ss * (1.0f / 384.0f) + EPS_F);
#pragma unroll
        for (int i = 0; i < 6; ++i) p.CQ[(size_t)row * 384 + lane + 64 * i] = (bf16_t)(pk_bf16(q[i] * rq * qg[lane + 64 * i], 0.f) & 0xffffu);
        const f32x4 kv = *(const f32x4*)(z + 384 + lane * 4);
        float s2 = kv[0] * kv[0] + kv[1] * kv[1] + kv[2] * kv[2] + kv[3] * kv[3];
        s2 = wave_sum(s2);
        const float rk = rsqrtf(s2 * (1.0f / 256.0f) + EPS_F);
        const f32x4 gv = *(const f32x4*)(kg + lane * 4);
        const f32x4 kn = kv * rk * gv;
        { u32x2 o; o.x = pk_bf16(kn[0], kn[1]); o.y = pk_bf16(kn[2], kn[3]); *(u32x2*)(p.CKV + (size_t)row * 256 + lane * 4) = o; }
        float kp = z[640 + lane];
        if (row < NPR) {
            const int b = row >> 8, t = row & 255;
            *(f32x4*)(p.out + OUT_CKV + ((size_t)(b * 2 + j) * 256 + t) * 256 + lane * 4) = kn;
            p.out[OUT_KPE + ((size_t)(b * 2 + j) * 256 + t) * 64 + lane] = kp;
        } else {
            const int t = (row - NPR) & 1023;
            const int pos = lane < 32 ? (t >> 6) : (t & 63);
            const float cs = rope_tab[(pos * 16 + (lane & 15)) * 2], sn = rope_tab[(pos * 16 + (lane & 15)) * 2 + 1];
            const float other = __shfl_xor(kp, 16);
            kp = (lane & 16) ? (kp * cs + other * sn) : (kp * cs - other * sn);
        }
        p.KPE[(size_t)row * 64 + lane] = (bf16_t)(pk_bf16(kp, 0.f) & 0xffffu);
    }
}

DEVI void phase_ln_a(const Params& p, int layer, lds_t* lds, int bid, int nblk, int tid) {
    const int lane = tid & 63, wave = tid >> 6;
    LAS float* rt = (LAS float*)lds;
    const float* router = p.moe_router + (size_t)layer * 1024 * 16;
    __syncthreads();
    for (int i = tid; i < 4096; i += NTHREADS) {
        const f32x4 w = *(const f32x4*)(router + i * 4);
        const int k = i >> 2, e0 = (i & 3) * 4;
        rt[(e0 + 0) * 1024 + k] = w[0]; rt[(e0 + 1) * 1024 + k] = w[1]; rt[(e0 + 2) * 1024 + k] = w[2]; rt[(e0 + 3) * 1024 + k] = w[3];
    }
    __syncthreads();
    const float* lg = p.ln_gain + (layer * 2 + 0) * 1024; const float* lb = p.ln_bias + (layer * 2 + 0) * 1024;
    for (int r0 = (bid * 8 + wave) * 4; r0 < NTOK; r0 += nblk * 32) {
        const int cnd = cond_of_row(r0);
        const float* sh = modp(p, layer, cnd, 3); const float* scl = modp(p, layer, cnd, 4);
        f32x4 v[4][4];
        float mu[4], rs[4];
#pragma unroll
        for (int j = 0; j < 4; ++j)
#pragma unroll
            for (int i = 0; i < 4; ++i) v[j][i] = *(const f32x4*)(p.T + (size_t)(r0 + j) * D + lane * 4 + 256 * i);
#pragma unroll
        for (int j = 0; j < 4; ++j) { float s = 0.f;
#pragma unroll
            for (int i = 0; i < 4; ++i) s += (v[j][i][0] + v[j][i][1]) + (v[j][i][2] + v[j][i][3]);
            mu[j] = s; }
#pragma unroll
        for (int j = 0; j < 4; ++j) mu[j] = wave_sum(mu[j]) * (1.0f / 1024.0f);
#pragma unroll
        for (int j = 0; j < 4; ++j) { float q = 0.f;
#pragma unroll
            for (int i = 0; i < 4; ++i) { v[j][i] = v[j][i] - mu[j]; q += (v[j][i][0] * v[j][i][0] + v[j][i][1] * v[j][i][1]) + (v[j][i][2] * v[j][i][2] + v[j][i][3] * v[j][i][3]); }
            rs[j] = q; }
#pragma unroll
        for (int j = 0; j < 4; ++j) rs[j] = rsqrtf(wave_sum(rs[j]) * (1.0f / 1024.0f) + EPS_F);
        float lgt[4][16];
#pragma unroll
        for (int j = 0; j < 4; ++j)
#pragma unroll
            for (int e = 0; e < 16; ++e) lgt[j][e] = 0.f;
#pragma unroll
        for (int i = 0; i < 4; ++i) {
            const int col = lane * 4 + 256 * i;
            const f32x4 g4 = *(const f32x4*)(lg + col), b4 = *(const f32x4*)(lb + col), sc4 = *(const f32x4*)(scl + col) + 1.0f, sh4 = *(const f32x4*)(sh + col);
            f32x4 h[4];
#pragma unroll
            for (int j = 0; j < 4; ++j) {
                const f32x4 x = v[j][i] * rs[j] * g4 + b4;
                *(f32x4*)(p.X1 + (size_t)(r0 + j) * D + col) = x;
                h[j] = x * sc4 + sh4;
                u32x2 o; o.x = pk_bf16(h[j][0], h[j][1]); o.y = pk_bf16(h[j][2], h[j][3]);
                *(u32x2*)(p.H2 + (size_t)(r0 + j) * D + col) = o;
            }
#pragma unroll
            for (int e = 0; e < 16; ++e) {
                const f32x4 rw = *(LAS f32x4*)(rt + e * 1024 + col);
#pragma unroll
                for (int j = 0; j < 4; ++j) lgt[j][e] += (h[j][0] * rw[0] + h[j][1] * rw[1]) + (h[j][2] * rw[2] + h[j][3] * rw[3]);
                if ((e & 3) == 3) __builtin_amdgcn_sched_barrier(0);
            }
        }
        float r1[4];
#pragma unroll
        for (int j = 0; j < 4; ++j) {
            float r8[8], r4[4], r2[2];
            { const bool hi = (lane & 32) != 0;
#pragma unroll
              for (int i = 0; i < 8; ++i) { const float keep = hi ? lgt[j][8 + i] : lgt[j][i], send = hi ? lgt[j][i] : lgt[j][8 + i]; r8[i] = keep + __shfl_xor(send, 32); } }
            { const bool hi = (lane & 16) != 0;
#pragma unroll
              for (int i = 0; i < 4; ++i) { const float keep = hi ? r8[4 + i] : r8[i], send = hi ? r8[i] : r8[4 + i]; r4[i] = keep + __shfl_xor(send, 16); } }
            { const bool hi = (lane & 8) != 0;
#pragma unroll
              for (int i = 0; i < 2; ++i) { const float keep = hi ? r4[2 + i] : r4[i], send = hi ? r4[i] : r4[2 + i]; r2[i] = keep + __shfl_xor(send, 8); } }
            { const bool hi = (lane & 4) != 0; const float keep = hi ? r2[1] : r2[0], send = hi ? r2[0] : r2[1]; r1[j] = keep + __shfl_xor(send, 4); }
        }
        const int e = ((lane >> 5) & 1) * 8 + ((lane >> 4) & 1) * 4 + ((lane >> 3) & 1) * 2 + ((lane >> 2) & 1);
#pragma unroll
        for (int j = 0; j < 4; ++j) {
            float r = r1[j];
            r += __shfl_xor(r, 2); r += __shfl_xor(r, 1);
            float mx = r;
            mx = fmaxf(mx, __shfl_xor(mx, 4)); mx = fmaxf(mx, __shfl_xor(mx, 8)); mx = fmaxf(mx, __shfl_xor(mx, 16)); mx = fmaxf(mx, __shfl_xor(mx, 32));
            const float ex = __expf(r - mx);
            float den = ex;
            den += __shfl_xor(den, 4); den += __shfl_xor(den, 8); den += __shfl_xor(den, 16); den += __shfl_xor(den, 32);
            if ((lane & 3) == 0) p.AFF[(size_t)e * NTOK + r0 + j] = ex / den;
        }
    }
}

DEVI int block_sum_i(int v, LAS int* red, int tid) {
    const int lane = tid & 63, wave = tid >> 6;
    v = __builtin_popcountll(__ballot(v & 1)) + 2 * __builtin_popcountll(__ballot(v & 2)) + 4 * __builtin_popcountll(__ballot(v & 4)) + 8 * __builtin_popcountll(__ballot(v & 8));
    __syncthreads();
    if (lane == 0) red[wave] = v;
    __syncthreads();
    return (red[0] + red[1]) + (red[2] + red[3]) + (red[4] + red[5]) + (red[6] + red[7]);
}
DEVI int block_excl_scan_i(int v, LAS int* red, int tid, int& total) {
    const int lane = tid & 63, wave = tid >> 6;
    int inc = v;
#pragma unroll
    for (int o = 1; o < 64; o <<= 1) { const int t = __shfl_up(inc, o); if (lane >= o) inc += t; }
    __syncthreads();
    if (lane == 63) red[wave] = inc;
    __syncthreads();
    int base = 0, tot = 0;
#pragma unroll
    for (int w = 0; w < 8; ++w) { const int c = red[w]; if (w < wave) base += c; tot += c; }
    total = tot;
    return base + inc - v;
}
DEVI void phase_topk(const Params& p, lds_t* lds, int bid, int nblk, int tid) {
    LAS int* red = (LAS int*)lds;
    for (int it = bid; it < 32; it += nblk) {
        const int grp = it >> 4, e = it & 15;
        const float* a = p.AFF + (size_t)e * NTOK + grp * 4096 + tid * 8;
        const f32x4 a0 = *(const f32x4*)a, a1 = *(const f32x4*)(a + 4);
        unsigned key[8];
#pragma unroll
        for (int i = 0; i < 4; ++i) { key[i] = __float_as_uint(a0[i]); key[4 + i] = __float_as_uint(a1[i]); }
        unsigned thr = 0u;
        for (int bit = 30; bit >= 0; --bit) {
            const unsigned cand = thr | (1u << bit);
            int c = 0;
#pragma unroll
            for (int i = 0; i < 8; ++i) c += key[i] >= cand ? 1 : 0;
            if (block_sum_i(c, red, tid) >= 512) thr = cand;
        }
        int cgt = 0, ceq = 0;
#pragma unroll
        for (int i = 0; i < 8; ++i) { cgt += key[i] > thr ? 1 : 0; ceq += key[i] == thr ? 1 : 0; }
        int ngt, neq;
        (void)block_excl_scan_i(cgt, red, tid, ngt);
        int tie_rank = block_excl_scan_i(ceq, red, tid, neq);
        const int need = 512 - ngt;
        int sel[8], cs = 0;
#pragma unroll
        for (int i = 0; i < 8; ++i) {
            const bool eq = key[i] == thr;
            sel[i] = (key[i] > thr || (eq && tie_rank < need)) ? 1 : 0;
            tie_rank += eq ? 1 : 0; cs += sel[i];
        }
        int tot;
        int slot = block_excl_scan_i(cs, red, tid, tot);
#pragma unroll
        for (int i = 0; i < 8; ++i) {
            const int t = grp * 4096 + tid * 8 + i;
            int sl = -1;
            if (sel[i]) { sl = grp * 512 + slot; ++slot; p.IDX[e * 1024 + sl] = t; p.GATEV[e * 1024 + sl] = __uint_as_float(key[i]); }
            p.SEL[(size_t)t * 16 + e] = sl;
        }
    }
}

DEVI void phase_ln_b(const Params& p, int layer, int bid, int nblk, int tid) {
    const int lane = tid & 63, wave = tid >> 6;
    const float* lg = p.ln_gain + (layer * 2 + 1) * 1024; const float* lb = p.ln_bias + (layer * 2 + 1) * 1024;
    const bool last = (layer == DEPTH - 1);
    float* xo = last ? p.out + OUT_Y : p.X0;
    const int stride = nblk * 8;
    int row = bid * 8 + wave;
    int seln = -1; f32x4 xn[4];
    if (row < NTOK) {
        if (lane < 16) seln = p.SEL[(size_t)row * 16 + lane];
#pragma unroll
        for (int i = 0; i < 4; ++i) xn[i] = *(const f32x4*)(p.X1 + (size_t)row * D + lane * 4 + 256 * i);
    }
    for (; row < NTOK; row += stride) {
        const int selv = seln;
        f32x4 v[4];
#pragma unroll
        for (int i = 0; i < 4; ++i) v[i] = xn[i];
        unsigned long long mask = __ballot(selv >= 0);
        f32x4 y[4];
#pragma unroll
        for (int i = 0; i < 4; ++i) y[i] = (f32x4){0.f, 0.f, 0.f, 0.f};
        while (mask) {
            const int e0 = __builtin_ctzll(mask); mask &= mask - 1;
            const int s0 = __builtin_amdgcn_readlane(selv, e0);
            const bf16_t* y0 = p.YE + ((size_t)e0 * 1024 + s0) * 1024 + lane * 4;
            const bool two = mask != 0;
            int e1 = e0, s1 = s0;
            if (two) { e1 = __builtin_ctzll(mask); mask &= mask - 1; s1 = __builtin_amdgcn_readlane(selv, e1); }
            const bf16_t* y1 = p.YE + ((size_t)e1 * 1024 + s1) * 1024 + lane * 4;
            u32x2 w0[4], w1[4];
#pragma unroll
            for (int i = 0; i < 4; ++i) { w0[i] = *(const u32x2*)(y0 + 256 * i); w1[i] = *(const u32x2*)(y1 + 256 * i); }
            const float f1 = two ? 1.0f : 0.0f;
#pragma unroll
            for (int i = 0; i < 4; ++i) {
                y[i][0] += bf_lo(w0[i].x) + f1 * bf_lo(w1[i].x); y[i][1] += bf_hi(w0[i].x) + f1 * bf_hi(w1[i].x);
                y[i][2] += bf_lo(w0[i].y) + f1 * bf_lo(w1[i].y); y[i][3] += bf_hi(w0[i].y) + f1 * bf_hi(w1[i].y);
            }
        }
        if (row + stride < NTOK) {
            seln = -1;
            if (lane < 16) seln = p.SEL[(size_t)(row + stride) * 16 + lane];
#pragma unroll
            for (int i = 0; i < 4; ++i) xn[i] = *(const f32x4*)(p.X1 + (size_t)(row + stride) * D + lane * 4 + 256 * i);
        }
        const int cnd = cond_of_row(row);
        const float* gt = modp(p, layer, cnd, 5);
        float s = 0.f;
#pragma unroll
        for (int i = 0; i < 4; ++i) {
            const int col = lane * 4 + 256 * i;
            v[i] = v[i] * ALPHA_F + *(const f32x4*)(gt + col) * y[i];
            s += (v[i][0] + v[i][1]) + (v[i][2] + v[i][3]);
        }
        s = wave_sum(s);
        const float mu = s * (1.0f / 1024.0f);
        float q = 0.f;
#pragma unroll
        for (int i = 0; i < 4; ++i) { v[i] = v[i] - mu; q += (v[i][0] * v[i][0] + v[i][1] * v[i][1]) + (v[i][2] * v[i][2] + v[i][3] * v[i][3]); }
        q = wave_sum(q);
        const float rs = rsqrtf(q * (1.0f / 1024.0f) + EPS_F);
        const float* sh = modp(p, last ? layer : layer + 1, cnd, 0); const float* scl = modp(p, last ? layer : layer + 1, cnd, 1);
#pragma unroll
        for (int i = 0; i < 4; ++i) {
            const int col = lane * 4 + 256 * i;
            const f32x4 x = v[i] * rs * *(const f32x4*)(lg + col) + *(const f32x4*)(lb + col);
            *(f32x4*)(xo + (size_t)row * D + col) = x;
            if (!last) {
                const f32x4 h = x * (*(const f32x4*)(scl + col) + 1.0f) + *(const f32x4*)(sh + col);
                u32x2 o; o.x = pk_bf16(h[0], h[1]); o.y = pk_bf16(h[2], h[3]);
                *(u32x2*)(p.H + (size_t)row * D + col) = o;
            }
        }
    }
}

constexpr int GBM = 128;
constexpr int GBM2 = 256;
DEVI int xcd_first_unit(int bid, int nblk) { return (nblk & 7) ? bid : (bid & 7) * (nblk >> 3) + (bid >> 3); }
struct RowLin { const bf16_t* base; unsigned ld; DEVI unsigned offset(int r) const { return (unsigned)r * ld; } };
struct RowGather { const bf16_t* base; const int* idx; DEVI unsigned offset(int r) const { return (unsigned)(idx[r] & 8191) * 1024u; } };
struct RowClamp { const bf16_t* base; unsigned ld; int r0, rmax; DEVI unsigned offset(int r) const { int q = r0 + r; if (q > rmax) q = rmax; return (unsigned)q * ld; } };
struct RowKv { const bf16_t* base; int n0, isv; DEVI unsigned offset(int r) const { const int n = n0 + r; return (unsigned)((n >> 7) * 256 + isv * 128 + (n & 127)) * 256u; } };
struct GDesc { RowLin rf; WLin wl; unsigned ldw; int nk; };
struct WUp { const float* base; int kv; DEVI const float* operator()(int lane) const { return kv ? base + (lane >> 5) * 256 + ((4 * lane) & 127) : base + 4 * lane; } };
struct GDescUp { RowLin rf; WUp wl; unsigned ldw; };
struct WClamp { const float* base; int col0; DEVI const float* operator()(int lane) const { int c = col0 + 4 * lane; if (c > 700) c = 700; return base + c; } };
struct WLinP { const float* base; DEVI const float* operator()(int lane) const { const int r = 4 * lane; return base + 32 * (r >> 5) + 8 * ((r & 15) >> 2) + 4 * ((r >> 4) & 1); } };
struct WMoe { const float* gate; const float* up; size_t off; DEVI const float* operator()(int lane) const { const int r = 4 * lane, sub = r >> 5;
    const unsigned long long ga = (unsigned long long)gate, ua = (unsigned long long)up, mk = 0ull - (unsigned long long)(sub & 1);
    return (const float*)(ga ^ ((ga ^ ua) & mk)) + off + 32 * (sub >> 1) + 8 * ((r & 15) >> 2) + 4 * ((r >> 4) & 1); } };

DEVI void st_bf16x4(bf16_t* dst, f32x4 v) { u32x2 o; o.x = pk_bf16(v[0], v[1]); o.y = pk_bf16(v[2], v[3]); *(u32x2*)dst = o; }

template <int TM> DEVI void rope_tile(f32x4 (&acc)[TM][4], int row0  , int lane) {
    const int r16 = lane & 15, g = lane >> 4;
#pragma unroll
    for (int mb = 0; mb < TM; ++mb) {
        const int t = (row0 + mb * 16 + r16 - NPR) & 1023;
        const int prow = t >> 6, pcol = t & 63;
#pragma unroll
        for (int r = 0; r < 4; ++r) {
            const int f = 4 * g + r;
            const float c1 = rope_tab[(prow * 16 + f) * 2], s1 = rope_tab[(prow * 16 + f) * 2 + 1];
            const float c2 = rope_tab[(pcol * 16 + f) * 2], s2 = rope_tab[(pcol * 16 + f) * 2 + 1];
            const float a1 = acc[mb][0][r], a2 = acc[mb][1][r], b1 = acc[mb][2][r], b2 = acc[mb][3][r];
            acc[mb][0][r] = a1 * c1 - a2 * s1; acc[mb][1][r] = a2 * c1 + a1 * s1;
            acc[mb][2][r] = b1 * c2 - b2 * s2; acc[mb][3][r] = b2 * c2 + b1 * s2;
        }
        __builtin_amdgcn_sched_barrier(0);
    }
}

template <int BM> struct EpiZ { float* Z; int m0, n0;
    DEVI void operator()(const f32x4 (&acc)[BM / 32][4], int wr, int wc, int lane) const {
        const int r16 = lane & 15, g = lane >> 4;
#pragma unroll
        for (int mb = 0; mb < BM / 32; ++mb) { const int row = m0 + wr * (BM / 2) + mb * 16 + r16;
#pragma unroll
            for (int nb = 0; nb < 4; ++nb) { const int col = n0 + wc * 64 + nb * 16 + 4 * g; if (col < 704) *(f32x4*)(Z + (size_t)row * 704 + col) = acc[mb][nb]; } }
    } };
DEVI void phase_mla_win(const Params& p, int j, lds_t* lds, int bid, int nblk, int tid) {
    constexpr int MT = NTOK / GBM, NU = MT * 3;
    for (int u = xcd_first_unit(bid, nblk); u < NU; u += nblk) {
        const int mt = u % MT, nt = u / MT;
        RowLin rf{p.H + (size_t)mt * GBM * 1024, 1024u};
        RowClamp wf{p.WTI + (size_t)j * 704 * 1024, 1024u, nt * 256, 703};
        EpiZ<GBM> epi{p.Z, mt * GBM, nt * 256};
        gemm_unit_bb3<GBM, true>(lds, rf, wf, 16, epi, tid);
    }
}

template <int BM> struct EpiQ { bf16_t* Q; int m0, n0; float scale;
    DEVI void operator()(f32x4 (&acc)[BM / 32][4], int wr, int wc, int lane) const {
        const int r16 = lane & 15, g = lane >> 4;
        const int ncol0 = n0 + wc * 64;
        if (m0 >= NPR && (ncol0 % 192) == 128) rope_tile<BM / 32>(acc, m0 + wr * (BM / 2), lane);
#pragma unroll
        for (int mb = 0; mb < BM / 32; ++mb) { const int row = m0 + wr * (BM / 2) + mb * 16 + r16;
#pragma unroll
            for (int nb = 0; nb < 4; ++nb) st_bf16x4(Q + (size_t)row * 1536 + ncol0 + nb * 16 + 4 * g, acc[mb][nb] * scale); }
    } };
template <int BM> struct EpiKN { bf16_t* KN; int m0, n0;
    DEVI void operator()(const f32x4 (&acc)[BM / 32][4], int wr, int wc, int lane) const {
        const int r16 = lane & 15, g = lane >> 4;
#pragma unroll
        for (int mb = 0; mb < BM / 32; ++mb) { const int row = m0 + wr * (BM / 2) + mb * 16 + r16;
#pragma unroll
            for (int nb = 0; nb < 4; ++nb) st_bf16x4(KN + (size_t)row * 1024 + n0 + wc * 64 + nb * 16 + 4 * g, acc[mb][nb]); }
    } };
template <int BM> struct EpiVT { bf16_t* VTP; bf16_t* VTS; int m0, n0;
    DEVI void operator()(const f32x4 (&acc)[BM / 32][4], int wr, int wc, int lane) const {
        const int r16 = lane & 15, g = lane >> 4;
#pragma unroll
        for (int mb = 0; mb < BM / 32; ++mb) { const int row = m0 + wr * (BM / 2) + mb * 16 + 4 * g;
            bf16_t* dst;
            if (row < NPR) dst = VTP + (size_t)(row >> 8) * (8 * 128 * 256) + (row & 255);
            else if (row < NTOK) dst = VTS + (size_t)((row - NPR) >> 10) * (8 * 128 * 1280) + 256 + ((row - NPR) & 1023);
            else dst = VTS + (size_t)((row - NTOK) >> 8) * (8 * 128 * 1280) + ((row - NTOK) & 255);
            const size_t ldk = row < NPR ? 256 : 1280;
#pragma unroll
            for (int nb = 0; nb < 4; ++nb) { const int col = n0 + wc * 64 + nb * 16 + r16;
                st_bf16x4(dst + (size_t)col * ldk, acc[mb][nb]); } }
    } };
DEVI void phase_mla_up(const Params& p, int j, lds_t* lds, int bid, int nblk, int tid) {
    const float qscale = 0.07216878364870322f * LOG2E;
    constexpr int MTQ = NTOK / GBM2, MTK = NROWS_KV / GBM2, NQ = MTQ * 6, NK = MTK * 4, NU = NQ + 2 * NK;
    for (int u = xcd_first_unit(bid, nblk); u < NU; u += nblk) {
        if (u < NQ) {
            const int mt = u % MTQ, nt = u / MTQ;
            RowLin rf{p.CQ + (size_t)mt * GBM2 * 384, 384u};
            RowLin wf{p.WTQ + (size_t)j * 1536 * 384 + (size_t)nt * 256 * 384, 384u};
            EpiQ<GBM2> epi{p.Q, mt * GBM2, nt * 256, qscale};
            gemm_unit_bb<GBM2, true>(lds, rf, wf, 6, epi, tid);
        } else if (u < NQ + NK) {
            const int v = u - NQ, mt = v % MTK, nt = v / MTK;
            RowLin rf{p.CKV + (size_t)mt * GBM2 * 256, 256u};
            RowKv wf{p.WTKV + (size_t)j * 2048 * 256, nt * 256, 0};
            EpiKN<GBM2> epi{p.KN, mt * GBM2, nt * 256};
            gemm_unit_bb<GBM2, true>(lds, rf, wf, 4, epi, tid);
        } else {
            const int v = u - NQ - NK, mt = v % MTK, nt = v / MTK;
            RowLin rf{p.CKV + (size_t)mt * GBM2 * 256, 256u};
            RowKv wf{p.WTKV + (size_t)j * 2048 * 256, nt * 256, 1};
            EpiVT<GBM2> epi{p.VTP, p.VTS, mt * GBM2, nt * 256};
            gemm_unit_bb<GBM2, false>(lds, rf, wf, 4, epi, tid);
        }
    }
}

struct EpiRes { float* T; const float* X0; const float* mod; int layer, m0, n0;
    DEVI void operator()(const f32x4 (&acc)[4][4], int wr, int wc, int lane) const {
        const int r16 = lane & 15, g = lane >> 4;
        const int cnd = cond_of_row(m0);
        const float* gt = mod + ((size_t)(layer * 5 + cnd) * 6 + 2) * 1024;
#pragma unroll
        for (int nb = 0; nb < 4; ++nb) { const int col = n0 + wc * 64 + nb * 16 + 4 * g; const f32x4 gv = *(const f32x4*)(gt + col);
#pragma unroll
            for (int mb = 0; mb < 4; ++mb) { const size_t o = (size_t)(m0 + wr * 64 + mb * 16 + r16) * 1024 + col;
                *(f32x4*)(T + o) = *(const f32x4*)(X0 + o) * ALPHA_F + gv * acc[mb][nb]; } }
    } };
DEVI void phase_out_proj(const Params& p, int layer, const bf16_t* A, int K, const bf16_t* Wt, lds_t* lds, int bid, int nblk, int tid) {
    constexpr int NU = 64 * 4;
    for (int u = xcd_first_unit(bid, nblk); u < NU; u += nblk) {
        const int mt = u & 63, nt = u >> 6;
        RowLin rf{A + (size_t)mt * 128 * K, (unsigned)K};
        RowLin wf{Wt + (size_t)nt * 256 * K, (unsigned)K};
        const float* xres = layer ? p.X0 : (mt * 128 < NPR ? p.x_prompt : p.x_sample - (size_t)NPR * D);
        EpiRes epi{p.T, xres, p.mod, layer, mt * 128, nt * 256};
        gemm_unit_bb3<128, true>(lds, rf, wf, K / 64, epi, tid);
    }
}

struct SchedGmWin { const bf16_t* H; const bf16_t* W; int v0, G;
    DEVI bool next(int i, pg8::Unit& u) const {
        const int L = i * G + v0; if (L >= 768) return false;
        if (L < 384) { const int g = L >> 5, w = L & 31; u.pm = (g & 3) * 8 + (w & 7); u.pn = (g >> 2) * 4 + (w >> 3); u.aux = 0; }
        else { const int g = (L - 384) >> 5, w = L & 31; u.pm = (g % 3) * 4 + (w & 3); u.pn = (g / 3) * 8 + (w >> 2); u.aux = 1; }
        return true; }
    DEVI void ptrs(const pg8::Unit& u, const char*& a, const char*& b) const {
        if (u.aux == 0) { a = (const char*)(H + (size_t)u.pm * 256 * 1024); b = (const char*)(W + (size_t)u.pn * 256 * 1024); }
        else { a = (const char*)(W + (size_t)(3072 + u.pm * 256) * 1024); b = (const char*)(H + (size_t)u.pn * 256 * 1024); } }
};
struct EpiGmWin { static constexpr bool PERM = true; bf16_t* U; bf16_t* GVT; float* GST;
    DEVI void operator()(const f32x4 (&acc)[2][2][4][2], const pg8::Unit& u, int wr, int wc, int fr_in, int fq_in) const {
        int ln = fr_in | (fq_in << 4); asm volatile("" : "+v"(ln));
        const int fr = ln & 15, fq = ln >> 4;
        const bool vhalf = u.aux != 0;
#pragma unroll
        for (int bj = 0; bj < 2; ++bj) {
            f32x4 s0 = (f32x4){0.f, 0.f, 0.f, 0.f}, s1 = s0, q0 = s0, q1 = s0;
            const int cpos = u.pn * 256 + bj * 128 + wc * 32 + 8 * fq;
#pragma unroll
            for (int ai = 0; ai < 2; ++ai)
#pragma unroll
                for (int m = 0; m < 4; ++m) { const int r = u.pm * 256 + ai * 128 + wr * 64 + m * 16 + fr;
                    f32x4 a = acc[ai][bj][m][0], b = acc[ai][bj][m][1];
#pragma unroll
                    for (int j = 0; j < 4; ++j) { a[j] = gelu_tanh_f(a[j]); b[j] = gelu_tanh_f(b[j]); }
                    u32x4 w; w.x = pk_bf16(a[0], a[1]); w.y = pk_bf16(a[2], a[3]); w.z = pk_bf16(b[0], b[1]); w.w = pk_bf16(b[2], b[3]);
                    if (!vhalf) *(u32x4*)(U + (size_t)r * 3072 + cpos) = w;
                    else { s0 += a; q0 += a * a; s1 += b; q1 += b * b; *(u32x4*)(GVT + ((size_t)(cpos >> 7) * 3072 + r) * 128 + (cpos & 127)) = w; }
                    __builtin_amdgcn_sched_barrier(0); }
            if (vhalf) {
#pragma unroll
                for (int o = 1; o < 16; o <<= 1)
#pragma unroll
                    for (int j = 0; j < 4; ++j) { s0[j] += __shfl_xor(s0[j], o); q0[j] += __shfl_xor(q0[j], o); s1[j] += __shfl_xor(s1[j], o); q1[j] += __shfl_xor(q1[j], o); }
                if (fr == 0) { const int part = u.pm * 2 + wr;
#pragma unroll
                    for (int j = 0; j < 4; ++j) { f32x2 w2; w2.x = s0[j]; w2.y = q0[j]; *(f32x2*)(GST + ((size_t)(cpos + j) * 24 + part) * 2) = w2;
                                                  f32x2 w3; w3.x = s1[j]; w3.y = q1[j]; *(f32x2*)(GST + ((size_t)(cpos + 4 + j) * 24 + part) * 2) = w3; } }
            }
            __builtin_amdgcn_sched_barrier(0);
        }
    } };
DEVI void phase_gm_win(const Params& p, lds_t* lds, int bid, int nblk, int tid) {
    SchedGmWin S{p.H, p.WTGI, xcd_first_unit(bid, nblk), nblk};
    EpiGmWin E{p.U, p.GVT, p.GST};
    pg8::gemm_phase(lds, 1024, 16, S, E, tid);
}

template <int BM> struct EpiSQ { bf16_t* Q; int m0, n0; float scale;
    DEVI void operator()(f32x4 (&acc)[BM / 32][4], int wr, int wc, int lane) const {
        const int r16 = lane & 15, g = lane >> 4;
        if (m0 >= NPR) rope_tile<BM / 32>(acc, m0 + wr * (BM / 2), lane);
#pragma unroll
        for (int mb = 0; mb < BM / 32; ++mb) { const int row = m0 + wr * (BM / 2) + mb * 16 + r16;
#pragma unroll
            for (int nb = 0; nb < 4; ++nb) st_bf16x4(Q + (size_t)row * 1024 + n0 + wc * 64 + nb * 16 + 4 * g, acc[mb][nb] * scale); }
    } };
template <int BM> struct EpiSK { bf16_t* SK; float* out; int m0;
    DEVI void operator()(f32x4 (&acc)[BM / 32][4], int wr, int wc, int lane) const {
        const int r16 = lane & 15, g = lane >> 4;
        if (m0 >= NPR) rope_tile<BM / 32>(acc, m0 + wr * (BM / 2), lane);
#pragma unroll
        for (int mb = 0; mb < BM / 32; ++mb) { const int row = m0 + wr * (BM / 2) + mb * 16 + r16;
#pragma unroll
            for (int nb = 0; nb < 4; ++nb) { const int col = wc * 64 + nb * 16 + 4 * g;
                if (m0 < NPR) *(f32x4*)(out + OUT_SK + (size_t)row * 256 + col) = acc[mb][nb];
                st_bf16x4(SK + (size_t)row * 256 + col, acc[mb][nb]); } }
    } };
template <int BM> struct EpiSV { bf16_t* SVTP; bf16_t* SVTS; float* out; int m0;
    DEVI void operator()(const f32x4 (&acc)[BM / 32][4], int wr, int wc, int lane) const {
        const int r16 = lane & 15, g = lane >> 4;
#pragma unroll
        for (int mb = 0; mb < BM / 32; ++mb) { const int row = m0 + wr * (BM / 2) + mb * 16 + 4 * g;
            bf16_t* dst; size_t ldk;
            if (row < NPR) { dst = SVTP + (size_t)(row >> 8) * (4 * 64 * 256) + (row & 255); ldk = 256; }
            else { dst = SVTS + (size_t)((row - NPR) >> 10) * (4 * 64 * 1280) + 256 + ((row - NPR) & 1023); ldk = 1280; }
#pragma unroll
            for (int nb = 0; nb < 4; ++nb) { const int col = wc * 64 + nb * 16 + r16;
                st_bf16x4(dst + (size_t)col * ldk, acc[mb][nb]);
                if (row < NPR) {
#pragma unroll
                    for (int r = 0; r < 4; ++r) out[OUT_SV + (size_t)(row + r) * 256 + col] = acc[mb][nb][r]; } } }
    } };
DEVI void phase_swa_qkv(const Params& p, lds_t* lds, int bid, int nblk, int tid) {
    constexpr int MT = NTOK / GBM2, NU = MT * 6;
    for (int u = xcd_first_unit(bid, nblk); u < NU; u += nblk) {
        const int mt = u % MT, nt = u / MT;
        RowLin rf{p.H + (size_t)mt * GBM2 * 1024, 1024u};
        RowLin wf{p.WTSQ + (size_t)nt * 256 * 1024, 1024u};
        if (nt < 4) { EpiSQ<GBM2> epi{p.Q, mt * GBM2, nt * 256, 0.125f * LOG2E}; gemm_unit_bb<GBM2, true>(lds, rf, wf, 16, epi, tid); }
        else if (nt == 4) { EpiSK<GBM2> epi{p.SK, p.out, mt * GBM2}; gemm_unit_bb<GBM2, true>(lds, rf, wf, 16, epi, tid); }
        else { EpiSV<GBM2> epi{p.SVTP, p.SVTS, p.out, mt * GBM2}; gemm_unit_bb<GBM2, false>(lds, rf, wf, 16, epi, tid); }
    }
}

template <int BM> struct EpiHid { bf16_t* HID; int e, mt, nt;
    DEVI void operator()(const f32x4 (&acc)[BM / 32][4], int wr, int wc, int lane) const {
        const int r16 = lane & 15, g = lane >> 4;
#pragma unroll
        for (int mb = 0; mb < BM / 32; ++mb) { const size_t row = (size_t)e * 1024 + mt * BM + wr * (BM / 2) + mb * 16 + r16;
            u32x4 w;
            { const f32x4 gv = acc[mb][0], uv = acc[mb][2]; w.x = pk_bf16(silu_f(gv[0]) * uv[0], silu_f(gv[1]) * uv[1]); w.y = pk_bf16(silu_f(gv[2]) * uv[2], silu_f(gv[3]) * uv[3]); }
            { const f32x4 gv = acc[mb][1], uv = acc[mb][3]; w.z = pk_bf16(silu_f(gv[0]) * uv[0], silu_f(gv[1]) * uv[1]); w.w = pk_bf16(silu_f(gv[2]) * uv[2], silu_f(gv[3]) * uv[3]); }
            *(u32x4*)(HID + row * 2048 + nt * 128 + wc * 32 + 8 * g) = w; }
    } };
template <int DBG = 0> DEVI void phase_moe_up(const Params& p, int layer, lds_t* lds, int bid, int nblk, int tid) {
    constexpr int MT = 1024 / GBM2, NU = 16 * MT * 16;
#define DEC_MU(u_, rf_, wf_) do { const int e_ = (u_) / (MT * 16), w_ = (u_) % (MT * 16), mt_ = w_ % MT, nt_ = w_ / MT; \
        rf_ = RowGather{p.H2, p.IDX + e_ * 1024 + mt_ * GBM2}; wf_ = WMoe{p.moe_w_gate, p.moe_w_up, ((size_t)layer * 16 + e_) * 1024 * 2048 + nt_ * 128}; } while (0)
    int u = xcd_first_unit(bid, nblk);
    RowGather rf, rfn; WMoe wf, wfn;
    for (; u < NU; u += nblk) {
        const int e = u / (MT * 16), w = u % (MT * 16), mt = w % MT, nt = w / MT;
        DEC_MU(u, rf, wf);
        EpiHid<GBM2> epi{p.HID, e, mt, nt};
        gemm_unit<GBM2, true>(lds, rf, wf, 2048u, 16, epi, tid);
    }
#undef DEC_MU
}
template <int BM> struct EpiYe { bf16_t* YE; const float* GATEV; int e, mt, nt;
    DEVI void operator()(const f32x4 (&acc)[BM / 32][4], int wr, int wc, int lane) const {
        const int r16 = lane & 15, g = lane >> 4;
#pragma unroll
        for (int mb = 0; mb < BM / 32; ++mb) { const size_t row = (size_t)e * 1024 + mt * BM + wr * (BM / 2) + mb * 16 + r16;
            const float gt = GATEV[row];
#pragma unroll
            for (int np = 0; np < 2; ++np) {
                const f32x4 a = acc[mb][2 * np] * gt, b = acc[mb][2 * np + 1] * gt;
                u32x4 w; w.x = pk_bf16(a[0], a[1]); w.y = pk_bf16(a[2], a[3]); w.z = pk_bf16(b[0], b[1]); w.w = pk_bf16(b[2], b[3]);
                *(u32x4*)(YE + row * 1024 + nt * 256 + wc * 64 + 32 * np + 8 * g) = w; } }
    } };
DEVI void phase_moe_down(const Params& p, int layer, lds_t* lds, int bid, int nblk, int tid) {
    constexpr int MT = 1024 / GBM2, NU = 16 * MT * 4;
#define DEC_MD(u_, d_) do { const int e_ = (u_) / (MT * 4), w_ = (u_) % (MT * 4), mt_ = w_ % MT, nt_ = w_ / MT; \
        d_.rf = RowLin{p.HID + ((size_t)e_ * 1024 + mt_ * GBM2) * 2048, 2048u}; d_.wl = WLin{p.moe_w_down + ((size_t)layer * 16 + e_) * 2048 * 1024 + nt_ * 256}; d_.ldw = 1024u; d_.nk = 32; } while (0)
    int u = xcd_first_unit(bid, nblk);
    GDesc d, dn;
    for (; u < NU; u += nblk) {
        const int e = u / (MT * 4), w = u % (MT * 4), mt = w % MT, nt = w / MT;
        DEC_MD(u, d);
        EpiYe<GBM2> epi{p.YE, p.GATEV, e, mt, nt};
        gemm_unit<GBM2, true>(lds, d.rf, WLinP{d.wl.base}, d.ldw, 32, epi, tid);
    }
#undef DEC_MD
}

template <int DK, int DV> struct AttnCfg {
    static constexpr int CPK = DK / 8;
    static constexpr int KT_BYTES = 64 * DK * 2;
    static constexpr int VT_BYTES = DV * 128;
    static constexpr int STAGE = KT_BYTES + VT_BYTES;
    static constexpr int NKC = 64 * CPK / NTHREADS;
    static constexpr int NVC = DV * 8 / NTHREADS;
};
DEVI int kswz(int key) { return ((key >> 1) & 1) | (((key >> 3) & 3) << 1); }

struct AttnSeg { int n_ctx, ctx_krow0, ctx_vcol0, n_loc, loc_krow0, loc_vcol0, loc_kpos0; };

template <int DK, int DV, bool WINDOW, class KSrc>
DEVI void attn_unit(lds_t* lds, const bf16_t* Qp, int ldq, const KSrc& ks, const bf16_t* vt, int ldv, const AttnSeg sg, int qpos0,
                    float sink, bool has_sink, bf16_t* Op, int ldo, int tid) {
    typedef AttnCfg<DK, DV> C;
    const int lane = tid & 63, wave = tid >> 6, r16 = lane & 15, g = lane >> 4;
    const int ntile = sg.n_ctx + sg.n_loc;
    bf16x8 qf[DK / 32];
    {
        const bf16_t* qr = Qp + (size_t)(wave * 16 + r16) * ldq + 8 * g;
#pragma unroll
        for (int s = 0; s < DK / 32; ++s) qf[s] = *(const bf16x8*)(qr + 32 * s);
    }
    u32x4 kreg[C::NKC], vreg[C::NVC];
#define TILE_LOAD(jj) do { const int j_ = (jj); int krow, vcol; \
        if (j_ < sg.n_ctx) { krow = sg.ctx_krow0 + 64 * j_; vcol = sg.ctx_vcol0 + 64 * j_; } \
        else { krow = sg.loc_krow0 + 64 * (j_ - sg.n_ctx); vcol = sg.loc_vcol0 + 64 * (j_ - sg.n_ctx); } \
        _Pragma("unroll") for (int i = 0; i < C::NKC; ++i) { const int c = tid + NTHREADS * i, key = c / C::CPK, ch = c % C::CPK; kreg[i] = *(const u32x4*)ks(krow + key, ch); } \
        _Pragma("unroll") for (int i = 0; i < C::NVC; ++i) { const int c = tid + NTHREADS * i, dv = c >> 3, ch = c & 7; vreg[i] = *(const u32x4*)(vt + (size_t)dv * ldv + vcol + ch * 8); } } while (0)
#define TILE_STORE(stp) do { lds_t* st_ = (stp); \
        _Pragma("unroll") for (int i = 0; i < C::NKC; ++i) { const int c = tid + NTHREADS * i, key = c / C::CPK, ch = c % C::CPK; lds_st128(st_ + key * (DK * 2) + ((ch ^ kswz(key)) << 4), kreg[i]); } \
        _Pragma("unroll") for (int i = 0; i < C::NVC; ++i) { const int c = tid + NTHREADS * i, dv = c >> 3, ch = c & 7; lds_st128(st_ + C::KT_BYTES + img_off(dv, ch), vreg[i]); } } while (0)
    f32x4 o[DV / 16];
#pragma unroll
    for (int i = 0; i < DV / 16; ++i) o[i] = (f32x4){0.f, 0.f, 0.f, 0.f};
    float m = has_sink ? sink : -1.0e30f;
    float l = (has_sink && g == 0) ? 1.0f : 0.0f;
    const int qpos = qpos0 + wave * 16 + r16;
    const int kbyte = (8 * (r16 >> 2) + (r16 & 3)) * (DK * 2);
    const int ksw0 = ((r16 >> 1) & 1) | ((r16 >> 2) << 1);
    const int ke0 = (g ^ ksw0) << 4, ke1 = ((4 + g) ^ ksw0) << 4;
    const int vc0 = g ^ ((r16 >> 1) & 7);

    TILE_LOAD(0);
    __syncthreads();
    TILE_STORE(lds);
    if (ntile > 1) TILE_LOAD(1);
    for (int j = 0; j < ntile; ++j) {
        __syncthreads();
        lds_t* cur = lds + (j & 1) * C::STAGE;
        if (j + 1 < ntile) { TILE_STORE(lds + ((j + 1) & 1) * C::STAGE); if (j + 2 < ntile) TILE_LOAD(j + 2); }
        const bool masked = WINDOW && (j >= sg.n_ctx);
        const int kpos0 = sg.loc_kpos0 + 64 * (j - sg.n_ctx);
        if (masked) {
            const int qlo = qpos0 + wave * 16;
            if (kpos0 > qlo + 15 + 128 || kpos0 + 63 < qlo - 128) continue;
        }
        f32x4 s[4];
        {
            lds_t* kb0 = cur + kbyte + ke0;
            lds_t* kb1 = cur + kbyte + ke1;
#pragma unroll
            for (int grp = 0; grp < 2; ++grp)
#pragma unroll
                for (int b = 0; b < 2; ++b) {
                    f32x4 a = (f32x4){0.f, 0.f, 0.f, 0.f};
#pragma unroll
                    for (int st = 0; st < DK / 32; ++st) {
                        const bf16x8 kf = lds_ld128(((st & 1) ? kb1 : kb0) + (32 * grp + 4 * b) * (DK * 2) + (st >> 1) * 128);
                        a = __builtin_amdgcn_mfma_f32_16x16x32_bf16(kf, qf[st], a, 0, 0, 0);
                    }
                    s[grp * 2 + b] = a;
                }
        }
        if (masked) {
#pragma unroll
            for (int grp = 0; grp < 2; ++grp)
#pragma unroll
                for (int b = 0; b < 2; ++b)
#pragma unroll
                    for (int r = 0; r < 4; ++r) {
                        const int kp = kpos0 + 32 * grp + 8 * g + 4 * b + r;
                        const int d = qpos - kp;
                        if (d > 128 || d < -128) s[grp * 2 + b][r] = -1.0e30f;
                    }
        }
        float mx = fmaxf(fmaxf(fmaxf(s[0][0], s[0][1]), fmaxf(s[0][2], s[0][3])), fmaxf(fmaxf(s[1][0], s[1][1]), fmaxf(s[1][2], s[1][3])));
        mx = fmaxf(mx, fmaxf(fmaxf(fmaxf(s[2][0], s[2][1]), fmaxf(s[2][2], s[2][3])), fmaxf(fmaxf(s[3][0], s[3][1]), fmaxf(s[3][2], s[3][3]))));
        mx = fmaxf(mx, __shfl_xor(mx, 16)); mx = fmaxf(mx, __shfl_xor(mx, 32));
        const float mn = fmaxf(m, mx);
        const float alpha = fexp2(m - mn);
        m = mn;
        float ps = 0.f;
#pragma unroll
        for (int i = 0; i < 4; ++i)
#pragma unroll
            for (int r = 0; r < 4; ++r) { const float pv = fexp2(s[i][r] - mn); s[i][r] = pv; ps += pv; }
        l = l * alpha + ps;
#pragma unroll
        for (int i = 0; i < DV / 16; ++i) o[i] = o[i] * alpha;
#pragma unroll
        for (int grp = 0; grp < 2; ++grp) {
            u32x4 pw;
            pw.x = pk_bf16(s[grp * 2][0], s[grp * 2][1]); pw.y = pk_bf16(s[grp * 2][2], s[grp * 2][3]);
            pw.z = pk_bf16(s[grp * 2 + 1][0], s[grp * 2 + 1][1]); pw.w = pk_bf16(s[grp * 2 + 1][2], s[grp * 2 + 1][3]);
            bf16x8 pf; __builtin_memcpy(&pf, &pw, 16);
#pragma unroll
            for (int dvb = 0; dvb < DV / 16; ++dvb) {
                const bf16x8 vf = lds_ld128(cur + C::KT_BYTES + r16 * 128 + dvb * 2048 + (((vc0 ^ (4 * grp)) ^ (dvb & 1)) << 4));
                o[dvb] = __builtin_amdgcn_mfma_f32_16x16x32_bf16(vf, pf, o[dvb], 0, 0, 0);
            }
        }
    }
    l += __shfl_xor(l, 16); l += __shfl_xor(l, 32);
    const float inv = frcp(l);
    bf16_t* orow = Op + (size_t)(wave * 16 + r16) * ldo + 4 * g;
#pragma unroll
    for (int dvb = 0; dvb < DV / 16; ++dvb) st_bf16x4(orow + dvb * 16, o[dvb] * inv);
}

struct KSrcMla { const bf16_t* KN; const bf16_t* KPE; int h;
    DEVI const bf16_t* operator()(int krow, int ch) const { return ch < 16 ? KN + (size_t)krow * 1024 + h * 128 + ch * 8 : KPE + (size_t)krow * 64 + (ch - 16) * 8; } };
struct KSrcSwa { const bf16_t* SK; int kvh;
    DEVI const bf16_t* operator()(int krow, int ch) const { return SK + (size_t)krow * 256 + kvh * 64 + ch * 8; } };

DEVI void phase_mla_attn(const Params& p, lds_t* lds, int bid, int nblk, int tid) {
    for (int u = xcd_first_unit(bid, nblk); u < 512; u += nblk) {
        if (u < 256) {
            const int b = u >> 6, h = (u >> 3) & 7, qt = u & 7;
            const int qrow0 = NPR + b * 1024 + qt * 128;
            KSrcMla ks{p.KN, p.KPE, h};
            AttnSeg sg{4, NTOK + b * 256, 0, 16, NPR + b * 1024, 256, 0};
            attn_unit<192, 128, false>(lds, p.Q + (size_t)qrow0 * 1536 + h * 192, 1536, ks, p.VTS + (size_t)(b * 8 + h) * 128 * 1280, 1280, sg, 0, 0.f, false,
                                       p.O + (size_t)qrow0 * 1024 + h * 128, 1024, tid);
        } else {
            const int v = u - 256, b = v >> 4, h = (v >> 1) & 7, qt = v & 1;
            const int qrow0 = b * 256 + qt * 128;
            KSrcMla ks{p.KN, p.KPE, h};
            AttnSeg sg{0, 0, 0, 4, b * 256, 0, 0};
            attn_unit<192, 128, false>(lds, p.Q + (size_t)qrow0 * 1536 + h * 192, 1536, ks, p.VTP + (size_t)(b * 8 + h) * 128 * 256, 256, sg, 0, 0.f, false,
                                       p.O + (size_t)qrow0 * 1024 + h * 128, 1024, tid);
        }
    }
}
DEVI void phase_swa_attn(const Params& p, lds_t* lds, int bid, int nblk, int tid) {
    for (int u = xcd_first_unit(bid, nblk); u < 1024; u += nblk) {
        const int w = u >> 8, idx = ((u >> 9) << 8) | (u & 255);
        if ((w & 1) == 0) {
            const int b = idx >> 7, hq = (idx >> 3) & 15, qt = idx & 7, kvh = hq >> 2;
            const int qs = qt * 128, qrow0 = NPR + b * 1024 + qs;
            const int lo = qs >= 128 ? qs - 128 : 0, hi = qs + 256 <= 1024 ? qs + 256 : 1024;
            KSrcSwa ks{p.SK, kvh};
            AttnSeg sg{4, NTOK + b * 256, 0, (hi - lo) >> 6, NPR + b * 1024 + lo, 256 + lo, lo};
            attn_unit<64, 64, true>(lds, p.Q + (size_t)qrow0 * 1024 + hq * 64, 1024, ks, p.SVTS + (size_t)(b * 4 + kvh) * 64 * 1280, 1280, sg, qs,
                                    p.swa_sink[hq] * LOG2E, true, p.O + (size_t)qrow0 * 1024 + hq * 64, 1024, tid);
        } else {
            const int b = idx >> 5, hq = (idx >> 1) & 15, qt = idx & 1, kvh = hq >> 2;
            const int qrow0 = b * 256 + qt * 128;
            KSrcSwa ks{p.SK, kvh};
            AttnSeg sg{0, 0, 0, 4, b * 256, 0, 0};
            attn_unit<64, 64, false>(lds, p.Q + (size_t)qrow0 * 1024 + hq * 64, 1024, ks, p.SVTP + (size_t)(b * 4 + kvh) * 64 * 256, 256, sg, 0,
                                     p.swa_sink[hq] * LOG2E, true, p.O + (size_t)qrow0 * 1024 + hq * 64, 1024, tid);
        }
    }
}

DEVI void phase_gm_spatial(const Params& p, lds_t* lds, int bid, int nblk, int tid) {
    const int lane = tid & 63, wave = tid >> 6, r16 = lane & 15, g = lane >> 4, wr = wave >> 2, wc = wave & 3;
    lds_t* aimg = lds;
    lds_t* vimg = lds + 32768;
    LAS float* mean = (LAS float*)(lds + 65536);
    LAS float* rstd = mean + 128;
    LAS float* biasp = rstd + 128;
    LAS float* bpart = biasp + 128;
    for (int u = xcd_first_unit(bid, nblk); u < 512; u += nblk) {
        const int chunk = u >> 3, grp = u & 7;
        __syncthreads();
        if (tid < 128) {
            const float* gs = p.GST + (size_t)(chunk * 128 + tid) * 48;
            float s = 0.f, q = 0.f;
            for (int i = 0; i < 24; ++i) { s += gs[2 * i]; q += gs[2 * i + 1]; }
            const float mu = s * (1.0f / 3072.0f);
            const float var = q * (1.0f / 3072.0f) - mu * mu;
            mean[tid] = mu; rstd[tid] = rsqrtf(fmaxf(var, 0.f) + EPS_F);
        }
        __syncthreads();
        {
            const int n = tid >> 2, mq = tid & 3;
            const float* ws = p.gm_w_s + ((size_t)grp * 128 + n) * 128 + mq * 32;
            float bp = 0.f;
#pragma unroll
            for (int c4 = 0; c4 < 4; ++c4) {
                const f32x4 w0 = *(const f32x4*)(ws + c4 * 8), w1 = *(const f32x4*)(ws + c4 * 8 + 4);
                const int m0 = mq * 32 + c4 * 8;
                float a[8];
#pragma unroll
                for (int i = 0; i < 4; ++i) { a[i] = w0[i] * rstd[m0 + i]; a[4 + i] = w1[i] * rstd[m0 + 4 + i]; }
                u32x4 v; v.x = pk_bf16(a[0], a[1]); v.y = pk_bf16(a[2], a[3]); v.z = pk_bf16(a[4], a[5]); v.w = pk_bf16(a[6], a[7]);
#pragma unroll
                for (int i = 0; i < 4; ++i) { const unsigned wd = i == 0 ? v.x : i == 1 ? v.y : i == 2 ? v.z : v.w; bp += bf_lo(wd) * mean[m0 + 2 * i] + bf_hi(wd) * mean[m0 + 2 * i + 1]; }
                const int kc = m0 >> 3;
                lds_st128(aimg + (kc >> 3) * 16384 + img_off(n, kc & 7), v);
            }
            bpart[mq * 128 + n] = bp;
        }
        __syncthreads();
        if (tid < 128) biasp[tid] = bpart[tid] + bpart[128 + tid] + bpart[256 + tid] + bpart[384 + tid];
        for (int cs = 0; cs < 3; ++cs) {
            __syncthreads();
            {
                const bf16_t* src = p.GVT + ((size_t)chunk * 3072 + grp * 384 + cs * 128) * 128;
#pragma unroll
                for (int i = 0; i < 4; ++i) { const int c = tid + NTHREADS * i, row = c >> 4, kc = c & 15;
                    const u32x4 v = *(const u32x4*)(src + (size_t)row * 128 + kc * 8);
                    lds_st128(vimg + (kc >> 3) * 16384 + img_off(row, kc & 7), v); }
            }
            __syncthreads();
            f32x4 acc[4][2];
#pragma unroll
            for (int i = 0; i < 4; ++i) { acc[i][0] = (f32x4){0.f, 0.f, 0.f, 0.f}; acc[i][1] = acc[i][0]; }
#pragma unroll
            for (int kh = 0; kh < 2; ++kh)
#pragma unroll
                for (int s = 0; s < 2; ++s) {
                    bf16x8 af[4], vf[2];
#pragma unroll
                    for (int mb = 0; mb < 4; ++mb) af[mb] = lds_ld128(aimg + kh * 16384 + img_off(wr * 64 + mb * 16 + r16, 4 * s + g));
#pragma unroll
                    for (int nb = 0; nb < 2; ++nb) vf[nb] = lds_ld128(vimg + kh * 16384 + img_off(wc * 32 + nb * 16 + r16, 4 * s + g));
#pragma unroll
                    for (int mb = 0; mb < 4; ++mb)
#pragma unroll
                        for (int nb = 0; nb < 2; ++nb) acc[mb][nb] = __builtin_amdgcn_mfma_f32_16x16x32_bf16(vf[nb], af[mb], acc[mb][nb], 0, 0, 0);
                }
#pragma unroll
            for (int mb = 0; mb < 4; ++mb) {
                const int n = wr * 64 + mb * 16 + r16;
                const float bp = biasp[n], bs = p.gm_b_s[grp * 128 + n];
                const size_t row = (size_t)chunk * 128 + n;
#pragma unroll
                for (int nb = 0; nb < 2; ++nb) {
                    const int col = grp * 384 + cs * 128 + wc * 32 + nb * 16 + 4 * g;
                    const f32x4 gn = *(const f32x4*)(p.gm_v_gain + col);
                    const u32x2 uw = *(const u32x2*)(p.U + row * 3072 + col);
                    f32x4 t;
                    t[0] = bf_lo(uw.x) * (gn[0] * (acc[mb][nb][0] - bp) + bs);
                    t[1] = bf_hi(uw.x) * (gn[1] * (acc[mb][nb][1] - bp) + bs);
                    t[2] = bf_lo(uw.y) * (gn[2] * (acc[mb][nb][2] - bp) + bs);
                    t[3] = bf_hi(uw.y) * (gn[3] * (acc[mb][nb][3] - bp) + bs);
                    st_bf16x4(p.TT + row * 3072 + col, t);
                }
            }
        }
    }
}

constexpr int N_PHASES = 2 + 10 * DEPTH;
__global__ void __launch_bounds__(NTHREADS, 2) fwd_kernel(Params p_kernarg) {
    extern __shared__ __attribute__((aligned(16))) unsigned char smem[];
    lds_t* lds = (lds_t*)smem;
    const int tid0 = threadIdx.x, bid0 = blockIdx.x, nblk0 = gridDim.x;
    const int wave0 = __builtin_amdgcn_readfirstlane(tid0 >> 6);
    volatile LAS unsigned* misc = (volatile LAS unsigned*)(lds + LDS_MAIN);
    if (tid0 == 0) { misc[0] = 0u; misc[1] = 0u; misc[2] = 0u; misc[3] = 0u; }
    __syncthreads();
    typedef const __attribute__((address_space(4))) Params* kparams_t;
    kparams_t pp = (kparams_t)__builtin_amdgcn_kernarg_segment_ptr();
    const int lo = (int)pp->ph_lo, hi = (int)pp->ph_hi;
    XcdBarrier bar; bar.bar = pp->bar; bar.x = 0; bar.st = misc;
    if (hi - lo > 1) bar = xcd_barrier_post(bar.bar, misc);
#define IN(k) (lo <= (k) && (k) < hi)
#ifndef REP_MASK
#define REP_MASK 0
#endif
#define RUN(k, knext, cls, body) do { if (IN(k)) { { asm volatile("" : "+s"(pp)); Params p; __builtin_memcpy(&p, pp, sizeof(Params)); \
        int tid = wave0 * 64 + (int)__builtin_amdgcn_mbcnt_hi(~0u, __builtin_amdgcn_mbcnt_lo(~0u, 0u)), bid = bid0, nblk = nblk0; asm volatile("" : "+v"(tid)); asm volatile("" : "+s"(bid), "+s"(nblk)); body; \
        if ((REP_MASK) & (cls)) { asm volatile("" : "+v"(tid)); body; } } if (IN(knext)) { xcd_barrier(bar); if ((REP_MASK) & 8192) xcd_barrier(bar); } } } while (0)
    RUN(0, 1, 64, { phase_modulation(p, lds, bid, nblk, tid); phase_wconv(p, lds, bid, nblk, tid); });
    RUN(1, 2, 512, phase_prep(p, bid, nblk, tid));
#pragma unroll 1
    for (int li = 0; li < DEPTH; ++li) {
        const int kind = li % 3, j = li / 3, base = 2 + 10 * li;
        if (kind == 0) {
            RUN(base + 0, base + 1, 32, phase_mla_win(p, j, lds, bid, nblk, tid));
            RUN(base + 1, base + 2, 1024, phase_mla_norm(p, j, bid, nblk, tid));
            RUN(base + 2, base + 3, 32, phase_mla_up(p, j, lds, bid, nblk, tid));
            RUN(base + 3, base + 4, 16, phase_mla_attn(p, lds, bid, nblk, tid));
            RUN(base + 4, base + 5, 8, phase_out_proj(p, li, p.O, 1024, p.WTO + (size_t)j * 1024 * 1024, lds, bid, nblk, tid));
        } else if (kind == 1) {
            RUN(base + 0, base + 1, 4, phase_gm_win(p, lds, bid, nblk, tid));
            RUN(base + 1, base + 2, 128, phase_gm_spatial(p, lds, bid, nblk, tid));
            RUN(base + 2, base + 5, 8, phase_out_proj(p, li, p.TT, 3072, p.WTGO, lds, bid, nblk, tid));
        } else {
            RUN(base + 0, base + 1, 32, phase_swa_qkv(p, lds, bid, nblk, tid));
            RUN(base + 1, base + 2, 16, phase_swa_attn(p, lds, bid, nblk, tid));
            RUN(base + 2, base + 5, 8, phase_out_proj(p, li, p.O, 1024, p.WTSO, lds, bid, nblk, tid));
        }
        RUN(base + 5, base + 6, 2048, phase_ln_a(p, li, lds, bid, nblk, tid));
        RUN(base + 6, base + 7, 256, phase_topk(p, lds, bid, nblk, tid));
        RUN(base + 7, base + 8, 1, phase_moe_up(p, li, lds, bid, nblk, tid));
        RUN(base + 8, base + 9, 2, phase_moe_down(p, li, lds, bid, nblk, tid));
        RUN(base + 9, base + 10, 4096, phase_ln_b(p, li, bid, nblk, tid));
    }
#undef IN
#undef RUN
}

#ifdef PROBE_V
__global__ void __launch_bounds__(NTHREADS, 2) probe_kernel(Params p) {
    extern __shared__ __attribute__((aligned(16))) unsigned char smem[];
    lds_t* lds = (lds_t*)smem;
    const int tid = threadIdx.x, bid = blockIdx.x, nblk = gridDim.x;
#if PROBE_V < 1000
    if (PROBE_V == 1) phase_mla_attn(p, lds, bid, nblk, tid);
    else if (PROBE_V == 2) phase_swa_attn(p, lds, bid, nblk, tid);
    else if (PROBE_V == 3) phase_gm_spatial(p, lds, bid, nblk, tid);
    else if (PROBE_V == 4) phase_ln_a(p, 3, lds, bid, nblk, tid);
    else if (PROBE_V == 5) phase_mla_up(p, 1, lds, bid, nblk, tid);
    else phase_moe_up<0>(p, 0, lds, bid, nblk, tid);
#else
    const int lane = tid & 63, wave = tid >> 6;
    const int u0 = xcd_first_unit(bid, nblk);
    f32x4 acc = (f32x4){0.f, 0.f, 0.f, 0.f};
    for (int u = u0; u < 1024; u += nblk) {
        const int e = u >> 6, w = u & 63, nt = w >> 2;
        const float* wp = p.moe_w_gate + (size_t)e * 1024 * 2048 + nt * 128 + 4 * lane + (size_t)(8 * wave) * 2048;
        const bf16_t* xp = p.H2 + (size_t)((u * 37 + wave * 8 + (lane >> 3)) & 8191) * 1024 + (lane & 7) * 8;
#pragma unroll 2
        for (int kt = 0; kt < 16; ++kt) {
            const float* q = wp + (size_t)((PROBE_V & 1) ? 0 : ((PROBE_V & 4) ? ((kt + (w & 3) * ((PROBE_V >> 4) & 7)) & 15) : ((PROBE_V & 8) ? (kt & 3) : kt))) * 64 * 2048;
#pragma unroll
            for (int i = 0; i < 8; ++i) acc += *(const f32x4*)(q + (size_t)i * 2048);
            if (PROBE_V & 2) {
#pragma unroll
                for (int j = 0; j < 4; ++j) { const u32x4 x = *(const u32x4*)(xp + (size_t)j * 64 * 1024 + kt * 64); acc[0] += __uint_as_float(x.x & 0x3f800000u); }
            }
        }
    }
    if (acc[0] + acc[1] + acc[2] + acc[3] == 12345.678f) p.GST[tid] = acc[0];
#endif
}
#endif
extern "C" void kernel_launch(void* const* d_in, const int* in_sizes, int n_in, void* d_out, int out_size, void* d_ws, size_t ws_size, hipStream_t stream) {
    static int grid = 0;
    if (grid == 0) {
        int dev = 0, cus = 0, per_cu = 0;
        if (hipGetDevice(&dev) != hipSuccess || hipDeviceGetAttribute(&cus, hipDeviceAttributeMultiprocessorCount, dev) != hipSuccess) { fprintf(stderr, "kernel_launch: device query failed\n"); grid = -1; return; }
        if (hipFuncSetAttribute((const void*)fwd_kernel, hipFuncAttributeMaxDynamicSharedMemorySize, LDS_BYTES) != hipSuccess) { fprintf(stderr, "kernel_launch: hipFuncSetAttribute failed\n"); grid = -1; return; }
        if (hipOccupancyMaxActiveBlocksPerMultiprocessor(&per_cu, (const void*)fwd_kernel, NTHREADS, LDS_BYTES) != hipSuccess || per_cu < 1) {
            fprintf(stderr, "kernel_launch: occupancy query reports %d blocks per CU\n", per_cu); (void)hipGetLastError(); per_cu = 1; }
        grid = cus;
    }
    if (grid < 0) return;
    unsigned char* ws = (unsigned char*)d_ws;
    size_t off = 0;
    auto take = [&](size_t bytes) { unsigned char* r = ws + off; off += (bytes + 255) & ~(size_t)255; return r; };
    Params p{};
    const float* const* in = (const float* const*)d_in;
    p.x_prompt = in[0]; p.x_sample = in[1]; p.cache_ckv = in[2]; p.cache_kpe = in[3]; p.cache_k = in[4]; p.cache_v = in[5]; p.c = in[6]; p.c_ctx = in[7];
    p.mod_w = in[8]; p.mod_b = in[9]; p.ln_gain = in[10]; p.ln_bias = in[11];
    p.mla_w_in = in[12]; p.mla_q_gain = in[13]; p.mla_kv_gain = in[14]; p.mla_w_q_up = in[15]; p.mla_w_kv_up = in[16]; p.mla_w_out = in[17];
    p.gm_w_in = in[18]; p.gm_v_gain = in[19]; p.gm_w_s = in[20]; p.gm_b_s = in[21]; p.gm_w_out = in[22];
    p.swa_w_qkv = in[23]; p.swa_sink = in[24]; p.swa_w_out = in[25];
    p.moe_router = in[26]; p.moe_w_gate = in[27]; p.moe_w_up = in[28]; p.moe_w_down = in[29];
    p.out = (float*)d_out;
    p.bar = (unsigned*)take(16384);
    p.mod = (float*)take((size_t)DEPTH * 5 * 6144 * 4);
    p.X0 = (float*)take((size_t)NTOK * D * 4); p.X1 = (float*)take((size_t)NTOK * D * 4); p.T = (float*)take((size_t)NTOK * D * 4);
    p.Z = (float*)take((size_t)NTOK * 704 * 4); p.GST = (float*)take((size_t)NTOK * 96 * 4); p.AFF = (float*)take((size_t)NTOK * 16 * 4); p.GATEV = (float*)take(16 * 1024 * 4);
    p.H = (bf16_t*)take((size_t)NTOK * D * 2); p.H2 = (bf16_t*)take((size_t)NTOK * D * 2);
    p.CQ = (bf16_t*)take((size_t)NTOK * 384 * 2); p.CKV = (bf16_t*)take((size_t)NROWS_KV * 256 * 2); p.KPE = (bf16_t*)take((size_t)NROWS_KV * 64 * 2);
    p.Q = (bf16_t*)take((size_t)NTOK * 1536 * 2); p.KN = (bf16_t*)take((size_t)NROWS_KV * 1024 * 2);
    p.VTP = (bf16_t*)take((size_t)16 * 8 * 128 * 256 * 2); p.VTS = (bf16_t*)take((size_t)4 * 8 * 128 * 1280 * 2);
    p.O = (bf16_t*)take((size_t)NTOK * D * 2);
    p.U = (bf16_t*)take((size_t)NTOK * 3072 * 2); p.GVT = (bf16_t*)take((size_t)NTOK * 3072 * 2); p.TT = (bf16_t*)take((size_t)NTOK * 3072 * 2);
    p.SK = (bf16_t*)take((size_t)NROWS_KV * 256 * 2); p.SVTP = (bf16_t*)take((size_t)16 * 4 * 64 * 256 * 2); p.SVTS = (bf16_t*)take((size_t)4 * 4 * 64 * 1280 * 2);
    p.HID = (bf16_t*)take((size_t)16 * 1024 * 2048 * 2); p.YE = (bf16_t*)take((size_t)16 * 1024 * 1024 * 2);
    p.SEL = (int*)take((size_t)NTOK * 16 * 4); p.IDX = (int*)take(16 * 1024 * 4);
    p.WTI = (bf16_t*)take((size_t)2 * 704 * 1024 * 2); p.WTQ = (bf16_t*)take((size_t)2 * 1536 * 384 * 2); p.WTKV = (bf16_t*)take((size_t)2 * 2048 * 256 * 2); p.WTO = (bf16_t*)take((size_t)2 * 1024 * 1024 * 2);
    p.WTGI = (bf16_t*)take((size_t)6144 * 1024 * 2); p.WTGO = (bf16_t*)take((size_t)1024 * 3072 * 2); p.WTSQ = (bf16_t*)take((size_t)1536 * 1024 * 2); p.WTSO = (bf16_t*)take((size_t)1024 * 1024 * 2);
    if (off > ws_size) { fprintf(stderr, "kernel_launch: workspace too small: need %zu, have %zu\n", off, ws_size); return; }
    (void)in_sizes; (void)n_in; (void)out_size;
    if (hipMemsetAsync(p.bar, 0, 16384, stream) != hipSuccess) { fprintf(stderr, "kernel_launch: memset failed\n"); return; }
#if N_LAUNCH_PER_PHASE
#ifndef MAX_PHASE
#define MAX_PHASE N_PHASES
#endif
    for (int k = 0; k < MAX_PHASE; ++k) {
        if (k >= 2) { const int li = (k - 2) / 10, s = (k - 2) % 10, kind = li % 3; if (kind != 0 && (s == 3 || s == 4)) continue; }
        p.ph_lo = k; p.ph_hi = k + 1;
        hipLaunchKernelGGL(fwd_kernel, dim3(grid), dim3(NTHREADS), LDS_BYTES, stream, p);
    }
#else
    p.ph_lo = 0; p.ph_hi = N_PHASES;
    hipLaunchKernelGGL(fwd_kernel, dim3(grid), dim3(NTHREADS), LDS_BYTES, stream, p);
#endif
#ifdef PROBE_V
    { static int once = 0; if (!once) { once = 1; (void)hipFuncSetAttribute((const void*)probe_kernel, hipFuncAttributeMaxDynamicSharedMemorySize, LDS_BYTES); }
      hipLaunchKernelGGL(probe_kernel, dim3(grid), dim3(NTHREADS), LDS_BYTES, stream, p); }
#endif
    const hipError_t le = hipPeekAtLastError();
    if (le != hipSuccess) fprintf(stderr, "kernel_launch: launch failed: %s\n", hipGetErrorName(le));
}
```

```cpp
#include <hip/hip_runtime.h>
#include <stdint.h>
#include <stdio.h>

#ifndef N_LAUNCH_PER_PHASE
#define N_LAUNCH_PER_PHASE 0
#endif

#define DEVI __device__ __forceinline__
#define LAS __attribute__((address_space(3)))
typedef unsigned short bf16_t;
typedef short bf16x8 __attribute__((ext_vector_type(8)));
typedef float f32x4 __attribute__((ext_vector_type(4)));
typedef float f32x2 __attribute__((ext_vector_type(2)));
typedef unsigned u32x4 __attribute__((ext_vector_type(4)));
typedef unsigned u32x2 __attribute__((ext_vector_type(2)));
typedef LAS unsigned char lds_t;

constexpr int D = 1024;
constexpr int NTOK = 8192, NPR = 4096;
constexpr int NROWS_KV = 9216;
constexpr int DEPTH = 4;
constexpr float ALPHA_F = 1.681792830507429f;
constexpr float EPS_F = 1e-6f;
constexpr float LOG2E = 1.4426950408889634f;
constexpr int NTHREADS = 512;
constexpr int LDS_MAIN = 147456;
constexpr int LDS_BYTES = LDS_MAIN + 1024;

__device__ const float rope_tab[64 * 16 * 2] = {
1.000000000e+00f,0.000000000e+00f,1.000000000e+00f,0.000000000e+00f,1.000000000e+00f,0.000000000e+00f,1.000000000e+00f,0.000000000e+00f,1.000000000e+00f,0.000000000e+00f,1.000000000e+00f,0.000000000e+00f,1.000000000e+00f,0.000000000e+00f,1.000000000e+00f,0.000000000e+00f,1.000000000e+00f,0.000000000e+00f,1.000000000e+00f,0.000000000e+00f,1.000000000e+00f,0.000000000e+00f,1.000000000e+00f,0.000000000e+00f,1.000000000e+00f,0.000000000e+00f,1.000000000e+00f,0.000000000e+00f,1.000000000e+00f,0.000000000e+00f,1.000000000e+00f,0.000000000e+00f,
5.403023059e-01f,8.414709848e-01f,8.460091064e-01f,5.331684460e-01f,9.504152809e-01f,3.109835909e-01f,9.842302348e-01f,1.768921847e-01f,9.950041651e-01f,9.983341813e-02f,9.984192778e-01f,5.620449919e-02f,9.995000417e-01f,3.161750470e-02f,9.998418903e-01f,1.778185709e-02f,9.999500004e-01f,9.999833111e-03f,9.999841887e-01f,5.623383612e-03f,9.999950000e-01f,3.162272359e-03f,9.999984189e-01f,1.778278494e-03f,9.999995000e-01f,9.999998808e-04f,9.999998419e-01f,5.623412721e-04f,9.999999500e-01f,3.162277519e-04f,9.999999842e-01f,1.778279393e-04f,
-4.161468365e-01f,9.092974268e-01f,4.314628163e-01f,9.021307212e-01f,8.065784124e-01f,5.911271138e-01f,9.374183100e-01f,3.482052729e-01f,9.800665772e-01f,1.986693337e-01f,9.936821085e-01f,1.122313110e-01f,9.980006668e-01f,6.320339453e-02f,9.993676111e-01f,3.555809121e-02f,9.998000067e-01f,1.999866625e-02f,9.999367551e-01f,1.124658940e-02f,9.999800001e-01f,6.324513096e-03f,9.999936755e-01f,3.556551364e-03f,9.999980000e-01f,1.999998762e-03f,9.999993675e-01f,1.124682366e-03f,9.999998000e-01f,6.324554721e-04f,9.999999368e-01f,3.556558729e-04f,
-9.899924966e-01f,1.411200081e-01f,-1.159661631e-01f,9.932531646e-01f,5.827536401e-01f,8.126488756e-01f,8.610406595e-01f,5.085361174e-01f,9.553364856e-01f,2.955202180e-01f,9.858034692e-01f,1.679033061e-01f,9.955033745e-01f,9.472608625e-02f,9.985773124e-01f,5.332308304e-02f,9.995500338e-01f,2.999549953e-02f,9.998577009e-01f,1.686943954e-02f,9.999550003e-01f,9.486690354e-03f,9.999857698e-01f,5.334812988e-03f,9.999955000e-01f,2.999995526e-03f,9.999985770e-01f,1.687023105e-03f,9.999995500e-01f,9.486831000e-04f,9.999998577e-01f,5.334837808e-04f,
-6.536436209e-01f,-7.568024953e-01f,-6.276796763e-01f,7.784717233e-01f,3.011374707e-01f,9.535807379e-01f,7.575061759e-01f,6.528279969e-01f,9.210609917e-01f,3.894183478e-01f,9.748082657e-01f,2.230444915e-01f,9.920106618e-01f,1.261540598e-01f,9.974712443e-01f,7.107120934e-02f,9.992001067e-01f,3.998933329e-02f,9.997470285e-01f,2.249175622e-02f,9.999200011e-01f,1.264877321e-02f,9.999747019e-01f,7.113057742e-03f,9.999920000e-01f,3.999989523e-03f,9.999974702e-01f,2.249363310e-03f,9.999992000e-01f,1.264910691e-03f,9.999997470e-01f,7.113117008e-04f,
2.836621855e-01f,-9.589242747e-01f,-9.460792425e-01f,3.239352821e-01f,-1.034233808e-02f,9.999465166e-01f,6.300802992e-01f,7.765299843e-01f,8.775825619e-01f,4.794255386e-01f,9.607312596e-01f,2.774805341e-01f,9.875260225e-01f,1.574558824e-01f,9.960497565e-01f,8.879686156e-02f,9.987502605e-01f,4.997916629e-02f,9.996047413e-01f,2.811336165e-02f,9.998750026e-01f,1.581072865e-02f,9.999604718e-01f,8.891280002e-03f,9.999875000e-01f,4.999979521e-03f,9.999960472e-01f,2.811702920e-03f,9.999987500e-01f,1.581138156e-03f,9.999996047e-01f,8.891395984e-04f,
9.601702867e-01f,-2.794154982e-01f,-9.731036980e-01f,-2.303675170e-01f,-3.207963899e-01f,9.471481807e-01f,4.827820346e-01f,8.757405478e-01f,8.253356014e-01f,5.646424931e-01f,9.436169596e-01f,3.310393232e-01f,9.820539372e-01f,1.886002770e-01f,9.943132976e-01f,1.064944419e-01f,9.982005400e-01f,5.996400514e-02f,9.994308440e-01f,3.373407806e-02f,9.998200054e-01f,1.897252691e-02f,9.999430795e-01f,1.066947415e-02f,9.999820001e-01f,5.999964052e-03f,9.999943079e-01f,3.374041408e-03f,9.999982000e-01f,1.897365346e-03f,9.999994308e-01f,1.066967410e-03f,
7.539022543e-01f,6.569865987e-01f,-7.004298139e-01f,-7.137212872e-01f,-5.994374526e-01f,8.004216016e-01f,3.202570024e-01f,9.473306986e-01f,7.648421950e-01f,6.442176781e-01f,9.235194568e-01f,3.835515778e-01f,9.755998794e-01f,2.195560870e-01f,9.922624183e-01f,1.241583392e-01f,9.975510002e-01f,6.994284763e-02f,9.992253421e-01f,3.935372584e-02f,9.997550100e-01f,2.213413545e-02f,9.999225252e-01f,1.244763455e-02f,9.999755001e-01f,6.999943050e-03f,9.999922524e-01f,3.936378830e-03f,9.999975500e-01f,2.213592463e-03f,9.999992252e-01f,1.244795304e-03f,
-1.455000338e-01f,9.893582466e-01f,-2.120364479e-01f,-9.772617586e-01f,-8.186324475e-01f,5.743177830e-01f,1.476312130e-01f,9.890424788e-01f,6.967067008e-01f,7.173560992e-01f,9.005023096e-01f,4.348512278e-01f,9.681703064e-01f,2.502923447e-01f,9.898977664e-01f,1.417829752e-01f,9.968017064e-01f,7.991469219e-02f,9.989882418e-01f,4.497213288e-02f,9.996800171e-01f,2.529552265e-02f,9.998988088e-01f,1.422575559e-02f,9.999680002e-01f,7.999915047e-03f,9.999898807e-01f,4.498715239e-03f,9.999968000e-01f,2.529819359e-03f,9.999989881e-01f,1.422623042e-03f,
-9.111302619e-01f,4.121184852e-01f,3.416602554e-01f,-9.398235313e-01f,-9.566441680e-01f,2.912592245e-01f,-2.965079623e-02f,9.995603185e-01f,6.216099403e-01f,7.833269319e-01f,8.746382611e-01f,4.847761465e-01f,9.597726443e-01f,2.807783310e-01f,9.872200896e-01f,1.593627767e-01f,9.959527334e-01f,8.987854534e-02f,9.987195508e-01f,5.058911778e-02f,9.995950273e-01f,2.845665689e-02f,9.998719305e-01f,1.600383071e-02f,9.999595003e-01f,8.999879044e-03f,9.999871928e-01f,5.061050226e-03f,9.999959500e-01f,2.846046001e-03f,9.999987193e-01f,1.600450735e-03f,
-8.390715291e-01f,-5.440211109e-01f,7.901318660e-01f,-6.129368926e-01f,-9.997860721e-01f,-2.068356987e-02f,-2.059976331e-01f,9.785524897e-01f,5.403023059e-01f,8.414709848e-01f,8.460091064e-01f,5.331684460e-01f,9.504152902e-01f,3.109835626e-01f,9.842302348e-01f,1.768921847e-01f,9.950041659e-01f,9.983341072e-02f,9.984192778e-01f,5.620449919e-02f,9.995000417e-01f,3.161750470e-02f,9.998418903e-01f,1.778185709e-02f,9.999500004e-01f,9.999834042e-03f,9.999841887e-01f,5.623383612e-03f,9.999950000e-01f,3.162272359e-03f,9.999984189e-01f,1.778278494e-03f,
4.425697988e-03f,-9.999902066e-01f,9.952573993e-01f,-9.727645772e-02f,-9.437797393e-01f,-3.305749593e-01f,-3.758474003e-01f,9.266815697e-01f,4.535961002e-01f,8.912073709e-01f,8.147053420e-01f,5.798751639e-01f,9.401075903e-01f,3.408778647e-01f,9.809291472e-01f,1.943656558e-01f,9.939560980e-01f,1.097783002e-01f,9.980874321e-01f,6.181810327e-02f,9.993950610e-01f,3.477804006e-02f,9.998086883e-01f,1.955982724e-02f,9.999395006e-01f,1.099977904e-02f,9.999808683e-01f,6.185714754e-03f,9.999939500e-01f,3.478498401e-03f,9.999980868e-01f,1.956106080e-03f,
8.438539587e-01f,-5.365729180e-01f,8.938616142e-01f,4.483429653e-01f,-7.941793525e-01f,-6.076834341e-01f,-5.338430142e-01f,8.455836068e-01f,3.623577100e-01f,9.320391032e-01f,7.808259330e-01f,6.247486393e-01f,9.288598710e-01f,3.704312892e-01f,9.773178677e-01f,2.117776794e-01f,9.928086362e-01f,1.197122046e-01f,9.977240240e-01f,6.742975621e-02f,9.992800864e-01f,3.793822392e-02f,9.997723246e-01f,2.133773367e-02f,9.999280009e-01f,1.199971211e-02f,9.999772317e-01f,6.748044406e-03f,9.999928000e-01f,3.794723862e-03f,9.999977232e-01f,2.133933605e-03f,
9.074467815e-01f,4.201670368e-01f,5.171728454e-01f,8.558809777e-01f,-5.658204930e-01f,-8.245284529e-01f,-6.750016657e-01f,7.378162043e-01f,2.674987597e-01f,9.635582046e-01f,7.444779872e-01f,6.676470075e-01f,9.166833698e-01f,3.996143135e-01f,9.733975442e-01f,2.291227201e-01f,9.915618943e-01f,1.296341379e-01f,9.973290651e-01f,7.303927684e-02f,9.991551190e-01f,4.109803212e-02f,9.997327995e-01f,2.311557262e-02f,9.999155012e-01f,1.299963410e-02f,9.999732789e-01f,7.310371924e-03f,9.999915500e-01f,4.110949176e-03f,9.999973279e-01f,2.311761062e-03f,
1.367372182e-01f,9.906073557e-01f,-1.879615160e-02f,9.998233367e-01f,-2.813494808e-01f,-9.596053718e-01f,-7.948709048e-01f,6.067785796e-01f,1.699671664e-01f,9.854497259e-01f,7.057763743e-01f,7.084346897e-01f,9.035902493e-01f,4.283977840e-01f,9.691694136e-01f,2.463953078e-01f,9.902159961e-01f,1.395431152e-01f,9.969025685e-01f,7.864648034e-02f,9.990201601e-01f,4.425742562e-02f,9.996901128e-01f,2.489334034e-02f,9.999020016e-01f,1.399954310e-02f,9.999690098e-01f,7.872696665e-03f,9.999902000e-01f,4.427174080e-03f,9.999969010e-01f,2.489588678e-03f,
-7.596879129e-01f,6.502878402e-01f,-5.489754720e-01f,8.358384600e-01f,3.102235090e-02f,-9.995186910e-01f,-8.896704271e-01f,4.566032536e-01f,7.073720167e-02f,9.974949866e-01f,6.648435293e-01f,7.469826514e-01f,8.895936264e-01f,4.567528653e-01f,9.646348168e-01f,2.635899662e-01f,9.887710793e-01f,1.494381236e-01f,9.964445467e-01f,8.425120425e-02f,9.988752109e-01f,4.741638026e-02f,9.996442648e-01f,2.667102934e-02f,9.998875021e-01f,1.499943810e-02f,9.999644246e-01f,8.435019847e-03f,9.999887500e-01f,4.743398540e-03f,9.999964424e-01f,2.667415984e-03f,
-9.576594803e-01f,-2.879033167e-01f,-9.100810896e-01f,4.144302238e-01f,3.403181682e-01f,-9.403103447e-01f,-9.564100499e-01f,2.920270818e-01f,-2.919954613e-02f,9.995736023e-01f,6.218088193e-01f,7.831690700e-01f,8.747074844e-01f,4.846512321e-01f,9.597951759e-01f,2.807013010e-01f,9.872272839e-01f,1.593182031e-01f,9.959550145e-01f,8.985326392e-02f,9.987202731e-01f,5.057485702e-02f,9.995952558e-01f,2.844863214e-02f,9.998720027e-01f,1.599931810e-02f,9.999595231e-01f,8.997339431e-03f,9.999872000e-01f,5.059622526e-03f,9.999959523e-01f,2.845243204e-03f,
-2.751633381e-01f,-9.613974919e-01f,-9.908979596e-01f,-1.346151313e-01f,6.158647923e-01f,-7.878518627e-01f,-9.929849841e-01f,1.182405237e-01f,-1.288445416e-01f,9.916648043e-01f,5.768082960e-01f,8.168795441e-01f,8.589467084e-01f,5.120649883e-01f,9.546520286e-01f,2.977238725e-01f,9.855847666e-01f,1.691823508e-01f,9.954339876e-01f,9.545248218e-02f,9.985553481e-01f,5.373282803e-02f,9.995430857e-01f,3.022614497e-02f,9.998555035e-01f,1.699918210e-02f,9.999543054e-01f,9.559656169e-03f,9.999855500e-01f,5.375846007e-03f,9.999954305e-01f,3.023070335e-03f,
6.603167082e-01f,-7.509872468e-01f,-7.665365398e-01f,-6.422006954e-01f,8.303361283e-01f,-5.572628770e-01f,-9.982416606e-01f,-5.927551864e-02f,-2.272021643e-01f,9.738476146e-01f,5.299841756e-01f,8.480075316e-01f,8.423270577e-01f,5.389667224e-01f,9.492070108e-01f,3.146522695e-01f,9.838436942e-01f,1.790295658e-01f,9.948814823e-01f,1.010486820e-01f,9.983804374e-01f,5.689026544e-02f,9.994877548e-01f,3.200356222e-02f,9.998380044e-01f,1.799902910e-02f,9.999487715e-01f,1.012197082e-02f,9.999838000e-01f,5.692068949e-03f,9.999948771e-01f,3.200897370e-03f,
9.887046182e-01f,1.498772097e-01f,-3.060954058e-01f,-9.520008417e-01f,9.624637956e-01f,-2.714100995e-01f,-9.720142724e-01f,-2.349218044e-01f,-3.232895443e-01f,9.463000954e-01f,4.814845890e-01f,8.764545570e-01f,8.248651506e-01f,5.653295351e-01f,9.434618259e-01f,3.314811956e-01f,9.820042356e-01f,1.888588926e-01f,9.942975170e-01f,1.066416789e-01f,9.981955430e-01f,6.004713022e-02f,9.994292631e-01f,3.378088199e-02f,9.998195054e-01f,1.899885811e-02f,9.999429214e-01f,1.068428133e-02f,9.999819501e-01f,6.008291323e-03f,9.999942921e-01f,3.378724537e-03f,
4.080820618e-01f,9.129452507e-01f,2.486167313e-01f,-9.686019414e-01f,9.991443799e-01f,4.135829015e-02f,-9.151299503e-01f,-4.031589936e-01f,-4.161468365e-01f,9.092974268e-01f,4.314628163e-01f,9.021307212e-01f,8.065784476e-01f,5.911270657e-01f,9.374183100e-01f,3.482052729e-01f,9.800665802e-01f,1.986693191e-01f,9.936821085e-01f,1.122313110e-01f,9.980006668e-01f,6.320339453e-02f,9.993676111e-01f,3.555809121e-02f,9.998000066e-01f,1.999866811e-02f,9.999367551e-01f,1.124658940e-02f,9.999800001e-01f,6.324513096e-03f,9.999936755e-01f,3.556551364e-03f,
-5.477292602e-01f,8.366556385e-01f,7.267602563e-01f,-6.868912067e-01f,9.367404516e-01f,3.500247509e-01f,-8.293829489e-01f,-5.586805205e-01f,-5.048462281e-01f,8.632092944e-01f,3.800769984e-01f,9.249548504e-01f,7.874851971e-01f,6.163335658e-01f,9.310783539e-01f,3.648192688e-01f,9.780309161e-01f,2.084598934e-01f,9.930352772e-01f,1.178173940e-01f,9.977958103e-01f,6.635903053e-02f,9.993027988e-01f,3.733518799e-02f,9.997795081e-01f,2.099845811e-02f,9.999302726e-01f,1.180889298e-02f,9.999779501e-01f,6.640734236e-03f,9.999930272e-01f,3.734378079e-03f,
-9.999608264e-01f,-8.851309290e-03f,9.810745815e-01f,-1.936302286e-01f,7.814403926e-01f,6.239798978e-01f,-7.174774633e-01f,-6.965817179e-01f,-5.885011558e-01f,8.084963758e-01f,3.274895886e-01f,9.448547874e-01f,7.676045628e-01f,6.409237359e-01f,9.244439837e-01f,3.813178741e-01f,9.758974496e-01f,2.182296219e-01f,9.923570442e-01f,1.233997439e-01f,9.975809759e-01f,6.951400294e-02f,9.992348263e-01f,3.911217043e-02f,9.997580097e-01f,2.199822712e-02f,9.999234739e-01f,1.237119282e-02f,9.999758001e-01f,6.956954712e-03f,9.999923473e-01f,3.912204676e-03f,
-5.328330203e-01f,-8.462204042e-01f,9.332357723e-01f,3.592645171e-01f,5.486452564e-01f,8.360552510e-01f,-5.829432350e-01f,-8.125128828e-01f,-6.662759857e-01f,7.457052439e-01f,2.738668392e-01f,9.617676197e-01f,7.469563882e-01f,6.648730361e-01f,9.175172750e-01f,3.976959268e-01f,9.736663975e-01f,2.279775131e-01f,9.916474294e-01f,1.289781990e-01f,9.973561656e-01f,7.266828020e-02f,9.991636941e-01f,4.088902546e-02f,9.997355116e-01f,2.299797413e-02f,9.999163589e-01f,1.293348969e-02f,9.999735501e-01f,7.273174492e-03f,9.999916358e-01f,4.090031381e-03f,
4.241790073e-01f,-9.055783620e-01f,5.979771709e-01f,8.015131335e-01f,2.614416878e-01f,9.652192724e-01f,-4.300232723e-01f,-9.028178029e-01f,-7.373937800e-01f,6.754631102e-01f,2.193782753e-01f,9.756398784e-01f,7.255613200e-01f,6.881575190e-01f,9.103004290e-01f,4.139482201e-01f,9.713379761e-01f,2.377026212e-01f,9.909064560e-01f,1.345525754e-01f,9.971213823e-01f,7.582182336e-02f,9.990894022e-01f,4.266575118e-02f,9.997120138e-01f,2.399769627e-02f,9.999089278e-01f,1.349578153e-02f,9.999712001e-01f,7.589393080e-03f,9.999908927e-01f,4.267857492e-03f,
9.912028119e-01f,-1.323517501e-01f,7.855226359e-02f,9.969099969e-01f,-5.168932904e-02f,9.986632131e-01f,-2.635405934e-01f,-9.646483067e-01f,-8.011436155e-01f,5.984721441e-01f,1.641961594e-01f,9.864277070e-01f,7.034407513e-01f,7.107539022e-01f,9.027957408e-01f,4.300695879e-01f,9.689124217e-01f,2.474039593e-01f,9.901341474e-01f,1.401226969e-01f,9.968766273e-01f,7.897461572e-02f,9.990119510e-01f,4.444234199e-02f,9.996875163e-01f,2.499739629e-02f,9.999011805e-01f,1.405806910e-02f,9.999687502e-01f,7.905611374e-03f,9.999901179e-01f,4.445683934e-03f,
6.469193223e-01f,7.625584505e-01f,-4.650644959e-01f,8.852768012e-01f,-3.596943393e-01f,9.330701915e-01f,-8.874550263e-02f,-9.960543337e-01f,-8.568888271e-01f,5.155012492e-01f,1.084949468e-01f,9.940970006e-01f,6.806168009e-01f,7.326395911e-01f,8.950055582e-01f,4.460549862e-01f,9.663899806e-01f,2.570805427e-01f,9.893305281e-01f,1.456883874e-01f,9.966219035e-01f,8.212661834e-02f,9.989313406e-01f,4.621879226e-02f,9.996620190e-01f,2.599707130e-02f,9.998931169e-01f,1.462035317e-02f,9.999662002e-01f,8.221828878e-03f,9.999893115e-01f,4.623509769e-03f,
-2.921388087e-01f,9.563759284e-01f,-8.654506342e-01f,5.009942114e-01f,-6.320286307e-01f,7.749450367e-01f,8.884811635e-02f,-9.960451858e-01f,-9.040721624e-01f,4.273798371e-01f,5.245061444e-02f,9.986235192e-01f,6.571122908e-01f,7.537927018e-01f,8.869323709e-01f,4.618993066e-01f,9.637709015e-01f,2.667314183e-01f,9.884956235e-01f,1.512494708e-01f,9.963572141e-01f,8.527779227e-02f,9.988475711e-01f,4.799510009e-02f,9.996355221e-01f,2.699672032e-02f,9.998847372e-01f,1.518263167e-02f,9.999635502e-01f,8.538045559e-03f,9.999884735e-01f,4.801335923e-03f,
-9.626058663e-01f,2.709057883e-01f,-9.992934094e-01f,-3.758566202e-02f,-8.416849393e-01f,5.399689462e-01f,2.636395107e-01f,-9.646212772e-01f,-9.422223247e-01f,3.349881951e-01f,-3.759419011e-03f,9.999929334e-01f,6.329506774e-01f,7.741921209e-01f,8.785787046e-01f,4.775975920e-01f,9.610554380e-01f,2.763556497e-01f,9.876294623e-01f,1.568057565e-01f,9.960825606e-01f,8.842812085e-02f,9.987606432e-01f,4.977125243e-02f,9.996080256e-01f,2.799634234e-02f,9.998760413e-01f,1.574490538e-02f,9.999608003e-01f,8.854261387e-03f,9.999876039e-01f,4.979161926e-03f,
-7.480575297e-01f,-6.636338842e-01f,-8.253716334e-01f,-5.645898217e-01f,-9.678715076e-01f,2.514453117e-01f,4.301158485e-01f,-9.027737019e-01f,-9.709581880e-01f,2.392492366e-01f,-5.995756728e-02f,9.982009267e-01f,6.081562113e-01f,7.938173736e-01f,8.699472142e-01f,4.931448515e-01f,9.582438779e-01f,2.859522171e-01f,9.867320673e-01f,1.623570984e-01f,9.957979462e-01f,9.157756515e-02f,9.986705569e-01f,5.154724737e-02f,9.995795294e-01f,2.899593637e-02f,9.998670292e-01f,1.630717503e-02f,9.999579503e-01f,9.170476329e-03f,9.999867027e-01f,5.156987306e-03f,
1.542514499e-01f,-9.880316241e-01f,-3.972518623e-01f,-9.177096261e-01f,-9.980752275e-01f,-6.201483913e-02f,5.830269376e-01f,-8.124528233e-01f,-9.899924966e-01f,1.411200081e-01f,-1.159661631e-01f,9.932531646e-01f,5.827536401e-01f,8.126488756e-01f,8.610406595e-01f,5.085361174e-01f,9.553364944e-01f,2.955201896e-01f,9.858034692e-01f,1.679033061e-01f,9.955033738e-01f,9.472609366e-02f,9.985773124e-01f,5.332308304e-02f,9.995500337e-01f,2.999550139e-02f,9.998577009e-01f,1.686943954e-02f,9.999550003e-01f,9.486690354e-03f,9.999857698e-01f,5.334812988e-03f,
9.147423578e-01f,-4.040376453e-01f,1.532154756e-01f,-9.881928041e-01f,-9.293002953e-01f,-3.693250075e-01f,7.175492218e-01f,-6.965077991e-01f,-9.991351562e-01f,4.158051951e-02f,-1.716081385e-01f,9.851652891e-01f,5.567683641e-01f,8.306677968e-01f,8.518617972e-01f,5.237666260e-01f,9.523335692e-01f,3.050586387e-01f,9.848436973e-01f,1.734442042e-01f,9.951988471e-01f,9.787366751e-02f,9.984809103e-01f,5.509874635e-02f,9.995195384e-01f,3.099503643e-02f,9.998480564e-01f,1.743169684e-02f,9.999519504e-01f,9.802903431e-03f,9.999848053e-01f,5.512638036e-03f,
8.342233605e-01f,5.514266812e-01f,6.564951791e-01f,-7.543302193e-01f,-7.683670888e-01f,-6.400093881e-01f,8.294403670e-01f,-5.585952717e-01f,-9.982947730e-01f,-5.837419103e-02f,-2.267075845e-01f,9.739628695e-01f,5.302263665e-01f,8.478561200e-01f,8.424135592e-01f,5.388315091e-01f,9.492354203e-01f,3.145665538e-01f,9.838527819e-01f,1.789796175e-01f,9.948843677e-01f,1.010202700e-01f,9.983813507e-01f,5.687423543e-02f,9.994880436e-01f,3.199454047e-02f,9.998380958e-01f,1.799395049e-02f,9.999488004e-01f,1.011911553e-02f,9.999838092e-01f,5.690463375e-03f,
-1.327674722e-02f,9.999118601e-01f,9.575860738e-01f,-2.881473778e-01f,-5.312352786e-01f,-8.472243379e-01f,9.151713830e-01f,-4.030649323e-01f,-9.874797774e-01f,-1.577456471e-01f,-2.810903074e-01f,9.596813216e-01f,5.031541870e-01f,8.641966582e-01f,8.326989334e-01f,5.537260030e-01f,9.460423489e-01f,3.240430126e-01f,9.828307545e-01f,1.845093711e-01f,9.945599394e-01f,1.041658623e-01f,9.982786339e-01f,5.864954466e-02f,9.994555494e-01f,3.299401065e-02f,9.998278189e-01f,1.855619846e-02f,9.999455505e-01f,1.043532661e-02f,9.999827814e-01f,5.868288535e-03f,
-8.485702748e-01f,5.290826861e-01f,9.637575328e-01f,2.667797179e-01f,-2.414211151e-01f,-9.704204476e-01f,9.720383571e-01f,-2.348221291e-01f,-9.667981682e-01f,-2.555411942e-01f,-3.345843792e-01f,9.423657958e-01f,4.755788956e-01f,8.796730723e-01f,8.227209915e-01f,5.684453977e-01f,9.427546643e-01f,3.334870955e-01f,9.817776473e-01f,1.900332899e-01f,9.942255664e-01f,1.073104056e-01f,9.981727603e-01f,6.042466843e-02f,9.994220556e-01f,3.399345156e-02f,9.998172259e-01f,1.911843869e-02f,9.999422006e-01f,1.075153665e-02f,9.999817221e-01f,6.046113043e-03f,
-9.036922051e-01f,-4.281826695e-01f,6.731102676e-01f,7.395421338e-01f,7.233466718e-02f,-9.973804169e-01f,9.982477619e-01f,-5.917267879e-02f,-9.364566873e-01f,-3.507832277e-01f,-3.870206816e-01f,9.220710342e-01f,4.475280652e-01f,8.942698871e-01f,8.124829236e-01f,5.829849902e-01f,9.393727149e-01f,3.428978019e-01f,9.806934936e-01f,1.955511994e-01f,9.938812503e-01f,1.104538832e-01f,9.980637300e-01f,6.219960483e-02f,9.993875625e-01f,3.499285475e-02f,9.998063168e-01f,1.968067474e-02f,9.999387506e-01f,1.106774562e-02f,9.999806311e-01f,6.223937825e-03f,
-1.279636896e-01f,-9.917788534e-01f,1.751565337e-01f,9.845405978e-01f,3.789161719e-01f,-9.254309994e-01f,9.929728258e-01f,1.183425843e-01f,-8.967583530e-01f,-4.425205716e-01f,-4.382335472e-01f,8.988611451e-01f,4.190297442e-01f,9.079725070e-01f,8.019878986e-01f,5.973402803e-01f,9.358968291e-01f,3.522742188e-01f,9.795783277e-01f,2.010629250e-01f,9.935269954e-01f,1.135962562e-01f,9.979515440e-01f,6.397433710e-02f,9.993520699e-01f,3.599222668e-02f,9.997950914e-01f,2.024290457e-02f,9.999352007e-01f,1.138395348e-02f,9.999795085e-01f,6.401761945e-03f,
7.654140519e-01f,-6.435381334e-01f,-3.767422893e-01f,9.263181135e-01f,6.479216888e-01f,-7.617069550e-01f,9.563800296e-01f,2.921253822e-01f,-8.481000064e-01f,-5.298361813e-01f,-4.880608524e-01f,8.728096037e-01f,3.901124287e-01f,9.207672306e-01f,7.912392691e-01f,6.115066795e-01f,9.323273439e-01f,3.616154364e-01f,9.784321880e-01f,2.065682779e-01f,9.931628052e-01f,1.167374932e-01f,9.978362017e-01f,6.574887451e-02f,9.993155781e-01f,3.699155889e-02f,9.997835499e-01f,2.080512613e-02f,9.999315508e-01f,1.170016020e-02f,9.999783543e-01f,6.579586328e-03f,
9.550736440e-01f,2.963685787e-01f,-8.126112051e-01f,5.828061679e-01f,8.526731157e-01f,-5.224447891e-01f,8.896234916e-01f,4.566946935e-01f,-7.909677411e-01f,-6.118578532e-01f,-5.363451811e-01f,8.439987244e-01f,3.608050334e-01f,9.326412643e-01f,7.802404339e-01f,6.254797082e-01f,9.286646373e-01f,3.709204650e-01f,9.772551046e-01f,2.120671131e-01f,9.927886843e-01f,1.198775555e-01f,9.977177040e-01f,6.752320399e-02f,9.992780868e-01f,3.799085783e-02f,9.997716923e-01f,2.136734297e-02f,9.999278009e-01f,1.201636575e-02f,9.999771684e-01f,6.757410504e-03f,
2.666429324e-01f,9.637953863e-01f,-9.982103598e-01f,5.980031485e-02f,9.728653499e-01f,-2.313720187e-01f,7.948083899e-01f,6.068604645e-01f,-7.259322386e-01f,-6.877662284e-01f,-5.829338849e-01f,8.125195911e-01f,3.311368634e-01f,9.435827349e-01f,7.689949093e-01f,6.392549018e-01f,9.249090653e-01f,3.801884019e-01f,9.760471178e-01f,2.175592422e-01f,9.924046346e-01f,1.230164264e-01f,9.975960518e-01f,6.929731252e-02f,9.992395964e-01f,3.899011506e-02f,9.997595184e-01f,2.192955306e-02f,9.999239510e-01f,1.233257010e-02f,9.999759510e-01f,6.935234000e-03f,
-6.669380617e-01f,7.451131605e-01f,-8.763794418e-01f,-4.816212973e-01f,9.965789837e-01f,8.264580634e-02f,6.749256518e-01f,7.378857395e-01f,-6.536436209e-01f,-7.568024953e-01f,-6.276796763e-01f,7.784717233e-01f,3.011375844e-01f,9.535807020e-01f,7.575061759e-01f,6.528279969e-01f,9.210610033e-01f,3.894183203e-01f,9.748082657e-01f,2.230444915e-01f,9.920106618e-01f,1.261540598e-01f,9.974712443e-01f,7.107120934e-02f,9.992001065e-01f,3.998933702e-02f,9.997470285e-01f,2.249175622e-02f,9.999200011e-01f,1.264877321e-02f,9.999747019e-01f,7.113057742e-03f,
-9.873392775e-01f,-1.586226688e-01f,-4.846393970e-01f,-8.747140418e-01f,9.214623472e-01f,3.884676855e-01f,5.337561004e-01f,8.456384720e-01f,-5.748240246e-01f,-8.182770562e-01f,-6.704410942e-01f,7.419627614e-01f,2.708370782e-01f,9.626252007e-01f,7.457779040e-01f,6.661946547e-01f,9.171208242e-01f,3.986093247e-01f,9.735385875e-01f,2.285226875e-01f,9.916067680e-01f,1.292904390e-01f,9.973432826e-01f,7.284488142e-02f,9.991596177e-01f,4.098851526e-02f,9.997342224e-01f,2.305395040e-02f,9.999159512e-01f,1.296497506e-02f,9.999734212e-01f,7.290880793e-03f,
-3.999853150e-01f,-9.165215479e-01f,5.636094028e-02f,-9.984104589e-01f,7.549653475e-01f,6.557646866e-01f,3.757521519e-01f,9.267201953e-01f,-4.902605720e-01f,-8.715759127e-01f,-7.110829506e-01f,7.031081264e-01f,2.402658714e-01f,9.707071191e-01f,7.338138022e-01f,6.793506485e-01f,9.130889457e-01f,4.077604411e-01f,9.722381233e-01f,2.339936570e-01f,9.911929581e-01f,1.324255253e-01f,9.972121675e-01f,7.461831571e-02f,9.991181295e-01f,4.198765625e-02f,9.997211001e-01f,2.361613915e-02f,9.999118013e-01f,1.328117562e-02f,9.999721088e-01f,7.468704080e-03f,
5.551133015e-01f,-8.317747426e-01f,5.800031129e-01f,-8.146142578e-01f,5.135984179e-01f,8.580306901e-01f,2.058971709e-01f,9.785736329e-01f,-4.007989973e-01f,-9.161660132e-01f,-7.494767587e-01f,6.620306550e-01f,2.094544189e-01f,9.778184118e-01f,7.216176540e-01f,6.922918182e-01f,9.089657591e-01f,4.168707818e-01f,9.709069144e-01f,2.394572270e-01f,9.907692363e-01f,1.355592873e-01f,9.970778984e-01f,7.639152146e-02f,9.990756424e-01f,4.298675152e-02f,9.997076617e-01f,2.417832043e-02f,9.999075514e-01f,1.359737484e-02f,9.999707649e-01f,7.646527131e-03f,
9.998433086e-01f,1.770192511e-02f,9.250146691e-01f,-3.799313911e-01f,2.212981743e-01f,9.752061926e-01f,2.954782069e-02f,9.995633678e-01f,-3.073327792e-01f,-9.516021032e-01f,-7.855011387e-01f,6.188602113e-01f,1.784335295e-01f,9.839519681e-01f,7.091933579e-01f,7.050140291e-01f,9.047516642e-01f,4.259394629e-01f,9.695450064e-01f,2.449132102e-01f,9.903356068e-01f,1.386916938e-01f,9.969404762e-01f,7.816448565e-02f,9.990321560e-01f,4.398580752e-02f,9.996939072e-01f,2.474049220e-02f,9.999032016e-01f,1.391357271e-02f,9.999693893e-01f,7.824349474e-03f,
5.253219888e-01f,8.509035245e-01f,9.851382016e-01f,1.717635693e-01f,-9.294810554e-02f,9.956709545e-01f,-1.477329862e-01f,9.890272821e-01f,-2.107957994e-01f,-9.775301177e-01f,-8.190422014e-01f,5.737332763e-01f,1.472342216e-01f,9.891016550e-01f,6.965447594e-01f,7.175133435e-01f,9.004471075e-01f,4.349655234e-01f,9.681524315e-01f,2.503614776e-01f,9.898920739e-01f,1.418227133e-01f,9.967999021e-01f,7.993719522e-02f,9.989876708e-01f,4.498481582e-02f,9.996798365e-01f,2.530265802e-02f,9.998987517e-01f,1.422976918e-02f,9.999679821e-01f,8.002171569e-03f,
-4.321779449e-01f,9.017883476e-01f,7.418580135e-01f,6.705569982e-01f,-3.979767653e-01f,9.173954950e-01f,-3.203543695e-01f,9.472977768e-01f,-1.121526217e-01f,-9.936909929e-01f,-8.499939088e-01f,5.267925161e-01f,1.158876918e-01f,9.932623233e-01f,6.836758997e-01f,7.297857660e-01f,8.960525071e-01f,4.439480877e-01f,9.667292484e-01f,2.558017989e-01f,9.894386421e-01f,1.449523146e-01f,9.966561752e-01f,8.170965944e-02f,9.989421864e-01f,4.598378286e-02f,9.996654497e-01f,2.586481583e-02f,9.998942019e-01f,1.454596424e-02f,9.999665433e-01f,8.179994343e-03f,
-9.923354692e-01f,1.235731227e-01f,2.700984580e-01f,9.628327077e-01f,-6.635382560e-01f,7.481423547e-01f,-4.828719382e-01f,8.756909793e-01f,-1.238837738e-02f,-9.999232611e-01f,-8.782584087e-01f,4.781863313e-01f,8.442528403e-02f,9.964298126e-01f,6.705908480e-01f,7.418274156e-01f,8.915682887e-01f,4.528862843e-01f,9.652754871e-01f,2.612340599e-01f,9.889753181e-01f,1.480804517e-01f,9.965092972e-01f,8.348185785e-02f,9.988957032e-01f,4.698270019e-02f,9.996507468e-01f,2.642696360e-02f,9.998895520e-01f,1.486215783e-02f,9.999650728e-01f,8.357815927e-03f,
-6.401443395e-01f,-7.682546613e-01f,-2.848466063e-01f,9.585731119e-01f,-8.632964878e-01f,5.046971113e-01f,-6.301599705e-01f,7.764653318e-01f,8.749917344e-02f,-9.961645921e-01f,-9.037463447e-01f,4.280683876e-01f,5.287845807e-02f,9.986009557e-01f,6.572937422e-01f,7.536344847e-01f,8.869949277e-01f,4.617791660e-01f,9.637912089e-01f,2.666580313e-01f,9.885021022e-01f,1.512071226e-01f,9.963592674e-01f,8.525379969e-02f,9.988482211e-01f,4.798157054e-02f,9.996357278e-01f,2.698910488e-02f,9.998848022e-01f,1.517834901e-02f,9.999635708e-01f,8.535637247e-03f,
3.005925437e-01f,-9.537526528e-01f,-7.520639951e-01f,6.590900905e-01f,-9.774427254e-01f,2.112006594e-01f,-7.575730765e-01f,6.527503610e-01f,1.865124631e-01f,-9.824525948e-01f,-9.263771379e-01f,3.765971301e-01f,2.127875808e-02f,9.997735816e-01f,6.437888326e-01f,7.652032012e-01f,8.823328681e-01f,4.706258703e-01f,9.622764532e-01f,2.720735702e-01f,9.880190013e-01f,1.543322815e-01f,9.962060867e-01f,8.702547193e-02f,9.987997401e-01f,4.898039663e-02f,9.996203926e-01f,2.755123762e-02f,9.998799524e-01f,1.549453961e-02f,9.999620371e-01f,8.713459228e-03f,
9.649660285e-01f,-2.623748537e-01f,-9.876590838e-01f,1.566190737e-01f,-9.946564265e-01f,-1.032404628e-01f,-8.610927113e-01f,5.084479743e-01f,2.836621855e-01f,-9.589242747e-01f,-9.460792425e-01f,3.239352821e-01f,-1.034221888e-02f,9.999465178e-01f,6.300802992e-01f,7.765299843e-01f,8.775825619e-01f,4.794255386e-01f,9.607312596e-01f,2.774805341e-01f,9.875260201e-01f,1.574558971e-01f,9.960497565e-01f,8.879686156e-02f,9.987502604e-01f,4.997917001e-02f,9.996047414e-01f,2.811335979e-02f,9.998750026e-01f,1.581072865e-02f,9.999604718e-01f,8.891280002e-03f,
7.421541968e-01f,6.702291758e-01f,-9.190735378e-01f,-3.940860720e-01f,-9.132301279e-01f,-4.074441477e-01f,-9.374542500e-01f,3.481085020e-01f,3.779776544e-01f,-9.258147184e-01f,-9.627903713e-01f,2.702493312e-01f,-4.195285448e-02f,9.991195914e-01f,6.161725219e-01f,7.876112133e-01f,8.727445123e-01f,4.881772386e-01f,9.591556934e-01f,2.828786946e-01f,9.870231637e-01f,1.605779382e-01f,9.958902758e-01f,9.056797780e-02f,9.986997817e-01f,5.097789714e-02f,9.995887740e-01f,2.867547492e-02f,9.998699528e-01f,1.612691704e-02f,9.999588749e-01f,9.069100495e-03f,
-1.629907808e-01f,9.866275920e-01f,-5.674300293e-01f,-8.234216185e-01f,-7.412399645e-01f,-6.712401321e-01f,-9.842484715e-01f,1.767906850e-01f,4.685169241e-01f,-8.834545217e-01f,-9.764576931e-01f,2.157090023e-01f,-7.352154075e-02f,9.972936293e-01f,6.020698986e-01f,7.984433839e-01f,8.678191892e-01f,4.968801213e-01f,9.575497876e-01f,2.882679384e-01f,9.865104371e-01f,1.636983734e-01f,9.957276465e-01f,9.233880022e-02f,9.986483046e-01f,5.197656957e-02f,9.995724905e-01f,2.923758099e-02f,9.998648031e-01f,1.644310196e-02f,9.999572463e-01f,9.246920701e-03f,
-9.182827862e-01f,3.959251502e-01f,-4.102818995e-02f,-9.991579893e-01f,-4.957418213e-01f,-8.684699457e-01f,-9.999999947e-01f,-1.030206758e-04f,5.543744949e-01f,-8.322673365e-01f,-9.870379993e-01f,1.604867217e-01f,-1.050167117e-01f,9.944704572e-01f,5.877769370e-01f,8.090230357e-01f,8.628070850e-01f,5.055333165e-01f,9.559136100e-01f,2.936480378e-01f,9.859878454e-01f,1.668171717e-01f,9.955618677e-01f,9.410933806e-02f,9.985958286e-01f,5.297519375e-02f,9.995558910e-01f,2.979967596e-02f,9.998595533e-01f,1.675928710e-02f,9.999555861e-01f,9.424741546e-03f,
-8.293098329e-01f,-5.587890489e-01f,4.980096003e-01f,-8.671715159e-01f,-2.010796199e-01f,-9.795749009e-01f,-9.842120244e-01f,-1.769934771e-01f,6.346929496e-01f,-7.727644270e-01f,-9.944978661e-01f,1.047568344e-01f,-1.364068747e-01f,9.906528981e-01f,5.732980611e-01f,8.193468943e-01f,8.577087010e-01f,5.141359589e-01f,9.542471952e-01f,2.990188798e-01f,9.854553963e-01f,1.699342871e-01f,9.953929407e-01f,9.587957830e-02f,9.985423542e-01f,5.397376122e-02f,9.995389754e-01f,3.036176336e-02f,9.998542036e-01f,1.707546870e-02f,9.999538943e-01f,9.602561162e-03f,
2.212675626e-02f,-9.997551734e-01f,8.836693140e-01f,-4.681116785e-01f,1.135217773e-01f,-9.935355082e-01f,-9.373825054e-01f,-3.483016489e-01f,7.086697743e-01f,-7.055403256e-01f,-9.988136461e-01f,4.869599955e-02f,-1.676606422e-01f,9.858447692e-01f,5.586378969e-01f,8.294116591e-01f,8.525245158e-01f,5.226872391e-01f,9.525506134e-01f,3.043802375e-01f,9.849130902e-01f,1.730497178e-01f,9.952208667e-01f,9.764950793e-02f,9.984878810e-01f,5.497227845e-02f,9.995217437e-01f,3.092384116e-02f,9.998487538e-01f,1.739165045e-02f,9.999521709e-01f,9.780380474e-03f,
8.532201077e-01f,-5.215510021e-01f,9.971746360e-01f,7.511820869e-02f,4.168670742e-01f,-9.089674595e-01f,-8.609884168e-01f,-5.086245631e-01f,7.755658183e-01f,-6.312667118e-01f,-9.999717335e-01f,-7.518784889e-03f,-1.987468801e-01f,9.800508546e-01f,5.438010803e-01f,8.392141473e-01f,8.472551097e-01f,5.311861999e-01f,9.508239095e-01f,3.097319700e-01f,9.843609349e-01f,1.761634181e-01f,9.950456449e-01f,9.941913618e-02f,9.984324096e-01f,5.597073698e-02f,9.995041959e-01f,3.148590732e-02f,9.998432041e-01f,1.770782860e-02f,9.999504159e-01f,9.958200408e-03f,
8.998668270e-01f,4.361647552e-01f,8.035690866e-01f,5.952114944e-01f,6.788702112e-01f,-7.342582900e-01f,-7.574391895e-01f,-6.529057162e-01f,8.347129424e-01f,-5.506853038e-01f,-9.979684672e-01f,-6.370979912e-02f,-2.296342702e-01f,9.732769914e-01f,5.287923029e-01f,8.487512594e-01f,8.419009790e-01f,5.396320427e-01f,9.490671287e-01f,3.150739362e-01f,9.837989360e-01f,1.792753567e-01f,9.948672764e-01f,1.011884500e-01f,9.983759396e-01f,5.696914326e-02f,9.994863320e-01f,3.204796724e-02f,9.998375544e-01f,1.802400685e-02f,9.999486292e-01f,1.013601910e-02f,
1.191801354e-01f,9.928726481e-01f,3.624766664e-01f,9.319928467e-01f,8.735505105e-01f,-4.867335058e-01f,-6.300007138e-01f,-7.765945536e-01f,8.855196056e-01f,-4.646020105e-01f,-9.928101803e-01f,-1.196993984e-01f,-2.602920453e-01f,9.655299328e-01f,5.136163109e-01f,8.580199795e-01f,8.364626591e-01f,5.480239228e-01f,9.472803452e-01f,3.204059106e-01f,9.832270991e-01f,1.823855026e-01f,9.946857626e-01f,1.029574365e-01f,9.983184713e-01f,5.796748886e-02f,9.994681521e-01f,3.261001331e-02f,9.998318047e-01f,1.834018143e-02f,9.999468110e-01f,1.031383746e-02f,
-7.710802230e-01f,6.367380071e-01f,-1.902490958e-01f,9.817358512e-01f,9.816020978e-01f,-1.909380047e-01f,-4.826923346e-01f,-8.757899920e-01f,9.274784664e-01f,-3.738765764e-01f,-9.845131804e-01f,-1.753105749e-01f,-2.906895502e-01f,9.568174253e-01f,4.982779032e-01f,8.670173765e-01f,8.309406937e-01f,5.563610011e-01f,9.454635966e-01f,3.257277812e-01f,9.826454300e-01f,1.854938246e-01f,9.945011026e-01f,1.047261048e-01f,9.982600046e-01f,5.896578020e-02f,9.994496561e-01f,3.317204907e-02f,9.998259550e-01f,1.865635603e-02f,9.999449611e-01f,1.049165644e-02f,
-9.524129804e-01f,-3.048106211e-01f,-6.843819158e-01f,7.291237161e-01f,9.923083195e-01f,1.237909494e-01f,-3.201591802e-01f,-9.473637630e-01f,9.601702867e-01f,-2.794154982e-01f,-9.731036980e-01f,-2.303675170e-01f,-3.207963899e-01f,9.471481807e-01f,4.827820346e-01f,8.757405478e-01f,8.253356351e-01f,5.646424439e-01f,9.436169596e-01f,3.310393232e-01f,9.820539344e-01f,1.886002917e-01f,9.943132976e-01f,1.064944419e-01f,9.982005398e-01f,5.996400886e-02f,9.994308440e-01f,3.373407806e-02f,9.998200054e-01f,1.897252691e-02f,9.999430795e-01f,1.066947415e-02f,
-2.581016359e-01f,-9.661177700e-01f,-9.677396624e-01f,2.519522691e-01f,9.046075662e-01f,4.262454119e-01f,-1.475292025e-01f,-9.890577002e-01f,9.832684211e-01f,-1.821625980e-01f,-9.586178037e-01f,-2.846961652e-01f,-3.505824602e-01f,9.365318674e-01f,4.671333972e-01f,8.841868520e-01f,8.196480097e-01f,5.728674718e-01f,9.417404730e-01f,3.363404250e-01f,9.814526211e-01f,1.917048581e-01f,9.941223492e-01f,1.082624348e-01f,9.981400766e-01f,6.096218127e-02f,9.994117160e-01f,3.429609266e-02f,9.998139558e-01f,1.928869776e-02f,9.999411664e-01f,1.084729152e-02f,
6.735071623e-01f,-7.391806966e-01f,-9.530500361e-01f,-3.028128610e-01f,7.271980777e-01f,6.864276770e-01f,2.975377145e-02f,-9.995572585e-01f,9.965421208e-01f,-8.308911770e-02f,-9.411012936e-01f,-3.381247627e-01f,-3.800179774e-01f,9.249791008e-01f,4.513370430e-01f,8.923535586e-01f,8.138784539e-01f,5.810351644e-01f,9.398342161e-01f,3.416308626e-01f,9.808414904e-01f,1.948075221e-01f,9.939282563e-01f,1.100300928e-01f,9.980786154e-01f,6.196028901e-02f,9.993922719e-01f,3.485809641e-02f,9.998078062e-01f,1.960486481e-02f,9.999392216e-01f,1.102510855e-02f,
9.858965816e-01f,1.673557003e-01f,-6.448370157e-01f,-7.643201052e-01f,4.776714527e-01f,8.785385497e-01f,2.060983265e-01f,-9.785312871e-01f,9.998586332e-01f,1.681409119e-02f,-9.206095453e-01f,-3.904843980e-01f,-4.090735085e-01f,9.125014327e-01f,4.353979670e-01f,9.002380853e-01f,8.080275111e-01f,5.891447541e-01f,9.378982288e-01f,3.469105251e-01f,9.802205514e-01f,1.979082381e-01f,9.937310211e-01f,1.117973955e-01f,9.980161562e-01f,6.295833478e-02f,9.993725116e-01f,3.542009286e-02f,9.998015566e-01f,1.992103176e-02f,9.999372453e-01f,1.120292616e-02f
};

#define XB_TMO      128
#define XB_XCNT(j)  (256  + 64 * (j))
#define XB_XSUB(j)  (1280 + 64 * (j))
#define XB_XGEN(j)  (2304 + 64 * (j))
#define XB_TOP      3328
#define XB_TOPGEN   3392
#define XCD_BAR_WORDS 3456
#define XB_SPIN_CAP (1u << 18)

__device__ __forceinline__ unsigned xb_ld(unsigned* p)              { return __hip_atomic_load(p, __ATOMIC_RELAXED, __HIP_MEMORY_SCOPE_AGENT); }
__device__ __forceinline__ unsigned xb_add(unsigned* p, unsigned v) { return __hip_atomic_fetch_add(p, v, __ATOMIC_RELAXED, __HIP_MEMORY_SCOPE_AGENT); }
__device__ __forceinline__ unsigned xb_xcc_id() { return (unsigned)__builtin_amdgcn_s_getreg((3 << 11) | 20) & 0xFu; }
#define XB_SPIN(cond, bar) do { unsigned _sp = 0; while (cond) { __builtin_amdgcn_s_sleep(1); \
    if ((++_sp & 255u) == 0u) { if (xb_ld(&(bar)[XB_TMO])) break; if (_sp > XB_SPIN_CAP) { atomicAdd(&(bar)[XB_TMO], 1u); break; } } } } while (0)

struct XcdBarrier {
    unsigned* bar; unsigned x;
    volatile LAS unsigned* st;
};

__device__ __forceinline__ XcdBarrier xcd_barrier_post(unsigned* bar, volatile LAS unsigned* st) {
    XcdBarrier b; b.bar = bar; b.x = xb_xcc_id(); b.st = st;
    if (threadIdx.x == 0) (void)xb_add(&bar[XB_XCNT(b.x)], 1u);
    return b;
}
__device__ __forceinline__ void xcd_barrier_complete(unsigned* bar, unsigned x, unsigned& nloc, unsigned& nx) {
    const unsigned G = gridDim.x * gridDim.y * gridDim.z;
    unsigned sum, cnt, mine, sp = 0u;
    for (;;) {
        sum = 0u; cnt = 0u; mine = 0u;
#pragma unroll
        for (unsigned j = 0; j < 16; ++j) { const unsigned c = xb_ld(&bar[XB_XCNT(j)]); sum += c; cnt += (c > 0u) ? 1u : 0u; mine = (j == x) ? c : mine; }
        if (sum == G) break;
        __builtin_amdgcn_s_sleep(1);
        if ((++sp & 255u) == 0u) { if (xb_ld(&bar[XB_TMO])) break; if (sp > XB_SPIN_CAP) { atomicAdd(&bar[XB_TMO], 1u); break; } }
    }
    nloc = mine > 0u ? mine : 1u; nx = cnt > 0u ? cnt : 1u;
}

__device__ __forceinline__ void xcd_barrier(const XcdBarrier& b) {
    asm volatile("s_waitcnt vmcnt(0)" ::: "memory");
    __syncthreads();
    if (threadIdx.x == 0) {
        unsigned* bar = b.bar;
        __builtin_amdgcn_s_waitcnt(0);
        unsigned nloc = b.st[0], nx = b.st[1];
        if (nloc == 0u) { xcd_barrier_complete(bar, b.x, nloc, nx); b.st[0] = nloc; b.st[1] = nx; }
        const unsigned old = xb_add(&bar[XB_XSUB(b.x)], 1u);
        const unsigned gen = old / nloc;
        if (old + 1u == (gen + 1u) * nloc) {
            __builtin_amdgcn_fence(__ATOMIC_RELEASE, "agent");
            asm volatile("s_waitcnt vmcnt(0)" ::: "memory");
            const unsigned og = xb_add(&bar[XB_TOP], 1u);
            const unsigned tg = og / nx;
            if (og + 1u == (tg + 1u) * nx) xb_add(&bar[XB_TOPGEN], 1u);
            else XB_SPIN(xb_ld(&bar[XB_TOPGEN]) == tg, bar);
            __builtin_amdgcn_fence(__ATOMIC_ACQUIRE, "agent");
            xb_add(&bar[XB_XGEN(b.x)], 1u);
            asm volatile("s_waitcnt vmcnt(0)" ::: "memory");
        } else {
            XB_SPIN(xb_ld(&bar[XB_XGEN(b.x)]) == gen, bar);
            __builtin_amdgcn_fence(__ATOMIC_ACQUIRE, "agent");
            asm volatile("s_waitcnt vmcnt(0)" ::: "memory");
        }
    }
    __syncthreads();
}

typedef __bf16 bf16x2_t __attribute__((ext_vector_type(2)));
DEVI unsigned pk_bf16(float lo, float hi) {
    f32x2 f = {lo, hi}; bf16x2_t v = __builtin_convertvector(f, bf16x2_t); unsigned r; __builtin_memcpy(&r, &v, 4); return r; }
DEVI float bf_lo(unsigned w) { return __uint_as_float(w << 16); }
DEVI float bf_hi(unsigned w) { return __uint_as_float(w & 0xffff0000u); }
DEVI bf16x8 lds_ld128(lds_t* p) { return *(LAS bf16x8*)p; }
DEVI void lds_st128(lds_t* p, u32x4 v) { *(LAS u32x4*)p = v; }
DEVI int lane_id_fresh() { unsigned z = 0u; asm volatile("" : "+s"(z)); return (int)__builtin_amdgcn_mbcnt_hi(~0u, __builtin_amdgcn_mbcnt_lo(~0u, z)); }
DEVI float wave_sum(float v) {
#pragma unroll
    for (int o = 32; o >= 1; o >>= 1) v += __shfl_xor(v, o);
    return v;
}
DEVI float fexp2(float x) { return __builtin_amdgcn_exp2f(x); }
DEVI float frcp(float x) { return __builtin_amdgcn_rcpf(x); }
DEVI float silu_f(float x) { return x * frcp(1.0f + fexp2(-LOG2E * x)); }
DEVI float gelu_tanh_f(float x) {
    const float y = 0.7978845608028654f * (x + 0.044715f * x * x * x);
    const float e = fexp2((2.0f * LOG2E) * y);
    const float t = 1.0f - 2.0f * frcp(e + 1.0f);
    return 0.5f * x * (1.0f + t);
}
DEVI int cond_of_row(int row) { return row < NPR ? 0 : 1 + ((row - NPR) >> 10); }

struct Params {
    const float *x_prompt, *x_sample, *cache_ckv, *cache_kpe, *cache_k, *cache_v, *c, *c_ctx, *mod_w, *mod_b, *ln_gain, *ln_bias,
        *mla_w_in, *mla_q_gain, *mla_kv_gain, *mla_w_q_up, *mla_w_kv_up, *mla_w_out,
        *gm_w_in, *gm_v_gain, *gm_w_s, *gm_b_s, *gm_w_out, *swa_w_qkv, *swa_sink, *swa_w_out,
        *moe_router, *moe_w_gate, *moe_w_up, *moe_w_down;
    float* out;
    unsigned* bar;
    float *mod, *X0, *X1, *T, *Z, *GST, *AFF, *GATEV;
    bf16_t *H, *H2, *CQ, *CKV, *KPE, *Q, *KN, *VTP, *VTS, *O, *U, *GVT, *TT, *SK, *SVTP, *SVTS, *HID, *YE;
    bf16_t *WTI, *WTQ, *WTKV, *WTO, *WTGI, *WTGO, *WTSQ, *WTSO;
    int *SEL, *IDX;
    long long ph_lo, ph_hi;
};
constexpr size_t OUT_Y = 0;
constexpr size_t OUT_CKV = 8388608;
constexpr size_t OUT_KPE = OUT_CKV + 2097152;
constexpr size_t OUT_SK = OUT_KPE + 524288;
constexpr size_t OUT_SV = OUT_SK + 1048576;

DEVI const float* modp(const Params& p, int layer, int cnd, int which) { return p.mod + ((size_t)(layer * 5 + cnd) * 6 + which) * 1024; }

DEVI int swz(int row) { return ((row >> 1) & 7) ^ ((row >> 4) & 1); }
DEVI int img_off(int row, int chunk) { return row * 128 + ((chunk ^ swz(row)) << 4); }

template <int BM> struct XDma {
    static constexpr int NI = BM / 64;
    const bf16_t* base; unsigned off[NI];
    template <class RowFn> DEVI void init(const RowFn& rowfn, int tid) {
        const int w = tid >> 6, i = tid & 63;
        base = rowfn.base;
#pragma unroll
        for (int j = 0; j < NI; ++j) { const int row = 64 * j + 8 * w + (i >> 3); off[j] = rowfn.offset(row) + (((i & 7) ^ swz(row)) << 3); }
    }
    DEVI void issue(int kt, lds_t* img, int tid) const {
        lds_t* dst = img + (tid >> 6) * 1024 + (tid & 63) * 16;
#pragma unroll
        for (int j = 0; j < NI; ++j) __builtin_amdgcn_global_load_lds((const unsigned*)(base + off[j] + kt * 64), (LAS unsigned*)(dst + j * 8192), 16, 0, 0);
    }
};

struct WRegs {
    f32x4 r[8];
    DEVI void load(const float* p, size_t ldw, int kt) {
        const float* q = p + (size_t)kt * 64 * ldw;
#pragma unroll
        for (int i = 0; i < 8; ++i) r[i] = *(const f32x4*)(q + (size_t)i * ldw);
    }
    DEVI void store(lds_t* img, int wave, int lane) const {
#pragma unroll
        for (int c = 0; c < 4; ++c) {
            u32x4 v;
            v.x = pk_bf16(r[0][c], r[1][c]); v.y = pk_bf16(r[2][c], r[3][c]); v.z = pk_bf16(r[4][c], r[5][c]); v.w = pk_bf16(r[6][c], r[7][c]);
            lds_st128(img + img_off(4 * lane + c, wave), v);
        }
    }
};

template <int BM, bool TRANS>
DEVI void gemm_compute(lds_t* ximg, lds_t* wimg, f32x4 (&acc)[BM / 32][4], int wr, int wc, int lane) {
    constexpr int TM = BM / 32, NH = TM / 4, NSTEP = 2 * NH;
    const int r16 = lane & 15, g = lane >> 4;
    const int c0 = g ^ ((r16 >> 1) & 7);
    lds_t* xb = ximg + (wr * (BM / 2) + r16) * 128;
    lds_t* wb = wimg + (wc * 64 + r16) * 128;
    bf16x8 wf[2][4], xf[2][4];
#define LD_W(buf, s_) do { const int o0_ = ((c0 ^ (4 * (s_))) << 4), o1_ = ((c0 ^ (4 * (s_)) ^ 1) << 4); \
        _Pragma("unroll") for (int nb = 0; nb < 4; ++nb) wf[buf][nb] = lds_ld128(wb + nb * 2048 + ((nb & 1) ? o1_ : o0_)); } while (0)
#define LD_X(buf, s_, h_) do { const int o0_ = ((c0 ^ (4 * (s_))) << 4), o1_ = ((c0 ^ (4 * (s_)) ^ 1) << 4); \
        _Pragma("unroll") for (int m4 = 0; m4 < 4; ++m4) { const int mb_ = 4 * (h_) + m4; xf[buf][m4] = lds_ld128(xb + mb_ * 2048 + ((mb_ & 1) ? o1_ : o0_)); } } while (0)
    LD_W(0, 0); LD_X(0, 0, 0);
#pragma unroll
    for (int st = 0; st < NSTEP; ++st) {
        const int s = st / NH, h = st % NH;
        if (st + 1 < NSTEP) {
            const int s1 = (st + 1) / NH, h1 = (st + 1) % NH;
            if (s1 != s) LD_W(s1 & 1, s1);
            LD_X((st + 1) & 1, s1, h1);
        }
#pragma unroll
        for (int m4 = 0; m4 < 4; ++m4)
#pragma unroll
            for (int nb = 0; nb < 4; ++nb) {
                const int mb = 4 * h + m4;
                acc[mb][nb] = TRANS ? __builtin_amdgcn_mfma_f32_16x16x32_bf16(wf[s & 1][nb], xf[st & 1][m4], acc[mb][nb], 0, 0, 0)
                                    : __builtin_amdgcn_mfma_f32_16x16x32_bf16(xf[st & 1][m4], wf[s & 1][nb], acc[mb][nb], 0, 0, 0);
            }
        __builtin_amdgcn_sched_barrier(0);
    }
#undef LD_W
#undef LD_X
}

struct WLin { const float* base; DEVI const float* operator()(int lane) const { return base + 4 * lane; } };
template <int BM> struct GemmPipe {
    static constexpr int TM = BM / 32, STAGE = (BM + 256) * 128, NI = BM / 64;
    XDma<BM> xd; const float* wp; unsigned ldw; WRegs wr_; int par;
    template <class RowFn, class WFn> DEVI void prime(lds_t* lds, const RowFn& rf, const WFn& wf, unsigned ldw_, int tid_in) {
        const int tid = tid_in;
        const int lane = tid & 63, wave = tid >> 6;
        xd.init(rf, tid); ldw = ldw_; wp = wf(lane) + (size_t)(8 * wave) * ldw_; par = 0;
        wr_.load(wp, ldw, 0);
        __syncthreads();
        xd.issue(0, lds, tid); wr_.store(lds + BM * 128, wave, lane);
        wr_.load(wp, ldw, 1);
    }
    template <bool TRANS, bool XUNIT = true, class Epi, class RowFnN, class WFnN>
    DEVI void run(lds_t* lds, int nk, const Epi& epi, bool has_next_in, const RowFnN& rfn, const WFnN& wfn, unsigned ldw_n, int tid_in) {
        int tid = tid_in; asm volatile("" : "+v"(tid));
        const int lane = tid & 63, wave = tid >> 6, wrow = wave >> 2, wcol = wave & 3;
        const bool has_next = XUNIT && has_next_in;
        f32x4 acc[TM][4];
#pragma unroll
        for (int i = 0; i < TM; ++i)
#pragma unroll
            for (int j = 0; j < 4; ++j) acc[i][j] = (f32x4){0.f, 0.f, 0.f, 0.f};
        unsigned offn[NI];
        if (XUNIT) {
#pragma unroll
            for (int j = 0; j < NI; ++j) offn[j] = 0u;
        }
        for (int t = 0; t < nk; ++t) {
            asm volatile("s_waitcnt vmcnt(0)" ::: "memory");
            __syncthreads();
            lds_t* cur = lds + ((par + t) & 1) * STAGE;
            lds_t* nxt = lds + ((par + t + 1) & 1) * STAGE;
            if (t + 2 < nk) {
                xd.issue(t + 1, nxt, tid); wr_.store(nxt + BM * 128, wave, lane); wr_.load(wp, ldw, t + 2);
            } else if (t + 1 < nk) {
                xd.issue(t + 1, nxt, tid); wr_.store(nxt + BM * 128, wave, lane);
                if (has_next) {
                    ldw = ldw_n; wp = wfn(lane) + (size_t)(8 * wave) * ldw_n; wr_.load(wp, ldw, 0);
#pragma unroll
                    for (int j = 0; j < NI; ++j) { const int row = 64 * j + 8 * wave + (lane >> 3); offn[j] = rfn.offset(row) + (((lane & 7) ^ swz(row)) << 3); }
                }
            } else if (has_next) {
                xd.base = rfn.base;
#pragma unroll
                for (int j = 0; j < NI; ++j) xd.off[j] = offn[j];
                xd.issue(0, nxt, tid); wr_.store(nxt + BM * 128, wave, lane); wr_.load(wp, ldw, 1);
            }
            gemm_compute<BM, TRANS>(cur, cur + BM * 128, acc, wrow, wcol, lane);
        }
        par = (par + nk) & 1;
        { int t2 = tid; asm volatile("" : "+v"(t2));
          const int w2 = t2 >> 6; epi(acc, w2 >> 2, w2 & 3, t2 & 63); }
    }
};

template <int BM, bool TRANS, class RowFn, class WFn, class Epi>
DEVI void gemm_unit(lds_t* lds, const RowFn& rowfn, const WFn& wfn, unsigned ldw, int nk, const Epi& epi, int tid_in) {
    int tid = tid_in; asm volatile("" : "+v"(tid));
    constexpr int TM = BM / 32;
    constexpr int STAGE = (BM + 256) * 128;
    const int lane = tid & 63, wave = tid >> 6, wr = wave >> 2, wc = wave & 3;
    XDma<BM> xd; WRegs wl;
    const float* wp = wfn(lane) + (size_t)(8 * wave) * ldw;
    wl.load(wp, ldw, 0);
    xd.init(rowfn, tid);
    f32x4 acc[TM][4];
#pragma unroll
    for (int i = 0; i < TM; ++i)
#pragma unroll
        for (int j = 0; j < 4; ++j) acc[i][j] = (f32x4){0.f, 0.f, 0.f, 0.f};
    __syncthreads();
    xd.issue(0, lds, tid); wl.store(lds + BM * 128, wave, lane);
    if (nk > 1) wl.load(wp, ldw, 1);
    for (int t = 0; t < nk; ++t) {
        asm volatile("s_waitcnt vmcnt(0)" ::: "memory");
        __syncthreads();
        lds_t* cur = lds + (t & 1) * STAGE;
        lds_t* nxt = lds + ((t + 1) & 1) * STAGE;
        if (t + 1 < nk) {
            xd.issue(t + 1, nxt, tid); wl.store(nxt + BM * 128, wave, lane);
            if (t + 2 < nk) wl.load(wp, ldw, t + 2);
        }
        gemm_compute<BM, TRANS>(cur, cur + BM * 128, acc, wr, wc, lane);
    }
    { int t2 = tid; asm volatile("" : "+v"(t2));
      const int w2 = t2 >> 6; epi(acc, w2 >> 2, w2 & 3, t2 & 63); }
}

template <int BM, bool TRANS, class RowFn, class WRowFn, class Epi>
DEVI void gemm_unit_bb(lds_t* lds, const RowFn& rowfn, const WRowFn& wrowfn, int nk, const Epi& epi, int tid_in) {
    int tid = tid_in; asm volatile("" : "+v"(tid));
    constexpr int TM = BM / 32;
    constexpr int STAGE = (BM + 256) * 128;
    const int lane = tid & 63, wave = tid >> 6, wr = wave >> 2, wc = wave & 3;
    XDma<BM> xd; XDma<256> wd;
    xd.init(rowfn, tid); wd.init(wrowfn, tid);
    f32x4 acc[TM][4];
#pragma unroll
    for (int i = 0; i < TM; ++i)
#pragma unroll
        for (int j = 0; j < 4; ++j) acc[i][j] = (f32x4){0.f, 0.f, 0.f, 0.f};
    __syncthreads();
    xd.issue(0, lds, tid); wd.issue(0, lds + BM * 128, tid);
    for (int t = 0; t < nk; ++t) {
        asm volatile("s_waitcnt vmcnt(0)" ::: "memory");
        __syncthreads();
        lds_t* cur = lds + (t & 1) * STAGE;
        lds_t* nxt = lds + ((t + 1) & 1) * STAGE;
        if (t + 1 < nk) { xd.issue(t + 1, nxt, tid); wd.issue(t + 1, nxt + BM * 128, tid); }
        gemm_compute<BM, TRANS>(cur, cur + BM * 128, acc, wr, wc, lane);
    }
    { int t2 = tid; asm volatile("" : "+v"(t2));
      const int w2 = t2 >> 6; epi(acc, w2 >> 2, w2 & 3, t2 & 63); }
}

template <int BM, bool TRANS, class RowFn, class WRowFn, class Epi>
DEVI void gemm_unit_bb3(lds_t* lds, const RowFn& rowfn, const WRowFn& wrowfn, int nk, const Epi& epi, int tid_in) {
    int tid = tid_in; asm volatile("" : "+v"(tid));
    constexpr int TM = BM / 32;
    constexpr int STAGE = (BM + 256) * 128;
    static_assert(BM == 128, "3 stages fit for BM = 128 only; the counted wait below assumes 2 + 4 DMA instructions per tile");
    const int lane = tid & 63, wave = tid >> 6, wr = wave >> 2, wc = wave & 3;
    XDma<BM> xd; XDma<256> wd;
    xd.init(rowfn, tid); wd.init(wrowfn, tid);
    f32x4 acc[TM][4];
#pragma unroll
    for (int i = 0; i < TM; ++i)
#pragma unroll
        for (int j = 0; j < 4; ++j) acc[i][j] = (f32x4){0.f, 0.f, 0.f, 0.f};
    __syncthreads();
    lds_t* s0 = lds; lds_t* s1 = lds + STAGE; lds_t* s2 = lds + 2 * STAGE;
    xd.issue(0, s0, tid); wd.issue(0, s0 + BM * 128, tid);
    if (nk > 1) { xd.issue(1, s1, tid); wd.issue(1, s1 + BM * 128, tid); }
    for (int t = 0; t < nk; ++t) {
        if (t + 1 < nk) asm volatile("s_waitcnt vmcnt(6)" ::: "memory");
        else asm volatile("s_waitcnt vmcnt(0)" ::: "memory");
        asm volatile("s_waitcnt lgkmcnt(0)" ::: "memory");
        __builtin_amdgcn_s_barrier();
        asm volatile("" ::: "memory");
        if (t + 2 < nk) { xd.issue(t + 2, s2, tid); wd.issue(t + 2, s2 + BM * 128, tid); }
        gemm_compute<BM, TRANS>(s0, s0 + BM * 128, acc, wr, wc, lane);
        lds_t* tmp = s0; s0 = s1; s1 = s2; s2 = tmp;
    }
    __syncthreads();
    { int t2 = tid; asm volatile("" : "+v"(t2));
      const int w2 = t2 >> 6; epi(acc, w2 >> 2, w2 & 3, t2 & 63); }
}

DEVI int swz32(int row) { return ((((row >> 2) ^ (row >> 3)) & 1) << 1) | ((row >> 2) & 1); }
template <int BM> struct XDma32 {
    static constexpr int NI = BM / 128;
    const bf16_t* base; unsigned off[NI];
    template <class RowFn> DEVI void init(const RowFn& rowfn, int tid) {
        const int w = tid >> 6, i = tid & 63;
        base = rowfn.base;
#pragma unroll
        for (int j = 0; j < NI; ++j) { const int row = 128 * j + 16 * w + (i >> 2); off[j] = rowfn.offset(row) + (((i & 3) ^ swz32(row)) << 3); }
    }
    DEVI void issue(int kt32, lds_t* img, int tid) const {
        lds_t* dst = img + (tid >> 6) * 1024 + (tid & 63) * 16;
#pragma unroll
        for (int j = 0; j < NI; ++j) __builtin_amdgcn_global_load_lds((const unsigned*)(base + off[j] + kt32 * 32), (LAS unsigned*)(dst + j * 8192), 16, 0, 0);
    }
};
template <int BM, bool TRANS>
DEVI void gemm_compute32(lds_t* ximg, lds_t* wimg, f32x4 (&acc)[BM / 32][4], int wr, int wc, int lane) {
    constexpr int TM = BM / 32;
    const int r16 = lane & 15, g = lane >> 4;
    const int c0 = (g ^ swz32(r16)) << 4;
    lds_t* xb = ximg + (wr * (BM / 2) + r16) * 64 + c0;
    lds_t* wb = wimg + (wc * 64 + r16) * 64 + c0;
    bf16x8 wf[4], xf[TM];
#pragma unroll
    for (int nb = 0; nb < 4; ++nb) wf[nb] = lds_ld128(wb + nb * 1024);
#pragma unroll
    for (int mb = 0; mb < TM; ++mb) xf[mb] = lds_ld128(xb + mb * 1024);
#pragma unroll
    for (int mb = 0; mb < TM; ++mb)
#pragma unroll
        for (int nb = 0; nb < 4; ++nb)
            acc[mb][nb] = TRANS ? __builtin_amdgcn_mfma_f32_16x16x32_bf16(wf[nb], xf[mb], acc[mb][nb], 0, 0, 0)
                                : __builtin_amdgcn_mfma_f32_16x16x32_bf16(xf[mb], wf[nb], acc[mb][nb], 0, 0, 0);
}
template <int BM, bool TRANS, class RowFn, class WRowFn, class Epi>
DEVI void gemm_unit_bb4(lds_t* lds, const RowFn& rowfn, const WRowFn& wrowfn, int nk2  , const Epi& epi, int tid_in) {
    int tid = tid_in; asm volatile("" : "+v"(tid));
    constexpr int TM = BM / 32;
    constexpr int XB = BM * 64, STAGE = XB + 256 * 64;
    static_assert(BM == 256, "the counted waits below assume 2 + 2 DMA instructions per sub-tile");
    const int lane = tid & 63, wave = tid >> 6, wr = wave >> 2, wc = wave & 3;
    XDma32<BM> xd; XDma32<256> wd;
    xd.init(rowfn, tid); wd.init(wrowfn, tid);
    f32x4 acc[TM][4];
#pragma unroll
    for (int i = 0; i < TM; ++i)
#pragma unroll
        for (int j = 0; j < 4; ++j) acc[i][j] = (f32x4){0.f, 0.f, 0.f, 0.f};
    __syncthreads();
#pragma unroll
    for (int t = 0; t < 3; ++t) if (t < nk2) { xd.issue(t, lds + t * STAGE, tid); wd.issue(t, lds + t * STAGE + XB, tid); }
    for (int t = 0; t < nk2; ++t) {
        const int rem = nk2 - 1 - t;
        if (rem >= 2) asm volatile("s_waitcnt vmcnt(8)" ::: "memory");
        else if (rem == 1) asm volatile("s_waitcnt vmcnt(4)" ::: "memory");
        else asm volatile("s_waitcnt vmcnt(0)" ::: "memory");
        asm volatile("s_waitcnt lgkmcnt(0)" ::: "memory");
        __builtin_amdgcn_s_barrier();
        asm volatile("" ::: "memory");
        if (t + 3 < nk2) { lds_t* st = lds + ((t + 3) & 3) * STAGE; xd.issue(t + 3, st, tid); wd.issue(t + 3, st + XB, tid); }
        lds_t* cur = lds + (t & 3) * STAGE;
        gemm_compute32<BM, TRANS>(cur, cur + XB, acc, wr, wc, lane);
    }
    __syncthreads();
    { int t2 = tid; asm volatile("" : "+v"(t2));
      const int w2 = t2 >> 6; epi(acc, w2 >> 2, w2 & 3, t2 & 63); }
}

namespace pg8 {
constexpr int BM = 256, BK = 64, HALF = 128, HTB = HALF * BK * 2  , STAGE_BYTES = 8 * HTB;
DEVI int lds_byte(int r, int c) { const int st = (r >> 4) * 2 + (c >> 5), rr = r & 15, cc = c & 31, ob = rr * 64 + cc * 2; return st * 1024 + (ob ^ (((ob >> 9) & 1) << 5)); }
DEVI void stage_rc(int b, int& R, int& C) { const int st = b / 1024, sb = b % 1024, swz = sb ^ (((sb >> 9) & 1) << 5); R = (st >> 1) * 16 + swz / 64; C = (st & 1) * 32 + (swz % 64) / 2; }
DEVI int perm32(int rho) { const int n = rho >> 4, i = rho & 15; return 8 * (i >> 2) + 4 * n + (i & 3); }
struct Unit { int pm, pn, aux; };

template <class Epi, class Sched>
DEVI void gemm_phase(lds_t* lds, const int ldk  , const int nt  , const Sched& S, const Epi& E, const int tid,
                      const int hrowsA = HALF, const int hrowsB = HALF  ) {
    const int wid = __builtin_amdgcn_readfirstlane(tid >> 6), lane = tid & 63, wr = wid >> 2, wc = wid & 3, fr = lane & 15, fq = lane >> 4;
    unsigned voffA[2], voffB[2];
#pragma unroll
    for (int i = 0; i < 2; ++i) { int R, C; stage_rc(tid * 16 + i * 8192, R, C); const int Rb = Epi::PERM ? ((R & ~31) + perm32(R & 31)) : R;
        voffA[i] = (unsigned)(R * ldk + C) * 2u; voffB[i] = (unsigned)(Rb * ldk + C) * 2u; }
    const size_t kstep = (size_t)(BK * 2);
    const size_t hstepA = (size_t)hrowsA * ldk * 2, hstepB = (size_t)hrowsB * ldk * 2;
    const unsigned ldsw = (unsigned)wid * 1024u;
    const int aoff = lds_byte(wr * 64 + fr, fq * 8), boff = lds_byte(wc * 32 + fr, fq * 8);
#define PG8_SA(b, h) (((b) * 2 + (h)) * HTB)
#define PG8_SB(b, h) ((4 + (b) * 2 + (h)) * HTB)
#define PG8_STAGE(bufoff, gbase, voff) do { _Pragma("unroll") for (int _i = 0; _i < 2; ++_i) \
        __builtin_amdgcn_global_load_lds((const unsigned*)((const char*)(gbase) + (voff)[_i]), (LAS unsigned*)(lds + (bufoff) + ldsw + _i * 8192), 16, 0, 0); } while (0)
#define PG8_LDA(dst, b, h) do { _Pragma("unroll") for (int m = 0; m < 4; ++m) _Pragma("unroll") for (int k = 0; k < 2; ++k) dst[m][k] = *(const LAS bf16x8*)(lds + PG8_SA(b, h) + aoff + m * 2048 + k * 1024); } while (0)
#define PG8_LDB(dst, b, h) do { _Pragma("unroll") for (int n = 0; n < 2; ++n) _Pragma("unroll") for (int k = 0; k < 2; ++k) dst[n][k] = *(const LAS bf16x8*)(lds + PG8_SB(b, h) + boff + n * 2048 + k * 1024); } while (0)
#define PG8_MMA(ai, bj, At, Bt) do { __builtin_amdgcn_s_setprio(1); _Pragma("unroll") for (int m = 0; m < 4; ++m) _Pragma("unroll") for (int n = 0; n < 2; ++n) _Pragma("unroll") for (int k = 0; k < 2; ++k) \
        acc[ai][bj][m][n] = __builtin_amdgcn_mfma_f32_16x16x32_bf16(Bt[n][k], At[m][k], acc[ai][bj][m][n], 0, 0, 0); __builtin_amdgcn_s_setprio(0); } while (0)
#define PG8_WAIT_V(n) asm volatile("s_waitcnt vmcnt(" #n ")" ::: "memory")
#define PG8_WAIT_L(n) asm volatile("s_waitcnt lgkmcnt(" #n ")" ::: "memory")
#define PG8_BAR __builtin_amdgcn_s_barrier()
#define PG8_SCHED __builtin_amdgcn_sched_barrier(0)
    Unit cur, nxt; int ui = 0;
    __syncthreads();
    if (!S.next(0, cur)) return;
    f32x4 acc[2][2][4][2];
#pragma unroll
    for (int a = 0; a < 2; ++a)
#pragma unroll
        for (int b = 0; b < 2; ++b)
#pragma unroll
            for (int m = 0; m < 4; ++m)
#pragma unroll
                for (int n = 0; n < 2; ++n) acc[a][b][m][n] = (f32x4){0.f, 0.f, 0.f, 0.f};
    bf16x8 At[4][2], B0[2][2], B1[2][2];
    const char* cA; const char* cB;
    S.ptrs(cur, cA, cB);
    PG8_STAGE(PG8_SB(0, 0), cB, voffB); PG8_STAGE(PG8_SA(0, 0), cA, voffA); PG8_STAGE(PG8_SB(0, 1), cB + hstepB, voffB); PG8_STAGE(PG8_SA(0, 1), cA + hstepA, voffA);
    if (wr == 1) PG8_BAR;
    PG8_WAIT_V(4); PG8_BAR;
    PG8_STAGE(PG8_SB(1, 0), cB + kstep, voffB); PG8_STAGE(PG8_SA(1, 0), cA + kstep, voffA); PG8_STAGE(PG8_SB(1, 1), cB + hstepB + kstep, voffB);
    PG8_WAIT_V(6); PG8_BAR;
    for (;;) {
        const bool has_next = S.next(ui + 1, nxt);
        const char* nA = cA; const char* nB = cB;
        if (has_next) S.ptrs(nxt, nA, nB);
        for (int t = 0; t < nt; t += 2) {
            const bool last = (t == nt - 2);
            const char* a1 = cA + (size_t)(t + 1) * kstep;
            const char* a2 = last ? nA : cA + (size_t)(t + 2) * kstep; const char* b2 = last ? nB : cB + (size_t)(t + 2) * kstep;
            const char* a3 = a2 + kstep; const char* b3 = b2 + kstep;
            PG8_LDB(B0, 0, 0); PG8_SCHED; PG8_LDA(At, 0, 0); PG8_STAGE(PG8_SA(1, 1), a1 + hstepA, voffA);
            PG8_WAIT_L(8); PG8_BAR; PG8_WAIT_L(0); PG8_MMA(0, 0, At, B0); PG8_BAR; PG8_SCHED;
            PG8_LDB(B1, 0, 1); PG8_STAGE(PG8_SB(0, 0), b2, voffB);
            PG8_BAR; PG8_WAIT_L(0); PG8_MMA(0, 1, At, B1); PG8_BAR;
            PG8_LDA(At, 0, 1); PG8_STAGE(PG8_SA(0, 0), a2, voffA);
            PG8_BAR; PG8_WAIT_L(0); PG8_MMA(1, 0, At, B0); PG8_BAR; PG8_SCHED;
            PG8_STAGE(PG8_SB(0, 1), b2 + hstepB, voffB);
            PG8_WAIT_V(6); PG8_BAR; PG8_MMA(1, 1, At, B1); PG8_BAR;
            PG8_LDB(B0, 1, 0); PG8_SCHED; PG8_LDA(At, 1, 0); PG8_STAGE(PG8_SA(0, 1), a2 + hstepA, voffA);
            PG8_WAIT_L(8); PG8_BAR; PG8_WAIT_L(0); PG8_MMA(0, 0, At, B0); PG8_BAR; PG8_SCHED;
            PG8_LDB(B1, 1, 1); PG8_STAGE(PG8_SB(1, 0), b3, voffB);
            PG8_BAR; PG8_WAIT_L(0); PG8_MMA(0, 1, At, B1); PG8_BAR;
            PG8_LDA(At, 1, 1); PG8_STAGE(PG8_SA(1, 0), a3, voffA);
            PG8_BAR; PG8_WAIT_L(0); PG8_MMA(1, 0, At, B0); PG8_BAR; PG8_SCHED;
            PG8_STAGE(PG8_SB(1, 1), b3 + hstepB, voffB);
            PG8_WAIT_V(6); PG8_BAR; PG8_MMA(1, 1, At, B1); PG8_BAR;
        }
        { const int ln = lane_id_fresh(); E(acc, cur, wr, wc, ln & 15, ln >> 4); }
        if (!has_next) break;
#pragma unroll
        for (int a = 0; a < 2; ++a)
#pragma unroll
            for (int b = 0; b < 2; ++b)
#pragma unroll
                for (int m = 0; m < 4; ++m)
#pragma unroll
                    for (int n = 0; n < 2; ++n) acc[a][b][m][n] = (f32x4){0.f, 0.f, 0.f, 0.f};
        cur = nxt; cA = nA; cB = nB; ++ui;
    }
    PG8_WAIT_V(0);
    if (wr == 0) PG8_BAR;
    PG8_BAR;
#undef PG8_SA
#undef PG8_SB
#undef PG8_STAGE
#undef PG8_LDA
#undef PG8_LDB
#undef PG8_MMA
#undef PG8_WAIT_V
#undef PG8_WAIT_L
#undef PG8_BAR
#undef PG8_SCHED
}
}

DEVI void phase_modulation(const Params& p, lds_t* lds, int bid, int nblk, int tid) {
    LAS float* sc = (LAS float*)lds;
    LAS float* red = (LAS float*)(lds + 20480);
    __syncthreads();
    for (int i = tid; i < 5 * 1024; i += NTHREADS) {
        const int cnd = i >> 10, k = i & 1023;
        const float v = cnd == 0 ? p.c_ctx[k] : p.c[(cnd - 1) * 1024 + k];
        sc[i] = silu_f(v);
    }
    __syncthreads();
    const int cg = tid & 31, kg = tid >> 5;
    for (int u = bid; u < DEPTH * 48; u += nblk) {
        const int l = u / 48, n0 = (u % 48) * 128;
        const float* w = p.mod_w + (size_t)l * 1024 * 6144 + n0 + 4 * cg;
        f32x4 a[5];
#pragma unroll
        for (int c = 0; c < 5; ++c) a[c] = (f32x4){0.f, 0.f, 0.f, 0.f};
#pragma unroll 8
        for (int kk = 0; kk < 64; ++kk) {
            const int k = kg * 64 + kk;
            const f32x4 wv = *(const f32x4*)(w + (size_t)k * 6144);
#pragma unroll
            for (int c = 0; c < 5; ++c) a[c] += wv * sc[c * 1024 + k];
        }
#pragma unroll
        for (int c = 0; c < 5; ++c) *(LAS f32x4*)(red + (kg * 5 + c) * 128 + 4 * cg) = a[c];
        __syncthreads();
        for (int i = tid; i < 5 * 128; i += NTHREADS) {
            const int c = i >> 7, n = i & 127;
            float s = 0.f;
#pragma unroll
            for (int q = 0; q < 16; ++q) s += red[(q * 5 + c) * 128 + n];
            p.mod[(size_t)(l * 5 + c) * 6144 + n0 + n] = s + p.mod_b[l * 6144 + n0 + n];
        }
        __syncthreads();
    }
}


DEVI void wconv_tile(const float* W, bf16_t* Wt, int K, int N, int tk, int tn, lds_t* lds, int tid) {
    LAS bf16_t* s = (LAS bf16_t*)lds;
    __syncthreads();
#pragma unroll
    for (int i = 0; i < 2; ++i) {
        const int c = tid + NTHREADS * i, k = c >> 4, n4 = (c & 15) * 4;
        const f32x4 v = *(const f32x4*)(W + (size_t)(tk * 64 + k) * N + tn * 64 + n4);
#pragma unroll
        for (int q = 0; q < 4; ++q) s[(n4 + q) * 72 + k] = (bf16_t)(pk_bf16(v[q], 0.f) & 0xffffu);
    }
    __syncthreads();
    { const int n = tid >> 3, kc = tid & 7;
      const u32x4 v = *(LAS u32x4*)(s + n * 72 + kc * 8);
      *(u32x4*)(Wt + (size_t)(tn * 64 + n) * K + tk * 64 + kc * 8) = v; }
}
DEVI void phase_wconv(const Params& p, lds_t* lds, int bid, int nblk, int tid) {
    for (int it = bid; it < 4352; it += nblk) {
        int r = it; const float* W; bf16_t* Wt; int K, N;
        if (r < 352) { const int j = r / 176; r %= 176; W = p.mla_w_in + (size_t)j * 1024 * 704; Wt = p.WTI + (size_t)j * 704 * 1024; K = 1024; N = 704; }
        else if ((r -= 352) < 288) { const int j = r / 144; r %= 144; W = p.mla_w_q_up + (size_t)j * 384 * 1536; Wt = p.WTQ + (size_t)j * 1536 * 384; K = 384; N = 1536; }
        else if ((r -= 288) < 256) { const int j = r / 128; r %= 128; W = p.mla_w_kv_up + (size_t)j * 256 * 2048; Wt = p.WTKV + (size_t)j * 2048 * 256; K = 256; N = 2048; }
        else if ((r -= 256) < 512) { const int j = r / 256; r %= 256; W = p.mla_w_out + (size_t)j * 1024 * 1024; Wt = p.WTO + (size_t)j * 1024 * 1024; K = 1024; N = 1024; }
        else if ((r -= 512) < 1536) { W = p.gm_w_in; Wt = p.WTGI; K = 1024; N = 6144; }
        else if ((r -= 1536) < 768) { W = p.gm_w_out; Wt = p.WTGO; K = 3072; N = 1024; }
        else if ((r -= 768) < 384) { W = p.swa_w_qkv; Wt = p.WTSQ; K = 1024; N = 1536; }
        else { r -= 384; W = p.swa_w_out; Wt = p.WTSO; K = 1024; N = 1024; }
        const int ntn = N / 64;
        wconv_tile(W, Wt, K, N, r / ntn, r % ntn, lds, tid);
    }
}

DEVI void phase_prep(const Params& p, int bid, int nblk, int tid) {
    const int lane = tid & 63, wave = tid >> 6;
    for (int row = bid * 8 + wave; row < NTOK; row += nblk * 8) {
        const float* src = row < NPR ? p.x_prompt + (size_t)row * D : p.x_sample + (size_t)(row - NPR) * D;
        const int cnd = cond_of_row(row);
        const float* sh = modp(p, 0, cnd, 0); const float* scl = modp(p, 0, cnd, 1);
#pragma unroll
        for (int i = 0; i < 4; ++i) {
            const int col = lane * 4 + 256 * i;
            const f32x4 v = *(const f32x4*)(src + col);
            const f32x4 s = *(const f32x4*)(scl + col), b = *(const f32x4*)(sh + col);
            const f32x4 h = v * (s + 1.0f) + b;
            u32x2 o; o.x = pk_bf16(h[0], h[1]); o.y = pk_bf16(h[2], h[3]);
            *(u32x2*)(p.H + (size_t)row * D + col) = o;
        }
    }
    for (int i = bid * NTHREADS + tid; i < 1024 * 64; i += nblk * NTHREADS) {
        const f32x4 v = *(const f32x4*)(p.cache_k + (size_t)i * 4);
        u32x2 o; o.x = pk_bf16(v[0], v[1]); o.y = pk_bf16(v[2], v[3]);
        *(u32x2*)(p.SK + (size_t)NTOK * 256 + (size_t)i * 4) = o;
    }
    for (int i = bid * NTHREADS + tid; i < 4 * 4 * 64 * 64; i += nblk * NTHREADS) {
        const int kg4 = i & 63, dv = (i >> 6) & 63, kvh = (i >> 12) & 3, b = i >> 14;
        float v[4];
#pragma unroll
        for (int q = 0; q < 4; ++q) v[q] = p.cache_v[((size_t)(b * 256 + kg4 * 4 + q) * 4 + kvh) * 64 + dv];
        u32x2 o; o.x = pk_bf16(v[0], v[1]); o.y = pk_bf16(v[2], v[3]);
        *(u32x2*)(p.SVTS + ((size_t)(b * 4 + kvh) * 64 + dv) * 1280 + kg4 * 4) = o;
    }
}

DEVI void phase_mla_norm(const Params& p, int j, int bid, int nblk, int tid) {
    const int lane = tid & 63, wave = tid >> 6;
    const float* qg = p.mla_q_gain + j * 384; const float* kg = p.mla_kv_gain + j * 256;
    for (int row = bid * 8 + wave; row < NROWS_KV; row += nblk * 8) {
        if (row >= NTOK) {
            const int b = (row - NTOK) >> 8, t = (row - NTOK) & 255;
            const float* ck = p.cache_ckv + ((size_t)(b * 2 + j) * 256 + t) * 256;
            const f32x4 v = *(const f32x4*)(ck + lane * 4);
            u32x2 o; o.x = pk_bf16(v[0], v[1]); o.y = pk_bf16(v[2], v[3]);
            *(u32x2*)(p.CKV + (size_t)row * 256 + lane * 4) = o;
            const float kp = p.cache_kpe[((size_t)(b * 2 + j) * 256 + t) * 64 + lane];
            p.KPE[(size_t)row * 64 + lane] = (bf16_t)(pk_bf16(kp, 0.f) & 0xffffu);
            continue;
        }
        const float* z = p.Z + (size_t)row * 704;
        float q[6]; float ss = 0.f;
#pragma unroll
        for (int i = 0; i < 6; ++i) { q[i] = z[lane + 64 * i]; ss += q[i] * q[i]; }
        ss = wave_sum(ss);
        const float rq = rsqrtf(ss * (1.0f / 384.0f) + EPS_F);
#pragma unroll
        for (int i = 0; i < 6; ++i) p.CQ[(size_t)row * 384 + lane + 64 * i] = (bf16_t)(pk_bf16(q[i] * rq * qg[lane + 64 * i], 0.f) & 0xffffu);
        const f32x4 kv = *(const f32x4*)(z + 384 + lane * 4);
        float s2 = kv[0] * kv[0] + kv[1] * kv[1] + kv[2] * kv[2] + kv[3] * kv[3];
        s2 = wave_sum(s2);
        const float rk = rsqrtf(s2 * (1.0f / 256.0f) + EPS_F);
        const f32x4 gv = *(const f32x4*)(kg + lane * 4);
        const f32x4 kn = kv * rk * gv;
        { u32x2 o; o.x = pk_bf16(kn[0], kn[1]); o.y = pk_bf16(kn[2], kn[3]); *(u32x2*)(p.CKV + (size_t)row * 256 + lane * 4) = o; }
        float kp = z[640 + lane];
        if (row < NPR) {
            const int b = row >> 8, t = row & 255;
            *(f32x4*)(p.out + OUT_CKV + ((size_t)(b * 2 + j) * 256 + t) * 256 + lane * 4) = kn;
            p.out[OUT_KPE + ((size_t)(b * 2 + j) * 256 + t) * 64 + lane] = kp;
        } else {
            const int t = (row - NPR) & 1023;
            const int pos = lane < 32 ? (t >> 6) : (t & 63);
            const float cs = rope_tab[(pos * 16 + (lane & 15)) * 2], sn = rope_tab[(pos * 16 + (lane & 15)) * 2 + 1];
            const float other = __shfl_xor(kp, 16);
            kp = (lane & 16) ? (kp * cs + other * sn) : (kp * cs - other * sn);
        }
        p.KPE[(size_t)row * 64 + lane] = (bf16_t)(pk_bf16(kp, 0.f) & 0xffffu);
    }
}

DEVI void phase_ln_a(const Params& p, int layer, lds_t* lds, int bid, int nblk, int tid) {
    const int lane = tid & 63, wave = tid >> 6;
    LAS float* rt = (LAS float*)lds;
    const float* router = p.moe_router + (size_t)layer * 1024 * 16;
    __syncthreads();
    for (int i = tid; i < 4096; i += NTHREADS) {
        const f32x4 w = *(const f32x4*)(router + i * 4);
        const int k = i >> 2, e0 = (i & 3) * 4;
        rt[(e0 + 0) * 1024 + k] = w[0]; rt[(e0 + 1) * 1024 + k] = w[1]; rt[(e0 + 2) * 1024 + k] = w[2]; rt[(e0 + 3) * 1024 + k] = w[3];
    }
    __syncthreads();
    const float* lg = p.ln_gain + (layer * 2 + 0) * 1024; const float* lb = p.ln_bias + (layer * 2 + 0) * 1024;
    for (int r0 = (bid * 8 + wave) * 4; r0 < NTOK; r0 += nblk * 32) {
        const int cnd = cond_of_row(r0);
        const float* sh = modp(p, layer, cnd, 3); const float* scl = modp(p, layer, cnd, 4);
        f32x4 v[4][4];
        float mu[4], rs[4];
        const float* xres = layer ? p.X0 : (r0 < NPR ? p.x_prompt : p.x_sample - (size_t)NPR * D);
        const bf16_t* Y0 = (const bf16_t*)p.T; const bf16_t* Y1 = Y0 + (size_t)NTOK * D;
#pragma unroll
        for (int j = 0; j < 4; ++j)
#pragma unroll
            for (int i = 0; i < 4; ++i) {
                const size_t o = (size_t)(r0 + j) * D + lane * 4 + 256 * i;
                const u32x2 ya = *(const u32x2*)(Y0 + o), yb = *(const u32x2*)(Y1 + o);
                f32x4 yv; yv[0] = bf_lo(ya.x) + bf_lo(yb.x); yv[1] = bf_hi(ya.x) + bf_hi(yb.x); yv[2] = bf_lo(ya.y) + bf_lo(yb.y); yv[3] = bf_hi(ya.y) + bf_hi(yb.y);
                v[j][i] = *(const f32x4*)(xres + o) * ALPHA_F + yv;
            }
#pragma unroll
        for (int j = 0; j < 4; ++j) { float s = 0.f;
#pragma unroll
            for (int i = 0; i < 4; ++i) s += (v[j][i][0] + v[j][i][1]) + (v[j][i][2] + v[j][i][3]);
            mu[j] = s; }
#pragma unroll
        for (int j = 0; j < 4; ++j) mu[j] = wave_sum(mu[j]) * (1.0f / 1024.0f);
#pragma unroll
        for (int j = 0; j < 4; ++j) { float q = 0.f;
#pragma unroll
            for (int i = 0; i < 4; ++i) { v[j][i] = v[j][i] - mu[j]; q += (v[j][i][0] * v[j][i][0] + v[j][i][1] * v[j][i][1]) + (v[j][i][2] * v[j][i][2] + v[j][i][3] * v[j][i][3]); }
            rs[j] = q; }
#pragma unroll
        for (int j = 0; j < 4; ++j) rs[j] = rsqrtf(wave_sum(rs[j]) * (1.0f / 1024.0f) + EPS_F);
        float lgt[4][16];
#pragma unroll
        for (int j = 0; j < 4; ++j)
#pragma unroll
            for (int e = 0; e < 16; ++e) lgt[j][e] = 0.f;
#pragma unroll
        for (int i = 0; i < 4; ++i) {
            const int col = lane * 4 + 256 * i;
            const f32x4 g4 = *(const f32x4*)(lg + col), b4 = *(const f32x4*)(lb + col), sc4 = *(const f32x4*)(scl + col) + 1.0f, sh4 = *(const f32x4*)(sh + col);
            f32x4 h[4];
#pragma unroll
            for (int j = 0; j < 4; ++j) {
                const f32x4 x = v[j][i] * rs[j] * g4 + b4;
                *(f32x4*)(p.X1 + (size_t)(r0 + j) * D + col) = x;
                h[j] = x * sc4 + sh4;
                u32x2 o; o.x = pk_bf16(h[j][0], h[j][1]); o.y = pk_bf16(h[j][2], h[j][3]);
                *(u32x2*)(p.H2 + (size_t)(r0 + j) * D + col) = o;
            }
#pragma unroll
            for (int e = 0; e < 16; ++e) {
                const f32x4 rw = *(LAS f32x4*)(rt + e * 1024 + col);
#pragma unroll
                for (int j = 0; j < 4; ++j) lgt[j][e] += (h[j][0] * rw[0] + h[j][1] * rw[1]) + (h[j][2] * rw[2] + h[j][3] * rw[3]);
                if ((e & 3) == 3) __builtin_amdgcn_sched_barrier(0);
            }
        }
        float r1[4];
#pragma unroll
        for (int j = 0; j < 4; ++j) {
            float r8[8], r4[4], r2[2];
            { const bool hi = (lane & 32) != 0;
#pragma unroll
              for (int i = 0; i < 8; ++i) { const float keep = hi ? lgt[j][8 + i] : lgt[j][i], send = hi ? lgt[j][i] : lgt[j][8 + i]; r8[i] = keep + __shfl_xor(send, 32); } }
            { const bool hi = (lane & 16) != 0;
#pragma unroll
              for (int i = 0; i < 4; ++i) { const float keep = hi ? r8[4 + i] : r8[i], send = hi ? r8[i] : r8[4 + i]; r4[i] = keep + __shfl_xor(send, 16); } }
            { const bool hi = (lane & 8) != 0;
#pragma unroll
              for (int i = 0; i < 2; ++i) { const float keep = hi ? r4[2 + i] : r4[i], send = hi ? r4[i] : r4[2 + i]; r2[i] = keep + __shfl_xor(send, 8); } }
            { const bool hi = (lane & 4) != 0; const float keep = hi ? r2[1] : r2[0], send = hi ? r2[0] : r2[1]; r1[j] = keep + __shfl_xor(send, 4); }
        }
        const int e = ((lane >> 5) & 1) * 8 + ((lane >> 4) & 1) * 4 + ((lane >> 3) & 1) * 2 + ((lane >> 2) & 1);
#pragma unroll
        for (int j = 0; j < 4; ++j) {
            float r = r1[j];
            r += __shfl_xor(r, 2); r += __shfl_xor(r, 1);
            float mx = r;
            mx = fmaxf(mx, __shfl_xor(mx, 4)); mx = fmaxf(mx, __shfl_xor(mx, 8)); mx = fmaxf(mx, __shfl_xor(mx, 16)); mx = fmaxf(mx, __shfl_xor(mx, 32));
            const float ex = __expf(r - mx);
            float den = ex;
            den += __shfl_xor(den, 4); den += __shfl_xor(den, 8); den += __shfl_xor(den, 16); den += __shfl_xor(den, 32);
            if ((lane & 3) == 0) p.AFF[(size_t)e * NTOK + r0 + j] = ex / den;
        }
    }
}

DEVI int block_sum_i(int v, LAS int* red, int tid) {
    const int lane = tid & 63, wave = tid >> 6;
    v = __builtin_popcountll(__ballot(v & 1)) + 2 * __builtin_popcountll(__ballot(v & 2)) + 4 * __builtin_popcountll(__ballot(v & 4)) + 8 * __builtin_popcountll(__ballot(v & 8));
    __syncthreads();
    if (lane == 0) red[wave] = v;
    __syncthreads();
    return (red[0] + red[1]) + (red[2] + red[3]) + (red[4] + red[5]) + (red[6] + red[7]);
}
DEVI int block_excl_scan_i(int v, LAS int* red, int tid, int& total) {
    const int lane = tid & 63, wave = tid >> 6;
    int inc = v;
#pragma unroll
    for (int o = 1; o < 64; o <<= 1) { const int t = __shfl_up(inc, o); if (lane >= o) inc += t; }
    __syncthreads();
    if (lane == 63) red[wave] = inc;
    __syncthreads();
    int base = 0, tot = 0;
#pragma unroll
    for (int w = 0; w < 8; ++w) { const int c = red[w]; if (w < wave) base += c; tot += c; }
    total = tot;
    return base + inc - v;
}
DEVI void phase_topk(const Params& p, lds_t* lds, int bid, int nblk, int tid) {
    LAS int* red = (LAS int*)lds;
    for (int it = bid; it < 32; it += nblk) {
        const int grp = it >> 4, e = it & 15;
        const float* a = p.AFF + (size_t)e * NTOK + grp * 4096 + tid * 8;
        const f32x4 a0 = *(const f32x4*)a, a1 = *(const f32x4*)(a + 4);
        unsigned key[8];
#pragma unroll
        for (int i = 0; i < 4; ++i) { key[i] = __float_as_uint(a0[i]); key[4 + i] = __float_as_uint(a1[i]); }
        unsigned thr = 0u;
        for (int bit = 30; bit >= 0; --bit) {
            const unsigned cand = thr | (1u << bit);
            int c = 0;
#pragma unroll
            for (int i = 0; i < 8; ++i) c += key[i] >= cand ? 1 : 0;
            if (block_sum_i(c, red, tid) >= 512) thr = cand;
        }
        int cgt = 0, ceq = 0;
#pragma unroll
        for (int i = 0; i < 8; ++i) { cgt += key[i] > thr ? 1 : 0; ceq += key[i] == thr ? 1 : 0; }
        int ngt, neq;
        (void)block_excl_scan_i(cgt, red, tid, ngt);
        int tie_rank = block_excl_scan_i(ceq, red, tid, neq);
        const int need = 512 - ngt;
        int sel[8], cs = 0;
#pragma unroll
        for (int i = 0; i < 8; ++i) {
            const bool eq = key[i] == thr;
            sel[i] = (key[i] > thr || (eq && tie_rank < need)) ? 1 : 0;
            tie_rank += eq ? 1 : 0; cs += sel[i];
        }
        int tot;
        int slot = block_excl_scan_i(cs, red, tid, tot);
#pragma unroll
        for (int i = 0; i < 8; ++i) {
            const int t = grp * 4096 + tid * 8 + i;
            int sl = -1;
            if (sel[i]) { sl = grp * 512 + slot; ++slot; p.IDX[e * 1024 + sl] = t; p.GATEV[e * 1024 + sl] = __uint_as_float(key[i]); }
            p.SEL[(size_t)t * 16 + e] = sl;
        }
    }
}

DEVI void phase_ln_b(const Params& p, int layer, int bid, int nblk, int tid) {
    const int lane = tid & 63, wave = tid >> 6;
    const float* lg = p.ln_gain + (layer * 2 + 1) * 1024; const float* lb = p.ln_bias + (layer * 2 + 1) * 1024;
    const bool last = (layer == DEPTH - 1);
    float* xo = last ? p.out + OUT_Y : p.X0;
    const int stride = nblk * 8;
    int row = bid * 8 + wave;
    int seln = -1; f32x4 xn[4];
    if (row < NTOK) {
        if (lane < 16) seln = p.SEL[(size_t)row * 16 + lane];
#pragma unroll
        for (int i = 0; i < 4; ++i) xn[i] = *(const f32x4*)(p.X1 + (size_t)row * D + lane * 4 + 256 * i);
    }
    for (; row < NTOK; row += stride) {
        const int selv = seln;
        f32x4 v[4];
#pragma unroll
        for (int i = 0; i < 4; ++i) v[i] = xn[i];
        unsigned long long mask = __ballot(selv >= 0);
        f32x4 y[4];
#pragma unroll
        for (int i = 0; i < 4; ++i) y[i] = (f32x4){0.f, 0.f, 0.f, 0.f};
        while (mask) {
            const int e0 = __builtin_ctzll(mask); mask &= mask - 1;
            const int s0 = __builtin_amdgcn_readlane(selv, e0);
            const bf16_t* y0 = p.YE + ((size_t)e0 * 1024 + s0) * 1024 + lane * 4;
            const bool two = mask != 0;
            int e1 = e0, s1 = s0;
            if (two) { e1 = __builtin_ctzll(mask); mask &= mask - 1; s1 = __builtin_amdgcn_readlane(selv, e1); }
            const bf16_t* y1 = p.YE + ((size_t)e1 * 1024 + s1) * 1024 + lane * 4;
            u32x2 w0[4], w1[4];
#pragma unroll
            for (int i = 0; i < 4; ++i) { w0[i] = *(const u32x2*)(y0 + 256 * i); w1[i] = *(const u32x2*)(y1 + 256 * i); }
            const float f1 = two ? 1.0f : 0.0f;
#pragma unroll
            for (int i = 0; i < 4; ++i) {
                y[i][0] += bf_lo(w0[i].x) + f1 * bf_lo(w1[i].x); y[i][1] += bf_hi(w0[i].x) + f1 * bf_hi(w1[i].x);
                y[i][2] += bf_lo(w0[i].y) + f1 * bf_lo(w1[i].y); y[i][3] += bf_hi(w0[i].y) + f1 * bf_hi(w1[i].y);
            }
        }
        if (row + stride < NTOK) {
            seln = -1;
            if (lane < 16) seln = p.SEL[(size_t)(row + stride) * 16 + lane];
#pragma unroll
            for (int i = 0; i < 4; ++i) xn[i] = *(const f32x4*)(p.X1 + (size_t)(row + stride) * D + lane * 4 + 256 * i);
        }
        const int cnd = cond_of_row(row);
        const float* gt = modp(p, layer, cnd, 5);
        float s = 0.f;
#pragma unroll
        for (int i = 0; i < 4; ++i) {
            const int col = lane * 4 + 256 * i;
            v[i] = v[i] * ALPHA_F + *(const f32x4*)(gt + col) * y[i];
            s += (v[i][0] + v[i][1]) + (v[i][2] + v[i][3]);
        }
        s = wave_sum(s);
        const float mu = s * (1.0f / 1024.0f);
        float q = 0.f;
#pragma unroll
        for (int i = 0; i < 4; ++i) { v[i] = v[i] - mu; q += (v[i][0] * v[i][0] + v[i][1] * v[i][1]) + (v[i][2] * v[i][2] + v[i][3] * v[i][3]); }
        q = wave_sum(q);
        const float rs = rsqrtf(q * (1.0f / 1024.0f) + EPS_F);
        const float* sh = modp(p, last ? layer : layer + 1, cnd, 0); const float* scl = modp(p, last ? layer : layer + 1, cnd, 1);
#pragma unroll
        for (int i = 0; i < 4; ++i) {
            const int col = lane * 4 + 256 * i;
            const f32x4 x = v[i] * rs * *(const f32x4*)(lg + col) + *(const f32x4*)(lb + col);
            *(f32x4*)(xo + (size_t)row * D + col) = x;
            if (!last) {
                const f32x4 h = x * (*(const f32x4*)(scl + col) + 1.0f) + *(const f32x4*)(sh + col);
                u32x2 o; o.x = pk_bf16(h[0], h[1]); o.y = pk_bf16(h[2], h[3]);
                *(u32x2*)(p.H + (size_t)row * D + col) = o;
            }
        }
    }
}

constexpr int GBM = 128;
constexpr int GBM2 = 256;
DEVI int xcd_first_unit(int bid, int nblk) { return (nblk & 7) ? bid : (bid & 7) * (nblk >> 3) + (bid >> 3); }
struct RowLin { const bf16_t* base; unsigned ld; DEVI unsigned offset(int r) const { return (unsigned)r * ld; } };
struct RowGather { const bf16_t* base; const int* idx; DEVI unsigned offset(int r) const { return (unsigned)(idx[r] & 8191) * 1024u; } };
struct RowClamp { const bf16_t* base; unsigned ld; int r0, rmax; DEVI unsigned offset(int r) const { int q = r0 + r; if (q > rmax) q = rmax; return (unsigned)q * ld; } };
struct RowKv { const bf16_t* base; int n0, isv; DEVI unsigned offset(int r) const { const int n = n0 + r; return (unsigned)((n >> 7) * 256 + isv * 128 + (n & 127)) * 256u; } };
struct GDesc { RowLin rf; WLin wl; unsigned ldw; int nk; };
struct WUp { const float* base; int kv; DEVI const float* operator()(int lane) const { return kv ? base + (lane >> 5) * 256 + ((4 * lane) & 127) : base + 4 * lane; } };
struct GDescUp { RowLin rf; WUp wl; unsigned ldw; };
struct WClamp { const float* base; int col0; DEVI const float* operator()(int lane) const { int c = col0 + 4 * lane; if (c > 700) c = 700; return base + c; } };
struct WLinP { const float* base; DEVI const float* operator()(int lane) const { const int r = 4 * lane; return base + 32 * (r >> 5) + 8 * ((r & 15) >> 2) + 4 * ((r >> 4) & 1); } };
struct WMoe { const float* gate; const float* up; size_t off; DEVI const float* operator()(int lane) const { const int r = 4 * lane, sub = r >> 5;
    const unsigned long long ga = (unsigned long long)gate, ua = (unsigned long long)up, mk = 0ull - (unsigned long long)(sub & 1);
    return (const float*)(ga ^ ((ga ^ ua) & mk)) + off + 32 * (sub >> 1) + 8 * ((r & 15) >> 2) + 4 * ((r >> 4) & 1); } };

DEVI void st_bf16x4(bf16_t* dst, f32x4 v) { u32x2 o; o.x = pk_bf16(v[0], v[1]); o.y = pk_bf16(v[2], v[3]); *(u32x2*)dst = o; }

template <int TM> DEVI void rope_tile(f32x4 (&acc)[TM][4], int row0  , int lane) {
    const int r16 = lane & 15, g = lane >> 4;
#pragma unroll
    for (int mb = 0; mb < TM; ++mb) {
        const int t = (row0 + mb * 16 + r16 - NPR) & 1023;
        const int prow = t >> 6, pcol = t & 63;
#pragma unroll
        for (int r = 0; r < 4; ++r) {
            const int f = 4 * g + r;
            const float c1 = rope_tab[(prow * 16 + f) * 2], s1 = rope_tab[(prow * 16 + f) * 2 + 1];
            const float c2 = rope_tab[(pcol * 16 + f) * 2], s2 = rope_tab[(pcol * 16 + f) * 2 + 1];
            const float a1 = acc[mb][0][r], a2 = acc[mb][1][r], b1 = acc[mb][2][r], b2 = acc[mb][3][r];
            acc[mb][0][r] = a1 * c1 - a2 * s1; acc[mb][1][r] = a2 * c1 + a1 * s1;
            acc[mb][2][r] = b1 * c2 - b2 * s2; acc[mb][3][r] = b2 * c2 + b1 * s2;
        }
        __builtin_amdgcn_sched_barrier(0);
    }
}

template <int BM> struct EpiZ { float* Z; int m0, n0;
    DEVI void operator()(const f32x4 (&acc)[BM / 32][4], int wr, int wc, int lane) const {
        const int r16 = lane & 15, g = lane >> 4;
#pragma unroll
        for (int mb = 0; mb < BM / 32; ++mb) { const int row = m0 + wr * (BM / 2) + mb * 16 + r16;
#pragma unroll
            for (int nb = 0; nb < 4; ++nb) { const int col = n0 + wc * 64 + nb * 16 + 4 * g; if (col < 704) *(f32x4*)(Z + (size_t)row * 704 + col) = acc[mb][nb]; } }
    } };
DEVI void phase_mla_win(const Params& p, int j, lds_t* lds, int bid, int nblk, int tid) {
    constexpr int MT = NTOK / GBM, NU = MT * 3;
    for (int u = xcd_first_unit(bid, nblk); u < NU; u += nblk) {
        const int mt = u % MT, nt = u / MT;
        RowLin rf{p.H + (size_t)mt * GBM * 1024, 1024u};
        RowClamp wf{p.WTI + (size_t)j * 704 * 1024, 1024u, nt * 256, 703};
        EpiZ<GBM> epi{p.Z, mt * GBM, nt * 256};
        gemm_unit_bb3<GBM, true>(lds, rf, wf, 16, epi, tid);
    }
}

template <int NPM, int NPN, int GM, int GN>
struct SchedGrid { const bf16_t* A; const bf16_t* B; int v0, G; size_t tileA, tileB;
    static_assert(NPM % GM == 0 && NPN % GN == 0, "unit grid");
    DEVI bool next(int i, pg8::Unit& u) const {
        const int L = __builtin_amdgcn_readfirstlane(i * G + v0); if (L >= NPM * NPN) return false;
        constexpr int NGM = NPM / GM;
        const int g = L / (GM * GN), w = L % (GM * GN); u.pm = (g % NGM) * GM + (w % GM); u.pn = (g / NGM) * GN + (w / GM); u.aux = 0; return true; }
    DEVI void ptrs(const pg8::Unit& u, const char*& a, const char*& b) const { a = (const char*)(A + (size_t)u.pm * tileA); b = (const char*)(B + (size_t)u.pn * tileB); }
};
DEVI int rot_unit(int v, int off, int G) { int r = v - off; if (r < 0) r += G; return r; }
struct EpiMlaQ { static constexpr bool PERM = false; bf16_t* Q; float scale;
    DEVI void operator()(const f32x4 (&acc)[2][2][4][2], const pg8::Unit& u, int wr, int wc, int fr_in, int fq_in) const {
        int ln = fr_in | (fq_in << 4); asm volatile("" : "+v"(ln));
#pragma unroll
        for (int bj = 0; bj < 2; ++bj) {
            const int c0 = u.pn * 256 + bj * 128 + wc * 32;
            const int gi = (c0 % 192) >> 5;
            const bool rope = (u.pm >= 16) && (gi >= 4);
#pragma unroll
            for (int ai = 0; ai < 2; ++ai)
#pragma unroll
                for (int m = 0; m < 4; ++m) { asm volatile("" : "+v"(ln)); const int fr = ln & 15, fq = ln >> 4;
                    const int row = u.pm * 256 + ai * 128 + wr * 64 + m * 16 + fr;
                    f32x4 x1 = acc[ai][bj][m][0], x2 = acc[ai][bj][m][1];
                    if (rope) { const int t = (row - NPR) & 1023, pos = (gi == 4) ? (t >> 6) : (t & 63);
#pragma unroll
                        for (int j = 0; j < 4; ++j) { const f32x2 cs = *(const f32x2*)(rope_tab + (pos * 16 + 4 * fq + j) * 2);
                            const float a = x1[j], b = x2[j]; x1[j] = a * cs.x - b * cs.y; x2[j] = b * cs.x + a * cs.y; } }
                    bf16_t* dst = Q + (size_t)row * 1536 + c0 + 4 * fq;
                    st_bf16x4(dst, x1 * scale); st_bf16x4(dst + 16, x2 * scale);
                    __builtin_amdgcn_sched_barrier(0); }
        }
    } };
struct EpiMlaK { static constexpr bool PERM = true; bf16_t* KN;
    DEVI void operator()(const f32x4 (&acc)[2][2][4][2], const pg8::Unit& u, int wr, int wc, int fr_in, int fq_in) const {
        int ln = fr_in | (fq_in << 4); asm volatile("" : "+v"(ln));
        const int fr = ln & 15, fq = ln >> 4;
#pragma unroll
        for (int ai = 0; ai < 2; ++ai)
#pragma unroll
            for (int m = 0; m < 4; ++m) { const int row = u.pm * 256 + ai * 128 + wr * 64 + m * 16 + fr;
#pragma unroll
                for (int bj = 0; bj < 2; ++bj) { const f32x4 a = acc[ai][bj][m][0], b = acc[ai][bj][m][1];
                    u32x4 w; w.x = pk_bf16(a[0], a[1]); w.y = pk_bf16(a[2], a[3]); w.z = pk_bf16(b[0], b[1]); w.w = pk_bf16(b[2], b[3]);
                    *(u32x4*)(KN + (size_t)row * 1024 + u.pn * 256 + bj * 128 + wc * 32 + 8 * fq) = w; } }
    } };
struct EpiMlaV { static constexpr bool PERM = true; bf16_t* VTP; bf16_t* VTS;
    DEVI void operator()(const f32x4 (&acc)[2][2][4][2], const pg8::Unit& u, int wr, int wc, int fr_in, int fq_in) const {
        int ln = fr_in | (fq_in << 4); asm volatile("" : "+v"(ln));
        const int fr = ln & 15, fq = ln >> 4;
        const int R0 = u.pn * 256;
        bf16_t* base; unsigned ldk;
        if (R0 < NPR) { base = VTP + (size_t)(R0 >> 8) * (8 * 128 * 256); ldk = 256; }
        else if (R0 < NTOK) { base = VTS + (size_t)((R0 - NPR) >> 10) * (8 * 128 * 1280) + 256 + ((R0 - NPR) & 1023); ldk = 1280; }
        else { base = VTS + (size_t)((R0 - NTOK) >> 8) * (8 * 128 * 1280); ldk = 1280; }
#pragma unroll
        for (int ai = 0; ai < 2; ++ai)
#pragma unroll
            for (int m = 0; m < 4; ++m) { const unsigned hd = (unsigned)((2 * u.pm + ai) * 128 + wr * 64 + m * 16 + fr);
#pragma unroll
                for (int bj = 0; bj < 2; ++bj) { const f32x4 a = acc[ai][bj][m][0], b = acc[ai][bj][m][1];
                    u32x4 w; w.x = pk_bf16(a[0], a[1]); w.y = pk_bf16(a[2], a[3]); w.z = pk_bf16(b[0], b[1]); w.w = pk_bf16(b[2], b[3]);
                    *(u32x4*)(base + (unsigned)(hd * ldk + bj * 128 + wc * 32 + 8 * fq)) = w; }
                __builtin_amdgcn_sched_barrier(0); }
    } };
DEVI void phase_mla_up(const Params& p, int j, lds_t* lds, int bid, int nblk, int tid) {
    int v = xcd_first_unit(bid, nblk);
    const int wid = __builtin_amdgcn_readfirstlane(tid >> 6);
    const bf16_t* wkv = p.WTKV + (size_t)j * 2048 * 256;
    {
        SchedGrid<32, 6, 16, 2> S{p.CQ, p.WTQ + (size_t)j * 1536 * 384, v, nblk, (size_t)256 * 384, (size_t)256 * 384};
        EpiMlaQ E{p.Q, 0.07216878364870322f * LOG2E};
        pg8::gemm_phase(lds, 384, 6, S, E, tid);
    }
    tid = wid * 64 + lane_id_fresh(); asm volatile("" : "+s"(v)); __builtin_amdgcn_sched_barrier(0);
    {
        SchedGrid<36, 4, 4, 4> S{p.CKV, wkv, rot_unit(v, 192 % nblk, nblk), nblk, (size_t)256 * 256, (size_t)512 * 256};
        EpiMlaK E{p.KN};
        pg8::gemm_phase(lds, 256, 4, S, E, tid, 128, 256);
    }
    tid = wid * 64 + lane_id_fresh(); asm volatile("" : "+s"(v)); __builtin_amdgcn_sched_barrier(0);
    {
        SchedGrid<4, 36, 4, 4> S{wkv + (size_t)128 * 256, p.CKV, rot_unit(v, 80 % nblk, nblk), nblk, (size_t)512 * 256, (size_t)256 * 256};
        EpiMlaV E{p.VTP, p.VTS};
        pg8::gemm_phase(lds, 256, 4, S, E, tid, 256, 128);
    }
}

struct SchedOut { const bf16_t* A; const bf16_t* W; int K, v0, G;
    DEVI bool next(int i, pg8::Unit& u) const {
        const int L = i * G + v0; if (L >= 256) return false;
        const int g = L >> 5, w = L & 31; u.aux = g & 1; u.pm = (g >> 1) * 8 + (w & 7); u.pn = w >> 3; return true; }
    DEVI void ptrs(const pg8::Unit& u, const char*& a, const char*& b) const {
        a = (const char*)(A + (size_t)u.pm * 256 * K + (size_t)u.aux * (K >> 1)); b = (const char*)(W + (size_t)u.pn * 256 * K + (size_t)u.aux * (K >> 1)); }
};
struct EpiOut { static constexpr bool PERM = true; bf16_t* Y; const float* mod; int layer;
    DEVI void operator()(const f32x4 (&acc)[2][2][4][2], const pg8::Unit& u, int wr, int wc, int fr_in, int fq_in) const {
        int ln = fr_in | (fq_in << 4); asm volatile("" : "+v"(ln));
        const int fr = ln & 15, fq = ln >> 4;
        const float* gt = mod + ((size_t)(layer * 5 + cond_of_row(u.pm * 256)) * 6 + 2) * 1024;
        bf16_t* Yk = Y + (size_t)u.aux * NTOK * D;
#pragma unroll
        for (int bj = 0; bj < 2; ++bj) { const int col = u.pn * 256 + bj * 128 + wc * 32 + 8 * fq;
            const f32x4 g0 = *(const f32x4*)(gt + col), g1 = *(const f32x4*)(gt + col + 4);
#pragma unroll
            for (int ai = 0; ai < 2; ++ai)
#pragma unroll
                for (int m = 0; m < 4; ++m) { const int row = u.pm * 256 + ai * 128 + wr * 64 + m * 16 + fr;
                    const f32x4 a = acc[ai][bj][m][0] * g0, b = acc[ai][bj][m][1] * g1;
                    u32x4 w; w.x = pk_bf16(a[0], a[1]); w.y = pk_bf16(a[2], a[3]); w.z = pk_bf16(b[0], b[1]); w.w = pk_bf16(b[2], b[3]);
                    *(u32x4*)(Yk + (size_t)row * D + col) = w; } }
    } };
DEVI void phase_out_proj(const Params& p, int layer, const bf16_t* A, int K, const bf16_t* Wt, lds_t* lds, int bid, int nblk, int tid) {
    SchedOut S{A, Wt, K, xcd_first_unit(bid, nblk), nblk};
    EpiOut E{(bf16_t*)p.T, p.mod, layer};
    pg8::gemm_phase(lds, K, K >> 7, S, E, tid);
}

struct SchedGmWin { const bf16_t* H; const bf16_t* W; int v0, G;
    DEVI bool next(int i, pg8::Unit& u) const {
        const int L = i * G + v0; if (L >= 768) return false;
        if (L < 384) { const int g = L >> 5, w = L & 31; u.pm = (g & 3) * 8 + (w & 7); u.pn = (g >> 2) * 4 + (w >> 3); u.aux = 0; }
        else { const int g = (L - 384) >> 5, w = L & 31; u.pm = (g % 3) * 4 + (w & 3); u.pn = (g / 3) * 8 + (w >> 2); u.aux = 1; }
        return true; }
    DEVI void ptrs(const pg8::Unit& u, const char*& a, const char*& b) const {
        if (u.aux == 0) { a = (const char*)(H + (size_t)u.pm * 256 * 1024); b = (const char*)(W + (size_t)u.pn * 256 * 1024); }
        else { a = (const char*)(W + (size_t)(3072 + u.pm * 256) * 1024); b = (const char*)(H + (size_t)u.pn * 256 * 1024); } }
};
struct EpiGmWin { static constexpr bool PERM = true; bf16_t* U; bf16_t* GVT; float* GST;
    DEVI void operator()(const f32x4 (&acc)[2][2][4][2], const pg8::Unit& u, int wr, int wc, int fr_in, int fq_in) const {
        int ln = fr_in | (fq_in << 4); asm volatile("" : "+v"(ln));
        const int fr = ln & 15, fq = ln >> 4;
        const bool vhalf = u.aux != 0;
#pragma unroll
        for (int bj = 0; bj < 2; ++bj) {
            f32x4 s0 = (f32x4){0.f, 0.f, 0.f, 0.f}, s1 = s0, q0 = s0, q1 = s0;
            const int cpos = u.pn * 256 + bj * 128 + wc * 32 + 8 * fq;
#pragma unroll
            for (int ai = 0; ai < 2; ++ai)
#pragma unroll
                for (int m = 0; m < 4; ++m) { const int r = u.pm * 256 + ai * 128 + wr * 64 + m * 16 + fr;
                    f32x4 a = acc[ai][bj][m][0], b = acc[ai][bj][m][1];
#pragma unroll
                    for (int j = 0; j < 4; ++j) { a[j] = gelu_tanh_f(a[j]); b[j] = gelu_tanh_f(b[j]); }
                    u32x4 w; w.x = pk_bf16(a[0], a[1]); w.y = pk_bf16(a[2], a[3]); w.z = pk_bf16(b[0], b[1]); w.w = pk_bf16(b[2], b[3]);
                    if (!vhalf) *(u32x4*)(U + (size_t)r * 3072 + cpos) = w;
                    else { s0 += a; q0 += a * a; s1 += b; q1 += b * b; *(u32x4*)(GVT + ((size_t)(cpos >> 7) * 3072 + r) * 128 + (cpos & 127)) = w; }
                    __builtin_amdgcn_sched_barrier(0); }
            if (vhalf) {
#pragma unroll
                for (int o = 1; o < 16; o <<= 1)
#pragma unroll
                    for (int j = 0; j < 4; ++j) { s0[j] += __shfl_xor(s0[j], o); q0[j] += __shfl_xor(q0[j], o); s1[j] += __shfl_xor(s1[j], o); q1[j] += __shfl_xor(q1[j], o); }
                if (fr == 0) { const int part = u.pm * 2 + wr;
#pragma unroll
                    for (int j = 0; j < 4; ++j) { f32x2 w2; w2.x = s0[j]; w2.y = q0[j]; *(f32x2*)(GST + ((size_t)(cpos + j) * 24 + part) * 2) = w2;
                                                  f32x2 w3; w3.x = s1[j]; w3.y = q1[j]; *(f32x2*)(GST + ((size_t)(cpos + 4 + j) * 24 + part) * 2) = w3; } }
            }
            __builtin_amdgcn_sched_barrier(0);
        }
    } };
DEVI void phase_gm_win(const Params& p, lds_t* lds, int bid, int nblk, int tid) {
    SchedGmWin S{p.H, p.WTGI, xcd_first_unit(bid, nblk), nblk};
    EpiGmWin E{p.U, p.GVT, p.GST};
    pg8::gemm_phase(lds, 1024, 16, S, E, tid);
}

template <int BM> struct EpiSQ { bf16_t* Q; int m0, n0; float scale;
    DEVI void operator()(f32x4 (&acc)[BM / 32][4], int wr, int wc, int lane) const {
        const int r16 = lane & 15, g = lane >> 4;
        if (m0 >= NPR) rope_tile<BM / 32>(acc, m0 + wr * (BM / 2), lane);
#pragma unroll
        for (int mb = 0; mb < BM / 32; ++mb) { const int row = m0 + wr * (BM / 2) + mb * 16 + r16;
#pragma unroll
            for (int nb = 0; nb < 4; ++nb) st_bf16x4(Q + (size_t)row * 1024 + n0 + wc * 64 + nb * 16 + 4 * g, acc[mb][nb] * scale); }
    } };
template <int BM> struct EpiSK { bf16_t* SK; float* out; int m0;
    DEVI void operator()(f32x4 (&acc)[BM / 32][4], int wr, int wc, int lane) const {
        const int r16 = lane & 15, g = lane >> 4;
        if (m0 >= NPR) rope_tile<BM / 32>(acc, m0 + wr * (BM / 2), lane);
#pragma unroll
        for (int mb = 0; mb < BM / 32; ++mb) { const int row = m0 + wr * (BM / 2) + mb * 16 + r16;
#pragma unroll
            for (int nb = 0; nb < 4; ++nb) { const int col = wc * 64 + nb * 16 + 4 * g;
                if (m0 < NPR) *(f32x4*)(out + OUT_SK + (size_t)row * 256 + col) = acc[mb][nb];
                st_bf16x4(SK + (size_t)row * 256 + col, acc[mb][nb]); } }
    } };
template <int BM> struct EpiSV { bf16_t* SVTP; bf16_t* SVTS; float* out; int m0;
    DEVI void operator()(const f32x4 (&acc)[BM / 32][4], int wr, int wc, int lane) const {
        const int r16 = lane & 15, g = lane >> 4;
#pragma unroll
        for (int mb = 0; mb < BM / 32; ++mb) { const int row = m0 + wr * (BM / 2) + mb * 16 + 4 * g;
            bf16_t* dst; size_t ldk;
            if (row < NPR) { dst = SVTP + (size_t)(row >> 8) * (4 * 64 * 256) + (row & 255); ldk = 256; }
            else { dst = SVTS + (size_t)((row - NPR) >> 10) * (4 * 64 * 1280) + 256 + ((row - NPR) & 1023); ldk = 1280; }
#pragma unroll
            for (int nb = 0; nb < 4; ++nb) { const int col = wc * 64 + nb * 16 + r16;
                st_bf16x4(dst + (size_t)col * ldk, acc[mb][nb]);
                if (row < NPR) {
#pragma unroll
                    for (int r = 0; r < 4; ++r) out[OUT_SV + (size_t)(row + r) * 256 + col] = acc[mb][nb][r]; } } }
    } };
DEVI void phase_swa_qkv(const Params& p, lds_t* lds, int bid, int nblk, int tid) {
    constexpr int MT = NTOK / GBM2, NU = MT * 6;
    for (int u = xcd_first_unit(bid, nblk); u < NU; u += nblk) {
        const int mt = u % MT, nt = u / MT;
        RowLin rf{p.H + (size_t)mt * GBM2 * 1024, 1024u};
        RowLin wf{p.WTSQ + (size_t)nt * 256 * 1024, 1024u};
        if (nt < 4) { EpiSQ<GBM2> epi{p.Q, mt * GBM2, nt * 256, 0.125f * LOG2E}; gemm_unit_bb<GBM2, true>(lds, rf, wf, 16, epi, tid); }
        else if (nt == 4) { EpiSK<GBM2> epi{p.SK, p.out, mt * GBM2}; gemm_unit_bb<GBM2, true>(lds, rf, wf, 16, epi, tid); }
        else { EpiSV<GBM2> epi{p.SVTP, p.SVTS, p.out, mt * GBM2}; gemm_unit_bb<GBM2, false>(lds, rf, wf, 16, epi, tid); }
    }
}

template <int BM> struct EpiHid { bf16_t* HID; int e, mt, nt;
    DEVI void operator()(const f32x4 (&acc)[BM / 32][4], int wr, int wc, int lane) const {
        const int r16 = lane & 15, g = lane >> 4;
#pragma unroll
        for (int mb = 0; mb < BM / 32; ++mb) { const size_t row = (size_t)e * 1024 + mt * BM + wr * (BM / 2) + mb * 16 + r16;
            u32x4 w;
            { const f32x4 gv = acc[mb][0], uv = acc[mb][2]; w.x = pk_bf16(silu_f(gv[0]) * uv[0], silu_f(gv[1]) * uv[1]); w.y = pk_bf16(silu_f(gv[2]) * uv[2], silu_f(gv[3]) * uv[3]); }
            { const f32x4 gv = acc[mb][1], uv = acc[mb][3]; w.z = pk_bf16(silu_f(gv[0]) * uv[0], silu_f(gv[1]) * uv[1]); w.w = pk_bf16(silu_f(gv[2]) * uv[2], silu_f(gv[3]) * uv[3]); }
            *(u32x4*)(HID + row * 2048 + nt * 128 + wc * 32 + 8 * g) = w; }
    } };
template <int DBG = 0> DEVI void phase_moe_up(const Params& p, int layer, lds_t* lds, int bid, int nblk, int tid) {
    constexpr int MT = 1024 / GBM2, NU = 16 * MT * 16;
#define DEC_MU(u_, rf_, wf_) do { const int e_ = (u_) / (MT * 16), w_ = (u_) % (MT * 16), mt_ = w_ % MT, nt_ = w_ / MT; \
        rf_ = RowGather{p.H2, p.IDX + e_ * 1024 + mt_ * GBM2}; wf_ = WMoe{p.moe_w_gate, p.moe_w_up, ((size_t)layer * 16 + e_) * 1024 * 2048 + nt_ * 128}; } while (0)
    int u = xcd_first_unit(bid, nblk);
    RowGather rf, rfn; WMoe wf, wfn;
    for (; u < NU; u += nblk) {
        const int e = u / (MT * 16), w = u % (MT * 16), mt = w % MT, nt = w / MT;
        DEC_MU(u, rf, wf);
        EpiHid<GBM2> epi{p.HID, e, mt, nt};
        gemm_unit<GBM2, true>(lds, rf, wf, 2048u, 16, epi, tid);
    }
#undef DEC_MU
}
template <int BM> struct EpiYe { bf16_t* YE; const float* GATEV; int e, mt, nt;
    DEVI void operator()(const f32x4 (&acc)[BM / 32][4], int wr, int wc, int lane) const {
        const int r16 = lane & 15, g = lane >> 4;
#pragma unroll
        for (int mb = 0; mb < BM / 32; ++mb) { const size_t row = (size_t)e * 1024 + mt * BM + wr * (BM / 2) + mb * 16 + r16;
            const float gt = GATEV[row];
#pragma unroll
            for (int np = 0; np < 2; ++np) {
                const f32x4 a = acc[mb][2 * np] * gt, b = acc[mb][2 * np + 1] * gt;
                u32x4 w; w.x = pk_bf16(a[0], a[1]); w.y = pk_bf16(a[2], a[3]); w.z = pk_bf16(b[0], b[1]); w.w = pk_bf16(b[2], b[3]);
                *(u32x4*)(YE + row * 1024 + nt * 256 + wc * 64 + 32 * np + 8 * g) = w; } }
    } };
DEVI void phase_moe_down(const Params& p, int layer, lds_t* lds, int bid, int nblk, int tid) {
    constexpr int MT = 1024 / GBM2, NU = 16 * MT * 4;
#define DEC_MD(u_, d_) do { const int e_ = (u_) / (MT * 4), w_ = (u_) % (MT * 4), mt_ = w_ % MT, nt_ = w_ / MT; \
        d_.rf = RowLin{p.HID + ((size_t)e_ * 1024 + mt_ * GBM2) * 2048, 2048u}; d_.wl = WLin{p.moe_w_down + ((size_t)layer * 16 + e_) * 2048 * 1024 + nt_ * 256}; d_.ldw = 1024u; d_.nk = 32; } while (0)
    int u = xcd_first_unit(bid, nblk);
    GDesc d, dn;
    for (; u < NU; u += nblk) {
        const int e = u / (MT * 4), w = u % (MT * 4), mt = w % MT, nt = w / MT;
        DEC_MD(u, d);
        EpiYe<GBM2> epi{p.YE, p.GATEV, e, mt, nt};
        gemm_unit<GBM2, true>(lds, d.rf, WLinP{d.wl.base}, d.ldw, 32, epi, tid);
    }
#undef DEC_MD
}

template <int DK, int DV> struct AttnCfg {
    static constexpr int CPK = DK / 8;
    static constexpr int KT_BYTES = 64 * DK * 2;
    static constexpr int VT_BYTES = DV * 128;
    static constexpr int STAGE = KT_BYTES + VT_BYTES;
    static constexpr int NKC = 64 * CPK / NTHREADS;
    static constexpr int NVC = DV * 8 / NTHREADS;
};
DEVI int kswz(int key) { return ((key >> 1) & 1) | (((key >> 3) & 3) << 1); }

struct AttnSeg { int n_ctx, ctx_krow0, ctx_vcol0, n_loc, loc_krow0, loc_vcol0, loc_kpos0; };

template <int DK, int DV, bool WINDOW, class KSrc>
DEVI void attn_unit(lds_t* lds, const bf16_t* Qp, int ldq, const KSrc& ks, const bf16_t* vt, int ldv, const AttnSeg sg, int qpos0,
                    float sink, bool has_sink, bf16_t* Op, int ldo, int tid) {
    typedef AttnCfg<DK, DV> C;
    const int lane = tid & 63, wave = tid >> 6, r16 = lane & 15, g = lane >> 4;
    const int ntile = sg.n_ctx + sg.n_loc;
    bf16x8 qf[DK / 32];
    {
        const bf16_t* qr = Qp + (size_t)(wave * 16 + r16) * ldq + 8 * g;
#pragma unroll
        for (int s = 0; s < DK / 32; ++s) qf[s] = *(const bf16x8*)(qr + 32 * s);
    }
    u32x4 kreg[C::NKC], vreg[C::NVC];
#define TILE_LOAD(jj) do { const int j_ = (jj); int krow, vcol; \
        if (j_ < sg.n_ctx) { krow = sg.ctx_krow0 + 64 * j_; vcol = sg.ctx_vcol0 + 64 * j_; } \
        else { krow = sg.loc_krow0 + 64 * (j_ - sg.n_ctx); vcol = sg.loc_vcol0 + 64 * (j_ - sg.n_ctx); } \
        _Pragma("unroll") for (int i = 0; i < C::NKC; ++i) { const int c = tid + NTHREADS * i, key = c / C::CPK, ch = c % C::CPK; kreg[i] = *(const u32x4*)ks(krow + key, ch); } \
        _Pragma("unroll") for (int i = 0; i < C::NVC; ++i) { const int c = tid + NTHREADS * i, dv = c >> 3, ch = c & 7; vreg[i] = *(const u32x4*)(vt + (size_t)dv * ldv + vcol + ch * 8); } } while (0)
#define TILE_STORE(stp) do { lds_t* st_ = (stp); \
        _Pragma("unroll") for (int i = 0; i < C::NKC; ++i) { const int c = tid + NTHREADS * i, key = c / C::CPK, ch = c % C::CPK; lds_st128(st_ + key * (DK * 2) + ((ch ^ kswz(key)) << 4), kreg[i]); } \
        _Pragma("unroll") for (int i = 0; i < C::NVC; ++i) { const int c = tid + NTHREADS * i, dv = c >> 3, ch = c & 7; lds_st128(st_ + C::KT_BYTES + img_off(dv, ch), vreg[i]); } } while (0)
    f32x4 o[DV / 16];
#pragma unroll
    for (int i = 0; i < DV / 16; ++i) o[i] = (f32x4){0.f, 0.f, 0.f, 0.f};
    float m = has_sink ? sink : -1.0e30f;
    float l = (has_sink && g == 0) ? 1.0f : 0.0f;
    const int qpos = qpos0 + wave * 16 + r16;
    const int kbyte = (8 * (r16 >> 2) + (r16 & 3)) * (DK * 2);
    const int ksw0 = ((r16 >> 1) & 1) | ((r16 >> 2) << 1);
    const int ke0 = (g ^ ksw0) << 4, ke1 = ((4 + g) ^ ksw0) << 4;
    const int vc0 = g ^ ((r16 >> 1) & 7);

    TILE_LOAD(0);
    __syncthreads();
    TILE_STORE(lds);
    if (ntile > 1) TILE_LOAD(1);
    for (int j = 0; j < ntile; ++j) {
        __syncthreads();
        lds_t* cur = lds + (j & 1) * C::STAGE;
        if (j + 1 < ntile) { TILE_STORE(lds + ((j + 1) & 1) * C::STAGE); if (j + 2 < ntile) TILE_LOAD(j + 2); }
        const bool masked = WINDOW && (j >= sg.n_ctx);
        const int kpos0 = sg.loc_kpos0 + 64 * (j - sg.n_ctx);
        if (masked) {
            const int qlo = qpos0 + wave * 16;
            if (kpos0 > qlo + 15 + 128 || kpos0 + 63 < qlo - 128) continue;
        }
        f32x4 s[4];
        {
            lds_t* kb0 = cur + kbyte + ke0;
            lds_t* kb1 = cur + kbyte + ke1;
#pragma unroll
            for (int grp = 0; grp < 2; ++grp)
#pragma unroll
                for (int b = 0; b < 2; ++b) {
                    f32x4 a = (f32x4){0.f, 0.f, 0.f, 0.f};
#pragma unroll
                    for (int st = 0; st < DK / 32; ++st) {
                        const bf16x8 kf = lds_ld128(((st & 1) ? kb1 : kb0) + (32 * grp + 4 * b) * (DK * 2) + (st >> 1) * 128);
                        a = __builtin_amdgcn_mfma_f32_16x16x32_bf16(kf, qf[st], a, 0, 0, 0);
                    }
                    s[grp * 2 + b] = a;
                }
        }
        if (masked) {
#pragma unroll
            for (int grp = 0; grp < 2; ++grp)
#pragma unroll
                for (int b = 0; b < 2; ++b)
#pragma unroll
                    for (int r = 0; r < 4; ++r) {
                        const int kp = kpos0 + 32 * grp + 8 * g + 4 * b + r;
                        const int d = qpos - kp;
                        if (d > 128 || d < -128) s[grp * 2 + b][r] = -1.0e30f;
                    }
        }
        float mx = fmaxf(fmaxf(fmaxf(s[0][0], s[0][1]), fmaxf(s[0][2], s[0][3])), fmaxf(fmaxf(s[1][0], s[1][1]), fmaxf(s[1][2], s[1][3])));
        mx = fmaxf(mx, fmaxf(fmaxf(fmaxf(s[2][0], s[2][1]), fmaxf(s[2][2], s[2][3])), fmaxf(fmaxf(s[3][0], s[3][1]), fmaxf(s[3][2], s[3][3]))));
        mx = fmaxf(mx, __shfl_xor(mx, 16)); mx = fmaxf(mx, __shfl_xor(mx, 32));
        const float mn = fmaxf(m, mx);
        const float alpha = fexp2(m - mn);
        m = mn;
        float ps = 0.f;
#pragma unroll
        for (int i = 0; i < 4; ++i)
#pragma unroll
            for (int r = 0; r < 4; ++r) { const float pv = fexp2(s[i][r] - mn); s[i][r] = pv; ps += pv; }
        l = l * alpha + ps;
#pragma unroll
        for (int i = 0; i < DV / 16; ++i) o[i] = o[i] * alpha;
#pragma unroll
        for (int grp = 0; grp < 2; ++grp) {
            u32x4 pw;
            pw.x = pk_bf16(s[grp * 2][0], s[grp * 2][1]); pw.y = pk_bf16(s[grp * 2][2], s[grp * 2][3]);
            pw.z = pk_bf16(s[grp * 2 + 1][0], s[grp * 2 + 1][1]); pw.w = pk_bf16(s[grp * 2 + 1][2], s[grp * 2 + 1][3]);
            bf16x8 pf; __builtin_memcpy(&pf, &pw, 16);
#pragma unroll
            for (int dvb = 0; dvb < DV / 16; ++dvb) {
                const bf16x8 vf = lds_ld128(cur + C::KT_BYTES + r16 * 128 + dvb * 2048 + (((vc0 ^ (4 * grp)) ^ (dvb & 1)) << 4));
                o[dvb] = __builtin_amdgcn_mfma_f32_16x16x32_bf16(vf, pf, o[dvb], 0, 0, 0);
            }
        }
    }
    l += __shfl_xor(l, 16); l += __shfl_xor(l, 32);
    const float inv = frcp(l);
    bf16_t* orow = Op + (size_t)(wave * 16 + r16) * ldo + 4 * g;
#pragma unroll
    for (int dvb = 0; dvb < DV / 16; ++dvb) st_bf16x4(orow + dvb * 16, o[dvb] * inv);
}

struct KSrcMla { const bf16_t* KN; const bf16_t* KPE; int h;
    DEVI const bf16_t* operator()(int krow, int ch) const { return ch < 16 ? KN + (size_t)krow * 1024 + h * 128 + ch * 8 : KPE + (size_t)krow * 64 + (ch - 16) * 8; } };
struct KSrcSwa { const bf16_t* SK; int kvh;
    DEVI const bf16_t* operator()(int krow, int ch) const { return SK + (size_t)krow * 256 + kvh * 64 + ch * 8; } };

DEVI void phase_mla_attn(const Params& p, lds_t* lds, int bid, int nblk, int tid) {
    for (int u = xcd_first_unit(bid, nblk); u < 512; u += nblk) {
        if (u < 256) {
            const int b = u >> 6, h = (u >> 3) & 7, qt = u & 7;
            const int qrow0 = NPR + b * 1024 + qt * 128;
            KSrcMla ks{p.KN, p.KPE, h};
            AttnSeg sg{4, NTOK + b * 256, 0, 16, NPR + b * 1024, 256, 0};
            attn_unit<192, 128, false>(lds, p.Q + (size_t)qrow0 * 1536 + h * 192, 1536, ks, p.VTS + (size_t)(b * 8 + h) * 128 * 1280, 1280, sg, 0, 0.f, false,
                                       p.O + (size_t)qrow0 * 1024 + h * 128, 1024, tid);
        } else {
            const int v = u - 256, b = v >> 4, h = (v >> 1) & 7, qt = v & 1;
            const int qrow0 = b * 256 + qt * 128;
            KSrcMla ks{p.KN, p.KPE, h};
            AttnSeg sg{0, 0, 0, 4, b * 256, 0, 0};
            attn_unit<192, 128, false>(lds, p.Q + (size_t)qrow0 * 1536 + h * 192, 1536, ks, p.VTP + (size_t)(b * 8 + h) * 128 * 256, 256, sg, 0, 0.f, false,
                                       p.O + (size_t)qrow0 * 1024 + h * 128, 1024, tid);
        }
    }
}
DEVI void phase_swa_attn(const Params& p, lds_t* lds, int bid, int nblk, int tid) {
    for (int u = xcd_first_unit(bid, nblk); u < 1024; u += nblk) {
        const int w = u >> 8, idx = ((u >> 9) << 8) | (u & 255);
        if ((w & 1) == 0) {
            const int b = idx >> 7, hq = (idx >> 3) & 15, qt = idx & 7, kvh = hq >> 2;
            const int qs = qt * 128, qrow0 = NPR + b * 1024 + qs;
            const int lo = qs >= 128 ? qs - 128 : 0, hi = qs + 256 <= 1024 ? qs + 256 : 1024;
            KSrcSwa ks{p.SK, kvh};
            AttnSeg sg{4, NTOK + b * 256, 0, (hi - lo) >> 6, NPR + b * 1024 + lo, 256 + lo, lo};
            attn_unit<64, 64, true>(lds, p.Q + (size_t)qrow0 * 1024 + hq * 64, 1024, ks, p.SVTS + (size_t)(b * 4 + kvh) * 64 * 1280, 1280, sg, qs,
                                    p.swa_sink[hq] * LOG2E, true, p.O + (size_t)qrow0 * 1024 + hq * 64, 1024, tid);
        } else {
            const int b = idx >> 5, hq = (idx >> 1) & 15, qt = idx & 1, kvh = hq >> 2;
            const int qrow0 = b * 256 + qt * 128;
            KSrcSwa ks{p.SK, kvh};
            AttnSeg sg{0, 0, 0, 4, b * 256, 0, 0};
            attn_unit<64, 64, false>(lds, p.Q + (size_t)qrow0 * 1024 + hq * 64, 1024, ks, p.SVTP + (size_t)(b * 4 + kvh) * 64 * 256, 256, sg, 0,
                                     p.swa_sink[hq] * LOG2E, true, p.O + (size_t)qrow0 * 1024 + hq * 64, 1024, tid);
        }
    }
}

DEVI void phase_gm_spatial(const Params& p, lds_t* lds, int bid, int nblk, int tid) {
    const int lane = tid & 63, wave = tid >> 6, r16 = lane & 15, g = lane >> 4, wr = wave >> 2, wc = wave & 3;
    lds_t* aimg = lds;
    lds_t* vimg = lds + 32768;
    LAS float* mean = (LAS float*)(lds + 65536);
    LAS float* rstd = mean + 128;
    LAS float* biasp = rstd + 128;
    LAS float* bpart = biasp + 128;
    for (int u = xcd_first_unit(bid, nblk); u < 512; u += nblk) {
        const int chunk = u >> 3, grp = u & 7;
        __syncthreads();
        if (tid < 128) {
            const float* gs = p.GST + (size_t)(chunk * 128 + tid) * 48;
            float s = 0.f, q = 0.f;
            for (int i = 0; i < 24; ++i) { s += gs[2 * i]; q += gs[2 * i + 1]; }
            const float mu = s * (1.0f / 3072.0f);
            const float var = q * (1.0f / 3072.0f) - mu * mu;
            mean[tid] = mu; rstd[tid] = rsqrtf(fmaxf(var, 0.f) + EPS_F);
        }
        __syncthreads();
        {
            const int n = tid >> 2, mq = tid & 3;
            const float* ws = p.gm_w_s + ((size_t)grp * 128 + n) * 128 + mq * 32;
            float bp = 0.f;
#pragma unroll
            for (int c4 = 0; c4 < 4; ++c4) {
                const f32x4 w0 = *(const f32x4*)(ws + c4 * 8), w1 = *(const f32x4*)(ws + c4 * 8 + 4);
                const int m0 = mq * 32 + c4 * 8;
                float a[8];
#pragma unroll
                for (int i = 0; i < 4; ++i) { a[i] = w0[i] * rstd[m0 + i]; a[4 + i] = w1[i] * rstd[m0 + 4 + i]; }
                u32x4 v; v.x = pk_bf16(a[0], a[1]); v.y = pk_bf16(a[2], a[3]); v.z = pk_bf16(a[4], a[5]); v.w = pk_bf16(a[6], a[7]);
#pragma unroll
                for (int i = 0; i < 4; ++i) { const unsigned wd = i == 0 ? v.x : i == 1 ? v.y : i == 2 ? v.z : v.w; bp += bf_lo(wd) * mean[m0 + 2 * i] + bf_hi(wd) * mean[m0 + 2 * i + 1]; }
                const int kc = m0 >> 3;
                lds_st128(aimg + (kc >> 3) * 16384 + img_off(n, kc & 7), v);
            }
            bpart[mq * 128 + n] = bp;
        }
        __syncthreads();
        if (tid < 128) biasp[tid] = bpart[tid] + bpart[128 + tid] + bpart[256 + tid] + bpart[384 + tid];
        for (int cs = 0; cs < 3; ++cs) {
            __syncthreads();
            {
                const bf16_t* src = p.GVT + ((size_t)chunk * 3072 + grp * 384 + cs * 128) * 128;
#pragma unroll
                for (int i = 0; i < 4; ++i) { const int c = tid + NTHREADS * i, row = c >> 4, kc = c & 15;
                    const u32x4 v = *(const u32x4*)(src + (size_t)row * 128 + kc * 8);
                    lds_st128(vimg + (kc >> 3) * 16384 + img_off(row, kc & 7), v); }
            }
            __syncthreads();
            f32x4 acc[4][2];
#pragma unroll
            for (int i = 0; i < 4; ++i) { acc[i][0] = (f32x4){0.f, 0.f, 0.f, 0.f}; acc[i][1] = acc[i][0]; }
#pragma unroll
            for (int kh = 0; kh < 2; ++kh)
#pragma unroll
                for (int s = 0; s < 2; ++s) {
                    bf16x8 af[4], vf[2];
#pragma unroll
                    for (int mb = 0; mb < 4; ++mb) af[mb] = lds_ld128(aimg + kh * 16384 + img_off(wr * 64 + mb * 16 + r16, 4 * s + g));
#pragma unroll
                    for (int nb = 0; nb < 2; ++nb) vf[nb] = lds_ld128(vimg + kh * 16384 + img_off(wc * 32 + nb * 16 + r16, 4 * s + g));
#pragma unroll
                    for (int mb = 0; mb < 4; ++mb)
#pragma unroll
                        for (int nb = 0; nb < 2; ++nb) acc[mb][nb] = __builtin_amdgcn_mfma_f32_16x16x32_bf16(vf[nb], af[mb], acc[mb][nb], 0, 0, 0);
                }
#pragma unroll
            for (int mb = 0; mb < 4; ++mb) {
                const int n = wr * 64 + mb * 16 + r16;
                const float bp = biasp[n], bs = p.gm_b_s[grp * 128 + n];
                const size_t row = (size_t)chunk * 128 + n;
#pragma unroll
                for (int nb = 0; nb < 2; ++nb) {
                    const int col = grp * 384 + cs * 128 + wc * 32 + nb * 16 + 4 * g;
                    const f32x4 gn = *(const f32x4*)(p.gm_v_gain + col);
                    const u32x2 uw = *(const u32x2*)(p.U + row * 3072 + col);
                    f32x4 t;
                    t[0] = bf_lo(uw.x) * (gn[0] * (acc[mb][nb][0] - bp) + bs);
                    t[1] = bf_hi(uw.x) * (gn[1] * (acc[mb][nb][1] - bp) + bs);
                    t[2] = bf_lo(uw.y) * (gn[2] * (acc[mb][nb][2] - bp) + bs);
                    t[3] = bf_hi(uw.y) * (gn[3] * (acc[mb][nb][3] - bp) + bs);
                    st_bf16x4(p.TT + row * 3072 + col, t);
                }
            }
        }
    }
}

constexpr int N_PHASES = 2 + 10 * DEPTH;
__global__ void __launch_bounds__(NTHREADS, 2) fwd_kernel(Params p_kernarg) {
    extern __shared__ __attribute__((aligned(16))) unsigned char smem[];
    lds_t* lds = (lds_t*)smem;
    const int tid0 = threadIdx.x, bid0 = blockIdx.x, nblk0 = gridDim.x;
    const int wave0 = __builtin_amdgcn_readfirstlane(tid0 >> 6);
    volatile LAS unsigned* misc = (volatile LAS unsigned*)(lds + LDS_MAIN);
    if (tid0 == 0) { misc[0] = 0u; misc[1] = 0u; misc[2] = 0u; misc[3] = 0u; }
    __syncthreads();
    typedef const __attribute__((address_space(4))) Params* kparams_t;
    kparams_t pp = (kparams_t)__builtin_amdgcn_kernarg_segment_ptr();
    const int lo = (int)pp->ph_lo, hi = (int)pp->ph_hi;
    XcdBarrier bar; bar.bar = pp->bar; bar.x = 0; bar.st = misc;
    if (hi - lo > 1) bar = xcd_barrier_post(bar.bar, misc);
#define IN(k) (lo <= (k) && (k) < hi)
#ifndef REP_MASK
#define REP_MASK 0
#endif
#define RUN(k, knext, cls, body) do { if (IN(k)) { { asm volatile("" : "+s"(pp)); Params p; __builtin_memcpy(&p, pp, sizeof(Params)); \
        unsigned zz = 0u; asm volatile("" : "+s"(zz)); int tid = wave0 * 64 + (int)__builtin_amdgcn_mbcnt_hi(~0u, __builtin_amdgcn_mbcnt_lo(~0u, zz)), bid = bid0, nblk = nblk0; asm volatile("" : "+v"(tid)); asm volatile("" : "+s"(bid), "+s"(nblk)); body; \
        if ((REP_MASK) & (cls)) { asm volatile("" : "+v"(tid)); body; } } if (IN(knext)) { xcd_barrier(bar); if ((REP_MASK) & 8192) xcd_barrier(bar); } } } while (0)
    RUN(0, 1, 64, { phase_modulation(p, lds, bid, nblk, tid); phase_wconv(p, lds, bid, nblk, tid); });
    RUN(1, 2, 512, phase_prep(p, bid, nblk, tid));
#pragma unroll 1
    for (int li = 0; li < DEPTH; ++li) {
        const int kind = li % 3, j = li / 3, base = 2 + 10 * li;
        if (kind == 0) {
            RUN(base + 0, base + 1, 32, phase_mla_win(p, j, lds, bid, nblk, tid));
            RUN(base + 1, base + 2, 1024, phase_mla_norm(p, j, bid, nblk, tid));
            RUN(base + 2, base + 3, 32, phase_mla_up(p, j, lds, bid, nblk, tid));
            RUN(base + 3, base + 4, 16, phase_mla_attn(p, lds, bid, nblk, tid));
            RUN(base + 4, base + 5, 8, phase_out_proj(p, li, p.O, 1024, p.WTO + (size_t)j * 1024 * 1024, lds, bid, nblk, tid));
        } else if (kind == 1) {
            RUN(base + 0, base + 1, 4, phase_gm_win(p, lds, bid, nblk, tid));
            RUN(base + 1, base + 2, 128, phase_gm_spatial(p, lds, bid, nblk, tid));
            RUN(base + 2, base + 5, 8, phase_out_proj(p, li, p.TT, 3072, p.WTGO, lds, bid, nblk, tid));
        } else {
            RUN(base + 0, base + 1, 32, phase_swa_qkv(p, lds, bid, nblk, tid));
            RUN(base + 1, base + 2, 16, phase_swa_attn(p, lds, bid, nblk, tid));
            RUN(base + 2, base + 5, 8, phase_out_proj(p, li, p.O, 1024, p.WTSO, lds, bid, nblk, tid));
        }
        RUN(base + 5, base + 6, 2048, phase_ln_a(p, li, lds, bid, nblk, tid));
        RUN(base + 6, base + 7, 256, phase_topk(p, lds, bid, nblk, tid));
        RUN(base + 7, base + 8, 1, phase_moe_up(p, li, lds, bid, nblk, tid));
        RUN(base + 8, base + 9, 2, phase_moe_down(p, li, lds, bid, nblk, tid));
        RUN(base + 9, base + 10, 4096, phase_ln_b(p, li, bid, nblk, tid));
    }
#undef IN
#undef RUN
}

#ifdef PROBE_V
__global__ void __launch_bounds__(NTHREADS, 2) probe_kernel(Params p) {
    extern __shared__ __attribute__((aligned(16))) unsigned char smem[];
    lds_t* lds = (lds_t*)smem;
    const int tid = threadIdx.x, bid = blockIdx.x, nblk = gridDim.x;
#if PROBE_V < 1000
    if (PROBE_V == 1) phase_mla_attn(p, lds, bid, nblk, tid);
    else if (PROBE_V == 2) phase_swa_attn(p, lds, bid, nblk, tid);
    else if (PROBE_V == 3) phase_gm_spatial(p, lds, bid, nblk, tid);
    else if (PROBE_V == 4) phase_ln_a(p, 3, lds, bid, nblk, tid);
    else if (PROBE_V == 5) phase_mla_up(p, 1, lds, bid, nblk, tid);
    else phase_moe_up<0>(p, 0, lds, bid, nblk, tid);
#else
    const int lane = tid & 63, wave = tid >> 6;
    const int u0 = xcd_first_unit(bid, nblk);
    f32x4 acc = (f32x4){0.f, 0.f, 0.f, 0.f};
    for (int u = u0; u < 1024; u += nblk) {
        const int e = u >> 6, w = u & 63, nt = w >> 2;
        const float* wp = p.moe_w_gate + (size_t)e * 1024 * 2048 + nt * 128 + 4 * lane + (size_t)(8 * wave) * 2048;
        const bf16_t* xp = p.H2 + (size_t)((u * 37 + wave * 8 + (lane >> 3)) & 8191) * 1024 + (lane & 7) * 8;
#pragma unroll 2
        for (int kt = 0; kt < 16; ++kt) {
            const float* q = wp + (size_t)((PROBE_V & 1) ? 0 : ((PROBE_V & 4) ? ((kt + (w & 3) * ((PROBE_V >> 4) & 7)) & 15) : ((PROBE_V & 8) ? (kt & 3) : kt))) * 64 * 2048;
#pragma unroll
            for (int i = 0; i < 8; ++i) acc += *(const f32x4*)(q + (size_t)i * 2048);
            if (PROBE_V & 2) {
#pragma unroll
                for (int j = 0; j < 4; ++j) { const u32x4 x = *(const u32x4*)(xp + (size_t)j * 64 * 1024 + kt * 64); acc[0] += __uint_as_float(x.x & 0x3f800000u); }
            }
        }
    }
    if (acc[0] + acc[1] + acc[2] + acc[3] == 12345.678f) p.GST[tid] = acc[0];
#endif
}
#endif
extern "C" void kernel_launch(void* const* d_in, const int* in_sizes, int n_in, void* d_out, int out_size, void* d_ws, size_t ws_size, hipStream_t stream) {
    static int grid = 0;
    if (grid == 0) {
        int dev = 0, cus = 0, per_cu = 0;
        if (hipGetDevice(&dev) != hipSuccess || hipDeviceGetAttribute(&cus, hipDeviceAttributeMultiprocessorCount, dev) != hipSuccess) { fprintf(stderr, "kernel_launch: device query failed\n"); grid = -1; return; }
        if (hipFuncSetAttribute((const void*)fwd_kernel, hipFuncAttributeMaxDynamicSharedMemorySize, LDS_BYTES) != hipSuccess) { fprintf(stderr, "kernel_launch: hipFuncSetAttribute failed\n"); grid = -1; return; }
        if (hipOccupancyMaxActiveBlocksPerMultiprocessor(&per_cu, (const void*)fwd_kernel, NTHREADS, LDS_BYTES) != hipSuccess || per_cu < 1) {
            fprintf(stderr, "kernel_launch: occupancy query reports %d blocks per CU\n", per_cu); (void)hipGetLastError(); per_cu = 1; }
        grid = cus;
    }
    if (grid < 0) return;
    unsigned char* ws = (unsigned char*)d_ws;
    size_t off = 0;
    auto take = [&](size_t bytes) { unsigned char* r = ws + off; off += (bytes + 255) & ~(size_t)255; return r; };
    Params p{};
    const float* const* in = (const float* const*)d_in;
    p.x_prompt = in[0]; p.x_sample = in[1]; p.cache_ckv = in[2]; p.cache_kpe = in[3]; p.cache_k = in[4]; p.cache_v = in[5]; p.c = in[6]; p.c_ctx = in[7];
    p.mod_w = in[8]; p.mod_b = in[9]; p.ln_gain = in[10]; p.ln_bias = in[11];
    p.mla_w_in = in[12]; p.mla_q_gain = in[13]; p.mla_kv_gain = in[14]; p.mla_w_q_up = in[15]; p.mla_w_kv_up = in[16]; p.mla_w_out = in[17];
    p.gm_w_in = in[18]; p.gm_v_gain = in[19]; p.gm_w_s = in[20]; p.gm_b_s = in[21]; p.gm_w_out = in[22];
    p.swa_w_qkv = in[23]; p.swa_sink = in[24]; p.swa_w_out = in[25];
    p.moe_router = in[26]; p.moe_w_gate = in[27]; p.moe_w_up = in[28]; p.moe_w_down = in[29];
    p.out = (float*)d_out;
    p.bar = (unsigned*)take(16384);
    p.mod = (float*)take((size_t)DEPTH * 5 * 6144 * 4);
    p.X0 = (float*)take((size_t)NTOK * D * 4); p.X1 = (float*)take((size_t)NTOK * D * 4); p.T = (float*)take((size_t)NTOK * D * 4);
    p.Z = (float*)take((size_t)NTOK * 704 * 4); p.GST = (float*)take((size_t)NTOK * 96 * 4); p.AFF = (float*)take((size_t)NTOK * 16 * 4); p.GATEV = (float*)take(16 * 1024 * 4);
    p.H = (bf16_t*)take((size_t)NTOK * D * 2); p.H2 = (bf16_t*)take((size_t)NTOK * D * 2);
    p.CQ = (bf16_t*)take((size_t)NTOK * 384 * 2); p.CKV = (bf16_t*)take((size_t)NROWS_KV * 256 * 2); p.KPE = (bf16_t*)take((size_t)NROWS_KV * 64 * 2);
    p.Q = (bf16_t*)take((size_t)NTOK * 1536 * 2); p.KN = (bf16_t*)take((size_t)NROWS_KV * 1024 * 2);
    p.VTP = (bf16_t*)take((size_t)16 * 8 * 128 * 256 * 2); p.VTS = (bf16_t*)take((size_t)4 * 8 * 128 * 1280 * 2);
    p.O = (bf16_t*)take((size_t)NTOK * D * 2);
    p.U = (bf16_t*)take((size_t)NTOK * 3072 * 2); p.GVT = (bf16_t*)take((size_t)NTOK * 3072 * 2); p.TT = (bf16_t*)take((size_t)NTOK * 3072 * 2);
    p.SK = (bf16_t*)take((size_t)NROWS_KV * 256 * 2); p.SVTP = (bf16_t*)take((size_t)16 * 4 * 64 * 256 * 2); p.SVTS = (bf16_t*)take((size_t)4 * 4 * 64 * 1280 * 2);
    p.HID = (bf16_t*)take((size_t)16 * 1024 * 2048 * 2); p.YE = (bf16_t*)take((size_t)16 * 1024 * 1024 * 2);
    p.SEL = (int*)take((size_t)NTOK * 16 * 4); p.IDX = (int*)take(16 * 1024 * 4);
    p.WTI = (bf16_t*)take((size_t)2 * 704 * 1024 * 2); p.WTQ = (bf16_t*)take((size_t)2 * 1536 * 384 * 2); p.WTKV = (bf16_t*)take((size_t)2 * 2048 * 256 * 2); p.WTO = (bf16_t*)take((size_t)2 * 1024 * 1024 * 2);
    p.WTGI = (bf16_t*)take((size_t)6144 * 1024 * 2); p.WTGO = (bf16_t*)take((size_t)1024 * 3072 * 2); p.WTSQ = (bf16_t*)take((size_t)1536 * 1024 * 2); p.WTSO = (bf16_t*)take((size_t)1024 * 1024 * 2);
    if (off > ws_size) { fprintf(stderr, "kernel_launch: workspace too small: need %zu, have %zu\n", off, ws_size); return; }
    (void)in_sizes; (void)n_in; (void)out_size;
    if (hipMemsetAsync(p.bar, 0, 16384, stream) != hipSuccess) { fprintf(stderr, "kernel_launch: memset failed\n"); return; }
#if N_LAUNCH_PER_PHASE
#ifndef MAX_PHASE
#define MAX_PHASE N_PHASES
#endif
    for (int k = 0; k < MAX_PHASE; ++k) {
        if (k >= 2) { const int li = (k - 2) / 10, s = (k - 2) % 10, kind = li % 3; if (kind != 0 && (s == 3 || s == 4)) continue; }
        p.ph_lo = k; p.ph_hi = k + 1;
        hipLaunchKernelGGL(fwd_kernel, dim3(grid), dim3(NTHREADS), LDS_BYTES, stream, p);
    }
#else
    p.ph_lo = 0; p.ph_hi = N_PHASES;
    hipLaunchKernelGGL(fwd_kernel, dim3(grid), dim3(NTHREADS), LDS_BYTES, stream, p);
#endif
#ifdef PROBE_V
    { static int once = 0; if (!once) { once = 1; (void)hipFuncSetAttribute((const void*)probe_kernel, hipFuncAttributeMaxDynamicSharedMemorySize, LDS_BYTES); }
      hipLaunchKernelGGL(probe_kernel, dim3(grid), dim3(NTHREADS), LDS_BYTES, stream, p); }
#endif
    const hipError_t le = hipPeekAtLastError();
    if (le != hipSuccess) fprintf(stderr, "kernel_launch: launch failed: %s\n", hipGetErrorName(le));
}
```

```cpp
#include <hip/hip_runtime.h>
#include <stdint.h>
#include <stdio.h>

#ifndef N_LAUNCH_PER_PHASE
#define N_LAUNCH_PER_PHASE 0
#endif

#define DEVI __device__ __forceinline__
#define LAS __attribute__((address_space(3)))
typedef unsigned short bf16_t;
typedef short bf16x8 __attribute__((ext_vector_type(8)));
typedef float f32x4 __attribute__((ext_vector_type(4)));
typedef float f32x2 __attribute__((ext_vector_type(2)));
typedef unsigned u32x4 __attribute__((ext_vector_type(4)));
typedef unsigned u32x2 __attribute__((ext_vector_type(2)));
typedef LAS unsigned char lds_t;

constexpr int D = 1024;
constexpr int NTOK = 8192, NPR = 4096;
constexpr int NROWS_KV = 9216;
constexpr int DEPTH = 4;
constexpr float ALPHA_F = 1.681792830507429f;
constexpr float EPS_F = 1e-6f;
constexpr float LOG2E = 1.4426950408889634f;
constexpr int NTHREADS = 512;
constexpr int LDS_MAIN = 147456;
constexpr int LDS_BYTES = LDS_MAIN + 1024;

__device__ const float rope_tab[64 * 16 * 2] = {
1.000000000e+00f,0.000000000e+00f,1.000000000e+00f,0.000000000e+00f,1.000000000e+00f,0.000000000e+00f,1.000000000e+00f,0.000000000e+00f,1.000000000e+00f,0.000000000e+00f,1.000000000e+00f,0.000000000e+00f,1.000000000e+00f,0.000000000e+00f,1.000000000e+00f,0.000000000e+00f,1.000000000e+00f,0.000000000e+00f,1.000000000e+00f,0.000000000e+00f,1.000000000e+00f,0.000000000e+00f,1.000000000e+00f,0.000000000e+00f,1.000000000e+00f,0.000000000e+00f,1.000000000e+00f,0.000000000e+00f,1.000000000e+00f,0.000000000e+00f,1.000000000e+00f,0.000000000e+00f,
5.403023059e-01f,8.414709848e-01f,8.460091064e-01f,5.331684460e-01f,9.504152809e-01f,3.109835909e-01f,9.842302348e-01f,1.768921847e-01f,9.950041651e-01f,9.983341813e-02f,9.984192778e-01f,5.620449919e-02f,9.995000417e-01f,3.161750470e-02f,9.998418903e-01f,1.778185709e-02f,9.999500004e-01f,9.999833111e-03f,9.999841887e-01f,5.623383612e-03f,9.999950000e-01f,3.162272359e-03f,9.999984189e-01f,1.778278494e-03f,9.999995000e-01f,9.999998808e-04f,9.999998419e-01f,5.623412721e-04f,9.999999500e-01f,3.162277519e-04f,9.999999842e-01f,1.778279393e-04f,
-4.161468365e-01f,9.092974268e-01f,4.314628163e-01f,9.021307212e-01f,8.065784124e-01f,5.911271138e-01f,9.374183100e-01f,3.482052729e-01f,9.800665772e-01f,1.986693337e-01f,9.936821085e-01f,1.122313110e-01f,9.980006668e-01f,6.320339453e-02f,9.993676111e-01f,3.555809121e-02f,9.998000067e-01f,1.999866625e-02f,9.999367551e-01f,1.124658940e-02f,9.999800001e-01f,6.324513096e-03f,9.999936755e-01f,3.556551364e-03f,9.999980000e-01f,1.999998762e-03f,9.999993675e-01f,1.124682366e-03f,9.999998000e-01f,6.324554721e-04f,9.999999368e-01f,3.556558729e-04f,
-9.899924966e-01f,1.411200081e-01f,-1.159661631e-01f,9.932531646e-01f,5.827536401e-01f,8.126488756e-01f,8.610406595e-01f,5.085361174e-01f,9.553364856e-01f,2.955202180e-01f,9.858034692e-01f,1.679033061e-01f,9.955033745e-01f,9.472608625e-02f,9.985773124e-01f,5.332308304e-02f,9.995500338e-01f,2.999549953e-02f,9.998577009e-01f,1.686943954e-02f,9.999550003e-01f,9.486690354e-03f,9.999857698e-01f,5.334812988e-03f,9.999955000e-01f,2.999995526e-03f,9.999985770e-01f,1.687023105e-03f,9.999995500e-01f,9.486831000e-04f,9.999998577e-01f,5.334837808e-04f,
-6.536436209e-01f,-7.568024953e-01f,-6.276796763e-01f,7.784717233e-01f,3.011374707e-01f,9.535807379e-01f,7.575061759e-01f,6.528279969e-01f,9.210609917e-01f,3.894183478e-01f,9.748082657e-01f,2.230444915e-01f,9.920106618e-01f,1.261540598e-01f,9.974712443e-01f,7.107120934e-02f,9.992001067e-01f,3.998933329e-02f,9.997470285e-01f,2.249175622e-02f,9.999200011e-01f,1.264877321e-02f,9.999747019e-01f,7.113057742e-03f,9.999920000e-01f,3.999989523e-03f,9.999974702e-01f,2.249363310e-03f,9.999992000e-01f,1.264910691e-03f,9.999997470e-01f,7.113117008e-04f,
2.836621855e-01f,-9.589242747e-01f,-9.460792425e-01f,3.239352821e-01f,-1.034233808e-02f,9.999465166e-01f,6.300802992e-01f,7.765299843e-01f,8.775825619e-01f,4.794255386e-01f,9.607312596e-01f,2.774805341e-01f,9.875260225e-01f,1.574558824e-01f,9.960497565e-01f,8.879686156e-02f,9.987502605e-01f,4.997916629e-02f,9.996047413e-01f,2.811336165e-02f,9.998750026e-01f,1.581072865e-02f,9.999604718e-01f,8.891280002e-03f,9.999875000e-01f,4.999979521e-03f,9.999960472e-01f,2.811702920e-03f,9.999987500e-01f,1.581138156e-03f,9.999996047e-01f,8.891395984e-04f,
9.601702867e-01f,-2.794154982e-01f,-9.731036980e-01f,-2.303675170e-01f,-3.207963899e-01f,9.471481807e-01f,4.827820346e-01f,8.757405478e-01f,8.253356014e-01f,5.646424931e-01f,9.436169596e-01f,3.310393232e-01f,9.820539372e-01f,1.886002770e-01f,9.943132976e-01f,1.064944419e-01f,9.982005400e-01f,5.996400514e-02f,9.994308440e-01f,3.373407806e-02f,9.998200054e-01f,1.897252691e-02f,9.999430795e-01f,1.066947415e-02f,9.999820001e-01f,5.999964052e-03f,9.999943079e-01f,3.374041408e-03f,9.999982000e-01f,1.897365346e-03f,9.999994308e-01f,1.066967410e-03f,
7.539022543e-01f,6.569865987e-01f,-7.004298139e-01f,-7.137212872e-01f,-5.994374526e-01f,8.004216016e-01f,3.202570024e-01f,9.473306986e-01f,7.648421950e-01f,6.442176781e-01f,9.235194568e-01f,3.835515778e-01f,9.755998794e-01f,2.195560870e-01f,9.922624183e-01f,1.241583392e-01f,9.975510002e-01f,6.994284763e-02f,9.992253421e-01f,3.935372584e-02f,9.997550100e-01f,2.213413545e-02f,9.999225252e-01f,1.244763455e-02f,9.999755001e-01f,6.999943050e-03f,9.999922524e-01f,3.936378830e-03f,9.999975500e-01f,2.213592463e-03f,9.999992252e-01f,1.244795304e-03f,
-1.455000338e-01f,9.893582466e-01f,-2.120364479e-01f,-9.772617586e-01f,-8.186324475e-01f,5.743177830e-01f,1.476312130e-01f,9.890424788e-01f,6.967067008e-01f,7.173560992e-01f,9.005023096e-01f,4.348512278e-01f,9.681703064e-01f,2.502923447e-01f,9.898977664e-01f,1.417829752e-01f,9.968017064e-01f,7.991469219e-02f,9.989882418e-01f,4.497213288e-02f,9.996800171e-01f,2.529552265e-02f,9.998988088e-01f,1.422575559e-02f,9.999680002e-01f,7.999915047e-03f,9.999898807e-01f,4.498715239e-03f,9.999968000e-01f,2.529819359e-03f,9.999989881e-01f,1.422623042e-03f,
-9.111302619e-01f,4.121184852e-01f,3.416602554e-01f,-9.398235313e-01f,-9.566441680e-01f,2.912592245e-01f,-2.965079623e-02f,9.995603185e-01f,6.216099403e-01f,7.833269319e-01f,8.746382611e-01f,4.847761465e-01f,9.597726443e-01f,2.807783310e-01f,9.872200896e-01f,1.593627767e-01f,9.959527334e-01f,8.987854534e-02f,9.987195508e-01f,5.058911778e-02f,9.995950273e-01f,2.845665689e-02f,9.998719305e-01f,1.600383071e-02f,9.999595003e-01f,8.999879044e-03f,9.999871928e-01f,5.061050226e-03f,9.999959500e-01f,2.846046001e-03f,9.999987193e-01f,1.600450735e-03f,
-8.390715291e-01f,-5.440211109e-01f,7.901318660e-01f,-6.129368926e-01f,-9.997860721e-01f,-2.068356987e-02f,-2.059976331e-01f,9.785524897e-01f,5.403023059e-01f,8.414709848e-01f,8.460091064e-01f,5.331684460e-01f,9.504152902e-01f,3.109835626e-01f,9.842302348e-01f,1.768921847e-01f,9.950041659e-01f,9.983341072e-02f,9.984192778e-01f,5.620449919e-02f,9.995000417e-01f,3.161750470e-02f,9.998418903e-01f,1.778185709e-02f,9.999500004e-01f,9.999834042e-03f,9.999841887e-01f,5.623383612e-03f,9.999950000e-01f,3.162272359e-03f,9.999984189e-01f,1.778278494e-03f,
4.425697988e-03f,-9.999902066e-01f,9.952573993e-01f,-9.727645772e-02f,-9.437797393e-01f,-3.305749593e-01f,-3.758474003e-01f,9.266815697e-01f,4.535961002e-01f,8.912073709e-01f,8.147053420e-01f,5.798751639e-01f,9.401075903e-01f,3.408778647e-01f,9.809291472e-01f,1.943656558e-01f,9.939560980e-01f,1.097783002e-01f,9.980874321e-01f,6.181810327e-02f,9.993950610e-01f,3.477804006e-02f,9.998086883e-01f,1.955982724e-02f,9.999395006e-01f,1.099977904e-02f,9.999808683e-01f,6.185714754e-03f,9.999939500e-01f,3.478498401e-03f,9.999980868e-01f,1.956106080e-03f,
8.438539587e-01f,-5.365729180e-01f,8.938616142e-01f,4.483429653e-01f,-7.941793525e-01f,-6.076834341e-01f,-5.338430142e-01f,8.455836068e-01f,3.623577100e-01f,9.320391032e-01f,7.808259330e-01f,6.247486393e-01f,9.288598710e-01f,3.704312892e-01f,9.773178677e-01f,2.117776794e-01f,9.928086362e-01f,1.197122046e-01f,9.977240240e-01f,6.742975621e-02f,9.992800864e-01f,3.793822392e-02f,9.997723246e-01f,2.133773367e-02f,9.999280009e-01f,1.199971211e-02f,9.999772317e-01f,6.748044406e-03f,9.999928000e-01f,3.794723862e-03f,9.999977232e-01f,2.133933605e-03f,
9.074467815e-01f,4.201670368e-01f,5.171728454e-01f,8.558809777e-01f,-5.658204930e-01f,-8.245284529e-01f,-6.750016657e-01f,7.378162043e-01f,2.674987597e-01f,9.635582046e-01f,7.444779872e-01f,6.676470075e-01f,9.166833698e-01f,3.996143135e-01f,9.733975442e-01f,2.291227201e-01f,9.915618943e-01f,1.296341379e-01f,9.973290651e-01f,7.303927684e-02f,9.991551190e-01f,4.109803212e-02f,9.997327995e-01f,2.311557262e-02f,9.999155012e-01f,1.299963410e-02f,9.999732789e-01f,7.310371924e-03f,9.999915500e-01f,4.110949176e-03f,9.999973279e-01f,2.311761062e-03f,
1.367372182e-01f,9.906073557e-01f,-1.879615160e-02f,9.998233367e-01f,-2.813494808e-01f,-9.596053718e-01f,-7.948709048e-01f,6.067785796e-01f,1.699671664e-01f,9.854497259e-01f,7.057763743e-01f,7.084346897e-01f,9.035902493e-01f,4.283977840e-01f,9.691694136e-01f,2.463953078e-01f,9.902159961e-01f,1.395431152e-01f,9.969025685e-01f,7.864648034e-02f,9.990201601e-01f,4.425742562e-02f,9.996901128e-01f,2.489334034e-02f,9.999020016e-01f,1.399954310e-02f,9.999690098e-01f,7.872696665e-03f,9.999902000e-01f,4.427174080e-03f,9.999969010e-01f,2.489588678e-03f,
-7.596879129e-01f,6.502878402e-01f,-5.489754720e-01f,8.358384600e-01f,3.102235090e-02f,-9.995186910e-01f,-8.896704271e-01f,4.566032536e-01f,7.073720167e-02f,9.974949866e-01f,6.648435293e-01f,7.469826514e-01f,8.895936264e-01f,4.567528653e-01f,9.646348168e-01f,2.635899662e-01f,9.887710793e-01f,1.494381236e-01f,9.964445467e-01f,8.425120425e-02f,9.988752109e-01f,4.741638026e-02f,9.996442648e-01f,2.667102934e-02f,9.998875021e-01f,1.499943810e-02f,9.999644246e-01f,8.435019847e-03f,9.999887500e-01f,4.743398540e-03f,9.999964424e-01f,2.667415984e-03f,
-9.576594803e-01f,-2.879033167e-01f,-9.100810896e-01f,4.144302238e-01f,3.403181682e-01f,-9.403103447e-01f,-9.564100499e-01f,2.920270818e-01f,-2.919954613e-02f,9.995736023e-01f,6.218088193e-01f,7.831690700e-01f,8.747074844e-01f,4.846512321e-01f,9.597951759e-01f,2.807013010e-01f,9.872272839e-01f,1.593182031e-01f,9.959550145e-01f,8.985326392e-02f,9.987202731e-01f,5.057485702e-02f,9.995952558e-01f,2.844863214e-02f,9.998720027e-01f,1.599931810e-02f,9.999595231e-01f,8.997339431e-03f,9.999872000e-01f,5.059622526e-03f,9.999959523e-01f,2.845243204e-03f,
-2.751633381e-01f,-9.613974919e-01f,-9.908979596e-01f,-1.346151313e-01f,6.158647923e-01f,-7.878518627e-01f,-9.929849841e-01f,1.182405237e-01f,-1.288445416e-01f,9.916648043e-01f,5.768082960e-01f,8.168795441e-01f,8.589467084e-01f,5.120649883e-01f,9.546520286e-01f,2.977238725e-01f,9.855847666e-01f,1.691823508e-01f,9.954339876e-01f,9.545248218e-02f,9.985553481e-01f,5.373282803e-02f,9.995430857e-01f,3.022614497e-02f,9.998555035e-01f,1.699918210e-02f,9.999543054e-01f,9.559656169e-03f,9.999855500e-01f,5.375846007e-03f,9.999954305e-01f,3.023070335e-03f,
6.603167082e-01f,-7.509872468e-01f,-7.665365398e-01f,-6.422006954e-01f,8.303361283e-01f,-5.572628770e-01f,-9.982416606e-01f,-5.927551864e-02f,-2.272021643e-01f,9.738476146e-01f,5.299841756e-01f,8.480075316e-01f,8.423270577e-01f,5.389667224e-01f,9.492070108e-01f,3.146522695e-01f,9.838436942e-01f,1.790295658e-01f,9.948814823e-01f,1.010486820e-01f,9.983804374e-01f,5.689026544e-02f,9.994877548e-01f,3.200356222e-02f,9.998380044e-01f,1.799902910e-02f,9.999487715e-01f,1.012197082e-02f,9.999838000e-01f,5.692068949e-03f,9.999948771e-01f,3.200897370e-03f,
9.887046182e-01f,1.498772097e-01f,-3.060954058e-01f,-9.520008417e-01f,9.624637956e-01f,-2.714100995e-01f,-9.720142724e-01f,-2.349218044e-01f,-3.232895443e-01f,9.463000954e-01f,4.814845890e-01f,8.764545570e-01f,8.248651506e-01f,5.653295351e-01f,9.434618259e-01f,3.314811956e-01f,9.820042356e-01f,1.888588926e-01f,9.942975170e-01f,1.066416789e-01f,9.981955430e-01f,6.004713022e-02f,9.994292631e-01f,3.378088199e-02f,9.998195054e-01f,1.899885811e-02f,9.999429214e-01f,1.068428133e-02f,9.999819501e-01f,6.008291323e-03f,9.999942921e-01f,3.378724537e-03f,
4.080820618e-01f,9.129452507e-01f,2.486167313e-01f,-9.686019414e-01f,9.991443799e-01f,4.135829015e-02f,-9.151299503e-01f,-4.031589936e-01f,-4.161468365e-01f,9.092974268e-01f,4.314628163e-01f,9.021307212e-01f,8.065784476e-01f,5.911270657e-01f,9.374183100e-01f,3.482052729e-01f,9.800665802e-01f,1.986693191e-01f,9.936821085e-01f,1.122313110e-01f,9.980006668e-01f,6.320339453e-02f,9.993676111e-01f,3.555809121e-02f,9.998000066e-01f,1.999866811e-02f,9.999367551e-01f,1.124658940e-02f,9.999800001e-01f,6.324513096e-03f,9.999936755e-01f,3.556551364e-03f,
-5.477292602e-01f,8.366556385e-01f,7.267602563e-01f,-6.868912067e-01f,9.367404516e-01f,3.500247509e-01f,-8.293829489e-01f,-5.586805205e-01f,-5.048462281e-01f,8.632092944e-01f,3.800769984e-01f,9.249548504e-01f,7.874851971e-01f,6.163335658e-01f,9.310783539e-01f,3.648192688e-01f,9.780309161e-01f,2.084598934e-01f,9.930352772e-01f,1.178173940e-01f,9.977958103e-01f,6.635903053e-02f,9.993027988e-01f,3.733518799e-02f,9.997795081e-01f,2.099845811e-02f,9.999302726e-01f,1.180889298e-02f,9.999779501e-01f,6.640734236e-03f,9.999930272e-01f,3.734378079e-03f,
-9.999608264e-01f,-8.851309290e-03f,9.810745815e-01f,-1.936302286e-01f,7.814403926e-01f,6.239798978e-01f,-7.174774633e-01f,-6.965817179e-01f,-5.885011558e-01f,8.084963758e-01f,3.274895886e-01f,9.448547874e-01f,7.676045628e-01f,6.409237359e-01f,9.244439837e-01f,3.813178741e-01f,9.758974496e-01f,2.182296219e-01f,9.923570442e-01f,1.233997439e-01f,9.975809759e-01f,6.951400294e-02f,9.992348263e-01f,3.911217043e-02f,9.997580097e-01f,2.199822712e-02f,9.999234739e-01f,1.237119282e-02f,9.999758001e-01f,6.956954712e-03f,9.999923473e-01f,3.912204676e-03f,
-5.328330203e-01f,-8.462204042e-01f,9.332357723e-01f,3.592645171e-01f,5.486452564e-01f,8.360552510e-01f,-5.829432350e-01f,-8.125128828e-01f,-6.662759857e-01f,7.457052439e-01f,2.738668392e-01f,9.617676197e-01f,7.469563882e-01f,6.648730361e-01f,9.175172750e-01f,3.976959268e-01f,9.736663975e-01f,2.279775131e-01f,9.916474294e-01f,1.289781990e-01f,9.973561656e-01f,7.266828020e-02f,9.991636941e-01f,4.088902546e-02f,9.997355116e-01f,2.299797413e-02f,9.999163589e-01f,1.293348969e-02f,9.999735501e-01f,7.273174492e-03f,9.999916358e-01f,4.090031381e-03f,
4.241790073e-01f,-9.055783620e-01f,5.979771709e-01f,8.015131335e-01f,2.614416878e-01f,9.652192724e-01f,-4.300232723e-01f,-9.028178029e-01f,-7.373937800e-01f,6.754631102e-01f,2.193782753e-01f,9.756398784e-01f,7.255613200e-01f,6.881575190e-01f,9.103004290e-01f,4.139482201e-01f,9.713379761e-01f,2.377026212e-01f,9.909064560e-01f,1.345525754e-01f,9.971213823e-01f,7.582182336e-02f,9.990894022e-01f,4.266575118e-02f,9.997120138e-01f,2.399769627e-02f,9.999089278e-01f,1.349578153e-02f,9.999712001e-01f,7.589393080e-03f,9.999908927e-01f,4.267857492e-03f,
9.912028119e-01f,-1.323517501e-01f,7.855226359e-02f,9.969099969e-01f,-5.168932904e-02f,9.986632131e-01f,-2.635405934e-01f,-9.646483067e-01f,-8.011436155e-01f,5.984721441e-01f,1.641961594e-01f,9.864277070e-01f,7.034407513e-01f,7.107539022e-01f,9.027957408e-01f,4.300695879e-01f,9.689124217e-01f,2.474039593e-01f,9.901341474e-01f,1.401226969e-01f,9.968766273e-01f,7.897461572e-02f,9.990119510e-01f,4.444234199e-02f,9.996875163e-01f,2.499739629e-02f,9.999011805e-01f,1.405806910e-02f,9.999687502e-01f,7.905611374e-03f,9.999901179e-01f,4.445683934e-03f,
6.469193223e-01f,7.625584505e-01f,-4.650644959e-01f,8.852768012e-01f,-3.596943393e-01f,9.330701915e-01f,-8.874550263e-02f,-9.960543337e-01f,-8.568888271e-01f,5.155012492e-01f,1.084949468e-01f,9.940970006e-01f,6.806168009e-01f,7.326395911e-01f,8.950055582e-01f,4.460549862e-01f,9.663899806e-01f,2.570805427e-01f,9.893305281e-01f,1.456883874e-01f,9.966219035e-01f,8.212661834e-02f,9.989313406e-01f,4.621879226e-02f,9.996620190e-01f,2.599707130e-02f,9.998931169e-01f,1.462035317e-02f,9.999662002e-01f,8.221828878e-03f,9.999893115e-01f,4.623509769e-03f,
-2.921388087e-01f,9.563759284e-01f,-8.654506342e-01f,5.009942114e-01f,-6.320286307e-01f,7.749450367e-01f,8.884811635e-02f,-9.960451858e-01f,-9.040721624e-01f,4.273798371e-01f,5.245061444e-02f,9.986235192e-01f,6.571122908e-01f,7.537927018e-01f,8.869323709e-01f,4.618993066e-01f,9.637709015e-01f,2.667314183e-01f,9.884956235e-01f,1.512494708e-01f,9.963572141e-01f,8.527779227e-02f,9.988475711e-01f,4.799510009e-02f,9.996355221e-01f,2.699672032e-02f,9.998847372e-01f,1.518263167e-02f,9.999635502e-01f,8.538045559e-03f,9.999884735e-01f,4.801335923e-03f,
-9.626058663e-01f,2.709057883e-01f,-9.992934094e-01f,-3.758566202e-02f,-8.416849393e-01f,5.399689462e-01f,2.636395107e-01f,-9.646212772e-01f,-9.422223247e-01f,3.349881951e-01f,-3.759419011e-03f,9.999929334e-01f,6.329506774e-01f,7.741921209e-01f,8.785787046e-01f,4.775975920e-01f,9.610554380e-01f,2.763556497e-01f,9.876294623e-01f,1.568057565e-01f,9.960825606e-01f,8.842812085e-02f,9.987606432e-01f,4.977125243e-02f,9.996080256e-01f,2.799634234e-02f,9.998760413e-01f,1.574490538e-02f,9.999608003e-01f,8.854261387e-03f,9.999876039e-01f,4.979161926e-03f,
-7.480575297e-01f,-6.636338842e-01f,-8.253716334e-01f,-5.645898217e-01f,-9.678715076e-01f,2.514453117e-01f,4.301158485e-01f,-9.027737019e-01f,-9.709581880e-01f,2.392492366e-01f,-5.995756728e-02f,9.982009267e-01f,6.081562113e-01f,7.938173736e-01f,8.699472142e-01f,4.931448515e-01f,9.582438779e-01f,2.859522171e-01f,9.867320673e-01f,1.623570984e-01f,9.957979462e-01f,9.157756515e-02f,9.986705569e-01f,5.154724737e-02f,9.995795294e-01f,2.899593637e-02f,9.998670292e-01f,1.630717503e-02f,9.999579503e-01f,9.170476329e-03f,9.999867027e-01f,5.156987306e-03f,
1.542514499e-01f,-9.880316241e-01f,-3.972518623e-01f,-9.177096261e-01f,-9.980752275e-01f,-6.201483913e-02f,5.830269376e-01f,-8.124528233e-01f,-9.899924966e-01f,1.411200081e-01f,-1.159661631e-01f,9.932531646e-01f,5.827536401e-01f,8.126488756e-01f,8.610406595e-01f,5.085361174e-01f,9.553364944e-01f,2.955201896e-01f,9.858034692e-01f,1.679033061e-01f,9.955033738e-01f,9.472609366e-02f,9.985773124e-01f,5.332308304e-02f,9.995500337e-01f,2.999550139e-02f,9.998577009e-01f,1.686943954e-02f,9.999550003e-01f,9.486690354e-03f,9.999857698e-01f,5.334812988e-03f,
9.147423578e-01f,-4.040376453e-01f,1.532154756e-01f,-9.881928041e-01f,-9.293002953e-01f,-3.693250075e-01f,7.175492218e-01f,-6.965077991e-01f,-9.991351562e-01f,4.158051951e-02f,-1.716081385e-01f,9.851652891e-01f,5.567683641e-01f,8.306677968e-01f,8.518617972e-01f,5.237666260e-01f,9.523335692e-01f,3.050586387e-01f,9.848436973e-01f,1.734442042e-01f,9.951988471e-01f,9.787366751e-02f,9.984809103e-01f,5.509874635e-02f,9.995195384e-01f,3.099503643e-02f,9.998480564e-01f,1.743169684e-02f,9.999519504e-01f,9.802903431e-03f,9.999848053e-01f,5.512638036e-03f,
8.342233605e-01f,5.514266812e-01f,6.564951791e-01f,-7.543302193e-01f,-7.683670888e-01f,-6.400093881e-01f,8.294403670e-01f,-5.585952717e-01f,-9.982947730e-01f,-5.837419103e-02f,-2.267075845e-01f,9.739628695e-01f,5.302263665e-01f,8.478561200e-01f,8.424135592e-01f,5.388315091e-01f,9.492354203e-01f,3.145665538e-01f,9.838527819e-01f,1.789796175e-01f,9.948843677e-01f,1.010202700e-01f,9.983813507e-01f,5.687423543e-02f,9.994880436e-01f,3.199454047e-02f,9.998380958e-01f,1.799395049e-02f,9.999488004e-01f,1.011911553e-02f,9.999838092e-01f,5.690463375e-03f,
-1.327674722e-02f,9.999118601e-01f,9.575860738e-01f,-2.881473778e-01f,-5.312352786e-01f,-8.472243379e-01f,9.151713830e-01f,-4.030649323e-01f,-9.874797774e-01f,-1.577456471e-01f,-2.810903074e-01f,9.596813216e-01f,5.031541870e-01f,8.641966582e-01f,8.326989334e-01f,5.537260030e-01f,9.460423489e-01f,3.240430126e-01f,9.828307545e-01f,1.845093711e-01f,9.945599394e-01f,1.041658623e-01f,9.982786339e-01f,5.864954466e-02f,9.994555494e-01f,3.299401065e-02f,9.998278189e-01f,1.855619846e-02f,9.999455505e-01f,1.043532661e-02f,9.999827814e-01f,5.868288535e-03f,
-8.485702748e-01f,5.290826861e-01f,9.637575328e-01f,2.667797179e-01f,-2.414211151e-01f,-9.704204476e-01f,9.720383571e-01f,-2.348221291e-01f,-9.667981682e-01f,-2.555411942e-01f,-3.345843792e-01f,9.423657958e-01f,4.755788956e-01f,8.796730723e-01f,8.227209915e-01f,5.684453977e-01f,9.427546643e-01f,3.334870955e-01f,9.817776473e-01f,1.900332899e-01f,9.942255664e-01f,1.073104056e-01f,9.981727603e-01f,6.042466843e-02f,9.994220556e-01f,3.399345156e-02f,9.998172259e-01f,1.911843869e-02f,9.999422006e-01f,1.075153665e-02f,9.999817221e-01f,6.046113043e-03f,
-9.036922051e-01f,-4.281826695e-01f,6.731102676e-01f,7.395421338e-01f,7.233466718e-02f,-9.973804169e-01f,9.982477619e-01f,-5.917267879e-02f,-9.364566873e-01f,-3.507832277e-01f,-3.870206816e-01f,9.220710342e-01f,4.475280652e-01f,8.942698871e-01f,8.124829236e-01f,5.829849902e-01f,9.393727149e-01f,3.428978019e-01f,9.806934936e-01f,1.955511994e-01f,9.938812503e-01f,1.104538832e-01f,9.980637300e-01f,6.219960483e-02f,9.993875625e-01f,3.499285475e-02f,9.998063168e-01f,1.968067474e-02f,9.999387506e-01f,1.106774562e-02f,9.999806311e-01f,6.223937825e-03f,
-1.279636896e-01f,-9.917788534e-01f,1.751565337e-01f,9.845405978e-01f,3.789161719e-01f,-9.254309994e-01f,9.929728258e-01f,1.183425843e-01f,-8.967583530e-01f,-4.425205716e-01f,-4.382335472e-01f,8.988611451e-01f,4.190297442e-01f,9.079725070e-01f,8.019878986e-01f,5.973402803e-01f,9.358968291e-01f,3.522742188e-01f,9.795783277e-01f,2.010629250e-01f,9.935269954e-01f,1.135962562e-01f,9.979515440e-01f,6.397433710e-02f,9.993520699e-01f,3.599222668e-02f,9.997950914e-01f,2.024290457e-02f,9.999352007e-01f,1.138395348e-02f,9.999795085e-01f,6.401761945e-03f,
7.654140519e-01f,-6.435381334e-01f,-3.767422893e-01f,9.263181135e-01f,6.479216888e-01f,-7.617069550e-01f,9.563800296e-01f,2.921253822e-01f,-8.481000064e-01f,-5.298361813e-01f,-4.880608524e-01f,8.728096037e-01f,3.901124287e-01f,9.207672306e-01f,7.912392691e-01f,6.115066795e-01f,9.323273439e-01f,3.616154364e-01f,9.784321880e-01f,2.065682779e-01f,9.931628052e-01f,1.167374932e-01f,9.978362017e-01f,6.574887451e-02f,9.993155781e-01f,3.699155889e-02f,9.997835499e-01f,2.080512613e-02f,9.999315508e-01f,1.170016020e-02f,9.999783543e-01f,6.579586328e-03f,
9.550736440e-01f,2.963685787e-01f,-8.126112051e-01f,5.828061679e-01f,8.526731157e-01f,-5.224447891e-01f,8.896234916e-01f,4.566946935e-01f,-7.909677411e-01f,-6.118578532e-01f,-5.363451811e-01f,8.439987244e-01f,3.608050334e-01f,9.326412643e-01f,7.802404339e-01f,6.254797082e-01f,9.286646373e-01f,3.709204650e-01f,9.772551046e-01f,2.120671131e-01f,9.927886843e-01f,1.198775555e-01f,9.977177040e-01f,6.752320399e-02f,9.992780868e-01f,3.799085783e-02f,9.997716923e-01f,2.136734297e-02f,9.999278009e-01f,1.201636575e-02f,9.999771684e-01f,6.757410504e-03f,
2.666429324e-01f,9.637953863e-01f,-9.982103598e-01f,5.980031485e-02f,9.728653499e-01f,-2.313720187e-01f,7.948083899e-01f,6.068604645e-01f,-7.259322386e-01f,-6.877662284e-01f,-5.829338849e-01f,8.125195911e-01f,3.311368634e-01f,9.435827349e-01f,7.689949093e-01f,6.392549018e-01f,9.249090653e-01f,3.801884019e-01f,9.760471178e-01f,2.175592422e-01f,9.924046346e-01f,1.230164264e-01f,9.975960518e-01f,6.929731252e-02f,9.992395964e-01f,3.899011506e-02f,9.997595184e-01f,2.192955306e-02f,9.999239510e-01f,1.233257010e-02f,9.999759510e-01f,6.935234000e-03f,
-6.669380617e-01f,7.451131605e-01f,-8.763794418e-01f,-4.816212973e-01f,9.965789837e-01f,8.264580634e-02f,6.749256518e-01f,7.378857395e-01f,-6.536436209e-01f,-7.568024953e-01f,-6.276796763e-01f,7.784717233e-01f,3.011375844e-01f,9.535807020e-01f,7.575061759e-01f,6.528279969e-01f,9.210610033e-01f,3.894183203e-01f,9.748082657e-01f,2.230444915e-01f,9.920106618e-01f,1.261540598e-01f,9.974712443e-01f,7.107120934e-02f,9.992001065e-01f,3.998933702e-02f,9.997470285e-01f,2.249175622e-02f,9.999200011e-01f,1.264877321e-02f,9.999747019e-01f,7.113057742e-03f,
-9.873392775e-01f,-1.586226688e-01f,-4.846393970e-01f,-8.747140418e-01f,9.214623472e-01f,3.884676855e-01f,5.337561004e-01f,8.456384720e-01f,-5.748240246e-01f,-8.182770562e-01f,-6.704410942e-01f,7.419627614e-01f,2.708370782e-01f,9.626252007e-01f,7.457779040e-01f,6.661946547e-01f,9.171208242e-01f,3.986093247e-01f,9.735385875e-01f,2.285226875e-01f,9.916067680e-01f,1.292904390e-01f,9.973432826e-01f,7.284488142e-02f,9.991596177e-01f,4.098851526e-02f,9.997342224e-01f,2.305395040e-02f,9.999159512e-01f,1.296497506e-02f,9.999734212e-01f,7.290880793e-03f,
-3.999853150e-01f,-9.165215479e-01f,5.636094028e-02f,-9.984104589e-01f,7.549653475e-01f,6.557646866e-01f,3.757521519e-01f,9.267201953e-01f,-4.902605720e-01f,-8.715759127e-01f,-7.110829506e-01f,7.031081264e-01f,2.402658714e-01f,9.707071191e-01f,7.338138022e-01f,6.793506485e-01f,9.130889457e-01f,4.077604411e-01f,9.722381233e-01f,2.339936570e-01f,9.911929581e-01f,1.324255253e-01f,9.972121675e-01f,7.461831571e-02f,9.991181295e-01f,4.198765625e-02f,9.997211001e-01f,2.361613915e-02f,9.999118013e-01f,1.328117562e-02f,9.999721088e-01f,7.468704080e-03f,
5.551133015e-01f,-8.317747426e-01f,5.800031129e-01f,-8.146142578e-01f,5.135984179e-01f,8.580306901e-01f,2.058971709e-01f,9.785736329e-01f,-4.007989973e-01f,-9.161660132e-01f,-7.494767587e-01f,6.620306550e-01f,2.094544189e-01f,9.778184118e-01f,7.216176540e-01f,6.922918182e-01f,9.089657591e-01f,4.168707818e-01f,9.709069144e-01f,2.394572270e-01f,9.907692363e-01f,1.355592873e-01f,9.970778984e-01f,7.639152146e-02f,9.990756424e-01f,4.298675152e-02f,9.997076617e-01f,2.417832043e-02f,9.999075514e-01f,1.359737484e-02f,9.999707649e-01f,7.646527131e-03f,
9.998433086e-01f,1.770192511e-02f,9.250146691e-01f,-3.799313911e-01f,2.212981743e-01f,9.752061926e-01f,2.954782069e-02f,9.995633678e-01f,-3.073327792e-01f,-9.516021032e-01f,-7.855011387e-01f,6.188602113e-01f,1.784335295e-01f,9.839519681e-01f,7.091933579e-01f,7.050140291e-01f,9.047516642e-01f,4.259394629e-01f,9.695450064e-01f,2.449132102e-01f,9.903356068e-01f,1.386916938e-01f,9.969404762e-01f,7.816448565e-02f,9.990321560e-01f,4.398580752e-02f,9.996939072e-01f,2.474049220e-02f,9.999032016e-01f,1.391357271e-02f,9.999693893e-01f,7.824349474e-03f,
5.253219888e-01f,8.509035245e-01f,9.851382016e-01f,1.717635693e-01f,-9.294810554e-02f,9.956709545e-01f,-1.477329862e-01f,9.890272821e-01f,-2.107957994e-01f,-9.775301177e-01f,-8.190422014e-01f,5.737332763e-01f,1.472342216e-01f,9.891016550e-01f,6.965447594e-01f,7.175133435e-01f,9.004471075e-01f,4.349655234e-01f,9.681524315e-01f,2.503614776e-01f,9.898920739e-01f,1.418227133e-01f,9.967999021e-01f,7.993719522e-02f,9.989876708e-01f,4.498481582e-02f,9.996798365e-01f,2.530265802e-02f,9.998987517e-01f,1.422976918e-02f,9.999679821e-01f,8.002171569e-03f,
-4.321779449e-01f,9.017883476e-01f,7.418580135e-01f,6.705569982e-01f,-3.979767653e-01f,9.173954950e-01f,-3.203543695e-01f,9.472977768e-01f,-1.121526217e-01f,-9.936909929e-01f,-8.499939088e-01f,5.267925161e-01f,1.158876918e-01f,9.932623233e-01f,6.836758997e-01f,7.297857660e-01f,8.960525071e-01f,4.439480877e-01f,9.667292484e-01f,2.558017989e-01f,9.894386421e-01f,1.449523146e-01f,9.966561752e-01f,8.170965944e-02f,9.989421864e-01f,4.598378286e-02f,9.996654497e-01f,2.586481583e-02f,9.998942019e-01f,1.454596424e-02f,9.999665433e-01f,8.179994343e-03f,
-9.923354692e-01f,1.235731227e-01f,2.700984580e-01f,9.628327077e-01f,-6.635382560e-01f,7.481423547e-01f,-4.828719382e-01f,8.756909793e-01f,-1.238837738e-02f,-9.999232611e-01f,-8.782584087e-01f,4.781863313e-01f,8.442528403e-02f,9.964298126e-01f,6.705908480e-01f,7.418274156e-01f,8.915682887e-01f,4.528862843e-01f,9.652754871e-01f,2.612340599e-01f,9.889753181e-01f,1.480804517e-01f,9.965092972e-01f,8.348185785e-02f,9.988957032e-01f,4.698270019e-02f,9.996507468e-01f,2.642696360e-02f,9.998895520e-01f,1.486215783e-02f,9.999650728e-01f,8.357815927e-03f,
-6.401443395e-01f,-7.682546613e-01f,-2.848466063e-01f,9.585731119e-01f,-8.632964878e-01f,5.046971113e-01f,-6.301599705e-01f,7.764653318e-01f,8.749917344e-02f,-9.961645921e-01f,-9.037463447e-01f,4.280683876e-01f,5.287845807e-02f,9.986009557e-01f,6.572937422e-01f,7.536344847e-01f,8.869949277e-01f,4.617791660e-01f,9.637912089e-01f,2.666580313e-01f,9.885021022e-01f,1.512071226e-01f,9.963592674e-01f,8.525379969e-02f,9.988482211e-01f,4.798157054e-02f,9.996357278e-01f,2.698910488e-02f,9.998848022e-01f,1.517834901e-02f,9.999635708e-01f,8.535637247e-03f,
3.005925437e-01f,-9.537526528e-01f,-7.520639951e-01f,6.590900905e-01f,-9.774427254e-01f,2.112006594e-01f,-7.575730765e-01f,6.527503610e-01f,1.865124631e-01f,-9.824525948e-01f,-9.263771379e-01f,3.765971301e-01f,2.127875808e-02f,9.997735816e-01f,6.437888326e-01f,7.652032012e-01f,8.823328681e-01f,4.706258703e-01f,9.622764532e-01f,2.720735702e-01f,9.880190013e-01f,1.543322815e-01f,9.962060867e-01f,8.702547193e-02f,9.987997401e-01f,4.898039663e-02f,9.996203926e-01f,2.755123762e-02f,9.998799524e-01f,1.549453961e-02f,9.999620371e-01f,8.713459228e-03f,
9.649660285e-01f,-2.623748537e-01f,-9.876590838e-01f,1.566190737e-01f,-9.946564265e-01f,-1.032404628e-01f,-8.610927113e-01f,5.084479743e-01f,2.836621855e-01f,-9.589242747e-01f,-9.460792425e-01f,3.239352821e-01f,-1.034221888e-02f,9.999465178e-01f,6.300802992e-01f,7.765299843e-01f,8.775825619e-01f,4.794255386e-01f,9.607312596e-01f,2.774805341e-01f,9.875260201e-01f,1.574558971e-01f,9.960497565e-01f,8.879686156e-02f,9.987502604e-01f,4.997917001e-02f,9.996047414e-01f,2.811335979e-02f,9.998750026e-01f,1.581072865e-02f,9.999604718e-01f,8.891280002e-03f,
7.421541968e-01f,6.702291758e-01f,-9.190735378e-01f,-3.940860720e-01f,-9.132301279e-01f,-4.074441477e-01f,-9.374542500e-01f,3.481085020e-01f,3.779776544e-01f,-9.258147184e-01f,-9.627903713e-01f,2.702493312e-01f,-4.195285448e-02f,9.991195914e-01f,6.161725219e-01f,7.876112133e-01f,8.727445123e-01f,4.881772386e-01f,9.591556934e-01f,2.828786946e-01f,9.870231637e-01f,1.605779382e-01f,9.958902758e-01f,9.056797780e-02f,9.986997817e-01f,5.097789714e-02f,9.995887740e-01f,2.867547492e-02f,9.998699528e-01f,1.612691704e-02f,9.999588749e-01f,9.069100495e-03f,
-1.629907808e-01f,9.866275920e-01f,-5.674300293e-01f,-8.234216185e-01f,-7.412399645e-01f,-6.712401321e-01f,-9.842484715e-01f,1.767906850e-01f,4.685169241e-01f,-8.834545217e-01f,-9.764576931e-01f,2.157090023e-01f,-7.352154075e-02f,9.972936293e-01f,6.020698986e-01f,7.984433839e-01f,8.678191892e-01f,4.968801213e-01f,9.575497876e-01f,2.882679384e-01f,9.865104371e-01f,1.636983734e-01f,9.957276465e-01f,9.233880022e-02f,9.986483046e-01f,5.197656957e-02f,9.995724905e-01f,2.923758099e-02f,9.998648031e-01f,1.644310196e-02f,9.999572463e-01f,9.246920701e-03f,
-9.182827862e-01f,3.959251502e-01f,-4.102818995e-02f,-9.991579893e-01f,-4.957418213e-01f,-8.684699457e-01f,-9.999999947e-01f,-1.030206758e-04f,5.543744949e-01f,-8.322673365e-01f,-9.870379993e-01f,1.604867217e-01f,-1.050167117e-01f,9.944704572e-01f,5.877769370e-01f,8.090230357e-01f,8.628070850e-01f,5.055333165e-01f,9.559136100e-01f,2.936480378e-01f,9.859878454e-01f,1.668171717e-01f,9.955618677e-01f,9.410933806e-02f,9.985958286e-01f,5.297519375e-02f,9.995558910e-01f,2.979967596e-02f,9.998595533e-01f,1.675928710e-02f,9.999555861e-01f,9.424741546e-03f,
-8.293098329e-01f,-5.587890489e-01f,4.980096003e-01f,-8.671715159e-01f,-2.010796199e-01f,-9.795749009e-01f,-9.842120244e-01f,-1.769934771e-01f,6.346929496e-01f,-7.727644270e-01f,-9.944978661e-01f,1.047568344e-01f,-1.364068747e-01f,9.906528981e-01f,5.732980611e-01f,8.193468943e-01f,8.577087010e-01f,5.141359589e-01f,9.542471952e-01f,2.990188798e-01f,9.854553963e-01f,1.699342871e-01f,9.953929407e-01f,9.587957830e-02f,9.985423542e-01f,5.397376122e-02f,9.995389754e-01f,3.036176336e-02f,9.998542036e-01f,1.707546870e-02f,9.999538943e-01f,9.602561162e-03f,
2.212675626e-02f,-9.997551734e-01f,8.836693140e-01f,-4.681116785e-01f,1.135217773e-01f,-9.935355082e-01f,-9.373825054e-01f,-3.483016489e-01f,7.086697743e-01f,-7.055403256e-01f,-9.988136461e-01f,4.869599955e-02f,-1.676606422e-01f,9.858447692e-01f,5.586378969e-01f,8.294116591e-01f,8.525245158e-01f,5.226872391e-01f,9.525506134e-01f,3.043802375e-01f,9.849130902e-01f,1.730497178e-01f,9.952208667e-01f,9.764950793e-02f,9.984878810e-01f,5.497227845e-02f,9.995217437e-01f,3.092384116e-02f,9.998487538e-01f,1.739165045e-02f,9.999521709e-01f,9.780380474e-03f,
8.532201077e-01f,-5.215510021e-01f,9.971746360e-01f,7.511820869e-02f,4.168670742e-01f,-9.089674595e-01f,-8.609884168e-01f,-5.086245631e-01f,7.755658183e-01f,-6.312667118e-01f,-9.999717335e-01f,-7.518784889e-03f,-1.987468801e-01f,9.800508546e-01f,5.438010803e-01f,8.392141473e-01f,8.472551097e-01f,5.311861999e-01f,9.508239095e-01f,3.097319700e-01f,9.843609349e-01f,1.761634181e-01f,9.950456449e-01f,9.941913618e-02f,9.984324096e-01f,5.597073698e-02f,9.995041959e-01f,3.148590732e-02f,9.998432041e-01f,1.770782860e-02f,9.999504159e-01f,9.958200408e-03f,
8.998668270e-01f,4.361647552e-01f,8.035690866e-01f,5.952114944e-01f,6.788702112e-01f,-7.342582900e-01f,-7.574391895e-01f,-6.529057162e-01f,8.347129424e-01f,-5.506853038e-01f,-9.979684672e-01f,-6.370979912e-02f,-2.296342702e-01f,9.732769914e-01f,5.287923029e-01f,8.487512594e-01f,8.419009790e-01f,5.396320427e-01f,9.490671287e-01f,3.150739362e-01f,9.837989360e-01f,1.792753567e-01f,9.948672764e-01f,1.011884500e-01f,9.983759396e-01f,5.696914326e-02f,9.994863320e-01f,3.204796724e-02f,9.998375544e-01f,1.802400685e-02f,9.999486292e-01f,1.013601910e-02f,
1.191801354e-01f,9.928726481e-01f,3.624766664e-01f,9.319928467e-01f,8.735505105e-01f,-4.867335058e-01f,-6.300007138e-01f,-7.765945536e-01f,8.855196056e-01f,-4.646020105e-01f,-9.928101803e-01f,-1.196993984e-01f,-2.602920453e-01f,9.655299328e-01f,5.136163109e-01f,8.580199795e-01f,8.364626591e-01f,5.480239228e-01f,9.472803452e-01f,3.204059106e-01f,9.832270991e-01f,1.823855026e-01f,9.946857626e-01f,1.029574365e-01f,9.983184713e-01f,5.796748886e-02f,9.994681521e-01f,3.261001331e-02f,9.998318047e-01f,1.834018143e-02f,9.999468110e-01f,1.031383746e-02f,
-7.710802230e-01f,6.367380071e-01f,-1.902490958e-01f,9.817358512e-01f,9.816020978e-01f,-1.909380047e-01f,-4.826923346e-01f,-8.757899920e-01f,9.274784664e-01f,-3.738765764e-01f,-9.845131804e-01f,-1.753105749e-01f,-2.906895502e-01f,9.568174253e-01f,4.982779032e-01f,8.670173765e-01f,8.309406937e-01f,5.563610011e-01f,9.454635966e-01f,3.257277812e-01f,9.826454300e-01f,1.854938246e-01f,9.945011026e-01f,1.047261048e-01f,9.982600046e-01f,5.896578020e-02f,9.994496561e-01f,3.317204907e-02f,9.998259550e-01f,1.865635603e-02f,9.999449611e-01f,1.049165644e-02f,
-9.524129804e-01f,-3.048106211e-01f,-6.843819158e-01f,7.291237161e-01f,9.923083195e-01f,1.237909494e-01f,-3.201591802e-01f,-9.473637630e-01f,9.601702867e-01f,-2.794154982e-01f,-9.731036980e-01f,-2.303675170e-01f,-3.207963899e-01f,9.471481807e-01f,4.827820346e-01f,8.757405478e-01f,8.253356351e-01f,5.646424439e-01f,9.436169596e-01f,3.310393232e-01f,9.820539344e-01f,1.886002917e-01f,9.943132976e-01f,1.064944419e-01f,9.982005398e-01f,5.996400886e-02f,9.994308440e-01f,3.373407806e-02f,9.998200054e-01f,1.897252691e-02f,9.999430795e-01f,1.066947415e-02f,
-2.581016359e-01f,-9.661177700e-01f,-9.677396624e-01f,2.519522691e-01f,9.046075662e-01f,4.262454119e-01f,-1.475292025e-01f,-9.890577002e-01f,9.832684211e-01f,-1.821625980e-01f,-9.586178037e-01f,-2.846961652e-01f,-3.505824602e-01f,9.365318674e-01f,4.671333972e-01f,8.841868520e-01f,8.196480097e-01f,5.728674718e-01f,9.417404730e-01f,3.363404250e-01f,9.814526211e-01f,1.917048581e-01f,9.941223492e-01f,1.082624348e-01f,9.981400766e-01f,6.096218127e-02f,9.994117160e-01f,3.429609266e-02f,9.998139558e-01f,1.928869776e-02f,9.999411664e-01f,1.084729152e-02f,
6.735071623e-01f,-7.391806966e-01f,-9.530500361e-01f,-3.028128610e-01f,7.271980777e-01f,6.864276770e-01f,2.975377145e-02f,-9.995572585e-01f,9.965421208e-01f,-8.308911770e-02f,-9.411012936e-01f,-3.381247627e-01f,-3.800179774e-01f,9.249791008e-01f,4.513370430e-01f,8.923535586e-01f,8.138784539e-01f,5.810351644e-01f,9.398342161e-01f,3.416308626e-01f,9.808414904e-01f,1.948075221e-01f,9.939282563e-01f,1.100300928e-01f,9.980786154e-01f,6.196028901e-02f,9.993922719e-01f,3.485809641e-02f,9.998078062e-01f,1.960486481e-02f,9.999392216e-01f,1.102510855e-02f,
9.858965816e-01f,1.673557003e-01f,-6.448370157e-01f,-7.643201052e-01f,4.776714527e-01f,8.785385497e-01f,2.060983265e-01f,-9.785312871e-01f,9.998586332e-01f,1.681409119e-02f,-9.206095453e-01f,-3.904843980e-01f,-4.090735085e-01f,9.125014327e-01f,4.353979670e-01f,9.002380853e-01f,8.080275111e-01f,5.891447541e-01f,9.378982288e-01f,3.469105251e-01f,9.802205514e-01f,1.979082381e-01f,9.937310211e-01f,1.117973955e-01f,9.980161562e-01f,6.295833478e-02f,9.993725116e-01f,3.542009286e-02f,9.998015566e-01f,1.992103176e-02f,9.999372453e-01f,1.120292616e-02f
};

#define XB_TMO      128
#define XB_XCNT(j)  (256  + 64 * (j))
#define XB_XSUB(j)  (1280 + 64 * (j))
#define XB_XGEN(j)  (2304 + 64 * (j))
#define XB_TOP      3328
#define XB_TOPGEN   3392
#define XCD_BAR_WORDS 3456
#define XB_SPIN_CAP (1u << 18)

__device__ __forceinline__ unsigned xb_ld(unsigned* p)              { return __hip_atomic_load(p, __ATOMIC_RELAXED, __HIP_MEMORY_SCOPE_AGENT); }
__device__ __forceinline__ unsigned xb_add(unsigned* p, unsigned v) { return __hip_atomic_fetch_add(p, v, __ATOMIC_RELAXED, __HIP_MEMORY_SCOPE_AGENT); }
__device__ __forceinline__ unsigned xb_xcc_id() { return (unsigned)__builtin_amdgcn_s_getreg((3 << 11) | 20) & 0xFu; }
#define XB_SPIN(cond, bar) do { unsigned _sp = 0; while (cond) { __builtin_amdgcn_s_sleep(1); \
    if ((++_sp & 255u) == 0u) { if (xb_ld(&(bar)[XB_TMO])) break; if (_sp > XB_SPIN_CAP) { atomicAdd(&(bar)[XB_TMO], 1u); break; } } } } while (0)

struct XcdBarrier {
    unsigned* bar; unsigned x;
    volatile LAS unsigned* st;
};

__device__ __forceinline__ XcdBarrier xcd_barrier_post(unsigned* bar, volatile LAS unsigned* st) {
    XcdBarrier b; b.bar = bar; b.x = xb_xcc_id(); b.st = st;
    if (threadIdx.x == 0) (void)xb_add(&bar[XB_XCNT(b.x)], 1u);
    return b;
}
__device__ __forceinline__ void xcd_barrier_complete(unsigned* bar, unsigned x, unsigned& nloc, unsigned& nx) {
    const unsigned G = gridDim.x * gridDim.y * gridDim.z;
    unsigned sum, cnt, mine, sp = 0u;
    for (;;) {
        sum = 0u; cnt = 0u; mine = 0u;
#pragma unroll
        for (unsigned j = 0; j < 16; ++j) { const unsigned c = xb_ld(&bar[XB_XCNT(j)]); sum += c; cnt += (c > 0u) ? 1u : 0u; mine = (j == x) ? c : mine; }
        if (sum == G) break;
        __builtin_amdgcn_s_sleep(1);
        if ((++sp & 255u) == 0u) { if (xb_ld(&bar[XB_TMO])) break; if (sp > XB_SPIN_CAP) { atomicAdd(&bar[XB_TMO], 1u); break; } }
    }
    nloc = mine > 0u ? mine : 1u; nx = cnt > 0u ? cnt : 1u;
}

__device__ __forceinline__ void xcd_barrier(const XcdBarrier& b) {
    asm volatile("s_waitcnt vmcnt(0)" ::: "memory");
    __syncthreads();
    if (threadIdx.x == 0) {
        unsigned* bar = b.bar;
        __builtin_amdgcn_s_waitcnt(0);
        unsigned nloc = b.st[0], nx = b.st[1];
        if (nloc == 0u) { xcd_barrier_complete(bar, b.x, nloc, nx); b.st[0] = nloc; b.st[1] = nx; }
        const unsigned old = xb_add(&bar[XB_XSUB(b.x)], 1u);
        const unsigned gen = old / nloc;
        if (old + 1u == (gen + 1u) * nloc) {
            __builtin_amdgcn_fence(__ATOMIC_RELEASE, "agent");
            asm volatile("s_waitcnt vmcnt(0)" ::: "memory");
            const unsigned og = xb_add(&bar[XB_TOP], 1u);
            const unsigned tg = og / nx;
            if (og + 1u == (tg + 1u) * nx) xb_add(&bar[XB_TOPGEN], 1u);
            else XB_SPIN(xb_ld(&bar[XB_TOPGEN]) == tg, bar);
            __builtin_amdgcn_fence(__ATOMIC_ACQUIRE, "agent");
            xb_add(&bar[XB_XGEN(b.x)], 1u);
            asm volatile("s_waitcnt vmcnt(0)" ::: "memory");
        } else {
            XB_SPIN(xb_ld(&bar[XB_XGEN(b.x)]) == gen, bar);
            __builtin_amdgcn_fence(__ATOMIC_ACQUIRE, "agent");
            asm volatile("s_waitcnt vmcnt(0)" ::: "memory");
        }
    }
    __syncthreads();
}

typedef __bf16 bf16x2_t __attribute__((ext_vector_type(2)));
DEVI unsigned pk_bf16(float lo, float hi) {
    f32x2 f = {lo, hi}; bf16x2_t v = __builtin_convertvector(f, bf16x2_t); unsigned r; __builtin_memcpy(&r, &v, 4); return r; }
DEVI float bf_lo(unsigned w) { return __uint_as_float(w << 16); }
DEVI float bf_hi(unsigned w) { return __uint_as_float(w & 0xffff0000u); }
DEVI bf16x8 lds_ld128(lds_t* p) { return *(LAS bf16x8*)p; }
DEVI void lds_st128(lds_t* p, u32x4 v) { *(LAS u32x4*)p = v; }
DEVI int lane_id_fresh() { unsigned z = 0u; asm volatile("" : "+s"(z)); return (int)__builtin_amdgcn_mbcnt_hi(~0u, __builtin_amdgcn_mbcnt_lo(~0u, z)); }
DEVI float wave_sum(float v) {
#pragma unroll
    for (int o = 32; o >= 1; o >>= 1) v += __shfl_xor(v, o);
    return v;
}
DEVI float fexp2(float x) { return __builtin_amdgcn_exp2f(x); }
DEVI float frcp(float x) { return __builtin_amdgcn_rcpf(x); }
DEVI float silu_f(float x) { return x * frcp(1.0f + fexp2(-LOG2E * x)); }
DEVI float gelu_tanh_f(float x) {
    const float y = 0.7978845608028654f * (x + 0.044715f * x * x * x);
    const float e = fexp2((2.0f * LOG2E) * y);
    const float t = 1.0f - 2.0f * frcp(e + 1.0f);
    return 0.5f * x * (1.0f + t);
}
DEVI int cond_of_row(int row) { return row < NPR ? 0 : 1 + ((row - NPR) >> 10); }

struct Params {
    const float *x_prompt, *x_sample, *cache_ckv, *cache_kpe, *cache_k, *cache_v, *c, *c_ctx, *mod_w, *mod_b, *ln_gain, *ln_bias,
        *mla_w_in, *mla_q_gain, *mla_kv_gain, *mla_w_q_up, *mla_w_kv_up, *mla_w_out,
        *gm_w_in, *gm_v_gain, *gm_w_s, *gm_b_s, *gm_w_out, *swa_w_qkv, *swa_sink, *swa_w_out,
        *moe_router, *moe_w_gate, *moe_w_up, *moe_w_down;
    float* out;
    unsigned* bar;
    float *mod, *X0, *X1, *T, *Z, *GST, *AFF, *GATEV;
    bf16_t *H, *H2, *CQ, *CKV, *KPE, *Q, *KN, *VTP, *VTS, *O, *U, *GVT, *TT, *SK, *SVTP, *SVTS, *HID, *YE;
    bf16_t *WTI, *WTQ, *WTKV, *WTO, *WTGI, *WTGO, *WTSQ, *WTSO;
    int *SEL, *IDX;
    long long ph_lo, ph_hi;
};
constexpr size_t OUT_Y = 0;
constexpr size_t OUT_CKV = 8388608;
constexpr size_t OUT_KPE = OUT_CKV + 2097152;
constexpr size_t OUT_SK = OUT_KPE + 524288;
constexpr size_t OUT_SV = OUT_SK + 1048576;

DEVI const float* modp(const Params& p, int layer, int cnd, int which) { return p.mod + ((size_t)(layer * 5 + cnd) * 6 + which) * 1024; }

DEVI int swz(int row) { return ((row >> 1) & 7) ^ ((row >> 4) & 1); }
DEVI int img_off(int row, int chunk) { return row * 128 + ((chunk ^ swz(row)) << 4); }

template <int BM> struct XDma {
    static constexpr int NI = BM / 64;
    const bf16_t* base; unsigned off[NI];
    template <class RowFn> DEVI void init(const RowFn& rowfn, int tid) {
        const int w = tid >> 6, i = tid & 63;
        base = rowfn.base;
#pragma unroll
        for (int j = 0; j < NI; ++j) { const int row = 64 * j + 8 * w + (i >> 3); off[j] = rowfn.offset(row) + (((i & 7) ^ swz(row)) << 3); }
    }
    DEVI void issue(int kt, lds_t* img, int tid) const {
        lds_t* dst = img + (tid >> 6) * 1024 + (tid & 63) * 16;
#pragma unroll
        for (int j = 0; j < NI; ++j) __builtin_amdgcn_global_load_lds((const unsigned*)(base + off[j] + kt * 64), (LAS unsigned*)(dst + j * 8192), 16, 0, 0);
    }
};

struct WRegs {
    f32x4 r[8];
    DEVI void load(const float* p, size_t ldw, int kt) {
        const float* q = p + (size_t)kt * 64 * ldw;
#pragma unroll
        for (int i = 0; i < 8; ++i) r[i] = *(const f32x4*)(q + (size_t)i * ldw);
    }
    DEVI void store(lds_t* img, int wave, int lane) const {
#pragma unroll
        for (int c = 0; c < 4; ++c) {
            u32x4 v;
            v.x = pk_bf16(r[0][c], r[1][c]); v.y = pk_bf16(r[2][c], r[3][c]); v.z = pk_bf16(r[4][c], r[5][c]); v.w = pk_bf16(r[6][c], r[7][c]);
            lds_st128(img + img_off(4 * lane + c, wave), v);
        }
    }
};

template <int BM, bool TRANS>
DEVI void gemm_compute(lds_t* ximg, lds_t* wimg, f32x4 (&acc)[BM / 32][4], int wr, int wc, int lane) {
    constexpr int TM = BM / 32, NH = TM / 4, NSTEP = 2 * NH;
    const int r16 = lane & 15, g = lane >> 4;
    const int c0 = g ^ ((r16 >> 1) & 7);
    lds_t* xb = ximg + (wr * (BM / 2) + r16) * 128;
    lds_t* wb = wimg + (wc * 64 + r16) * 128;
    bf16x8 wf[2][4], xf[2][4];
#define LD_W(buf, s_) do { const int o0_ = ((c0 ^ (4 * (s_))) << 4), o1_ = ((c0 ^ (4 * (s_)) ^ 1) << 4); \
        _Pragma("unroll") for (int nb = 0; nb < 4; ++nb) wf[buf][nb] = lds_ld128(wb + nb * 2048 + ((nb & 1) ? o1_ : o0_)); } while (0)
#define LD_X(buf, s_, h_) do { const int o0_ = ((c0 ^ (4 * (s_))) << 4), o1_ = ((c0 ^ (4 * (s_)) ^ 1) << 4); \
        _Pragma("unroll") for (int m4 = 0; m4 < 4; ++m4) { const int mb_ = 4 * (h_) + m4; xf[buf][m4] = lds_ld128(xb + mb_ * 2048 + ((mb_ & 1) ? o1_ : o0_)); } } while (0)
    LD_W(0, 0); LD_X(0, 0, 0);
#pragma unroll
    for (int st = 0; st < NSTEP; ++st) {
        const int s = st / NH, h = st % NH;
        if (st + 1 < NSTEP) {
            const int s1 = (st + 1) / NH, h1 = (st + 1) % NH;
            if (s1 != s) LD_W(s1 & 1, s1);
            LD_X((st + 1) & 1, s1, h1);
        }
#pragma unroll
        for (int m4 = 0; m4 < 4; ++m4)
#pragma unroll
            for (int nb = 0; nb < 4; ++nb) {
                const int mb = 4 * h + m4;
                acc[mb][nb] = TRANS ? __builtin_amdgcn_mfma_f32_16x16x32_bf16(wf[s & 1][nb], xf[st & 1][m4], acc[mb][nb], 0, 0, 0)
                                    : __builtin_amdgcn_mfma_f32_16x16x32_bf16(xf[st & 1][m4], wf[s & 1][nb], acc[mb][nb], 0, 0, 0);
            }
        __builtin_amdgcn_sched_barrier(0);
    }
#undef LD_W
#undef LD_X
}

struct WLin { const float* base; DEVI const float* operator()(int lane) const { return base + 4 * lane; } };
template <int BM> struct GemmPipe {
    static constexpr int TM = BM / 32, STAGE = (BM + 256) * 128, NI = BM / 64;
    XDma<BM> xd; const float* wp; unsigned ldw; WRegs wr_; int par;
    template <class RowFn, class WFn> DEVI void prime(lds_t* lds, const RowFn& rf, const WFn& wf, unsigned ldw_, int tid_in) {
        const int tid = tid_in;
        const int lane = tid & 63, wave = tid >> 6;
        xd.init(rf, tid); ldw = ldw_; wp = wf(lane) + (size_t)(8 * wave) * ldw_; par = 0;
        wr_.load(wp, ldw, 0);
        __syncthreads();
        xd.issue(0, lds, tid); wr_.store(lds + BM * 128, wave, lane);
        wr_.load(wp, ldw, 1);
    }
    template <bool TRANS, bool XUNIT = true, class Epi, class RowFnN, class WFnN>
    DEVI void run(lds_t* lds, int nk, const Epi& epi, bool has_next_in, const RowFnN& rfn, const WFnN& wfn, unsigned ldw_n, int tid_in) {
        int tid = tid_in; asm volatile("" : "+v"(tid));
        const int lane = tid & 63, wave = tid >> 6, wrow = wave >> 2, wcol = wave & 3;
        const bool has_next = XUNIT && has_next_in;
        f32x4 acc[TM][4];
#pragma unroll
        for (int i = 0; i < TM; ++i)
#pragma unroll
            for (int j = 0; j < 4; ++j) acc[i][j] = (f32x4){0.f, 0.f, 0.f, 0.f};
        unsigned offn[NI];
        if (XUNIT) {
#pragma unroll
            for (int j = 0; j < NI; ++j) offn[j] = 0u;
        }
        for (int t = 0; t < nk; ++t) {
            asm volatile("s_waitcnt vmcnt(0)" ::: "memory");
            __syncthreads();
            lds_t* cur = lds + ((par + t) & 1) * STAGE;
            lds_t* nxt = lds + ((par + t + 1) & 1) * STAGE;
            if (t + 2 < nk) {
                xd.issue(t + 1, nxt, tid); wr_.store(nxt + BM * 128, wave, lane); wr_.load(wp, ldw, t + 2);
            } else if (t + 1 < nk) {
                xd.issue(t + 1, nxt, tid); wr_.store(nxt + BM * 128, wave, lane);
                if (has_next) {
                    ldw = ldw_n; wp = wfn(lane) + (size_t)(8 * wave) * ldw_n; wr_.load(wp, ldw, 0);
#pragma unroll
                    for (int j = 0; j < NI; ++j) { const int row = 64 * j + 8 * wave + (lane >> 3); offn[j] = rfn.offset(row) + (((lane & 7) ^ swz(row)) << 3); }
                }
            } else if (has_next) {
                xd.base = rfn.base;
#pragma unroll
                for (int j = 0; j < NI; ++j) xd.off[j] = offn[j];
                xd.issue(0, nxt, tid); wr_.store(nxt + BM * 128, wave, lane); wr_.load(wp, ldw, 1);
            }
            gemm_compute<BM, TRANS>(cur, cur + BM * 128, acc, wrow, wcol, lane);
        }
        par = (par + nk) & 1;
        { int t2 = tid; asm volatile("" : "+v"(t2));
          const int w2 = t2 >> 6; epi(acc, w2 >> 2, w2 & 3, t2 & 63); }
    }
};

template <int BM, bool TRANS, class RowFn, class WFn, class Epi>
DEVI void gemm_unit(lds_t* lds, const RowFn& rowfn, const WFn& wfn, unsigned ldw, int nk, const Epi& epi, int tid_in) {
    int tid = tid_in; asm volatile("" : "+v"(tid));
    constexpr int TM = BM / 32;
    constexpr int STAGE = (BM + 256) * 128;
    const int lane = tid & 63, wave = tid >> 6, wr = wave >> 2, wc = wave & 3;
    XDma<BM> xd; WRegs wl;
    const float* wp = wfn(lane) + (size_t)(8 * wave) * ldw;
    wl.load(wp, ldw, 0);
    xd.init(rowfn, tid);
    f32x4 acc[TM][4];
#pragma unroll
    for (int i = 0; i < TM; ++i)
#pragma unroll
        for (int j = 0; j < 4; ++j) acc[i][j] = (f32x4){0.f, 0.f, 0.f, 0.f};
    __syncthreads();
    xd.issue(0, lds, tid); wl.store(lds + BM * 128, wave, lane);
    if (nk > 1) wl.load(wp, ldw, 1);
    for (int t = 0; t < nk; ++t) {
        asm volatile("s_waitcnt vmcnt(0)" ::: "memory");
        __syncthreads();
        lds_t* cur = lds + (t & 1) * STAGE;
        lds_t* nxt = lds + ((t + 1) & 1) * STAGE;
        if (t + 1 < nk) {
            xd.issue(t + 1, nxt, tid); wl.store(nxt + BM * 128, wave, lane);
            if (t + 2 < nk) wl.load(wp, ldw, t + 2);
        }
        gemm_compute<BM, TRANS>(cur, cur + BM * 128, acc, wr, wc, lane);
    }
    { int t2 = tid; asm volatile("" : "+v"(t2));
      const int w2 = t2 >> 6; epi(acc, w2 >> 2, w2 & 3, t2 & 63); }
}

template <int BM, bool TRANS, class RowFn, class WRowFn, class Epi>
DEVI void gemm_unit_bb(lds_t* lds, const RowFn& rowfn, const WRowFn& wrowfn, int nk, const Epi& epi, int tid_in) {
    int tid = tid_in; asm volatile("" : "+v"(tid));
    constexpr int TM = BM / 32;
    constexpr int STAGE = (BM + 256) * 128;
    const int lane = tid & 63, wave = tid >> 6, wr = wave >> 2, wc = wave & 3;
    XDma<BM> xd; XDma<256> wd;
    xd.init(rowfn, tid); wd.init(wrowfn, tid);
    f32x4 acc[TM][4];
#pragma unroll
    for (int i = 0; i < TM; ++i)
#pragma unroll
        for (int j = 0; j < 4; ++j) acc[i][j] = (f32x4){0.f, 0.f, 0.f, 0.f};
    __syncthreads();
    xd.issue(0, lds, tid); wd.issue(0, lds + BM * 128, tid);
    for (int t = 0; t < nk; ++t) {
        asm volatile("s_waitcnt vmcnt(0)" ::: "memory");
        __syncthreads();
        lds_t* cur = lds + (t & 1) * STAGE;
        lds_t* nxt = lds + ((t + 1) & 1) * STAGE;
        if (t + 1 < nk) { xd.issue(t + 1, nxt, tid); wd.issue(t + 1, nxt + BM * 128, tid); }
        gemm_compute<BM, TRANS>(cur, cur + BM * 128, acc, wr, wc, lane);
    }
    { int t2 = tid; asm volatile("" : "+v"(t2));
      const int w2 = t2 >> 6; epi(acc, w2 >> 2, w2 & 3, t2 & 63); }
}

template <int BM, bool TRANS, class RowFn, class WRowFn, class Epi>
DEVI void gemm_unit_bb3(lds_t* lds, const RowFn& rowfn, const WRowFn& wrowfn, int nk, const Epi& epi, int tid_in) {
    int tid = tid_in; asm volatile("" : "+v"(tid));
    constexpr int TM = BM / 32;
    constexpr int STAGE = (BM + 256) * 128;
    static_assert(BM == 128, "3 stages fit for BM = 128 only; the counted wait below assumes 2 + 4 DMA instructions per tile");
    const int lane = tid & 63, wave = tid >> 6, wr = wave >> 2, wc = wave & 3;
    XDma<BM> xd; XDma<256> wd;
    xd.init(rowfn, tid); wd.init(wrowfn, tid);
    f32x4 acc[TM][4];
#pragma unroll
    for (int i = 0; i < TM; ++i)
#pragma unroll
        for (int j = 0; j < 4; ++j) acc[i][j] = (f32x4){0.f, 0.f, 0.f, 0.f};
    __syncthreads();
    lds_t* s0 = lds; lds_t* s1 = lds + STAGE; lds_t* s2 = lds + 2 * STAGE;
    xd.issue(0, s0, tid); wd.issue(0, s0 + BM * 128, tid);
    if (nk > 1) { xd.issue(1, s1, tid); wd.issue(1, s1 + BM * 128, tid); }
    for (int t = 0; t < nk; ++t) {
        if (t + 1 < nk) asm volatile("s_waitcnt vmcnt(6)" ::: "memory");
        else asm volatile("s_waitcnt vmcnt(0)" ::: "memory");
        asm volatile("s_waitcnt lgkmcnt(0)" ::: "memory");
        __builtin_amdgcn_s_barrier();
        asm volatile("" ::: "memory");
        if (t + 2 < nk) { xd.issue(t + 2, s2, tid); wd.issue(t + 2, s2 + BM * 128, tid); }
        gemm_compute<BM, TRANS>(s0, s0 + BM * 128, acc, wr, wc, lane);
        lds_t* tmp = s0; s0 = s1; s1 = s2; s2 = tmp;
    }
    __syncthreads();
    { int t2 = tid; asm volatile("" : "+v"(t2));
      const int w2 = t2 >> 6; epi(acc, w2 >> 2, w2 & 3, t2 & 63); }
}

DEVI int swz32(int row) { return ((((row >> 2) ^ (row >> 3)) & 1) << 1) | ((row >> 2) & 1); }
template <int BM> struct XDma32 {
    static constexpr int NI = BM / 128;
    const bf16_t* base; unsigned off[NI];
    template <class RowFn> DEVI void init(const RowFn& rowfn, int tid) {
        const int w = tid >> 6, i = tid & 63;
        base = rowfn.base;
#pragma unroll
        for (int j = 0; j < NI; ++j) { const int row = 128 * j + 16 * w + (i >> 2); off[j] = rowfn.offset(row) + (((i & 3) ^ swz32(row)) << 3); }
    }
    DEVI void issue(int kt32, lds_t* img, int tid) const {
        lds_t* dst = img + (tid >> 6) * 1024 + (tid & 63) * 16;
#pragma unroll
        for (int j = 0; j < NI; ++j) __builtin_amdgcn_global_load_lds((const unsigned*)(base + off[j] + kt32 * 32), (LAS unsigned*)(dst + j * 8192), 16, 0, 0);
    }
};
template <int BM, bool TRANS>
DEVI void gemm_compute32(lds_t* ximg, lds_t* wimg, f32x4 (&acc)[BM / 32][4], int wr, int wc, int lane) {
    constexpr int TM = BM / 32;
    const int r16 = lane & 15, g = lane >> 4;
    const int c0 = (g ^ swz32(r16)) << 4;
    lds_t* xb = ximg + (wr * (BM / 2) + r16) * 64 + c0;
    lds_t* wb = wimg + (wc * 64 + r16) * 64 + c0;
    bf16x8 wf[4], xf[TM];
#pragma unroll
    for (int nb = 0; nb < 4; ++nb) wf[nb] = lds_ld128(wb + nb * 1024);
#pragma unroll
    for (int mb = 0; mb < TM; ++mb) xf[mb] = lds_ld128(xb + mb * 1024);
#pragma unroll
    for (int mb = 0; mb < TM; ++mb)
#pragma unroll
        for (int nb = 0; nb < 4; ++nb)
            acc[mb][nb] = TRANS ? __builtin_amdgcn_mfma_f32_16x16x32_bf16(wf[nb], xf[mb], acc[mb][nb], 0, 0, 0)
                                : __builtin_amdgcn_mfma_f32_16x16x32_bf16(xf[mb], wf[nb], acc[mb][nb], 0, 0, 0);
}
template <int BM, bool TRANS, class RowFn, class WRowFn, class Epi>
DEVI void gemm_unit_bb4(lds_t* lds, const RowFn& rowfn, const WRowFn& wrowfn, int nk2  , const Epi& epi, int tid_in) {
    int tid = tid_in; asm volatile("" : "+v"(tid));
    constexpr int TM = BM / 32;
    constexpr int XB = BM * 64, STAGE = XB + 256 * 64;
    static_assert(BM == 256, "the counted waits below assume 2 + 2 DMA instructions per sub-tile");
    const int lane = tid & 63, wave = tid >> 6, wr = wave >> 2, wc = wave & 3;
    XDma32<BM> xd; XDma32<256> wd;
    xd.init(rowfn, tid); wd.init(wrowfn, tid);
    f32x4 acc[TM][4];
#pragma unroll
    for (int i = 0; i < TM; ++i)
#pragma unroll
        for (int j = 0; j < 4; ++j) acc[i][j] = (f32x4){0.f, 0.f, 0.f, 0.f};
    __syncthreads();
#pragma unroll
    for (int t = 0; t < 3; ++t) if (t < nk2) { xd.issue(t, lds + t * STAGE, tid); wd.issue(t, lds + t * STAGE + XB, tid); }
    for (int t = 0; t < nk2; ++t) {
        const int rem = nk2 - 1 - t;
        if (rem >= 2) asm volatile("s_waitcnt vmcnt(8)" ::: "memory");
        else if (rem == 1) asm volatile("s_waitcnt vmcnt(4)" ::: "memory");
        else asm volatile("s_waitcnt vmcnt(0)" ::: "memory");
        asm volatile("s_waitcnt lgkmcnt(0)" ::: "memory");
        __builtin_amdgcn_s_barrier();
        asm volatile("" ::: "memory");
        if (t + 3 < nk2) { lds_t* st = lds + ((t + 3) & 3) * STAGE; xd.issue(t + 3, st, tid); wd.issue(t + 3, st + XB, tid); }
        lds_t* cur = lds + (t & 3) * STAGE;
        gemm_compute32<BM, TRANS>(cur, cur + XB, acc, wr, wc, lane);
    }
    __syncthreads();
    { int t2 = tid; asm volatile("" : "+v"(t2));
      const int w2 = t2 >> 6; epi(acc, w2 >> 2, w2 & 3, t2 & 63); }
}

namespace pg8 {
constexpr int BM = 256, BK = 64, HALF = 128, HTB = HALF * BK * 2  , STAGE_BYTES = 8 * HTB;
DEVI int lds_byte(int r, int c) { const int st = (r >> 4) * 2 + (c >> 5), rr = r & 15, cc = c & 31, ob = rr * 64 + cc * 2; return st * 1024 + (ob ^ (((ob >> 9) & 1) << 5)); }
DEVI void stage_rc(int b, int& R, int& C) { const int st = b / 1024, sb = b % 1024, swz = sb ^ (((sb >> 9) & 1) << 5); R = (st >> 1) * 16 + swz / 64; C = (st & 1) * 32 + (swz % 64) / 2; }
DEVI int perm32(int rho) { const int n = rho >> 4, i = rho & 15; return 8 * (i >> 2) + 4 * n + (i & 3); }
struct Unit { int pm, pn, aux; };

template <class Epi, class Sched>
DEVI void gemm_phase(lds_t* lds, const int ldk  , const int nt  , const Sched& S, const Epi& E, const int tid,
                      const int hrowsA = HALF, const int hrowsB = HALF  ) {
    const int wid = __builtin_amdgcn_readfirstlane(tid >> 6), lane = tid & 63, wr = wid >> 2, wc = wid & 3, fr = lane & 15, fq = lane >> 4;
    unsigned voffA[2], voffB[2];
#pragma unroll
    for (int i = 0; i < 2; ++i) { int R, C; stage_rc(tid * 16 + i * 8192, R, C); const int Rb = Epi::PERM ? ((R & ~31) + perm32(R & 31)) : R;
        voffA[i] = (unsigned)(R * ldk + C) * 2u; voffB[i] = (unsigned)(Rb * ldk + C) * 2u; }
    const size_t kstep = (size_t)(BK * 2);
    const size_t hstepA = (size_t)hrowsA * ldk * 2, hstepB = (size_t)hrowsB * ldk * 2;
    const unsigned ldsw = (unsigned)wid * 1024u;
    const int aoff = lds_byte(wr * 64 + fr, fq * 8), boff = lds_byte(wc * 32 + fr, fq * 8);
#define PG8_SA(b, h) (((b) * 2 + (h)) * HTB)
#define PG8_SB(b, h) ((4 + (b) * 2 + (h)) * HTB)
#define PG8_STAGE(bufoff, gbase, voff) do { _Pragma("unroll") for (int _i = 0; _i < 2; ++_i) \
        __builtin_amdgcn_global_load_lds((const unsigned*)((const char*)(gbase) + (voff)[_i]), (LAS unsigned*)(lds + (bufoff) + ldsw + _i * 8192), 16, 0, 0); } while (0)
#define PG8_LDA(dst, b, h) do { _Pragma("unroll") for (int m = 0; m < 4; ++m) _Pragma("unroll") for (int k = 0; k < 2; ++k) dst[m][k] = *(const LAS bf16x8*)(lds + PG8_SA(b, h) + aoff + m * 2048 + k * 1024); } while (0)
#define PG8_LDB(dst, b, h) do { _Pragma("unroll") for (int n = 0; n < 2; ++n) _Pragma("unroll") for (int k = 0; k < 2; ++k) dst[n][k] = *(const LAS bf16x8*)(lds + PG8_SB(b, h) + boff + n * 2048 + k * 1024); } while (0)
#define PG8_MMA(ai, bj, At, Bt) do { __builtin_amdgcn_s_setprio(1); _Pragma("unroll") for (int m = 0; m < 4; ++m) _Pragma("unroll") for (int n = 0; n < 2; ++n) _Pragma("unroll") for (int k = 0; k < 2; ++k) \
        acc[ai][bj][m][n] = __builtin_amdgcn_mfma_f32_16x16x32_bf16(Bt[n][k], At[m][k], acc[ai][bj][m][n], 0, 0, 0); __builtin_amdgcn_s_setprio(0); } while (0)
#define PG8_WAIT_V(n) asm volatile("s_waitcnt vmcnt(" #n ")" ::: "memory")
#define PG8_WAIT_L(n) asm volatile("s_waitcnt lgkmcnt(" #n ")" ::: "memory")
#define PG8_BAR __builtin_amdgcn_s_barrier()
#define PG8_SCHED __builtin_amdgcn_sched_barrier(0)
    Unit cur, nxt; int ui = 0;
    __syncthreads();
    if (!S.next(0, cur)) return;
    f32x4 acc[2][2][4][2];
#pragma unroll
    for (int a = 0; a < 2; ++a)
#pragma unroll
        for (int b = 0; b < 2; ++b)
#pragma unroll
            for (int m = 0; m < 4; ++m)
#pragma unroll
                for (int n = 0; n < 2; ++n) acc[a][b][m][n] = (f32x4){0.f, 0.f, 0.f, 0.f};
    bf16x8 At[4][2], B0[2][2], B1[2][2];
    const char* cA; const char* cB;
    S.ptrs(cur, cA, cB);
    PG8_STAGE(PG8_SB(0, 0), cB, voffB); PG8_STAGE(PG8_SA(0, 0), cA, voffA); PG8_STAGE(PG8_SB(0, 1), cB + hstepB, voffB); PG8_STAGE(PG8_SA(0, 1), cA + hstepA, voffA);
    if (wr == 1) PG8_BAR;
    PG8_WAIT_V(4); PG8_BAR;
    PG8_STAGE(PG8_SB(1, 0), cB + kstep, voffB); PG8_STAGE(PG8_SA(1, 0), cA + kstep, voffA); PG8_STAGE(PG8_SB(1, 1), cB + hstepB + kstep, voffB);
    PG8_WAIT_V(6); PG8_BAR;
    for (;;) {
        const bool has_next = S.next(ui + 1, nxt);
        const char* nA = cA; const char* nB = cB;
        if (has_next) S.ptrs(nxt, nA, nB);
        for (int t = 0; t < nt; t += 2) {
            const bool last = (t == nt - 2);
            const char* a1 = cA + (size_t)(t + 1) * kstep;
            const char* a2 = last ? nA : cA + (size_t)(t + 2) * kstep; const char* b2 = last ? nB : cB + (size_t)(t + 2) * kstep;
            const char* a3 = a2 + kstep; const char* b3 = b2 + kstep;
            PG8_LDB(B0, 0, 0); PG8_SCHED; PG8_LDA(At, 0, 0); PG8_STAGE(PG8_SA(1, 1), a1 + hstepA, voffA);
            PG8_WAIT_L(8); PG8_BAR; PG8_WAIT_L(0); PG8_MMA(0, 0, At, B0); PG8_BAR; PG8_SCHED;
            PG8_LDB(B1, 0, 1); PG8_STAGE(PG8_SB(0, 0), b2, voffB);
            PG8_BAR; PG8_WAIT_L(0); PG8_MMA(0, 1, At, B1); PG8_BAR;
            PG8_LDA(At, 0, 1); PG8_STAGE(PG8_SA(0, 0), a2, voffA);
            PG8_BAR; PG8_WAIT_L(0); PG8_MMA(1, 0, At, B0); PG8_BAR; PG8_SCHED;
            PG8_STAGE(PG8_SB(0, 1), b2 + hstepB, voffB);
            PG8_WAIT_V(6); PG8_BAR; PG8_MMA(1, 1, At, B1); PG8_BAR;
            PG8_LDB(B0, 1, 0); PG8_SCHED; PG8_LDA(At, 1, 0); PG8_STAGE(PG8_SA(0, 1), a2 + hstepA, voffA);
            PG8_WAIT_L(8); PG8_BAR; PG8_WAIT_L(0); PG8_MMA(0, 0, At, B0); PG8_BAR; PG8_SCHED;
            PG8_LDB(B1, 1, 1); PG8_STAGE(PG8_SB(1, 0), b3, voffB);
            PG8_BAR; PG8_WAIT_L(0); PG8_MMA(0, 1, At, B1); PG8_BAR;
            PG8_LDA(At, 1, 1); PG8_STAGE(PG8_SA(1, 0), a3, voffA);
            PG8_BAR; PG8_WAIT_L(0); PG8_MMA(1, 0, At, B0); PG8_BAR; PG8_SCHED;
            PG8_STAGE(PG8_SB(1, 1), b3 + hstepB, voffB);
            PG8_WAIT_V(6); PG8_BAR; PG8_MMA(1, 1, At, B1); PG8_BAR;
        }
        { const int ln = lane_id_fresh(); E(acc, cur, wr, wc, ln & 15, ln >> 4); }
        if (!has_next) break;
#pragma unroll
        for (int a = 0; a < 2; ++a)
#pragma unroll
            for (int b = 0; b < 2; ++b)
#pragma unroll
                for (int m = 0; m < 4; ++m)
#pragma unroll
                    for (int n = 0; n < 2; ++n) acc[a][b][m][n] = (f32x4){0.f, 0.f, 0.f, 0.f};
        cur = nxt; cA = nA; cB = nB; ++ui;
    }
    PG8_WAIT_V(0);
    if (wr == 0) PG8_BAR;
    PG8_BAR;
#undef PG8_SA
#undef PG8_SB
#undef PG8_STAGE
#undef PG8_LDA
#undef PG8_LDB
#undef PG8_MMA
#undef PG8_WAIT_V
#undef PG8_WAIT_L
#undef PG8_BAR
#undef PG8_SCHED
}
}

DEVI void phase_modulation(const Params& p, lds_t* lds, int bid, int nblk, int tid) {
    LAS float* sc = (LAS float*)lds;
    LAS float* red = (LAS float*)(lds + 20480);
    __syncthreads();
    for (int i = tid; i < 5 * 1024; i += NTHREADS) {
        const int cnd = i >> 10, k = i & 1023;
        const float v = cnd == 0 ? p.c_ctx[k] : p.c[(cnd - 1) * 1024 + k];
        sc[i] = silu_f(v);
    }
    __syncthreads();
    const int cg = tid & 31, kg = tid >> 5;
    for (int u = bid; u < DEPTH * 48; u += nblk) {
        const int l = u / 48, n0 = (u % 48) * 128;
        const float* w = p.mod_w + (size_t)l * 1024 * 6144 + n0 + 4 * cg;
        f32x4 a[5];
#pragma unroll
        for (int c = 0; c < 5; ++c) a[c] = (f32x4){0.f, 0.f, 0.f, 0.f};
#pragma unroll 8
        for (int kk = 0; kk < 64; ++kk) {
            const int k = kg * 64 + kk;
            const f32x4 wv = *(const f32x4*)(w + (size_t)k * 6144);
#pragma unroll
            for (int c = 0; c < 5; ++c) a[c] += wv * sc[c * 1024 + k];
        }
#pragma unroll
        for (int c = 0; c < 5; ++c) *(LAS f32x4*)(red + (kg * 5 + c) * 128 + 4 * cg) = a[c];
        __syncthreads();
        for (int i = tid; i < 5 * 128; i += NTHREADS) {
            const int c = i >> 7, n = i & 127;
            float s = 0.f;
#pragma unroll
            for (int q = 0; q < 16; ++q) s += red[(q * 5 + c) * 128 + n];
            p.mod[(size_t)(l * 5 + c) * 6144 + n0 + n] = s + p.mod_b[l * 6144 + n0 + n];
        }
        __syncthreads();
    }
}


DEVI void wconv_tile(const float* W, bf16_t* Wt, int K, int N, int tk, int tn, lds_t* lds, int tid) {
    LAS bf16_t* s = (LAS bf16_t*)lds;
    __syncthreads();
#pragma unroll
    for (int i = 0; i < 2; ++i) {
        const int c = tid + NTHREADS * i, k = c >> 4, n4 = (c & 15) * 4;
        const f32x4 v = *(const f32x4*)(W + (size_t)(tk * 64 + k) * N + tn * 64 + n4);
#pragma unroll
        for (int q = 0; q < 4; ++q) s[(n4 + q) * 72 + k] = (bf16_t)(pk_bf16(v[q], 0.f) & 0xffffu);
    }
    __syncthreads();
    { const int n = tid >> 3, kc = tid & 7;
      const u32x4 v = *(LAS u32x4*)(s + n * 72 + kc * 8);
      *(u32x4*)(Wt + (size_t)(tn * 64 + n) * K + tk * 64 + kc * 8) = v; }
}
DEVI void phase_wconv(const Params& p, lds_t* lds, int bid, int nblk, int tid) {
    for (int it = bid; it < 4352; it += nblk) {
        int r = it; const float* W; bf16_t* Wt; int K, N;
        if (r < 352) { const int j = r / 176; r %= 176; W = p.mla_w_in + (size_t)j * 1024 * 704; Wt = p.WTI + (size_t)j * 704 * 1024; K = 1024; N = 704; }
        else if ((r -= 352) < 288) { const int j = r / 144; r %= 144; W = p.mla_w_q_up + (size_t)j * 384 * 1536; Wt = p.WTQ + (size_t)j * 1536 * 384; K = 384; N = 1536; }
        else if ((r -= 288) < 256) { const int j = r / 128; r %= 128; W = p.mla_w_kv_up + (size_t)j * 256 * 2048; Wt = p.WTKV + (size_t)j * 2048 * 256; K = 256; N = 2048; }
        else if ((r -= 256) < 512) { const int j = r / 256; r %= 256; W = p.mla_w_out + (size_t)j * 1024 * 1024; Wt = p.WTO + (size_t)j * 1024 * 1024; K = 1024; N = 1024; }
        else if ((r -= 512) < 1536) { W = p.gm_w_in; Wt = p.WTGI; K = 1024; N = 6144; }
        else if ((r -= 1536) < 768) { W = p.gm_w_out; Wt = p.WTGO; K = 3072; N = 1024; }
        else if ((r -= 768) < 384) { W = p.swa_w_qkv; Wt = p.WTSQ; K = 1024; N = 1536; }
        else { r -= 384; W = p.swa_w_out; Wt = p.WTSO; K = 1024; N = 1024; }
        const int ntn = N / 64;
        wconv_tile(W, Wt, K, N, r / ntn, r % ntn, lds, tid);
    }
}

DEVI void phase_prep(const Params& p, int bid, int nblk, int tid) {
    const int lane = tid & 63, wave = tid >> 6;
    for (int row = bid * 8 + wave; row < NTOK; row += nblk * 8) {
        const float* src = row < NPR ? p.x_prompt + (size_t)row * D : p.x_sample + (size_t)(row - NPR) * D;
        const int cnd = cond_of_row(row);
        const float* sh = modp(p, 0, cnd, 0); const float* scl = modp(p, 0, cnd, 1);
#pragma unroll
        for (int i = 0; i < 4; ++i) {
            const int col = lane * 4 + 256 * i;
            const f32x4 v = *(const f32x4*)(src + col);
            const f32x4 s = *(const f32x4*)(scl + col), b = *(const f32x4*)(sh + col);
            const f32x4 h = v * (s + 1.0f) + b;
            u32x2 o; o.x = pk_bf16(h[0], h[1]); o.y = pk_bf16(h[2], h[3]);
            *(u32x2*)(p.H + (size_t)row * D + col) = o;
        }
    }
    for (int i = bid * NTHREADS + tid; i < 1024 * 64; i += nblk * NTHREADS) {
        const f32x4 v = *(const f32x4*)(p.cache_k + (size_t)i * 4);
        u32x2 o; o.x = pk_bf16(v[0], v[1]); o.y = pk_bf16(v[2], v[3]);
        *(u32x2*)(p.SK + (size_t)NTOK * 256 + (size_t)i * 4) = o;
    }
    for (int i = bid * NTHREADS + tid; i < 4 * 4 * 64 * 64; i += nblk * NTHREADS) {
        const int kg4 = i & 63, dv = (i >> 6) & 63, kvh = (i >> 12) & 3, b = i >> 14;
        float v[4];
#pragma unroll
        for (int q = 0; q < 4; ++q) v[q] = p.cache_v[((size_t)(b * 256 + kg4 * 4 + q) * 4 + kvh) * 64 + dv];
        u32x2 o; o.x = pk_bf16(v[0], v[1]); o.y = pk_bf16(v[2], v[3]);
        *(u32x2*)(p.SVTS + ((size_t)(b * 4 + kvh) * 64 + dv) * 1280 + kg4 * 4) = o;
    }
}

DEVI void phase_mla_norm(const Params& p, int j, int bid, int nblk, int tid) {
    const int lane = tid & 63, wave = tid >> 6;
    const float* qg = p.mla_q_gain + j * 384; const float* kg = p.mla_kv_gain + j * 256;
    for (int row = bid * 8 + wave; row < NROWS_KV; row += nblk * 8) {
        if (row >= NTOK) {
            const int b = (row - NTOK) >> 8, t = (row - NTOK) & 255;
            const float* ck = p.cache_ckv + ((size_t)(b * 2 + j) * 256 + t) * 256;
            const f32x4 v = *(const f32x4*)(ck + lane * 4);
            u32x2 o; o.x = pk_bf16(v[0], v[1]); o.y = pk_bf16(v[2], v[3]);
            *(u32x2*)(p.CKV + (size_t)row * 256 + lane * 4) = o;
            const float kp = p.cache_kpe[((size_t)(b * 2 + j) * 256 + t) * 64 + lane];
            p.KPE[(size_t)row * 64 + lane] = (bf16_t)(pk_bf16(kp, 0.f) & 0xffffu);
            continue;
        }
        const float* z = p.Z + (size_t)row * 704;
        float q[6]; float ss = 0.f;
#pragma unroll
        for (int i = 0; i < 6; ++i) { q[i] = z[lane + 64 * i]; ss += q[i] * q[i]; }
        ss = wave_sum(ss);
        const float rq = rsqrtf(ss * (1.0f / 384.0f) + EPS_F);
#pragma unroll
        for (int i = 0; i < 6; ++i) p.CQ[(size_t)row * 384 + lane + 64 * i] = (bf16_t)(pk_bf16(q[i] * rq * qg[lane + 64 * i], 0.f) & 0xffffu);
        const f32x4 kv = *(const f32x4*)(z + 384 + lane * 4);
        float s2 = kv[0] * kv[0] + kv[1] * kv[1] + kv[2] * kv[2] + kv[3] * kv[3];
        s2 = wave_sum(s2);
        const float rk = rsqrtf(s2 * (1.0f / 256.0f) + EPS_F);
        const f32x4 gv = *(const f32x4*)(kg + lane * 4);
        const f32x4 kn = kv * rk * gv;
        { u32x2 o; o.x = pk_bf16(kn[0], kn[1]); o.y = pk_bf16(kn[2], kn[3]); *(u32x2*)(p.CKV + (size_t)row * 256 + lane * 4) = o; }
        float kp = z[640 + lane];
        if (row < NPR) {
            const int b = row >> 8, t = row & 255;
            *(f32x4*)(p.out + OUT_CKV + ((size_t)(b * 2 + j) * 256 + t) * 256 + lane * 4) = kn;
            p.out[OUT_KPE + ((size_t)(b * 2 + j) * 256 + t) * 64 + lane] = kp;
        } else {
            const int t = (row - NPR) & 1023;
            const int pos = lane < 32 ? (t >> 6) : (t & 63);
            const float cs = rope_tab[(pos * 16 + (lane & 15)) * 2], sn = rope_tab[(pos * 16 + (lane & 15)) * 2 + 1];
            const float other = __shfl_xor(kp, 16);
            kp = (lane & 16) ? (kp * cs + other * sn) : (kp * cs - other * sn);
        }
        p.KPE[(size_t)row * 64 + lane] = (bf16_t)(pk_bf16(kp, 0.f) & 0xffffu);
    }
}

DEVI void phase_ln_a(const Params& p, int layer, lds_t* lds, int bid, int nblk, int tid) {
    const int lane = tid & 63, wave = tid >> 6;
    LAS float* rt = (LAS float*)lds;
    const float* router = p.moe_router + (size_t)layer * 1024 * 16;
    __syncthreads();
    for (int i = tid; i < 4096; i += NTHREADS) {
        const f32x4 w = *(const f32x4*)(router + i * 4);
        const int k = i >> 2, e0 = (i & 3) * 4;
        rt[(e0 + 0) * 1024 + k] = w[0]; rt[(e0 + 1) * 1024 + k] = w[1]; rt[(e0 + 2) * 1024 + k] = w[2]; rt[(e0 + 3) * 1024 + k] = w[3];
    }
    __syncthreads();
    const float* lg = p.ln_gain + (layer * 2 + 0) * 1024; const float* lb = p.ln_bias + (layer * 2 + 0) * 1024;
    for (int r0 = (bid * 8 + wave) * 4; r0 < NTOK; r0 += nblk * 32) {
        const int cnd = cond_of_row(r0);
        const float* sh = modp(p, layer, cnd, 3); const float* scl = modp(p, layer, cnd, 4);
        f32x4 v[4][4];
        float mu[4], rs[4];
        const float* xin = (r0 < NPR ? p.x_prompt : p.x_sample - (size_t)NPR * D);
        const bf16_t* X0b = (const bf16_t*)p.X0;
        const bf16_t* Y0 = (const bf16_t*)p.T; const bf16_t* Y1 = Y0 + (size_t)NTOK * D;
#pragma unroll
        for (int j = 0; j < 4; ++j)
#pragma unroll
            for (int i = 0; i < 4; ++i) {
                const size_t o = (size_t)(r0 + j) * D + lane * 4 + 256 * i;
                const u32x2 ya = *(const u32x2*)(Y0 + o), yb = *(const u32x2*)(Y1 + o);
                f32x4 yv; yv[0] = bf_lo(ya.x) + bf_lo(yb.x); yv[1] = bf_hi(ya.x) + bf_hi(yb.x); yv[2] = bf_lo(ya.y) + bf_lo(yb.y); yv[3] = bf_hi(ya.y) + bf_hi(yb.y);
                f32x4 xr;
                if (layer) { const u32x2 xb = *(const u32x2*)(X0b + o); xr[0] = bf_lo(xb.x); xr[1] = bf_hi(xb.x); xr[2] = bf_lo(xb.y); xr[3] = bf_hi(xb.y); }
                else xr = *(const f32x4*)(xin + o);
                v[j][i] = xr * ALPHA_F + yv;
            }
#pragma unroll
        for (int j = 0; j < 4; ++j) { float s = 0.f;
#pragma unroll
            for (int i = 0; i < 4; ++i) s += (v[j][i][0] + v[j][i][1]) + (v[j][i][2] + v[j][i][3]);
            mu[j] = s; }
#pragma unroll
        for (int j = 0; j < 4; ++j) mu[j] = wave_sum(mu[j]) * (1.0f / 1024.0f);
#pragma unroll
        for (int j = 0; j < 4; ++j) { float q = 0.f;
#pragma unroll
            for (int i = 0; i < 4; ++i) { v[j][i] = v[j][i] - mu[j]; q += (v[j][i][0] * v[j][i][0] + v[j][i][1] * v[j][i][1]) + (v[j][i][2] * v[j][i][2] + v[j][i][3] * v[j][i][3]); }
            rs[j] = q; }
#pragma unroll
        for (int j = 0; j < 4; ++j) rs[j] = rsqrtf(wave_sum(rs[j]) * (1.0f / 1024.0f) + EPS_F);
        float lgt[4][16];
#pragma unroll
        for (int j = 0; j < 4; ++j)
#pragma unroll
            for (int e = 0; e < 16; ++e) lgt[j][e] = 0.f;
#pragma unroll
        for (int i = 0; i < 4; ++i) {
            const int col = lane * 4 + 256 * i;
            const f32x4 g4 = *(const f32x4*)(lg + col), b4 = *(const f32x4*)(lb + col), sc4 = *(const f32x4*)(scl + col) + 1.0f, sh4 = *(const f32x4*)(sh + col);
            f32x4 h[4];
#pragma unroll
            for (int j = 0; j < 4; ++j) {
                const f32x4 x = v[j][i] * rs[j] * g4 + b4;
                { u32x2 xo; xo.x = pk_bf16(x[0], x[1]); xo.y = pk_bf16(x[2], x[3]); *(u32x2*)((bf16_t*)p.X1 + (size_t)(r0 + j) * D + col) = xo; }
                h[j] = x * sc4 + sh4;
                u32x2 o; o.x = pk_bf16(h[j][0], h[j][1]); o.y = pk_bf16(h[j][2], h[j][3]);
                *(u32x2*)(p.H2 + (size_t)(r0 + j) * D + col) = o;
            }
#pragma unroll
            for (int e = 0; e < 16; ++e) {
                const f32x4 rw = *(LAS f32x4*)(rt + e * 1024 + col);
#pragma unroll
                for (int j = 0; j < 4; ++j) lgt[j][e] += (h[j][0] * rw[0] + h[j][1] * rw[1]) + (h[j][2] * rw[2] + h[j][3] * rw[3]);
                if ((e & 3) == 3) __builtin_amdgcn_sched_barrier(0);
            }
        }
        float r1[4];
#pragma unroll
        for (int j = 0; j < 4; ++j) {
            float r8[8], r4[4], r2[2];
            { const bool hi = (lane & 32) != 0;
#pragma unroll
              for (int i = 0; i < 8; ++i) { const float keep = hi ? lgt[j][8 + i] : lgt[j][i], send = hi ? lgt[j][i] : lgt[j][8 + i]; r8[i] = keep + __shfl_xor(send, 32); } }
            { const bool hi = (lane & 16) != 0;
#pragma unroll
              for (int i = 0; i < 4; ++i) { const float keep = hi ? r8[4 + i] : r8[i], send = hi ? r8[i] : r8[4 + i]; r4[i] = keep + __shfl_xor(send, 16); } }
            { const bool hi = (lane & 8) != 0;
#pragma unroll
              for (int i = 0; i < 2; ++i) { const float keep = hi ? r4[2 + i] : r4[i], send = hi ? r4[i] : r4[2 + i]; r2[i] = keep + __shfl_xor(send, 8); } }
            { const bool hi = (lane & 4) != 0; const float keep = hi ? r2[1] : r2[0], send = hi ? r2[0] : r2[1]; r1[j] = keep + __shfl_xor(send, 4); }
        }
        const int e = ((lane >> 5) & 1) * 8 + ((lane >> 4) & 1) * 4 + ((lane >> 3) & 1) * 2 + ((lane >> 2) & 1);
#pragma unroll
        for (int j = 0; j < 4; ++j) {
            float r = r1[j];
            r += __shfl_xor(r, 2); r += __shfl_xor(r, 1);
            float mx = r;
            mx = fmaxf(mx, __shfl_xor(mx, 4)); mx = fmaxf(mx, __shfl_xor(mx, 8)); mx = fmaxf(mx, __shfl_xor(mx, 16)); mx = fmaxf(mx, __shfl_xor(mx, 32));
            const float ex = __expf(r - mx);
            float den = ex;
            den += __shfl_xor(den, 4); den += __shfl_xor(den, 8); den += __shfl_xor(den, 16); den += __shfl_xor(den, 32);
            if ((lane & 3) == 0) p.AFF[(size_t)e * NTOK + r0 + j] = ex / den;
        }
    }
}

DEVI int block_sum_i(int v, LAS int* red, int tid) {
    const int lane = tid & 63, wave = tid >> 6;
    v = __builtin_popcountll(__ballot(v & 1)) + 2 * __builtin_popcountll(__ballot(v & 2)) + 4 * __builtin_popcountll(__ballot(v & 4)) + 8 * __builtin_popcountll(__ballot(v & 8));
    __syncthreads();
    if (lane == 0) red[wave] = v;
    __syncthreads();
    return (red[0] + red[1]) + (red[2] + red[3]) + (red[4] + red[5]) + (red[6] + red[7]);
}
DEVI int block_excl_scan_i(int v, LAS int* red, int tid, int& total) {
    const int lane = tid & 63, wave = tid >> 6;
    int inc = v;
#pragma unroll
    for (int o = 1; o < 64; o <<= 1) { const int t = __shfl_up(inc, o); if (lane >= o) inc += t; }
    __syncthreads();
    if (lane == 63) red[wave] = inc;
    __syncthreads();
    int base = 0, tot = 0;
#pragma unroll
    for (int w = 0; w < 8; ++w) { const int c = red[w]; if (w < wave) base += c; tot += c; }
    total = tot;
    return base + inc - v;
}
DEVI void phase_topk(const Params& p, lds_t* lds, int bid, int nblk, int tid) {
    LAS int* red = (LAS int*)lds;
    for (int it = bid; it < 32; it += nblk) {
        const int grp = it >> 4, e = it & 15;
        const float* a = p.AFF + (size_t)e * NTOK + grp * 4096 + tid * 8;
        const f32x4 a0 = *(const f32x4*)a, a1 = *(const f32x4*)(a + 4);
        unsigned key[8];
#pragma unroll
        for (int i = 0; i < 4; ++i) { key[i] = __float_as_uint(a0[i]); key[4 + i] = __float_as_uint(a1[i]); }
        unsigned thr = 0u;
        for (int bit = 30; bit >= 0; --bit) {
            const unsigned cand = thr | (1u << bit);
            int c = 0;
#pragma unroll
            for (int i = 0; i < 8; ++i) c += key[i] >= cand ? 1 : 0;
            if (block_sum_i(c, red, tid) >= 512) thr = cand;
        }
        int cgt = 0, ceq = 0;
#pragma unroll
        for (int i = 0; i < 8; ++i) { cgt += key[i] > thr ? 1 : 0; ceq += key[i] == thr ? 1 : 0; }
        int ngt, neq;
        (void)block_excl_scan_i(cgt, red, tid, ngt);
        int tie_rank = block_excl_scan_i(ceq, red, tid, neq);
        const int need = 512 - ngt;
        int sel[8], cs = 0;
#pragma unroll
        for (int i = 0; i < 8; ++i) {
            const bool eq = key[i] == thr;
            sel[i] = (key[i] > thr || (eq && tie_rank < need)) ? 1 : 0;
            tie_rank += eq ? 1 : 0; cs += sel[i];
        }
        int tot;
        int slot = block_excl_scan_i(cs, red, tid, tot);
#pragma unroll
        for (int i = 0; i < 8; ++i) {
            const int t = grp * 4096 + tid * 8 + i;
            int sl = -1;
            if (sel[i]) { sl = grp * 512 + slot; ++slot; p.IDX[e * 1024 + sl] = t; p.GATEV[e * 1024 + sl] = __uint_as_float(key[i]); }
            p.SEL[(size_t)t * 16 + e] = sl;
        }
    }
}

DEVI void phase_ln_b(const Params& p, int layer, int bid, int nblk, int tid) {
    const int lane = tid & 63, wave = tid >> 6;
    const float* lg = p.ln_gain + (layer * 2 + 1) * 1024; const float* lb = p.ln_bias + (layer * 2 + 1) * 1024;
    const bool last = (layer == DEPTH - 1);
    float* xo = p.out + OUT_Y; bf16_t* X0b = (bf16_t*)p.X0; const bf16_t* X1b = (const bf16_t*)p.X1;
    const int stride = nblk * 8;
    int row = bid * 8 + wave;
    int seln = -1; u32x2 xn[4];
    if (row < NTOK) {
        if (lane < 16) seln = p.SEL[(size_t)row * 16 + lane];
#pragma unroll
        for (int i = 0; i < 4; ++i) xn[i] = *(const u32x2*)(X1b + (size_t)row * D + lane * 4 + 256 * i);
    }
    for (; row < NTOK; row += stride) {
        const int selv = seln;
        f32x4 v[4];
#pragma unroll
        for (int i = 0; i < 4; ++i) { v[i][0] = bf_lo(xn[i].x); v[i][1] = bf_hi(xn[i].x); v[i][2] = bf_lo(xn[i].y); v[i][3] = bf_hi(xn[i].y); }
        unsigned long long mask = __ballot(selv >= 0);
        f32x4 y[4];
#pragma unroll
        for (int i = 0; i < 4; ++i) y[i] = (f32x4){0.f, 0.f, 0.f, 0.f};
        while (mask) {
            const int e0 = __builtin_ctzll(mask); mask &= mask - 1;
            const int s0 = __builtin_amdgcn_readlane(selv, e0);
            const bf16_t* y0 = p.YE + ((size_t)e0 * 1024 + s0) * 1024 + lane * 4;
            const bool two = mask != 0;
            int e1 = e0, s1 = s0;
            if (two) { e1 = __builtin_ctzll(mask); mask &= mask - 1; s1 = __builtin_amdgcn_readlane(selv, e1); }
            const bf16_t* y1 = p.YE + ((size_t)e1 * 1024 + s1) * 1024 + lane * 4;
            u32x2 w0[4], w1[4];
#pragma unroll
            for (int i = 0; i < 4; ++i) { w0[i] = *(const u32x2*)(y0 + 256 * i); w1[i] = *(const u32x2*)(y1 + 256 * i); }
            const float f1 = two ? 1.0f : 0.0f;
#pragma unroll
            for (int i = 0; i < 4; ++i) {
                y[i][0] += bf_lo(w0[i].x) + f1 * bf_lo(w1[i].x); y[i][1] += bf_hi(w0[i].x) + f1 * bf_hi(w1[i].x);
                y[i][2] += bf_lo(w0[i].y) + f1 * bf_lo(w1[i].y); y[i][3] += bf_hi(w0[i].y) + f1 * bf_hi(w1[i].y);
            }
        }
        if (row + stride < NTOK) {
            seln = -1;
            if (lane < 16) seln = p.SEL[(size_t)(row + stride) * 16 + lane];
#pragma unroll
            for (int i = 0; i < 4; ++i) xn[i] = *(const u32x2*)(X1b + (size_t)(row + stride) * D + lane * 4 + 256 * i);
        }
        const int cnd = cond_of_row(row);
        const float* gt = modp(p, layer, cnd, 5);
        float s = 0.f;
#pragma unroll
        for (int i = 0; i < 4; ++i) {
            const int col = lane * 4 + 256 * i;
            v[i] = v[i] * ALPHA_F + *(const f32x4*)(gt + col) * y[i];
            s += (v[i][0] + v[i][1]) + (v[i][2] + v[i][3]);
        }
        s = wave_sum(s);
        const float mu = s * (1.0f / 1024.0f);
        float q = 0.f;
#pragma unroll
        for (int i = 0; i < 4; ++i) { v[i] = v[i] - mu; q += (v[i][0] * v[i][0] + v[i][1] * v[i][1]) + (v[i][2] * v[i][2] + v[i][3] * v[i][3]); }
        q = wave_sum(q);
        const float rs = rsqrtf(q * (1.0f / 1024.0f) + EPS_F);
        const float* sh = modp(p, last ? layer : layer + 1, cnd, 0); const float* scl = modp(p, last ? layer : layer + 1, cnd, 1);
#pragma unroll
        for (int i = 0; i < 4; ++i) {
            const int col = lane * 4 + 256 * i;
            const f32x4 x = v[i] * rs * *(const f32x4*)(lg + col) + *(const f32x4*)(lb + col);
            if (last) *(f32x4*)(xo + (size_t)row * D + col) = x;
            else {
                { u32x2 xb; xb.x = pk_bf16(x[0], x[1]); xb.y = pk_bf16(x[2], x[3]); *(u32x2*)(X0b + (size_t)row * D + col) = xb; }
                const f32x4 h = x * (*(const f32x4*)(scl + col) + 1.0f) + *(const f32x4*)(sh + col);
                u32x2 o; o.x = pk_bf16(h[0], h[1]); o.y = pk_bf16(h[2], h[3]);
                *(u32x2*)(p.H + (size_t)row * D + col) = o;
            }
        }
    }
}

constexpr int GBM = 128;
constexpr int GBM2 = 256;
DEVI int xcd_first_unit(int bid, int nblk) { return (nblk & 7) ? bid : (bid & 7) * (nblk >> 3) + (bid >> 3); }
struct RowLin { const bf16_t* base; unsigned ld; DEVI unsigned offset(int r) const { return (unsigned)r * ld; } };
struct RowGather { const bf16_t* base; const int* idx; DEVI unsigned offset(int r) const { return (unsigned)(idx[r] & 8191) * 1024u; } };
struct RowClamp { const bf16_t* base; unsigned ld; int r0, rmax; DEVI unsigned offset(int r) const { int q = r0 + r; if (q > rmax) q = rmax; return (unsigned)q * ld; } };
struct RowKv { const bf16_t* base; int n0, isv; DEVI unsigned offset(int r) const { const int n = n0 + r; return (unsigned)((n >> 7) * 256 + isv * 128 + (n & 127)) * 256u; } };
struct GDesc { RowLin rf; WLin wl; unsigned ldw; int nk; };
struct WUp { const float* base; int kv; DEVI const float* operator()(int lane) const { return kv ? base + (lane >> 5) * 256 + ((4 * lane) & 127) : base + 4 * lane; } };
struct GDescUp { RowLin rf; WUp wl; unsigned ldw; };
struct WClamp { const float* base; int col0; DEVI const float* operator()(int lane) const { int c = col0 + 4 * lane; if (c > 700) c = 700; return base + c; } };
struct WLinP { const float* base; DEVI const float* operator()(int lane) const { const int r = 4 * lane; return base + 32 * (r >> 5) + 8 * ((r & 15) >> 2) + 4 * ((r >> 4) & 1); } };
struct WMoe { const float* gate; const float* up; size_t off; DEVI const float* operator()(int lane) const { const int r = 4 * lane, sub = r >> 5;
    const unsigned long long ga = (unsigned long long)gate, ua = (unsigned long long)up, mk = 0ull - (unsigned long long)(sub & 1);
    return (const float*)(ga ^ ((ga ^ ua) & mk)) + off + 32 * (sub >> 1) + 8 * ((r & 15) >> 2) + 4 * ((r >> 4) & 1); } };

DEVI void st_bf16x4(bf16_t* dst, f32x4 v) { u32x2 o; o.x = pk_bf16(v[0], v[1]); o.y = pk_bf16(v[2], v[3]); *(u32x2*)dst = o; }

template <int TM> DEVI void rope_tile(f32x4 (&acc)[TM][4], int row0  , int lane) {
    const int r16 = lane & 15, g = lane >> 4;
#pragma unroll
    for (int mb = 0; mb < TM; ++mb) {
        const int t = (row0 + mb * 16 + r16 - NPR) & 1023;
        const int prow = t >> 6, pcol = t & 63;
#pragma unroll
        for (int r = 0; r < 4; ++r) {
            const int f = 4 * g + r;
            const float c1 = rope_tab[(prow * 16 + f) * 2], s1 = rope_tab[(prow * 16 + f) * 2 + 1];
            const float c2 = rope_tab[(pcol * 16 + f) * 2], s2 = rope_tab[(pcol * 16 + f) * 2 + 1];
            const float a1 = acc[mb][0][r], a2 = acc[mb][1][r], b1 = acc[mb][2][r], b2 = acc[mb][3][r];
            acc[mb][0][r] = a1 * c1 - a2 * s1; acc[mb][1][r] = a2 * c1 + a1 * s1;
            acc[mb][2][r] = b1 * c2 - b2 * s2; acc[mb][3][r] = b2 * c2 + b1 * s2;
        }
        __builtin_amdgcn_sched_barrier(0);
    }
}

template <int BM> struct EpiZ { float* Z; int m0, n0;
    DEVI void operator()(const f32x4 (&acc)[BM / 32][4], int wr, int wc, int lane) const {
        const int r16 = lane & 15, g = lane >> 4;
#pragma unroll
        for (int mb = 0; mb < BM / 32; ++mb) { const int row = m0 + wr * (BM / 2) + mb * 16 + r16;
#pragma unroll
            for (int nb = 0; nb < 4; ++nb) { const int col = n0 + wc * 64 + nb * 16 + 4 * g; if (col < 704) *(f32x4*)(Z + (size_t)row * 704 + col) = acc[mb][nb]; } }
    } };
DEVI void phase_mla_win(const Params& p, int j, lds_t* lds, int bid, int nblk, int tid) {
    constexpr int MT = NTOK / GBM, NU = MT * 3;
    for (int u = xcd_first_unit(bid, nblk); u < NU; u += nblk) {
        const int mt = u % MT, nt = u / MT;
        RowLin rf{p.H + (size_t)mt * GBM * 1024, 1024u};
        RowClamp wf{p.WTI + (size_t)j * 704 * 1024, 1024u, nt * 256, 703};
        EpiZ<GBM> epi{p.Z, mt * GBM, nt * 256};
        gemm_unit_bb3<GBM, true>(lds, rf, wf, 16, epi, tid);
    }
}

DEVI int xcd_slot(int v, int nblk, int lo, int cnt, int& G) {
    if (nblk == 256) { G = 1 << 20; const int i = ((v & 31) - lo) & 31; return i < cnt ? (v >> 5) * cnt + i : (1 << 20); }
    G = nblk; return v; }
DEVI int rot_unit(int v, int off, int G) { int r = v - off; if (r < 0) r += G; return r; }
template <int NPM, int NPN, int GM, int GN>
struct SchedGrid { const bf16_t* A; const bf16_t* B; int v0, G; size_t tileA, tileB;
    static_assert(NPM % GM == 0 && NPN % GN == 0, "unit grid");
    DEVI bool next(int i, pg8::Unit& u) const {
        const int L = __builtin_amdgcn_readfirstlane(i * G + v0); if (L >= NPM * NPN) return false;
        constexpr int NGM = NPM / GM;
        const int g = L / (GM * GN), w = L % (GM * GN); u.pm = (g % NGM) * GM + (w % GM); u.pn = (g / NGM) * GN + (w / GM); u.aux = 0; return true; }
    DEVI void ptrs(const pg8::Unit& u, const char*& a, const char*& b) const { a = (const char*)(A + (size_t)u.pm * tileA); b = (const char*)(B + (size_t)u.pn * tileB); }
};
struct EpiMlaQ { static constexpr bool PERM = false; bf16_t* Q; float scale;
    DEVI void operator()(const f32x4 (&acc)[2][2][4][2], const pg8::Unit& u, int wr, int wc, int fr_in, int fq_in) const {
        int ln = fr_in | (fq_in << 4); asm volatile("" : "+v"(ln));
#pragma unroll
        for (int bj = 0; bj < 2; ++bj) {
            const int c0 = u.pn * 256 + bj * 128 + wc * 32;
            const int gi = (c0 % 192) >> 5;
            const bool rope = (u.pm >= 16) && (gi >= 4);
#pragma unroll
            for (int ai = 0; ai < 2; ++ai)
#pragma unroll
                for (int m = 0; m < 4; ++m) { asm volatile("" : "+v"(ln)); const int fr = ln & 15, fq = ln >> 4;
                    const int row = u.pm * 256 + ai * 128 + wr * 64 + m * 16 + fr;
                    f32x4 x1 = acc[ai][bj][m][0], x2 = acc[ai][bj][m][1];
                    if (rope) { const int t = (row - NPR) & 1023, pos = (gi == 4) ? (t >> 6) : (t & 63);
#pragma unroll
                        for (int j = 0; j < 4; ++j) { const f32x2 cs = *(const f32x2*)(rope_tab + (pos * 16 + 4 * fq + j) * 2);
                            const float a = x1[j], b = x2[j]; x1[j] = a * cs.x - b * cs.y; x2[j] = b * cs.x + a * cs.y; } }
                    bf16_t* dst = Q + (size_t)row * 1536 + c0 + 4 * fq;
                    st_bf16x4(dst, x1 * scale); st_bf16x4(dst + 16, x2 * scale);
                    __builtin_amdgcn_sched_barrier(0); }
        }
    } };
struct EpiMlaK { static constexpr bool PERM = true; bf16_t* KN;
    DEVI void operator()(const f32x4 (&acc)[2][2][4][2], const pg8::Unit& u, int wr, int wc, int fr_in, int fq_in) const {
        int ln = fr_in | (fq_in << 4); asm volatile("" : "+v"(ln));
        const int fr = ln & 15, fq = ln >> 4;
#pragma unroll
        for (int ai = 0; ai < 2; ++ai)
#pragma unroll
            for (int m = 0; m < 4; ++m) { const int row = u.pm * 256 + ai * 128 + wr * 64 + m * 16 + fr;
#pragma unroll
                for (int bj = 0; bj < 2; ++bj) { const f32x4 a = acc[ai][bj][m][0], b = acc[ai][bj][m][1];
                    u32x4 w; w.x = pk_bf16(a[0], a[1]); w.y = pk_bf16(a[2], a[3]); w.z = pk_bf16(b[0], b[1]); w.w = pk_bf16(b[2], b[3]);
                    *(u32x4*)(KN + (size_t)row * 1024 + u.pn * 256 + bj * 128 + wc * 32 + 8 * fq) = w; } }
    } };
struct EpiMlaV { static constexpr bool PERM = true; bf16_t* VTP; bf16_t* VTS;
    DEVI void operator()(const f32x4 (&acc)[2][2][4][2], const pg8::Unit& u, int wr, int wc, int fr_in, int fq_in) const {
        int ln = fr_in | (fq_in << 4); asm volatile("" : "+v"(ln));
        const int fr = ln & 15, fq = ln >> 4;
        const int R0 = u.pn * 256;
        bf16_t* base; unsigned ldk;
        if (R0 < NPR) { base = VTP + (size_t)(R0 >> 8) * (8 * 128 * 256); ldk = 256; }
        else if (R0 < NTOK) { base = VTS + (size_t)((R0 - NPR) >> 10) * (8 * 128 * 1280) + 256 + ((R0 - NPR) & 1023); ldk = 1280; }
        else { base = VTS + (size_t)((R0 - NTOK) >> 8) * (8 * 128 * 1280); ldk = 1280; }
#pragma unroll
        for (int ai = 0; ai < 2; ++ai)
#pragma unroll
            for (int m = 0; m < 4; ++m) { const unsigned hd = (unsigned)((2 * u.pm + ai) * 128 + wr * 64 + m * 16 + fr);
#pragma unroll
                for (int bj = 0; bj < 2; ++bj) { const f32x4 a = acc[ai][bj][m][0], b = acc[ai][bj][m][1];
                    u32x4 w; w.x = pk_bf16(a[0], a[1]); w.y = pk_bf16(a[2], a[3]); w.z = pk_bf16(b[0], b[1]); w.w = pk_bf16(b[2], b[3]);
                    *(u32x4*)(base + (unsigned)(hd * ldk + bj * 128 + wc * 32 + 8 * fq)) = w; }
                __builtin_amdgcn_sched_barrier(0); }
    } };
DEVI void phase_mla_up(const Params& p, int j, lds_t* lds, int bid, int nblk, int tid) {
    int v = xcd_first_unit(bid, nblk);
    const int wid = __builtin_amdgcn_readfirstlane(tid >> 6);
    const bf16_t* wkv = p.WTKV + (size_t)j * 2048 * 256;
    {
        SchedGrid<32, 6, 16, 2> S{p.CQ, p.WTQ + (size_t)j * 1536 * 384, v, nblk, (size_t)256 * 384, (size_t)256 * 384};
        EpiMlaQ E{p.Q, 0.07216878364870322f * LOG2E};
        pg8::gemm_phase(lds, 384, 6, S, E, tid);
    }
    tid = wid * 64 + lane_id_fresh(); asm volatile("" : "+s"(v)); __builtin_amdgcn_sched_barrier(0);
    {
        SchedGrid<36, 4, 4, 4> S{p.CKV, wkv, rot_unit(v, 192 % nblk, nblk), nblk, (size_t)256 * 256, (size_t)512 * 256};
        EpiMlaK E{p.KN};
        pg8::gemm_phase(lds, 256, 4, S, E, tid, 128, 256);
    }
    tid = wid * 64 + lane_id_fresh(); asm volatile("" : "+s"(v)); __builtin_amdgcn_sched_barrier(0);
    {
        SchedGrid<4, 36, 4, 4> S{wkv + (size_t)128 * 256, p.CKV, rot_unit(v, 80 % nblk, nblk), nblk, (size_t)512 * 256, (size_t)256 * 256};
        EpiMlaV E{p.VTP, p.VTS};
        pg8::gemm_phase(lds, 256, 4, S, E, tid, 256, 128);
    }
}

struct SchedOut { const bf16_t* A; const bf16_t* W; int K, v0, G;
    DEVI bool next(int i, pg8::Unit& u) const {
        const int L = i * G + v0; if (L >= 256) return false;
        const int g = L >> 5, w = L & 31; u.aux = g & 1; u.pm = (g >> 1) * 8 + (w & 7); u.pn = w >> 3; return true; }
    DEVI void ptrs(const pg8::Unit& u, const char*& a, const char*& b) const {
        a = (const char*)(A + (size_t)u.pm * 256 * K + (size_t)u.aux * (K >> 1)); b = (const char*)(W + (size_t)u.pn * 256 * K + (size_t)u.aux * (K >> 1)); }
};
struct EpiOut { static constexpr bool PERM = true; bf16_t* Y; const float* mod; int layer;
    DEVI void operator()(const f32x4 (&acc)[2][2][4][2], const pg8::Unit& u, int wr, int wc, int fr_in, int fq_in) const {
        int ln = fr_in | (fq_in << 4); asm volatile("" : "+v"(ln));
        const int fr = ln & 15, fq = ln >> 4;
        const float* gt = mod + ((size_t)(layer * 5 + cond_of_row(u.pm * 256)) * 6 + 2) * 1024;
        bf16_t* Yk = Y + (size_t)u.aux * NTOK * D;
#pragma unroll
        for (int bj = 0; bj < 2; ++bj) { const int col = u.pn * 256 + bj * 128 + wc * 32 + 8 * fq;
            const f32x4 g0 = *(const f32x4*)(gt + col), g1 = *(const f32x4*)(gt + col + 4);
#pragma unroll
            for (int ai = 0; ai < 2; ++ai)
#pragma unroll
                for (int m = 0; m < 4; ++m) { const int row = u.pm * 256 + ai * 128 + wr * 64 + m * 16 + fr;
                    const f32x4 a = acc[ai][bj][m][0] * g0, b = acc[ai][bj][m][1] * g1;
                    u32x4 w; w.x = pk_bf16(a[0], a[1]); w.y = pk_bf16(a[2], a[3]); w.z = pk_bf16(b[0], b[1]); w.w = pk_bf16(b[2], b[3]);
                    *(u32x4*)(Yk + (size_t)row * D + col) = w; } }
    } };
DEVI void phase_out_proj(const Params& p, int layer, const bf16_t* A, int K, const bf16_t* Wt, lds_t* lds, int bid, int nblk, int tid) {
    SchedOut S{A, Wt, K, xcd_first_unit(bid, nblk), nblk};
    EpiOut E{(bf16_t*)p.T, p.mod, layer};
    pg8::gemm_phase(lds, K, K >> 7, S, E, tid);
}

struct SchedGmWin { const bf16_t* H; const bf16_t* W; int v0, G;
    DEVI bool next(int i, pg8::Unit& u) const {
        const int L = i * G + v0; if (L >= 768) return false;
        if (L < 384) { const int g = L >> 5, w = L & 31; u.pm = (g & 3) * 8 + (w & 7); u.pn = (g >> 2) * 4 + (w >> 3); u.aux = 0; }
        else { const int g = (L - 384) >> 5, w = L & 31; u.pm = (g % 3) * 4 + (w & 3); u.pn = (g / 3) * 8 + (w >> 2); u.aux = 1; }
        return true; }
    DEVI void ptrs(const pg8::Unit& u, const char*& a, const char*& b) const {
        if (u.aux == 0) { a = (const char*)(H + (size_t)u.pm * 256 * 1024); b = (const char*)(W + (size_t)u.pn * 256 * 1024); }
        else { a = (const char*)(W + (size_t)(3072 + u.pm * 256) * 1024); b = (const char*)(H + (size_t)u.pn * 256 * 1024); } }
};
struct EpiGmWin { static constexpr bool PERM = true; bf16_t* U; bf16_t* GVT; float* GST;
    DEVI void operator()(const f32x4 (&acc)[2][2][4][2], const pg8::Unit& u, int wr, int wc, int fr_in, int fq_in) const {
        int ln = fr_in | (fq_in << 4); asm volatile("" : "+v"(ln));
        const int fr = ln & 15, fq = ln >> 4;
        const bool vhalf = u.aux != 0;
#pragma unroll
        for (int bj = 0; bj < 2; ++bj) {
            f32x4 s0 = (f32x4){0.f, 0.f, 0.f, 0.f}, s1 = s0, q0 = s0, q1 = s0;
            const int cpos = u.pn * 256 + bj * 128 + wc * 32 + 8 * fq;
#pragma unroll
            for (int ai = 0; ai < 2; ++ai)
#pragma unroll
                for (int m = 0; m < 4; ++m) { const int r = u.pm * 256 + ai * 128 + wr * 64 + m * 16 + fr;
                    f32x4 a = acc[ai][bj][m][0], b = acc[ai][bj][m][1];
#pragma unroll
                    for (int j = 0; j < 4; ++j) { a[j] = gelu_tanh_f(a[j]); b[j] = gelu_tanh_f(b[j]); }
                    u32x4 w; w.x = pk_bf16(a[0], a[1]); w.y = pk_bf16(a[2], a[3]); w.z = pk_bf16(b[0], b[1]); w.w = pk_bf16(b[2], b[3]);
                    if (!vhalf) *(u32x4*)(U + (size_t)r * 3072 + cpos) = w;
                    else { s0 += a; q0 += a * a; s1 += b; q1 += b * b; *(u32x4*)(GVT + ((size_t)(cpos >> 7) * 3072 + r) * 128 + (cpos & 127)) = w; }
                    __builtin_amdgcn_sched_barrier(0); }
            if (vhalf) {
#pragma unroll
                for (int o = 1; o < 16; o <<= 1)
#pragma unroll
                    for (int j = 0; j < 4; ++j) { s0[j] += __shfl_xor(s0[j], o); q0[j] += __shfl_xor(q0[j], o); s1[j] += __shfl_xor(s1[j], o); q1[j] += __shfl_xor(q1[j], o); }
                if (fr == 0) { const int part = u.pm * 2 + wr;
#pragma unroll
                    for (int j = 0; j < 4; ++j) { f32x2 w2; w2.x = s0[j]; w2.y = q0[j]; *(f32x2*)(GST + ((size_t)(cpos + j) * 24 + part) * 2) = w2;
                                                  f32x2 w3; w3.x = s1[j]; w3.y = q1[j]; *(f32x2*)(GST + ((size_t)(cpos + 4 + j) * 24 + part) * 2) = w3; } }
            }
            __builtin_amdgcn_sched_barrier(0);
        }
    } };
DEVI void phase_gm_win(const Params& p, lds_t* lds, int bid, int nblk, int tid) {
    SchedGmWin S{p.H, p.WTGI, xcd_first_unit(bid, nblk), nblk};
    EpiGmWin E{p.U, p.GVT, p.GST};
    pg8::gemm_phase(lds, 1024, 16, S, E, tid);
}

struct EpiSwaQK { static constexpr bool PERM = false; bf16_t* Q; bf16_t* SK; float* out; float scale;
    DEVI void operator()(const f32x4 (&acc)[2][2][4][2], const pg8::Unit& u, int wr, int wc, int fr_in, int fq_in) const {
        int ln = fr_in | (fq_in << 4); asm volatile("" : "+v"(ln));
        const bool isk = (u.pn == 4), rope = (u.pm >= 16), kout = isk && !rope;
        bf16_t* dstb = isk ? SK : Q + u.pn * 256; const unsigned ld = isk ? 256u : 1024u; const float sc = isk ? 1.f : scale;
        const int gi = wc & 1;
#pragma unroll
        for (int bj = 0; bj < 2; ++bj) {
            const int c0 = bj * 128 + wc * 32;
#pragma unroll
            for (int ai = 0; ai < 2; ++ai)
#pragma unroll
                for (int m = 0; m < 4; ++m) { asm volatile("" : "+v"(ln)); const int fr = ln & 15, fq = ln >> 4;
                    const int row = u.pm * 256 + ai * 128 + wr * 64 + m * 16 + fr;
                    f32x4 x1 = acc[ai][bj][m][0], x2 = acc[ai][bj][m][1];
                    if (rope) { const int t = (row - NPR) & 1023, pos = gi ? (t & 63) : (t >> 6);
#pragma unroll
                        for (int j = 0; j < 4; ++j) { const f32x2 cs = *(const f32x2*)(rope_tab + (pos * 16 + 4 * fq + j) * 2);
                            const float a = x1[j], b = x2[j]; x1[j] = a * cs.x - b * cs.y; x2[j] = b * cs.x + a * cs.y; } }
                    const unsigned o = (unsigned)row * ld + c0 + 4 * fq;
                    if (kout) { float* po = out + OUT_SK + (size_t)row * 256 + c0 + 4 * fq; *(f32x4*)po = x1; *(f32x4*)(po + 16) = x2; }
                    st_bf16x4(dstb + o, x1 * sc); st_bf16x4(dstb + o + 16, x2 * sc);
                    __builtin_amdgcn_sched_barrier(0); }
        }
    } };
struct EpiSwaV { static constexpr bool PERM = true; bf16_t* SVTP; bf16_t* SVTS; float* out;
    DEVI void operator()(const f32x4 (&acc)[2][2][4][2], const pg8::Unit& u, int wr, int wc, int fr_in, int fq_in) const {
        int ln = fr_in | (fq_in << 4); asm volatile("" : "+v"(ln));
        const int fr = ln & 15, fq = ln >> 4;
        const int R0 = u.pn * 256;
        bf16_t* base; unsigned ldk;
        if (R0 < NPR) { base = SVTP + (size_t)(R0 >> 8) * (4 * 64 * 256); ldk = 256; }
        else { base = SVTS + (size_t)((R0 - NPR) >> 10) * (4 * 64 * 1280) + 256 + ((R0 - NPR) & 1023); ldk = 1280; }
#pragma unroll
        for (int ai = 0; ai < 2; ++ai)
#pragma unroll
            for (int m = 0; m < 4; ++m) { const unsigned r = (unsigned)(ai * 128 + wr * 64 + m * 16 + fr);
#pragma unroll
                for (int bj = 0; bj < 2; ++bj) { const f32x4 a = acc[ai][bj][m][0], b = acc[ai][bj][m][1];
                    const unsigned c = (unsigned)(bj * 128 + wc * 32 + 8 * fq);
                    u32x4 w; w.x = pk_bf16(a[0], a[1]); w.y = pk_bf16(a[2], a[3]); w.z = pk_bf16(b[0], b[1]); w.w = pk_bf16(b[2], b[3]);
                    *(u32x4*)(base + (r * ldk + c)) = w;
                    if (R0 < NPR) { float* po = out + OUT_SV + (size_t)(R0 + c) * 256 + r;
#pragma unroll
                        for (int i = 0; i < 4; ++i) { po[i * 256] = a[i]; po[(i + 4) * 256] = b[i]; } } }
                __builtin_amdgcn_sched_barrier(0); }
    } };
DEVI void phase_swa_qkv(const Params& p, lds_t* lds, int bid, int nblk, int tid) {
    int v = xcd_first_unit(bid, nblk);
    const int wid = __builtin_amdgcn_readfirstlane(tid >> 6);
    {   int G; const int v0 = xcd_slot(v, nblk, 0, 20, G);
        SchedGrid<32, 5, 4, 5> S{p.H, p.WTSQ, v0, G, (size_t)256 * 1024, (size_t)256 * 1024};
        EpiSwaQK E{p.Q, p.SK, p.out, 0.125f * LOG2E};
        pg8::gemm_phase(lds, 1024, 16, S, E, tid);
    }
    tid = wid * 64 + lane_id_fresh(); asm volatile("" : "+s"(v)); __builtin_amdgcn_sched_barrier(0);
    {   int G; const int v0 = xcd_slot(v, nblk, 20, 4, G);
        SchedGrid<1, 32, 1, 4> S{p.WTSQ + (size_t)1280 * 1024, p.H, v0, G, (size_t)256 * 1024, (size_t)256 * 1024};
        EpiSwaV E{p.SVTP, p.SVTS, p.out};
        pg8::gemm_phase(lds, 1024, 16, S, E, tid);
    }
}

template <int BM> struct EpiHid { bf16_t* HID; int e, mt, nt;
    DEVI void operator()(const f32x4 (&acc)[BM / 32][4], int wr, int wc, int lane) const {
        const int r16 = lane & 15, g = lane >> 4;
#pragma unroll
        for (int mb = 0; mb < BM / 32; ++mb) { const size_t row = (size_t)e * 1024 + mt * BM + wr * (BM / 2) + mb * 16 + r16;
            u32x4 w;
            { const f32x4 gv = acc[mb][0], uv = acc[mb][2]; w.x = pk_bf16(silu_f(gv[0]) * uv[0], silu_f(gv[1]) * uv[1]); w.y = pk_bf16(silu_f(gv[2]) * uv[2], silu_f(gv[3]) * uv[3]); }
            { const f32x4 gv = acc[mb][1], uv = acc[mb][3]; w.z = pk_bf16(silu_f(gv[0]) * uv[0], silu_f(gv[1]) * uv[1]); w.w = pk_bf16(silu_f(gv[2]) * uv[2], silu_f(gv[3]) * uv[3]); }
            *(u32x4*)(HID + row * 2048 + nt * 128 + wc * 32 + 8 * g) = w; }
    } };
template <int DBG = 0> DEVI void phase_moe_up(const Params& p, int layer, lds_t* lds, int bid, int nblk, int tid) {
    constexpr int MT = 1024 / GBM2, NU = 16 * MT * 16;
#define DEC_MU(u_, rf_, wf_) do { const int e_ = (u_) / (MT * 16), w_ = (u_) % (MT * 16), mt_ = w_ % MT, nt_ = w_ / MT; \
        rf_ = RowGather{p.H2, p.IDX + e_ * 1024 + mt_ * GBM2}; wf_ = WMoe{p.moe_w_gate, p.moe_w_up, ((size_t)layer * 16 + e_) * 1024 * 2048 + nt_ * 128}; } while (0)
    int u = xcd_first_unit(bid, nblk);
    RowGather rf, rfn; WMoe wf, wfn;
    for (; u < NU; u += nblk) {
        const int e = u / (MT * 16), w = u % (MT * 16), mt = w % MT, nt = w / MT;
        DEC_MU(u, rf, wf);
        EpiHid<GBM2> epi{p.HID, e, mt, nt};
        gemm_unit<GBM2, true>(lds, rf, wf, 2048u, 16, epi, tid);
    }
#undef DEC_MU
}
template <int BM> struct EpiYe { bf16_t* YE; const float* GATEV; int e, mt, nt;
    DEVI void operator()(const f32x4 (&acc)[BM / 32][4], int wr, int wc, int lane) const {
        const int r16 = lane & 15, g = lane >> 4;
#pragma unroll
        for (int mb = 0; mb < BM / 32; ++mb) { const size_t row = (size_t)e * 1024 + mt * BM + wr * (BM / 2) + mb * 16 + r16;
            const float gt = GATEV[row];
#pragma unroll
            for (int np = 0; np < 2; ++np) {
                const f32x4 a = acc[mb][2 * np] * gt, b = acc[mb][2 * np + 1] * gt;
                u32x4 w; w.x = pk_bf16(a[0], a[1]); w.y = pk_bf16(a[2], a[3]); w.z = pk_bf16(b[0], b[1]); w.w = pk_bf16(b[2], b[3]);
                *(u32x4*)(YE + row * 1024 + nt * 256 + wc * 64 + 32 * np + 8 * g) = w; } }
    } };
DEVI void phase_moe_down(const Params& p, int layer, lds_t* lds, int bid, int nblk, int tid) {
    constexpr int MT = 1024 / GBM2, NU = 16 * MT * 4;
#define DEC_MD(u_, d_) do { const int e_ = (u_) / (MT * 4), w_ = (u_) % (MT * 4), mt_ = w_ % MT, nt_ = w_ / MT; \
        d_.rf = RowLin{p.HID + ((size_t)e_ * 1024 + mt_ * GBM2) * 2048, 2048u}; d_.wl = WLin{p.moe_w_down + ((size_t)layer * 16 + e_) * 2048 * 1024 + nt_ * 256}; d_.ldw = 1024u; d_.nk = 32; } while (0)
    int u = xcd_first_unit(bid, nblk);
    GDesc d, dn;
    for (; u < NU; u += nblk) {
        const int e = u / (MT * 4), w = u % (MT * 4), mt = w % MT, nt = w / MT;
        DEC_MD(u, d);
        EpiYe<GBM2> epi{p.YE, p.GATEV, e, mt, nt};
        gemm_unit<GBM2, true>(lds, d.rf, WLinP{d.wl.base}, d.ldw, 32, epi, tid);
    }
#undef DEC_MD
}

template <int DK, int DV> struct AttnCfg {
    static constexpr int CPK = DK / 8;
    static constexpr int KT_BYTES = 64 * DK * 2;
    static constexpr int VT_BYTES = DV * 128;
    static constexpr int STAGE = KT_BYTES + VT_BYTES;
    static constexpr int NKC = 64 * CPK / NTHREADS;
    static constexpr int NVC = DV * 8 / NTHREADS;
};
DEVI int kswz(int key) { return ((key >> 1) & 1) | (((key >> 3) & 3) << 1); }

struct AttnSeg { int n_ctx, ctx_krow0, ctx_vcol0, n_loc, loc_krow0, loc_vcol0, loc_kpos0; };

template <int DK, int DV, bool WINDOW, class KSrc>
DEVI void attn_unit(lds_t* lds, const bf16_t* Qp, int ldq, const KSrc& ks, const bf16_t* vt, int ldv, const AttnSeg sg, int qpos0,
                    float sink, bool has_sink, bf16_t* Op, int ldo, int tid) {
    typedef AttnCfg<DK, DV> C;
    const int lane = tid & 63, wave = tid >> 6, r16 = lane & 15, g = lane >> 4;
    const int ntile = sg.n_ctx + sg.n_loc;
    bf16x8 qf[DK / 32];
    {
        const bf16_t* qr = Qp + (size_t)(wave * 16 + r16) * ldq + 8 * g;
#pragma unroll
        for (int s = 0; s < DK / 32; ++s) qf[s] = *(const bf16x8*)(qr + 32 * s);
    }
    u32x4 kreg[C::NKC], vreg[C::NVC];
#define TILE_LOAD(jj) do { const int j_ = (jj); int krow, vcol; \
        if (j_ < sg.n_ctx) { krow = sg.ctx_krow0 + 64 * j_; vcol = sg.ctx_vcol0 + 64 * j_; } \
        else { krow = sg.loc_krow0 + 64 * (j_ - sg.n_ctx); vcol = sg.loc_vcol0 + 64 * (j_ - sg.n_ctx); } \
        _Pragma("unroll") for (int i = 0; i < C::NKC; ++i) { const int c = tid + NTHREADS * i, key = c / C::CPK, ch = c % C::CPK; kreg[i] = *(const u32x4*)ks(krow + key, ch); } \
        _Pragma("unroll") for (int i = 0; i < C::NVC; ++i) { const int c = tid + NTHREADS * i, dv = c >> 3, ch = c & 7; vreg[i] = *(const u32x4*)(vt + (size_t)dv * ldv + vcol + ch * 8); } } while (0)
#define TILE_STORE(stp) do { lds_t* st_ = (stp); \
        _Pragma("unroll") for (int i = 0; i < C::NKC; ++i) { const int c = tid + NTHREADS * i, key = c / C::CPK, ch = c % C::CPK; lds_st128(st_ + key * (DK * 2) + ((ch ^ kswz(key)) << 4), kreg[i]); } \
        _Pragma("unroll") for (int i = 0; i < C::NVC; ++i) { const int c = tid + NTHREADS * i, dv = c >> 3, ch = c & 7; lds_st128(st_ + C::KT_BYTES + img_off(dv, ch), vreg[i]); } } while (0)
    f32x4 o[DV / 16];
#pragma unroll
    for (int i = 0; i < DV / 16; ++i) o[i] = (f32x4){0.f, 0.f, 0.f, 0.f};
    float m = has_sink ? sink : -1.0e30f;
    float l = (has_sink && g == 0) ? 1.0f : 0.0f;
    const int qpos = qpos0 + wave * 16 + r16;
    const int kbyte = (8 * (r16 >> 2) + (r16 & 3)) * (DK * 2);
    const int ksw0 = ((r16 >> 1) & 1) | ((r16 >> 2) << 1);
    const int ke0 = (g ^ ksw0) << 4, ke1 = ((4 + g) ^ ksw0) << 4;
    const int vc0 = g ^ ((r16 >> 1) & 7);

    TILE_LOAD(0);
    __syncthreads();
    TILE_STORE(lds);
    if (ntile > 1) TILE_LOAD(1);
    for (int j = 0; j < ntile; ++j) {
        __syncthreads();
        lds_t* cur = lds + (j & 1) * C::STAGE;
        if (j + 1 < ntile) { TILE_STORE(lds + ((j + 1) & 1) * C::STAGE); if (j + 2 < ntile) TILE_LOAD(j + 2); }
        const bool masked = WINDOW && (j >= sg.n_ctx);
        const int kpos0 = sg.loc_kpos0 + 64 * (j - sg.n_ctx);
        if (masked) {
            const int qlo = qpos0 + wave * 16;
            if (kpos0 > qlo + 15 + 128 || kpos0 + 63 < qlo - 128) continue;
        }
        f32x4 s[4];
        {
            lds_t* kb0 = cur + kbyte + ke0;
            lds_t* kb1 = cur + kbyte + ke1;
#pragma unroll
            for (int grp = 0; grp < 2; ++grp)
#pragma unroll
                for (int b = 0; b < 2; ++b) {
                    f32x4 a = (f32x4){0.f, 0.f, 0.f, 0.f};
#pragma unroll
                    for (int st = 0; st < DK / 32; ++st) {
                        const bf16x8 kf = lds_ld128(((st & 1) ? kb1 : kb0) + (32 * grp + 4 * b) * (DK * 2) + (st >> 1) * 128);
                        a = __builtin_amdgcn_mfma_f32_16x16x32_bf16(kf, qf[st], a, 0, 0, 0);
                    }
                    s[grp * 2 + b] = a;
                }
        }
        if (masked) {
#pragma unroll
            for (int grp = 0; grp < 2; ++grp)
#pragma unroll
                for (int b = 0; b < 2; ++b)
#pragma unroll
                    for (int r = 0; r < 4; ++r) {
                        const int kp = kpos0 + 32 * grp + 8 * g + 4 * b + r;
                        const int d = qpos - kp;
                        if (d > 128 || d < -128) s[grp * 2 + b][r] = -1.0e30f;
                    }
        }
        float mx = fmaxf(fmaxf(fmaxf(s[0][0], s[0][1]), fmaxf(s[0][2], s[0][3])), fmaxf(fmaxf(s[1][0], s[1][1]), fmaxf(s[1][2], s[1][3])));
        mx = fmaxf(mx, fmaxf(fmaxf(fmaxf(s[2][0], s[2][1]), fmaxf(s[2][2], s[2][3])), fmaxf(fmaxf(s[3][0], s[3][1]), fmaxf(s[3][2], s[3][3]))));
        mx = fmaxf(mx, __shfl_xor(mx, 16)); mx = fmaxf(mx, __shfl_xor(mx, 32));
        const float mn = fmaxf(m, mx);
        const float alpha = fexp2(m - mn);
        m = mn;
        float ps = 0.f;
#pragma unroll
        for (int i = 0; i < 4; ++i)
#pragma unroll
            for (int r = 0; r < 4; ++r) { const float pv = fexp2(s[i][r] - mn); s[i][r] = pv; ps += pv; }
        l = l * alpha + ps;
#pragma unroll
        for (int i = 0; i < DV / 16; ++i) o[i] = o[i] * alpha;
#pragma unroll
        for (int grp = 0; grp < 2; ++grp) {
            u32x4 pw;
            pw.x = pk_bf16(s[grp * 2][0], s[grp * 2][1]); pw.y = pk_bf16(s[grp * 2][2], s[grp * 2][3]);
            pw.z = pk_bf16(s[grp * 2 + 1][0], s[grp * 2 + 1][1]); pw.w = pk_bf16(s[grp * 2 + 1][2], s[grp * 2 + 1][3]);
            bf16x8 pf; __builtin_memcpy(&pf, &pw, 16);
#pragma unroll
            for (int dvb = 0; dvb < DV / 16; ++dvb) {
                const bf16x8 vf = lds_ld128(cur + C::KT_BYTES + r16 * 128 + dvb * 2048 + (((vc0 ^ (4 * grp)) ^ (dvb & 1)) << 4));
                o[dvb] = __builtin_amdgcn_mfma_f32_16x16x32_bf16(vf, pf, o[dvb], 0, 0, 0);
            }
        }
    }
    l += __shfl_xor(l, 16); l += __shfl_xor(l, 32);
    const float inv = frcp(l);
    bf16_t* orow = Op + (size_t)(wave * 16 + r16) * ldo + 4 * g;
#pragma unroll
    for (int dvb = 0; dvb < DV / 16; ++dvb) st_bf16x4(orow + dvb * 16, o[dvb] * inv);
}

struct KSrcMla { const bf16_t* KN; const bf16_t* KPE; int h;
    DEVI const bf16_t* operator()(int krow, int ch) const { return ch < 16 ? KN + (size_t)krow * 1024 + h * 128 + ch * 8 : KPE + (size_t)krow * 64 + (ch - 16) * 8; } };
struct KSrcSwa { const bf16_t* SK; int kvh;
    DEVI const bf16_t* operator()(int krow, int ch) const { return SK + (size_t)krow * 256 + kvh * 64 + ch * 8; } };

DEVI void phase_mla_attn(const Params& p, lds_t* lds, int bid, int nblk, int tid) {
    for (int u = xcd_first_unit(bid, nblk); u < 512; u += nblk) {
        if (u < 256) {
            const int b = u >> 6, h = (u >> 3) & 7, qt = u & 7;
            const int qrow0 = NPR + b * 1024 + qt * 128;
            KSrcMla ks{p.KN, p.KPE, h};
            AttnSeg sg{4, NTOK + b * 256, 0, 16, NPR + b * 1024, 256, 0};
            attn_unit<192, 128, false>(lds, p.Q + (size_t)qrow0 * 1536 + h * 192, 1536, ks, p.VTS + (size_t)(b * 8 + h) * 128 * 1280, 1280, sg, 0, 0.f, false,
                                       p.O + (size_t)qrow0 * 1024 + h * 128, 1024, tid);
        } else {
            const int v = u - 256, b = v >> 4, h = (v >> 1) & 7, qt = v & 1;
            const int qrow0 = b * 256 + qt * 128;
            KSrcMla ks{p.KN, p.KPE, h};
            AttnSeg sg{0, 0, 0, 4, b * 256, 0, 0};
            attn_unit<192, 128, false>(lds, p.Q + (size_t)qrow0 * 1536 + h * 192, 1536, ks, p.VTP + (size_t)(b * 8 + h) * 128 * 256, 256, sg, 0, 0.f, false,
                                       p.O + (size_t)qrow0 * 1024 + h * 128, 1024, tid);
        }
    }
}
DEVI void phase_swa_attn(const Params& p, lds_t* lds, int bid, int nblk, int tid) {
    for (int u = xcd_first_unit(bid, nblk); u < 1024; u += nblk) {
        const int w = u >> 8, idx = ((u >> 9) << 8) | (u & 255);
        if ((w & 1) == 0) {
            const int b = idx >> 7, hq = (idx >> 3) & 15, qt = idx & 7, kvh = hq >> 2;
            const int qs = qt * 128, qrow0 = NPR + b * 1024 + qs;
            const int lo = qs >= 128 ? qs - 128 : 0, hi = qs + 256 <= 1024 ? qs + 256 : 1024;
            KSrcSwa ks{p.SK, kvh};
            AttnSeg sg{4, NTOK + b * 256, 0, (hi - lo) >> 6, NPR + b * 1024 + lo, 256 + lo, lo};
            attn_unit<64, 64, true>(lds, p.Q + (size_t)qrow0 * 1024 + hq * 64, 1024, ks, p.SVTS + (size_t)(b * 4 + kvh) * 64 * 1280, 1280, sg, qs,
                                    p.swa_sink[hq] * LOG2E, true, p.O + (size_t)qrow0 * 1024 + hq * 64, 1024, tid);
        } else {
            const int b = idx >> 5, hq = (idx >> 1) & 15, qt = idx & 1, kvh = hq >> 2;
            const int qrow0 = b * 256 + qt * 128;
            KSrcSwa ks{p.SK, kvh};
            AttnSeg sg{0, 0, 0, 4, b * 256, 0, 0};
            attn_unit<64, 64, false>(lds, p.Q + (size_t)qrow0 * 1024 + hq * 64, 1024, ks, p.SVTP + (size_t)(b * 4 + kvh) * 64 * 256, 256, sg, 0,
                                     p.swa_sink[hq] * LOG2E, true, p.O + (size_t)qrow0 * 1024 + hq * 64, 1024, tid);
        }
    }
}

DEVI void phase_gm_spatial(const Params& p, lds_t* lds, int bid, int nblk, int tid) {
    const int lane = tid & 63, wave = tid >> 6, r16 = lane & 15, g = lane >> 4, wr = wave >> 2, wc = wave & 3;
    lds_t* aimg = lds;
    lds_t* vimg = lds + 32768;
    LAS float* mean = (LAS float*)(lds + 65536);
    LAS float* rstd = mean + 128;
    LAS float* biasp = rstd + 128;
    LAS float* bpart = biasp + 128;
    for (int u = xcd_first_unit(bid, nblk); u < 512; u += nblk) {
        const int chunk = u >> 3, grp = u & 7;
        __syncthreads();
        if (tid < 128) {
            const float* gs = p.GST + (size_t)(chunk * 128 + tid) * 48;
            float s = 0.f, q = 0.f;
            for (int i = 0; i < 24; ++i) { s += gs[2 * i]; q += gs[2 * i + 1]; }
            const float mu = s * (1.0f / 3072.0f);
            const float var = q * (1.0f / 3072.0f) - mu * mu;
            mean[tid] = mu; rstd[tid] = rsqrtf(fmaxf(var, 0.f) + EPS_F);
        }
        __syncthreads();
        {
            const int n = tid >> 2, mq = tid & 3;
            const float* ws = p.gm_w_s + ((size_t)grp * 128 + n) * 128 + mq * 32;
            float bp = 0.f;
#pragma unroll
            for (int c4 = 0; c4 < 4; ++c4) {
                const f32x4 w0 = *(const f32x4*)(ws + c4 * 8), w1 = *(const f32x4*)(ws + c4 * 8 + 4);
                const int m0 = mq * 32 + c4 * 8;
                float a[8];
#pragma unroll
                for (int i = 0; i < 4; ++i) { a[i] = w0[i] * rstd[m0 + i]; a[4 + i] = w1[i] * rstd[m0 + 4 + i]; }
                u32x4 v; v.x = pk_bf16(a[0], a[1]); v.y = pk_bf16(a[2], a[3]); v.z = pk_bf16(a[4], a[5]); v.w = pk_bf16(a[6], a[7]);
#pragma unroll
                for (int i = 0; i < 4; ++i) { const unsigned wd = i == 0 ? v.x : i == 1 ? v.y : i == 2 ? v.z : v.w; bp += bf_lo(wd) * mean[m0 + 2 * i] + bf_hi(wd) * mean[m0 + 2 * i + 1]; }
                const int kc = m0 >> 3;
                lds_st128(aimg + (kc >> 3) * 16384 + img_off(n, kc & 7), v);
            }
            bpart[mq * 128 + n] = bp;
        }
        __syncthreads();
        if (tid < 128) biasp[tid] = bpart[tid] + bpart[128 + tid] + bpart[256 + tid] + bpart[384 + tid];
        for (int cs = 0; cs < 3; ++cs) {
            __syncthreads();
            {
                const bf16_t* src = p.GVT + ((size_t)chunk * 3072 + grp * 384 + cs * 128) * 128;
#pragma unroll
                for (int i = 0; i < 4; ++i) { const int c = tid + NTHREADS * i, row = c >> 4, kc = c & 15;
                    const u32x4 v = *(const u32x4*)(src + (size_t)row * 128 + kc * 8);
                    lds_st128(vimg + (kc >> 3) * 16384 + img_off(row, kc & 7), v); }
            }
            __syncthreads();
            f32x4 acc[4][2];
#pragma unroll
            for (int i = 0; i < 4; ++i) { acc[i][0] = (f32x4){0.f, 0.f, 0.f, 0.f}; acc[i][1] = acc[i][0]; }
#pragma unroll
            for (int kh = 0; kh < 2; ++kh)
#pragma unroll
                for (int s = 0; s < 2; ++s) {
                    bf16x8 af[4], vf[2];
#pragma unroll
                    for (int mb = 0; mb < 4; ++mb) af[mb] = lds_ld128(aimg + kh * 16384 + img_off(wr * 64 + mb * 16 + r16, 4 * s + g));
#pragma unroll
                    for (int nb = 0; nb < 2; ++nb) vf[nb] = lds_ld128(vimg + kh * 16384 + img_off(wc * 32 + nb * 16 + r16, 4 * s + g));
#pragma unroll
                    for (int mb = 0; mb < 4; ++mb)
#pragma unroll
                        for (int nb = 0; nb < 2; ++nb) acc[mb][nb] = __builtin_amdgcn_mfma_f32_16x16x32_bf16(vf[nb], af[mb], acc[mb][nb], 0, 0, 0);
                }
#pragma unroll
            for (int mb = 0; mb < 4; ++mb) {
                const int n = wr * 64 + mb * 16 + r16;
                const float bp = biasp[n], bs = p.gm_b_s[grp * 128 + n];
                const size_t row = (size_t)chunk * 128 + n;
#pragma unroll
                for (int nb = 0; nb < 2; ++nb) {
                    const int col = grp * 384 + cs * 128 + wc * 32 + nb * 16 + 4 * g;
                    const f32x4 gn = *(const f32x4*)(p.gm_v_gain + col);
                    const u32x2 uw = *(const u32x2*)(p.U + row * 3072 + col);
                    f32x4 t;
                    t[0] = bf_lo(uw.x) * (gn[0] * (acc[mb][nb][0] - bp) + bs);
                    t[1] = bf_hi(uw.x) * (gn[1] * (acc[mb][nb][1] - bp) + bs);
                    t[2] = bf_lo(uw.y) * (gn[2] * (acc[mb][nb][2] - bp) + bs);
                    t[3] = bf_hi(uw.y) * (gn[3] * (acc[mb][nb][3] - bp) + bs);
                    st_bf16x4(p.TT + row * 3072 + col, t);
                }
            }
        }
    }
}

constexpr int N_PHASES = 2 + 10 * DEPTH;
__global__ void __launch_bounds__(NTHREADS, 2) fwd_kernel(Params p_kernarg) {
    extern __shared__ __attribute__((aligned(16))) unsigned char smem[];
    lds_t* lds = (lds_t*)smem;
    const int tid0 = threadIdx.x, bid0 = blockIdx.x, nblk0 = gridDim.x;
    const int wave0 = __builtin_amdgcn_readfirstlane(tid0 >> 6);
    volatile LAS unsigned* misc = (volatile LAS unsigned*)(lds + LDS_MAIN);
    if (tid0 == 0) { misc[0] = 0u; misc[1] = 0u; misc[2] = 0u; misc[3] = 0u; }
    __syncthreads();
    typedef const __attribute__((address_space(4))) Params* kparams_t;
    kparams_t pp = (kparams_t)__builtin_amdgcn_kernarg_segment_ptr();
    const int lo = (int)pp->ph_lo, hi = (int)pp->ph_hi;
    XcdBarrier bar; bar.bar = pp->bar; bar.x = 0; bar.st = misc;
    if (hi - lo > 1) bar = xcd_barrier_post(bar.bar, misc);
#define IN(k) (lo <= (k) && (k) < hi)
#ifndef REP_MASK
#define REP_MASK 0
#endif
#ifndef REP_N
#define REP_N 1
#endif
#define RUN(k, knext, cls, body) do { if (IN(k)) { { asm volatile("" : "+s"(pp)); Params p; __builtin_memcpy(&p, pp, sizeof(Params)); \
        unsigned zz = 0u; asm volatile("" : "+s"(zz)); int tid = wave0 * 64 + (int)__builtin_amdgcn_mbcnt_hi(~0u, __builtin_amdgcn_mbcnt_lo(~0u, zz)), bid = bid0, nblk = nblk0; asm volatile("" : "+v"(tid)); asm volatile("" : "+s"(bid), "+s"(nblk)); body; \
        if ((REP_MASK) & (cls)) { _Pragma("unroll 1") for (int rr = 0; rr < REP_N; ++rr) { asm volatile("" : "+v"(tid)); body; } } } if (IN(knext)) { xcd_barrier(bar); if ((REP_MASK) & 8192) xcd_barrier(bar); } } } while (0)
    RUN(0, 1, 64, { phase_modulation(p, lds, bid, nblk, tid); phase_wconv(p, lds, bid, nblk, tid); });
    RUN(1, 2, 512, phase_prep(p, bid, nblk, tid));
#pragma unroll 1
    for (int li = 0; li < DEPTH; ++li) {
        const int kind = li % 3, j = li / 3, base = 2 + 10 * li;
        if (kind == 0) {
            RUN(base + 0, base + 1, 32, phase_mla_win(p, j, lds, bid, nblk, tid));
            RUN(base + 1, base + 2, 1024, phase_mla_norm(p, j, bid, nblk, tid));
            RUN(base + 2, base + 3, 32768, phase_mla_up(p, j, lds, bid, nblk, tid));
            RUN(base + 3, base + 4, 16, phase_mla_attn(p, lds, bid, nblk, tid));
            RUN(base + 4, base + 5, 8, phase_out_proj(p, li, p.O, 1024, p.WTO + (size_t)j * 1024 * 1024, lds, bid, nblk, tid));
        } else if (kind == 1) {
            RUN(base + 0, base + 1, 4, phase_gm_win(p, lds, bid, nblk, tid));
            RUN(base + 1, base + 2, 128, phase_gm_spatial(p, lds, bid, nblk, tid));
            RUN(base + 2, base + 5, 8, phase_out_proj(p, li, p.TT, 3072, p.WTGO, lds, bid, nblk, tid));
        } else {
            RUN(base + 0, base + 1, 16384, phase_swa_qkv(p, lds, bid, nblk, tid));
            RUN(base + 1, base + 2, 16, phase_swa_attn(p, lds, bid, nblk, tid));
            RUN(base + 2, base + 5, 8, phase_out_proj(p, li, p.O, 1024, p.WTSO, lds, bid, nblk, tid));
        }
        RUN(base + 5, base + 6, 2048, phase_ln_a(p, li, lds, bid, nblk, tid));
        RUN(base + 6, base + 7, 256, phase_topk(p, lds, bid, nblk, tid));
        RUN(base + 7, base + 8, 1, phase_moe_up(p, li, lds, bid, nblk, tid));
        RUN(base + 8, base + 9, 2, phase_moe_down(p, li, lds, bid, nblk, tid));
        RUN(base + 9, base + 10, 4096, phase_ln_b(p, li, bid, nblk, tid));
    }
#undef IN
#undef RUN
}

#ifdef PROBE_V
__global__ void __launch_bounds__(NTHREADS, 2) probe_kernel(Params p) {
    extern __shared__ __attribute__((aligned(16))) unsigned char smem[];
    lds_t* lds = (lds_t*)smem;
    const int tid = threadIdx.x, bid = blockIdx.x, nblk = gridDim.x;
#if PROBE_V < 1000
    if (PROBE_V == 1) phase_mla_attn(p, lds, bid, nblk, tid);
    else if (PROBE_V == 2) phase_swa_attn(p, lds, bid, nblk, tid);
    else if (PROBE_V == 3) phase_gm_spatial(p, lds, bid, nblk, tid);
    else if (PROBE_V == 4) phase_ln_a(p, 3, lds, bid, nblk, tid);
    else if (PROBE_V == 5) phase_mla_up(p, 1, lds, bid, nblk, tid);
    else phase_moe_up<0>(p, 0, lds, bid, nblk, tid);
#else
    const int lane = tid & 63, wave = tid >> 6;
    const int u0 = xcd_first_unit(bid, nblk);
    f32x4 acc = (f32x4){0.f, 0.f, 0.f, 0.f};
    for (int u = u0; u < 1024; u += nblk) {
        const int e = u >> 6, w = u & 63, nt = w >> 2;
        const float* wp = p.moe_w_gate + (size_t)e * 1024 * 2048 + nt * 128 + 4 * lane + (size_t)(8 * wave) * 2048;
        const bf16_t* xp = p.H2 + (size_t)((u * 37 + wave * 8 + (lane >> 3)) & 8191) * 1024 + (lane & 7) * 8;
#pragma unroll 2
        for (int kt = 0; kt < 16; ++kt) {
            const float* q = wp + (size_t)((PROBE_V & 1) ? 0 : ((PROBE_V & 4) ? ((kt + (w & 3) * ((PROBE_V >> 4) & 7)) & 15) : ((PROBE_V & 8) ? (kt & 3) : kt))) * 64 * 2048;
#pragma unroll
            for (int i = 0; i < 8; ++i) acc += *(const f32x4*)(q + (size_t)i * 2048);
            if (PROBE_V & 2) {
#pragma unroll
                for (int j = 0; j < 4; ++j) { const u32x4 x = *(const u32x4*)(xp + (size_t)j * 64 * 1024 + kt * 64); acc[0] += __uint_as_float(x.x & 0x3f800000u); }
            }
        }
    }
    if (acc[0] + acc[1] + acc[2] + acc[3] == 12345.678f) p.GST[tid] = acc[0];
#endif
}
#endif
extern "C" void kernel_launch(void* const* d_in, const int* in_sizes, int n_in, void* d_out, int out_size, void* d_ws, size_t ws_size, hipStream_t stream) {
    static int grid = 0;
    if (grid == 0) {
        int dev = 0, cus = 0, per_cu = 0;
        if (hipGetDevice(&dev) != hipSuccess || hipDeviceGetAttribute(&cus, hipDeviceAttributeMultiprocessorCount, dev) != hipSuccess) { fprintf(stderr, "kernel_launch: device query failed\n"); grid = -1; return; }
        if (hipFuncSetAttribute((const void*)fwd_kernel, hipFuncAttributeMaxDynamicSharedMemorySize, LDS_BYTES) != hipSuccess) { fprintf(stderr, "kernel_launch: hipFuncSetAttribute failed\n"); grid = -1; return; }
        if (hipOccupancyMaxActiveBlocksPerMultiprocessor(&per_cu, (const void*)fwd_kernel, NTHREADS, LDS_BYTES) != hipSuccess || per_cu < 1) {
            fprintf(stderr, "kernel_launch: occupancy query reports %d blocks per CU\n", per_cu); (void)hipGetLastError(); per_cu = 1; }
        grid = cus;
    }
    if (grid < 0) return;
    unsigned char* ws = (unsigned char*)d_ws;
    size_t off = 0;
    auto take = [&](size_t bytes) { unsigned char* r = ws + off; off += (bytes + 255) & ~(size_t)255; return r; };
    Params p{};
    const float* const* in = (const float* const*)d_in;
    p.x_prompt = in[0]; p.x_sample = in[1]; p.cache_ckv = in[2]; p.cache_kpe = in[3]; p.cache_k = in[4]; p.cache_v = in[5]; p.c = in[6]; p.c_ctx = in[7];
    p.mod_w = in[8]; p.mod_b = in[9]; p.ln_gain = in[10]; p.ln_bias = in[11];
    p.mla_w_in = in[12]; p.mla_q_gain = in[13]; p.mla_kv_gain = in[14]; p.mla_w_q_up = in[15]; p.mla_w_kv_up = in[16]; p.mla_w_out = in[17];
    p.gm_w_in = in[18]; p.gm_v_gain = in[19]; p.gm_w_s = in[20]; p.gm_b_s = in[21]; p.gm_w_out = in[22];
    p.swa_w_qkv = in[23]; p.swa_sink = in[24]; p.swa_w_out = in[25];
    p.moe_router = in[26]; p.moe_w_gate = in[27]; p.moe_w_up = in[28]; p.moe_w_down = in[29];
    p.out = (float*)d_out;
    p.bar = (unsigned*)take(16384);
    p.mod = (float*)take((size_t)DEPTH * 5 * 6144 * 4);
    p.X0 = (float*)take((size_t)NTOK * D * 4); p.X1 = (float*)take((size_t)NTOK * D * 4); p.T = (float*)take((size_t)NTOK * D * 4);
    p.Z = (float*)take((size_t)NTOK * 704 * 4); p.GST = (float*)take((size_t)NTOK * 96 * 4); p.AFF = (float*)take((size_t)NTOK * 16 * 4); p.GATEV = (float*)take(16 * 1024 * 4);
    p.H = (bf16_t*)take((size_t)NTOK * D * 2); p.H2 = (bf16_t*)take((size_t)NTOK * D * 2);
    p.CQ = (bf16_t*)take((size_t)NTOK * 384 * 2); p.CKV = (bf16_t*)take((size_t)NROWS_KV * 256 * 2); p.KPE = (bf16_t*)take((size_t)NROWS_KV * 64 * 2);
    p.Q = (bf16_t*)take((size_t)NTOK * 1536 * 2); p.KN = (bf16_t*)take((size_t)NROWS_KV * 1024 * 2);
    p.VTP = (bf16_t*)take((size_t)16 * 8 * 128 * 256 * 2); p.VTS = (bf16_t*)take((size_t)4 * 8 * 128 * 1280 * 2);
    p.O = (bf16_t*)take((size_t)NTOK * D * 2);
    p.U = (bf16_t*)take((size_t)NTOK * 3072 * 2); p.GVT = (bf16_t*)take((size_t)NTOK * 3072 * 2); p.TT = (bf16_t*)take((size_t)NTOK * 3072 * 2);
    p.SK = (bf16_t*)take((size_t)NROWS_KV * 256 * 2); p.SVTP = (bf16_t*)take((size_t)16 * 4 * 64 * 256 * 2); p.SVTS = (bf16_t*)take((size_t)4 * 4 * 64 * 1280 * 2);
    p.HID = (bf16_t*)take((size_t)16 * 1024 * 2048 * 2); p.YE = (bf16_t*)take((size_t)16 * 1024 * 1024 * 2);
    p.SEL = (int*)take((size_t)NTOK * 16 * 4); p.IDX = (int*)take(16 * 1024 * 4);
    p.WTI = (bf16_t*)take((size_t)2 * 704 * 1024 * 2); p.WTQ = (bf16_t*)take((size_t)2 * 1536 * 384 * 2); p.WTKV = (bf16_t*)take((size_t)2 * 2048 * 256 * 2); p.WTO = (bf16_t*)take((size_t)2 * 1024 * 1024 * 2);
    p.WTGI = (bf16_t*)take((size_t)6144 * 1024 * 2); p.WTGO = (bf16_t*)take((size_t)1024 * 3072 * 2); p.WTSQ = (bf16_t*)take((size_t)1536 * 1024 * 2); p.WTSO = (bf16_t*)take((size_t)1024 * 1024 * 2);
    if (off > ws_size) { fprintf(stderr, "kernel_launch: workspace too small: need %zu, have %zu\n", off, ws_size); return; }
    (void)in_sizes; (void)n_in; (void)out_size;
    if (hipMemsetAsync(p.bar, 0, 16384, stream) != hipSuccess) { fprintf(stderr, "kernel_launch: memset failed\n"); return; }
#if N_LAUNCH_PER_PHASE
#ifndef MAX_PHASE
#define MAX_PHASE N_PHASES
#endif
    for (int k = 0; k < MAX_PHASE; ++k) {
        if (k >= 2) { const int li = (k - 2) / 10, s = (k - 2) % 10, kind = li % 3; if (kind != 0 && (s == 3 || s == 4)) continue; }
        p.ph_lo = k; p.ph_hi = k + 1;
        hipLaunchKernelGGL(fwd_kernel, dim3(grid), dim3(NTHREADS), LDS_BYTES, stream, p);
    }
#else
    p.ph_lo = 0; p.ph_hi = N_PHASES;
    hipLaunchKernelGGL(fwd_kernel, dim3(grid), dim3(NTHREADS), LDS_BYTES, stream, p);
#endif
#ifdef PROBE_V
    { static int once = 0; if (!once) { once = 1; (void)hipFuncSetAttribute((const void*)probe_kernel, hipFuncAttributeMaxDynamicSharedMemorySize, LDS_BYTES); }
      hipLaunchKernelGGL(probe_kernel, dim3(grid), dim3(NTHREADS), LDS_BYTES, stream, p); }
#endif
    const hipError_t le = hipPeekAtLastError();
    if (le != hipSuccess) fprintf(stderr, "kernel_launch: launch failed: %s\n", hipGetErrorName(le));
}
```

```cpp
#include <hip/hip_runtime.h>
#include <stdint.h>
#include <stdio.h>

#ifndef N_LAUNCH_PER_PHASE
#define N_LAUNCH_PER_PHASE 0
#endif

#define DEVI __device__ __forceinline__
#define LAS __attribute__((address_space(3)))
typedef unsigned short bf16_t;
typedef short bf16x8 __attribute__((ext_vector_type(8)));
typedef float f32x4 __attribute__((ext_vector_type(4)));
typedef float f32x2 __attribute__((ext_vector_type(2)));
typedef unsigned u32x4 __attribute__((ext_vector_type(4)));
typedef int i32x4 __attribute__((ext_vector_type(4)));
typedef unsigned u32x2 __attribute__((ext_vector_type(2)));
typedef LAS unsigned char lds_t;

constexpr int D = 1024;
constexpr int NTOK = 8192, NPR = 4096;
constexpr int NROWS_KV = 9216;
constexpr int DEPTH = 4;
constexpr float ALPHA_F = 1.681792830507429f;
constexpr float EPS_F = 1e-6f;
constexpr float LOG2E = 1.4426950408889634f;
constexpr int NTHREADS = 512;
constexpr int LDS_MAIN = 147456;
constexpr int LDS_BYTES = LDS_MAIN + 1024;

__device__ const float rope_tab[64 * 16 * 2] = {
1.000000000e+00f,0.000000000e+00f,1.000000000e+00f,0.000000000e+00f,1.000000000e+00f,0.000000000e+00f,1.000000000e+00f,0.000000000e+00f,1.000000000e+00f,0.000000000e+00f,1.000000000e+00f,0.000000000e+00f,1.000000000e+00f,0.000000000e+00f,1.000000000e+00f,0.000000000e+00f,1.000000000e+00f,0.000000000e+00f,1.000000000e+00f,0.000000000e+00f,1.000000000e+00f,0.000000000e+00f,1.000000000e+00f,0.000000000e+00f,1.000000000e+00f,0.000000000e+00f,1.000000000e+00f,0.000000000e+00f,1.000000000e+00f,0.000000000e+00f,1.000000000e+00f,0.000000000e+00f,
5.403023059e-01f,8.414709848e-01f,8.460091064e-01f,5.331684460e-01f,9.504152809e-01f,3.109835909e-01f,9.842302348e-01f,1.768921847e-01f,9.950041651e-01f,9.983341813e-02f,9.984192778e-01f,5.620449919e-02f,9.995000417e-01f,3.161750470e-02f,9.998418903e-01f,1.778185709e-02f,9.999500004e-01f,9.999833111e-03f,9.999841887e-01f,5.623383612e-03f,9.999950000e-01f,3.162272359e-03f,9.999984189e-01f,1.778278494e-03f,9.999995000e-01f,9.999998808e-04f,9.999998419e-01f,5.623412721e-04f,9.999999500e-01f,3.162277519e-04f,9.999999842e-01f,1.778279393e-04f,
-4.161468365e-01f,9.092974268e-01f,4.314628163e-01f,9.021307212e-01f,8.065784124e-01f,5.911271138e-01f,9.374183100e-01f,3.482052729e-01f,9.800665772e-01f,1.986693337e-01f,9.936821085e-01f,1.122313110e-01f,9.980006668e-01f,6.320339453e-02f,9.993676111e-01f,3.555809121e-02f,9.998000067e-01f,1.999866625e-02f,9.999367551e-01f,1.124658940e-02f,9.999800001e-01f,6.324513096e-03f,9.999936755e-01f,3.556551364e-03f,9.999980000e-01f,1.999998762e-03f,9.999993675e-01f,1.124682366e-03f,9.999998000e-01f,6.324554721e-04f,9.999999368e-01f,3.556558729e-04f,
-9.899924966e-01f,1.411200081e-01f,-1.159661631e-01f,9.932531646e-01f,5.827536401e-01f,8.126488756e-01f,8.610406595e-01f,5.085361174e-01f,9.553364856e-01f,2.955202180e-01f,9.858034692e-01f,1.679033061e-01f,9.955033745e-01f,9.472608625e-02f,9.985773124e-01f,5.332308304e-02f,9.995500338e-01f,2.999549953e-02f,9.998577009e-01f,1.686943954e-02f,9.999550003e-01f,9.486690354e-03f,9.999857698e-01f,5.334812988e-03f,9.999955000e-01f,2.999995526e-03f,9.999985770e-01f,1.687023105e-03f,9.999995500e-01f,9.486831000e-04f,9.999998577e-01f,5.334837808e-04f,
-6.536436209e-01f,-7.568024953e-01f,-6.276796763e-01f,7.784717233e-01f,3.011374707e-01f,9.535807379e-01f,7.575061759e-01f,6.528279969e-01f,9.210609917e-01f,3.894183478e-01f,9.748082657e-01f,2.230444915e-01f,9.920106618e-01f,1.261540598e-01f,9.974712443e-01f,7.107120934e-02f,9.992001067e-01f,3.998933329e-02f,9.997470285e-01f,2.249175622e-02f,9.999200011e-01f,1.264877321e-02f,9.999747019e-01f,7.113057742e-03f,9.999920000e-01f,3.999989523e-03f,9.999974702e-01f,2.249363310e-03f,9.999992000e-01f,1.264910691e-03f,9.999997470e-01f,7.113117008e-04f,
2.836621855e-01f,-9.589242747e-01f,-9.460792425e-01f,3.239352821e-01f,-1.034233808e-02f,9.999465166e-01f,6.300802992e-01f,7.765299843e-01f,8.775825619e-01f,4.794255386e-01f,9.607312596e-01f,2.774805341e-01f,9.875260225e-01f,1.574558824e-01f,9.960497565e-01f,8.879686156e-02f,9.987502605e-01f,4.997916629e-02f,9.996047413e-01f,2.811336165e-02f,9.998750026e-01f,1.581072865e-02f,9.999604718e-01f,8.891280002e-03f,9.999875000e-01f,4.999979521e-03f,9.999960472e-01f,2.811702920e-03f,9.999987500e-01f,1.581138156e-03f,9.999996047e-01f,8.891395984e-04f,
9.601702867e-01f,-2.794154982e-01f,-9.731036980e-01f,-2.303675170e-01f,-3.207963899e-01f,9.471481807e-01f,4.827820346e-01f,8.757405478e-01f,8.253356014e-01f,5.646424931e-01f,9.436169596e-01f,3.310393232e-01f,9.820539372e-01f,1.886002770e-01f,9.943132976e-01f,1.064944419e-01f,9.982005400e-01f,5.996400514e-02f,9.994308440e-01f,3.373407806e-02f,9.998200054e-01f,1.897252691e-02f,9.999430795e-01f,1.066947415e-02f,9.999820001e-01f,5.999964052e-03f,9.999943079e-01f,3.374041408e-03f,9.999982000e-01f,1.897365346e-03f,9.999994308e-01f,1.066967410e-03f,
7.539022543e-01f,6.569865987e-01f,-7.004298139e-01f,-7.137212872e-01f,-5.994374526e-01f,8.004216016e-01f,3.202570024e-01f,9.473306986e-01f,7.648421950e-01f,6.442176781e-01f,9.235194568e-01f,3.835515778e-01f,9.755998794e-01f,2.195560870e-01f,9.922624183e-01f,1.241583392e-01f,9.975510002e-01f,6.994284763e-02f,9.992253421e-01f,3.935372584e-02f,9.997550100e-01f,2.213413545e-02f,9.999225252e-01f,1.244763455e-02f,9.999755001e-01f,6.999943050e-03f,9.999922524e-01f,3.936378830e-03f,9.999975500e-01f,2.213592463e-03f,9.999992252e-01f,1.244795304e-03f,
-1.455000338e-01f,9.893582466e-01f,-2.120364479e-01f,-9.772617586e-01f,-8.186324475e-01f,5.743177830e-01f,1.476312130e-01f,9.890424788e-01f,6.967067008e-01f,7.173560992e-01f,9.005023096e-01f,4.348512278e-01f,9.681703064e-01f,2.502923447e-01f,9.898977664e-01f,1.417829752e-01f,9.968017064e-01f,7.991469219e-02f,9.989882418e-01f,4.497213288e-02f,9.996800171e-01f,2.529552265e-02f,9.998988088e-01f,1.422575559e-02f,9.999680002e-01f,7.999915047e-03f,9.999898807e-01f,4.498715239e-03f,9.999968000e-01f,2.529819359e-03f,9.999989881e-01f,1.422623042e-03f,
-9.111302619e-01f,4.121184852e-01f,3.416602554e-01f,-9.398235313e-01f,-9.566441680e-01f,2.912592245e-01f,-2.965079623e-02f,9.995603185e-01f,6.216099403e-01f,7.833269319e-01f,8.746382611e-01f,4.847761465e-01f,9.597726443e-01f,2.807783310e-01f,9.872200896e-01f,1.593627767e-01f,9.959527334e-01f,8.987854534e-02f,9.987195508e-01f,5.058911778e-02f,9.995950273e-01f,2.845665689e-02f,9.998719305e-01f,1.600383071e-02f,9.999595003e-01f,8.999879044e-03f,9.999871928e-01f,5.061050226e-03f,9.999959500e-01f,2.846046001e-03f,9.999987193e-01f,1.600450735e-03f,
-8.390715291e-01f,-5.440211109e-01f,7.901318660e-01f,-6.129368926e-01f,-9.997860721e-01f,-2.068356987e-02f,-2.059976331e-01f,9.785524897e-01f,5.403023059e-01f,8.414709848e-01f,8.460091064e-01f,5.331684460e-01f,9.504152902e-01f,3.109835626e-01f,9.842302348e-01f,1.768921847e-01f,9.950041659e-01f,9.983341072e-02f,9.984192778e-01f,5.620449919e-02f,9.995000417e-01f,3.161750470e-02f,9.998418903e-01f,1.778185709e-02f,9.999500004e-01f,9.999834042e-03f,9.999841887e-01f,5.623383612e-03f,9.999950000e-01f,3.162272359e-03f,9.999984189e-01f,1.778278494e-03f,
4.425697988e-03f,-9.999902066e-01f,9.952573993e-01f,-9.727645772e-02f,-9.437797393e-01f,-3.305749593e-01f,-3.758474003e-01f,9.266815697e-01f,4.535961002e-01f,8.912073709e-01f,8.147053420e-01f,5.798751639e-01f,9.401075903e-01f,3.408778647e-01f,9.809291472e-01f,1.943656558e-01f,9.939560980e-01f,1.097783002e-01f,9.980874321e-01f,6.181810327e-02f,9.993950610e-01f,3.477804006e-02f,9.998086883e-01f,1.955982724e-02f,9.999395006e-01f,1.099977904e-02f,9.999808683e-01f,6.185714754e-03f,9.999939500e-01f,3.478498401e-03f,9.999980868e-01f,1.956106080e-03f,
8.438539587e-01f,-5.365729180e-01f,8.938616142e-01f,4.483429653e-01f,-7.941793525e-01f,-6.076834341e-01f,-5.338430142e-01f,8.455836068e-01f,3.623577100e-01f,9.320391032e-01f,7.808259330e-01f,6.247486393e-01f,9.288598710e-01f,3.704312892e-01f,9.773178677e-01f,2.117776794e-01f,9.928086362e-01f,1.197122046e-01f,9.977240240e-01f,6.742975621e-02f,9.992800864e-01f,3.793822392e-02f,9.997723246e-01f,2.133773367e-02f,9.999280009e-01f,1.199971211e-02f,9.999772317e-01f,6.748044406e-03f,9.999928000e-01f,3.794723862e-03f,9.999977232e-01f,2.133933605e-03f,
9.074467815e-01f,4.201670368e-01f,5.171728454e-01f,8.558809777e-01f,-5.658204930e-01f,-8.245284529e-01f,-6.750016657e-01f,7.378162043e-01f,2.674987597e-01f,9.635582046e-01f,7.444779872e-01f,6.676470075e-01f,9.166833698e-01f,3.996143135e-01f,9.733975442e-01f,2.291227201e-01f,9.915618943e-01f,1.296341379e-01f,9.973290651e-01f,7.303927684e-02f,9.991551190e-01f,4.109803212e-02f,9.997327995e-01f,2.311557262e-02f,9.999155012e-01f,1.299963410e-02f,9.999732789e-01f,7.310371924e-03f,9.999915500e-01f,4.110949176e-03f,9.999973279e-01f,2.311761062e-03f,
1.367372182e-01f,9.906073557e-01f,-1.879615160e-02f,9.998233367e-01f,-2.813494808e-01f,-9.596053718e-01f,-7.948709048e-01f,6.067785796e-01f,1.699671664e-01f,9.854497259e-01f,7.057763743e-01f,7.084346897e-01f,9.035902493e-01f,4.283977840e-01f,9.691694136e-01f,2.463953078e-01f,9.902159961e-01f,1.395431152e-01f,9.969025685e-01f,7.864648034e-02f,9.990201601e-01f,4.425742562e-02f,9.996901128e-01f,2.489334034e-02f,9.999020016e-01f,1.399954310e-02f,9.999690098e-01f,7.872696665e-03f,9.999902000e-01f,4.427174080e-03f,9.999969010e-01f,2.489588678e-03f,
-7.596879129e-01f,6.502878402e-01f,-5.489754720e-01f,8.358384600e-01f,3.102235090e-02f,-9.995186910e-01f,-8.896704271e-01f,4.566032536e-01f,7.073720167e-02f,9.974949866e-01f,6.648435293e-01f,7.469826514e-01f,8.895936264e-01f,4.567528653e-01f,9.646348168e-01f,2.635899662e-01f,9.887710793e-01f,1.494381236e-01f,9.964445467e-01f,8.425120425e-02f,9.988752109e-01f,4.741638026e-02f,9.996442648e-01f,2.667102934e-02f,9.998875021e-01f,1.499943810e-02f,9.999644246e-01f,8.435019847e-03f,9.999887500e-01f,4.743398540e-03f,9.999964424e-01f,2.667415984e-03f,
-9.576594803e-01f,-2.879033167e-01f,-9.100810896e-01f,4.144302238e-01f,3.403181682e-01f,-9.403103447e-01f,-9.564100499e-01f,2.920270818e-01f,-2.919954613e-02f,9.995736023e-01f,6.218088193e-01f,7.831690700e-01f,8.747074844e-01f,4.846512321e-01f,9.597951759e-01f,2.807013010e-01f,9.872272839e-01f,1.593182031e-01f,9.959550145e-01f,8.985326392e-02f,9.987202731e-01f,5.057485702e-02f,9.995952558e-01f,2.844863214e-02f,9.998720027e-01f,1.599931810e-02f,9.999595231e-01f,8.997339431e-03f,9.999872000e-01f,5.059622526e-03f,9.999959523e-01f,2.845243204e-03f,
-2.751633381e-01f,-9.613974919e-01f,-9.908979596e-01f,-1.346151313e-01f,6.158647923e-01f,-7.878518627e-01f,-9.929849841e-01f,1.182405237e-01f,-1.288445416e-01f,9.916648043e-01f,5.768082960e-01f,8.168795441e-01f,8.589467084e-01f,5.120649883e-01f,9.546520286e-01f,2.977238725e-01f,9.855847666e-01f,1.691823508e-01f,9.954339876e-01f,9.545248218e-02f,9.985553481e-01f,5.373282803e-02f,9.995430857e-01f,3.022614497e-02f,9.998555035e-01f,1.699918210e-02f,9.999543054e-01f,9.559656169e-03f,9.999855500e-01f,5.375846007e-03f,9.999954305e-01f,3.023070335e-03f,
6.603167082e-01f,-7.509872468e-01f,-7.665365398e-01f,-6.422006954e-01f,8.303361283e-01f,-5.572628770e-01f,-9.982416606e-01f,-5.927551864e-02f,-2.272021643e-01f,9.738476146e-01f,5.299841756e-01f,8.480075316e-01f,8.423270577e-01f,5.389667224e-01f,9.492070108e-01f,3.146522695e-01f,9.838436942e-01f,1.790295658e-01f,9.948814823e-01f,1.010486820e-01f,9.983804374e-01f,5.689026544e-02f,9.994877548e-01f,3.200356222e-02f,9.998380044e-01f,1.799902910e-02f,9.999487715e-01f,1.012197082e-02f,9.999838000e-01f,5.692068949e-03f,9.999948771e-01f,3.200897370e-03f,
9.887046182e-01f,1.498772097e-01f,-3.060954058e-01f,-9.520008417e-01f,9.624637956e-01f,-2.714100995e-01f,-9.720142724e-01f,-2.349218044e-01f,-3.232895443e-01f,9.463000954e-01f,4.814845890e-01f,8.764545570e-01f,8.248651506e-01f,5.653295351e-01f,9.434618259e-01f,3.314811956e-01f,9.820042356e-01f,1.888588926e-01f,9.942975170e-01f,1.066416789e-01f,9.981955430e-01f,6.004713022e-02f,9.994292631e-01f,3.378088199e-02f,9.998195054e-01f,1.899885811e-02f,9.999429214e-01f,1.068428133e-02f,9.999819501e-01f,6.008291323e-03f,9.999942921e-01f,3.378724537e-03f,
4.080820618e-01f,9.129452507e-01f,2.486167313e-01f,-9.686019414e-01f,9.991443799e-01f,4.135829015e-02f,-9.151299503e-01f,-4.031589936e-01f,-4.161468365e-01f,9.092974268e-01f,4.314628163e-01f,9.021307212e-01f,8.065784476e-01f,5.911270657e-01f,9.374183100e-01f,3.482052729e-01f,9.800665802e-01f,1.986693191e-01f,9.936821085e-01f,1.122313110e-01f,9.980006668e-01f,6.320339453e-02f,9.993676111e-01f,3.555809121e-02f,9.998000066e-01f,1.999866811e-02f,9.999367551e-01f,1.124658940e-02f,9.999800001e-01f,6.324513096e-03f,9.999936755e-01f,3.556551364e-03f,
-5.477292602e-01f,8.366556385e-01f,7.267602563e-01f,-6.868912067e-01f,9.367404516e-01f,3.500247509e-01f,-8.293829489e-01f,-5.586805205e-01f,-5.048462281e-01f,8.632092944e-01f,3.800769984e-01f,9.249548504e-01f,7.874851971e-01f,6.163335658e-01f,9.310783539e-01f,3.648192688e-01f,9.780309161e-01f,2.084598934e-01f,9.930352772e-01f,1.178173940e-01f,9.977958103e-01f,6.635903053e-02f,9.993027988e-01f,3.733518799e-02f,9.997795081e-01f,2.099845811e-02f,9.999302726e-01f,1.180889298e-02f,9.999779501e-01f,6.640734236e-03f,9.999930272e-01f,3.734378079e-03f,
-9.999608264e-01f,-8.851309290e-03f,9.810745815e-01f,-1.936302286e-01f,7.814403926e-01f,6.239798978e-01f,-7.174774633e-01f,-6.965817179e-01f,-5.885011558e-01f,8.084963758e-01f,3.274895886e-01f,9.448547874e-01f,7.676045628e-01f,6.409237359e-01f,9.244439837e-01f,3.813178741e-01f,9.758974496e-01f,2.182296219e-01f,9.923570442e-01f,1.233997439e-01f,9.975809759e-01f,6.951400294e-02f,9.992348263e-01f,3.911217043e-02f,9.997580097e-01f,2.199822712e-02f,9.999234739e-01f,1.237119282e-02f,9.999758001e-01f,6.956954712e-03f,9.999923473e-01f,3.912204676e-03f,
-5.328330203e-01f,-8.462204042e-01f,9.332357723e-01f,3.592645171e-01f,5.486452564e-01f,8.360552510e-01f,-5.829432350e-01f,-8.125128828e-01f,-6.662759857e-01f,7.457052439e-01f,2.738668392e-01f,9.617676197e-01f,7.469563882e-01f,6.648730361e-01f,9.175172750e-01f,3.976959268e-01f,9.736663975e-01f,2.279775131e-01f,9.916474294e-01f,1.289781990e-01f,9.973561656e-01f,7.266828020e-02f,9.991636941e-01f,4.088902546e-02f,9.997355116e-01f,2.299797413e-02f,9.999163589e-01f,1.293348969e-02f,9.999735501e-01f,7.273174492e-03f,9.999916358e-01f,4.090031381e-03f,
4.241790073e-01f,-9.055783620e-01f,5.979771709e-01f,8.015131335e-01f,2.614416878e-01f,9.652192724e-01f,-4.300232723e-01f,-9.028178029e-01f,-7.373937800e-01f,6.754631102e-01f,2.193782753e-01f,9.756398784e-01f,7.255613200e-01f,6.881575190e-01f,9.103004290e-01f,4.139482201e-01f,9.713379761e-01f,2.377026212e-01f,9.909064560e-01f,1.345525754e-01f,9.971213823e-01f,7.582182336e-02f,9.990894022e-01f,4.266575118e-02f,9.997120138e-01f,2.399769627e-02f,9.999089278e-01f,1.349578153e-02f,9.999712001e-01f,7.589393080e-03f,9.999908927e-01f,4.267857492e-03f,
9.912028119e-01f,-1.323517501e-01f,7.855226359e-02f,9.969099969e-01f,-5.168932904e-02f,9.986632131e-01f,-2.635405934e-01f,-9.646483067e-01f,-8.011436155e-01f,5.984721441e-01f,1.641961594e-01f,9.864277070e-01f,7.034407513e-01f,7.107539022e-01f,9.027957408e-01f,4.300695879e-01f,9.689124217e-01f,2.474039593e-01f,9.901341474e-01f,1.401226969e-01f,9.968766273e-01f,7.897461572e-02f,9.990119510e-01f,4.444234199e-02f,9.996875163e-01f,2.499739629e-02f,9.999011805e-01f,1.405806910e-02f,9.999687502e-01f,7.905611374e-03f,9.999901179e-01f,4.445683934e-03f,
6.469193223e-01f,7.625584505e-01f,-4.650644959e-01f,8.852768012e-01f,-3.596943393e-01f,9.330701915e-01f,-8.874550263e-02f,-9.960543337e-01f,-8.568888271e-01f,5.155012492e-01f,1.084949468e-01f,9.940970006e-01f,6.806168009e-01f,7.326395911e-01f,8.950055582e-01f,4.460549862e-01f,9.663899806e-01f,2.570805427e-01f,9.893305281e-01f,1.456883874e-01f,9.966219035e-01f,8.212661834e-02f,9.989313406e-01f,4.621879226e-02f,9.996620190e-01f,2.599707130e-02f,9.998931169e-01f,1.462035317e-02f,9.999662002e-01f,8.221828878e-03f,9.999893115e-01f,4.623509769e-03f,
-2.921388087e-01f,9.563759284e-01f,-8.654506342e-01f,5.009942114e-01f,-6.320286307e-01f,7.749450367e-01f,8.884811635e-02f,-9.960451858e-01f,-9.040721624e-01f,4.273798371e-01f,5.245061444e-02f,9.986235192e-01f,6.571122908e-01f,7.537927018e-01f,8.869323709e-01f,4.618993066e-01f,9.637709015e-01f,2.667314183e-01f,9.884956235e-01f,1.512494708e-01f,9.963572141e-01f,8.527779227e-02f,9.988475711e-01f,4.799510009e-02f,9.996355221e-01f,2.699672032e-02f,9.998847372e-01f,1.518263167e-02f,9.999635502e-01f,8.538045559e-03f,9.999884735e-01f,4.801335923e-03f,
-9.626058663e-01f,2.709057883e-01f,-9.992934094e-01f,-3.758566202e-02f,-8.416849393e-01f,5.399689462e-01f,2.636395107e-01f,-9.646212772e-01f,-9.422223247e-01f,3.349881951e-01f,-3.759419011e-03f,9.999929334e-01f,6.329506774e-01f,7.741921209e-01f,8.785787046e-01f,4.775975920e-01f,9.610554380e-01f,2.763556497e-01f,9.876294623e-01f,1.568057565e-01f,9.960825606e-01f,8.842812085e-02f,9.987606432e-01f,4.977125243e-02f,9.996080256e-01f,2.799634234e-02f,9.998760413e-01f,1.574490538e-02f,9.999608003e-01f,8.854261387e-03f,9.999876039e-01f,4.979161926e-03f,
-7.480575297e-01f,-6.636338842e-01f,-8.253716334e-01f,-5.645898217e-01f,-9.678715076e-01f,2.514453117e-01f,4.301158485e-01f,-9.027737019e-01f,-9.709581880e-01f,2.392492366e-01f,-5.995756728e-02f,9.982009267e-01f,6.081562113e-01f,7.938173736e-01f,8.699472142e-01f,4.931448515e-01f,9.582438779e-01f,2.859522171e-01f,9.867320673e-01f,1.623570984e-01f,9.957979462e-01f,9.157756515e-02f,9.986705569e-01f,5.154724737e-02f,9.995795294e-01f,2.899593637e-02f,9.998670292e-01f,1.630717503e-02f,9.999579503e-01f,9.170476329e-03f,9.999867027e-01f,5.156987306e-03f,
1.542514499e-01f,-9.880316241e-01f,-3.972518623e-01f,-9.177096261e-01f,-9.980752275e-01f,-6.201483913e-02f,5.830269376e-01f,-8.124528233e-01f,-9.899924966e-01f,1.411200081e-01f,-1.159661631e-01f,9.932531646e-01f,5.827536401e-01f,8.126488756e-01f,8.610406595e-01f,5.085361174e-01f,9.553364944e-01f,2.955201896e-01f,9.858034692e-01f,1.679033061e-01f,9.955033738e-01f,9.472609366e-02f,9.985773124e-01f,5.332308304e-02f,9.995500337e-01f,2.999550139e-02f,9.998577009e-01f,1.686943954e-02f,9.999550003e-01f,9.486690354e-03f,9.999857698e-01f,5.334812988e-03f,
9.147423578e-01f,-4.040376453e-01f,1.532154756e-01f,-9.881928041e-01f,-9.293002953e-01f,-3.693250075e-01f,7.175492218e-01f,-6.965077991e-01f,-9.991351562e-01f,4.158051951e-02f,-1.716081385e-01f,9.851652891e-01f,5.567683641e-01f,8.306677968e-01f,8.518617972e-01f,5.237666260e-01f,9.523335692e-01f,3.050586387e-01f,9.848436973e-01f,1.734442042e-01f,9.951988471e-01f,9.787366751e-02f,9.984809103e-01f,5.509874635e-02f,9.995195384e-01f,3.099503643e-02f,9.998480564e-01f,1.743169684e-02f,9.999519504e-01f,9.802903431e-03f,9.999848053e-01f,5.512638036e-03f,
8.342233605e-01f,5.514266812e-01f,6.564951791e-01f,-7.543302193e-01f,-7.683670888e-01f,-6.400093881e-01f,8.294403670e-01f,-5.585952717e-01f,-9.982947730e-01f,-5.837419103e-02f,-2.267075845e-01f,9.739628695e-01f,5.302263665e-01f,8.478561200e-01f,8.424135592e-01f,5.388315091e-01f,9.492354203e-01f,3.145665538e-01f,9.838527819e-01f,1.789796175e-01f,9.948843677e-01f,1.010202700e-01f,9.983813507e-01f,5.687423543e-02f,9.994880436e-01f,3.199454047e-02f,9.998380958e-01f,1.799395049e-02f,9.999488004e-01f,1.011911553e-02f,9.999838092e-01f,5.690463375e-03f,
-1.327674722e-02f,9.999118601e-01f,9.575860738e-01f,-2.881473778e-01f,-5.312352786e-01f,-8.472243379e-01f,9.151713830e-01f,-4.030649323e-01f,-9.874797774e-01f,-1.577456471e-01f,-2.810903074e-01f,9.596813216e-01f,5.031541870e-01f,8.641966582e-01f,8.326989334e-01f,5.537260030e-01f,9.460423489e-01f,3.240430126e-01f,9.828307545e-01f,1.845093711e-01f,9.945599394e-01f,1.041658623e-01f,9.982786339e-01f,5.864954466e-02f,9.994555494e-01f,3.299401065e-02f,9.998278189e-01f,1.855619846e-02f,9.999455505e-01f,1.043532661e-02f,9.999827814e-01f,5.868288535e-03f,
-8.485702748e-01f,5.290826861e-01f,9.637575328e-01f,2.667797179e-01f,-2.414211151e-01f,-9.704204476e-01f,9.720383571e-01f,-2.348221291e-01f,-9.667981682e-01f,-2.555411942e-01f,-3.345843792e-01f,9.423657958e-01f,4.755788956e-01f,8.796730723e-01f,8.227209915e-01f,5.684453977e-01f,9.427546643e-01f,3.334870955e-01f,9.817776473e-01f,1.900332899e-01f,9.942255664e-01f,1.073104056e-01f,9.981727603e-01f,6.042466843e-02f,9.994220556e-01f,3.399345156e-02f,9.998172259e-01f,1.911843869e-02f,9.999422006e-01f,1.075153665e-02f,9.999817221e-01f,6.046113043e-03f,
-9.036922051e-01f,-4.281826695e-01f,6.731102676e-01f,7.395421338e-01f,7.233466718e-02f,-9.973804169e-01f,9.982477619e-01f,-5.917267879e-02f,-9.364566873e-01f,-3.507832277e-01f,-3.870206816e-01f,9.220710342e-01f,4.475280652e-01f,8.942698871e-01f,8.124829236e-01f,5.829849902e-01f,9.393727149e-01f,3.428978019e-01f,9.806934936e-01f,1.955511994e-01f,9.938812503e-01f,1.104538832e-01f,9.980637300e-01f,6.219960483e-02f,9.993875625e-01f,3.499285475e-02f,9.998063168e-01f,1.968067474e-02f,9.999387506e-01f,1.106774562e-02f,9.999806311e-01f,6.223937825e-03f,
-1.279636896e-01f,-9.917788534e-01f,1.751565337e-01f,9.845405978e-01f,3.789161719e-01f,-9.254309994e-01f,9.929728258e-01f,1.183425843e-01f,-8.967583530e-01f,-4.425205716e-01f,-4.382335472e-01f,8.988611451e-01f,4.190297442e-01f,9.079725070e-01f,8.019878986e-01f,5.973402803e-01f,9.358968291e-01f,3.522742188e-01f,9.795783277e-01f,2.010629250e-01f,9.935269954e-01f,1.135962562e-01f,9.979515440e-01f,6.397433710e-02f,9.993520699e-01f,3.599222668e-02f,9.997950914e-01f,2.024290457e-02f,9.999352007e-01f,1.138395348e-02f,9.999795085e-01f,6.401761945e-03f,
7.654140519e-01f,-6.435381334e-01f,-3.767422893e-01f,9.263181135e-01f,6.479216888e-01f,-7.617069550e-01f,9.563800296e-01f,2.921253822e-01f,-8.481000064e-01f,-5.298361813e-01f,-4.880608524e-01f,8.728096037e-01f,3.901124287e-01f,9.207672306e-01f,7.912392691e-01f,6.115066795e-01f,9.323273439e-01f,3.616154364e-01f,9.784321880e-01f,2.065682779e-01f,9.931628052e-01f,1.167374932e-01f,9.978362017e-01f,6.574887451e-02f,9.993155781e-01f,3.699155889e-02f,9.997835499e-01f,2.080512613e-02f,9.999315508e-01f,1.170016020e-02f,9.999783543e-01f,6.579586328e-03f,
9.550736440e-01f,2.963685787e-01f,-8.126112051e-01f,5.828061679e-01f,8.526731157e-01f,-5.224447891e-01f,8.896234916e-01f,4.566946935e-01f,-7.909677411e-01f,-6.118578532e-01f,-5.363451811e-01f,8.439987244e-01f,3.608050334e-01f,9.326412643e-01f,7.802404339e-01f,6.254797082e-01f,9.286646373e-01f,3.709204650e-01f,9.772551046e-01f,2.120671131e-01f,9.927886843e-01f,1.198775555e-01f,9.977177040e-01f,6.752320399e-02f,9.992780868e-01f,3.799085783e-02f,9.997716923e-01f,2.136734297e-02f,9.999278009e-01f,1.201636575e-02f,9.999771684e-01f,6.757410504e-03f,
2.666429324e-01f,9.637953863e-01f,-9.982103598e-01f,5.980031485e-02f,9.728653499e-01f,-2.313720187e-01f,7.948083899e-01f,6.068604645e-01f,-7.259322386e-01f,-6.877662284e-01f,-5.829338849e-01f,8.125195911e-01f,3.311368634e-01f,9.435827349e-01f,7.689949093e-01f,6.392549018e-01f,9.249090653e-01f,3.801884019e-01f,9.760471178e-01f,2.175592422e-01f,9.924046346e-01f,1.230164264e-01f,9.975960518e-01f,6.929731252e-02f,9.992395964e-01f,3.899011506e-02f,9.997595184e-01f,2.192955306e-02f,9.999239510e-01f,1.233257010e-02f,9.999759510e-01f,6.935234000e-03f,
-6.669380617e-01f,7.451131605e-01f,-8.763794418e-01f,-4.816212973e-01f,9.965789837e-01f,8.264580634e-02f,6.749256518e-01f,7.378857395e-01f,-6.536436209e-01f,-7.568024953e-01f,-6.276796763e-01f,7.784717233e-01f,3.011375844e-01f,9.535807020e-01f,7.575061759e-01f,6.528279969e-01f,9.210610033e-01f,3.894183203e-01f,9.748082657e-01f,2.230444915e-01f,9.920106618e-01f,1.261540598e-01f,9.974712443e-01f,7.107120934e-02f,9.992001065e-01f,3.998933702e-02f,9.997470285e-01f,2.249175622e-02f,9.999200011e-01f,1.264877321e-02f,9.999747019e-01f,7.113057742e-03f,
-9.873392775e-01f,-1.586226688e-01f,-4.846393970e-01f,-8.747140418e-01f,9.214623472e-01f,3.884676855e-01f,5.337561004e-01f,8.456384720e-01f,-5.748240246e-01f,-8.182770562e-01f,-6.704410942e-01f,7.419627614e-01f,2.708370782e-01f,9.626252007e-01f,7.457779040e-01f,6.661946547e-01f,9.171208242e-01f,3.986093247e-01f,9.735385875e-01f,2.285226875e-01f,9.916067680e-01f,1.292904390e-01f,9.973432826e-01f,7.284488142e-02f,9.991596177e-01f,4.098851526e-02f,9.997342224e-01f,2.305395040e-02f,9.999159512e-01f,1.296497506e-02f,9.999734212e-01f,7.290880793e-03f,
-3.999853150e-01f,-9.165215479e-01f,5.636094028e-02f,-9.984104589e-01f,7.549653475e-01f,6.557646866e-01f,3.757521519e-01f,9.267201953e-01f,-4.902605720e-01f,-8.715759127e-01f,-7.110829506e-01f,7.031081264e-01f,2.402658714e-01f,9.707071191e-01f,7.338138022e-01f,6.793506485e-01f,9.130889457e-01f,4.077604411e-01f,9.722381233e-01f,2.339936570e-01f,9.911929581e-01f,1.324255253e-01f,9.972121675e-01f,7.461831571e-02f,9.991181295e-01f,4.198765625e-02f,9.997211001e-01f,2.361613915e-02f,9.999118013e-01f,1.328117562e-02f,9.999721088e-01f,7.468704080e-03f,
5.551133015e-01f,-8.317747426e-01f,5.800031129e-01f,-8.146142578e-01f,5.135984179e-01f,8.580306901e-01f,2.058971709e-01f,9.785736329e-01f,-4.007989973e-01f,-9.161660132e-01f,-7.494767587e-01f,6.620306550e-01f,2.094544189e-01f,9.778184118e-01f,7.216176540e-01f,6.922918182e-01f,9.089657591e-01f,4.168707818e-01f,9.709069144e-01f,2.394572270e-01f,9.907692363e-01f,1.355592873e-01f,9.970778984e-01f,7.639152146e-02f,9.990756424e-01f,4.298675152e-02f,9.997076617e-01f,2.417832043e-02f,9.999075514e-01f,1.359737484e-02f,9.999707649e-01f,7.646527131e-03f,
9.998433086e-01f,1.770192511e-02f,9.250146691e-01f,-3.799313911e-01f,2.212981743e-01f,9.752061926e-01f,2.954782069e-02f,9.995633678e-01f,-3.073327792e-01f,-9.516021032e-01f,-7.855011387e-01f,6.188602113e-01f,1.784335295e-01f,9.839519681e-01f,7.091933579e-01f,7.050140291e-01f,9.047516642e-01f,4.259394629e-01f,9.695450064e-01f,2.449132102e-01f,9.903356068e-01f,1.386916938e-01f,9.969404762e-01f,7.816448565e-02f,9.990321560e-01f,4.398580752e-02f,9.996939072e-01f,2.474049220e-02f,9.999032016e-01f,1.391357271e-02f,9.999693893e-01f,7.824349474e-03f,
5.253219888e-01f,8.509035245e-01f,9.851382016e-01f,1.717635693e-01f,-9.294810554e-02f,9.956709545e-01f,-1.477329862e-01f,9.890272821e-01f,-2.107957994e-01f,-9.775301177e-01f,-8.190422014e-01f,5.737332763e-01f,1.472342216e-01f,9.891016550e-01f,6.965447594e-01f,7.175133435e-01f,9.004471075e-01f,4.349655234e-01f,9.681524315e-01f,2.503614776e-01f,9.898920739e-01f,1.418227133e-01f,9.967999021e-01f,7.993719522e-02f,9.989876708e-01f,4.498481582e-02f,9.996798365e-01f,2.530265802e-02f,9.998987517e-01f,1.422976918e-02f,9.999679821e-01f,8.002171569e-03f,
-4.321779449e-01f,9.017883476e-01f,7.418580135e-01f,6.705569982e-01f,-3.979767653e-01f,9.173954950e-01f,-3.203543695e-01f,9.472977768e-01f,-1.121526217e-01f,-9.936909929e-01f,-8.499939088e-01f,5.267925161e-01f,1.158876918e-01f,9.932623233e-01f,6.836758997e-01f,7.297857660e-01f,8.960525071e-01f,4.439480877e-01f,9.667292484e-01f,2.558017989e-01f,9.894386421e-01f,1.449523146e-01f,9.966561752e-01f,8.170965944e-02f,9.989421864e-01f,4.598378286e-02f,9.996654497e-01f,2.586481583e-02f,9.998942019e-01f,1.454596424e-02f,9.999665433e-01f,8.179994343e-03f,
-9.923354692e-01f,1.235731227e-01f,2.700984580e-01f,9.628327077e-01f,-6.635382560e-01f,7.481423547e-01f,-4.828719382e-01f,8.756909793e-01f,-1.238837738e-02f,-9.999232611e-01f,-8.782584087e-01f,4.781863313e-01f,8.442528403e-02f,9.964298126e-01f,6.705908480e-01f,7.418274156e-01f,8.915682887e-01f,4.528862843e-01f,9.652754871e-01f,2.612340599e-01f,9.889753181e-01f,1.480804517e-01f,9.965092972e-01f,8.348185785e-02f,9.988957032e-01f,4.698270019e-02f,9.996507468e-01f,2.642696360e-02f,9.998895520e-01f,1.486215783e-02f,9.999650728e-01f,8.357815927e-03f,
-6.401443395e-01f,-7.682546613e-01f,-2.848466063e-01f,9.585731119e-01f,-8.632964878e-01f,5.046971113e-01f,-6.301599705e-01f,7.764653318e-01f,8.749917344e-02f,-9.961645921e-01f,-9.037463447e-01f,4.280683876e-01f,5.287845807e-02f,9.986009557e-01f,6.572937422e-01f,7.536344847e-01f,8.869949277e-01f,4.617791660e-01f,9.637912089e-01f,2.666580313e-01f,9.885021022e-01f,1.512071226e-01f,9.963592674e-01f,8.525379969e-02f,9.988482211e-01f,4.798157054e-02f,9.996357278e-01f,2.698910488e-02f,9.998848022e-01f,1.517834901e-02f,9.999635708e-01f,8.535637247e-03f,
3.005925437e-01f,-9.537526528e-01f,-7.520639951e-01f,6.590900905e-01f,-9.774427254e-01f,2.112006594e-01f,-7.575730765e-01f,6.527503610e-01f,1.865124631e-01f,-9.824525948e-01f,-9.263771379e-01f,3.765971301e-01f,2.127875808e-02f,9.997735816e-01f,6.437888326e-01f,7.652032012e-01f,8.823328681e-01f,4.706258703e-01f,9.622764532e-01f,2.720735702e-01f,9.880190013e-01f,1.543322815e-01f,9.962060867e-01f,8.702547193e-02f,9.987997401e-01f,4.898039663e-02f,9.996203926e-01f,2.755123762e-02f,9.998799524e-01f,1.549453961e-02f,9.999620371e-01f,8.713459228e-03f,
9.649660285e-01f,-2.623748537e-01f,-9.876590838e-01f,1.566190737e-01f,-9.946564265e-01f,-1.032404628e-01f,-8.610927113e-01f,5.084479743e-01f,2.836621855e-01f,-9.589242747e-01f,-9.460792425e-01f,3.239352821e-01f,-1.034221888e-02f,9.999465178e-01f,6.300802992e-01f,7.765299843e-01f,8.775825619e-01f,4.794255386e-01f,9.607312596e-01f,2.774805341e-01f,9.875260201e-01f,1.574558971e-01f,9.960497565e-01f,8.879686156e-02f,9.987502604e-01f,4.997917001e-02f,9.996047414e-01f,2.811335979e-02f,9.998750026e-01f,1.581072865e-02f,9.999604718e-01f,8.891280002e-03f,
7.421541968e-01f,6.702291758e-01f,-9.190735378e-01f,-3.940860720e-01f,-9.132301279e-01f,-4.074441477e-01f,-9.374542500e-01f,3.481085020e-01f,3.779776544e-01f,-9.258147184e-01f,-9.627903713e-01f,2.702493312e-01f,-4.195285448e-02f,9.991195914e-01f,6.161725219e-01f,7.876112133e-01f,8.727445123e-01f,4.881772386e-01f,9.591556934e-01f,2.828786946e-01f,9.870231637e-01f,1.605779382e-01f,9.958902758e-01f,9.056797780e-02f,9.986997817e-01f,5.097789714e-02f,9.995887740e-01f,2.867547492e-02f,9.998699528e-01f,1.612691704e-02f,9.999588749e-01f,9.069100495e-03f,
-1.629907808e-01f,9.866275920e-01f,-5.674300293e-01f,-8.234216185e-01f,-7.412399645e-01f,-6.712401321e-01f,-9.842484715e-01f,1.767906850e-01f,4.685169241e-01f,-8.834545217e-01f,-9.764576931e-01f,2.157090023e-01f,-7.352154075e-02f,9.972936293e-01f,6.020698986e-01f,7.984433839e-01f,8.678191892e-01f,4.968801213e-01f,9.575497876e-01f,2.882679384e-01f,9.865104371e-01f,1.636983734e-01f,9.957276465e-01f,9.233880022e-02f,9.986483046e-01f,5.197656957e-02f,9.995724905e-01f,2.923758099e-02f,9.998648031e-01f,1.644310196e-02f,9.999572463e-01f,9.246920701e-03f,
-9.182827862e-01f,3.959251502e-01f,-4.102818995e-02f,-9.991579893e-01f,-4.957418213e-01f,-8.684699457e-01f,-9.999999947e-01f,-1.030206758e-04f,5.543744949e-01f,-8.322673365e-01f,-9.870379993e-01f,1.604867217e-01f,-1.050167117e-01f,9.944704572e-01f,5.877769370e-01f,8.090230357e-01f,8.628070850e-01f,5.055333165e-01f,9.559136100e-01f,2.936480378e-01f,9.859878454e-01f,1.668171717e-01f,9.955618677e-01f,9.410933806e-02f,9.985958286e-01f,5.297519375e-02f,9.995558910e-01f,2.979967596e-02f,9.998595533e-01f,1.675928710e-02f,9.999555861e-01f,9.424741546e-03f,
-8.293098329e-01f,-5.587890489e-01f,4.980096003e-01f,-8.671715159e-01f,-2.010796199e-01f,-9.795749009e-01f,-9.842120244e-01f,-1.769934771e-01f,6.346929496e-01f,-7.727644270e-01f,-9.944978661e-01f,1.047568344e-01f,-1.364068747e-01f,9.906528981e-01f,5.732980611e-01f,8.193468943e-01f,8.577087010e-01f,5.141359589e-01f,9.542471952e-01f,2.990188798e-01f,9.854553963e-01f,1.699342871e-01f,9.953929407e-01f,9.587957830e-02f,9.985423542e-01f,5.397376122e-02f,9.995389754e-01f,3.036176336e-02f,9.998542036e-01f,1.707546870e-02f,9.999538943e-01f,9.602561162e-03f,
2.212675626e-02f,-9.997551734e-01f,8.836693140e-01f,-4.681116785e-01f,1.135217773e-01f,-9.935355082e-01f,-9.373825054e-01f,-3.483016489e-01f,7.086697743e-01f,-7.055403256e-01f,-9.988136461e-01f,4.869599955e-02f,-1.676606422e-01f,9.858447692e-01f,5.586378969e-01f,8.294116591e-01f,8.525245158e-01f,5.226872391e-01f,9.525506134e-01f,3.043802375e-01f,9.849130902e-01f,1.730497178e-01f,9.952208667e-01f,9.764950793e-02f,9.984878810e-01f,5.497227845e-02f,9.995217437e-01f,3.092384116e-02f,9.998487538e-01f,1.739165045e-02f,9.999521709e-01f,9.780380474e-03f,
8.532201077e-01f,-5.215510021e-01f,9.971746360e-01f,7.511820869e-02f,4.168670742e-01f,-9.089674595e-01f,-8.609884168e-01f,-5.086245631e-01f,7.755658183e-01f,-6.312667118e-01f,-9.999717335e-01f,-7.518784889e-03f,-1.987468801e-01f,9.800508546e-01f,5.438010803e-01f,8.392141473e-01f,8.472551097e-01f,5.311861999e-01f,9.508239095e-01f,3.097319700e-01f,9.843609349e-01f,1.761634181e-01f,9.950456449e-01f,9.941913618e-02f,9.984324096e-01f,5.597073698e-02f,9.995041959e-01f,3.148590732e-02f,9.998432041e-01f,1.770782860e-02f,9.999504159e-01f,9.958200408e-03f,
8.998668270e-01f,4.361647552e-01f,8.035690866e-01f,5.952114944e-01f,6.788702112e-01f,-7.342582900e-01f,-7.574391895e-01f,-6.529057162e-01f,8.347129424e-01f,-5.506853038e-01f,-9.979684672e-01f,-6.370979912e-02f,-2.296342702e-01f,9.732769914e-01f,5.287923029e-01f,8.487512594e-01f,8.419009790e-01f,5.396320427e-01f,9.490671287e-01f,3.150739362e-01f,9.837989360e-01f,1.792753567e-01f,9.948672764e-01f,1.011884500e-01f,9.983759396e-01f,5.696914326e-02f,9.994863320e-01f,3.204796724e-02f,9.998375544e-01f,1.802400685e-02f,9.999486292e-01f,1.013601910e-02f,
1.191801354e-01f,9.928726481e-01f,3.624766664e-01f,9.319928467e-01f,8.735505105e-01f,-4.867335058e-01f,-6.300007138e-01f,-7.765945536e-01f,8.855196056e-01f,-4.646020105e-01f,-9.928101803e-01f,-1.196993984e-01f,-2.602920453e-01f,9.655299328e-01f,5.136163109e-01f,8.580199795e-01f,8.364626591e-01f,5.480239228e-01f,9.472803452e-01f,3.204059106e-01f,9.832270991e-01f,1.823855026e-01f,9.946857626e-01f,1.029574365e-01f,9.983184713e-01f,5.796748886e-02f,9.994681521e-01f,3.261001331e-02f,9.998318047e-01f,1.834018143e-02f,9.999468110e-01f,1.031383746e-02f,
-7.710802230e-01f,6.367380071e-01f,-1.902490958e-01f,9.817358512e-01f,9.816020978e-01f,-1.909380047e-01f,-4.826923346e-01f,-8.757899920e-01f,9.274784664e-01f,-3.738765764e-01f,-9.845131804e-01f,-1.753105749e-01f,-2.906895502e-01f,9.568174253e-01f,4.982779032e-01f,8.670173765e-01f,8.309406937e-01f,5.563610011e-01f,9.454635966e-01f,3.257277812e-01f,9.826454300e-01f,1.854938246e-01f,9.945011026e-01f,1.047261048e-01f,9.982600046e-01f,5.896578020e-02f,9.994496561e-01f,3.317204907e-02f,9.998259550e-01f,1.865635603e-02f,9.999449611e-01f,1.049165644e-02f,
-9.524129804e-01f,-3.048106211e-01f,-6.843819158e-01f,7.291237161e-01f,9.923083195e-01f,1.237909494e-01f,-3.201591802e-01f,-9.473637630e-01f,9.601702867e-01f,-2.794154982e-01f,-9.731036980e-01f,-2.303675170e-01f,-3.207963899e-01f,9.471481807e-01f,4.827820346e-01f,8.757405478e-01f,8.253356351e-01f,5.646424439e-01f,9.436169596e-01f,3.310393232e-01f,9.820539344e-01f,1.886002917e-01f,9.943132976e-01f,1.064944419e-01f,9.982005398e-01f,5.996400886e-02f,9.994308440e-01f,3.373407806e-02f,9.998200054e-01f,1.897252691e-02f,9.999430795e-01f,1.066947415e-02f,
-2.581016359e-01f,-9.661177700e-01f,-9.677396624e-01f,2.519522691e-01f,9.046075662e-01f,4.262454119e-01f,-1.475292025e-01f,-9.890577002e-01f,9.832684211e-01f,-1.821625980e-01f,-9.586178037e-01f,-2.846961652e-01f,-3.505824602e-01f,9.365318674e-01f,4.671333972e-01f,8.841868520e-01f,8.196480097e-01f,5.728674718e-01f,9.417404730e-01f,3.363404250e-01f,9.814526211e-01f,1.917048581e-01f,9.941223492e-01f,1.082624348e-01f,9.981400766e-01f,6.096218127e-02f,9.994117160e-01f,3.429609266e-02f,9.998139558e-01f,1.928869776e-02f,9.999411664e-01f,1.084729152e-02f,
6.735071623e-01f,-7.391806966e-01f,-9.530500361e-01f,-3.028128610e-01f,7.271980777e-01f,6.864276770e-01f,2.975377145e-02f,-9.995572585e-01f,9.965421208e-01f,-8.308911770e-02f,-9.411012936e-01f,-3.381247627e-01f,-3.800179774e-01f,9.249791008e-01f,4.513370430e-01f,8.923535586e-01f,8.138784539e-01f,5.810351644e-01f,9.398342161e-01f,3.416308626e-01f,9.808414904e-01f,1.948075221e-01f,9.939282563e-01f,1.100300928e-01f,9.980786154e-01f,6.196028901e-02f,9.993922719e-01f,3.485809641e-02f,9.998078062e-01f,1.960486481e-02f,9.999392216e-01f,1.102510855e-02f,
9.858965816e-01f,1.673557003e-01f,-6.448370157e-01f,-7.643201052e-01f,4.776714527e-01f,8.785385497e-01f,2.060983265e-01f,-9.785312871e-01f,9.998586332e-01f,1.681409119e-02f,-9.206095453e-01f,-3.904843980e-01f,-4.090735085e-01f,9.125014327e-01f,4.353979670e-01f,9.002380853e-01f,8.080275111e-01f,5.891447541e-01f,9.378982288e-01f,3.469105251e-01f,9.802205514e-01f,1.979082381e-01f,9.937310211e-01f,1.117973955e-01f,9.980161562e-01f,6.295833478e-02f,9.993725116e-01f,3.542009286e-02f,9.998015566e-01f,1.992103176e-02f,9.999372453e-01f,1.120292616e-02f
};

#define XB_TMO      128
#define XB_XCNT(j)  (256  + 64 * (j))
#define XB_XSUB(j)  (1280 + 64 * (j))
#define XB_XGEN(j)  (2304 + 64 * (j))
#define XB_TOP      3328
#define XB_TOPGEN   3392
#define XCD_BAR_WORDS 3456
#define XB_SPIN_CAP (1u << 18)

__device__ __forceinline__ unsigned xb_ld(unsigned* p)              { return __hip_atomic_load(p, __ATOMIC_RELAXED, __HIP_MEMORY_SCOPE_AGENT); }
__device__ __forceinline__ unsigned xb_add(unsigned* p, unsigned v) { return __hip_atomic_fetch_add(p, v, __ATOMIC_RELAXED, __HIP_MEMORY_SCOPE_AGENT); }
__device__ __forceinline__ unsigned xb_xcc_id() { return (unsigned)__builtin_amdgcn_s_getreg((3 << 11) | 20) & 0xFu; }
#define XB_SPIN(cond, bar) do { unsigned _sp = 0; while (cond) { __builtin_amdgcn_s_sleep(1); \
    if ((++_sp & 255u) == 0u) { if (xb_ld(&(bar)[XB_TMO])) break; if (_sp > XB_SPIN_CAP) { atomicAdd(&(bar)[XB_TMO], 1u); break; } } } } while (0)

struct XcdBarrier {
    unsigned* bar; unsigned x;
    volatile LAS unsigned* st;
};

__device__ __forceinline__ XcdBarrier xcd_barrier_post(unsigned* bar, volatile LAS unsigned* st) {
    XcdBarrier b; b.bar = bar; b.x = xb_xcc_id(); b.st = st;
    if (threadIdx.x == 0) (void)xb_add(&bar[XB_XCNT(b.x)], 1u);
    return b;
}
__device__ __forceinline__ void xcd_barrier_complete(unsigned* bar, unsigned x, unsigned& nloc, unsigned& nx) {
    const unsigned G = gridDim.x * gridDim.y * gridDim.z;
    unsigned sum, cnt, mine, sp = 0u;
    for (;;) {
        sum = 0u; cnt = 0u; mine = 0u;
#pragma unroll
        for (unsigned j = 0; j < 16; ++j) { const unsigned c = xb_ld(&bar[XB_XCNT(j)]); sum += c; cnt += (c > 0u) ? 1u : 0u; mine = (j == x) ? c : mine; }
        if (sum == G) break;
        __builtin_amdgcn_s_sleep(1);
        if ((++sp & 255u) == 0u) { if (xb_ld(&bar[XB_TMO])) break; if (sp > XB_SPIN_CAP) { atomicAdd(&bar[XB_TMO], 1u); break; } }
    }
    nloc = mine > 0u ? mine : 1u; nx = cnt > 0u ? cnt : 1u;
}

__device__ __forceinline__ void xcd_barrier(const XcdBarrier& b) {
    asm volatile("s_waitcnt vmcnt(0)" ::: "memory");
    __syncthreads();
    if (threadIdx.x == 0) {
        unsigned* bar = b.bar;
        __builtin_amdgcn_s_waitcnt(0);
        unsigned nloc = b.st[0], nx = b.st[1];
        if (nloc == 0u) { xcd_barrier_complete(bar, b.x, nloc, nx); b.st[0] = nloc; b.st[1] = nx; }
        const unsigned old = xb_add(&bar[XB_XSUB(b.x)], 1u);
        const unsigned gen = old / nloc;
        if (old + 1u == (gen + 1u) * nloc) {
            __builtin_amdgcn_fence(__ATOMIC_RELEASE, "agent");
            asm volatile("s_waitcnt vmcnt(0)" ::: "memory");
            const unsigned og = xb_add(&bar[XB_TOP], 1u);
            const unsigned tg = og / nx;
            if (og + 1u == (tg + 1u) * nx) xb_add(&bar[XB_TOPGEN], 1u);
            else XB_SPIN(xb_ld(&bar[XB_TOPGEN]) == tg, bar);
            __builtin_amdgcn_fence(__ATOMIC_ACQUIRE, "agent");
            xb_add(&bar[XB_XGEN(b.x)], 1u);
            asm volatile("s_waitcnt vmcnt(0)" ::: "memory");
        } else {
            XB_SPIN(xb_ld(&bar[XB_XGEN(b.x)]) == gen, bar);
            __builtin_amdgcn_fence(__ATOMIC_ACQUIRE, "agent");
            asm volatile("s_waitcnt vmcnt(0)" ::: "memory");
        }
    }
    __syncthreads();
}

typedef __bf16 bf16x2_t __attribute__((ext_vector_type(2)));
DEVI unsigned pk_bf16(float lo, float hi) {
    f32x2 f = {lo, hi}; bf16x2_t v = __builtin_convertvector(f, bf16x2_t); unsigned r; __builtin_memcpy(&r, &v, 4); return r; }
DEVI float bf_lo(unsigned w) { return __uint_as_float(w << 16); }
DEVI float bf_hi(unsigned w) { return __uint_as_float(w & 0xffff0000u); }
DEVI bf16x8 lds_ld128(lds_t* p) { return *(LAS bf16x8*)p; }
DEVI void lds_st128(lds_t* p, u32x4 v) { *(LAS u32x4*)p = v; }
DEVI int lane_id_fresh() { unsigned z = 0u; asm volatile("" : "+s"(z)); return (int)__builtin_amdgcn_mbcnt_hi(~0u, __builtin_amdgcn_mbcnt_lo(~0u, z)); }
DEVI float wave_sum(float v) {
#pragma unroll
    for (int o = 32; o >= 1; o >>= 1) v += __shfl_xor(v, o);
    return v;
}
DEVI float fexp2(float x) { return __builtin_amdgcn_exp2f(x); }
DEVI float frcp(float x) { return __builtin_amdgcn_rcpf(x); }
DEVI float silu_f(float x) { return x * frcp(1.0f + fexp2(-LOG2E * x)); }
DEVI float gelu_tanh_f(float x) {
    const float y = 0.7978845608028654f * (x + 0.044715f * x * x * x);
    const float e = fexp2((2.0f * LOG2E) * y);
    const float t = 1.0f - 2.0f * frcp(e + 1.0f);
    return 0.5f * x * (1.0f + t);
}
DEVI int cond_of_row(int row) { return row < NPR ? 0 : 1 + ((row - NPR) >> 10); }

struct Params {
    const float *x_prompt, *x_sample, *cache_ckv, *cache_kpe, *cache_k, *cache_v, *c, *c_ctx, *mod_w, *mod_b, *ln_gain, *ln_bias,
        *mla_w_in, *mla_q_gain, *mla_kv_gain, *mla_w_q_up, *mla_w_kv_up, *mla_w_out,
        *gm_w_in, *gm_v_gain, *gm_w_s, *gm_b_s, *gm_w_out, *swa_w_qkv, *swa_sink, *swa_w_out,
        *moe_router, *moe_w_gate, *moe_w_up, *moe_w_down;
    float* out;
    unsigned* bar;
    float *mod, *X0, *X1, *T, *Z, *GST, *AFF, *GATEV;
    bf16_t *H, *H2, *CQ, *CKV, *KPE, *Q, *KN, *VTP, *VTS, *O, *U, *GVT, *TT, *SK, *SVTP, *SVTS, *HID, *YE;
    bf16_t *WTI, *WTQ, *WTKV, *WTO, *WTGI, *WTGO, *WTSQ, *WTSO;
    int *SEL, *IDX;
    long long ph_lo, ph_hi;
};
constexpr size_t OUT_Y = 0;
constexpr size_t OUT_CKV = 8388608;
constexpr size_t OUT_KPE = OUT_CKV + 2097152;
constexpr size_t OUT_SK = OUT_KPE + 524288;
constexpr size_t OUT_SV = OUT_SK + 1048576;

DEVI const float* modp(const Params& p, int layer, int cnd, int which) { return p.mod + ((size_t)(layer * 5 + cnd) * 6 + which) * 1024; }

DEVI int swz(int row) { return ((row >> 1) & 7) ^ ((row >> 4) & 1); }
DEVI int img_off(int row, int chunk) { return row * 128 + ((chunk ^ swz(row)) << 4); }

template <int BM> struct XDma {
    static constexpr int NI = BM / 64;
    const bf16_t* base; unsigned off[NI];
    template <class RowFn> DEVI void init(const RowFn& rowfn, int tid) {
        const int w = tid >> 6, i = tid & 63;
        base = rowfn.base;
#pragma unroll
        for (int j = 0; j < NI; ++j) { const int row = 64 * j + 8 * w + (i >> 3); off[j] = rowfn.offset(row) + (((i & 7) ^ swz(row)) << 3); }
    }
    DEVI void issue(int kt, lds_t* img, int tid) const {
        lds_t* dst = img + (tid >> 6) * 1024 + (tid & 63) * 16;
#pragma unroll
        for (int j = 0; j < NI; ++j) __builtin_amdgcn_global_load_lds((const unsigned*)(base + off[j] + kt * 64), (LAS unsigned*)(dst + j * 8192), 16, 0, 0);
    }
};

struct WRegs {
    f32x4 r[8];
    DEVI void load(const float* p, size_t ldw, int kt) {
        const float* q = p + (size_t)kt * 64 * ldw;
#pragma unroll
        for (int i = 0; i < 8; ++i) r[i] = *(const f32x4*)(q + (size_t)i * ldw);
    }
    DEVI void store(lds_t* img, int wave, int lane) const {
#pragma unroll
        for (int c = 0; c < 4; ++c) {
            u32x4 v;
            v.x = pk_bf16(r[0][c], r[1][c]); v.y = pk_bf16(r[2][c], r[3][c]); v.z = pk_bf16(r[4][c], r[5][c]); v.w = pk_bf16(r[6][c], r[7][c]);
            lds_st128(img + img_off(4 * lane + c, wave), v);
        }
    }
};

template <int BM, bool TRANS>
DEVI void gemm_compute(lds_t* ximg, lds_t* wimg, f32x4 (&acc)[BM / 32][4], int wr, int wc, int lane) {
    constexpr int TM = BM / 32, NH = TM / 4, NSTEP = 2 * NH;
    const int r16 = lane & 15, g = lane >> 4;
    const int c0 = g ^ ((r16 >> 1) & 7);
    lds_t* xb = ximg + (wr * (BM / 2) + r16) * 128;
    lds_t* wb = wimg + (wc * 64 + r16) * 128;
    bf16x8 wf[2][4], xf[2][4];
#define LD_W(buf, s_) do { const int o0_ = ((c0 ^ (4 * (s_))) << 4), o1_ = ((c0 ^ (4 * (s_)) ^ 1) << 4); \
        _Pragma("unroll") for (int nb = 0; nb < 4; ++nb) wf[buf][nb] = lds_ld128(wb + nb * 2048 + ((nb & 1) ? o1_ : o0_)); } while (0)
#define LD_X(buf, s_, h_) do { const int o0_ = ((c0 ^ (4 * (s_))) << 4), o1_ = ((c0 ^ (4 * (s_)) ^ 1) << 4); \
        _Pragma("unroll") for (int m4 = 0; m4 < 4; ++m4) { const int mb_ = 4 * (h_) + m4; xf[buf][m4] = lds_ld128(xb + mb_ * 2048 + ((mb_ & 1) ? o1_ : o0_)); } } while (0)
    LD_W(0, 0); LD_X(0, 0, 0);
#pragma unroll
    for (int st = 0; st < NSTEP; ++st) {
        const int s = st / NH, h = st % NH;
        if (st + 1 < NSTEP) {
            const int s1 = (st + 1) / NH, h1 = (st + 1) % NH;
            if (s1 != s) LD_W(s1 & 1, s1);
            LD_X((st + 1) & 1, s1, h1);
        }
#pragma unroll
        for (int m4 = 0; m4 < 4; ++m4)
#pragma unroll
            for (int nb = 0; nb < 4; ++nb) {
                const int mb = 4 * h + m4;
                acc[mb][nb] = TRANS ? __builtin_amdgcn_mfma_f32_16x16x32_bf16(wf[s & 1][nb], xf[st & 1][m4], acc[mb][nb], 0, 0, 0)
                                    : __builtin_amdgcn_mfma_f32_16x16x32_bf16(xf[st & 1][m4], wf[s & 1][nb], acc[mb][nb], 0, 0, 0);
            }
        __builtin_amdgcn_sched_barrier(0);
    }
#undef LD_W
#undef LD_X
}

struct WLin { const float* base; DEVI const float* operator()(int lane) const { return base + 4 * lane; } };
template <int BM> struct GemmPipe {
    static constexpr int TM = BM / 32, STAGE = (BM + 256) * 128, NI = BM / 64;
    XDma<BM> xd; const float* wp; unsigned ldw; WRegs wr_; int par;
    template <class RowFn, class WFn> DEVI void prime(lds_t* lds, const RowFn& rf, const WFn& wf, unsigned ldw_, int tid_in) {
        const int tid = tid_in;
        const int lane = tid & 63, wave = tid >> 6;
        xd.init(rf, tid); ldw = ldw_; wp = wf(lane) + (size_t)(8 * wave) * ldw_; par = 0;
        wr_.load(wp, ldw, 0);
        __syncthreads();
        xd.issue(0, lds, tid); wr_.store(lds + BM * 128, wave, lane);
        wr_.load(wp, ldw, 1);
    }
    template <bool TRANS, bool XUNIT = true, class Epi, class RowFnN, class WFnN>
    DEVI void run(lds_t* lds, int nk, const Epi& epi, bool has_next_in, const RowFnN& rfn, const WFnN& wfn, unsigned ldw_n, int tid_in) {
        int tid = tid_in; asm volatile("" : "+v"(tid));
        const int lane = tid & 63, wave = tid >> 6, wrow = wave >> 2, wcol = wave & 3;
        const bool has_next = XUNIT && has_next_in;
        f32x4 acc[TM][4];
#pragma unroll
        for (int i = 0; i < TM; ++i)
#pragma unroll
            for (int j = 0; j < 4; ++j) acc[i][j] = (f32x4){0.f, 0.f, 0.f, 0.f};
        unsigned offn[NI];
        if (XUNIT) {
#pragma unroll
            for (int j = 0; j < NI; ++j) offn[j] = 0u;
        }
        for (int t = 0; t < nk; ++t) {
            asm volatile("s_waitcnt vmcnt(0)" ::: "memory");
            __syncthreads();
            lds_t* cur = lds + ((par + t) & 1) * STAGE;
            lds_t* nxt = lds + ((par + t + 1) & 1) * STAGE;
            if (t + 2 < nk) {
                xd.issue(t + 1, nxt, tid); wr_.store(nxt + BM * 128, wave, lane); wr_.load(wp, ldw, t + 2);
            } else if (t + 1 < nk) {
                xd.issue(t + 1, nxt, tid); wr_.store(nxt + BM * 128, wave, lane);
                if (has_next) {
                    ldw = ldw_n; wp = wfn(lane) + (size_t)(8 * wave) * ldw_n; wr_.load(wp, ldw, 0);
#pragma unroll
                    for (int j = 0; j < NI; ++j) { const int row = 64 * j + 8 * wave + (lane >> 3); offn[j] = rfn.offset(row) + (((lane & 7) ^ swz(row)) << 3); }
                }
            } else if (has_next) {
                xd.base = rfn.base;
#pragma unroll
                for (int j = 0; j < NI; ++j) xd.off[j] = offn[j];
                xd.issue(0, nxt, tid); wr_.store(nxt + BM * 128, wave, lane); wr_.load(wp, ldw, 1);
            }
            gemm_compute<BM, TRANS>(cur, cur + BM * 128, acc, wrow, wcol, lane);
        }
        par = (par + nk) & 1;
        { int t2 = tid; asm volatile("" : "+v"(t2));
          const int w2 = t2 >> 6; epi(acc, w2 >> 2, w2 & 3, t2 & 63); }
    }
};

template <int BM, bool TRANS, class RowFn, class WFn, class Epi>
DEVI void gemm_unit(lds_t* lds, const RowFn& rowfn, const WFn& wfn, unsigned ldw, int nk, const Epi& epi, int tid_in) {
    int tid = tid_in; asm volatile("" : "+v"(tid));
    constexpr int TM = BM / 32;
    constexpr int STAGE = (BM + 256) * 128;
    const int lane = tid & 63, wave = tid >> 6, wr = wave >> 2, wc = wave & 3;
    XDma<BM> xd; WRegs wl;
    const float* wp = wfn(lane) + (size_t)(8 * wave) * ldw;
    wl.load(wp, ldw, 0);
    xd.init(rowfn, tid);
    f32x4 acc[TM][4];
#pragma unroll
    for (int i = 0; i < TM; ++i)
#pragma unroll
        for (int j = 0; j < 4; ++j) acc[i][j] = (f32x4){0.f, 0.f, 0.f, 0.f};
    __syncthreads();
    xd.issue(0, lds, tid); wl.store(lds + BM * 128, wave, lane);
    if (nk > 1) wl.load(wp, ldw, 1);
    for (int t = 0; t < nk; ++t) {
        asm volatile("s_waitcnt vmcnt(0)" ::: "memory");
        __syncthreads();
        lds_t* cur = lds + (t & 1) * STAGE;
        lds_t* nxt = lds + ((t + 1) & 1) * STAGE;
        if (t + 1 < nk) {
            xd.issue(t + 1, nxt, tid); wl.store(nxt + BM * 128, wave, lane);
            if (t + 2 < nk) wl.load(wp, ldw, t + 2);
        }
        gemm_compute<BM, TRANS>(cur, cur + BM * 128, acc, wr, wc, lane);
    }
    { int t2 = tid; asm volatile("" : "+v"(t2));
      const int w2 = t2 >> 6; epi(acc, w2 >> 2, w2 & 3, t2 & 63); }
}

template <int BM, bool TRANS, class RowFn, class WRowFn, class Epi>
DEVI void gemm_unit_bb(lds_t* lds, const RowFn& rowfn, const WRowFn& wrowfn, int nk, const Epi& epi, int tid_in) {
    int tid = tid_in; asm volatile("" : "+v"(tid));
    constexpr int TM = BM / 32;
    constexpr int STAGE = (BM + 256) * 128;
    const int lane = tid & 63, wave = tid >> 6, wr = wave >> 2, wc = wave & 3;
    XDma<BM> xd; XDma<256> wd;
    xd.init(rowfn, tid); wd.init(wrowfn, tid);
    f32x4 acc[TM][4];
#pragma unroll
    for (int i = 0; i < TM; ++i)
#pragma unroll
        for (int j = 0; j < 4; ++j) acc[i][j] = (f32x4){0.f, 0.f, 0.f, 0.f};
    __syncthreads();
    xd.issue(0, lds, tid); wd.issue(0, lds + BM * 128, tid);
    for (int t = 0; t < nk; ++t) {
        asm volatile("s_waitcnt vmcnt(0)" ::: "memory");
        __syncthreads();
        lds_t* cur = lds + (t & 1) * STAGE;
        lds_t* nxt = lds + ((t + 1) & 1) * STAGE;
        if (t + 1 < nk) { xd.issue(t + 1, nxt, tid); wd.issue(t + 1, nxt + BM * 128, tid); }
        gemm_compute<BM, TRANS>(cur, cur + BM * 128, acc, wr, wc, lane);
    }
    { int t2 = tid; asm volatile("" : "+v"(t2));
      const int w2 = t2 >> 6; epi(acc, w2 >> 2, w2 & 3, t2 & 63); }
}

template <int BM, bool TRANS, class RowFn, class WRowFn, class Epi>
DEVI void gemm_unit_bb3(lds_t* lds, const RowFn& rowfn, const WRowFn& wrowfn, int nk, const Epi& epi, int tid_in) {
    int tid = tid_in; asm volatile("" : "+v"(tid));
    constexpr int TM = BM / 32;
    constexpr int STAGE = (BM + 256) * 128;
    static_assert(BM == 128, "3 stages fit for BM = 128 only; the counted wait below assumes 2 + 4 DMA instructions per tile");
    const int lane = tid & 63, wave = tid >> 6, wr = wave >> 2, wc = wave & 3;
    XDma<BM> xd; XDma<256> wd;
    xd.init(rowfn, tid); wd.init(wrowfn, tid);
    f32x4 acc[TM][4];
#pragma unroll
    for (int i = 0; i < TM; ++i)
#pragma unroll
        for (int j = 0; j < 4; ++j) acc[i][j] = (f32x4){0.f, 0.f, 0.f, 0.f};
    __syncthreads();
    lds_t* s0 = lds; lds_t* s1 = lds + STAGE; lds_t* s2 = lds + 2 * STAGE;
    xd.issue(0, s0, tid); wd.issue(0, s0 + BM * 128, tid);
    if (nk > 1) { xd.issue(1, s1, tid); wd.issue(1, s1 + BM * 128, tid); }
    for (int t = 0; t < nk; ++t) {
        if (t + 1 < nk) asm volatile("s_waitcnt vmcnt(6)" ::: "memory");
        else asm volatile("s_waitcnt vmcnt(0)" ::: "memory");
        asm volatile("s_waitcnt lgkmcnt(0)" ::: "memory");
        __builtin_amdgcn_s_barrier();
        asm volatile("" ::: "memory");
        if (t + 2 < nk) { xd.issue(t + 2, s2, tid); wd.issue(t + 2, s2 + BM * 128, tid); }
        gemm_compute<BM, TRANS>(s0, s0 + BM * 128, acc, wr, wc, lane);
        lds_t* tmp = s0; s0 = s1; s1 = s2; s2 = tmp;
    }
    __syncthreads();
    { int t2 = tid; asm volatile("" : "+v"(t2));
      const int w2 = t2 >> 6; epi(acc, w2 >> 2, w2 & 3, t2 & 63); }
}

DEVI int swz32(int row) { return ((((row >> 2) ^ (row >> 3)) & 1) << 1) | ((row >> 2) & 1); }
template <int BM> struct XDma32 {
    static constexpr int NI = BM / 128;
    const bf16_t* base; unsigned off[NI];
    template <class RowFn> DEVI void init(const RowFn& rowfn, int tid) {
        const int w = tid >> 6, i = tid & 63;
        base = rowfn.base;
#pragma unroll
        for (int j = 0; j < NI; ++j) { const int row = 128 * j + 16 * w + (i >> 2); off[j] = rowfn.offset(row) + (((i & 3) ^ swz32(row)) << 3); }
    }
    DEVI void issue(int kt32, lds_t* img, int tid) const {
        lds_t* dst = img + (tid >> 6) * 1024 + (tid & 63) * 16;
#pragma unroll
        for (int j = 0; j < NI; ++j) __builtin_amdgcn_global_load_lds((const unsigned*)(base + off[j] + kt32 * 32), (LAS unsigned*)(dst + j * 8192), 16, 0, 0);
    }
};
template <int BM, bool TRANS>
DEVI void gemm_compute32(lds_t* ximg, lds_t* wimg, f32x4 (&acc)[BM / 32][4], int wr, int wc, int lane) {
    constexpr int TM = BM / 32;
    const int r16 = lane & 15, g = lane >> 4;
    const int c0 = (g ^ swz32(r16)) << 4;
    lds_t* xb = ximg + (wr * (BM / 2) + r16) * 64 + c0;
    lds_t* wb = wimg + (wc * 64 + r16) * 64 + c0;
    bf16x8 wf[4], xf[TM];
#pragma unroll
    for (int nb = 0; nb < 4; ++nb) wf[nb] = lds_ld128(wb + nb * 1024);
#pragma unroll
    for (int mb = 0; mb < TM; ++mb) xf[mb] = lds_ld128(xb + mb * 1024);
#pragma unroll
    for (int mb = 0; mb < TM; ++mb)
#pragma unroll
        for (int nb = 0; nb < 4; ++nb)
            acc[mb][nb] = TRANS ? __builtin_amdgcn_mfma_f32_16x16x32_bf16(wf[nb], xf[mb], acc[mb][nb], 0, 0, 0)
                                : __builtin_amdgcn_mfma_f32_16x16x32_bf16(xf[mb], wf[nb], acc[mb][nb], 0, 0, 0);
}
template <int BM, bool TRANS, class RowFn, class WRowFn, class Epi>
DEVI void gemm_unit_bb4(lds_t* lds, const RowFn& rowfn, const WRowFn& wrowfn, int nk2  , const Epi& epi, int tid_in) {
    int tid = tid_in; asm volatile("" : "+v"(tid));
    constexpr int TM = BM / 32;
    constexpr int XB = BM * 64, STAGE = XB + 256 * 64;
    static_assert(BM == 256, "the counted waits below assume 2 + 2 DMA instructions per sub-tile");
    const int lane = tid & 63, wave = tid >> 6, wr = wave >> 2, wc = wave & 3;
    XDma32<BM> xd; XDma32<256> wd;
    xd.init(rowfn, tid); wd.init(wrowfn, tid);
    f32x4 acc[TM][4];
#pragma unroll
    for (int i = 0; i < TM; ++i)
#pragma unroll
        for (int j = 0; j < 4; ++j) acc[i][j] = (f32x4){0.f, 0.f, 0.f, 0.f};
    __syncthreads();
#pragma unroll
    for (int t = 0; t < 3; ++t) if (t < nk2) { xd.issue(t, lds + t * STAGE, tid); wd.issue(t, lds + t * STAGE + XB, tid); }
    for (int t = 0; t < nk2; ++t) {
        const int rem = nk2 - 1 - t;
        if (rem >= 2) asm volatile("s_waitcnt vmcnt(8)" ::: "memory");
        else if (rem == 1) asm volatile("s_waitcnt vmcnt(4)" ::: "memory");
        else asm volatile("s_waitcnt vmcnt(0)" ::: "memory");
        asm volatile("s_waitcnt lgkmcnt(0)" ::: "memory");
        __builtin_amdgcn_s_barrier();
        asm volatile("" ::: "memory");
        if (t + 3 < nk2) { lds_t* st = lds + ((t + 3) & 3) * STAGE; xd.issue(t + 3, st, tid); wd.issue(t + 3, st + XB, tid); }
        lds_t* cur = lds + (t & 3) * STAGE;
        gemm_compute32<BM, TRANS>(cur, cur + XB, acc, wr, wc, lane);
    }
    __syncthreads();
    { int t2 = tid; asm volatile("" : "+v"(t2));
      const int w2 = t2 >> 6; epi(acc, w2 >> 2, w2 & 3, t2 & 63); }
}

namespace pg8 {
constexpr int BM = 256, BK = 64, HALF = 128, HTB = HALF * BK * 2  , STAGE_BYTES = 8 * HTB;
DEVI int lds_byte(int r, int c) { const int st = (r >> 4) * 2 + (c >> 5), rr = r & 15, cc = c & 31, ob = rr * 64 + cc * 2; return st * 1024 + (ob ^ (((ob >> 9) & 1) << 5)); }
DEVI void stage_rc(int b, int& R, int& C) { const int st = b / 1024, sb = b % 1024, swz = sb ^ (((sb >> 9) & 1) << 5); R = (st >> 1) * 16 + swz / 64; C = (st & 1) * 32 + (swz % 64) / 2; }
DEVI int perm32(int rho) { const int n = rho >> 4, i = rho & 15; return 8 * (i >> 2) + 4 * n + (i & 3); }
struct Unit { int pm, pn, aux; };

template <class Epi, class Sched>
DEVI void gemm_phase(lds_t* lds, const int ldk  , const int nt  , const Sched& S, const Epi& E, const int tid,
                      const int hrowsA = HALF, const int hrowsB = HALF  ) {
    const int wid = __builtin_amdgcn_readfirstlane(tid >> 6), lane = tid & 63, wr = wid >> 2, wc = wid & 3, fr = lane & 15, fq = lane >> 4;
    unsigned voffA[2], voffB[2];
#pragma unroll
    for (int i = 0; i < 2; ++i) { int R, C; stage_rc(tid * 16 + i * 8192, R, C); const int Rb = Epi::PERM ? ((R & ~31) + perm32(R & 31)) : R;
        voffA[i] = (unsigned)(R * ldk + C) * 2u; voffB[i] = (unsigned)(Rb * ldk + C) * 2u; }
    const size_t kstep = (size_t)(BK * 2);
    const size_t hstepA = (size_t)hrowsA * ldk * 2, hstepB = (size_t)hrowsB * ldk * 2;
    const unsigned ldsw = (unsigned)wid * 1024u;
    const int aoff = lds_byte(wr * 64 + fr, fq * 8), boff = lds_byte(wc * 32 + fr, fq * 8);
#define PG8_SA(b, h) (((b) * 2 + (h)) * HTB)
#define PG8_SB(b, h) ((4 + (b) * 2 + (h)) * HTB)
#define PG8_STAGE(bufoff, gbase, voff) do { _Pragma("unroll") for (int _i = 0; _i < 2; ++_i) \
        __builtin_amdgcn_global_load_lds((const unsigned*)((const char*)(gbase) + (voff)[_i]), (LAS unsigned*)(lds + (bufoff) + ldsw + _i * 8192), 16, 0, 0); } while (0)
#define PG8_LDA(dst, b, h) do { _Pragma("unroll") for (int m = 0; m < 4; ++m) _Pragma("unroll") for (int k = 0; k < 2; ++k) dst[m][k] = *(const LAS bf16x8*)(lds + PG8_SA(b, h) + aoff + m * 2048 + k * 1024); } while (0)
#define PG8_LDB(dst, b, h) do { _Pragma("unroll") for (int n = 0; n < 2; ++n) _Pragma("unroll") for (int k = 0; k < 2; ++k) dst[n][k] = *(const LAS bf16x8*)(lds + PG8_SB(b, h) + boff + n * 2048 + k * 1024); } while (0)
#define PG8_MMA(ai, bj, At, Bt) do { __builtin_amdgcn_s_setprio(1); _Pragma("unroll") for (int m = 0; m < 4; ++m) _Pragma("unroll") for (int n = 0; n < 2; ++n) _Pragma("unroll") for (int k = 0; k < 2; ++k) \
        acc[ai][bj][m][n] = __builtin_amdgcn_mfma_f32_16x16x32_bf16(Bt[n][k], At[m][k], acc[ai][bj][m][n], 0, 0, 0); __builtin_amdgcn_s_setprio(0); } while (0)
#define PG8_WAIT_V(n) asm volatile("s_waitcnt vmcnt(" #n ")" ::: "memory")
#define PG8_WAIT_L(n) asm volatile("s_waitcnt lgkmcnt(" #n ")" ::: "memory")
#define PG8_BAR __builtin_amdgcn_s_barrier()
#define PG8_SCHED __builtin_amdgcn_sched_barrier(0)
    Unit cur, nxt; int ui = 0;
    __syncthreads();
    if (!S.next(0, cur)) return;
    f32x4 acc[2][2][4][2];
#pragma unroll
    for (int a = 0; a < 2; ++a)
#pragma unroll
        for (int b = 0; b < 2; ++b)
#pragma unroll
            for (int m = 0; m < 4; ++m)
#pragma unroll
                for (int n = 0; n < 2; ++n) acc[a][b][m][n] = (f32x4){0.f, 0.f, 0.f, 0.f};
    bf16x8 At[4][2], B0[2][2], B1[2][2];
    const char* cA; const char* cB;
    S.ptrs(cur, cA, cB);
    PG8_STAGE(PG8_SB(0, 0), cB, voffB); PG8_STAGE(PG8_SA(0, 0), cA, voffA); PG8_STAGE(PG8_SB(0, 1), cB + hstepB, voffB); PG8_STAGE(PG8_SA(0, 1), cA + hstepA, voffA);
    if (wr == 1) PG8_BAR;
    PG8_WAIT_V(4); PG8_BAR;
    PG8_STAGE(PG8_SB(1, 0), cB + kstep, voffB); PG8_STAGE(PG8_SA(1, 0), cA + kstep, voffA); PG8_STAGE(PG8_SB(1, 1), cB + hstepB + kstep, voffB);
    PG8_WAIT_V(6); PG8_BAR;
    for (;;) {
        const bool has_next = S.next(ui + 1, nxt);
        const char* nA = cA; const char* nB = cB;
        if (has_next) S.ptrs(nxt, nA, nB);
        for (int t = 0; t < nt; t += 2) {
            const bool last = (t == nt - 2);
            const char* a1 = cA + (size_t)(t + 1) * kstep;
            const char* a2 = last ? nA : cA + (size_t)(t + 2) * kstep; const char* b2 = last ? nB : cB + (size_t)(t + 2) * kstep;
            const char* a3 = a2 + kstep; const char* b3 = b2 + kstep;
            PG8_LDB(B0, 0, 0); PG8_SCHED; PG8_LDA(At, 0, 0); PG8_STAGE(PG8_SA(1, 1), a1 + hstepA, voffA);
            PG8_WAIT_L(8); PG8_BAR; PG8_WAIT_L(0); PG8_MMA(0, 0, At, B0); PG8_BAR; PG8_SCHED;
            PG8_LDB(B1, 0, 1); PG8_STAGE(PG8_SB(0, 0), b2, voffB);
            PG8_BAR; PG8_WAIT_L(0); PG8_MMA(0, 1, At, B1); PG8_BAR;
            PG8_LDA(At, 0, 1); PG8_STAGE(PG8_SA(0, 0), a2, voffA);
            PG8_BAR; PG8_WAIT_L(0); PG8_MMA(1, 0, At, B0); PG8_BAR; PG8_SCHED;
            PG8_STAGE(PG8_SB(0, 1), b2 + hstepB, voffB);
            PG8_WAIT_V(6); PG8_BAR; PG8_MMA(1, 1, At, B1); PG8_BAR;
            PG8_LDB(B0, 1, 0); PG8_SCHED; PG8_LDA(At, 1, 0); PG8_STAGE(PG8_SA(0, 1), a2 + hstepA, voffA);
            PG8_WAIT_L(8); PG8_BAR; PG8_WAIT_L(0); PG8_MMA(0, 0, At, B0); PG8_BAR; PG8_SCHED;
            PG8_LDB(B1, 1, 1); PG8_STAGE(PG8_SB(1, 0), b3, voffB);
            PG8_BAR; PG8_WAIT_L(0); PG8_MMA(0, 1, At, B1); PG8_BAR;
            PG8_LDA(At, 1, 1); PG8_STAGE(PG8_SA(1, 0), a3, voffA);
            PG8_BAR; PG8_WAIT_L(0); PG8_MMA(1, 0, At, B0); PG8_BAR; PG8_SCHED;
            PG8_STAGE(PG8_SB(1, 1), b3 + hstepB, voffB);
            PG8_WAIT_V(6); PG8_BAR; PG8_MMA(1, 1, At, B1); PG8_BAR;
        }
        { const int ln = lane_id_fresh(); E(acc, cur, wr, wc, ln & 15, ln >> 4); }
        if (!has_next) break;
#pragma unroll
        for (int a = 0; a < 2; ++a)
#pragma unroll
            for (int b = 0; b < 2; ++b)
#pragma unroll
                for (int m = 0; m < 4; ++m)
#pragma unroll
                    for (int n = 0; n < 2; ++n) acc[a][b][m][n] = (f32x4){0.f, 0.f, 0.f, 0.f};
        cur = nxt; cA = nA; cB = nB; ++ui;
    }
    PG8_WAIT_V(0);
    if (wr == 0) PG8_BAR;
    PG8_BAR;
#undef PG8_SA
#undef PG8_SB
#undef PG8_STAGE
#undef PG8_LDA
#undef PG8_LDB
#undef PG8_MMA
#undef PG8_WAIT_V
#undef PG8_WAIT_L
#undef PG8_BAR
#undef PG8_SCHED
}
}

DEVI void phase_modulation(const Params& p, lds_t* lds, int bid, int nblk, int tid) {
    LAS float* sc = (LAS float*)lds;
    LAS float* red = (LAS float*)(lds + 20480);
    __syncthreads();
    for (int i = tid; i < 5 * 1024; i += NTHREADS) {
        const int cnd = i >> 10, k = i & 1023;
        const float v = cnd == 0 ? p.c_ctx[k] : p.c[(cnd - 1) * 1024 + k];
        sc[i] = silu_f(v);
    }
    __syncthreads();
    const int cg = tid & 31, kg = tid >> 5;
    for (int u = bid; u < DEPTH * 48; u += nblk) {
        const int l = u / 48, n0 = (u % 48) * 128;
        const float* w = p.mod_w + (size_t)l * 1024 * 6144 + n0 + 4 * cg;
        f32x4 a[5];
#pragma unroll
        for (int c = 0; c < 5; ++c) a[c] = (f32x4){0.f, 0.f, 0.f, 0.f};
#pragma unroll 8
        for (int kk = 0; kk < 64; ++kk) {
            const int k = kg * 64 + kk;
            const f32x4 wv = *(const f32x4*)(w + (size_t)k * 6144);
#pragma unroll
            for (int c = 0; c < 5; ++c) a[c] += wv * sc[c * 1024 + k];
        }
#pragma unroll
        for (int c = 0; c < 5; ++c) *(LAS f32x4*)(red + (kg * 5 + c) * 128 + 4 * cg) = a[c];
        __syncthreads();
        for (int i = tid; i < 5 * 128; i += NTHREADS) {
            const int c = i >> 7, n = i & 127;
            float s = 0.f;
#pragma unroll
            for (int q = 0; q < 16; ++q) s += red[(q * 5 + c) * 128 + n];
            p.mod[(size_t)(l * 5 + c) * 6144 + n0 + n] = s + p.mod_b[l * 6144 + n0 + n];
        }
        __syncthreads();
    }
}


DEVI void wconv_tile(const float* W, bf16_t* Wt, int K, int N, int tk, int tn, lds_t* lds, int tid) {
    LAS bf16_t* s = (LAS bf16_t*)lds;
    __syncthreads();
#pragma unroll
    for (int i = 0; i < 2; ++i) {
        const int c = tid + NTHREADS * i, k = c >> 4, n4 = (c & 15) * 4;
        const f32x4 v = *(const f32x4*)(W + (size_t)(tk * 64 + k) * N + tn * 64 + n4);
#pragma unroll
        for (int q = 0; q < 4; ++q) s[(n4 + q) * 72 + k] = (bf16_t)(pk_bf16(v[q], 0.f) & 0xffffu);
    }
    __syncthreads();
    { const int n = tid >> 3, kc = tid & 7;
      const u32x4 v = *(LAS u32x4*)(s + n * 72 + kc * 8);
      *(u32x4*)(Wt + (size_t)(tn * 64 + n) * K + tk * 64 + kc * 8) = v; }
}
DEVI void phase_wconv(const Params& p, lds_t* lds, int bid, int nblk, int tid) {
    for (int it = bid; it < 4352; it += nblk) {
        int r = it; const float* W; bf16_t* Wt; int K, N;
        if (r < 352) { const int j = r / 176; r %= 176; W = p.mla_w_in + (size_t)j * 1024 * 704; Wt = p.WTI + (size_t)j * 704 * 1024; K = 1024; N = 704; }
        else if ((r -= 352) < 288) { const int j = r / 144; r %= 144; W = p.mla_w_q_up + (size_t)j * 384 * 1536; Wt = p.WTQ + (size_t)j * 1536 * 384; K = 384; N = 1536; }
        else if ((r -= 288) < 256) { const int j = r / 128; r %= 128; W = p.mla_w_kv_up + (size_t)j * 256 * 2048; Wt = p.WTKV + (size_t)j * 2048 * 256; K = 256; N = 2048; }
        else if ((r -= 256) < 512) { const int j = r / 256; r %= 256; W = p.mla_w_out + (size_t)j * 1024 * 1024; Wt = p.WTO + (size_t)j * 1024 * 1024; K = 1024; N = 1024; }
        else if ((r -= 512) < 1536) { W = p.gm_w_in; Wt = p.WTGI; K = 1024; N = 6144; }
        else if ((r -= 1536) < 768) { W = p.gm_w_out; Wt = p.WTGO; K = 3072; N = 1024; }
        else if ((r -= 768) < 384) { W = p.swa_w_qkv; Wt = p.WTSQ; K = 1024; N = 1536; }
        else { r -= 384; W = p.swa_w_out; Wt = p.WTSO; K = 1024; N = 1024; }
        const int ntn = N / 64;
        wconv_tile(W, Wt, K, N, r / ntn, r % ntn, lds, tid);
    }
}

DEVI void phase_prep(const Params& p, int bid, int nblk, int tid) {
    const int lane = tid & 63, wave = tid >> 6;
    for (int row = bid * 8 + wave; row < NTOK; row += nblk * 8) {
        const float* src = row < NPR ? p.x_prompt + (size_t)row * D : p.x_sample + (size_t)(row - NPR) * D;
        const int cnd = cond_of_row(row);
        const float* sh = modp(p, 0, cnd, 0); const float* scl = modp(p, 0, cnd, 1);
#pragma unroll
        for (int i = 0; i < 4; ++i) {
            const int col = lane * 4 + 256 * i;
            const f32x4 v = *(const f32x4*)(src + col);
            const f32x4 s = *(const f32x4*)(scl + col), b = *(const f32x4*)(sh + col);
            const f32x4 h = v * (s + 1.0f) + b;
            u32x2 o; o.x = pk_bf16(h[0], h[1]); o.y = pk_bf16(h[2], h[3]);
            *(u32x2*)(p.H + (size_t)row * D + col) = o;
        }
    }
    for (int i = bid * NTHREADS + tid; i < 1024 * 64; i += nblk * NTHREADS) {
        const f32x4 v = *(const f32x4*)(p.cache_k + (size_t)i * 4);
        u32x2 o; o.x = pk_bf16(v[0], v[1]); o.y = pk_bf16(v[2], v[3]);
        *(u32x2*)(p.SK + (size_t)NTOK * 256 + (size_t)i * 4) = o;
    }
    for (int i = bid * NTHREADS + tid; i < 4 * 4 * 64 * 64; i += nblk * NTHREADS) {
        const int kg4 = i & 63, dv = (i >> 6) & 63, kvh = (i >> 12) & 3, b = i >> 14;
        float v[4];
#pragma unroll
        for (int q = 0; q < 4; ++q) v[q] = p.cache_v[((size_t)(b * 256 + kg4 * 4 + q) * 4 + kvh) * 64 + dv];
        u32x2 o; o.x = pk_bf16(v[0], v[1]); o.y = pk_bf16(v[2], v[3]);
        *(u32x2*)(p.SVTS + ((size_t)(b * 4 + kvh) * 64 + dv) * 1280 + kg4 * 4) = o;
    }
}

DEVI void phase_mla_norm(const Params& p, int j, int bid, int nblk, int tid) {
    const int lane = tid & 63, wave = tid >> 6;
    const float* qg = p.mla_q_gain + j * 384; const float* kg = p.mla_kv_gain + j * 256;
    for (int row = bid * 8 + wave; row < NROWS_KV; row += nblk * 8) {
        if (row >= NTOK) {
            const int b = (row - NTOK) >> 8, t = (row - NTOK) & 255;
            const float* ck = p.cache_ckv + ((size_t)(b * 2 + j) * 256 + t) * 256;
            const f32x4 v = *(const f32x4*)(ck + lane * 4);
            u32x2 o; o.x = pk_bf16(v[0], v[1]); o.y = pk_bf16(v[2], v[3]);
            *(u32x2*)(p.CKV + (size_t)row * 256 + lane * 4) = o;
            const float kp = p.cache_kpe[((size_t)(b * 2 + j) * 256 + t) * 64 + lane];
            p.KPE[(size_t)row * 64 + lane] = (bf16_t)(pk_bf16(kp, 0.f) & 0xffffu);
            continue;
        }
        const float* z = p.Z + (size_t)row * 704;
        float q[6]; float ss = 0.f;
#pragma unroll
        for (int i = 0; i < 6; ++i) { q[i] = z[lane + 64 * i]; ss += q[i] * q[i]; }
        ss = wave_sum(ss);
        const float rq = rsqrtf(ss * (1.0f / 384.0f) + EPS_F);
#pragma unroll
        for (int i = 0; i < 6; ++i) p.CQ[(size_t)row * 384 + lane + 64 * i] = (bf16_t)(pk_bf16(q[i] * rq * qg[lane + 64 * i], 0.f) & 0xffffu);
        const f32x4 kv = *(const f32x4*)(z + 384 + lane * 4);
        float s2 = kv[0] * kv[0] + kv[1] * kv[1] + kv[2] * kv[2] + kv[3] * kv[3];
        s2 = wave_sum(s2);
        const float rk = rsqrtf(s2 * (1.0f / 256.0f) + EPS_F);
        const f32x4 gv = *(const f32x4*)(kg + lane * 4);
        const f32x4 kn = kv * rk * gv;
        { u32x2 o; o.x = pk_bf16(kn[0], kn[1]); o.y = pk_bf16(kn[2], kn[3]); *(u32x2*)(p.CKV + (size_t)row * 256 + lane * 4) = o; }
        float kp = z[640 + lane];
        if (row < NPR) {
            const int b = row >> 8, t = row & 255;
            *(f32x4*)(p.out + OUT_CKV + ((size_t)(b * 2 + j) * 256 + t) * 256 + lane * 4) = kn;
            p.out[OUT_KPE + ((size_t)(b * 2 + j) * 256 + t) * 64 + lane] = kp;
        } else {
            const int t = (row - NPR) & 1023;
            const int pos = lane < 32 ? (t >> 6) : (t & 63);
            const float cs = rope_tab[(pos * 16 + (lane & 15)) * 2], sn = rope_tab[(pos * 16 + (lane & 15)) * 2 + 1];
            const float other = __shfl_xor(kp, 16);
            kp = (lane & 16) ? (kp * cs + other * sn) : (kp * cs - other * sn);
        }
        p.KPE[(size_t)row * 64 + lane] = (bf16_t)(pk_bf16(kp, 0.f) & 0xffffu);
    }
}

DEVI void phase_ln_a(const Params& p, int layer, lds_t* lds, int bid, int nblk, int tid) {
    const int lane = tid & 63, wave = tid >> 6;
    LAS float* rt = (LAS float*)lds;
    const float* router = p.moe_router + (size_t)layer * 1024 * 16;
    __syncthreads();
    for (int i = tid; i < 4096; i += NTHREADS) {
        const f32x4 w = *(const f32x4*)(router + i * 4);
        const int k = i >> 2, e0 = (i & 3) * 4;
        rt[(e0 + 0) * 1024 + k] = w[0]; rt[(e0 + 1) * 1024 + k] = w[1]; rt[(e0 + 2) * 1024 + k] = w[2]; rt[(e0 + 3) * 1024 + k] = w[3];
    }
    __syncthreads();
    const float* lg = p.ln_gain + (layer * 2 + 0) * 1024; const float* lb = p.ln_bias + (layer * 2 + 0) * 1024;
    for (int r0 = (bid * 8 + wave) * 4; r0 < NTOK; r0 += nblk * 32) {
        const int cnd = cond_of_row(r0);
        const float* sh = modp(p, layer, cnd, 3); const float* scl = modp(p, layer, cnd, 4);
        f32x4 v[4][4];
        float mu[4], rs[4];
        const float* xin = (r0 < NPR ? p.x_prompt : p.x_sample - (size_t)NPR * D);
        const bf16_t* X0b = (const bf16_t*)p.X0;
        const bf16_t* Y0 = (const bf16_t*)p.T; const bf16_t* Y1 = Y0 + (size_t)NTOK * D;
#pragma unroll
        for (int j = 0; j < 4; ++j)
#pragma unroll
            for (int i = 0; i < 4; ++i) {
                const size_t o = (size_t)(r0 + j) * D + lane * 4 + 256 * i;
                const u32x2 ya = *(const u32x2*)(Y0 + o), yb = *(const u32x2*)(Y1 + o);
                f32x4 yv; yv[0] = bf_lo(ya.x) + bf_lo(yb.x); yv[1] = bf_hi(ya.x) + bf_hi(yb.x); yv[2] = bf_lo(ya.y) + bf_lo(yb.y); yv[3] = bf_hi(ya.y) + bf_hi(yb.y);
                f32x4 xr;
                if (layer) { const u32x2 xb = *(const u32x2*)(X0b + o); xr[0] = bf_lo(xb.x); xr[1] = bf_hi(xb.x); xr[2] = bf_lo(xb.y); xr[3] = bf_hi(xb.y); }
                else xr = *(const f32x4*)(xin + o);
                v[j][i] = xr * ALPHA_F + yv;
            }
#pragma unroll
        for (int j = 0; j < 4; ++j) { float s = 0.f;
#pragma unroll
            for (int i = 0; i < 4; ++i) s += (v[j][i][0] + v[j][i][1]) + (v[j][i][2] + v[j][i][3]);
            mu[j] = s; }
#pragma unroll
        for (int j = 0; j < 4; ++j) mu[j] = wave_sum(mu[j]) * (1.0f / 1024.0f);
#pragma unroll
        for (int j = 0; j < 4; ++j) { float q = 0.f;
#pragma unroll
            for (int i = 0; i < 4; ++i) { v[j][i] = v[j][i] - mu[j]; q += (v[j][i][0] * v[j][i][0] + v[j][i][1] * v[j][i][1]) + (v[j][i][2] * v[j][i][2] + v[j][i][3] * v[j][i][3]); }
            rs[j] = q; }
#pragma unroll
        for (int j = 0; j < 4; ++j) rs[j] = rsqrtf(wave_sum(rs[j]) * (1.0f / 1024.0f) + EPS_F);
        float lgt[4][16];
#pragma unroll
        for (int j = 0; j < 4; ++j)
#pragma unroll
            for (int e = 0; e < 16; ++e) lgt[j][e] = 0.f;
#pragma unroll
        for (int i = 0; i < 4; ++i) {
            const int col = lane * 4 + 256 * i;
            const f32x4 g4 = *(const f32x4*)(lg + col), b4 = *(const f32x4*)(lb + col), sc4 = *(const f32x4*)(scl + col) + 1.0f, sh4 = *(const f32x4*)(sh + col);
            f32x4 h[4];
#pragma unroll
            for (int j = 0; j < 4; ++j) {
                const f32x4 x = v[j][i] * rs[j] * g4 + b4;
                { u32x2 xo; xo.x = pk_bf16(x[0], x[1]); xo.y = pk_bf16(x[2], x[3]); *(u32x2*)((bf16_t*)p.X1 + (size_t)(r0 + j) * D + col) = xo; }
                h[j] = x * sc4 + sh4;
                u32x2 o; o.x = pk_bf16(h[j][0], h[j][1]); o.y = pk_bf16(h[j][2], h[j][3]);
                *(u32x2*)(p.H2 + (size_t)(r0 + j) * D + col) = o;
            }
#pragma unroll
            for (int e = 0; e < 16; ++e) {
                const f32x4 rw = *(LAS f32x4*)(rt + e * 1024 + col);
#pragma unroll
                for (int j = 0; j < 4; ++j) lgt[j][e] += (h[j][0] * rw[0] + h[j][1] * rw[1]) + (h[j][2] * rw[2] + h[j][3] * rw[3]);
                if ((e & 3) == 3) __builtin_amdgcn_sched_barrier(0);
            }
        }
        float r1[4];
#pragma unroll
        for (int j = 0; j < 4; ++j) {
            float r8[8], r4[4], r2[2];
            { const bool hi = (lane & 32) != 0;
#pragma unroll
              for (int i = 0; i < 8; ++i) { const float keep = hi ? lgt[j][8 + i] : lgt[j][i], send = hi ? lgt[j][i] : lgt[j][8 + i]; r8[i] = keep + __shfl_xor(send, 32); } }
            { const bool hi = (lane & 16) != 0;
#pragma unroll
              for (int i = 0; i < 4; ++i) { const float keep = hi ? r8[4 + i] : r8[i], send = hi ? r8[i] : r8[4 + i]; r4[i] = keep + __shfl_xor(send, 16); } }
            { const bool hi = (lane & 8) != 0;
#pragma unroll
              for (int i = 0; i < 2; ++i) { const float keep = hi ? r4[2 + i] : r4[i], send = hi ? r4[i] : r4[2 + i]; r2[i] = keep + __shfl_xor(send, 8); } }
            { const bool hi = (lane & 4) != 0; const float keep = hi ? r2[1] : r2[0], send = hi ? r2[0] : r2[1]; r1[j] = keep + __shfl_xor(send, 4); }
        }
        const int e = ((lane >> 5) & 1) * 8 + ((lane >> 4) & 1) * 4 + ((lane >> 3) & 1) * 2 + ((lane >> 2) & 1);
#pragma unroll
        for (int j = 0; j < 4; ++j) {
            float r = r1[j];
            r += __shfl_xor(r, 2); r += __shfl_xor(r, 1);
            float mx = r;
            mx = fmaxf(mx, __shfl_xor(mx, 4)); mx = fmaxf(mx, __shfl_xor(mx, 8)); mx = fmaxf(mx, __shfl_xor(mx, 16)); mx = fmaxf(mx, __shfl_xor(mx, 32));
            const float ex = __expf(r - mx);
            float den = ex;
            den += __shfl_xor(den, 4); den += __shfl_xor(den, 8); den += __shfl_xor(den, 16); den += __shfl_xor(den, 32);
            if ((lane & 3) == 0) p.AFF[(size_t)e * NTOK + r0 + j] = ex / den;
        }
    }
}

DEVI int block_sum_i(int v, LAS int* red, int tid) {
    const int lane = tid & 63, wave = tid >> 6;
    v = __builtin_popcountll(__ballot(v & 1)) + 2 * __builtin_popcountll(__ballot(v & 2)) + 4 * __builtin_popcountll(__ballot(v & 4)) + 8 * __builtin_popcountll(__ballot(v & 8));
    __syncthreads();
    if (lane == 0) red[wave] = v;
    __syncthreads();
    return (red[0] + red[1]) + (red[2] + red[3]) + (red[4] + red[5]) + (red[6] + red[7]);
}
DEVI int block_excl_scan_i(int v, LAS int* red, int tid, int& total) {
    const int lane = tid & 63, wave = tid >> 6;
    int inc = v;
#pragma unroll
    for (int o = 1; o < 64; o <<= 1) { const int t = __shfl_up(inc, o); if (lane >= o) inc += t; }
    __syncthreads();
    if (lane == 63) red[wave] = inc;
    __syncthreads();
    int base = 0, tot = 0;
#pragma unroll
    for (int w = 0; w < 8; ++w) { const int c = red[w]; if (w < wave) base += c; tot += c; }
    total = tot;
    return base + inc - v;
}
DEVI int wave_sum_i(int v) {
#pragma unroll
    for (int o = 32; o > 0; o >>= 1) v += __shfl_xor(v, o);
    return v;
}
DEVI void phase_topk(const Params& p, lds_t* lds, int bid, int nblk, int tid) {
    LAS int* red = (LAS int*)lds;
    const int lane = tid & 63, wave = tid >> 6;
    for (int it = bid; it < 32; it += nblk) {
        const int grp = it >> 4, e = it & 15;
        const float* a = p.AFF + (size_t)e * NTOK + grp * 4096 + tid * 8;
        const f32x4 a0 = *(const f32x4*)a, a1 = *(const f32x4*)(a + 4);
        unsigned key[8];
#pragma unroll
        for (int i = 0; i < 4; ++i) { key[i] = __float_as_uint(a0[i]); key[4 + i] = __float_as_uint(a1[i]); }
        __syncthreads();
        unsigned thr = 0u;
        for (int lo = 30; lo >= 0; lo -= 2) {
            const unsigned c1 = thr | (1u << lo), c2 = thr | (2u << lo), c3 = thr | (3u << lo);
            int w1 = 0, w2 = 0, w3 = 0;
#pragma unroll
            for (int i = 0; i < 8; ++i) { w1 += __builtin_popcountll(__ballot(key[i] >= c1)); w2 += __builtin_popcountll(__ballot(key[i] >= c2)); w3 += __builtin_popcountll(__ballot(key[i] >= c3)); }
            const int c = w1 | (w2 << 10) | (w3 << 20);
            LAS int* r = red + ((lo >> 1) & 1) * 8;
            if (lane == 0) r[wave] = c;
            __syncthreads();
            int n1 = 0, n2 = 0, n3 = 0;
#pragma unroll
            for (int w = 0; w < 8; ++w) { const int v = r[w]; n1 += v & 1023; n2 += (v >> 10) & 1023; n3 += v >> 20; }
            thr = n3 >= 512 ? c3 : (n2 >= 512 ? c2 : (n1 >= 512 ? c1 : thr));
        }
        int cgt = 0, ceq = 0;
#pragma unroll
        for (int i = 0; i < 8; ++i) { cgt += key[i] > thr ? 1 : 0; ceq += key[i] == thr ? 1 : 0; }
        int both;
        const int pre = block_excl_scan_i(cgt | (ceq << 16), red + 16, tid, both);
        const int ngt = both & 0xffff;
        int tie_rank = pre >> 16;
        const int need = 512 - ngt;
        int sel[8], cs = 0;
#pragma unroll
        for (int i = 0; i < 8; ++i) {
            const bool eq = key[i] == thr;
            sel[i] = (key[i] > thr || (eq && tie_rank < need)) ? 1 : 0;
            tie_rank += eq ? 1 : 0; cs += sel[i];
        }
        int tot;
        int slot = block_excl_scan_i(cs, red + 24, tid, tot);
        int slv[8];
#pragma unroll
        for (int i = 0; i < 8; ++i) {
            const int t = grp * 4096 + tid * 8 + i;
            int sl = -1;
            if (sel[i]) { sl = grp * 512 + slot; ++slot; p.IDX[e * 1024 + sl] = t; p.GATEV[e * 1024 + sl] = __uint_as_float(key[i]); }
            slv[i] = sl;
        }
        {
            int* dst = p.SEL + (size_t)e * NTOK + grp * 4096 + tid * 8;
            i32x4 s0, s1; s0.x = slv[0]; s0.y = slv[1]; s0.z = slv[2]; s0.w = slv[3]; s1.x = slv[4]; s1.y = slv[5]; s1.z = slv[6]; s1.w = slv[7];
            *(i32x4*)dst = s0; *(i32x4*)(dst + 4) = s1;
        }
    }
}

DEVI void phase_ln_b(const Params& p, int layer, int bid, int nblk, int tid) {
    const int lane = tid & 63, wave = tid >> 6;
    const float* lg = p.ln_gain + (layer * 2 + 1) * 1024; const float* lb = p.ln_bias + (layer * 2 + 1) * 1024;
    const bool last = (layer == DEPTH - 1);
    float* xo = p.out + OUT_Y; bf16_t* X0b = (bf16_t*)p.X0; const bf16_t* X1b = (const bf16_t*)p.X1;
    const int stride = nblk * 8;
    int row = bid * 8 + wave;
    int seln = -1; u32x2 xn[4];
    if (row < NTOK) {
        if (lane < 16) seln = p.SEL[(size_t)lane * NTOK + row];
#pragma unroll
        for (int i = 0; i < 4; ++i) xn[i] = *(const u32x2*)(X1b + (size_t)row * D + lane * 4 + 256 * i);
    }
    for (; row < NTOK; row += stride) {
        const int selv = seln;
        f32x4 v[4];
#pragma unroll
        for (int i = 0; i < 4; ++i) { v[i][0] = bf_lo(xn[i].x); v[i][1] = bf_hi(xn[i].x); v[i][2] = bf_lo(xn[i].y); v[i][3] = bf_hi(xn[i].y); }
        unsigned long long mask = __ballot(selv >= 0);
        f32x4 y[4];
#pragma unroll
        for (int i = 0; i < 4; ++i) y[i] = (f32x4){0.f, 0.f, 0.f, 0.f};
        while (mask) {
            const int e0 = __builtin_ctzll(mask); mask &= mask - 1;
            const int s0 = __builtin_amdgcn_readlane(selv, e0);
            const bf16_t* y0 = p.YE + ((size_t)e0 * 1024 + s0) * 1024 + lane * 4;
            const bool two = mask != 0;
            int e1 = e0, s1 = s0;
            if (two) { e1 = __builtin_ctzll(mask); mask &= mask - 1; s1 = __builtin_amdgcn_readlane(selv, e1); }
            const bf16_t* y1 = p.YE + ((size_t)e1 * 1024 + s1) * 1024 + lane * 4;
            u32x2 w0[4], w1[4];
#pragma unroll
            for (int i = 0; i < 4; ++i) { w0[i] = *(const u32x2*)(y0 + 256 * i); w1[i] = *(const u32x2*)(y1 + 256 * i); }
            const float f1 = two ? 1.0f : 0.0f;
#pragma unroll
            for (int i = 0; i < 4; ++i) {
                y[i][0] += bf_lo(w0[i].x) + f1 * bf_lo(w1[i].x); y[i][1] += bf_hi(w0[i].x) + f1 * bf_hi(w1[i].x);
                y[i][2] += bf_lo(w0[i].y) + f1 * bf_lo(w1[i].y); y[i][3] += bf_hi(w0[i].y) + f1 * bf_hi(w1[i].y);
            }
        }
        if (row + stride < NTOK) {
            seln = -1;
            if (lane < 16) seln = p.SEL[(size_t)lane * NTOK + row + stride];
#pragma unroll
            for (int i = 0; i < 4; ++i) xn[i] = *(const u32x2*)(X1b + (size_t)(row + stride) * D + lane * 4 + 256 * i);
        }
        const int cnd = cond_of_row(row);
        const float* gt = modp(p, layer, cnd, 5);
        float s = 0.f;
#pragma unroll
        for (int i = 0; i < 4; ++i) {
            const int col = lane * 4 + 256 * i;
            v[i] = v[i] * ALPHA_F + *(const f32x4*)(gt + col) * y[i];
            s += (v[i][0] + v[i][1]) + (v[i][2] + v[i][3]);
        }
        s = wave_sum(s);
        const float mu = s * (1.0f / 1024.0f);
        float q = 0.f;
#pragma unroll
        for (int i = 0; i < 4; ++i) { v[i] = v[i] - mu; q += (v[i][0] * v[i][0] + v[i][1] * v[i][1]) + (v[i][2] * v[i][2] + v[i][3] * v[i][3]); }
        q = wave_sum(q);
        const float rs = rsqrtf(q * (1.0f / 1024.0f) + EPS_F);
        const float* sh = modp(p, last ? layer : layer + 1, cnd, 0); const float* scl = modp(p, last ? layer : layer + 1, cnd, 1);
#pragma unroll
        for (int i = 0; i < 4; ++i) {
            const int col = lane * 4 + 256 * i;
            const f32x4 x = v[i] * rs * *(const f32x4*)(lg + col) + *(const f32x4*)(lb + col);
            if (last) *(f32x4*)(xo + (size_t)row * D + col) = x;
            else {
                { u32x2 xb; xb.x = pk_bf16(x[0], x[1]); xb.y = pk_bf16(x[2], x[3]); *(u32x2*)(X0b + (size_t)row * D + col) = xb; }
                const f32x4 h = x * (*(const f32x4*)(scl + col) + 1.0f) + *(const f32x4*)(sh + col);
                u32x2 o; o.x = pk_bf16(h[0], h[1]); o.y = pk_bf16(h[2], h[3]);
                *(u32x2*)(p.H + (size_t)row * D + col) = o;
            }
        }
    }
}

constexpr int GBM = 128;
constexpr int GBM2 = 256;
DEVI int xcd_first_unit(int bid, int nblk) { return (nblk & 7) ? bid : (bid & 7) * (nblk >> 3) + (bid >> 3); }
struct RowLin { const bf16_t* base; unsigned ld; DEVI unsigned offset(int r) const { return (unsigned)r * ld; } };
struct RowGather { const bf16_t* base; const int* idx; DEVI unsigned offset(int r) const { return (unsigned)(idx[r] & 8191) * 1024u; } };
struct RowClamp { const bf16_t* base; unsigned ld; int r0, rmax; DEVI unsigned offset(int r) const { int q = r0 + r; if (q > rmax) q = rmax; return (unsigned)q * ld; } };
struct RowKv { const bf16_t* base; int n0, isv; DEVI unsigned offset(int r) const { const int n = n0 + r; return (unsigned)((n >> 7) * 256 + isv * 128 + (n & 127)) * 256u; } };
struct GDesc { RowLin rf; WLin wl; unsigned ldw; int nk; };
struct WUp { const float* base; int kv; DEVI const float* operator()(int lane) const { return kv ? base + (lane >> 5) * 256 + ((4 * lane) & 127) : base + 4 * lane; } };
struct GDescUp { RowLin rf; WUp wl; unsigned ldw; };
struct WClamp { const float* base; int col0; DEVI const float* operator()(int lane) const { int c = col0 + 4 * lane; if (c > 700) c = 700; return base + c; } };
struct WLinP { const float* base; DEVI const float* operator()(int lane) const { const int r = 4 * lane; return base + 32 * (r >> 5) + 8 * ((r & 15) >> 2) + 4 * ((r >> 4) & 1); } };
struct WMoe { const float* gate; const float* up; size_t off; DEVI const float* operator()(int lane) const { const int r = 4 * lane, sub = r >> 5;
    const unsigned long long ga = (unsigned long long)gate, ua = (unsigned long long)up, mk = 0ull - (unsigned long long)(sub & 1);
    return (const float*)(ga ^ ((ga ^ ua) & mk)) + off + 32 * (sub >> 1) + 8 * ((r & 15) >> 2) + 4 * ((r >> 4) & 1); } };

DEVI void st_bf16x4(bf16_t* dst, f32x4 v) { u32x2 o; o.x = pk_bf16(v[0], v[1]); o.y = pk_bf16(v[2], v[3]); *(u32x2*)dst = o; }

template <int TM> DEVI void rope_tile(f32x4 (&acc)[TM][4], int row0  , int lane) {
    const int r16 = lane & 15, g = lane >> 4;
#pragma unroll
    for (int mb = 0; mb < TM; ++mb) {
        const int t = (row0 + mb * 16 + r16 - NPR) & 1023;
        const int prow = t >> 6, pcol = t & 63;
#pragma unroll
        for (int r = 0; r < 4; ++r) {
            const int f = 4 * g + r;
            const float c1 = rope_tab[(prow * 16 + f) * 2], s1 = rope_tab[(prow * 16 + f) * 2 + 1];
            const float c2 = rope_tab[(pcol * 16 + f) * 2], s2 = rope_tab[(pcol * 16 + f) * 2 + 1];
            const float a1 = acc[mb][0][r], a2 = acc[mb][1][r], b1 = acc[mb][2][r], b2 = acc[mb][3][r];
            acc[mb][0][r] = a1 * c1 - a2 * s1; acc[mb][1][r] = a2 * c1 + a1 * s1;
            acc[mb][2][r] = b1 * c2 - b2 * s2; acc[mb][3][r] = b2 * c2 + b1 * s2;
        }
        __builtin_amdgcn_sched_barrier(0);
    }
}

template <int BM> struct EpiZ { float* Z; int m0, n0;
    DEVI void operator()(const f32x4 (&acc)[BM / 32][4], int wr, int wc, int lane) const {
        const int r16 = lane & 15, g = lane >> 4;
#pragma unroll
        for (int mb = 0; mb < BM / 32; ++mb) { const int row = m0 + wr * (BM / 2) + mb * 16 + r16;
#pragma unroll
            for (int nb = 0; nb < 4; ++nb) { const int col = n0 + wc * 64 + nb * 16 + 4 * g; if (col < 704) *(f32x4*)(Z + (size_t)row * 704 + col) = acc[mb][nb]; } }
    } };
DEVI void phase_mla_win(const Params& p, int j, lds_t* lds, int bid, int nblk, int tid) {
    constexpr int MT = NTOK / GBM, NU = MT * 3;
    for (int u = xcd_first_unit(bid, nblk); u < NU; u += nblk) {
        const int mt = u % MT, nt = u / MT;
        RowLin rf{p.H + (size_t)mt * GBM * 1024, 1024u};
        RowClamp wf{p.WTI + (size_t)j * 704 * 1024, 1024u, nt * 256, 703};
        EpiZ<GBM> epi{p.Z, mt * GBM, nt * 256};
        gemm_unit_bb3<GBM, true>(lds, rf, wf, 16, epi, tid);
    }
}

DEVI int xcd_slot(int v, int nblk, int lo, int cnt, int& G) {
    if (nblk == 256) { G = 1 << 20; const int i = ((v & 31) - lo) & 31; return i < cnt ? (v >> 5) * cnt + i : (1 << 20); }
    G = nblk; return v; }
DEVI int rot_unit(int v, int off, int G) { int r = v - off; if (r < 0) r += G; return r; }
template <int NPM, int NPN, int GM, int GN>
struct SchedGrid { const bf16_t* A; const bf16_t* B; int v0, G; size_t tileA, tileB;
    static_assert(NPM % GM == 0 && NPN % GN == 0, "unit grid");
    DEVI bool next(int i, pg8::Unit& u) const {
        const int L = __builtin_amdgcn_readfirstlane(i * G + v0); if (L >= NPM * NPN) return false;
        constexpr int NGM = NPM / GM;
        const int g = L / (GM * GN), w = L % (GM * GN); u.pm = (g % NGM) * GM + (w % GM); u.pn = (g / NGM) * GN + (w / GM); u.aux = 0; return true; }
    DEVI void ptrs(const pg8::Unit& u, const char*& a, const char*& b) const { a = (const char*)(A + (size_t)u.pm * tileA); b = (const char*)(B + (size_t)u.pn * tileB); }
};
struct EpiMlaQ { static constexpr bool PERM = false; bf16_t* Q; float scale;
    DEVI void operator()(const f32x4 (&acc)[2][2][4][2], const pg8::Unit& u, int wr, int wc, int fr_in, int fq_in) const {
        int ln = fr_in | (fq_in << 4); asm volatile("" : "+v"(ln));
#pragma unroll
        for (int bj = 0; bj < 2; ++bj) {
            const int c0 = u.pn * 256 + bj * 128 + wc * 32;
            const int gi = (c0 % 192) >> 5;
            const bool rope = (u.pm >= 16) && (gi >= 4);
#pragma unroll
            for (int ai = 0; ai < 2; ++ai)
#pragma unroll
                for (int m = 0; m < 4; ++m) { asm volatile("" : "+v"(ln)); const int fr = ln & 15, fq = ln >> 4;
                    const int row = u.pm * 256 + ai * 128 + wr * 64 + m * 16 + fr;
                    f32x4 x1 = acc[ai][bj][m][0], x2 = acc[ai][bj][m][1];
                    if (rope) { const int t = (row - NPR) & 1023, pos = (gi == 4) ? (t >> 6) : (t & 63);
#pragma unroll
                        for (int j = 0; j < 4; ++j) { const f32x2 cs = *(const f32x2*)(rope_tab + (pos * 16 + 4 * fq + j) * 2);
                            const float a = x1[j], b = x2[j]; x1[j] = a * cs.x - b * cs.y; x2[j] = b * cs.x + a * cs.y; } }
                    bf16_t* dst = Q + (size_t)row * 1536 + c0 + 4 * fq;
                    st_bf16x4(dst, x1 * scale); st_bf16x4(dst + 16, x2 * scale);
                    __builtin_amdgcn_sched_barrier(0); }
        }
    } };
struct EpiMlaK { static constexpr bool PERM = true; bf16_t* KN;
    DEVI void operator()(const f32x4 (&acc)[2][2][4][2], const pg8::Unit& u, int wr, int wc, int fr_in, int fq_in) const {
        int ln = fr_in | (fq_in << 4); asm volatile("" : "+v"(ln));
        const int fr = ln & 15, fq = ln >> 4;
#pragma unroll
        for (int ai = 0; ai < 2; ++ai)
#pragma unroll
            for (int m = 0; m < 4; ++m) { const int row = u.pm * 256 + ai * 128 + wr * 64 + m * 16 + fr;
#pragma unroll
                for (int bj = 0; bj < 2; ++bj) { const f32x4 a = acc[ai][bj][m][0], b = acc[ai][bj][m][1];
                    u32x4 w; w.x = pk_bf16(a[0], a[1]); w.y = pk_bf16(a[2], a[3]); w.z = pk_bf16(b[0], b[1]); w.w = pk_bf16(b[2], b[3]);
                    *(u32x4*)(KN + (size_t)row * 1024 + u.pn * 256 + bj * 128 + wc * 32 + 8 * fq) = w; } }
    } };
struct EpiMlaV { static constexpr bool PERM = true; bf16_t* VTP; bf16_t* VTS;
    DEVI void operator()(const f32x4 (&acc)[2][2][4][2], const pg8::Unit& u, int wr, int wc, int fr_in, int fq_in) const {
        int ln = fr_in | (fq_in << 4); asm volatile("" : "+v"(ln));
        const int fr = ln & 15, fq = ln >> 4;
        const int R0 = u.pn * 256;
        bf16_t* base; unsigned ldk;
        if (R0 < NPR) { base = VTP + (size_t)(R0 >> 8) * (8 * 128 * 256); ldk = 256; }
        else if (R0 < NTOK) { base = VTS + (size_t)((R0 - NPR) >> 10) * (8 * 128 * 1280) + 256 + ((R0 - NPR) & 1023); ldk = 1280; }
        else { base = VTS + (size_t)((R0 - NTOK) >> 8) * (8 * 128 * 1280); ldk = 1280; }
#pragma unroll
        for (int ai = 0; ai < 2; ++ai)
#pragma unroll
            for (int m = 0; m < 4; ++m) { const unsigned hd = (unsigned)((2 * u.pm + ai) * 128 + wr * 64 + m * 16 + fr);
#pragma unroll
                for (int bj = 0; bj < 2; ++bj) { const f32x4 a = acc[ai][bj][m][0], b = acc[ai][bj][m][1];
                    u32x4 w; w.x = pk_bf16(a[0], a[1]); w.y = pk_bf16(a[2], a[3]); w.z = pk_bf16(b[0], b[1]); w.w = pk_bf16(b[2], b[3]);
                    *(u32x4*)(base + (unsigned)(hd * ldk + bj * 128 + wc * 32 + 8 * fq)) = w; }
                __builtin_amdgcn_sched_barrier(0); }
    } };
DEVI void phase_mla_up(const Params& p, int j, lds_t* lds, int bid, int nblk, int tid) {
    int v = xcd_first_unit(bid, nblk);
    const int wid = __builtin_amdgcn_readfirstlane(tid >> 6);
    const bf16_t* wkv = p.WTKV + (size_t)j * 2048 * 256;
    {
        SchedGrid<32, 6, 16, 2> S{p.CQ, p.WTQ + (size_t)j * 1536 * 384, v, nblk, (size_t)256 * 384, (size_t)256 * 384};
        EpiMlaQ E{p.Q, 0.07216878364870322f * LOG2E};
        pg8::gemm_phase(lds, 384, 6, S, E, tid);
    }
    tid = wid * 64 + lane_id_fresh(); asm volatile("" : "+s"(v)); __builtin_amdgcn_sched_barrier(0);
    {
        SchedGrid<36, 4, 4, 4> S{p.CKV, wkv, rot_unit(v, 192 % nblk, nblk), nblk, (size_t)256 * 256, (size_t)512 * 256};
        EpiMlaK E{p.KN};
        pg8::gemm_phase(lds, 256, 4, S, E, tid, 128, 256);
    }
    tid = wid * 64 + lane_id_fresh(); asm volatile("" : "+s"(v)); __builtin_amdgcn_sched_barrier(0);
    {
        SchedGrid<4, 36, 4, 4> S{wkv + (size_t)128 * 256, p.CKV, rot_unit(v, 80 % nblk, nblk), nblk, (size_t)512 * 256, (size_t)256 * 256};
        EpiMlaV E{p.VTP, p.VTS};
        pg8::gemm_phase(lds, 256, 4, S, E, tid, 256, 128);
    }
}

struct SchedOut { const bf16_t* A; const bf16_t* W; int K, v0, G;
    DEVI bool next(int i, pg8::Unit& u) const {
        const int L = i * G + v0; if (L >= 256) return false;
        const int g = L >> 5, w = L & 31; u.aux = g & 1; u.pm = (g >> 1) * 8 + (w & 7); u.pn = w >> 3; return true; }
    DEVI void ptrs(const pg8::Unit& u, const char*& a, const char*& b) const {
        a = (const char*)(A + (size_t)u.pm * 256 * K + (size_t)u.aux * (K >> 1)); b = (const char*)(W + (size_t)u.pn * 256 * K + (size_t)u.aux * (K >> 1)); }
};
struct EpiOut { static constexpr bool PERM = true; bf16_t* Y; const float* mod; int layer;
    DEVI void operator()(const f32x4 (&acc)[2][2][4][2], const pg8::Unit& u, int wr, int wc, int fr_in, int fq_in) const {
        int ln = fr_in | (fq_in << 4); asm volatile("" : "+v"(ln));
        const int fr = ln & 15, fq = ln >> 4;
        const float* gt = mod + ((size_t)(layer * 5 + cond_of_row(u.pm * 256)) * 6 + 2) * 1024;
        bf16_t* Yk = Y + (size_t)u.aux * NTOK * D;
#pragma unroll
        for (int bj = 0; bj < 2; ++bj) { const int col = u.pn * 256 + bj * 128 + wc * 32 + 8 * fq;
            const f32x4 g0 = *(const f32x4*)(gt + col), g1 = *(const f32x4*)(gt + col + 4);
#pragma unroll
            for (int ai = 0; ai < 2; ++ai)
#pragma unroll
                for (int m = 0; m < 4; ++m) { const int row = u.pm * 256 + ai * 128 + wr * 64 + m * 16 + fr;
                    const f32x4 a = acc[ai][bj][m][0] * g0, b = acc[ai][bj][m][1] * g1;
                    u32x4 w; w.x = pk_bf16(a[0], a[1]); w.y = pk_bf16(a[2], a[3]); w.z = pk_bf16(b[0], b[1]); w.w = pk_bf16(b[2], b[3]);
                    *(u32x4*)(Yk + (size_t)row * D + col) = w; } }
    } };
DEVI void phase_out_proj(const Params& p, int layer, const bf16_t* A, int K, const bf16_t* Wt, lds_t* lds, int bid, int nblk, int tid) {
    SchedOut S{A, Wt, K, xcd_first_unit(bid, nblk), nblk};
    EpiOut E{(bf16_t*)p.T, p.mod, layer};
    pg8::gemm_phase(lds, K, K >> 7, S, E, tid);
}

struct SchedGmWin { const bf16_t* H; const bf16_t* W; int v0, G;
    DEVI bool next(int i, pg8::Unit& u) const {
        const int L = i * G + v0; if (L >= 768) return false;
        if (L < 384) { const int g = L >> 5, w = L & 31; u.pm = (g & 3) * 8 + (w & 7); u.pn = (g >> 2) * 4 + (w >> 3); u.aux = 0; }
        else { const int g = (L - 384) >> 5, w = L & 31; u.pm = (g % 3) * 4 + (w & 3); u.pn = (g / 3) * 8 + (w >> 2); u.aux = 1; }
        return true; }
    DEVI void ptrs(const pg8::Unit& u, const char*& a, const char*& b) const {
        if (u.aux == 0) { a = (const char*)(H + (size_t)u.pm * 256 * 1024); b = (const char*)(W + (size_t)u.pn * 256 * 1024); }
        else { a = (const char*)(W + (size_t)(3072 + u.pm * 256) * 1024); b = (const char*)(H + (size_t)u.pn * 256 * 1024); } }
};
struct EpiGmWin { static constexpr bool PERM = true; bf16_t* U; bf16_t* GVT; float* GST;
    DEVI void operator()(const f32x4 (&acc)[2][2][4][2], const pg8::Unit& u, int wr, int wc, int fr_in, int fq_in) const {
        int ln = fr_in | (fq_in << 4); asm volatile("" : "+v"(ln));
        const int fr = ln & 15, fq = ln >> 4;
        const bool vhalf = u.aux != 0;
#pragma unroll
        for (int bj = 0; bj < 2; ++bj) {
            f32x4 s0 = (f32x4){0.f, 0.f, 0.f, 0.f}, s1 = s0, q0 = s0, q1 = s0;
            const int cpos = u.pn * 256 + bj * 128 + wc * 32 + 8 * fq;
#pragma unroll
            for (int ai = 0; ai < 2; ++ai)
#pragma unroll
                for (int m = 0; m < 4; ++m) { const int r = u.pm * 256 + ai * 128 + wr * 64 + m * 16 + fr;
                    f32x4 a = acc[ai][bj][m][0], b = acc[ai][bj][m][1];
#pragma unroll
                    for (int j = 0; j < 4; ++j) { a[j] = gelu_tanh_f(a[j]); b[j] = gelu_tanh_f(b[j]); }
                    u32x4 w; w.x = pk_bf16(a[0], a[1]); w.y = pk_bf16(a[2], a[3]); w.z = pk_bf16(b[0], b[1]); w.w = pk_bf16(b[2], b[3]);
                    if (!vhalf) *(u32x4*)(U + (size_t)r * 3072 + cpos) = w;
                    else { s0 += a; q0 += a * a; s1 += b; q1 += b * b; *(u32x4*)(GVT + ((size_t)(cpos >> 7) * 3072 + r) * 128 + (cpos & 127)) = w; }
                    __builtin_amdgcn_sched_barrier(0); }
            if (vhalf) {
#pragma unroll
                for (int o = 1; o < 16; o <<= 1)
#pragma unroll
                    for (int j = 0; j < 4; ++j) { s0[j] += __shfl_xor(s0[j], o); q0[j] += __shfl_xor(q0[j], o); s1[j] += __shfl_xor(s1[j], o); q1[j] += __shfl_xor(q1[j], o); }
                if (fr == 0) { const int part = u.pm * 2 + wr;
#pragma unroll
                    for (int j = 0; j < 4; ++j) { f32x2 w2; w2.x = s0[j]; w2.y = q0[j]; *(f32x2*)(GST + ((size_t)(cpos + j) * 24 + part) * 2) = w2;
                                                  f32x2 w3; w3.x = s1[j]; w3.y = q1[j]; *(f32x2*)(GST + ((size_t)(cpos + 4 + j) * 24 + part) * 2) = w3; } }
            }
            __builtin_amdgcn_sched_barrier(0);
        }
    } };
DEVI void phase_gm_win(const Params& p, lds_t* lds, int bid, int nblk, int tid) {
    SchedGmWin S{p.H, p.WTGI, xcd_first_unit(bid, nblk), nblk};
    EpiGmWin E{p.U, p.GVT, p.GST};
    pg8::gemm_phase(lds, 1024, 16, S, E, tid);
}

struct EpiSwaQK { static constexpr bool PERM = false; bf16_t* Q; bf16_t* SK; float* out; float scale;
    DEVI void operator()(const f32x4 (&acc)[2][2][4][2], const pg8::Unit& u, int wr, int wc, int fr_in, int fq_in) const {
        int ln = fr_in | (fq_in << 4); asm volatile("" : "+v"(ln));
        const bool isk = (u.pn == 4), rope = (u.pm >= 16), kout = isk && !rope;
        bf16_t* dstb = isk ? SK : Q + u.pn * 256; const unsigned ld = isk ? 256u : 1024u; const float sc = isk ? 1.f : scale;
        const int gi = wc & 1;
#pragma unroll
        for (int bj = 0; bj < 2; ++bj) {
            const int c0 = bj * 128 + wc * 32;
#pragma unroll
            for (int ai = 0; ai < 2; ++ai)
#pragma unroll
                for (int m = 0; m < 4; ++m) { asm volatile("" : "+v"(ln)); const int fr = ln & 15, fq = ln >> 4;
                    const int row = u.pm * 256 + ai * 128 + wr * 64 + m * 16 + fr;
                    f32x4 x1 = acc[ai][bj][m][0], x2 = acc[ai][bj][m][1];
                    if (rope) { const int t = (row - NPR) & 1023, pos = gi ? (t & 63) : (t >> 6);
#pragma unroll
                        for (int j = 0; j < 4; ++j) { const f32x2 cs = *(const f32x2*)(rope_tab + (pos * 16 + 4 * fq + j) * 2);
                            const float a = x1[j], b = x2[j]; x1[j] = a * cs.x - b * cs.y; x2[j] = b * cs.x + a * cs.y; } }
                    const unsigned o = (unsigned)row * ld + c0 + 4 * fq;
                    if (kout) { float* po = out + OUT_SK + (size_t)row * 256 + c0 + 4 * fq; *(f32x4*)po = x1; *(f32x4*)(po + 16) = x2; }
                    st_bf16x4(dstb + o, x1 * sc); st_bf16x4(dstb + o + 16, x2 * sc);
                    __builtin_amdgcn_sched_barrier(0); }
        }
    } };
struct EpiSwaV { static constexpr bool PERM = true; bf16_t* SVTP; bf16_t* SVTS; float* out;
    DEVI void operator()(const f32x4 (&acc)[2][2][4][2], const pg8::Unit& u, int wr, int wc, int fr_in, int fq_in) const {
        int ln = fr_in | (fq_in << 4); asm volatile("" : "+v"(ln));
        const int fr = ln & 15, fq = ln >> 4;
        const int R0 = u.pn * 256;
        bf16_t* base; unsigned ldk;
        if (R0 < NPR) { base = SVTP + (size_t)(R0 >> 8) * (4 * 64 * 256); ldk = 256; }
        else { base = SVTS + (size_t)((R0 - NPR) >> 10) * (4 * 64 * 1280) + 256 + ((R0 - NPR) & 1023); ldk = 1280; }
#pragma unroll
        for (int ai = 0; ai < 2; ++ai)
#pragma unroll
            for (int m = 0; m < 4; ++m) { const unsigned r = (unsigned)(ai * 128 + wr * 64 + m * 16 + fr);
#pragma unroll
                for (int bj = 0; bj < 2; ++bj) { const f32x4 a = acc[ai][bj][m][0], b = acc[ai][bj][m][1];
                    const unsigned c = (unsigned)(bj * 128 + wc * 32 + 8 * fq);
                    u32x4 w; w.x = pk_bf16(a[0], a[1]); w.y = pk_bf16(a[2], a[3]); w.z = pk_bf16(b[0], b[1]); w.w = pk_bf16(b[2], b[3]);
                    *(u32x4*)(base + (r * ldk + c)) = w;
                    if (R0 < NPR) { float* po = out + OUT_SV + (size_t)(R0 + c) * 256 + r;
#pragma unroll
                        for (int i = 0; i < 4; ++i) { po[i * 256] = a[i]; po[(i + 4) * 256] = b[i]; } } }
                __builtin_amdgcn_sched_barrier(0); }
    } };
DEVI void phase_swa_qkv(const Params& p, lds_t* lds, int bid, int nblk, int tid) {
    int v = xcd_first_unit(bid, nblk);
    const int wid = __builtin_amdgcn_readfirstlane(tid >> 6);
    {   int G; const int v0 = xcd_slot(v, nblk, 0, 20, G);
        SchedGrid<32, 5, 4, 5> S{p.H, p.WTSQ, v0, G, (size_t)256 * 1024, (size_t)256 * 1024};
        EpiSwaQK E{p.Q, p.SK, p.out, 0.125f * LOG2E};
        pg8::gemm_phase(lds, 1024, 16, S, E, tid);
    }
    tid = wid * 64 + lane_id_fresh(); asm volatile("" : "+s"(v)); __builtin_amdgcn_sched_barrier(0);
    {   int G; const int v0 = xcd_slot(v, nblk, 20, 4, G);
        SchedGrid<1, 32, 1, 4> S{p.WTSQ + (size_t)1280 * 1024, p.H, v0, G, (size_t)256 * 1024, (size_t)256 * 1024};
        EpiSwaV E{p.SVTP, p.SVTS, p.out};
        pg8::gemm_phase(lds, 1024, 16, S, E, tid);
    }
}

template <int BM> struct EpiHid { bf16_t* HID; int e, mt, nt;
    DEVI void operator()(const f32x4 (&acc)[BM / 32][4], int wr, int wc, int lane) const {
        const int r16 = lane & 15, g = lane >> 4;
#pragma unroll
        for (int mb = 0; mb < BM / 32; ++mb) { const size_t row = (size_t)e * 1024 + mt * BM + wr * (BM / 2) + mb * 16 + r16;
            u32x4 w;
            { const f32x4 gv = acc[mb][0], uv = acc[mb][2]; w.x = pk_bf16(silu_f(gv[0]) * uv[0], silu_f(gv[1]) * uv[1]); w.y = pk_bf16(silu_f(gv[2]) * uv[2], silu_f(gv[3]) * uv[3]); }
            { const f32x4 gv = acc[mb][1], uv = acc[mb][3]; w.z = pk_bf16(silu_f(gv[0]) * uv[0], silu_f(gv[1]) * uv[1]); w.w = pk_bf16(silu_f(gv[2]) * uv[2], silu_f(gv[3]) * uv[3]); }
            *(u32x4*)(HID + row * 2048 + nt * 128 + wc * 32 + 8 * g) = w; }
    } };
template <int DBG = 0> DEVI void phase_moe_up(const Params& p, int layer, lds_t* lds, int bid, int nblk, int tid) {
    constexpr int MT = 1024 / GBM2, NU = 16 * MT * 16;
#define DEC_MU(u_, rf_, wf_) do { const int e_ = (u_) / (MT * 16), w_ = (u_) % (MT * 16), mt_ = w_ % MT, nt_ = w_ / MT; \
        rf_ = RowGather{p.H2, p.IDX + e_ * 1024 + mt_ * GBM2}; wf_ = WMoe{p.moe_w_gate, p.moe_w_up, ((size_t)layer * 16 + e_) * 1024 * 2048 + nt_ * 128}; } while (0)
    int u = xcd_first_unit(bid, nblk);
    RowGather rf, rfn; WMoe wf, wfn;
    for (; u < NU; u += nblk) {
        const int e = u / (MT * 16), w = u % (MT * 16), mt = w % MT, nt = w / MT;
        DEC_MU(u, rf, wf);
        EpiHid<GBM2> epi{p.HID, e, mt, nt};
        gemm_unit<GBM2, true>(lds, rf, wf, 2048u, DBG == 1 ? 8 : 16, epi, tid);
    }
#undef DEC_MU
}
template <int BM> struct EpiYe { bf16_t* YE; const float* GATEV; int e, mt, nt;
    DEVI void operator()(const f32x4 (&acc)[BM / 32][4], int wr, int wc, int lane) const {
        const int r16 = lane & 15, g = lane >> 4;
#pragma unroll
        for (int mb = 0; mb < BM / 32; ++mb) { const size_t row = (size_t)e * 1024 + mt * BM + wr * (BM / 2) + mb * 16 + r16;
            const float gt = GATEV[row];
#pragma unroll
            for (int np = 0; np < 2; ++np) {
                const f32x4 a = acc[mb][2 * np] * gt, b = acc[mb][2 * np + 1] * gt;
                u32x4 w; w.x = pk_bf16(a[0], a[1]); w.y = pk_bf16(a[2], a[3]); w.z = pk_bf16(b[0], b[1]); w.w = pk_bf16(b[2], b[3]);
                *(u32x4*)(YE + row * 1024 + nt * 256 + wc * 64 + 32 * np + 8 * g) = w; } }
    } };
DEVI void phase_moe_down(const Params& p, int layer, lds_t* lds, int bid, int nblk, int tid) {
    constexpr int MT = 1024 / GBM2, NU = 16 * MT * 4;
#define DEC_MD(u_, d_) do { const int e_ = (u_) / (MT * 4), w_ = (u_) % (MT * 4), mt_ = w_ % MT, nt_ = w_ / MT; \
        d_.rf = RowLin{p.HID + ((size_t)e_ * 1024 + mt_ * GBM2) * 2048, 2048u}; d_.wl = WLin{p.moe_w_down + ((size_t)layer * 16 + e_) * 2048 * 1024 + nt_ * 256}; d_.ldw = 1024u; d_.nk = 32; } while (0)
    int u = xcd_first_unit(bid, nblk);
    GDesc d, dn;
    for (; u < NU; u += nblk) {
        const int e = u / (MT * 4), w = u % (MT * 4), mt = w % MT, nt = w / MT;
        DEC_MD(u, d);
        EpiYe<GBM2> epi{p.YE, p.GATEV, e, mt, nt};
        gemm_unit<GBM2, true>(lds, d.rf, WLinP{d.wl.base}, d.ldw, 32, epi, tid);
    }
#undef DEC_MD
}

template <int DK, int DV> struct AttnCfg {
    static constexpr int CPK = DK / 8;
    static constexpr int KT_BYTES = 64 * DK * 2;
    static constexpr int VT_BYTES = DV * 128;
    static constexpr int STAGE = KT_BYTES + VT_BYTES;
    static constexpr int NKC = 64 * CPK / NTHREADS;
    static constexpr int NVC = DV * 8 / NTHREADS;
};
DEVI int kswz(int key) { return ((key >> 1) & 1) | (((key >> 3) & 3) << 1); }

struct AttnSeg { int n_ctx, ctx_krow0, ctx_vcol0, n_loc, loc_krow0, loc_vcol0, loc_kpos0; };

template <int DK, int DV, bool WINDOW, class KSrc>
DEVI void attn_unit(lds_t* lds, const bf16_t* Qp, int ldq, const KSrc& ks, const bf16_t* vt, int ldv, const AttnSeg sg, int qpos0,
                    float sink, bool has_sink, bf16_t* Op, int ldo, int tid) {
    typedef AttnCfg<DK, DV> C;
    const int lane = tid & 63, wave = tid >> 6, r16 = lane & 15, g = lane >> 4;
    const int ntile = sg.n_ctx + sg.n_loc;
    bf16x8 qf[DK / 32];
    {
        const bf16_t* qr = Qp + (size_t)(wave * 16 + r16) * ldq + 8 * g;
#pragma unroll
        for (int s = 0; s < DK / 32; ++s) qf[s] = *(const bf16x8*)(qr + 32 * s);
    }
    u32x4 kreg[C::NKC], vreg[C::NVC];
#define TILE_LOAD(jj) do { const int j_ = (jj); int krow, vcol; \
        if (j_ < sg.n_ctx) { krow = sg.ctx_krow0 + 64 * j_; vcol = sg.ctx_vcol0 + 64 * j_; } \
        else { krow = sg.loc_krow0 + 64 * (j_ - sg.n_ctx); vcol = sg.loc_vcol0 + 64 * (j_ - sg.n_ctx); } \
        _Pragma("unroll") for (int i = 0; i < C::NKC; ++i) { const int c = tid + NTHREADS * i, key = c / C::CPK, ch = c % C::CPK; kreg[i] = *(const u32x4*)ks(krow + key, ch); } \
        _Pragma("unroll") for (int i = 0; i < C::NVC; ++i) { const int c = tid + NTHREADS * i, dv = c >> 3, ch = c & 7; vreg[i] = *(const u32x4*)(vt + (size_t)dv * ldv + vcol + ch * 8); } } while (0)
#define TILE_STORE(stp) do { lds_t* st_ = (stp); \
        _Pragma("unroll") for (int i = 0; i < C::NKC; ++i) { const int c = tid + NTHREADS * i, key = c / C::CPK, ch = c % C::CPK; lds_st128(st_ + key * (DK * 2) + ((ch ^ kswz(key)) << 4), kreg[i]); } \
        _Pragma("unroll") for (int i = 0; i < C::NVC; ++i) { const int c = tid + NTHREADS * i, dv = c >> 3, ch = c & 7; lds_st128(st_ + C::KT_BYTES + img_off(dv, ch), vreg[i]); } } while (0)
    f32x4 o[DV / 16];
#pragma unroll
    for (int i = 0; i < DV / 16; ++i) o[i] = (f32x4){0.f, 0.f, 0.f, 0.f};
    float m = has_sink ? sink : -1.0e30f;
    float l = (has_sink && g == 0) ? 1.0f : 0.0f;
    const int qpos = qpos0 + wave * 16 + r16;
    const int kbyte = (8 * (r16 >> 2) + (r16 & 3)) * (DK * 2);
    const int ksw0 = ((r16 >> 1) & 1) | ((r16 >> 2) << 1);
    const int ke0 = (g ^ ksw0) << 4, ke1 = ((4 + g) ^ ksw0) << 4;
    const int vc0 = g ^ ((r16 >> 1) & 7);

    TILE_LOAD(0);
    __syncthreads();
    TILE_STORE(lds);
    if (ntile > 1) TILE_LOAD(1);
    for (int j = 0; j < ntile; ++j) {
        __syncthreads();
        lds_t* cur = lds + (j & 1) * C::STAGE;
        if (j + 1 < ntile) { TILE_STORE(lds + ((j + 1) & 1) * C::STAGE); if (j + 2 < ntile) TILE_LOAD(j + 2); }
        const bool masked = WINDOW && (j >= sg.n_ctx);
        const int kpos0 = sg.loc_kpos0 + 64 * (j - sg.n_ctx);
        if (masked) {
            const int qlo = qpos0 + wave * 16;
            if (kpos0 > qlo + 15 + 128 || kpos0 + 63 < qlo - 128) continue;
        }
        f32x4 s[4];
        {
            lds_t* kb0 = cur + kbyte + ke0;
            lds_t* kb1 = cur + kbyte + ke1;
#pragma unroll
            for (int grp = 0; grp < 2; ++grp)
#pragma unroll
                for (int b = 0; b < 2; ++b) {
                    f32x4 a = (f32x4){0.f, 0.f, 0.f, 0.f};
#pragma unroll
                    for (int st = 0; st < DK / 32; ++st) {
                        const bf16x8 kf = lds_ld128(((st & 1) ? kb1 : kb0) + (32 * grp + 4 * b) * (DK * 2) + (st >> 1) * 128);
                        a = __builtin_amdgcn_mfma_f32_16x16x32_bf16(kf, qf[st], a, 0, 0, 0);
                    }
                    s[grp * 2 + b] = a;
                }
        }
        if (masked) {
#pragma unroll
            for (int grp = 0; grp < 2; ++grp)
#pragma unroll
                for (int b = 0; b < 2; ++b)
#pragma unroll
                    for (int r = 0; r < 4; ++r) {
                        const int kp = kpos0 + 32 * grp + 8 * g + 4 * b + r;
                        const int d = qpos - kp;
                        if (d > 128 || d < -128) s[grp * 2 + b][r] = -1.0e30f;
                    }
        }
        float mx = fmaxf(fmaxf(fmaxf(s[0][0], s[0][1]), fmaxf(s[0][2], s[0][3])), fmaxf(fmaxf(s[1][0], s[1][1]), fmaxf(s[1][2], s[1][3])));
        mx = fmaxf(mx, fmaxf(fmaxf(fmaxf(s[2][0], s[2][1]), fmaxf(s[2][2], s[2][3])), fmaxf(fmaxf(s[3][0], s[3][1]), fmaxf(s[3][2], s[3][3]))));
        mx = fmaxf(mx, __shfl_xor(mx, 16)); mx = fmaxf(mx, __shfl_xor(mx, 32));
        const float mn = fmaxf(m, mx);
        const float alpha = fexp2(m - mn);
        m = mn;
        float ps = 0.f;
#pragma unroll
        for (int i = 0; i < 4; ++i)
#pragma unroll
            for (int r = 0; r < 4; ++r) { const float pv = fexp2(s[i][r] - mn); s[i][r] = pv; ps += pv; }
        l = l * alpha + ps;
#pragma unroll
        for (int i = 0; i < DV / 16; ++i) o[i] = o[i] * alpha;
#pragma unroll
        for (int grp = 0; grp < 2; ++grp) {
            u32x4 pw;
            pw.x = pk_bf16(s[grp * 2][0], s[grp * 2][1]); pw.y = pk_bf16(s[grp * 2][2], s[grp * 2][3]);
            pw.z = pk_bf16(s[grp * 2 + 1][0], s[grp * 2 + 1][1]); pw.w = pk_bf16(s[grp * 2 + 1][2], s[grp * 2 + 1][3]);
            bf16x8 pf; __builtin_memcpy(&pf, &pw, 16);
#pragma unroll
            for (int dvb = 0; dvb < DV / 16; ++dvb) {
                const bf16x8 vf = lds_ld128(cur + C::KT_BYTES + r16 * 128 + dvb * 2048 + (((vc0 ^ (4 * grp)) ^ (dvb & 1)) << 4));
                o[dvb] = __builtin_amdgcn_mfma_f32_16x16x32_bf16(vf, pf, o[dvb], 0, 0, 0);
            }
        }
    }
    l += __shfl_xor(l, 16); l += __shfl_xor(l, 32);
    const float inv = frcp(l);
    bf16_t* orow = Op + (size_t)(wave * 16 + r16) * ldo + 4 * g;
#pragma unroll
    for (int dvb = 0; dvb < DV / 16; ++dvb) st_bf16x4(orow + dvb * 16, o[dvb] * inv);
}

struct KSrcMla { const bf16_t* KN; const bf16_t* KPE; int h;
    DEVI const bf16_t* operator()(int krow, int ch) const { return ch < 16 ? KN + (size_t)krow * 1024 + h * 128 + ch * 8 : KPE + (size_t)krow * 64 + (ch - 16) * 8; } };
struct KSrcSwa { const bf16_t* SK; int kvh;
    DEVI const bf16_t* operator()(int krow, int ch) const { return SK + (size_t)krow * 256 + kvh * 64 + ch * 8; } };

DEVI void phase_mla_attn(const Params& p, lds_t* lds, int bid, int nblk, int tid) {
    for (int u = xcd_first_unit(bid, nblk); u < 512; u += nblk) {
        if (u < 256) {
            const int b = u >> 6, h = (u >> 3) & 7, qt = u & 7;
            const int qrow0 = NPR + b * 1024 + qt * 128;
            KSrcMla ks{p.KN, p.KPE, h};
            AttnSeg sg{4, NTOK + b * 256, 0, 16, NPR + b * 1024, 256, 0};
            attn_unit<192, 128, false>(lds, p.Q + (size_t)qrow0 * 1536 + h * 192, 1536, ks, p.VTS + (size_t)(b * 8 + h) * 128 * 1280, 1280, sg, 0, 0.f, false,
                                       p.O + (size_t)qrow0 * 1024 + h * 128, 1024, tid);
        } else {
            const int v = u - 256, b = v >> 4, h = (v >> 1) & 7, qt = v & 1;
            const int qrow0 = b * 256 + qt * 128;
            KSrcMla ks{p.KN, p.KPE, h};
            AttnSeg sg{0, 0, 0, 4, b * 256, 0, 0};
            attn_unit<192, 128, false>(lds, p.Q + (size_t)qrow0 * 1536 + h * 192, 1536, ks, p.VTP + (size_t)(b * 8 + h) * 128 * 256, 256, sg, 0, 0.f, false,
                                       p.O + (size_t)qrow0 * 1024 + h * 128, 1024, tid);
        }
    }
}
DEVI void phase_swa_attn(const Params& p, lds_t* lds, int bid, int nblk, int tid) {
    for (int u = xcd_first_unit(bid, nblk); u < 1024; u += nblk) {
        const int w = u >> 8, idx = ((u >> 9) << 8) | (u & 255);
        if ((w & 1) == 0) {
            const int b = idx >> 7, hq = (idx >> 3) & 15, qt = idx & 7, kvh = hq >> 2;
            const int qs = qt * 128, qrow0 = NPR + b * 1024 + qs;
            const int lo = qs >= 128 ? qs - 128 : 0, hi = qs + 256 <= 1024 ? qs + 256 : 1024;
            KSrcSwa ks{p.SK, kvh};
            AttnSeg sg{4, NTOK + b * 256, 0, (hi - lo) >> 6, NPR + b * 1024 + lo, 256 + lo, lo};
            attn_unit<64, 64, true>(lds, p.Q + (size_t)qrow0 * 1024 + hq * 64, 1024, ks, p.SVTS + (size_t)(b * 4 + kvh) * 64 * 1280, 1280, sg, qs,
                                    p.swa_sink[hq] * LOG2E, true, p.O + (size_t)qrow0 * 1024 + hq * 64, 1024, tid);
        } else {
            const int b = idx >> 5, hq = (idx >> 1) & 15, qt = idx & 1, kvh = hq >> 2;
            const int qrow0 = b * 256 + qt * 128;
            KSrcSwa ks{p.SK, kvh};
            AttnSeg sg{0, 0, 0, 4, b * 256, 0, 0};
            attn_unit<64, 64, false>(lds, p.Q + (size_t)qrow0 * 1024 + hq * 64, 1024, ks, p.SVTP + (size_t)(b * 4 + kvh) * 64 * 256, 256, sg, 0,
                                     p.swa_sink[hq] * LOG2E, true, p.O + (size_t)qrow0 * 1024 + hq * 64, 1024, tid);
        }
    }
}

DEVI void phase_gm_spatial(const Params& p, lds_t* lds, int bid, int nblk, int tid) {
    const int lane = tid & 63, wave = tid >> 6, r16 = lane & 15, g = lane >> 4, wr = wave >> 2, wc = wave & 3;
    lds_t* aimg = lds;
    lds_t* vimg = lds + 32768;
    LAS float* mean = (LAS float*)(lds + 65536);
    LAS float* rstd = mean + 128;
    LAS float* biasp = rstd + 128;
    LAS float* bpart = biasp + 128;
    for (int u = xcd_first_unit(bid, nblk); u < 512; u += nblk) {
        const int chunk = u >> 3, grp = u & 7;
        __syncthreads();
        if (tid < 128) {
            const float* gs = p.GST + (size_t)(chunk * 128 + tid) * 48;
            float s = 0.f, q = 0.f;
            for (int i = 0; i < 24; ++i) { s += gs[2 * i]; q += gs[2 * i + 1]; }
            const float mu = s * (1.0f / 3072.0f);
            const float var = q * (1.0f / 3072.0f) - mu * mu;
            mean[tid] = mu; rstd[tid] = rsqrtf(fmaxf(var, 0.f) + EPS_F);
        }
        __syncthreads();
        {
            const int n = tid >> 2, mq = tid & 3;
            const float* ws = p.gm_w_s + ((size_t)grp * 128 + n) * 128 + mq * 32;
            float bp = 0.f;
#pragma unroll
            for (int c4 = 0; c4 < 4; ++c4) {
                const f32x4 w0 = *(const f32x4*)(ws + c4 * 8), w1 = *(const f32x4*)(ws + c4 * 8 + 4);
                const int m0 = mq * 32 + c4 * 8;
                float a[8];
#pragma unroll
                for (int i = 0; i < 4; ++i) { a[i] = w0[i] * rstd[m0 + i]; a[4 + i] = w1[i] * rstd[m0 + 4 + i]; }
                u32x4 v; v.x = pk_bf16(a[0], a[1]); v.y = pk_bf16(a[2], a[3]); v.z = pk_bf16(a[4], a[5]); v.w = pk_bf16(a[6], a[7]);
#pragma unroll
                for (int i = 0; i < 4; ++i) { const unsigned wd = i == 0 ? v.x : i == 1 ? v.y : i == 2 ? v.z : v.w; bp += bf_lo(wd) * mean[m0 + 2 * i] + bf_hi(wd) * mean[m0 + 2 * i + 1]; }
                const int kc = m0 >> 3;
                lds_st128(aimg + (kc >> 3) * 16384 + img_off(n, kc & 7), v);
            }
            bpart[mq * 128 + n] = bp;
        }
        __syncthreads();
        if (tid < 128) biasp[tid] = bpart[tid] + bpart[128 + tid] + bpart[256 + tid] + bpart[384 + tid];
        for (int cs = 0; cs < 3; ++cs) {
            __syncthreads();
            {
                const bf16_t* src = p.GVT + ((size_t)chunk * 3072 + grp * 384 + cs * 128) * 128;
#pragma unroll
                for (int i = 0; i < 4; ++i) { const int c = tid + NTHREADS * i, row = c >> 4, kc = c & 15;
                    const u32x4 v = *(const u32x4*)(src + (size_t)row * 128 + kc * 8);
                    lds_st128(vimg + (kc >> 3) * 16384 + img_off(row, kc & 7), v); }
            }
            __syncthreads();
            f32x4 acc[4][2];
#pragma unroll
            for (int i = 0; i < 4; ++i) { acc[i][0] = (f32x4){0.f, 0.f, 0.f, 0.f}; acc[i][1] = acc[i][0]; }
#pragma unroll
            for (int kh = 0; kh < 2; ++kh)
#pragma unroll
                for (int s = 0; s < 2; ++s) {
                    bf16x8 af[4], vf[2];
#pragma unroll
                    for (int mb = 0; mb < 4; ++mb) af[mb] = lds_ld128(aimg + kh * 16384 + img_off(wr * 64 + mb * 16 + r16, 4 * s + g));
#pragma unroll
                    for (int nb = 0; nb < 2; ++nb) vf[nb] = lds_ld128(vimg + kh * 16384 + img_off(wc * 32 + nb * 16 + r16, 4 * s + g));
#pragma unroll
                    for (int mb = 0; mb < 4; ++mb)
#pragma unroll
                        for (int nb = 0; nb < 2; ++nb) acc[mb][nb] = __builtin_amdgcn_mfma_f32_16x16x32_bf16(vf[nb], af[mb], acc[mb][nb], 0, 0, 0);
                }
#pragma unroll
            for (int mb = 0; mb < 4; ++mb) {
                const int n = wr * 64 + mb * 16 + r16;
                const float bp = biasp[n], bs = p.gm_b_s[grp * 128 + n];
                const size_t row = (size_t)chunk * 128 + n;
#pragma unroll
                for (int nb = 0; nb < 2; ++nb) {
                    const int col = grp * 384 + cs * 128 + wc * 32 + nb * 16 + 4 * g;
                    const f32x4 gn = *(const f32x4*)(p.gm_v_gain + col);
                    const u32x2 uw = *(const u32x2*)(p.U + row * 3072 + col);
                    f32x4 t;
                    t[0] = bf_lo(uw.x) * (gn[0] * (acc[mb][nb][0] - bp) + bs);
                    t[1] = bf_hi(uw.x) * (gn[1] * (acc[mb][nb][1] - bp) + bs);
                    t[2] = bf_lo(uw.y) * (gn[2] * (acc[mb][nb][2] - bp) + bs);
                    t[3] = bf_hi(uw.y) * (gn[3] * (acc[mb][nb][3] - bp) + bs);
                    st_bf16x4(p.TT + row * 3072 + col, t);
                }
            }
        }
    }
}

constexpr int N_PHASES = 2 + 10 * DEPTH;
__global__ void __launch_bounds__(NTHREADS, 2) fwd_kernel(Params p_kernarg) {
    extern __shared__ __attribute__((aligned(16))) unsigned char smem[];
    lds_t* lds = (lds_t*)smem;
    const int tid0 = threadIdx.x, bid0 = blockIdx.x, nblk0 = gridDim.x;
    const int wave0 = __builtin_amdgcn_readfirstlane(tid0 >> 6);
    volatile LAS unsigned* misc = (volatile LAS unsigned*)(lds + LDS_MAIN);
    if (tid0 == 0) { misc[0] = 0u; misc[1] = 0u; misc[2] = 0u; misc[3] = 0u; }
    __syncthreads();
    typedef const __attribute__((address_space(4))) Params* kparams_t;
    kparams_t pp = (kparams_t)__builtin_amdgcn_kernarg_segment_ptr();
    const int lo = (int)pp->ph_lo, hi = (int)pp->ph_hi;
    XcdBarrier bar; bar.bar = pp->bar; bar.x = 0; bar.st = misc;
    if (hi - lo > 1) bar = xcd_barrier_post(bar.bar, misc);
#define IN(k) (lo <= (k) && (k) < hi)
#ifndef REP_MASK
#define REP_MASK 0
#endif
#ifndef REP_N
#define REP_N 1
#endif
#define RUN(k, knext, cls, body) do { if (IN(k)) { { asm volatile("" : "+s"(pp)); Params p; __builtin_memcpy(&p, pp, sizeof(Params)); \
        unsigned zz = 0u; asm volatile("" : "+s"(zz)); int tid = wave0 * 64 + (int)__builtin_amdgcn_mbcnt_hi(~0u, __builtin_amdgcn_mbcnt_lo(~0u, zz)), bid = bid0, nblk = nblk0; asm volatile("" : "+v"(tid)); asm volatile("" : "+s"(bid), "+s"(nblk)); body; \
        if ((REP_MASK) & (cls)) { _Pragma("unroll 1") for (int rr = 0; rr < REP_N; ++rr) { asm volatile("" : "+v"(tid)); body; } } } if (IN(knext)) { xcd_barrier(bar); if ((REP_MASK) & 8192) xcd_barrier(bar); } } } while (0)
    RUN(0, 1, 64, { phase_modulation(p, lds, bid, nblk, tid); phase_wconv(p, lds, bid, nblk, tid); });
    RUN(1, 2, 512, phase_prep(p, bid, nblk, tid));
#pragma unroll 1
    for (int li = 0; li < DEPTH; ++li) {
        const int kind = li % 3, j = li / 3, base = 2 + 10 * li;
        if (kind == 0) {
            RUN(base + 0, base + 1, 32, phase_mla_win(p, j, lds, bid, nblk, tid));
            RUN(base + 1, base + 2, 1024, phase_mla_norm(p, j, bid, nblk, tid));
            RUN(base + 2, base + 3, 32768, phase_mla_up(p, j, lds, bid, nblk, tid));
            RUN(base + 3, base + 4, 16, phase_mla_attn(p, lds, bid, nblk, tid));
            RUN(base + 4, base + 5, 8, phase_out_proj(p, li, p.O, 1024, p.WTO + (size_t)j * 1024 * 1024, lds, bid, nblk, tid));
        } else if (kind == 1) {
            RUN(base + 0, base + 1, 4, phase_gm_win(p, lds, bid, nblk, tid));
            RUN(base + 1, base + 2, 128, phase_gm_spatial(p, lds, bid, nblk, tid));
            RUN(base + 2, base + 5, 8, phase_out_proj(p, li, p.TT, 3072, p.WTGO, lds, bid, nblk, tid));
        } else {
            RUN(base + 0, base + 1, 16384, phase_swa_qkv(p, lds, bid, nblk, tid));
            RUN(base + 1, base + 2, 16, phase_swa_attn(p, lds, bid, nblk, tid));
            RUN(base + 2, base + 5, 8, phase_out_proj(p, li, p.O, 1024, p.WTSO, lds, bid, nblk, tid));
        }
        RUN(base + 5, base + 6, 2048, phase_ln_a(p, li, lds, bid, nblk, tid));
        RUN(base + 6, base + 7, 256, phase_topk(p, lds, bid, nblk, tid));
        RUN(base + 7, base + 8, 1, phase_moe_up(p, li, lds, bid, nblk, tid));
        RUN(base + 8, base + 9, 2, phase_moe_down(p, li, lds, bid, nblk, tid));
        RUN(base + 9, base + 10, 4096, phase_ln_b(p, li, bid, nblk, tid));
    }
#undef IN
#undef RUN
}

#ifdef PROBE_V
__global__ void __launch_bounds__(NTHREADS, 2) probe_kernel(Params p) {
    extern __shared__ __attribute__((aligned(16))) unsigned char smem[];
    lds_t* lds = (lds_t*)smem;
    const int tid = threadIdx.x, bid = blockIdx.x, nblk = gridDim.x;
#if PROBE_V < 1000
    if (PROBE_V == 1) phase_mla_attn(p, lds, bid, nblk, tid);
    else if (PROBE_V == 2) phase_swa_attn(p, lds, bid, nblk, tid);
    else if (PROBE_V == 3) phase_gm_spatial(p, lds, bid, nblk, tid);
    else if (PROBE_V == 4) phase_ln_a(p, 3, lds, bid, nblk, tid);
    else if (PROBE_V == 5) phase_mla_up(p, 1, lds, bid, nblk, tid);
    else if (PROBE_V == 7) phase_moe_up<1>(p, 0, lds, bid, nblk, tid);
    else phase_moe_up<0>(p, 0, lds, bid, nblk, tid);
#else
    const int lane = tid & 63, wave = tid >> 6;
    const int u0 = xcd_first_unit(bid, nblk);
    f32x4 acc = (f32x4){0.f, 0.f, 0.f, 0.f};
    for (int u = u0; u < 1024; u += nblk) {
        const int e = u >> 6, w = u & 63, nt = w >> 2;
        const float* wp = p.moe_w_gate + (size_t)e * 1024 * 2048 + nt * 128 + 4 * lane + (size_t)(8 * wave) * 2048;
        const bf16_t* xp = p.H2 + (size_t)((u * 37 + wave * 8 + (lane >> 3)) & 8191) * 1024 + (lane & 7) * 8;
#pragma unroll 2
        for (int kt = 0; kt < 16; ++kt) {
            const float* q = wp + (size_t)((PROBE_V & 1) ? 0 : ((PROBE_V & 4) ? ((kt + (w & 3) * ((PROBE_V >> 4) & 7)) & 15) : ((PROBE_V & 8) ? (kt & 3) : kt))) * 64 * 2048;
#pragma unroll
            for (int i = 0; i < 8; ++i) acc += *(const f32x4*)(q + (size_t)i * 2048);
            if (PROBE_V & 2) {
#pragma unroll
                for (int j = 0; j < 4; ++j) { const u32x4 x = *(const u32x4*)(xp + (size_t)j * 64 * 1024 + kt * 64); acc[0] += __uint_as_float(x.x & 0x3f800000u); }
            }
        }
    }
    if (acc[0] + acc[1] + acc[2] + acc[3] == 12345.678f) p.GST[tid] = acc[0];
#endif
}
#endif
extern "C" void kernel_launch(void* const* d_in, const int* in_sizes, int n_in, void* d_out, int out_size, void* d_ws, size_t ws_size, hipStream_t stream) {
    static int grid = 0;
    if (grid == 0) {
        int dev = 0, cus = 0, per_cu = 0;
        if (hipGetDevice(&dev) != hipSuccess || hipDeviceGetAttribute(&cus, hipDeviceAttributeMultiprocessorCount, dev) != hipSuccess) { fprintf(stderr, "kernel_launch: device query failed\n"); grid = -1; return; }
        if (hipFuncSetAttribute((const void*)fwd_kernel, hipFuncAttributeMaxDynamicSharedMemorySize, LDS_BYTES) != hipSuccess) { fprintf(stderr, "kernel_launch: hipFuncSetAttribute failed\n"); grid = -1; return; }
        if (hipOccupancyMaxActiveBlocksPerMultiprocessor(&per_cu, (const void*)fwd_kernel, NTHREADS, LDS_BYTES) != hipSuccess || per_cu < 1) {
            fprintf(stderr, "kernel_launch: occupancy query reports %d blocks per CU\n", per_cu); (void)hipGetLastError(); per_cu = 1; }
        grid = cus;
    }
    if (grid < 0) return;
    unsigned char* ws = (unsigned char*)d_ws;
    size_t off = 0;
    auto take = [&](size_t bytes) { unsigned char* r = ws + off; off += (bytes + 255) & ~(size_t)255; return r; };
    Params p{};
    const float* const* in = (const float* const*)d_in;
    p.x_prompt = in[0]; p.x_sample = in[1]; p.cache_ckv = in[2]; p.cache_kpe = in[3]; p.cache_k = in[4]; p.cache_v = in[5]; p.c = in[6]; p.c_ctx = in[7];
    p.mod_w = in[8]; p.mod_b = in[9]; p.ln_gain = in[10]; p.ln_bias = in[11];
    p.mla_w_in = in[12]; p.mla_q_gain = in[13]; p.mla_kv_gain = in[14]; p.mla_w_q_up = in[15]; p.mla_w_kv_up = in[16]; p.mla_w_out = in[17];
    p.gm_w_in = in[18]; p.gm_v_gain = in[19]; p.gm_w_s = in[20]; p.gm_b_s = in[21]; p.gm_w_out = in[22];
    p.swa_w_qkv = in[23]; p.swa_sink = in[24]; p.swa_w_out = in[25];
    p.moe_router = in[26]; p.moe_w_gate = in[27]; p.moe_w_up = in[28]; p.moe_w_down = in[29];
    p.out = (float*)d_out;
    p.bar = (unsigned*)take(16384);
    p.mod = (float*)take((size_t)DEPTH * 5 * 6144 * 4);
    p.X0 = (float*)take((size_t)NTOK * D * 4); p.X1 = (float*)take((size_t)NTOK * D * 4); p.T = (float*)take((size_t)NTOK * D * 4);
    p.Z = (float*)take((size_t)NTOK * 704 * 4); p.GST = (float*)take((size_t)NTOK * 96 * 4); p.AFF = (float*)take((size_t)NTOK * 16 * 4); p.GATEV = (float*)take(16 * 1024 * 4);
    p.H = (bf16_t*)take((size_t)NTOK * D * 2); p.H2 = (bf16_t*)take((size_t)NTOK * D * 2);
    p.CQ = (bf16_t*)take((size_t)NTOK * 384 * 2); p.CKV = (bf16_t*)take((size_t)NROWS_KV * 256 * 2); p.KPE = (bf16_t*)take((size_t)NROWS_KV * 64 * 2);
    p.Q = (bf16_t*)take((size_t)NTOK * 1536 * 2); p.KN = (bf16_t*)take((size_t)NROWS_KV * 1024 * 2);
    p.VTP = (bf16_t*)take((size_t)16 * 8 * 128 * 256 * 2); p.VTS = (bf16_t*)take((size_t)4 * 8 * 128 * 1280 * 2);
    p.O = (bf16_t*)take((size_t)NTOK * D * 2);
    p.U = (bf16_t*)take((size_t)NTOK * 3072 * 2); p.GVT = (bf16_t*)take((size_t)NTOK * 3072 * 2); p.TT = (bf16_t*)take((size_t)NTOK * 3072 * 2);
    p.SK = (bf16_t*)take((size_t)NROWS_KV * 256 * 2); p.SVTP = (bf16_t*)take((size_t)16 * 4 * 64 * 256 * 2); p.SVTS = (bf16_t*)take((size_t)4 * 4 * 64 * 1280 * 2);
    p.HID = (bf16_t*)take((size_t)16 * 1024 * 2048 * 2); p.YE = (bf16_t*)take((size_t)16 * 1024 * 1024 * 2);
    p.SEL = (int*)take((size_t)NTOK * 16 * 4); p.IDX = (int*)take(16 * 1024 * 4);
    p.WTI = (bf16_t*)take((size_t)2 * 704 * 1024 * 2); p.WTQ = (bf16_t*)take((size_t)2 * 1536 * 384 * 2); p.WTKV = (bf16_t*)take((size_t)2 * 2048 * 256 * 2); p.WTO = (bf16_t*)take((size_t)2 * 1024 * 1024 * 2);
    p.WTGI = (bf16_t*)take((size_t)6144 * 1024 * 2); p.WTGO = (bf16_t*)take((size_t)1024 * 3072 * 2); p.WTSQ = (bf16_t*)take((size_t)1536 * 1024 * 2); p.WTSO = (bf16_t*)take((size_t)1024 * 1024 * 2);
    if (off > ws_size) { fprintf(stderr, "kernel_launch: workspace too small: need %zu, have %zu\n", off, ws_size); return; }
    (void)in_sizes; (void)n_in; (void)out_size;
    if (hipMemsetAsync(p.bar, 0, 16384, stream) != hipSuccess) { fprintf(stderr, "kernel_launch: memset failed\n"); return; }
#if N_LAUNCH_PER_PHASE
#ifndef MAX_PHASE
#define MAX_PHASE N_PHASES
#endif
    for (int k = 0; k < MAX_PHASE; ++k) {
        if (k >= 2) { const int li = (k - 2) / 10, s = (k - 2) % 10, kind = li % 3; if (kind != 0 && (s == 3 || s == 4)) continue; }
        p.ph_lo = k; p.ph_hi = k + 1;
        hipLaunchKernelGGL(fwd_kernel, dim3(grid), dim3(NTHREADS), LDS_BYTES, stream, p);
    }
#else
    p.ph_lo = 0; p.ph_hi = N_PHASES;
    hipLaunchKernelGGL(fwd_kernel, dim3(grid), dim3(NTHREADS), LDS_BYTES, stream, p);
#endif
#ifdef PROBE_V
    { static int once = 0; if (!once) { once = 1; (void)hipFuncSetAttribute((const void*)probe_kernel, hipFuncAttributeMaxDynamicSharedMemorySize, LDS_BYTES); }
      hipLaunchKernelGGL(probe_kernel, dim3(grid), dim3(NTHREADS), LDS_BYTES, stream, p); }
#endif
    const hipError_t le = hipPeekAtLastError();
    if (le != hipSuccess) fprintf(stderr, "kernel_launch: launch failed: %s\n", hipGetErrorName(le));
}
```

```cpp
#include <hip/hip_runtime.h>
#include <stdint.h>
#include <stdio.h>

#ifndef N_LAUNCH_PER_PHASE
#define N_LAUNCH_PER_PHASE 0
#endif

#define DEVI __device__ __forceinline__
#define LAS __attribute__((address_space(3)))
typedef unsigned short bf16_t;
typedef short bf16x8 __attribute__((ext_vector_type(8)));
typedef float f32x4 __attribute__((ext_vector_type(4)));
typedef float f32x2 __attribute__((ext_vector_type(2)));
typedef unsigned u32x4 __attribute__((ext_vector_type(4)));
typedef int i32x4 __attribute__((ext_vector_type(4)));
typedef unsigned u32x2 __attribute__((ext_vector_type(2)));
typedef LAS unsigned char lds_t;

constexpr int D = 1024;
constexpr int NTOK = 8192, NPR = 4096;
constexpr int NROWS_KV = 9216;
constexpr int DEPTH = 4;
constexpr float ALPHA_F = 1.681792830507429f;
constexpr float EPS_F = 1e-6f;
constexpr float LOG2E = 1.4426950408889634f;
constexpr int NTHREADS = 512;
constexpr int LDS_MAIN = 147456;
constexpr int LDS_BYTES = LDS_MAIN + 1024;

__device__ const float rope_tab[64 * 16 * 2] = {
1.000000000e+00f,0.000000000e+00f,1.000000000e+00f,0.000000000e+00f,1.000000000e+00f,0.000000000e+00f,1.000000000e+00f,0.000000000e+00f,1.000000000e+00f,0.000000000e+00f,1.000000000e+00f,0.000000000e+00f,1.000000000e+00f,0.000000000e+00f,1.000000000e+00f,0.000000000e+00f,1.000000000e+00f,0.000000000e+00f,1.000000000e+00f,0.000000000e+00f,1.000000000e+00f,0.000000000e+00f,1.000000000e+00f,0.000000000e+00f,1.000000000e+00f,0.000000000e+00f,1.000000000e+00f,0.000000000e+00f,1.000000000e+00f,0.000000000e+00f,1.000000000e+00f,0.000000000e+00f,
5.403023059e-01f,8.414709848e-01f,8.460091064e-01f,5.331684460e-01f,9.504152809e-01f,3.109835909e-01f,9.842302348e-01f,1.768921847e-01f,9.950041651e-01f,9.983341813e-02f,9.984192778e-01f,5.620449919e-02f,9.995000417e-01f,3.161750470e-02f,9.998418903e-01f,1.778185709e-02f,9.999500004e-01f,9.999833111e-03f,9.999841887e-01f,5.623383612e-03f,9.999950000e-01f,3.162272359e-03f,9.999984189e-01f,1.778278494e-03f,9.999995000e-01f,9.999998808e-04f,9.999998419e-01f,5.623412721e-04f,9.999999500e-01f,3.162277519e-04f,9.999999842e-01f,1.778279393e-04f,
-4.161468365e-01f,9.092974268e-01f,4.314628163e-01f,9.021307212e-01f,8.065784124e-01f,5.911271138e-01f,9.374183100e-01f,3.482052729e-01f,9.800665772e-01f,1.986693337e-01f,9.936821085e-01f,1.122313110e-01f,9.980006668e-01f,6.320339453e-02f,9.993676111e-01f,3.555809121e-02f,9.998000067e-01f,1.999866625e-02f,9.999367551e-01f,1.124658940e-02f,9.999800001e-01f,6.324513096e-03f,9.999936755e-01f,3.556551364e-03f,9.999980000e-01f,1.999998762e-03f,9.999993675e-01f,1.124682366e-03f,9.999998000e-01f,6.324554721e-04f,9.999999368e-01f,3.556558729e-04f,
-9.899924966e-01f,1.411200081e-01f,-1.159661631e-01f,9.932531646e-01f,5.827536401e-01f,8.126488756e-01f,8.610406595e-01f,5.085361174e-01f,9.553364856e-01f,2.955202180e-01f,9.858034692e-01f,1.679033061e-01f,9.955033745e-01f,9.472608625e-02f,9.985773124e-01f,5.332308304e-02f,9.995500338e-01f,2.999549953e-02f,9.998577009e-01f,1.686943954e-02f,9.999550003e-01f,9.486690354e-03f,9.999857698e-01f,5.334812988e-03f,9.999955000e-01f,2.999995526e-03f,9.999985770e-01f,1.687023105e-03f,9.999995500e-01f,9.486831000e-04f,9.999998577e-01f,5.334837808e-04f,
-6.536436209e-01f,-7.568024953e-01f,-6.276796763e-01f,7.784717233e-01f,3.011374707e-01f,9.535807379e-01f,7.575061759e-01f,6.528279969e-01f,9.210609917e-01f,3.894183478e-01f,9.748082657e-01f,2.230444915e-01f,9.920106618e-01f,1.261540598e-01f,9.974712443e-01f,7.107120934e-02f,9.992001067e-01f,3.998933329e-02f,9.997470285e-01f,2.249175622e-02f,9.999200011e-01f,1.264877321e-02f,9.999747019e-01f,7.113057742e-03f,9.999920000e-01f,3.999989523e-03f,9.999974702e-01f,2.249363310e-03f,9.999992000e-01f,1.264910691e-03f,9.999997470e-01f,7.113117008e-04f,
2.836621855e-01f,-9.589242747e-01f,-9.460792425e-01f,3.239352821e-01f,-1.034233808e-02f,9.999465166e-01f,6.300802992e-01f,7.765299843e-01f,8.775825619e-01f,4.794255386e-01f,9.607312596e-01f,2.774805341e-01f,9.875260225e-01f,1.574558824e-01f,9.960497565e-01f,8.879686156e-02f,9.987502605e-01f,4.997916629e-02f,9.996047413e-01f,2.811336165e-02f,9.998750026e-01f,1.581072865e-02f,9.999604718e-01f,8.891280002e-03f,9.999875000e-01f,4.999979521e-03f,9.999960472e-01f,2.811702920e-03f,9.999987500e-01f,1.581138156e-03f,9.999996047e-01f,8.891395984e-04f,
9.601702867e-01f,-2.794154982e-01f,-9.731036980e-01f,-2.303675170e-01f,-3.207963899e-01f,9.471481807e-01f,4.827820346e-01f,8.757405478e-01f,8.253356014e-01f,5.646424931e-01f,9.436169596e-01f,3.310393232e-01f,9.820539372e-01f,1.886002770e-01f,9.943132976e-01f,1.064944419e-01f,9.982005400e-01f,5.996400514e-02f,9.994308440e-01f,3.373407806e-02f,9.998200054e-01f,1.897252691e-02f,9.999430795e-01f,1.066947415e-02f,9.999820001e-01f,5.999964052e-03f,9.999943079e-01f,3.374041408e-03f,9.999982000e-01f,1.897365346e-03f,9.999994308e-01f,1.066967410e-03f,
7.539022543e-01f,6.569865987e-01f,-7.004298139e-01f,-7.137212872e-01f,-5.994374526e-01f,8.004216016e-01f,3.202570024e-01f,9.473306986e-01f,7.648421950e-01f,6.442176781e-01f,9.235194568e-01f,3.835515778e-01f,9.755998794e-01f,2.195560870e-01f,9.922624183e-01f,1.241583392e-01f,9.975510002e-01f,6.994284763e-02f,9.992253421e-01f,3.935372584e-02f,9.997550100e-01f,2.213413545e-02f,9.999225252e-01f,1.244763455e-02f,9.999755001e-01f,6.999943050e-03f,9.999922524e-01f,3.936378830e-03f,9.999975500e-01f,2.213592463e-03f,9.999992252e-01f,1.244795304e-03f,
-1.455000338e-01f,9.893582466e-01f,-2.120364479e-01f,-9.772617586e-01f,-8.186324475e-01f,5.743177830e-01f,1.476312130e-01f,9.890424788e-01f,6.967067008e-01f,7.173560992e-01f,9.005023096e-01f,4.348512278e-01f,9.681703064e-01f,2.502923447e-01f,9.898977664e-01f,1.417829752e-01f,9.968017064e-01f,7.991469219e-02f,9.989882418e-01f,4.497213288e-02f,9.996800171e-01f,2.529552265e-02f,9.998988088e-01f,1.422575559e-02f,9.999680002e-01f,7.999915047e-03f,9.999898807e-01f,4.498715239e-03f,9.999968000e-01f,2.529819359e-03f,9.999989881e-01f,1.422623042e-03f,
-9.111302619e-01f,4.121184852e-01f,3.416602554e-01f,-9.398235313e-01f,-9.566441680e-01f,2.912592245e-01f,-2.965079623e-02f,9.995603185e-01f,6.216099403e-01f,7.833269319e-01f,8.746382611e-01f,4.847761465e-01f,9.597726443e-01f,2.807783310e-01f,9.872200896e-01f,1.593627767e-01f,9.959527334e-01f,8.987854534e-02f,9.987195508e-01f,5.058911778e-02f,9.995950273e-01f,2.845665689e-02f,9.998719305e-01f,1.600383071e-02f,9.999595003e-01f,8.999879044e-03f,9.999871928e-01f,5.061050226e-03f,9.999959500e-01f,2.846046001e-03f,9.999987193e-01f,1.600450735e-03f,
-8.390715291e-01f,-5.440211109e-01f,7.901318660e-01f,-6.129368926e-01f,-9.997860721e-01f,-2.068356987e-02f,-2.059976331e-01f,9.785524897e-01f,5.403023059e-01f,8.414709848e-01f,8.460091064e-01f,5.331684460e-01f,9.504152902e-01f,3.109835626e-01f,9.842302348e-01f,1.768921847e-01f,9.950041659e-01f,9.983341072e-02f,9.984192778e-01f,5.620449919e-02f,9.995000417e-01f,3.161750470e-02f,9.998418903e-01f,1.778185709e-02f,9.999500004e-01f,9.999834042e-03f,9.999841887e-01f,5.623383612e-03f,9.999950000e-01f,3.162272359e-03f,9.999984189e-01f,1.778278494e-03f,
4.425697988e-03f,-9.999902066e-01f,9.952573993e-01f,-9.727645772e-02f,-9.437797393e-01f,-3.305749593e-01f,-3.758474003e-01f,9.266815697e-01f,4.535961002e-01f,8.912073709e-01f,8.147053420e-01f,5.798751639e-01f,9.401075903e-01f,3.408778647e-01f,9.809291472e-01f,1.943656558e-01f,9.939560980e-01f,1.097783002e-01f,9.980874321e-01f,6.181810327e-02f,9.993950610e-01f,3.477804006e-02f,9.998086883e-01f,1.955982724e-02f,9.999395006e-01f,1.099977904e-02f,9.999808683e-01f,6.185714754e-03f,9.999939500e-01f,3.478498401e-03f,9.999980868e-01f,1.956106080e-03f,
8.438539587e-01f,-5.365729180e-01f,8.938616142e-01f,4.483429653e-01f,-7.941793525e-01f,-6.076834341e-01f,-5.338430142e-01f,8.455836068e-01f,3.623577100e-01f,9.320391032e-01f,7.808259330e-01f,6.247486393e-01f,9.288598710e-01f,3.704312892e-01f,9.773178677e-01f,2.117776794e-01f,9.928086362e-01f,1.197122046e-01f,9.977240240e-01f,6.742975621e-02f,9.992800864e-01f,3.793822392e-02f,9.997723246e-01f,2.133773367e-02f,9.999280009e-01f,1.199971211e-02f,9.999772317e-01f,6.748044406e-03f,9.999928000e-01f,3.794723862e-03f,9.999977232e-01f,2.133933605e-03f,
9.074467815e-01f,4.201670368e-01f,5.171728454e-01f,8.558809777e-01f,-5.658204930e-01f,-8.245284529e-01f,-6.750016657e-01f,7.378162043e-01f,2.674987597e-01f,9.635582046e-01f,7.444779872e-01f,6.676470075e-01f,9.166833698e-01f,3.996143135e-01f,9.733975442e-01f,2.291227201e-01f,9.915618943e-01f,1.296341379e-01f,9.973290651e-01f,7.303927684e-02f,9.991551190e-01f,4.109803212e-02f,9.997327995e-01f,2.311557262e-02f,9.999155012e-01f,1.299963410e-02f,9.999732789e-01f,7.310371924e-03f,9.999915500e-01f,4.110949176e-03f,9.999973279e-01f,2.311761062e-03f,
1.367372182e-01f,9.906073557e-01f,-1.879615160e-02f,9.998233367e-01f,-2.813494808e-01f,-9.596053718e-01f,-7.948709048e-01f,6.067785796e-01f,1.699671664e-01f,9.854497259e-01f,7.057763743e-01f,7.084346897e-01f,9.035902493e-01f,4.283977840e-01f,9.691694136e-01f,2.463953078e-01f,9.902159961e-01f,1.395431152e-01f,9.969025685e-01f,7.864648034e-02f,9.990201601e-01f,4.425742562e-02f,9.996901128e-01f,2.489334034e-02f,9.999020016e-01f,1.399954310e-02f,9.999690098e-01f,7.872696665e-03f,9.999902000e-01f,4.427174080e-03f,9.999969010e-01f,2.489588678e-03f,
-7.596879129e-01f,6.502878402e-01f,-5.489754720e-01f,8.358384600e-01f,3.102235090e-02f,-9.995186910e-01f,-8.896704271e-01f,4.566032536e-01f,7.073720167e-02f,9.974949866e-01f,6.648435293e-01f,7.469826514e-01f,8.895936264e-01f,4.567528653e-01f,9.646348168e-01f,2.635899662e-01f,9.887710793e-01f,1.494381236e-01f,9.964445467e-01f,8.425120425e-02f,9.988752109e-01f,4.741638026e-02f,9.996442648e-01f,2.667102934e-02f,9.998875021e-01f,1.499943810e-02f,9.999644246e-01f,8.435019847e-03f,9.999887500e-01f,4.743398540e-03f,9.999964424e-01f,2.667415984e-03f,
-9.576594803e-01f,-2.879033167e-01f,-9.100810896e-01f,4.144302238e-01f,3.403181682e-01f,-9.403103447e-01f,-9.564100499e-01f,2.920270818e-01f,-2.919954613e-02f,9.995736023e-01f,6.218088193e-01f,7.831690700e-01f,8.747074844e-01f,4.846512321e-01f,9.597951759e-01f,2.807013010e-01f,9.872272839e-01f,1.593182031e-01f,9.959550145e-01f,8.985326392e-02f,9.987202731e-01f,5.057485702e-02f,9.995952558e-01f,2.844863214e-02f,9.998720027e-01f,1.599931810e-02f,9.999595231e-01f,8.997339431e-03f,9.999872000e-01f,5.059622526e-03f,9.999959523e-01f,2.845243204e-03f,
-2.751633381e-01f,-9.613974919e-01f,-9.908979596e-01f,-1.346151313e-01f,6.158647923e-01f,-7.878518627e-01f,-9.929849841e-01f,1.182405237e-01f,-1.288445416e-01f,9.916648043e-01f,5.768082960e-01f,8.168795441e-01f,8.589467084e-01f,5.120649883e-01f,9.546520286e-01f,2.977238725e-01f,9.855847666e-01f,1.691823508e-01f,9.954339876e-01f,9.545248218e-02f,9.985553481e-01f,5.373282803e-02f,9.995430857e-01f,3.022614497e-02f,9.998555035e-01f,1.699918210e-02f,9.999543054e-01f,9.559656169e-03f,9.999855500e-01f,5.375846007e-03f,9.999954305e-01f,3.023070335e-03f,
6.603167082e-01f,-7.509872468e-01f,-7.665365398e-01f,-6.422006954e-01f,8.303361283e-01f,-5.572628770e-01f,-9.982416606e-01f,-5.927551864e-02f,-2.272021643e-01f,9.738476146e-01f,5.299841756e-01f,8.480075316e-01f,8.423270577e-01f,5.389667224e-01f,9.492070108e-01f,3.146522695e-01f,9.838436942e-01f,1.790295658e-01f,9.948814823e-01f,1.010486820e-01f,9.983804374e-01f,5.689026544e-02f,9.994877548e-01f,3.200356222e-02f,9.998380044e-01f,1.799902910e-02f,9.999487715e-01f,1.012197082e-02f,9.999838000e-01f,5.692068949e-03f,9.999948771e-01f,3.200897370e-03f,
9.887046182e-01f,1.498772097e-01f,-3.060954058e-01f,-9.520008417e-01f,9.624637956e-01f,-2.714100995e-01f,-9.720142724e-01f,-2.349218044e-01f,-3.232895443e-01f,9.463000954e-01f,4.814845890e-01f,8.764545570e-01f,8.248651506e-01f,5.653295351e-01f,9.434618259e-01f,3.314811956e-01f,9.820042356e-01f,1.888588926e-01f,9.942975170e-01f,1.066416789e-01f,9.981955430e-01f,6.004713022e-02f,9.994292631e-01f,3.378088199e-02f,9.998195054e-01f,1.899885811e-02f,9.999429214e-01f,1.068428133e-02f,9.999819501e-01f,6.008291323e-03f,9.999942921e-01f,3.378724537e-03f,
4.080820618e-01f,9.129452507e-01f,2.486167313e-01f,-9.686019414e-01f,9.991443799e-01f,4.135829015e-02f,-9.151299503e-01f,-4.031589936e-01f,-4.161468365e-01f,9.092974268e-01f,4.314628163e-01f,9.021307212e-01f,8.065784476e-01f,5.911270657e-01f,9.374183100e-01f,3.482052729e-01f,9.800665802e-01f,1.986693191e-01f,9.936821085e-01f,1.122313110e-01f,9.980006668e-01f,6.320339453e-02f,9.993676111e-01f,3.555809121e-02f,9.998000066e-01f,1.999866811e-02f,9.999367551e-01f,1.124658940e-02f,9.999800001e-01f,6.324513096e-03f,9.999936755e-01f,3.556551364e-03f,
-5.477292602e-01f,8.366556385e-01f,7.267602563e-01f,-6.868912067e-01f,9.367404516e-01f,3.500247509e-01f,-8.293829489e-01f,-5.586805205e-01f,-5.048462281e-01f,8.632092944e-01f,3.800769984e-01f,9.249548504e-01f,7.874851971e-01f,6.163335658e-01f,9.310783539e-01f,3.648192688e-01f,9.780309161e-01f,2.084598934e-01f,9.930352772e-01f,1.178173940e-01f,9.977958103e-01f,6.635903053e-02f,9.993027988e-01f,3.733518799e-02f,9.997795081e-01f,2.099845811e-02f,9.999302726e-01f,1.180889298e-02f,9.999779501e-01f,6.640734236e-03f,9.999930272e-01f,3.734378079e-03f,
-9.999608264e-01f,-8.851309290e-03f,9.810745815e-01f,-1.936302286e-01f,7.814403926e-01f,6.239798978e-01f,-7.174774633e-01f,-6.965817179e-01f,-5.885011558e-01f,8.084963758e-01f,3.274895886e-01f,9.448547874e-01f,7.676045628e-01f,6.409237359e-01f,9.244439837e-01f,3.813178741e-01f,9.758974496e-01f,2.182296219e-01f,9.923570442e-01f,1.233997439e-01f,9.975809759e-01f,6.951400294e-02f,9.992348263e-01f,3.911217043e-02f,9.997580097e-01f,2.199822712e-02f,9.999234739e-01f,1.237119282e-02f,9.999758001e-01f,6.956954712e-03f,9.999923473e-01f,3.912204676e-03f,
-5.328330203e-01f,-8.462204042e-01f,9.332357723e-01f,3.592645171e-01f,5.486452564e-01f,8.360552510e-01f,-5.829432350e-01f,-8.125128828e-01f,-6.662759857e-01f,7.457052439e-01f,2.738668392e-01f,9.617676197e-01f,7.469563882e-01f,6.648730361e-01f,9.175172750e-01f,3.976959268e-01f,9.736663975e-01f,2.279775131e-01f,9.916474294e-01f,1.289781990e-01f,9.973561656e-01f,7.266828020e-02f,9.991636941e-01f,4.088902546e-02f,9.997355116e-01f,2.299797413e-02f,9.999163589e-01f,1.293348969e-02f,9.999735501e-01f,7.273174492e-03f,9.999916358e-01f,4.090031381e-03f,
4.241790073e-01f,-9.055783620e-01f,5.979771709e-01f,8.015131335e-01f,2.614416878e-01f,9.652192724e-01f,-4.300232723e-01f,-9.028178029e-01f,-7.373937800e-01f,6.754631102e-01f,2.193782753e-01f,9.756398784e-01f,7.255613200e-01f,6.881575190e-01f,9.103004290e-01f,4.139482201e-01f,9.713379761e-01f,2.377026212e-01f,9.909064560e-01f,1.345525754e-01f,9.971213823e-01f,7.582182336e-02f,9.990894022e-01f,4.266575118e-02f,9.997120138e-01f,2.399769627e-02f,9.999089278e-01f,1.349578153e-02f,9.999712001e-01f,7.589393080e-03f,9.999908927e-01f,4.267857492e-03f,
9.912028119e-01f,-1.323517501e-01f,7.855226359e-02f,9.969099969e-01f,-5.168932904e-02f,9.986632131e-01f,-2.635405934e-01f,-9.646483067e-01f,-8.011436155e-01f,5.984721441e-01f,1.641961594e-01f,9.864277070e-01f,7.034407513e-01f,7.107539022e-01f,9.027957408e-01f,4.300695879e-01f,9.689124217e-01f,2.474039593e-01f,9.901341474e-01f,1.401226969e-01f,9.968766273e-01f,7.897461572e-02f,9.990119510e-01f,4.444234199e-02f,9.996875163e-01f,2.499739629e-02f,9.999011805e-01f,1.405806910e-02f,9.999687502e-01f,7.905611374e-03f,9.999901179e-01f,4.445683934e-03f,
6.469193223e-01f,7.625584505e-01f,-4.650644959e-01f,8.852768012e-01f,-3.596943393e-01f,9.330701915e-01f,-8.874550263e-02f,-9.960543337e-01f,-8.568888271e-01f,5.155012492e-01f,1.084949468e-01f,9.940970006e-01f,6.806168009e-01f,7.326395911e-01f,8.950055582e-01f,4.460549862e-01f,9.663899806e-01f,2.570805427e-01f,9.893305281e-01f,1.456883874e-01f,9.966219035e-01f,8.212661834e-02f,9.989313406e-01f,4.621879226e-02f,9.996620190e-01f,2.599707130e-02f,9.998931169e-01f,1.462035317e-02f,9.999662002e-01f,8.221828878e-03f,9.999893115e-01f,4.623509769e-03f,
-2.921388087e-01f,9.563759284e-01f,-8.654506342e-01f,5.009942114e-01f,-6.320286307e-01f,7.749450367e-01f,8.884811635e-02f,-9.960451858e-01f,-9.040721624e-01f,4.273798371e-01f,5.245061444e-02f,9.986235192e-01f,6.571122908e-01f,7.537927018e-01f,8.869323709e-01f,4.618993066e-01f,9.637709015e-01f,2.667314183e-01f,9.884956235e-01f,1.512494708e-01f,9.963572141e-01f,8.527779227e-02f,9.988475711e-01f,4.799510009e-02f,9.996355221e-01f,2.699672032e-02f,9.998847372e-01f,1.518263167e-02f,9.999635502e-01f,8.538045559e-03f,9.999884735e-01f,4.801335923e-03f,
-9.626058663e-01f,2.709057883e-01f,-9.992934094e-01f,-3.758566202e-02f,-8.416849393e-01f,5.399689462e-01f,2.636395107e-01f,-9.646212772e-01f,-9.422223247e-01f,3.349881951e-01f,-3.759419011e-03f,9.999929334e-01f,6.329506774e-01f,7.741921209e-01f,8.785787046e-01f,4.775975920e-01f,9.610554380e-01f,2.763556497e-01f,9.876294623e-01f,1.568057565e-01f,9.960825606e-01f,8.842812085e-02f,9.987606432e-01f,4.977125243e-02f,9.996080256e-01f,2.799634234e-02f,9.998760413e-01f,1.574490538e-02f,9.999608003e-01f,8.854261387e-03f,9.999876039e-01f,4.979161926e-03f,
-7.480575297e-01f,-6.636338842e-01f,-8.253716334e-01f,-5.645898217e-01f,-9.678715076e-01f,2.514453117e-01f,4.301158485e-01f,-9.027737019e-01f,-9.709581880e-01f,2.392492366e-01f,-5.995756728e-02f,9.982009267e-01f,6.081562113e-01f,7.938173736e-01f,8.699472142e-01f,4.931448515e-01f,9.582438779e-01f,2.859522171e-01f,9.867320673e-01f,1.623570984e-01f,9.957979462e-01f,9.157756515e-02f,9.986705569e-01f,5.154724737e-02f,9.995795294e-01f,2.899593637e-02f,9.998670292e-01f,1.630717503e-02f,9.999579503e-01f,9.170476329e-03f,9.999867027e-01f,5.156987306e-03f,
1.542514499e-01f,-9.880316241e-01f,-3.972518623e-01f,-9.177096261e-01f,-9.980752275e-01f,-6.201483913e-02f,5.830269376e-01f,-8.124528233e-01f,-9.899924966e-01f,1.411200081e-01f,-1.159661631e-01f,9.932531646e-01f,5.827536401e-01f,8.126488756e-01f,8.610406595e-01f,5.085361174e-01f,9.553364944e-01f,2.955201896e-01f,9.858034692e-01f,1.679033061e-01f,9.955033738e-01f,9.472609366e-02f,9.985773124e-01f,5.332308304e-02f,9.995500337e-01f,2.999550139e-02f,9.998577009e-01f,1.686943954e-02f,9.999550003e-01f,9.486690354e-03f,9.999857698e-01f,5.334812988e-03f,
9.147423578e-01f,-4.040376453e-01f,1.532154756e-01f,-9.881928041e-01f,-9.293002953e-01f,-3.693250075e-01f,7.175492218e-01f,-6.965077991e-01f,-9.991351562e-01f,4.158051951e-02f,-1.716081385e-01f,9.851652891e-01f,5.567683641e-01f,8.306677968e-01f,8.518617972e-01f,5.237666260e-01f,9.523335692e-01f,3.050586387e-01f,9.848436973e-01f,1.734442042e-01f,9.951988471e-01f,9.787366751e-02f,9.984809103e-01f,5.509874635e-02f,9.995195384e-01f,3.099503643e-02f,9.998480564e-01f,1.743169684e-02f,9.999519504e-01f,9.802903431e-03f,9.999848053e-01f,5.512638036e-03f,
8.342233605e-01f,5.514266812e-01f,6.564951791e-01f,-7.543302193e-01f,-7.683670888e-01f,-6.400093881e-01f,8.294403670e-01f,-5.585952717e-01f,-9.982947730e-01f,-5.837419103e-02f,-2.267075845e-01f,9.739628695e-01f,5.302263665e-01f,8.478561200e-01f,8.424135592e-01f,5.388315091e-01f,9.492354203e-01f,3.145665538e-01f,9.838527819e-01f,1.789796175e-01f,9.948843677e-01f,1.010202700e-01f,9.983813507e-01f,5.687423543e-02f,9.994880436e-01f,3.199454047e-02f,9.998380958e-01f,1.799395049e-02f,9.999488004e-01f,1.011911553e-02f,9.999838092e-01f,5.690463375e-03f,
-1.327674722e-02f,9.999118601e-01f,9.575860738e-01f,-2.881473778e-01f,-5.312352786e-01f,-8.472243379e-01f,9.151713830e-01f,-4.030649323e-01f,-9.874797774e-01f,-1.577456471e-01f,-2.810903074e-01f,9.596813216e-01f,5.031541870e-01f,8.641966582e-01f,8.326989334e-01f,5.537260030e-01f,9.460423489e-01f,3.240430126e-01f,9.828307545e-01f,1.845093711e-01f,9.945599394e-01f,1.041658623e-01f,9.982786339e-01f,5.864954466e-02f,9.994555494e-01f,3.299401065e-02f,9.998278189e-01f,1.855619846e-02f,9.999455505e-01f,1.043532661e-02f,9.999827814e-01f,5.868288535e-03f,
-8.485702748e-01f,5.290826861e-01f,9.637575328e-01f,2.667797179e-01f,-2.414211151e-01f,-9.704204476e-01f,9.720383571e-01f,-2.348221291e-01f,-9.667981682e-01f,-2.555411942e-01f,-3.345843792e-01f,9.423657958e-01f,4.755788956e-01f,8.796730723e-01f,8.227209915e-01f,5.684453977e-01f,9.427546643e-01f,3.334870955e-01f,9.817776473e-01f,1.900332899e-01f,9.942255664e-01f,1.073104056e-01f,9.981727603e-01f,6.042466843e-02f,9.994220556e-01f,3.399345156e-02f,9.998172259e-01f,1.911843869e-02f,9.999422006e-01f,1.075153665e-02f,9.999817221e-01f,6.046113043e-03f,
-9.036922051e-01f,-4.281826695e-01f,6.731102676e-01f,7.395421338e-01f,7.233466718e-02f,-9.973804169e-01f,9.982477619e-01f,-5.917267879e-02f,-9.364566873e-01f,-3.507832277e-01f,-3.870206816e-01f,9.220710342e-01f,4.475280652e-01f,8.942698871e-01f,8.124829236e-01f,5.829849902e-01f,9.393727149e-01f,3.428978019e-01f,9.806934936e-01f,1.955511994e-01f,9.938812503e-01f,1.104538832e-01f,9.980637300e-01f,6.219960483e-02f,9.993875625e-01f,3.499285475e-02f,9.998063168e-01f,1.968067474e-02f,9.999387506e-01f,1.106774562e-02f,9.999806311e-01f,6.223937825e-03f,
-1.279636896e-01f,-9.917788534e-01f,1.751565337e-01f,9.845405978e-01f,3.789161719e-01f,-9.254309994e-01f,9.929728258e-01f,1.183425843e-01f,-8.967583530e-01f,-4.425205716e-01f,-4.382335472e-01f,8.988611451e-01f,4.190297442e-01f,9.079725070e-01f,8.019878986e-01f,5.973402803e-01f,9.358968291e-01f,3.522742188e-01f,9.795783277e-01f,2.010629250e-01f,9.935269954e-01f,1.135962562e-01f,9.979515440e-01f,6.397433710e-02f,9.993520699e-01f,3.599222668e-02f,9.997950914e-01f,2.024290457e-02f,9.999352007e-01f,1.138395348e-02f,9.999795085e-01f,6.401761945e-03f,
7.654140519e-01f,-6.435381334e-01f,-3.767422893e-01f,9.263181135e-01f,6.479216888e-01f,-7.617069550e-01f,9.563800296e-01f,2.921253822e-01f,-8.481000064e-01f,-5.298361813e-01f,-4.880608524e-01f,8.728096037e-01f,3.901124287e-01f,9.207672306e-01f,7.912392691e-01f,6.115066795e-01f,9.323273439e-01f,3.616154364e-01f,9.784321880e-01f,2.065682779e-01f,9.931628052e-01f,1.167374932e-01f,9.978362017e-01f,6.574887451e-02f,9.993155781e-01f,3.699155889e-02f,9.997835499e-01f,2.080512613e-02f,9.999315508e-01f,1.170016020e-02f,9.999783543e-01f,6.579586328e-03f,
9.550736440e-01f,2.963685787e-01f,-8.126112051e-01f,5.828061679e-01f,8.526731157e-01f,-5.224447891e-01f,8.896234916e-01f,4.566946935e-01f,-7.909677411e-01f,-6.118578532e-01f,-5.363451811e-01f,8.439987244e-01f,3.608050334e-01f,9.326412643e-01f,7.802404339e-01f,6.254797082e-01f,9.286646373e-01f,3.709204650e-01f,9.772551046e-01f,2.120671131e-01f,9.927886843e-01f,1.198775555e-01f,9.977177040e-01f,6.752320399e-02f,9.992780868e-01f,3.799085783e-02f,9.997716923e-01f,2.136734297e-02f,9.999278009e-01f,1.201636575e-02f,9.999771684e-01f,6.757410504e-03f,
2.666429324e-01f,9.637953863e-01f,-9.982103598e-01f,5.980031485e-02f,9.728653499e-01f,-2.313720187e-01f,7.948083899e-01f,6.068604645e-01f,-7.259322386e-01f,-6.877662284e-01f,-5.829338849e-01f,8.125195911e-01f,3.311368634e-01f,9.435827349e-01f,7.689949093e-01f,6.392549018e-01f,9.249090653e-01f,3.801884019e-01f,9.760471178e-01f,2.175592422e-01f,9.924046346e-01f,1.230164264e-01f,9.975960518e-01f,6.929731252e-02f,9.992395964e-01f,3.899011506e-02f,9.997595184e-01f,2.192955306e-02f,9.999239510e-01f,1.233257010e-02f,9.999759510e-01f,6.935234000e-03f,
-6.669380617e-01f,7.451131605e-01f,-8.763794418e-01f,-4.816212973e-01f,9.965789837e-01f,8.264580634e-02f,6.749256518e-01f,7.378857395e-01f,-6.536436209e-01f,-7.568024953e-01f,-6.276796763e-01f,7.784717233e-01f,3.011375844e-01f,9.535807020e-01f,7.575061759e-01f,6.528279969e-01f,9.210610033e-01f,3.894183203e-01f,9.748082657e-01f,2.230444915e-01f,9.920106618e-01f,1.261540598e-01f,9.974712443e-01f,7.107120934e-02f,9.992001065e-01f,3.998933702e-02f,9.997470285e-01f,2.249175622e-02f,9.999200011e-01f,1.264877321e-02f,9.999747019e-01f,7.113057742e-03f,
-9.873392775e-01f,-1.586226688e-01f,-4.846393970e-01f,-8.747140418e-01f,9.214623472e-01f,3.884676855e-01f,5.337561004e-01f,8.456384720e-01f,-5.748240246e-01f,-8.182770562e-01f,-6.704410942e-01f,7.419627614e-01f,2.708370782e-01f,9.626252007e-01f,7.457779040e-01f,6.661946547e-01f,9.171208242e-01f,3.986093247e-01f,9.735385875e-01f,2.285226875e-01f,9.916067680e-01f,1.292904390e-01f,9.973432826e-01f,7.284488142e-02f,9.991596177e-01f,4.098851526e-02f,9.997342224e-01f,2.305395040e-02f,9.999159512e-01f,1.296497506e-02f,9.999734212e-01f,7.290880793e-03f,
-3.999853150e-01f,-9.165215479e-01f,5.636094028e-02f,-9.984104589e-01f,7.549653475e-01f,6.557646866e-01f,3.757521519e-01f,9.267201953e-01f,-4.902605720e-01f,-8.715759127e-01f,-7.110829506e-01f,7.031081264e-01f,2.402658714e-01f,9.707071191e-01f,7.338138022e-01f,6.793506485e-01f,9.130889457e-01f,4.077604411e-01f,9.722381233e-01f,2.339936570e-01f,9.911929581e-01f,1.324255253e-01f,9.972121675e-01f,7.461831571e-02f,9.991181295e-01f,4.198765625e-02f,9.997211001e-01f,2.361613915e-02f,9.999118013e-01f,1.328117562e-02f,9.999721088e-01f,7.468704080e-03f,
5.551133015e-01f,-8.317747426e-01f,5.800031129e-01f,-8.146142578e-01f,5.135984179e-01f,8.580306901e-01f,2.058971709e-01f,9.785736329e-01f,-4.007989973e-01f,-9.161660132e-01f,-7.494767587e-01f,6.620306550e-01f,2.094544189e-01f,9.778184118e-01f,7.216176540e-01f,6.922918182e-01f,9.089657591e-01f,4.168707818e-01f,9.709069144e-01f,2.394572270e-01f,9.907692363e-01f,1.355592873e-01f,9.970778984e-01f,7.639152146e-02f,9.990756424e-01f,4.298675152e-02f,9.997076617e-01f,2.417832043e-02f,9.999075514e-01f,1.359737484e-02f,9.999707649e-01f,7.646527131e-03f,
9.998433086e-01f,1.770192511e-02f,9.250146691e-01f,-3.799313911e-01f,2.212981743e-01f,9.752061926e-01f,2.954782069e-02f,9.995633678e-01f,-3.073327792e-01f,-9.516021032e-01f,-7.855011387e-01f,6.188602113e-01f,1.784335295e-01f,9.839519681e-01f,7.091933579e-01f,7.050140291e-01f,9.047516642e-01f,4.259394629e-01f,9.695450064e-01f,2.449132102e-01f,9.903356068e-01f,1.386916938e-01f,9.969404762e-01f,7.816448565e-02f,9.990321560e-01f,4.398580752e-02f,9.996939072e-01f,2.474049220e-02f,9.999032016e-01f,1.391357271e-02f,9.999693893e-01f,7.824349474e-03f,
5.253219888e-01f,8.509035245e-01f,9.851382016e-01f,1.717635693e-01f,-9.294810554e-02f,9.956709545e-01f,-1.477329862e-01f,9.890272821e-01f,-2.107957994e-01f,-9.775301177e-01f,-8.190422014e-01f,5.737332763e-01f,1.472342216e-01f,9.891016550e-01f,6.965447594e-01f,7.175133435e-01f,9.004471075e-01f,4.349655234e-01f,9.681524315e-01f,2.503614776e-01f,9.898920739e-01f,1.418227133e-01f,9.967999021e-01f,7.993719522e-02f,9.989876708e-01f,4.498481582e-02f,9.996798365e-01f,2.530265802e-02f,9.998987517e-01f,1.422976918e-02f,9.999679821e-01f,8.002171569e-03f,
-4.321779449e-01f,9.017883476e-01f,7.418580135e-01f,6.705569982e-01f,-3.979767653e-01f,9.173954950e-01f,-3.203543695e-01f,9.472977768e-01f,-1.121526217e-01f,-9.936909929e-01f,-8.499939088e-01f,5.267925161e-01f,1.158876918e-01f,9.932623233e-01f,6.836758997e-01f,7.297857660e-01f,8.960525071e-01f,4.439480877e-01f,9.667292484e-01f,2.558017989e-01f,9.894386421e-01f,1.449523146e-01f,9.966561752e-01f,8.170965944e-02f,9.989421864e-01f,4.598378286e-02f,9.996654497e-01f,2.586481583e-02f,9.998942019e-01f,1.454596424e-02f,9.999665433e-01f,8.179994343e-03f,
-9.923354692e-01f,1.235731227e-01f,2.700984580e-01f,9.628327077e-01f,-6.635382560e-01f,7.481423547e-01f,-4.828719382e-01f,8.756909793e-01f,-1.238837738e-02f,-9.999232611e-01f,-8.782584087e-01f,4.781863313e-01f,8.442528403e-02f,9.964298126e-01f,6.705908480e-01f,7.418274156e-01f,8.915682887e-01f,4.528862843e-01f,9.652754871e-01f,2.612340599e-01f,9.889753181e-01f,1.480804517e-01f,9.965092972e-01f,8.348185785e-02f,9.988957032e-01f,4.698270019e-02f,9.996507468e-01f,2.642696360e-02f,9.998895520e-01f,1.486215783e-02f,9.999650728e-01f,8.357815927e-03f,
-6.401443395e-01f,-7.682546613e-01f,-2.848466063e-01f,9.585731119e-01f,-8.632964878e-01f,5.046971113e-01f,-6.301599705e-01f,7.764653318e-01f,8.749917344e-02f,-9.961645921e-01f,-9.037463447e-01f,4.280683876e-01f,5.287845807e-02f,9.986009557e-01f,6.572937422e-01f,7.536344847e-01f,8.869949277e-01f,4.617791660e-01f,9.637912089e-01f,2.666580313e-01f,9.885021022e-01f,1.512071226e-01f,9.963592674e-01f,8.525379969e-02f,9.988482211e-01f,4.798157054e-02f,9.996357278e-01f,2.698910488e-02f,9.998848022e-01f,1.517834901e-02f,9.999635708e-01f,8.535637247e-03f,
3.005925437e-01f,-9.537526528e-01f,-7.520639951e-01f,6.590900905e-01f,-9.774427254e-01f,2.112006594e-01f,-7.575730765e-01f,6.527503610e-01f,1.865124631e-01f,-9.824525948e-01f,-9.263771379e-01f,3.765971301e-01f,2.127875808e-02f,9.997735816e-01f,6.437888326e-01f,7.652032012e-01f,8.823328681e-01f,4.706258703e-01f,9.622764532e-01f,2.720735702e-01f,9.880190013e-01f,1.543322815e-01f,9.962060867e-01f,8.702547193e-02f,9.987997401e-01f,4.898039663e-02f,9.996203926e-01f,2.755123762e-02f,9.998799524e-01f,1.549453961e-02f,9.999620371e-01f,8.713459228e-03f,
9.649660285e-01f,-2.623748537e-01f,-9.876590838e-01f,1.566190737e-01f,-9.946564265e-01f,-1.032404628e-01f,-8.610927113e-01f,5.084479743e-01f,2.836621855e-01f,-9.589242747e-01f,-9.460792425e-01f,3.239352821e-01f,-1.034221888e-02f,9.999465178e-01f,6.300802992e-01f,7.765299843e-01f,8.775825619e-01f,4.794255386e-01f,9.607312596e-01f,2.774805341e-01f,9.875260201e-01f,1.574558971e-01f,9.960497565e-01f,8.879686156e-02f,9.987502604e-01f,4.997917001e-02f,9.996047414e-01f,2.811335979e-02f,9.998750026e-01f,1.581072865e-02f,9.999604718e-01f,8.891280002e-03f,
7.421541968e-01f,6.702291758e-01f,-9.190735378e-01f,-3.940860720e-01f,-9.132301279e-01f,-4.074441477e-01f,-9.374542500e-01f,3.481085020e-01f,3.779776544e-01f,-9.258147184e-01f,-9.627903713e-01f,2.702493312e-01f,-4.195285448e-02f,9.991195914e-01f,6.161725219e-01f,7.876112133e-01f,8.727445123e-01f,4.881772386e-01f,9.591556934e-01f,2.828786946e-01f,9.870231637e-01f,1.605779382e-01f,9.958902758e-01f,9.056797780e-02f,9.986997817e-01f,5.097789714e-02f,9.995887740e-01f,2.867547492e-02f,9.998699528e-01f,1.612691704e-02f,9.999588749e-01f,9.069100495e-03f,
-1.629907808e-01f,9.866275920e-01f,-5.674300293e-01f,-8.234216185e-01f,-7.412399645e-01f,-6.712401321e-01f,-9.842484715e-01f,1.767906850e-01f,4.685169241e-01f,-8.834545217e-01f,-9.764576931e-01f,2.157090023e-01f,-7.352154075e-02f,9.972936293e-01f,6.020698986e-01f,7.984433839e-01f,8.678191892e-01f,4.968801213e-01f,9.575497876e-01f,2.882679384e-01f,9.865104371e-01f,1.636983734e-01f,9.957276465e-01f,9.233880022e-02f,9.986483046e-01f,5.197656957e-02f,9.995724905e-01f,2.923758099e-02f,9.998648031e-01f,1.644310196e-02f,9.999572463e-01f,9.246920701e-03f,
-9.182827862e-01f,3.959251502e-01f,-4.102818995e-02f,-9.991579893e-01f,-4.957418213e-01f,-8.684699457e-01f,-9.999999947e-01f,-1.030206758e-04f,5.543744949e-01f,-8.322673365e-01f,-9.870379993e-01f,1.604867217e-01f,-1.050167117e-01f,9.944704572e-01f,5.877769370e-01f,8.090230357e-01f,8.628070850e-01f,5.055333165e-01f,9.559136100e-01f,2.936480378e-01f,9.859878454e-01f,1.668171717e-01f,9.955618677e-01f,9.410933806e-02f,9.985958286e-01f,5.297519375e-02f,9.995558910e-01f,2.979967596e-02f,9.998595533e-01f,1.675928710e-02f,9.999555861e-01f,9.424741546e-03f,
-8.293098329e-01f,-5.587890489e-01f,4.980096003e-01f,-8.671715159e-01f,-2.010796199e-01f,-9.795749009e-01f,-9.842120244e-01f,-1.769934771e-01f,6.346929496e-01f,-7.727644270e-01f,-9.944978661e-01f,1.047568344e-01f,-1.364068747e-01f,9.906528981e-01f,5.732980611e-01f,8.193468943e-01f,8.577087010e-01f,5.141359589e-01f,9.542471952e-01f,2.990188798e-01f,9.854553963e-01f,1.699342871e-01f,9.953929407e-01f,9.587957830e-02f,9.985423542e-01f,5.397376122e-02f,9.995389754e-01f,3.036176336e-02f,9.998542036e-01f,1.707546870e-02f,9.999538943e-01f,9.602561162e-03f,
2.212675626e-02f,-9.997551734e-01f,8.836693140e-01f,-4.681116785e-01f,1.135217773e-01f,-9.935355082e-01f,-9.373825054e-01f,-3.483016489e-01f,7.086697743e-01f,-7.055403256e-01f,-9.988136461e-01f,4.869599955e-02f,-1.676606422e-01f,9.858447692e-01f,5.586378969e-01f,8.294116591e-01f,8.525245158e-01f,5.226872391e-01f,9.525506134e-01f,3.043802375e-01f,9.849130902e-01f,1.730497178e-01f,9.952208667e-01f,9.764950793e-02f,9.984878810e-01f,5.497227845e-02f,9.995217437e-01f,3.092384116e-02f,9.998487538e-01f,1.739165045e-02f,9.999521709e-01f,9.780380474e-03f,
8.532201077e-01f,-5.215510021e-01f,9.971746360e-01f,7.511820869e-02f,4.168670742e-01f,-9.089674595e-01f,-8.609884168e-01f,-5.086245631e-01f,7.755658183e-01f,-6.312667118e-01f,-9.999717335e-01f,-7.518784889e-03f,-1.987468801e-01f,9.800508546e-01f,5.438010803e-01f,8.392141473e-01f,8.472551097e-01f,5.311861999e-01f,9.508239095e-01f,3.097319700e-01f,9.843609349e-01f,1.761634181e-01f,9.950456449e-01f,9.941913618e-02f,9.984324096e-01f,5.597073698e-02f,9.995041959e-01f,3.148590732e-02f,9.998432041e-01f,1.770782860e-02f,9.999504159e-01f,9.958200408e-03f,
8.998668270e-01f,4.361647552e-01f,8.035690866e-01f,5.952114944e-01f,6.788702112e-01f,-7.342582900e-01f,-7.574391895e-01f,-6.529057162e-01f,8.347129424e-01f,-5.506853038e-01f,-9.979684672e-01f,-6.370979912e-02f,-2.296342702e-01f,9.732769914e-01f,5.287923029e-01f,8.487512594e-01f,8.419009790e-01f,5.396320427e-01f,9.490671287e-01f,3.150739362e-01f,9.837989360e-01f,1.792753567e-01f,9.948672764e-01f,1.011884500e-01f,9.983759396e-01f,5.696914326e-02f,9.994863320e-01f,3.204796724e-02f,9.998375544e-01f,1.802400685e-02f,9.999486292e-01f,1.013601910e-02f,
1.191801354e-01f,9.928726481e-01f,3.624766664e-01f,9.319928467e-01f,8.735505105e-01f,-4.867335058e-01f,-6.300007138e-01f,-7.765945536e-01f,8.855196056e-01f,-4.646020105e-01f,-9.928101803e-01f,-1.196993984e-01f,-2.602920453e-01f,9.655299328e-01f,5.136163109e-01f,8.580199795e-01f,8.364626591e-01f,5.480239228e-01f,9.472803452e-01f,3.204059106e-01f,9.832270991e-01f,1.823855026e-01f,9.946857626e-01f,1.029574365e-01f,9.983184713e-01f,5.796748886e-02f,9.994681521e-01f,3.261001331e-02f,9.998318047e-01f,1.834018143e-02f,9.999468110e-01f,1.031383746e-02f,
-7.710802230e-01f,6.367380071e-01f,-1.902490958e-01f,9.817358512e-01f,9.816020978e-01f,-1.909380047e-01f,-4.826923346e-01f,-8.757899920e-01f,9.274784664e-01f,-3.738765764e-01f,-9.845131804e-01f,-1.753105749e-01f,-2.906895502e-01f,9.568174253e-01f,4.982779032e-01f,8.670173765e-01f,8.309406937e-01f,5.563610011e-01f,9.454635966e-01f,3.257277812e-01f,9.826454300e-01f,1.854938246e-01f,9.945011026e-01f,1.047261048e-01f,9.982600046e-01f,5.896578020e-02f,9.994496561e-01f,3.317204907e-02f,9.998259550e-01f,1.865635603e-02f,9.999449611e-01f,1.049165644e-02f,
-9.524129804e-01f,-3.048106211e-01f,-6.843819158e-01f,7.291237161e-01f,9.923083195e-01f,1.237909494e-01f,-3.201591802e-01f,-9.473637630e-01f,9.601702867e-01f,-2.794154982e-01f,-9.731036980e-01f,-2.303675170e-01f,-3.207963899e-01f,9.471481807e-01f,4.827820346e-01f,8.757405478e-01f,8.253356351e-01f,5.646424439e-01f,9.436169596e-01f,3.310393232e-01f,9.820539344e-01f,1.886002917e-01f,9.943132976e-01f,1.064944419e-01f,9.982005398e-01f,5.996400886e-02f,9.994308440e-01f,3.373407806e-02f,9.998200054e-01f,1.897252691e-02f,9.999430795e-01f,1.066947415e-02f,
-2.581016359e-01f,-9.661177700e-01f,-9.677396624e-01f,2.519522691e-01f,9.046075662e-01f,4.262454119e-01f,-1.475292025e-01f,-9.890577002e-01f,9.832684211e-01f,-1.821625980e-01f,-9.586178037e-01f,-2.846961652e-01f,-3.505824602e-01f,9.365318674e-01f,4.671333972e-01f,8.841868520e-01f,8.196480097e-01f,5.728674718e-01f,9.417404730e-01f,3.363404250e-01f,9.814526211e-01f,1.917048581e-01f,9.941223492e-01f,1.082624348e-01f,9.981400766e-01f,6.096218127e-02f,9.994117160e-01f,3.429609266e-02f,9.998139558e-01f,1.928869776e-02f,9.999411664e-01f,1.084729152e-02f,
6.735071623e-01f,-7.391806966e-01f,-9.530500361e-01f,-3.028128610e-01f,7.271980777e-01f,6.864276770e-01f,2.975377145e-02f,-9.995572585e-01f,9.965421208e-01f,-8.308911770e-02f,-9.411012936e-01f,-3.381247627e-01f,-3.800179774e-01f,9.249791008e-01f,4.513370430e-01f,8.923535586e-01f,8.138784539e-01f,5.810351644e-01f,9.398342161e-01f,3.416308626e-01f,9.808414904e-01f,1.948075221e-01f,9.939282563e-01f,1.100300928e-01f,9.980786154e-01f,6.196028901e-02f,9.993922719e-01f,3.485809641e-02f,9.998078062e-01f,1.960486481e-02f,9.999392216e-01f,1.102510855e-02f,
9.858965816e-01f,1.673557003e-01f,-6.448370157e-01f,-7.643201052e-01f,4.776714527e-01f,8.785385497e-01f,2.060983265e-01f,-9.785312871e-01f,9.998586332e-01f,1.681409119e-02f,-9.206095453e-01f,-3.904843980e-01f,-4.090735085e-01f,9.125014327e-01f,4.353979670e-01f,9.002380853e-01f,8.080275111e-01f,5.891447541e-01f,9.378982288e-01f,3.469105251e-01f,9.802205514e-01f,1.979082381e-01f,9.937310211e-01f,1.117973955e-01f,9.980161562e-01f,6.295833478e-02f,9.993725116e-01f,3.542009286e-02f,9.998015566e-01f,1.992103176e-02f,9.999372453e-01f,1.120292616e-02f
};

#define XB_TMO      128
#define XB_XCNT(j)  (256  + 64 * (j))
#define XB_XSUB(j)  (1280 + 64 * (j))
#define XB_XGEN(j)  (2304 + 64 * (j))
#define XB_TOP      3328
#define XB_TOPGEN   3392
#define XCD_BAR_WORDS 3456
#define XB_SPIN_CAP (1u << 18)

__device__ __forceinline__ unsigned xb_ld(unsigned* p)              { return __hip_atomic_load(p, __ATOMIC_RELAXED, __HIP_MEMORY_SCOPE_AGENT); }
__device__ __forceinline__ unsigned xb_add(unsigned* p, unsigned v) { return __hip_atomic_fetch_add(p, v, __ATOMIC_RELAXED, __HIP_MEMORY_SCOPE_AGENT); }
__device__ __forceinline__ unsigned xb_xcc_id() { return (unsigned)__builtin_amdgcn_s_getreg((3 << 11) | 20) & 0xFu; }
#define XB_SPIN(cond, bar) do { unsigned _sp = 0; while (cond) { __builtin_amdgcn_s_sleep(1); \
    if ((++_sp & 255u) == 0u) { if (xb_ld(&(bar)[XB_TMO])) break; if (_sp > XB_SPIN_CAP) { atomicAdd(&(bar)[XB_TMO], 1u); break; } } } } while (0)

struct XcdBarrier {
    unsigned* bar; unsigned x;
    volatile LAS unsigned* st;
};

__device__ __forceinline__ XcdBarrier xcd_barrier_post(unsigned* bar, volatile LAS unsigned* st) {
    XcdBarrier b; b.bar = bar; b.x = xb_xcc_id(); b.st = st;
    if (threadIdx.x == 0) (void)xb_add(&bar[XB_XCNT(b.x)], 1u);
    return b;
}
__device__ __forceinline__ void xcd_barrier_complete(unsigned* bar, unsigned x, unsigned& nloc, unsigned& nx) {
    const unsigned G = gridDim.x * gridDim.y * gridDim.z;
    unsigned sum, cnt, mine, sp = 0u;
    for (;;) {
        sum = 0u; cnt = 0u; mine = 0u;
#pragma unroll
        for (unsigned j = 0; j < 16; ++j) { const unsigned c = xb_ld(&bar[XB_XCNT(j)]); sum += c; cnt += (c > 0u) ? 1u : 0u; mine = (j == x) ? c : mine; }
        if (sum == G) break;
        __builtin_amdgcn_s_sleep(1);
        if ((++sp & 255u) == 0u) { if (xb_ld(&bar[XB_TMO])) break; if (sp > XB_SPIN_CAP) { atomicAdd(&bar[XB_TMO], 1u); break; } }
    }
    nloc = mine > 0u ? mine : 1u; nx = cnt > 0u ? cnt : 1u;
}

__device__ __forceinline__ void xcd_barrier(const XcdBarrier& b) {
    asm volatile("s_waitcnt vmcnt(0)" ::: "memory");
    __syncthreads();
    if (threadIdx.x == 0) {
        unsigned* bar = b.bar;
        __builtin_amdgcn_s_waitcnt(0);
        unsigned nloc = b.st[0], nx = b.st[1];
        if (nloc == 0u) { xcd_barrier_complete(bar, b.x, nloc, nx); b.st[0] = nloc; b.st[1] = nx; }
        const unsigned old = xb_add(&bar[XB_XSUB(b.x)], 1u);
        const unsigned gen = old / nloc;
        if (old + 1u == (gen + 1u) * nloc) {
            __builtin_amdgcn_fence(__ATOMIC_RELEASE, "agent");
            asm volatile("s_waitcnt vmcnt(0)" ::: "memory");
            const unsigned og = xb_add(&bar[XB_TOP], 1u);
            const unsigned tg = og / nx;
            if (og + 1u == (tg + 1u) * nx) xb_add(&bar[XB_TOPGEN], 1u);
            else XB_SPIN(xb_ld(&bar[XB_TOPGEN]) == tg, bar);
            __builtin_amdgcn_fence(__ATOMIC_ACQUIRE, "agent");
            xb_add(&bar[XB_XGEN(b.x)], 1u);
            asm volatile("s_waitcnt vmcnt(0)" ::: "memory");
        } else {
            XB_SPIN(xb_ld(&bar[XB_XGEN(b.x)]) == gen, bar);
            __builtin_amdgcn_fence(__ATOMIC_ACQUIRE, "agent");
            asm volatile("s_waitcnt vmcnt(0)" ::: "memory");
        }
    }
    __syncthreads();
}

typedef __bf16 bf16x2_t __attribute__((ext_vector_type(2)));
DEVI unsigned pk_bf16(float lo, float hi) {
    f32x2 f = {lo, hi}; bf16x2_t v = __builtin_convertvector(f, bf16x2_t); unsigned r; __builtin_memcpy(&r, &v, 4); return r; }
DEVI float bf_lo(unsigned w) { return __uint_as_float(w << 16); }
DEVI float bf_hi(unsigned w) { return __uint_as_float(w & 0xffff0000u); }
DEVI bf16x8 lds_ld128(lds_t* p) { return *(LAS bf16x8*)p; }
DEVI void lds_st128(lds_t* p, u32x4 v) { *(LAS u32x4*)p = v; }
DEVI int lane_id_fresh() { unsigned z = 0u; asm volatile("" : "+s"(z)); return (int)__builtin_amdgcn_mbcnt_hi(~0u, __builtin_amdgcn_mbcnt_lo(~0u, z)); }
DEVI float wave_sum(float v) {
#pragma unroll
    for (int o = 32; o >= 1; o >>= 1) v += __shfl_xor(v, o);
    return v;
}
DEVI float fexp2(float x) { return __builtin_amdgcn_exp2f(x); }
DEVI float frcp(float x) { return __builtin_amdgcn_rcpf(x); }
DEVI float silu_f(float x) { return x * frcp(1.0f + fexp2(-LOG2E * x)); }
DEVI float gelu_tanh_f(float x) {
    const float t = __builtin_fmaf(x * x, 0.044715f, 1.0f);
    const float e = fexp2((x * t) * (-2.0f * LOG2E * 0.7978845608028654f));
    return x * frcp(1.0f + e);
}
DEVI int cond_of_row(int row) { return row < NPR ? 0 : 1 + ((row - NPR) >> 10); }

struct Params {
    const float *x_prompt, *x_sample, *cache_ckv, *cache_kpe, *cache_k, *cache_v, *c, *c_ctx, *mod_w, *mod_b, *ln_gain, *ln_bias,
        *mla_w_in, *mla_q_gain, *mla_kv_gain, *mla_w_q_up, *mla_w_kv_up, *mla_w_out,
        *gm_w_in, *gm_v_gain, *gm_w_s, *gm_b_s, *gm_w_out, *swa_w_qkv, *swa_sink, *swa_w_out,
        *moe_router, *moe_w_gate, *moe_w_up, *moe_w_down;
    float* out;
    unsigned* bar;
    float *mod, *X0, *X1, *T, *Z, *GST, *AFF, *GATEV;
    bf16_t *H, *H2, *CQ, *CKV, *KPE, *Q, *KN, *VTP, *VTS, *O, *U, *GVT, *TT, *SK, *SVTP, *SVTS, *HID, *YE;
    bf16_t *WTI, *WTQ, *WTKV, *WTO, *WTGI, *WTGO, *WTSQ, *WTSO;
    int *SEL, *IDX;
    long long ph_lo, ph_hi;
};
constexpr size_t OUT_Y = 0;
constexpr size_t OUT_CKV = 8388608;
constexpr size_t OUT_KPE = OUT_CKV + 2097152;
constexpr size_t OUT_SK = OUT_KPE + 524288;
constexpr size_t OUT_SV = OUT_SK + 1048576;

DEVI const float* modp(const Params& p, int layer, int cnd, int which) { return p.mod + ((size_t)(layer * 5 + cnd) * 6 + which) * 1024; }

DEVI int swz(int row) { return ((row >> 1) & 7) ^ ((row >> 4) & 1); }
DEVI int img_off(int row, int chunk) { return row * 128 + ((chunk ^ swz(row)) << 4); }

template <int BM> struct XDma {
    static constexpr int NI = BM / 64;
    const bf16_t* base; unsigned off[NI];
    template <class RowFn> DEVI void init(const RowFn& rowfn, int tid) {
        const int w = tid >> 6, i = tid & 63;
        base = rowfn.base;
#pragma unroll
        for (int j = 0; j < NI; ++j) { const int row = 64 * j + 8 * w + (i >> 3); off[j] = rowfn.offset(row) + (((i & 7) ^ swz(row)) << 3); }
    }
    DEVI void issue(int kt, lds_t* img, int tid) const {
        lds_t* dst = img + (tid >> 6) * 1024 + (tid & 63) * 16;
#pragma unroll
        for (int j = 0; j < NI; ++j) __builtin_amdgcn_global_load_lds((const unsigned*)(base + off[j] + kt * 64), (LAS unsigned*)(dst + j * 8192), 16, 0, 0);
    }
};

struct WRegs {
    f32x4 r[8];
    DEVI void load(const float* p, size_t ldw, int kt) {
        const float* q = p + (size_t)kt * 64 * ldw;
#pragma unroll
        for (int i = 0; i < 8; ++i) r[i] = *(const f32x4*)(q + (size_t)i * ldw);
    }
    DEVI void store(lds_t* img, int wave, int lane) const {
#pragma unroll
        for (int c = 0; c < 4; ++c) {
            u32x4 v;
            v.x = pk_bf16(r[0][c], r[1][c]); v.y = pk_bf16(r[2][c], r[3][c]); v.z = pk_bf16(r[4][c], r[5][c]); v.w = pk_bf16(r[6][c], r[7][c]);
            lds_st128(img + img_off(4 * lane + c, wave), v);
        }
    }
};

template <int BM, bool TRANS>
DEVI void gemm_compute(lds_t* ximg, lds_t* wimg, f32x4 (&acc)[BM / 32][4], int wr, int wc, int lane) {
    constexpr int TM = BM / 32, NH = TM / 4, NSTEP = 2 * NH;
    const int r16 = lane & 15, g = lane >> 4;
    const int c0 = g ^ ((r16 >> 1) & 7);
    lds_t* xb = ximg + (wr * (BM / 2) + r16) * 128;
    lds_t* wb = wimg + (wc * 64 + r16) * 128;
    bf16x8 wf[2][4], xf[2][4];
#define LD_W(buf, s_) do { const int o0_ = ((c0 ^ (4 * (s_))) << 4), o1_ = ((c0 ^ (4 * (s_)) ^ 1) << 4); \
        _Pragma("unroll") for (int nb = 0; nb < 4; ++nb) wf[buf][nb] = lds_ld128(wb + nb * 2048 + ((nb & 1) ? o1_ : o0_)); } while (0)
#define LD_X(buf, s_, h_) do { const int o0_ = ((c0 ^ (4 * (s_))) << 4), o1_ = ((c0 ^ (4 * (s_)) ^ 1) << 4); \
        _Pragma("unroll") for (int m4 = 0; m4 < 4; ++m4) { const int mb_ = 4 * (h_) + m4; xf[buf][m4] = lds_ld128(xb + mb_ * 2048 + ((mb_ & 1) ? o1_ : o0_)); } } while (0)
    LD_W(0, 0); LD_X(0, 0, 0);
#pragma unroll
    for (int st = 0; st < NSTEP; ++st) {
        const int s = st / NH, h = st % NH;
        if (st + 1 < NSTEP) {
            const int s1 = (st + 1) / NH, h1 = (st + 1) % NH;
            if (s1 != s) LD_W(s1 & 1, s1);
            LD_X((st + 1) & 1, s1, h1);
        }
#pragma unroll
        for (int m4 = 0; m4 < 4; ++m4)
#pragma unroll
            for (int nb = 0; nb < 4; ++nb) {
                const int mb = 4 * h + m4;
                acc[mb][nb] = TRANS ? __builtin_amdgcn_mfma_f32_16x16x32_bf16(wf[s & 1][nb], xf[st & 1][m4], acc[mb][nb], 0, 0, 0)
                                    : __builtin_amdgcn_mfma_f32_16x16x32_bf16(xf[st & 1][m4], wf[s & 1][nb], acc[mb][nb], 0, 0, 0);
            }
        __builtin_amdgcn_sched_barrier(0);
    }
#undef LD_W
#undef LD_X
}

struct WLin { const float* base; DEVI const float* operator()(int lane) const { return base + 4 * lane; } };
template <int BM> struct GemmPipe {
    static constexpr int TM = BM / 32, STAGE = (BM + 256) * 128, NI = BM / 64;
    XDma<BM> xd; const float* wp; unsigned ldw; WRegs wr_; int par;
    template <class RowFn, class WFn> DEVI void prime(lds_t* lds, const RowFn& rf, const WFn& wf, unsigned ldw_, int tid_in) {
        const int tid = tid_in;
        const int lane = tid & 63, wave = tid >> 6;
        xd.init(rf, tid); ldw = ldw_; wp = wf(lane) + (size_t)(8 * wave) * ldw_; par = 0;
        wr_.load(wp, ldw, 0);
        __syncthreads();
        xd.issue(0, lds, tid); wr_.store(lds + BM * 128, wave, lane);
        wr_.load(wp, ldw, 1);
    }
    template <bool TRANS, bool XUNIT = true, class Epi, class RowFnN, class WFnN>
    DEVI void run(lds_t* lds, int nk, const Epi& epi, bool has_next_in, const RowFnN& rfn, const WFnN& wfn, unsigned ldw_n, int tid_in) {
        int tid = tid_in; asm volatile("" : "+v"(tid));
        const int lane = tid & 63, wave = tid >> 6, wrow = wave >> 2, wcol = wave & 3;
        const bool has_next = XUNIT && has_next_in;
        f32x4 acc[TM][4];
#pragma unroll
        for (int i = 0; i < TM; ++i)
#pragma unroll
            for (int j = 0; j < 4; ++j) acc[i][j] = (f32x4){0.f, 0.f, 0.f, 0.f};
        unsigned offn[NI];
        if (XUNIT) {
#pragma unroll
            for (int j = 0; j < NI; ++j) offn[j] = 0u;
        }
        for (int t = 0; t < nk; ++t) {
            asm volatile("s_waitcnt vmcnt(0)" ::: "memory");
            __syncthreads();
            lds_t* cur = lds + ((par + t) & 1) * STAGE;
            lds_t* nxt = lds + ((par + t + 1) & 1) * STAGE;
            if (t + 2 < nk) {
                xd.issue(t + 1, nxt, tid); wr_.store(nxt + BM * 128, wave, lane); wr_.load(wp, ldw, t + 2);
            } else if (t + 1 < nk) {
                xd.issue(t + 1, nxt, tid); wr_.store(nxt + BM * 128, wave, lane);
                if (has_next) {
                    ldw = ldw_n; wp = wfn(lane) + (size_t)(8 * wave) * ldw_n; wr_.load(wp, ldw, 0);
#pragma unroll
                    for (int j = 0; j < NI; ++j) { const int row = 64 * j + 8 * wave + (lane >> 3); offn[j] = rfn.offset(row) + (((lane & 7) ^ swz(row)) << 3); }
                }
            } else if (has_next) {
                xd.base = rfn.base;
#pragma unroll
                for (int j = 0; j < NI; ++j) xd.off[j] = offn[j];
                xd.issue(0, nxt, tid); wr_.store(nxt + BM * 128, wave, lane); wr_.load(wp, ldw, 1);
            }
            gemm_compute<BM, TRANS>(cur, cur + BM * 128, acc, wrow, wcol, lane);
        }
        par = (par + nk) & 1;
        { int t2 = tid; asm volatile("" : "+v"(t2));
          const int w2 = t2 >> 6; epi(acc, w2 >> 2, w2 & 3, t2 & 63); }
    }
};

template <int BM, bool TRANS, class RowFn, class WFn, class Epi>
DEVI void gemm_unit(lds_t* lds, const RowFn& rowfn, const WFn& wfn, unsigned ldw, int nk, const Epi& epi, int tid_in) {
    int tid = tid_in; asm volatile("" : "+v"(tid));
    constexpr int TM = BM / 32;
    constexpr int STAGE = (BM + 256) * 128;
    const int lane = tid & 63, wave = tid >> 6, wr = wave >> 2, wc = wave & 3;
    XDma<BM> xd; WRegs wl;
    const float* wp = wfn(lane) + (size_t)(8 * wave) * ldw;
    wl.load(wp, ldw, 0);
    xd.init(rowfn, tid);
    f32x4 acc[TM][4];
#pragma unroll
    for (int i = 0; i < TM; ++i)
#pragma unroll
        for (int j = 0; j < 4; ++j) acc[i][j] = (f32x4){0.f, 0.f, 0.f, 0.f};
    __syncthreads();
    xd.issue(0, lds, tid); wl.store(lds + BM * 128, wave, lane);
    if (nk > 1) wl.load(wp, ldw, 1);
    for (int t = 0; t < nk; ++t) {
        asm volatile("s_waitcnt vmcnt(0)" ::: "memory");
        __syncthreads();
        lds_t* cur = lds + (t & 1) * STAGE;
        lds_t* nxt = lds + ((t + 1) & 1) * STAGE;
        if (t + 1 < nk) {
            xd.issue(t + 1, nxt, tid); wl.store(nxt + BM * 128, wave, lane);
            if (t + 2 < nk) wl.load(wp, ldw, t + 2);
        }
        gemm_compute<BM, TRANS>(cur, cur + BM * 128, acc, wr, wc, lane);
    }
    { int t2 = tid; asm volatile("" : "+v"(t2));
      const int w2 = t2 >> 6; epi(acc, w2 >> 2, w2 & 3, t2 & 63); }
}

template <int BM, bool TRANS, class RowFn, class WRowFn, class Epi>
DEVI void gemm_unit_bb(lds_t* lds, const RowFn& rowfn, const WRowFn& wrowfn, int nk, const Epi& epi, int tid_in) {
    int tid = tid_in; asm volatile("" : "+v"(tid));
    constexpr int TM = BM / 32;
    constexpr int STAGE = (BM + 256) * 128;
    const int lane = tid & 63, wave = tid >> 6, wr = wave >> 2, wc = wave & 3;
    XDma<BM> xd; XDma<256> wd;
    xd.init(rowfn, tid); wd.init(wrowfn, tid);
    f32x4 acc[TM][4];
#pragma unroll
    for (int i = 0; i < TM; ++i)
#pragma unroll
        for (int j = 0; j < 4; ++j) acc[i][j] = (f32x4){0.f, 0.f, 0.f, 0.f};
    __syncthreads();
    xd.issue(0, lds, tid); wd.issue(0, lds + BM * 128, tid);
    for (int t = 0; t < nk; ++t) {
        asm volatile("s_waitcnt vmcnt(0)" ::: "memory");
        __syncthreads();
        lds_t* cur = lds + (t & 1) * STAGE;
        lds_t* nxt = lds + ((t + 1) & 1) * STAGE;
        if (t + 1 < nk) { xd.issue(t + 1, nxt, tid); wd.issue(t + 1, nxt + BM * 128, tid); }
        gemm_compute<BM, TRANS>(cur, cur + BM * 128, acc, wr, wc, lane);
    }
    { int t2 = tid; asm volatile("" : "+v"(t2));
      const int w2 = t2 >> 6; epi(acc, w2 >> 2, w2 & 3, t2 & 63); }
}

template <int BM, bool TRANS, class RowFn, class WRowFn, class Epi>
DEVI void gemm_unit_bb3(lds_t* lds, const RowFn& rowfn, const WRowFn& wrowfn, int nk, const Epi& epi, int tid_in) {
    int tid = tid_in; asm volatile("" : "+v"(tid));
    constexpr int TM = BM / 32;
    constexpr int STAGE = (BM + 256) * 128;
    static_assert(BM == 128, "3 stages fit for BM = 128 only; the counted wait below assumes 2 + 4 DMA instructions per tile");
    const int lane = tid & 63, wave = tid >> 6, wr = wave >> 2, wc = wave & 3;
    XDma<BM> xd; XDma<256> wd;
    xd.init(rowfn, tid); wd.init(wrowfn, tid);
    f32x4 acc[TM][4];
#pragma unroll
    for (int i = 0; i < TM; ++i)
#pragma unroll
        for (int j = 0; j < 4; ++j) acc[i][j] = (f32x4){0.f, 0.f, 0.f, 0.f};
    __syncthreads();
    lds_t* s0 = lds; lds_t* s1 = lds + STAGE; lds_t* s2 = lds + 2 * STAGE;
    xd.issue(0, s0, tid); wd.issue(0, s0 + BM * 128, tid);
    if (nk > 1) { xd.issue(1, s1, tid); wd.issue(1, s1 + BM * 128, tid); }
    for (int t = 0; t < nk; ++t) {
        if (t + 1 < nk) asm volatile("s_waitcnt vmcnt(6)" ::: "memory");
        else asm volatile("s_waitcnt vmcnt(0)" ::: "memory");
        asm volatile("s_waitcnt lgkmcnt(0)" ::: "memory");
        __builtin_amdgcn_s_barrier();
        asm volatile("" ::: "memory");
        if (t + 2 < nk) { xd.issue(t + 2, s2, tid); wd.issue(t + 2, s2 + BM * 128, tid); }
        gemm_compute<BM, TRANS>(s0, s0 + BM * 128, acc, wr, wc, lane);
        lds_t* tmp = s0; s0 = s1; s1 = s2; s2 = tmp;
    }
    __syncthreads();
    { int t2 = tid; asm volatile("" : "+v"(t2));
      const int w2 = t2 >> 6; epi(acc, w2 >> 2, w2 & 3, t2 & 63); }
}

DEVI int swz32(int row) { return ((((row >> 2) ^ (row >> 3)) & 1) << 1) | ((row >> 2) & 1); }
template <int BM> struct XDma32 {
    static constexpr int NI = BM / 128;
    const bf16_t* base; unsigned off[NI];
    template <class RowFn> DEVI void init(const RowFn& rowfn, int tid) {
        const int w = tid >> 6, i = tid & 63;
        base = rowfn.base;
#pragma unroll
        for (int j = 0; j < NI; ++j) { const int row = 128 * j + 16 * w + (i >> 2); off[j] = rowfn.offset(row) + (((i & 3) ^ swz32(row)) << 3); }
    }
    DEVI void issue(int kt32, lds_t* img, int tid) const {
        lds_t* dst = img + (tid >> 6) * 1024 + (tid & 63) * 16;
#pragma unroll
        for (int j = 0; j < NI; ++j) __builtin_amdgcn_global_load_lds((const unsigned*)(base + off[j] + kt32 * 32), (LAS unsigned*)(dst + j * 8192), 16, 0, 0);
    }
};
template <int BM, bool TRANS>
DEVI void gemm_compute32(lds_t* ximg, lds_t* wimg, f32x4 (&acc)[BM / 32][4], int wr, int wc, int lane) {
    constexpr int TM = BM / 32;
    const int r16 = lane & 15, g = lane >> 4;
    const int c0 = (g ^ swz32(r16)) << 4;
    lds_t* xb = ximg + (wr * (BM / 2) + r16) * 64 + c0;
    lds_t* wb = wimg + (wc * 64 + r16) * 64 + c0;
    bf16x8 wf[4], xf[TM];
#pragma unroll
    for (int nb = 0; nb < 4; ++nb) wf[nb] = lds_ld128(wb + nb * 1024);
#pragma unroll
    for (int mb = 0; mb < TM; ++mb) xf[mb] = lds_ld128(xb + mb * 1024);
#pragma unroll
    for (int mb = 0; mb < TM; ++mb)
#pragma unroll
        for (int nb = 0; nb < 4; ++nb)
            acc[mb][nb] = TRANS ? __builtin_amdgcn_mfma_f32_16x16x32_bf16(wf[nb], xf[mb], acc[mb][nb], 0, 0, 0)
                                : __builtin_amdgcn_mfma_f32_16x16x32_bf16(xf[mb], wf[nb], acc[mb][nb], 0, 0, 0);
}
template <int BM, bool TRANS, class RowFn, class WRowFn, class Epi>
DEVI void gemm_unit_bb4(lds_t* lds, const RowFn& rowfn, const WRowFn& wrowfn, int nk2  , const Epi& epi, int tid_in) {
    int tid = tid_in; asm volatile("" : "+v"(tid));
    constexpr int TM = BM / 32;
    constexpr int XB = BM * 64, STAGE = XB + 256 * 64;
    static_assert(BM == 256, "the counted waits below assume 2 + 2 DMA instructions per sub-tile");
    const int lane = tid & 63, wave = tid >> 6, wr = wave >> 2, wc = wave & 3;
    XDma32<BM> xd; XDma32<256> wd;
    xd.init(rowfn, tid); wd.init(wrowfn, tid);
    f32x4 acc[TM][4];
#pragma unroll
    for (int i = 0; i < TM; ++i)
#pragma unroll
        for (int j = 0; j < 4; ++j) acc[i][j] = (f32x4){0.f, 0.f, 0.f, 0.f};
    __syncthreads();
#pragma unroll
    for (int t = 0; t < 3; ++t) if (t < nk2) { xd.issue(t, lds + t * STAGE, tid); wd.issue(t, lds + t * STAGE + XB, tid); }
    for (int t = 0; t < nk2; ++t) {
        const int rem = nk2 - 1 - t;
        if (rem >= 2) asm volatile("s_waitcnt vmcnt(8)" ::: "memory");
        else if (rem == 1) asm volatile("s_waitcnt vmcnt(4)" ::: "memory");
        else asm volatile("s_waitcnt vmcnt(0)" ::: "memory");
        asm volatile("s_waitcnt lgkmcnt(0)" ::: "memory");
        __builtin_amdgcn_s_barrier();
        asm volatile("" ::: "memory");
        if (t + 3 < nk2) { lds_t* st = lds + ((t + 3) & 3) * STAGE; xd.issue(t + 3, st, tid); wd.issue(t + 3, st + XB, tid); }
        lds_t* cur = lds + (t & 3) * STAGE;
        gemm_compute32<BM, TRANS>(cur, cur + XB, acc, wr, wc, lane);
    }
    __syncthreads();
    { int t2 = tid; asm volatile("" : "+v"(t2));
      const int w2 = t2 >> 6; epi(acc, w2 >> 2, w2 & 3, t2 & 63); }
}

namespace pg8 {
constexpr int BM = 256, BK = 64, HALF = 128, HTB = HALF * BK * 2  , STAGE_BYTES = 8 * HTB;
DEVI int lds_byte(int r, int c) { const int st = (r >> 4) * 2 + (c >> 5), rr = r & 15, cc = c & 31, ob = rr * 64 + cc * 2; return st * 1024 + (ob ^ (((ob >> 9) & 1) << 5)); }
DEVI void stage_rc(int b, int& R, int& C) { const int st = b / 1024, sb = b % 1024, swz = sb ^ (((sb >> 9) & 1) << 5); R = (st >> 1) * 16 + swz / 64; C = (st & 1) * 32 + (swz % 64) / 2; }
DEVI int perm32(int rho) { const int n = rho >> 4, i = rho & 15; return 8 * (i >> 2) + 4 * n + (i & 3); }
struct Unit { int pm, pn, aux; };

template <class Epi, class Sched>
DEVI void gemm_phase(lds_t* lds, const int ldk  , const int nt  , const Sched& S, const Epi& E, const int tid,
                      const int hrowsA = HALF, const int hrowsB = HALF  ) {
    const int wid = __builtin_amdgcn_readfirstlane(tid >> 6), lane = tid & 63, wr = wid >> 2, wc = wid & 3, fr = lane & 15, fq = lane >> 4;
    unsigned voffA[2], voffB[2];
#pragma unroll
    for (int i = 0; i < 2; ++i) { int R, C; stage_rc(tid * 16 + i * 8192, R, C); const int Rb = Epi::PERM ? ((R & ~31) + perm32(R & 31)) : R;
        voffA[i] = (unsigned)(R * ldk + C) * 2u; voffB[i] = (unsigned)(Rb * ldk + C) * 2u; }
    const size_t kstep = (size_t)(BK * 2);
    const size_t hstepA = (size_t)hrowsA * ldk * 2, hstepB = (size_t)hrowsB * ldk * 2;
    const unsigned ldsw = (unsigned)wid * 1024u;
    const int aoff = lds_byte(wr * 64 + fr, fq * 8), boff = lds_byte(wc * 32 + fr, fq * 8);
#define PG8_SA(b, h) (((b) * 2 + (h)) * HTB)
#define PG8_SB(b, h) ((4 + (b) * 2 + (h)) * HTB)
#define PG8_STAGE(bufoff, gbase, voff) do { _Pragma("unroll") for (int _i = 0; _i < 2; ++_i) \
        __builtin_amdgcn_global_load_lds((const unsigned*)((const char*)(gbase) + (voff)[_i]), (LAS unsigned*)(lds + (bufoff) + ldsw + _i * 8192), 16, 0, 0); } while (0)
#define PG8_LDA(dst, b, h) do { _Pragma("unroll") for (int m = 0; m < 4; ++m) _Pragma("unroll") for (int k = 0; k < 2; ++k) dst[m][k] = *(const LAS bf16x8*)(lds + PG8_SA(b, h) + aoff + m * 2048 + k * 1024); } while (0)
#define PG8_LDB(dst, b, h) do { _Pragma("unroll") for (int n = 0; n < 2; ++n) _Pragma("unroll") for (int k = 0; k < 2; ++k) dst[n][k] = *(const LAS bf16x8*)(lds + PG8_SB(b, h) + boff + n * 2048 + k * 1024); } while (0)
#define PG8_MMA(ai, bj, At, Bt) do { __builtin_amdgcn_s_setprio(1); _Pragma("unroll") for (int m = 0; m < 4; ++m) _Pragma("unroll") for (int n = 0; n < 2; ++n) _Pragma("unroll") for (int k = 0; k < 2; ++k) \
        acc[ai][bj][m][n] = __builtin_amdgcn_mfma_f32_16x16x32_bf16(Bt[n][k], At[m][k], acc[ai][bj][m][n], 0, 0, 0); __builtin_amdgcn_s_setprio(0); } while (0)
#define PG8_WAIT_V(n) asm volatile("s_waitcnt vmcnt(" #n ")" ::: "memory")
#define PG8_WAIT_L(n) asm volatile("s_waitcnt lgkmcnt(" #n ")" ::: "memory")
#define PG8_BAR __builtin_amdgcn_s_barrier()
#define PG8_SCHED __builtin_amdgcn_sched_barrier(0)
    Unit cur, nxt; int ui = 0;
    __syncthreads();
    if (!S.next(0, cur)) return;
    f32x4 acc[2][2][4][2];
#pragma unroll
    for (int a = 0; a < 2; ++a)
#pragma unroll
        for (int b = 0; b < 2; ++b)
#pragma unroll
            for (int m = 0; m < 4; ++m)
#pragma unroll
                for (int n = 0; n < 2; ++n) acc[a][b][m][n] = (f32x4){0.f, 0.f, 0.f, 0.f};
    bf16x8 At[4][2], B0[2][2], B1[2][2];
    const char* cA; const char* cB;
    S.ptrs(cur, cA, cB);
    PG8_STAGE(PG8_SB(0, 0), cB, voffB); PG8_STAGE(PG8_SA(0, 0), cA, voffA); PG8_STAGE(PG8_SB(0, 1), cB + hstepB, voffB); PG8_STAGE(PG8_SA(0, 1), cA + hstepA, voffA);
    if (wr == 1) PG8_BAR;
    PG8_WAIT_V(4); PG8_BAR;
    PG8_STAGE(PG8_SB(1, 0), cB + kstep, voffB); PG8_STAGE(PG8_SA(1, 0), cA + kstep, voffA); PG8_STAGE(PG8_SB(1, 1), cB + hstepB + kstep, voffB);
    PG8_WAIT_V(6); PG8_BAR;
    for (;;) {
        const bool has_next = S.next(ui + 1, nxt);
        const char* nA = cA; const char* nB = cB;
        if (has_next) S.ptrs(nxt, nA, nB);
        for (int t = 0; t < nt; t += 2) {
            const bool last = (t == nt - 2);
            const char* a1 = cA + (size_t)(t + 1) * kstep;
            const char* a2 = last ? nA : cA + (size_t)(t + 2) * kstep; const char* b2 = last ? nB : cB + (size_t)(t + 2) * kstep;
            const char* a3 = a2 + kstep; const char* b3 = b2 + kstep;
            PG8_LDB(B0, 0, 0); PG8_SCHED; PG8_LDA(At, 0, 0); PG8_STAGE(PG8_SA(1, 1), a1 + hstepA, voffA);
            PG8_WAIT_L(8); PG8_BAR; PG8_WAIT_L(0); PG8_MMA(0, 0, At, B0); PG8_BAR; PG8_SCHED;
            PG8_LDB(B1, 0, 1); PG8_STAGE(PG8_SB(0, 0), b2, voffB);
            PG8_BAR; PG8_WAIT_L(0); PG8_MMA(0, 1, At, B1); PG8_BAR;
            PG8_LDA(At, 0, 1); PG8_STAGE(PG8_SA(0, 0), a2, voffA);
            PG8_BAR; PG8_WAIT_L(0); PG8_MMA(1, 0, At, B0); PG8_BAR; PG8_SCHED;
            PG8_STAGE(PG8_SB(0, 1), b2 + hstepB, voffB);
            PG8_WAIT_V(6); PG8_BAR; PG8_MMA(1, 1, At, B1); PG8_BAR;
            PG8_LDB(B0, 1, 0); PG8_SCHED; PG8_LDA(At, 1, 0); PG8_STAGE(PG8_SA(0, 1), a2 + hstepA, voffA);
            PG8_WAIT_L(8); PG8_BAR; PG8_WAIT_L(0); PG8_MMA(0, 0, At, B0); PG8_BAR; PG8_SCHED;
            PG8_LDB(B1, 1, 1); PG8_STAGE(PG8_SB(1, 0), b3, voffB);
            PG8_BAR; PG8_WAIT_L(0); PG8_MMA(0, 1, At, B1); PG8_BAR;
            PG8_LDA(At, 1, 1); PG8_STAGE(PG8_SA(1, 0), a3, voffA);
            PG8_BAR; PG8_WAIT_L(0); PG8_MMA(1, 0, At, B0); PG8_BAR; PG8_SCHED;
            PG8_STAGE(PG8_SB(1, 1), b3 + hstepB, voffB);
            PG8_WAIT_V(6); PG8_BAR; PG8_MMA(1, 1, At, B1); PG8_BAR;
        }
        { const int ln = lane_id_fresh(); E(acc, cur, wr, wc, ln & 15, ln >> 4); }
        if (!has_next) break;
#pragma unroll
        for (int a = 0; a < 2; ++a)
#pragma unroll
            for (int b = 0; b < 2; ++b)
#pragma unroll
                for (int m = 0; m < 4; ++m)
#pragma unroll
                    for (int n = 0; n < 2; ++n) acc[a][b][m][n] = (f32x4){0.f, 0.f, 0.f, 0.f};
        cur = nxt; cA = nA; cB = nB; ++ui;
    }
    PG8_WAIT_V(0);
    if (wr == 0) PG8_BAR;
    PG8_BAR;
#undef PG8_SA
#undef PG8_SB
#undef PG8_STAGE
#undef PG8_LDA
#undef PG8_LDB
#undef PG8_MMA
#undef PG8_WAIT_V
#undef PG8_WAIT_L
#undef PG8_BAR
#undef PG8_SCHED
}
}

DEVI void phase_modulation(const Params& p, lds_t* lds, int bid, int nblk, int tid) {
    LAS float* sc = (LAS float*)lds;
    LAS float* red = (LAS float*)(lds + 20480);
    __syncthreads();
    for (int i = tid; i < 5 * 1024; i += NTHREADS) {
        const int cnd = i >> 10, k = i & 1023;
        const float v = cnd == 0 ? p.c_ctx[k] : p.c[(cnd - 1) * 1024 + k];
        sc[i] = silu_f(v);
    }
    __syncthreads();
    const int cg = tid & 31, kg = tid >> 5;
    for (int u = bid; u < DEPTH * 48; u += nblk) {
        const int l = u / 48, n0 = (u % 48) * 128;
        const float* w = p.mod_w + (size_t)l * 1024 * 6144 + n0 + 4 * cg;
        f32x4 a[5];
#pragma unroll
        for (int c = 0; c < 5; ++c) a[c] = (f32x4){0.f, 0.f, 0.f, 0.f};
#pragma unroll 8
        for (int kk = 0; kk < 64; ++kk) {
            const int k = kg * 64 + kk;
            const f32x4 wv = *(const f32x4*)(w + (size_t)k * 6144);
#pragma unroll
            for (int c = 0; c < 5; ++c) a[c] += wv * sc[c * 1024 + k];
        }
#pragma unroll
        for (int c = 0; c < 5; ++c) *(LAS f32x4*)(red + (kg * 5 + c) * 128 + 4 * cg) = a[c];
        __syncthreads();
        for (int i = tid; i < 5 * 128; i += NTHREADS) {
            const int c = i >> 7, n = i & 127;
            float s = 0.f;
#pragma unroll
            for (int q = 0; q < 16; ++q) s += red[(q * 5 + c) * 128 + n];
            p.mod[(size_t)(l * 5 + c) * 6144 + n0 + n] = s + p.mod_b[l * 6144 + n0 + n];
        }
        __syncthreads();
    }
}


struct WcTile { const float* src; bf16_t* dst; int ldn, ldk; };
DEVI WcTile wconv_decode(const Params& p, int it) {
    int r = it; const float* W; bf16_t* Wt; int K, N;
    if (r < 352) { const int j = r / 176; r %= 176; W = p.mla_w_in + (size_t)j * 1024 * 704; Wt = p.WTI + (size_t)j * 704 * 1024; K = 1024; N = 704; }
    else if ((r -= 352) < 288) { const int j = r / 144; r %= 144; W = p.mla_w_q_up + (size_t)j * 384 * 1536; Wt = p.WTQ + (size_t)j * 1536 * 384; K = 384; N = 1536; }
    else if ((r -= 288) < 256) { const int j = r / 128; r %= 128; W = p.mla_w_kv_up + (size_t)j * 256 * 2048; Wt = p.WTKV + (size_t)j * 2048 * 256; K = 256; N = 2048; }
    else if ((r -= 256) < 512) { const int j = r / 256; r %= 256; W = p.mla_w_out + (size_t)j * 1024 * 1024; Wt = p.WTO + (size_t)j * 1024 * 1024; K = 1024; N = 1024; }
    else if ((r -= 512) < 1536) { W = p.gm_w_in; Wt = p.WTGI; K = 1024; N = 6144; }
    else if ((r -= 1536) < 768) { W = p.gm_w_out; Wt = p.WTGO; K = 3072; N = 1024; }
    else if ((r -= 768) < 384) { W = p.swa_w_qkv; Wt = p.WTSQ; K = 1024; N = 1536; }
    else { r -= 384; W = p.swa_w_out; Wt = p.WTSO; K = 1024; N = 1024; }
    const int ntn = N / 64, tk = r / ntn, tn = r % ntn;
    WcTile t; t.src = W + (size_t)(tk * 64) * N + tn * 64; t.dst = Wt + (size_t)(tn * 64) * K + tk * 64; t.ldn = N; t.ldk = K;
    return t;
}
DEVI int wconv_stage_tiles(int st) { return st == 0 ? 704 : st == 1 ? 2304 : st == 2 ? 640 : 704; }
DEVI int wconv_stage_tile(int st, int i) {
    if (st == 1) return 1408 + i;
    if (st == 2) return 3712 + i;
    const int j = st == 0 ? 0 : 1;
    if (i < 176) return j * 176 + i;
    if (i < 320) return 352 + j * 144 + (i - 176);
    if (i < 448) return 640 + j * 128 + (i - 320);
    return 896 + j * 256 + (i - 448);
}
DEVI void phase_wconv(const Params& p, int st, lds_t* lds, int rank, int nrank, int tid) {
    const int k0 = tid >> 4, n4 = (tid & 15) * 4;
    const int ntile = wconv_stage_tiles(st), nblk = nrank;
    int it = rank;
#define WC_LOAD(T, A, B, idx) do { T = wconv_decode(p, wconv_stage_tile(st, (idx))); A = *(const f32x4*)(T.src + (size_t)k0 * T.ldn + n4); B = *(const f32x4*)(T.src + (size_t)(k0 + 32) * T.ldn + n4); } while (0)
    WcTile t, t1; f32x4 v0, v1, w0, w1;
    if (it < ntile) WC_LOAD(t, v0, v1, it);
    if (it + nblk < ntile) WC_LOAD(t1, w0, w1, it + nblk);
    __syncthreads();
    int b = 0;
    for (; it < ntile; it += nblk) {
        LAS bf16_t* s = (LAS bf16_t*)(lds + b * 9216);
#pragma unroll
        for (int q = 0; q < 4; ++q) { s[(n4 + q) * 72 + k0] = (bf16_t)(pk_bf16(v0[q], 0.f) & 0xffffu); s[(n4 + q) * 72 + k0 + 32] = (bf16_t)(pk_bf16(v1[q], 0.f) & 0xffffu); }
        const WcTile c = t;
        t = t1; v0 = w0; v1 = w1;
        if (it + 2 * nblk < ntile) WC_LOAD(t1, w0, w1, it + 2 * nblk);
        __syncthreads();
        { const int n = tid >> 3, kc = tid & 7;
          const u32x4 v = *(LAS u32x4*)(s + n * 72 + kc * 8);
          *(u32x4*)(c.dst + (size_t)n * c.ldk + kc * 8) = v; }
        b ^= 1;
    }
#undef WC_LOAD
}

DEVI void phase_prep(const Params& p, int bid, int nblk, int tid) {
    const int lane = tid & 63, wave = tid >> 6;
    for (int row = bid * 8 + wave; row < NTOK; row += nblk * 8) {
        const float* src = row < NPR ? p.x_prompt + (size_t)row * D : p.x_sample + (size_t)(row - NPR) * D;
        const int cnd = cond_of_row(row);
        const float* sh = modp(p, 0, cnd, 0); const float* scl = modp(p, 0, cnd, 1);
#pragma unroll
        for (int i = 0; i < 4; ++i) {
            const int col = lane * 4 + 256 * i;
            const f32x4 v = *(const f32x4*)(src + col);
            const f32x4 s = *(const f32x4*)(scl + col), b = *(const f32x4*)(sh + col);
            const f32x4 h = v * (s + 1.0f) + b;
            u32x2 o; o.x = pk_bf16(h[0], h[1]); o.y = pk_bf16(h[2], h[3]);
            *(u32x2*)(p.H + (size_t)row * D + col) = o;
        }
    }
    for (int i = bid * NTHREADS + tid; i < 1024 * 64; i += nblk * NTHREADS) {
        const f32x4 v = *(const f32x4*)(p.cache_k + (size_t)i * 4);
        u32x2 o; o.x = pk_bf16(v[0], v[1]); o.y = pk_bf16(v[2], v[3]);
        *(u32x2*)(p.SK + (size_t)NTOK * 256 + (size_t)i * 4) = o;
    }
    for (int i = bid * NTHREADS + tid; i < 4 * 4 * 64 * 64; i += nblk * NTHREADS) {
        const int kg4 = i & 63, dv = (i >> 6) & 63, kvh = (i >> 12) & 3, b = i >> 14;
        float v[4];
#pragma unroll
        for (int q = 0; q < 4; ++q) v[q] = p.cache_v[((size_t)(b * 256 + kg4 * 4 + q) * 4 + kvh) * 64 + dv];
        u32x2 o; o.x = pk_bf16(v[0], v[1]); o.y = pk_bf16(v[2], v[3]);
        *(u32x2*)(p.SVTS + ((size_t)(b * 4 + kvh) * 64 + dv) * 1280 + kg4 * 4) = o;
    }
}

DEVI void phase_mla_norm(const Params& p, int j, int bid, int nblk, int tid) {
    const int lane = tid & 63, wave = tid >> 6;
    const float* qg = p.mla_q_gain + j * 384; const float* kg = p.mla_kv_gain + j * 256;
    for (int row = bid * 8 + wave; row < NROWS_KV; row += nblk * 8) {
        if (row >= NTOK) {
            const int b = (row - NTOK) >> 8, t = (row - NTOK) & 255;
            const float* ck = p.cache_ckv + ((size_t)(b * 2 + j) * 256 + t) * 256;
            const f32x4 v = *(const f32x4*)(ck + lane * 4);
            u32x2 o; o.x = pk_bf16(v[0], v[1]); o.y = pk_bf16(v[2], v[3]);
            *(u32x2*)(p.CKV + (size_t)row * 256 + lane * 4) = o;
            const float kp = p.cache_kpe[((size_t)(b * 2 + j) * 256 + t) * 64 + lane];
            p.KPE[(size_t)row * 64 + lane] = (bf16_t)(pk_bf16(kp, 0.f) & 0xffffu);
            continue;
        }
        const float* z = p.Z + (size_t)row * 704;
        float q[6]; float ss = 0.f;
#pragma unroll
        for (int i = 0; i < 6; ++i) { q[i] = z[lane + 64 * i]; ss += q[i] * q[i]; }
        ss = wave_sum(ss);
        const float rq = rsqrtf(ss * (1.0f / 384.0f) + EPS_F);
#pragma unroll
        for (int i = 0; i < 6; ++i) p.CQ[(size_t)row * 384 + lane + 64 * i] = (bf16_t)(pk_bf16(q[i] * rq * qg[lane + 64 * i], 0.f) & 0xffffu);
        const f32x4 kv = *(const f32x4*)(z + 384 + lane * 4);
        float s2 = kv[0] * kv[0] + kv[1] * kv[1] + kv[2] * kv[2] + kv[3] * kv[3];
        s2 = wave_sum(s2);
        const float rk = rsqrtf(s2 * (1.0f / 256.0f) + EPS_F);
        const f32x4 gv = *(const f32x4*)(kg + lane * 4);
        const f32x4 kn = kv * rk * gv;
        { u32x2 o; o.x = pk_bf16(kn[0], kn[1]); o.y = pk_bf16(kn[2], kn[3]); *(u32x2*)(p.CKV + (size_t)row * 256 + lane * 4) = o; }
        float kp = z[640 + lane];
        if (row < NPR) {
            const int b = row >> 8, t = row & 255;
            *(f32x4*)(p.out + OUT_CKV + ((size_t)(b * 2 + j) * 256 + t) * 256 + lane * 4) = kn;
            p.out[OUT_KPE + ((size_t)(b * 2 + j) * 256 + t) * 64 + lane] = kp;
        } else {
            const int t = (row - NPR) & 1023;
            const int pos = lane < 32 ? (t >> 6) : (t & 63);
            const float cs = rope_tab[(pos * 16 + (lane & 15)) * 2], sn = rope_tab[(pos * 16 + (lane & 15)) * 2 + 1];
            const float other = __shfl_xor(kp, 16);
            kp = (lane & 16) ? (kp * cs + other * sn) : (kp * cs - other * sn);
        }
        p.KPE[(size_t)row * 64 + lane] = (bf16_t)(pk_bf16(kp, 0.f) & 0xffffu);
    }
}

DEVI void phase_ln_a(const Params& p, int layer, lds_t* lds, int bid, int nblk, int tid) {
    const int lane = tid & 63, wave = tid >> 6;
    LAS float* rt = (LAS float*)lds;
    const float* router = p.moe_router + (size_t)layer * 1024 * 16;
    const bool all_busy = (nblk * 32 <= NTOK);
    bool staged = false;
    if (!all_busy) {
        __syncthreads();
        for (int i = tid; i < 4096; i += NTHREADS) {
            const f32x4 w = *(const f32x4*)(router + i * 4);
            const int k = i >> 2, e0 = (i & 3) * 4;
            rt[(e0 + 0) * 1024 + k] = w[0]; rt[(e0 + 1) * 1024 + k] = w[1]; rt[(e0 + 2) * 1024 + k] = w[2]; rt[(e0 + 3) * 1024 + k] = w[3];
        }
        __syncthreads();
        staged = true;
    }
    const float* lg = p.ln_gain + (layer * 2 + 0) * 1024; const float* lb = p.ln_bias + (layer * 2 + 0) * 1024;
    for (int r0 = (bid * 8 + wave) * 4; r0 < NTOK; r0 += nblk * 32) {
        const int cnd = cond_of_row(r0);
        const float* sh = modp(p, layer, cnd, 3); const float* scl = modp(p, layer, cnd, 4);
        f32x4 v[4][4];
        float mu[4], rs[4];
        f32x4 rw8[8];
        if (!staged) {
#pragma unroll
            for (int q = 0; q < 8; ++q) rw8[q] = *(const f32x4*)(router + (tid + NTHREADS * q) * 4);
        }
        const float* xin = (r0 < NPR ? p.x_prompt : p.x_sample - (size_t)NPR * D);
        const bf16_t* X0b = (const bf16_t*)p.X0;
        const bf16_t* Y0 = (const bf16_t*)p.T; const bf16_t* Y1 = Y0 + (size_t)NTOK * D;
#pragma unroll
        for (int j = 0; j < 4; ++j)
#pragma unroll
            for (int i = 0; i < 4; ++i) {
                const size_t o = (size_t)(r0 + j) * D + lane * 4 + 256 * i;
                const u32x2 ya = *(const u32x2*)(Y0 + o), yb = *(const u32x2*)(Y1 + o);
                f32x4 yv; yv[0] = bf_lo(ya.x) + bf_lo(yb.x); yv[1] = bf_hi(ya.x) + bf_hi(yb.x); yv[2] = bf_lo(ya.y) + bf_lo(yb.y); yv[3] = bf_hi(ya.y) + bf_hi(yb.y);
                f32x4 xr;
                if (layer) { const u32x2 xb = *(const u32x2*)(X0b + o); xr[0] = bf_lo(xb.x); xr[1] = bf_hi(xb.x); xr[2] = bf_lo(xb.y); xr[3] = bf_hi(xb.y); }
                else xr = *(const f32x4*)(xin + o);
                v[j][i] = xr * ALPHA_F + yv;
            }
#pragma unroll
        for (int j = 0; j < 4; ++j) { float s = 0.f;
#pragma unroll
            for (int i = 0; i < 4; ++i) s += (v[j][i][0] + v[j][i][1]) + (v[j][i][2] + v[j][i][3]);
            mu[j] = s; }
#pragma unroll
        for (int j = 0; j < 4; ++j) mu[j] = wave_sum(mu[j]) * (1.0f / 1024.0f);
#pragma unroll
        for (int j = 0; j < 4; ++j) { float q = 0.f;
#pragma unroll
            for (int i = 0; i < 4; ++i) { v[j][i] = v[j][i] - mu[j]; q += (v[j][i][0] * v[j][i][0] + v[j][i][1] * v[j][i][1]) + (v[j][i][2] * v[j][i][2] + v[j][i][3] * v[j][i][3]); }
            rs[j] = q; }
#pragma unroll
        for (int j = 0; j < 4; ++j) rs[j] = rsqrtf(wave_sum(rs[j]) * (1.0f / 1024.0f) + EPS_F);
        if (!staged) {
            __syncthreads();
#pragma unroll
            for (int q = 0; q < 8; ++q) { const int i = tid + NTHREADS * q, k = i >> 2, e0 = (i & 3) * 4;
                rt[(e0 + 0) * 1024 + k] = rw8[q][0]; rt[(e0 + 1) * 1024 + k] = rw8[q][1]; rt[(e0 + 2) * 1024 + k] = rw8[q][2]; rt[(e0 + 3) * 1024 + k] = rw8[q][3]; }
            __syncthreads();
            staged = true;
        }
        float lgt[4][16];
#pragma unroll
        for (int j = 0; j < 4; ++j)
#pragma unroll
            for (int e = 0; e < 16; ++e) lgt[j][e] = 0.f;
#pragma unroll
        for (int i = 0; i < 4; ++i) {
            const int col = lane * 4 + 256 * i;
            const f32x4 g4 = *(const f32x4*)(lg + col), b4 = *(const f32x4*)(lb + col), sc4 = *(const f32x4*)(scl + col) + 1.0f, sh4 = *(const f32x4*)(sh + col);
            f32x4 h[4];
#pragma unroll
            for (int j = 0; j < 4; ++j) {
                const f32x4 x = v[j][i] * rs[j] * g4 + b4;
                { u32x2 xo; xo.x = pk_bf16(x[0], x[1]); xo.y = pk_bf16(x[2], x[3]); *(u32x2*)((bf16_t*)p.X1 + (size_t)(r0 + j) * D + col) = xo; }
                h[j] = x * sc4 + sh4;
                u32x2 o; o.x = pk_bf16(h[j][0], h[j][1]); o.y = pk_bf16(h[j][2], h[j][3]);
                *(u32x2*)(p.H2 + (size_t)(r0 + j) * D + col) = o;
            }
#pragma unroll
            for (int e = 0; e < 16; ++e) {
                const f32x4 rw = *(LAS f32x4*)(rt + e * 1024 + col);
#pragma unroll
                for (int j = 0; j < 4; ++j) lgt[j][e] += (h[j][0] * rw[0] + h[j][1] * rw[1]) + (h[j][2] * rw[2] + h[j][3] * rw[3]);
                if ((e & 3) == 3) __builtin_amdgcn_sched_barrier(0);
            }
        }
        float r1[4];
#pragma unroll
        for (int j = 0; j < 4; ++j) {
            float r8[8], r4[4], r2[2];
            { const bool hi = (lane & 32) != 0;
#pragma unroll
              for (int i = 0; i < 8; ++i) { const float keep = hi ? lgt[j][8 + i] : lgt[j][i], send = hi ? lgt[j][i] : lgt[j][8 + i]; r8[i] = keep + __shfl_xor(send, 32); } }
            { const bool hi = (lane & 16) != 0;
#pragma unroll
              for (int i = 0; i < 4; ++i) { const float keep = hi ? r8[4 + i] : r8[i], send = hi ? r8[i] : r8[4 + i]; r4[i] = keep + __shfl_xor(send, 16); } }
            { const bool hi = (lane & 8) != 0;
#pragma unroll
              for (int i = 0; i < 2; ++i) { const float keep = hi ? r4[2 + i] : r4[i], send = hi ? r4[i] : r4[2 + i]; r2[i] = keep + __shfl_xor(send, 8); } }
            { const bool hi = (lane & 4) != 0; const float keep = hi ? r2[1] : r2[0], send = hi ? r2[0] : r2[1]; r1[j] = keep + __shfl_xor(send, 4); }
        }
        const int e = ((lane >> 5) & 1) * 8 + ((lane >> 4) & 1) * 4 + ((lane >> 3) & 1) * 2 + ((lane >> 2) & 1);
#pragma unroll
        for (int j = 0; j < 4; ++j) {
            float r = r1[j];
            r += __shfl_xor(r, 2); r += __shfl_xor(r, 1);
            float mx = r;
            mx = fmaxf(mx, __shfl_xor(mx, 4)); mx = fmaxf(mx, __shfl_xor(mx, 8)); mx = fmaxf(mx, __shfl_xor(mx, 16)); mx = fmaxf(mx, __shfl_xor(mx, 32));
            const float ex = __expf(r - mx);
            float den = ex;
            den += __shfl_xor(den, 4); den += __shfl_xor(den, 8); den += __shfl_xor(den, 16); den += __shfl_xor(den, 32);
            if ((lane & 3) == 0) p.AFF[(size_t)e * NTOK + r0 + j] = ex / den;
        }
    }
}

DEVI int block_sum_i(int v, LAS int* red, int tid) {
    const int lane = tid & 63, wave = tid >> 6;
    v = __builtin_popcountll(__ballot(v & 1)) + 2 * __builtin_popcountll(__ballot(v & 2)) + 4 * __builtin_popcountll(__ballot(v & 4)) + 8 * __builtin_popcountll(__ballot(v & 8));
    __syncthreads();
    if (lane == 0) red[wave] = v;
    __syncthreads();
    return (red[0] + red[1]) + (red[2] + red[3]) + (red[4] + red[5]) + (red[6] + red[7]);
}
DEVI int block_excl_scan_i(int v, LAS int* red, int tid, int& total) {
    const int lane = tid & 63, wave = tid >> 6;
    int inc = v;
#pragma unroll
    for (int o = 1; o < 64; o <<= 1) { const int t = __shfl_up(inc, o); if (lane >= o) inc += t; }
    __syncthreads();
    if (lane == 63) red[wave] = inc;
    __syncthreads();
    int base = 0, tot = 0;
#pragma unroll
    for (int w = 0; w < 8; ++w) { const int c = red[w]; if (w < wave) base += c; tot += c; }
    total = tot;
    return base + inc - v;
}
DEVI int wave_sum_i(int v) {
#pragma unroll
    for (int o = 32; o > 0; o >>= 1) v += __shfl_xor(v, o);
    return v;
}
DEVI void phase_topk(const Params& p, lds_t* lds, int bid, int nblk, int tid) {
    LAS int* red = (LAS int*)lds;
    const int lane = tid & 63, wave = tid >> 6;
    for (int it = bid; it < 32; it += nblk) {
        const int grp = it >> 4, e = it & 15;
        const float* a = p.AFF + (size_t)e * NTOK + grp * 4096 + tid * 8;
        const f32x4 a0 = *(const f32x4*)a, a1 = *(const f32x4*)(a + 4);
        unsigned key[8];
#pragma unroll
        for (int i = 0; i < 4; ++i) { key[i] = __float_as_uint(a0[i]); key[4 + i] = __float_as_uint(a1[i]); }
        LAS int* cnt = red + 32;
        __syncthreads();
        if (tid < 64) cnt[tid] = 0;
        __syncthreads();
        unsigned thr = 0u;
        for (int lo = 28; lo >= 0; lo -= 2) {
            const unsigned c1 = thr | (1u << lo), c2 = thr | (2u << lo), c3 = thr | (3u << lo);
            int w1 = 0, w2 = 0, w3 = 0;
#pragma unroll
            for (int i = 0; i < 8; ++i) { w1 += __builtin_popcountll(__ballot(key[i] >= c1)); w2 += __builtin_popcountll(__ballot(key[i] >= c2)); w3 += __builtin_popcountll(__ballot(key[i] >= c3)); }
            LAS int* r = cnt + ((30 - lo) >> 1) * 4;
            if (lane == 0) {
                __hip_atomic_fetch_add(r + 0, w1, __ATOMIC_RELAXED, __HIP_MEMORY_SCOPE_WORKGROUP);
                __hip_atomic_fetch_add(r + 1, w2, __ATOMIC_RELAXED, __HIP_MEMORY_SCOPE_WORKGROUP);
                __hip_atomic_fetch_add(r + 2, w3, __ATOMIC_RELAXED, __HIP_MEMORY_SCOPE_WORKGROUP);
            }
            __syncthreads();
            const i32x4 n = *(LAS i32x4*)r;
            thr = n.z >= 512 ? c3 : (n.y >= 512 ? c2 : (n.x >= 512 ? c1 : thr));
        }
        int cgt = 0, ceq = 0;
#pragma unroll
        for (int i = 0; i < 8; ++i) { cgt += key[i] > thr ? 1 : 0; ceq += key[i] == thr ? 1 : 0; }
        int both;
        const int pre = block_excl_scan_i(cgt | (ceq << 16), red + 16, tid, both);
        const int ngt = both & 0xffff;
        int tie_rank = pre >> 16;
        const int need = 512 - ngt;
        int sel[8], cs = 0;
#pragma unroll
        for (int i = 0; i < 8; ++i) {
            const bool eq = key[i] == thr;
            sel[i] = (key[i] > thr || (eq && tie_rank < need)) ? 1 : 0;
            tie_rank += eq ? 1 : 0; cs += sel[i];
        }
        int tot;
        int slot = block_excl_scan_i(cs, red + 24, tid, tot);
        int slv[8];
#pragma unroll
        for (int i = 0; i < 8; ++i) {
            const int t = grp * 4096 + tid * 8 + i;
            int sl = -1;
            if (sel[i]) { sl = grp * 512 + slot; ++slot; p.IDX[e * 1024 + sl] = t; p.GATEV[e * 1024 + sl] = __uint_as_float(key[i]); }
            slv[i] = sl;
        }
        {
            int* dst = p.SEL + (size_t)e * NTOK + grp * 4096 + tid * 8;
            i32x4 s0, s1; s0.x = slv[0]; s0.y = slv[1]; s0.z = slv[2]; s0.w = slv[3]; s1.x = slv[4]; s1.y = slv[5]; s1.z = slv[6]; s1.w = slv[7];
            *(i32x4*)dst = s0; *(i32x4*)(dst + 4) = s1;
        }
    }
}

DEVI void phase_ln_b(const Params& p, int layer, int bid, int nblk, int tid) {
    const int lane = tid & 63, wave = tid >> 6;
    const float* lg = p.ln_gain + (layer * 2 + 1) * 1024; const float* lb = p.ln_bias + (layer * 2 + 1) * 1024;
    const bool last = (layer == DEPTH - 1);
    float* xo = p.out + OUT_Y; bf16_t* X0b = (bf16_t*)p.X0; const bf16_t* X1b = (const bf16_t*)p.X1;
    const int stride = nblk * 8;
    int row = bid * 8 + wave;
    int seln = -1; u32x2 xn[4];
    if (row < NTOK) {
        if (lane < 16) seln = p.SEL[(size_t)lane * NTOK + row];
#pragma unroll
        for (int i = 0; i < 4; ++i) xn[i] = *(const u32x2*)(X1b + (size_t)row * D + lane * 4 + 256 * i);
    }
    for (; row < NTOK; row += stride) {
        const int selv = seln;
        f32x4 v[4];
#pragma unroll
        for (int i = 0; i < 4; ++i) { v[i][0] = bf_lo(xn[i].x); v[i][1] = bf_hi(xn[i].x); v[i][2] = bf_lo(xn[i].y); v[i][3] = bf_hi(xn[i].y); }
        unsigned long long mask = __ballot(selv >= 0);
        f32x4 y[4];
#pragma unroll
        for (int i = 0; i < 4; ++i) y[i] = (f32x4){0.f, 0.f, 0.f, 0.f};
        while (mask) {
            const int e0 = __builtin_ctzll(mask); mask &= mask - 1;
            const int s0 = __builtin_amdgcn_readlane(selv, e0);
            const bf16_t* y0 = p.YE + ((size_t)e0 * 1024 + s0) * 1024 + lane * 4;
            const bool two = mask != 0;
            int e1 = e0, s1 = s0;
            if (two) { e1 = __builtin_ctzll(mask); mask &= mask - 1; s1 = __builtin_amdgcn_readlane(selv, e1); }
            const bf16_t* y1 = p.YE + ((size_t)e1 * 1024 + s1) * 1024 + lane * 4;
            u32x2 w0[4], w1[4];
#pragma unroll
            for (int i = 0; i < 4; ++i) { w0[i] = *(const u32x2*)(y0 + 256 * i); w1[i] = *(const u32x2*)(y1 + 256 * i); }
            const float f1 = two ? 1.0f : 0.0f;
#pragma unroll
            for (int i = 0; i < 4; ++i) {
                y[i][0] += bf_lo(w0[i].x) + f1 * bf_lo(w1[i].x); y[i][1] += bf_hi(w0[i].x) + f1 * bf_hi(w1[i].x);
                y[i][2] += bf_lo(w0[i].y) + f1 * bf_lo(w1[i].y); y[i][3] += bf_hi(w0[i].y) + f1 * bf_hi(w1[i].y);
            }
        }
        if (row + stride < NTOK) {
            seln = -1;
            if (lane < 16) seln = p.SEL[(size_t)lane * NTOK + row + stride];
#pragma unroll
            for (int i = 0; i < 4; ++i) xn[i] = *(const u32x2*)(X1b + (size_t)(row + stride) * D + lane * 4 + 256 * i);
        }
        const int cnd = cond_of_row(row);
        const float* gt = modp(p, layer, cnd, 5);
        float s = 0.f;
#pragma unroll
        for (int i = 0; i < 4; ++i) {
            const int col = lane * 4 + 256 * i;
            v[i] = v[i] * ALPHA_F + *(const f32x4*)(gt + col) * y[i];
            s += (v[i][0] + v[i][1]) + (v[i][2] + v[i][3]);
        }
        s = wave_sum(s);
        const float mu = s * (1.0f / 1024.0f);
        float q = 0.f;
#pragma unroll
        for (int i = 0; i < 4; ++i) { v[i] = v[i] - mu; q += (v[i][0] * v[i][0] + v[i][1] * v[i][1]) + (v[i][2] * v[i][2] + v[i][3] * v[i][3]); }
        q = wave_sum(q);
        const float rs = rsqrtf(q * (1.0f / 1024.0f) + EPS_F);
        const float* sh = modp(p, last ? layer : layer + 1, cnd, 0); const float* scl = modp(p, last ? layer : layer + 1, cnd, 1);
#pragma unroll
        for (int i = 0; i < 4; ++i) {
            const int col = lane * 4 + 256 * i;
            const f32x4 x = v[i] * rs * *(const f32x4*)(lg + col) + *(const f32x4*)(lb + col);
            if (last) *(f32x4*)(xo + (size_t)row * D + col) = x;
            else {
                { u32x2 xb; xb.x = pk_bf16(x[0], x[1]); xb.y = pk_bf16(x[2], x[3]); *(u32x2*)(X0b + (size_t)row * D + col) = xb; }
                const f32x4 h = x * (*(const f32x4*)(scl + col) + 1.0f) + *(const f32x4*)(sh + col);
                u32x2 o; o.x = pk_bf16(h[0], h[1]); o.y = pk_bf16(h[2], h[3]);
                *(u32x2*)(p.H + (size_t)row * D + col) = o;
            }
        }
    }
}

constexpr int GBM = 128;
constexpr int GBM2 = 256;
DEVI int xcd_first_unit(int bid, int nblk) { return (nblk & 7) ? bid : (bid & 7) * (nblk >> 3) + (bid >> 3); }
struct RowLin { const bf16_t* base; unsigned ld; DEVI unsigned offset(int r) const { return (unsigned)r * ld; } };
struct RowGather { const bf16_t* base; const int* idx; DEVI unsigned offset(int r) const { return (unsigned)(idx[r] & 8191) * 1024u; } };
struct RowClamp { const bf16_t* base; unsigned ld; int r0, rmax; DEVI unsigned offset(int r) const { int q = r0 + r; if (q > rmax) q = rmax; return (unsigned)q * ld; } };
struct RowKv { const bf16_t* base; int n0, isv; DEVI unsigned offset(int r) const { const int n = n0 + r; return (unsigned)((n >> 7) * 256 + isv * 128 + (n & 127)) * 256u; } };
struct GDesc { RowLin rf; WLin wl; unsigned ldw; int nk; };
struct WUp { const float* base; int kv; DEVI const float* operator()(int lane) const { return kv ? base + (lane >> 5) * 256 + ((4 * lane) & 127) : base + 4 * lane; } };
struct GDescUp { RowLin rf; WUp wl; unsigned ldw; };
struct WClamp { const float* base; int col0; DEVI const float* operator()(int lane) const { int c = col0 + 4 * lane; if (c > 700) c = 700; return base + c; } };
struct WLinP { const float* base; DEVI const float* operator()(int lane) const { const int r = 4 * lane; return base + 32 * (r >> 5) + 8 * ((r & 15) >> 2) + 4 * ((r >> 4) & 1); } };
struct WMoe { const float* gate; const float* up; size_t off; DEVI const float* operator()(int lane) const { const int r = 4 * lane, sub = r >> 5;
    const unsigned long long ga = (unsigned long long)gate, ua = (unsigned long long)up, mk = 0ull - (unsigned long long)(sub & 1);
    return (const float*)(ga ^ ((ga ^ ua) & mk)) + off + 32 * (sub >> 1) + 8 * ((r & 15) >> 2) + 4 * ((r >> 4) & 1); } };

DEVI void st_bf16x4(bf16_t* dst, f32x4 v) { u32x2 o; o.x = pk_bf16(v[0], v[1]); o.y = pk_bf16(v[2], v[3]); *(u32x2*)dst = o; }

template <int TM> DEVI void rope_tile(f32x4 (&acc)[TM][4], int row0  , int lane) {
    const int r16 = lane & 15, g = lane >> 4;
#pragma unroll
    for (int mb = 0; mb < TM; ++mb) {
        const int t = (row0 + mb * 16 + r16 - NPR) & 1023;
        const int prow = t >> 6, pcol = t & 63;
#pragma unroll
        for (int r = 0; r < 4; ++r) {
            const int f = 4 * g + r;
            const float c1 = rope_tab[(prow * 16 + f) * 2], s1 = rope_tab[(prow * 16 + f) * 2 + 1];
            const float c2 = rope_tab[(pcol * 16 + f) * 2], s2 = rope_tab[(pcol * 16 + f) * 2 + 1];
            const float a1 = acc[mb][0][r], a2 = acc[mb][1][r], b1 = acc[mb][2][r], b2 = acc[mb][3][r];
            acc[mb][0][r] = a1 * c1 - a2 * s1; acc[mb][1][r] = a2 * c1 + a1 * s1;
            acc[mb][2][r] = b1 * c2 - b2 * s2; acc[mb][3][r] = b2 * c2 + b1 * s2;
        }
        __builtin_amdgcn_sched_barrier(0);
    }
}

template <int BM> struct EpiZ { float* Z; int m0, n0;
    DEVI void operator()(const f32x4 (&acc)[BM / 32][4], int wr, int wc, int lane) const {
        const int r16 = lane & 15, g = lane >> 4;
#pragma unroll
        for (int mb = 0; mb < BM / 32; ++mb) { const int row = m0 + wr * (BM / 2) + mb * 16 + r16;
#pragma unroll
            for (int nb = 0; nb < 4; ++nb) { const int col = n0 + wc * 64 + nb * 16 + 4 * g; if (col < 704) *(f32x4*)(Z + (size_t)row * 704 + col) = acc[mb][nb]; } }
    } };
DEVI void phase_mla_win(const Params& p, int j, lds_t* lds, int bid, int nblk, int tid) {
    constexpr int MT = NTOK / GBM, NU = MT * 3;
    for (int u = xcd_first_unit(bid, nblk); u < NU; u += nblk) {
        const int mt = u % MT, nt = u / MT;
        RowLin rf{p.H + (size_t)mt * GBM * 1024, 1024u};
        RowClamp wf{p.WTI + (size_t)j * 704 * 1024, 1024u, nt * 256, 703};
        EpiZ<GBM> epi{p.Z, mt * GBM, nt * 256};
        gemm_unit_bb3<GBM, true>(lds, rf, wf, 16, epi, tid);
    }
}

DEVI int xcd_slot(int v, int nblk, int lo, int cnt, int& G) {
    if (nblk == 256) { G = 1 << 20; const int i = ((v & 31) - lo) & 31; return i < cnt ? (v >> 5) * cnt + i : (1 << 20); }
    G = nblk; return v; }
DEVI int rot_unit(int v, int off, int G) { int r = v - off; if (r < 0) r += G; return r; }
template <int NPM, int NPN, int GM, int GN>
struct SchedGrid { const bf16_t* A; const bf16_t* B; int v0, G; size_t tileA, tileB;
    static_assert(NPM % GM == 0 && NPN % GN == 0, "unit grid");
    DEVI bool next(int i, pg8::Unit& u) const {
        const int L = __builtin_amdgcn_readfirstlane(i * G + v0); if (L >= NPM * NPN) return false;
        constexpr int NGM = NPM / GM;
        const int g = L / (GM * GN), w = L % (GM * GN); u.pm = (g % NGM) * GM + (w % GM); u.pn = (g / NGM) * GN + (w / GM); u.aux = 0; return true; }
    DEVI void ptrs(const pg8::Unit& u, const char*& a, const char*& b) const { a = (const char*)(A + (size_t)u.pm * tileA); b = (const char*)(B + (size_t)u.pn * tileB); }
};
struct EpiMlaQ { static constexpr bool PERM = false; bf16_t* Q; float scale;
    DEVI void operator()(const f32x4 (&acc)[2][2][4][2], const pg8::Unit& u, int wr, int wc, int fr_in, int fq_in) const {
        int ln = fr_in | (fq_in << 4); asm volatile("" : "+v"(ln));
#pragma unroll
        for (int bj = 0; bj < 2; ++bj) {
            const int c0 = u.pn * 256 + bj * 128 + wc * 32;
            const int gi = (c0 % 192) >> 5;
            const bool rope = (u.pm >= 16) && (gi >= 4);
#pragma unroll
            for (int ai = 0; ai < 2; ++ai)
#pragma unroll
                for (int m = 0; m < 4; ++m) { asm volatile("" : "+v"(ln)); const int fr = ln & 15, fq = ln >> 4;
                    const int row = u.pm * 256 + ai * 128 + wr * 64 + m * 16 + fr;
                    f32x4 x1 = acc[ai][bj][m][0], x2 = acc[ai][bj][m][1];
                    if (rope) { const int t = (row - NPR) & 1023, pos = (gi == 4) ? (t >> 6) : (t & 63);
#pragma unroll
                        for (int j = 0; j < 4; ++j) { const f32x2 cs = *(const f32x2*)(rope_tab + (pos * 16 + 4 * fq + j) * 2);
                            const float a = x1[j], b = x2[j]; x1[j] = a * cs.x - b * cs.y; x2[j] = b * cs.x + a * cs.y; } }
                    bf16_t* dst = Q + (size_t)row * 1536 + c0 + 4 * fq;
                    st_bf16x4(dst, x1 * scale); st_bf16x4(dst + 16, x2 * scale);
                    __builtin_amdgcn_sched_barrier(0); }
        }
    } };
struct EpiMlaK { static constexpr bool PERM = true; bf16_t* KN;
    DEVI void operator()(const f32x4 (&acc)[2][2][4][2], const pg8::Unit& u, int wr, int wc, int fr_in, int fq_in) const {
        int ln = fr_in | (fq_in << 4); asm volatile("" : "+v"(ln));
        const int fr = ln & 15, fq = ln >> 4;
#pragma unroll
        for (int ai = 0; ai < 2; ++ai)
#pragma unroll
            for (int m = 0; m < 4; ++m) { const int row = u.pm * 256 + ai * 128 + wr * 64 + m * 16 + fr;
#pragma unroll
                for (int bj = 0; bj < 2; ++bj) { const f32x4 a = acc[ai][bj][m][0], b = acc[ai][bj][m][1];
                    u32x4 w; w.x = pk_bf16(a[0], a[1]); w.y = pk_bf16(a[2], a[3]); w.z = pk_bf16(b[0], b[1]); w.w = pk_bf16(b[2], b[3]);
                    *(u32x4*)(KN + (size_t)row * 1024 + u.pn * 256 + bj * 128 + wc * 32 + 8 * fq) = w; } }
    } };
struct EpiMlaV { static constexpr bool PERM = true; bf16_t* VTP; bf16_t* VTS;
    DEVI void operator()(const f32x4 (&acc)[2][2][4][2], const pg8::Unit& u, int wr, int wc, int fr_in, int fq_in) const {
        int ln = fr_in | (fq_in << 4); asm volatile("" : "+v"(ln));
        const int fr = ln & 15, fq = ln >> 4;
        const int R0 = u.pn * 256;
        bf16_t* base; unsigned ldk;
        if (R0 < NPR) { base = VTP + (size_t)(R0 >> 8) * (8 * 128 * 256); ldk = 256; }
        else if (R0 < NTOK) { base = VTS + (size_t)((R0 - NPR) >> 10) * (8 * 128 * 1280) + 256 + ((R0 - NPR) & 1023); ldk = 1280; }
        else { base = VTS + (size_t)((R0 - NTOK) >> 8) * (8 * 128 * 1280); ldk = 1280; }
#pragma unroll
        for (int ai = 0; ai < 2; ++ai)
#pragma unroll
            for (int m = 0; m < 4; ++m) { const unsigned hd = (unsigned)((2 * u.pm + ai) * 128 + wr * 64 + m * 16 + fr);
#pragma unroll
                for (int bj = 0; bj < 2; ++bj) { const f32x4 a = acc[ai][bj][m][0], b = acc[ai][bj][m][1];
                    u32x4 w; w.x = pk_bf16(a[0], a[1]); w.y = pk_bf16(a[2], a[3]); w.z = pk_bf16(b[0], b[1]); w.w = pk_bf16(b[2], b[3]);
                    *(u32x4*)(base + (unsigned)(hd * ldk + bj * 128 + wc * 32 + 8 * fq)) = w; }
                __builtin_amdgcn_sched_barrier(0); }
    } };
DEVI void phase_mla_up(const Params& p, int j, lds_t* lds, int bid, int nblk, int tid) {
    int v = xcd_first_unit(bid, nblk);
    const int wid = __builtin_amdgcn_readfirstlane(tid >> 6);
    const bf16_t* wkv = p.WTKV + (size_t)j * 2048 * 256;
    {
        SchedGrid<32, 6, 16, 2> S{p.CQ, p.WTQ + (size_t)j * 1536 * 384, v, nblk, (size_t)256 * 384, (size_t)256 * 384};
        EpiMlaQ E{p.Q, 0.07216878364870322f * LOG2E};
        pg8::gemm_phase(lds, 384, 6, S, E, tid);
    }
    tid = wid * 64 + lane_id_fresh(); asm volatile("" : "+s"(v)); __builtin_amdgcn_sched_barrier(0);
    {
        SchedGrid<36, 4, 4, 4> S{p.CKV, wkv, rot_unit(v, 192 % nblk, nblk), nblk, (size_t)256 * 256, (size_t)512 * 256};
        EpiMlaK E{p.KN};
        pg8::gemm_phase(lds, 256, 4, S, E, tid, 128, 256);
    }
    tid = wid * 64 + lane_id_fresh(); asm volatile("" : "+s"(v)); __builtin_amdgcn_sched_barrier(0);
    {
        SchedGrid<4, 36, 4, 4> S{wkv + (size_t)128 * 256, p.CKV, rot_unit(v, 80 % nblk, nblk), nblk, (size_t)512 * 256, (size_t)256 * 256};
        EpiMlaV E{p.VTP, p.VTS};
        pg8::gemm_phase(lds, 256, 4, S, E, tid, 256, 128);
    }
}

struct SchedOut { const bf16_t* A; const bf16_t* W; int K, v0, G;
    DEVI bool next(int i, pg8::Unit& u) const {
        const int L = i * G + v0; if (L >= 256) return false;
        const int g = L >> 5, w = L & 31; u.aux = g & 1; u.pm = (g >> 1) * 8 + (w & 7); u.pn = w >> 3; return true; }
    DEVI void ptrs(const pg8::Unit& u, const char*& a, const char*& b) const {
        a = (const char*)(A + (size_t)u.pm * 256 * K + (size_t)u.aux * (K >> 1)); b = (const char*)(W + (size_t)u.pn * 256 * K + (size_t)u.aux * (K >> 1)); }
};
struct EpiOut { static constexpr bool PERM = true; bf16_t* Y; const float* mod; int layer;
    DEVI void operator()(const f32x4 (&acc)[2][2][4][2], const pg8::Unit& u, int wr, int wc, int fr_in, int fq_in) const {
        int ln = fr_in | (fq_in << 4); asm volatile("" : "+v"(ln));
        const int fr = ln & 15, fq = ln >> 4;
        const float* gt = mod + ((size_t)(layer * 5 + cond_of_row(u.pm * 256)) * 6 + 2) * 1024;
        bf16_t* Yk = Y + (size_t)u.aux * NTOK * D;
#pragma unroll
        for (int bj = 0; bj < 2; ++bj) { const int col = u.pn * 256 + bj * 128 + wc * 32 + 8 * fq;
            const f32x4 g0 = *(const f32x4*)(gt + col), g1 = *(const f32x4*)(gt + col + 4);
#pragma unroll
            for (int ai = 0; ai < 2; ++ai)
#pragma unroll
                for (int m = 0; m < 4; ++m) { const int row = u.pm * 256 + ai * 128 + wr * 64 + m * 16 + fr;
                    const f32x4 a = acc[ai][bj][m][0] * g0, b = acc[ai][bj][m][1] * g1;
                    u32x4 w; w.x = pk_bf16(a[0], a[1]); w.y = pk_bf16(a[2], a[3]); w.z = pk_bf16(b[0], b[1]); w.w = pk_bf16(b[2], b[3]);
                    *(u32x4*)(Yk + (size_t)row * D + col) = w; } }
    } };
DEVI void phase_out_proj(const Params& p, int layer, const bf16_t* A, int K, const bf16_t* Wt, lds_t* lds, int bid, int nblk, int tid) {
    SchedOut S{A, Wt, K, xcd_first_unit(bid, nblk), nblk};
    EpiOut E{(bf16_t*)p.T, p.mod, layer};
    pg8::gemm_phase(lds, K, K >> 7, S, E, tid);
}

struct SchedGmWin { const bf16_t* H; const bf16_t* W; int v0, G;
    DEVI bool next(int i, pg8::Unit& u) const {
        const int L = i * G + v0; if (L >= 768) return false;
        if (L < 384) { const int g = L >> 5, w = L & 31; u.pm = (g & 3) * 8 + (w & 7); u.pn = (g >> 2) * 4 + (w >> 3); u.aux = 0; }
        else { const int g = (L - 384) >> 5, w = L & 31; u.pm = (g % 3) * 4 + (w & 3); u.pn = (g / 3) * 8 + (w >> 2); u.aux = 1; }
        return true; }
    DEVI void ptrs(const pg8::Unit& u, const char*& a, const char*& b) const {
        if (u.aux == 0) { a = (const char*)(H + (size_t)u.pm * 256 * 1024); b = (const char*)(W + (size_t)u.pn * 256 * 1024); }
        else { a = (const char*)(W + (size_t)(3072 + u.pm * 256) * 1024); b = (const char*)(H + (size_t)u.pn * 256 * 1024); } }
};
struct EpiGmWin { static constexpr bool PERM = true; bf16_t* U; bf16_t* GVT; float* GST;
    DEVI void operator()(const f32x4 (&acc)[2][2][4][2], const pg8::Unit& u, int wr, int wc, int fr_in, int fq_in) const {
        int ln = fr_in | (fq_in << 4); asm volatile("" : "+v"(ln));
        const int fr = ln & 15, fq = ln >> 4;
        const bool vhalf = u.aux != 0;
#pragma unroll
        for (int bj = 0; bj < 2; ++bj) {
            f32x4 s0 = (f32x4){0.f, 0.f, 0.f, 0.f}, s1 = s0, q0 = s0, q1 = s0;
            const int cpos = u.pn * 256 + bj * 128 + wc * 32 + 8 * fq;
#pragma unroll
            for (int ai = 0; ai < 2; ++ai)
#pragma unroll
                for (int m = 0; m < 4; ++m) { const int r = u.pm * 256 + ai * 128 + wr * 64 + m * 16 + fr;
                    f32x4 a = acc[ai][bj][m][0], b = acc[ai][bj][m][1];
#pragma unroll
                    for (int j = 0; j < 4; ++j) { a[j] = gelu_tanh_f(a[j]); b[j] = gelu_tanh_f(b[j]); }
                    u32x4 w; w.x = pk_bf16(a[0], a[1]); w.y = pk_bf16(a[2], a[3]); w.z = pk_bf16(b[0], b[1]); w.w = pk_bf16(b[2], b[3]);
                    if (!vhalf) *(u32x4*)(U + (size_t)r * 3072 + cpos) = w;
                    else { s0 += a; q0 += a * a; s1 += b; q1 += b * b; *(u32x4*)(GVT + ((size_t)(cpos >> 7) * 3072 + r) * 128 + (cpos & 127)) = w; }
                    __builtin_amdgcn_sched_barrier(0); }
            if (vhalf) {
#pragma unroll
                for (int o = 1; o < 16; o <<= 1)
#pragma unroll
                    for (int j = 0; j < 4; ++j) { s0[j] += __shfl_xor(s0[j], o); q0[j] += __shfl_xor(q0[j], o); s1[j] += __shfl_xor(s1[j], o); q1[j] += __shfl_xor(q1[j], o); }
                if (fr == 0) { const int part = u.pm * 2 + wr;
#pragma unroll
                    for (int j = 0; j < 4; ++j) { f32x2 w2; w2.x = s0[j]; w2.y = q0[j]; *(f32x2*)(GST + ((size_t)(cpos + j) * 24 + part) * 2) = w2;
                                                  f32x2 w3; w3.x = s1[j]; w3.y = q1[j]; *(f32x2*)(GST + ((size_t)(cpos + 4 + j) * 24 + part) * 2) = w3; } }
            }
            __builtin_amdgcn_sched_barrier(0);
        }
    } };
DEVI void phase_gm_win(const Params& p, lds_t* lds, int bid, int nblk, int tid) {
    SchedGmWin S{p.H, p.WTGI, xcd_first_unit(bid, nblk), nblk};
    EpiGmWin E{p.U, p.GVT, p.GST};
    pg8::gemm_phase(lds, 1024, 16, S, E, tid);
}

struct EpiSwaQK { static constexpr bool PERM = false; bf16_t* Q; bf16_t* SK; float* out; float scale;
    DEVI void operator()(const f32x4 (&acc)[2][2][4][2], const pg8::Unit& u, int wr, int wc, int fr_in, int fq_in) const {
        int ln = fr_in | (fq_in << 4); asm volatile("" : "+v"(ln));
        const bool isk = (u.pn == 4), rope = (u.pm >= 16), kout = isk && !rope;
        bf16_t* dstb = isk ? SK : Q + u.pn * 256; const unsigned ld = isk ? 256u : 1024u; const float sc = isk ? 1.f : scale;
        const int gi = wc & 1;
#pragma unroll
        for (int bj = 0; bj < 2; ++bj) {
            const int c0 = bj * 128 + wc * 32;
#pragma unroll
            for (int ai = 0; ai < 2; ++ai)
#pragma unroll
                for (int m = 0; m < 4; ++m) { asm volatile("" : "+v"(ln)); const int fr = ln & 15, fq = ln >> 4;
                    const int row = u.pm * 256 + ai * 128 + wr * 64 + m * 16 + fr;
                    f32x4 x1 = acc[ai][bj][m][0], x2 = acc[ai][bj][m][1];
                    if (rope) { const int t = (row - NPR) & 1023, pos = gi ? (t & 63) : (t >> 6);
#pragma unroll
                        for (int j = 0; j < 4; ++j) { const f32x2 cs = *(const f32x2*)(rope_tab + (pos * 16 + 4 * fq + j) * 2);
                            const float a = x1[j], b = x2[j]; x1[j] = a * cs.x - b * cs.y; x2[j] = b * cs.x + a * cs.y; } }
                    const unsigned o = (unsigned)row * ld + c0 + 4 * fq;
                    if (kout) { float* po = out + OUT_SK + (size_t)row * 256 + c0 + 4 * fq; *(f32x4*)po = x1; *(f32x4*)(po + 16) = x2; }
                    st_bf16x4(dstb + o, x1 * sc); st_bf16x4(dstb + o + 16, x2 * sc);
                    __builtin_amdgcn_sched_barrier(0); }
        }
    } };
struct EpiSwaV { static constexpr bool PERM = true; bf16_t* SVTP; bf16_t* SVTS; float* out;
    DEVI void operator()(const f32x4 (&acc)[2][2][4][2], const pg8::Unit& u, int wr, int wc, int fr_in, int fq_in) const {
        int ln = fr_in | (fq_in << 4); asm volatile("" : "+v"(ln));
        const int fr = ln & 15, fq = ln >> 4;
        const int R0 = u.pn * 256;
        bf16_t* base; unsigned ldk;
        if (R0 < NPR) { base = SVTP + (size_t)(R0 >> 8) * (4 * 64 * 256); ldk = 256; }
        else { base = SVTS + (size_t)((R0 - NPR) >> 10) * (4 * 64 * 1280) + 256 + ((R0 - NPR) & 1023); ldk = 1280; }
#pragma unroll
        for (int ai = 0; ai < 2; ++ai)
#pragma unroll
            for (int m = 0; m < 4; ++m) { const unsigned r = (unsigned)(ai * 128 + wr * 64 + m * 16 + fr);
#pragma unroll
                for (int bj = 0; bj < 2; ++bj) { const f32x4 a = acc[ai][bj][m][0], b = acc[ai][bj][m][1];
                    const unsigned c = (unsigned)(bj * 128 + wc * 32 + 8 * fq);
                    u32x4 w; w.x = pk_bf16(a[0], a[1]); w.y = pk_bf16(a[2], a[3]); w.z = pk_bf16(b[0], b[1]); w.w = pk_bf16(b[2], b[3]);
                    *(u32x4*)(base + (r * ldk + c)) = w;
                    if (R0 < NPR) { float* po = out + OUT_SV + (size_t)(R0 + c) * 256 + r;
#pragma unroll
                        for (int i = 0; i < 4; ++i) { po[i * 256] = a[i]; po[(i + 4) * 256] = b[i]; } } }
                __builtin_amdgcn_sched_barrier(0); }
    } };
DEVI void phase_swa_qkv(const Params& p, lds_t* lds, int bid, int nblk, int tid) {
    int v = xcd_first_unit(bid, nblk);
    const int wid = __builtin_amdgcn_readfirstlane(tid >> 6);
    {   int G; const int v0 = xcd_slot(v, nblk, 0, 20, G);
        SchedGrid<32, 5, 4, 5> S{p.H, p.WTSQ, v0, G, (size_t)256 * 1024, (size_t)256 * 1024};
        EpiSwaQK E{p.Q, p.SK, p.out, 0.125f * LOG2E};
        pg8::gemm_phase(lds, 1024, 16, S, E, tid);
    }
    tid = wid * 64 + lane_id_fresh(); asm volatile("" : "+s"(v)); __builtin_amdgcn_sched_barrier(0);
    {   int G; const int v0 = xcd_slot(v, nblk, 20, 4, G);
        SchedGrid<1, 32, 1, 4> S{p.WTSQ + (size_t)1280 * 1024, p.H, v0, G, (size_t)256 * 1024, (size_t)256 * 1024};
        EpiSwaV E{p.SVTP, p.SVTS, p.out};
        pg8::gemm_phase(lds, 1024, 16, S, E, tid);
    }
}

template <int BM> struct EpiHid { bf16_t* HID; int e, mt, nt;
    DEVI void operator()(const f32x4 (&acc)[BM / 32][4], int wr, int wc, int lane) const {
        const int r16 = lane & 15, g = lane >> 4;
#pragma unroll
        for (int mb = 0; mb < BM / 32; ++mb) { const size_t row = (size_t)e * 1024 + mt * BM + wr * (BM / 2) + mb * 16 + r16;
            u32x4 w;
            { const f32x4 gv = acc[mb][0], uv = acc[mb][2]; w.x = pk_bf16(silu_f(gv[0]) * uv[0], silu_f(gv[1]) * uv[1]); w.y = pk_bf16(silu_f(gv[2]) * uv[2], silu_f(gv[3]) * uv[3]); }
            { const f32x4 gv = acc[mb][1], uv = acc[mb][3]; w.z = pk_bf16(silu_f(gv[0]) * uv[0], silu_f(gv[1]) * uv[1]); w.w = pk_bf16(silu_f(gv[2]) * uv[2], silu_f(gv[3]) * uv[3]); }
            *(u32x4*)(HID + row * 2048 + nt * 128 + wc * 32 + 8 * g) = w; }
    } };
template <int DBG = 0> DEVI void phase_moe_up(const Params& p, int layer, lds_t* lds, int bid, int nblk, int tid) {
    constexpr int MT = 1024 / GBM2, NU = 16 * MT * 16;
#define DEC_MU(u_, rf_, wf_) do { const int e_ = (u_) / (MT * 16), w_ = (u_) % (MT * 16), mt_ = w_ % MT, nt_ = w_ / MT; \
        rf_ = RowGather{p.H2, p.IDX + e_ * 1024 + mt_ * GBM2}; wf_ = WMoe{p.moe_w_gate, p.moe_w_up, ((size_t)layer * 16 + e_) * 1024 * 2048 + nt_ * 128}; } while (0)
    int u = xcd_first_unit(bid, nblk);
    RowGather rf, rfn; WMoe wf, wfn;
    for (; u < NU; u += nblk) {
        const int e = u / (MT * 16), w = u % (MT * 16), mt = w % MT, nt = w / MT;
        DEC_MU(u, rf, wf);
        EpiHid<GBM2> epi{p.HID, e, mt, nt};
        gemm_unit<GBM2, true>(lds, rf, wf, 2048u, DBG == 1 ? 8 : 16, epi, tid);
    }
#undef DEC_MU
}
template <int BM> struct EpiYe { bf16_t* YE; const float* GATEV; int e, mt, nt;
    DEVI void operator()(const f32x4 (&acc)[BM / 32][4], int wr, int wc, int lane) const {
        const int r16 = lane & 15, g = lane >> 4;
#pragma unroll
        for (int mb = 0; mb < BM / 32; ++mb) { const size_t row = (size_t)e * 1024 + mt * BM + wr * (BM / 2) + mb * 16 + r16;
            const float gt = GATEV[row];
#pragma unroll
            for (int np = 0; np < 2; ++np) {
                const f32x4 a = acc[mb][2 * np] * gt, b = acc[mb][2 * np + 1] * gt;
                u32x4 w; w.x = pk_bf16(a[0], a[1]); w.y = pk_bf16(a[2], a[3]); w.z = pk_bf16(b[0], b[1]); w.w = pk_bf16(b[2], b[3]);
                *(u32x4*)(YE + row * 1024 + nt * 256 + wc * 64 + 32 * np + 8 * g) = w; } }
    } };
DEVI void phase_moe_down(const Params& p, int layer, lds_t* lds, int bid, int nblk, int tid) {
    constexpr int MT = 1024 / GBM2, NU = 16 * MT * 4;
#define DEC_MD(u_, d_) do { const int e_ = (u_) / (MT * 4), w_ = (u_) % (MT * 4), mt_ = w_ % MT, nt_ = w_ / MT; \
        d_.rf = RowLin{p.HID + ((size_t)e_ * 1024 + mt_ * GBM2) * 2048, 2048u}; d_.wl = WLin{p.moe_w_down + ((size_t)layer * 16 + e_) * 2048 * 1024 + nt_ * 256}; d_.ldw = 1024u; d_.nk = 32; } while (0)
    int u = xcd_first_unit(bid, nblk);
    GDesc d, dn;
    for (; u < NU; u += nblk) {
        const int e = u / (MT * 4), w = u % (MT * 4), mt = w % MT, nt = w / MT;
        DEC_MD(u, d);
        EpiYe<GBM2> epi{p.YE, p.GATEV, e, mt, nt};
        gemm_unit<GBM2, true>(lds, d.rf, WLinP{d.wl.base}, d.ldw, 32, epi, tid);
    }
#undef DEC_MD
}

template <int DK, int DV> struct AttnCfg {
    static constexpr int CPK = DK / 8;
    static constexpr int KT_BYTES = 64 * DK * 2;
    static constexpr int VT_BYTES = DV * 128;
    static constexpr int STAGE = KT_BYTES + VT_BYTES;
    static constexpr int NKC = 64 * CPK / NTHREADS;
    static constexpr int NVC = DV * 8 / NTHREADS;
};
DEVI int kswz(int key) { return ((key >> 1) & 1) | (((key >> 3) & 3) << 1); }

struct AttnSeg { int n_ctx, ctx_krow0, ctx_vcol0, n_loc, loc_krow0, loc_vcol0, loc_kpos0; };

template <int DK, int DV, bool WINDOW, class KSrc>
DEVI void attn_unit(lds_t* lds, const bf16_t* Qp, int ldq, const KSrc& ks, const bf16_t* vt, int ldv, const AttnSeg sg, int qpos0,
                    float sink, bool has_sink, bf16_t* Op, int ldo, int tid) {
    typedef AttnCfg<DK, DV> C;
    const int lane = tid & 63, wave = tid >> 6, r16 = lane & 15, g = lane >> 4;
    const int ntile = sg.n_ctx + sg.n_loc;
    bf16x8 qf[DK / 32];
    {
        const bf16_t* qr = Qp + (size_t)(wave * 16 + r16) * ldq + 8 * g;
#pragma unroll
        for (int s = 0; s < DK / 32; ++s) qf[s] = *(const bf16x8*)(qr + 32 * s);
    }
    u32x4 kreg[C::NKC], vreg[C::NVC];
#define TILE_LOAD(jj) do { const int j_ = (jj); int krow, vcol; \
        if (j_ < sg.n_ctx) { krow = sg.ctx_krow0 + 64 * j_; vcol = sg.ctx_vcol0 + 64 * j_; } \
        else { krow = sg.loc_krow0 + 64 * (j_ - sg.n_ctx); vcol = sg.loc_vcol0 + 64 * (j_ - sg.n_ctx); } \
        _Pragma("unroll") for (int i = 0; i < C::NKC; ++i) { const int c = tid + NTHREADS * i, key = c / C::CPK, ch = c % C::CPK; kreg[i] = *(const u32x4*)ks(krow + key, ch); } \
        _Pragma("unroll") for (int i = 0; i < C::NVC; ++i) { const int c = tid + NTHREADS * i, dv = c >> 3, ch = c & 7; vreg[i] = *(const u32x4*)(vt + (size_t)dv * ldv + vcol + ch * 8); } } while (0)
#define TILE_STORE(stp) do { lds_t* st_ = (stp); \
        _Pragma("unroll") for (int i = 0; i < C::NKC; ++i) { const int c = tid + NTHREADS * i, key = c / C::CPK, ch = c % C::CPK; lds_st128(st_ + key * (DK * 2) + ((ch ^ kswz(key)) << 4), kreg[i]); } \
        _Pragma("unroll") for (int i = 0; i < C::NVC; ++i) { const int c = tid + NTHREADS * i, dv = c >> 3, ch = c & 7; lds_st128(st_ + C::KT_BYTES + img_off(dv, ch), vreg[i]); } } while (0)
    f32x4 o[DV / 16];
#pragma unroll
    for (int i = 0; i < DV / 16; ++i) o[i] = (f32x4){0.f, 0.f, 0.f, 0.f};
    float m = has_sink ? sink : -1.0e30f;
    float l = (has_sink && g == 0) ? 1.0f : 0.0f;
    const int qpos = qpos0 + wave * 16 + r16;
    const int kbyte = (8 * (r16 >> 2) + (r16 & 3)) * (DK * 2);
    const int ksw0 = ((r16 >> 1) & 1) | ((r16 >> 2) << 1);
    const int ke0 = (g ^ ksw0) << 4, ke1 = ((4 + g) ^ ksw0) << 4;
    const int vc0 = g ^ ((r16 >> 1) & 7);

    TILE_LOAD(0);
    __syncthreads();
    TILE_STORE(lds);
    if (ntile > 1) TILE_LOAD(1);
    for (int j = 0; j < ntile; ++j) {
        __syncthreads();
        lds_t* cur = lds + (j & 1) * C::STAGE;
        if (j + 1 < ntile) { TILE_STORE(lds + ((j + 1) & 1) * C::STAGE); if (j + 2 < ntile) TILE_LOAD(j + 2); }
        const bool masked = WINDOW && (j >= sg.n_ctx);
        const int kpos0 = sg.loc_kpos0 + 64 * (j - sg.n_ctx);
        if (masked) {
            const int qlo = qpos0 + wave * 16;
            if (kpos0 > qlo + 15 + 128 || kpos0 + 63 < qlo - 128) continue;
        }
        f32x4 s[4];
        {
            lds_t* kb0 = cur + kbyte + ke0;
            lds_t* kb1 = cur + kbyte + ke1;
#pragma unroll
            for (int grp = 0; grp < 2; ++grp)
#pragma unroll
                for (int b = 0; b < 2; ++b) {
                    f32x4 a = (f32x4){0.f, 0.f, 0.f, 0.f};
#pragma unroll
                    for (int st = 0; st < DK / 32; ++st) {
                        const bf16x8 kf = lds_ld128(((st & 1) ? kb1 : kb0) + (32 * grp + 4 * b) * (DK * 2) + (st >> 1) * 128);
                        a = __builtin_amdgcn_mfma_f32_16x16x32_bf16(kf, qf[st], a, 0, 0, 0);
                    }
                    s[grp * 2 + b] = a;
                }
        }
        if (masked) {
#pragma unroll
            for (int grp = 0; grp < 2; ++grp)
#pragma unroll
                for (int b = 0; b < 2; ++b)
#pragma unroll
                    for (int r = 0; r < 4; ++r) {
                        const int kp = kpos0 + 32 * grp + 8 * g + 4 * b + r;
                        const int d = qpos - kp;
                        if (d > 128 || d < -128) s[grp * 2 + b][r] = -1.0e30f;
                    }
        }
        float mx = fmaxf(fmaxf(fmaxf(s[0][0], s[0][1]), fmaxf(s[0][2], s[0][3])), fmaxf(fmaxf(s[1][0], s[1][1]), fmaxf(s[1][2], s[1][3])));
        mx = fmaxf(mx, fmaxf(fmaxf(fmaxf(s[2][0], s[2][1]), fmaxf(s[2][2], s[2][3])), fmaxf(fmaxf(s[3][0], s[3][1]), fmaxf(s[3][2], s[3][3]))));
        mx = fmaxf(mx, __shfl_xor(mx, 16)); mx = fmaxf(mx, __shfl_xor(mx, 32));
        const float mn = fmaxf(m, mx);
        const float alpha = fexp2(m - mn);
        m = mn;
        float ps = 0.f;
#pragma unroll
        for (int i = 0; i < 4; ++i)
#pragma unroll
            for (int r = 0; r < 4; ++r) { const float pv = fexp2(s[i][r] - mn); s[i][r] = pv; ps += pv; }
        l = l * alpha + ps;
#pragma unroll
        for (int i = 0; i < DV / 16; ++i) o[i] = o[i] * alpha;
#pragma unroll
        for (int grp = 0; grp < 2; ++grp) {
            u32x4 pw;
            pw.x = pk_bf16(s[grp * 2][0], s[grp * 2][1]); pw.y = pk_bf16(s[grp * 2][2], s[grp * 2][3]);
            pw.z = pk_bf16(s[grp * 2 + 1][0], s[grp * 2 + 1][1]); pw.w = pk_bf16(s[grp * 2 + 1][2], s[grp * 2 + 1][3]);
            bf16x8 pf; __builtin_memcpy(&pf, &pw, 16);
#pragma unroll
            for (int dvb = 0; dvb < DV / 16; ++dvb) {
                const bf16x8 vf = lds_ld128(cur + C::KT_BYTES + r16 * 128 + dvb * 2048 + (((vc0 ^ (4 * grp)) ^ (dvb & 1)) << 4));
                o[dvb] = __builtin_amdgcn_mfma_f32_16x16x32_bf16(vf, pf, o[dvb], 0, 0, 0);
            }
        }
    }
    l += __shfl_xor(l, 16); l += __shfl_xor(l, 32);
    const float inv = frcp(l);
    bf16_t* orow = Op + (size_t)(wave * 16 + r16) * ldo + 4 * g;
#pragma unroll
    for (int dvb = 0; dvb < DV / 16; ++dvb) st_bf16x4(orow + dvb * 16, o[dvb] * inv);
}

struct KSrcMla { const bf16_t* KN; const bf16_t* KPE; int h;
    DEVI const bf16_t* operator()(int krow, int ch) const { return ch < 16 ? KN + (size_t)krow * 1024 + h * 128 + ch * 8 : KPE + (size_t)krow * 64 + (ch - 16) * 8; } };
struct KSrcSwa { const bf16_t* SK; int kvh;
    DEVI const bf16_t* operator()(int krow, int ch) const { return SK + (size_t)krow * 256 + kvh * 64 + ch * 8; } };

DEVI void phase_mla_attn(const Params& p, lds_t* lds, int bid, int nblk, int tid) {
    for (int u = xcd_first_unit(bid, nblk); u < 512; u += nblk) {
        if (u < 256) {
            const int b = u >> 6, h = (u >> 3) & 7, qt = u & 7;
            const int qrow0 = NPR + b * 1024 + qt * 128;
            KSrcMla ks{p.KN, p.KPE, h};
            AttnSeg sg{4, NTOK + b * 256, 0, 16, NPR + b * 1024, 256, 0};
            attn_unit<192, 128, false>(lds, p.Q + (size_t)qrow0 * 1536 + h * 192, 1536, ks, p.VTS + (size_t)(b * 8 + h) * 128 * 1280, 1280, sg, 0, 0.f, false,
                                       p.O + (size_t)qrow0 * 1024 + h * 128, 1024, tid);
        } else {
            const int v = u - 256, b = v >> 4, h = (v >> 1) & 7, qt = v & 1;
            const int qrow0 = b * 256 + qt * 128;
            KSrcMla ks{p.KN, p.KPE, h};
            AttnSeg sg{0, 0, 0, 4, b * 256, 0, 0};
            attn_unit<192, 128, false>(lds, p.Q + (size_t)qrow0 * 1536 + h * 192, 1536, ks, p.VTP + (size_t)(b * 8 + h) * 128 * 256, 256, sg, 0, 0.f, false,
                                       p.O + (size_t)qrow0 * 1024 + h * 128, 1024, tid);
        }
    }
}
DEVI void phase_swa_attn(const Params& p, lds_t* lds, int bid, int nblk, int tid) {
    for (int u = xcd_first_unit(bid, nblk); u < 1024; u += nblk) {
        const int w = u >> 8, idx = ((u >> 9) << 8) | (u & 255);
        if ((w & 1) == 0) {
            const int b = idx >> 7, hq = (idx >> 3) & 15, qt = idx & 7, kvh = hq >> 2;
            const int qs = qt * 128, qrow0 = NPR + b * 1024 + qs;
            const int lo = qs >= 128 ? qs - 128 : 0, hi = qs + 256 <= 1024 ? qs + 256 : 1024;
            KSrcSwa ks{p.SK, kvh};
            AttnSeg sg{4, NTOK + b * 256, 0, (hi - lo) >> 6, NPR + b * 1024 + lo, 256 + lo, lo};
            attn_unit<64, 64, true>(lds, p.Q + (size_t)qrow0 * 1024 + hq * 64, 1024, ks, p.SVTS + (size_t)(b * 4 + kvh) * 64 * 1280, 1280, sg, qs,
                                    p.swa_sink[hq] * LOG2E, true, p.O + (size_t)qrow0 * 1024 + hq * 64, 1024, tid);
        } else {
            const int b = idx >> 5, hq = (idx >> 1) & 15, qt = idx & 1, kvh = hq >> 2;
            const int qrow0 = b * 256 + qt * 128;
            KSrcSwa ks{p.SK, kvh};
            AttnSeg sg{0, 0, 0, 4, b * 256, 0, 0};
            attn_unit<64, 64, false>(lds, p.Q + (size_t)qrow0 * 1024 + hq * 64, 1024, ks, p.SVTP + (size_t)(b * 4 + kvh) * 64 * 256, 256, sg, 0,
                                     p.swa_sink[hq] * LOG2E, true, p.O + (size_t)qrow0 * 1024 + hq * 64, 1024, tid);
        }
    }
}

DEVI void phase_gm_spatial(const Params& p, lds_t* lds, int bid, int nblk, int tid) {
    const int lane = tid & 63, wave = tid >> 6, r16 = lane & 15, g = lane >> 4, wr = wave >> 2, wc = wave & 3;
    lds_t* aimg = lds;
    lds_t* vimg = lds + 32768;
    LAS float* mean = (LAS float*)(lds + 65536);
    LAS float* rstd = mean + 128;
    LAS float* biasp = rstd + 128;
    LAS float* bpart = biasp + 128;
    for (int u = xcd_first_unit(bid, nblk); u < 512; u += nblk) {
        const int chunk = u >> 3, grp = u & 7;
        u32x4 vt[4]; u32x2 uw[4][2];
#define GS_LOAD_VT(cs_) do { const bf16_t* src_ = p.GVT + ((size_t)chunk * 3072 + grp * 384 + (cs_) * 128) * 128; \
            _Pragma("unroll") for (int i = 0; i < 4; ++i) { const int c_ = tid + NTHREADS * i; vt[i] = *(const u32x4*)(src_ + (size_t)(c_ >> 4) * 128 + (c_ & 15) * 8); } } while (0)
#define GS_LOAD_U(cs_) do { _Pragma("unroll") for (int mb = 0; mb < 4; ++mb) _Pragma("unroll") for (int nb = 0; nb < 2; ++nb) \
            uw[mb][nb] = *(const u32x2*)(p.U + ((size_t)chunk * 128 + wr * 64 + mb * 16 + r16) * 3072 + grp * 384 + (cs_) * 128 + wc * 32 + nb * 16 + 4 * g); } while (0)
        GS_LOAD_VT(0); GS_LOAD_U(0);
        __syncthreads();
        if (tid < 128) {
            const float* gs = p.GST + (size_t)(chunk * 128 + tid) * 48;
            float s = 0.f, q = 0.f;
            for (int i = 0; i < 24; ++i) { s += gs[2 * i]; q += gs[2 * i + 1]; }
            const float mu = s * (1.0f / 3072.0f);
            const float var = q * (1.0f / 3072.0f) - mu * mu;
            mean[tid] = mu; rstd[tid] = rsqrtf(fmaxf(var, 0.f) + EPS_F);
        }
        __syncthreads();
        {
            const int n = tid >> 2, mq = tid & 3;
            const float* ws = p.gm_w_s + ((size_t)grp * 128 + n) * 128 + mq * 32;
            float bp = 0.f;
#pragma unroll
            for (int c4 = 0; c4 < 4; ++c4) {
                const f32x4 w0 = *(const f32x4*)(ws + c4 * 8), w1 = *(const f32x4*)(ws + c4 * 8 + 4);
                const int m0 = mq * 32 + c4 * 8;
                float a[8];
#pragma unroll
                for (int i = 0; i < 4; ++i) { a[i] = w0[i] * rstd[m0 + i]; a[4 + i] = w1[i] * rstd[m0 + 4 + i]; }
                u32x4 v; v.x = pk_bf16(a[0], a[1]); v.y = pk_bf16(a[2], a[3]); v.z = pk_bf16(a[4], a[5]); v.w = pk_bf16(a[6], a[7]);
#pragma unroll
                for (int i = 0; i < 4; ++i) { const unsigned wd = i == 0 ? v.x : i == 1 ? v.y : i == 2 ? v.z : v.w; bp += bf_lo(wd) * mean[m0 + 2 * i] + bf_hi(wd) * mean[m0 + 2 * i + 1]; }
                const int kc = m0 >> 3;
                lds_st128(aimg + (kc >> 3) * 16384 + img_off(n, kc & 7), v);
            }
            bpart[mq * 128 + n] = bp;
        }
        __syncthreads();
        if (tid < 128) biasp[tid] = bpart[tid] + bpart[128 + tid] + bpart[256 + tid] + bpart[384 + tid];
        for (int cs = 0; cs < 3; ++cs) {
            __syncthreads();
            {
#pragma unroll
                for (int i = 0; i < 4; ++i) { const int c = tid + NTHREADS * i, row = c >> 4, kc = c & 15;
                    lds_st128(vimg + (kc >> 3) * 16384 + img_off(row, kc & 7), vt[i]); }
                if (cs < 2) GS_LOAD_VT(cs + 1);
            }
            __syncthreads();
            f32x4 acc[4][2];
#pragma unroll
            for (int i = 0; i < 4; ++i) { acc[i][0] = (f32x4){0.f, 0.f, 0.f, 0.f}; acc[i][1] = acc[i][0]; }
#pragma unroll
            for (int kh = 0; kh < 2; ++kh)
#pragma unroll
                for (int s = 0; s < 2; ++s) {
                    bf16x8 af[4], vf[2];
#pragma unroll
                    for (int mb = 0; mb < 4; ++mb) af[mb] = lds_ld128(aimg + kh * 16384 + img_off(wr * 64 + mb * 16 + r16, 4 * s + g));
#pragma unroll
                    for (int nb = 0; nb < 2; ++nb) vf[nb] = lds_ld128(vimg + kh * 16384 + img_off(wc * 32 + nb * 16 + r16, 4 * s + g));
#pragma unroll
                    for (int mb = 0; mb < 4; ++mb)
#pragma unroll
                        for (int nb = 0; nb < 2; ++nb) acc[mb][nb] = __builtin_amdgcn_mfma_f32_16x16x32_bf16(vf[nb], af[mb], acc[mb][nb], 0, 0, 0);
                }
#pragma unroll
            for (int mb = 0; mb < 4; ++mb) {
                const int n = wr * 64 + mb * 16 + r16;
                const float bp = biasp[n], bs = p.gm_b_s[grp * 128 + n];
                const size_t row = (size_t)chunk * 128 + n;
#pragma unroll
                for (int nb = 0; nb < 2; ++nb) {
                    const int col = grp * 384 + cs * 128 + wc * 32 + nb * 16 + 4 * g;
                    const f32x4 gn = *(const f32x4*)(p.gm_v_gain + col);
                    const u32x2 uq = uw[mb][nb];
                    f32x4 t;
                    t[0] = bf_lo(uq.x) * (gn[0] * (acc[mb][nb][0] - bp) + bs);
                    t[1] = bf_hi(uq.x) * (gn[1] * (acc[mb][nb][1] - bp) + bs);
                    t[2] = bf_lo(uq.y) * (gn[2] * (acc[mb][nb][2] - bp) + bs);
                    t[3] = bf_hi(uq.y) * (gn[3] * (acc[mb][nb][3] - bp) + bs);
                    st_bf16x4(p.TT + row * 3072 + col, t);
                }
            }
            if (cs < 2) GS_LOAD_U(cs + 1);
        }
#undef GS_LOAD_VT
#undef GS_LOAD_U
    }
}

constexpr int N_PHASES = 2 + 10 * DEPTH;
__global__ void __launch_bounds__(NTHREADS, 2) fwd_kernel(Params p_kernarg) {
    extern __shared__ __attribute__((aligned(16))) unsigned char smem[];
    lds_t* lds = (lds_t*)smem;
    const int tid0 = threadIdx.x, bid0 = blockIdx.x, nblk0 = gridDim.x;
    const int wave0 = __builtin_amdgcn_readfirstlane(tid0 >> 6);
    volatile LAS unsigned* misc = (volatile LAS unsigned*)(lds + LDS_MAIN);
    if (tid0 == 0) { misc[0] = 0u; misc[1] = 0u; misc[2] = 0u; misc[3] = 0u; }
    __syncthreads();
    typedef const __attribute__((address_space(4))) Params* kparams_t;
    kparams_t pp = (kparams_t)__builtin_amdgcn_kernarg_segment_ptr();
    const int lo = (int)pp->ph_lo, hi = (int)pp->ph_hi;
    XcdBarrier bar; bar.bar = pp->bar; bar.x = 0; bar.st = misc;
    if (hi - lo > 1) bar = xcd_barrier_post(bar.bar, misc);
#define IN(k) (lo <= (k) && (k) < hi)
#ifndef REP_MASK
#define REP_MASK 0
#endif
#ifndef REP_N
#define REP_N 1
#endif
#define RUN(k, knext, cls, body) do { if (IN(k)) { { asm volatile("" : "+s"(pp)); Params p; __builtin_memcpy(&p, pp, sizeof(Params)); \
        unsigned zz = 0u; asm volatile("" : "+s"(zz)); int tid = wave0 * 64 + (int)__builtin_amdgcn_mbcnt_hi(~0u, __builtin_amdgcn_mbcnt_lo(~0u, zz)), bid = bid0, nblk = nblk0; asm volatile("" : "+v"(tid)); asm volatile("" : "+s"(bid), "+s"(nblk)); body; \
        if ((REP_MASK) & (cls)) { _Pragma("unroll 1") for (int rr = 0; rr < REP_N; ++rr) { asm volatile("" : "+v"(tid)); body; } } } if (IN(knext)) { xcd_barrier(bar); if ((REP_MASK) & 8192) xcd_barrier(bar); } } } while (0)
    RUN(0, 1, 64, { phase_modulation(p, lds, bid, nblk, tid); phase_wconv(p, 0, lds, bid, nblk, tid); });
    RUN(1, 2, 512, phase_prep(p, bid, nblk, tid));
#pragma unroll 1
    for (int li = 0; li < DEPTH; ++li) {
        const int kind = li % 3, j = li / 3, base = 2 + 10 * li;
        if (kind == 0) {
            RUN(base + 0, base + 1, 32, phase_mla_win(p, j, lds, bid, nblk, tid));
            RUN(base + 1, base + 2, 1024, phase_mla_norm(p, j, bid, nblk, tid));
            RUN(base + 2, base + 3, 32768, phase_mla_up(p, j, lds, bid, nblk, tid));
            RUN(base + 3, base + 4, 16, phase_mla_attn(p, lds, bid, nblk, tid));
            RUN(base + 4, base + 5, 8, phase_out_proj(p, li, p.O, 1024, p.WTO + (size_t)j * 1024 * 1024, lds, bid, nblk, tid));
        } else if (kind == 1) {
            RUN(base + 0, base + 1, 4, phase_gm_win(p, lds, bid, nblk, tid));
            RUN(base + 1, base + 2, 128, phase_gm_spatial(p, lds, bid, nblk, tid));
            RUN(base + 2, base + 5, 8, phase_out_proj(p, li, p.TT, 3072, p.WTGO, lds, bid, nblk, tid));
        } else {
            RUN(base + 0, base + 1, 16384, phase_swa_qkv(p, lds, bid, nblk, tid));
            RUN(base + 1, base + 2, 16, phase_swa_attn(p, lds, bid, nblk, tid));
            RUN(base + 2, base + 5, 8, phase_out_proj(p, li, p.O, 1024, p.WTSO, lds, bid, nblk, tid));
        }
        RUN(base + 5, base + 6, 2048, phase_ln_a(p, li, lds, bid, nblk, tid));
        RUN(base + 6, base + 7, 256, { phase_topk(p, lds, bid, nblk, tid);
            if (li < DEPTH - 1) { if (nblk > 32) { if (bid >= 32) phase_wconv(p, li + 1, lds, bid - 32, nblk - 32, tid); } else phase_wconv(p, li + 1, lds, bid, nblk, tid); } });
        RUN(base + 7, base + 8, 1, phase_moe_up(p, li, lds, bid, nblk, tid));
        RUN(base + 8, base + 9, 2, phase_moe_down(p, li, lds, bid, nblk, tid));
        RUN(base + 9, base + 10, 4096, phase_ln_b(p, li, bid, nblk, tid));
    }
#undef IN
#undef RUN
}

#ifdef PROBE_V
__global__ void __launch_bounds__(NTHREADS, 2) probe_kernel(Params p) {
    extern __shared__ __attribute__((aligned(16))) unsigned char smem[];
    lds_t* lds = (lds_t*)smem;
    const int tid = threadIdx.x, bid = blockIdx.x, nblk = gridDim.x;
#if PROBE_V < 1000
    if (PROBE_V == 1) phase_mla_attn(p, lds, bid, nblk, tid);
    else if (PROBE_V == 2) phase_swa_attn(p, lds, bid, nblk, tid);
    else if (PROBE_V == 3) phase_gm_spatial(p, lds, bid, nblk, tid);
    else if (PROBE_V == 4) phase_ln_a(p, 3, lds, bid, nblk, tid);
    else if (PROBE_V == 5) phase_mla_up(p, 1, lds, bid, nblk, tid);
    else if (PROBE_V == 7) phase_moe_up<1>(p, 0, lds, bid, nblk, tid);
    else phase_moe_up<0>(p, 0, lds, bid, nblk, tid);
#else
    const int lane = tid & 63, wave = tid >> 6;
    const int u0 = xcd_first_unit(bid, nblk);
    f32x4 acc = (f32x4){0.f, 0.f, 0.f, 0.f};
    for (int u = u0; u < 1024; u += nblk) {
        const int e = u >> 6, w = u & 63, nt = w >> 2;
        const float* wp = p.moe_w_gate + (size_t)e * 1024 * 2048 + nt * 128 + 4 * lane + (size_t)(8 * wave) * 2048;
        const bf16_t* xp = p.H2 + (size_t)((u * 37 + wave * 8 + (lane >> 3)) & 8191) * 1024 + (lane & 7) * 8;
#pragma unroll 2
        for (int kt = 0; kt < 16; ++kt) {
            const float* q = wp + (size_t)((PROBE_V & 1) ? 0 : ((PROBE_V & 4) ? ((kt + (w & 3) * ((PROBE_V >> 4) & 7)) & 15) : ((PROBE_V & 8) ? (kt & 3) : kt))) * 64 * 2048;
#pragma unroll
            for (int i = 0; i < 8; ++i) acc += *(const f32x4*)(q + (size_t)i * 2048);
            if (PROBE_V & 2) {
#pragma unroll
                for (int j = 0; j < 4; ++j) { const u32x4 x = *(const u32x4*)(xp + (size_t)j * 64 * 1024 + kt * 64); acc[0] += __uint_as_float(x.x & 0x3f800000u); }
            }
        }
    }
    if (acc[0] + acc[1] + acc[2] + acc[3] == 12345.678f) p.GST[tid] = acc[0];
#endif
}
#endif
extern "C" void kernel_launch(void* const* d_in, const int* in_sizes, int n_in, void* d_out, int out_size, void* d_ws, size_t ws_size, hipStream_t stream) {
    static int grid = 0;
    if (grid == 0) {
        int dev = 0, cus = 0, per_cu = 0;
        if (hipGetDevice(&dev) != hipSuccess || hipDeviceGetAttribute(&cus, hipDeviceAttributeMultiprocessorCount, dev) != hipSuccess) { fprintf(stderr, "kernel_launch: device query failed\n"); grid = -1; return; }
        if (hipFuncSetAttribute((const void*)fwd_kernel, hipFuncAttributeMaxDynamicSharedMemorySize, LDS_BYTES) != hipSuccess) { fprintf(stderr, "kernel_launch: hipFuncSetAttribute failed\n"); grid = -1; return; }
        if (hipOccupancyMaxActiveBlocksPerMultiprocessor(&per_cu, (const void*)fwd_kernel, NTHREADS, LDS_BYTES) != hipSuccess || per_cu < 1) {
            fprintf(stderr, "kernel_launch: occupancy query reports %d blocks per CU\n", per_cu); (void)hipGetLastError(); per_cu = 1; }
        grid = cus;
    }
    if (grid < 0) return;
    unsigned char* ws = (unsigned char*)d_ws;
    size_t off = 0;
    auto take = [&](size_t bytes) { unsigned char* r = ws + off; off += (bytes + 255) & ~(size_t)255; return r; };
    Params p{};
    const float* const* in = (const float* const*)d_in;
    p.x_prompt = in[0]; p.x_sample = in[1]; p.cache_ckv = in[2]; p.cache_kpe = in[3]; p.cache_k = in[4]; p.cache_v = in[5]; p.c = in[6]; p.c_ctx = in[7];
    p.mod_w = in[8]; p.mod_b = in[9]; p.ln_gain = in[10]; p.ln_bias = in[11];
    p.mla_w_in = in[12]; p.mla_q_gain = in[13]; p.mla_kv_gain = in[14]; p.mla_w_q_up = in[15]; p.mla_w_kv_up = in[16]; p.mla_w_out = in[17];
    p.gm_w_in = in[18]; p.gm_v_gain = in[19]; p.gm_w_s = in[20]; p.gm_b_s = in[21]; p.gm_w_out = in[22];
    p.swa_w_qkv = in[23]; p.swa_sink = in[24]; p.swa_w_out = in[25];
    p.moe_router = in[26]; p.moe_w_gate = in[27]; p.moe_w_up = in[28]; p.moe_w_down = in[29];
    p.out = (float*)d_out;
    p.bar = (unsigned*)take(16384);
    p.mod = (float*)take((size_t)DEPTH * 5 * 6144 * 4);
    p.X0 = (float*)take((size_t)NTOK * D * 4); p.X1 = (float*)take((size_t)NTOK * D * 4); p.T = (float*)take((size_t)NTOK * D * 4);
    p.Z = (float*)take((size_t)NTOK * 704 * 4); p.GST = (float*)take((size_t)NTOK * 96 * 4); p.AFF = (float*)take((size_t)NTOK * 16 * 4); p.GATEV = (float*)take(16 * 1024 * 4);
    p.H = (bf16_t*)take((size_t)NTOK * D * 2); p.H2 = (bf16_t*)take((size_t)NTOK * D * 2);
    p.CQ = (bf16_t*)take((size_t)NTOK * 384 * 2); p.CKV = (bf16_t*)take((size_t)NROWS_KV * 256 * 2); p.KPE = (bf16_t*)take((size_t)NROWS_KV * 64 * 2);
    p.Q = (bf16_t*)take((size_t)NTOK * 1536 * 2); p.KN = (bf16_t*)take((size_t)NROWS_KV * 1024 * 2);
    p.VTP = (bf16_t*)take((size_t)16 * 8 * 128 * 256 * 2); p.VTS = (bf16_t*)take((size_t)4 * 8 * 128 * 1280 * 2);
    p.O = (bf16_t*)take((size_t)NTOK * D * 2);
    p.U = (bf16_t*)take((size_t)NTOK * 3072 * 2); p.GVT = (bf16_t*)take((size_t)NTOK * 3072 * 2); p.TT = (bf16_t*)take((size_t)NTOK * 3072 * 2);
    p.SK = (bf16_t*)take((size_t)NROWS_KV * 256 * 2); p.SVTP = (bf16_t*)take((size_t)16 * 4 * 64 * 256 * 2); p.SVTS = (bf16_t*)take((size_t)4 * 4 * 64 * 1280 * 2);
    p.HID = (bf16_t*)take((size_t)16 * 1024 * 2048 * 2); p.YE = (bf16_t*)take((size_t)16 * 1024 * 1024 * 2);
    p.SEL = (int*)take((size_t)NTOK * 16 * 4); p.IDX = (int*)take(16 * 1024 * 4);
    p.WTI = (bf16_t*)take((size_t)2 * 704 * 1024 * 2); p.WTQ = (bf16_t*)take((size_t)2 * 1536 * 384 * 2); p.WTKV = (bf16_t*)take((size_t)2 * 2048 * 256 * 2); p.WTO = (bf16_t*)take((size_t)2 * 1024 * 1024 * 2);
    p.WTGI = (bf16_t*)take((size_t)6144 * 1024 * 2); p.WTGO = (bf16_t*)take((size_t)1024 * 3072 * 2); p.WTSQ = (bf16_t*)take((size_t)1536 * 1024 * 2); p.WTSO = (bf16_t*)take((size_t)1024 * 1024 * 2);
    if (off > ws_size) { fprintf(stderr, "kernel_launch: workspace too small: need %zu, have %zu\n", off, ws_size); return; }
    (void)in_sizes; (void)n_in; (void)out_size;
    if (hipMemsetAsync(p.bar, 0, 16384, stream) != hipSuccess) { fprintf(stderr, "kernel_launch: memset failed\n"); return; }
#if N_LAUNCH_PER_PHASE
#ifndef MAX_PHASE
#define MAX_PHASE N_PHASES
#endif
    for (int k = 0; k < MAX_PHASE; ++k) {
        if (k >= 2) { const int li = (k - 2) / 10, s = (k - 2) % 10, kind = li % 3; if (kind != 0 && (s == 3 || s == 4)) continue; }
        p.ph_lo = k; p.ph_hi = k + 1;
        hipLaunchKernelGGL(fwd_kernel, dim3(grid), dim3(NTHREADS), LDS_BYTES, stream, p);
    }
#else
    p.ph_lo = 0; p.ph_hi = N_PHASES;
    hipLaunchKernelGGL(fwd_kernel, dim3(grid), dim3(NTHREADS), LDS_BYTES, stream, p);
#endif
#ifdef PROBE_V
    { static int once = 0; if (!once) { once = 1; (void)hipFuncSetAttribute((const void*)probe_kernel, hipFuncAttributeMaxDynamicSharedMemorySize, LDS_BYTES); }
      hipLaunchKernelGGL(probe_kernel, dim3(grid), dim3(NTHREADS), LDS_BYTES, stream, p); }
#endif
    const hipError_t le = hipPeekAtLastError();
    if (le != hipSuccess) fprintf(stderr, "kernel_launch: launch failed: %s\n", hipGetErrorName(le));
}
```
